# Optimizing an MI355X kernel written in HIP

```python
import math
import jax, jax.numpy as jnp
from jax import lax
import numpy as np


D_MODEL = 1024
BATCH = 2
SEQ = 8192
DEPTH = 2

N_META = 16
CHUNK = 128
PAD = CHUNK
ROPE_THETA = 10000.0
EPS = 1e-6
LB_FLOOR = 1e-30
RET_HEADS = 4
RET_DK = 128
RET_DV = 256
HG_HEADS = 8
HG_DK = 128
HG_DV = 128
DA_HEADS = 8
DA_DH = 64
DA_DV = 2 * DA_DH
N_BRANCH = 3
BRANCH_WIDTH = 1024
D_FF = 2816
CONV_W = 3
Q_BLOCK = 128
MASK_VALUE = -1e30
RET_QK_W = RET_HEADS * RET_DK
RET_V_W = RET_HEADS * RET_DV
HG_K_W = HG_HEADS * HG_DK
HG_V_W = HG_HEADS * HG_DV
DA_QK_W = DA_HEADS * 2 * DA_DH
DA_V_W = DA_HEADS * DA_DV
IN_SPLITS = (RET_QK_W, RET_QK_W, RET_V_W, RET_V_W, HG_K_W, HG_K_W, HG_V_W, HG_V_W, DA_QK_W, DA_QK_W, DA_V_W, N_BRANCH * D_MODEL)
IN_WIDTH = sum(IN_SPLITS)
F32 = jnp.float32

kernel_name = 'hybrid_retention_hgrn2_diffattn_block'


def _rms(x):
    xf = x.astype(F32)
    return xf * lax.rsqrt(jnp.mean(xf * xf, axis=-1, keepdims=True) + EPS)


def rms_norm(x, g):
    return (_rms(x) * g.astype(F32)).astype(x.dtype)


def rope(x, pos):
    d = x.shape[-1]
    inv = ROPE_THETA ** (-jnp.arange(0, d, 2, dtype=F32) / d)
    ang = pos.astype(F32)[:, None] * inv[None, :]
    cos = jnp.cos(ang)[None, :, None, :]
    sin = jnp.sin(ang)[None, :, None, :]
    x1, x2 = jnp.split(x, 2, axis=-1)
    return jnp.concatenate([x1 * cos - x2 * sin, x2 * cos + x1 * sin], axis=-1)


def to_chunks(x):
    b, l = x.shape[:2]
    return jnp.swapaxes(x.reshape((b, l // CHUNK, CHUNK) + x.shape[2:]), 0, 1)


def from_chunks(x):
    n, b = x.shape[:2]
    return jnp.swapaxes(x, 0, 1).reshape((b, n * CHUNK) + x.shape[3:])


def retention(q, k, v, gate, valid, pos):
    b = q.shape[0]
    q = rope(q, pos)
    k = jnp.where(valid[None, :, None, None], rope(k, pos) * RET_DK ** -0.5, 0.0)
    log_g = jnp.log1p(-jnp.exp2(-5.0 - jnp.arange(RET_HEADS, dtype=F32)))
    idx = jnp.arange(CHUNK, dtype=F32)
    gap = idx[:, None] - idx[None, :]
    intra = jnp.where(gap >= 0, jnp.exp(log_g[:, None, None] * jnp.maximum(gap, 0.0)), 0.0)
    q_dec = jnp.exp(log_g[:, None] * (idx[None, :] + 1.0))
    k_dec = jnp.exp(log_g[:, None] * (CHUNK - 1.0 - idx[None, :]))
    c_dec = jnp.exp(log_g * CHUNK)[None, :, None, None]

    def step(state, xs):
        qc, kc, vc = xs
        s = jnp.einsum('bqhd,bkhd->bhqk', qc, kc) * intra[None]
        o = jnp.einsum('bhqk,bkhe->bqhe', s, vc) + jnp.einsum('bqhd,hq,bhde->bqhe', qc, q_dec, state)
        state = c_dec * state + jnp.einsum('bkhd,hk,bkhe->bhde', kc, k_dec, vc)
        return state, o

    s0 = jnp.zeros((b, RET_HEADS, RET_DK, RET_DV), F32)
    _, o = lax.scan(step, s0, (to_chunks(q), to_chunks(k), to_chunks(v)))
    o = _rms(from_chunks(o)) * jax.nn.silu(gate)
    return o.reshape(b, -1, RET_V_W)


def hgrn2(q, f_logit, inp, gate, lb, valid):
    b = q.shape[0]
    lbh = lb.reshape(HG_HEADS, HG_DK)
    log_f = jnp.logaddexp(jnp.log(jnp.maximum(lbh, LB_FLOOR)), jnp.log1p(-lbh) + jax.nn.log_sigmoid(f_logit))
    k = (1.0 - lbh) * jax.nn.sigmoid(-f_logit)
    v = jnp.where(valid[None, :, None, None], inp, 0.0)
    causal = jnp.tril(jnp.ones((CHUNK, CHUNK), bool))[None, :, :, None, None]

    def step(state, xs):
        qc, kc, vc, lfc = xs
        cb = jnp.cumsum(lfc, axis=1)
        rel = cb[:, :, None] - cb[:, None, :]
        dec = jnp.where(causal, jnp.exp(jnp.where(causal, rel, 0.0)), 0.0)
        a = jnp.einsum('bqhd,bkhd,bqkhd->bhqk', qc, kc, dec)
        o = jnp.einsum('bhqk,bkhe->bqhe', a, vc) + jnp.einsum('bqhd,bhde->bqhe', qc * jnp.exp(cb), state)
        c_end = cb[:, -1]
        state = jnp.exp(c_end)[..., None] * state + jnp.einsum('bkhd,bkhe->bhde', kc * jnp.exp(c_end[:, None] - cb), vc)
        return state, o

    s0 = jnp.zeros((b, HG_HEADS, HG_DK, HG_DV), F32)
    _, o = lax.scan(step, s0, (to_chunks(q), to_chunks(k), to_chunks(v), to_chunks(log_f)))
    o = _rms(from_chunks(o)) * jax.nn.silu(gate)
    return o.reshape(b, -1, HG_V_W)


def diff_attention(q, k, v, lam_p, subln_g, lambda_init, valid, pos):
    b, l = q.shape[:2]
    lp = lam_p.astype(F32)
    lam = jnp.exp(jnp.sum(lp[0] * lp[1])) - jnp.exp(jnp.sum(lp[2] * lp[3])) + lambda_init
    q = rope(q.reshape(b, l, 2 * DA_HEADS, DA_DH), pos).reshape(b, l, DA_HEADS, 2, DA_DH) * DA_DH ** -0.5
    k = rope(k.reshape(b, l, 2 * DA_HEADS, DA_DH), pos).reshape(b, l, DA_HEADS, 2, DA_DH)
    n_blk = l // Q_BLOCK
    q_blocks = jnp.swapaxes(q.reshape(b, n_blk, Q_BLOCK, DA_HEADS, 2, DA_DH), 0, 1)
    key_pos = jnp.arange(l)

    def block(args):
        qb, bi = args
        s = jnp.einsum('bqhmd,bkhmd->bhmqk', qb, k)
        q_pos = bi * Q_BLOCK + jnp.arange(Q_BLOCK)
        allowed = (key_pos[None, :] <= q_pos[:, None]) & valid[None, :]
        p = jax.nn.softmax(jnp.where(allowed, s, MASK_VALUE), axis=-1)
        w = p[:, :, 0] - lam * p[:, :, 1]
        return jnp.einsum('bhqk,bkhe->bqhe', w, v)

    o = lax.map(block, (q_blocks, jnp.arange(n_blk)))
    o = jnp.swapaxes(o, 0, 1).reshape(b, l, DA_HEADS, DA_DV)
    o = _rms(o) * subln_g.astype(F32) * (1.0 - lambda_init)
    return o.reshape(b, l, DA_V_W)


def mixer(hn, w_in, w_branch, w_out, lb, lam_p, subln_g, lambda_init, valid, pos):
    b, l, _ = hn.shape
    proj = (hn @ w_in).astype(F32)
    offs = [int(o) for o in np.cumsum(IN_SPLITS)[:-1]]
    rq, rk, rv, rg, hq, hf, hi, hg, dq, dk, dv, mg = jnp.split(proj, offs, axis=-1)
    o_ret = retention(rq.reshape(b, l, RET_HEADS, RET_DK), rk.reshape(b, l, RET_HEADS, RET_DK),
                      rv.reshape(b, l, RET_HEADS, RET_DV), rg.reshape(b, l, RET_HEADS, RET_DV), valid, pos)
    o_hg = hgrn2(hq.reshape(b, l, HG_HEADS, HG_DK), hf.reshape(b, l, HG_HEADS, HG_DK),
                 hi.reshape(b, l, HG_HEADS, HG_DV), hg.reshape(b, l, HG_HEADS, HG_DV), lb, valid)
    o_da = diff_attention(dq.reshape(b, l, DA_HEADS, 2, DA_DH), dk.reshape(b, l, DA_HEADS, 2, DA_DH),
                          dv.reshape(b, l, DA_HEADS, DA_DV), lam_p, subln_g, lambda_init, valid, pos)
    branches = jnp.stack([o_ret, o_hg, o_da], axis=2)
    y_b = jnp.einsum('blnc,ncd->blnd', branches, w_branch.astype(F32))
    gates = jax.nn.sigmoid(mg.reshape(b, l, N_BRANCH, D_MODEL))
    y = jnp.sum(gates * y_b, axis=2)
    return y.astype(hn.dtype) @ w_out


def conv_ffn(hn, w_ffn_in, conv_w, conv_b, w_ffn_out, valid):
    l = hn.shape[1]
    u = jnp.where(valid[None, :, None], hn @ w_ffn_in, 0.0)
    up = jnp.pad(u, ((0, 0), (CONV_W - 1, 0), (0, 0)))
    c = conv_b + sum(conv_w[j] * up[:, j:j + l] for j in range(CONV_W))
    gate, val = jnp.split(c, 2, axis=-1)
    return (jax.nn.silu(gate) * val) @ w_ffn_out


def setup_inputs(seed: int = 0) -> dict:
    key = jax.random.key(seed)
    ks = jax.random.split(key, 16)

    def nrm(k, shape, scale):
        return jax.random.normal(k, shape, F32) * scale

    return {
        'x': nrm(ks[0], (BATCH, SEQ, D_MODEL), 1.0),
        'meta': nrm(ks[1], (N_META, D_MODEL), 1.0),
        'norm_mix_g': 1.0 + nrm(ks[2], (DEPTH, D_MODEL), 0.02),
        'w_in': nrm(ks[3], (DEPTH, D_MODEL, IN_WIDTH), D_MODEL ** -0.5),
        'w_branch': nrm(ks[4], (DEPTH, N_BRANCH, BRANCH_WIDTH, D_MODEL), BRANCH_WIDTH ** -0.5),
        'w_out': nrm(ks[5], (DEPTH, D_MODEL, D_MODEL), D_MODEL ** -0.5),
        'hg_lb': nrm(ks[6], (DEPTH, HG_K_W), 0.1),
        'da_lambda': nrm(ks[7], (DEPTH, 4, DA_DH), 0.1),
        'da_subln_g': 1.0 + nrm(ks[8], (DEPTH, DA_DV), 0.02),
        'norm_ffn_g': 1.0 + nrm(ks[9], (DEPTH, D_MODEL), 0.02),
        'w_ffn_in': nrm(ks[10], (DEPTH, D_MODEL, 2 * D_FF), D_MODEL ** -0.5),
        'ffn_conv_w': nrm(ks[11], (DEPTH, CONV_W, 2 * D_FF), CONV_W ** -0.5),
        'ffn_conv_b': nrm(ks[12], (DEPTH, 2 * D_FF), 0.01),
        'w_ffn_out': nrm(ks[13], (DEPTH, D_FF, D_MODEL), D_FF ** -0.5),
        'norm_final_g': 1.0 + nrm(ks[14], (D_MODEL,), 0.02),
    }


def reference(x, meta, norm_mix_g, w_in, w_branch, w_out, hg_lb, da_lambda, da_subln_g,
              norm_ffn_g, w_ffn_in, ffn_conv_w, ffn_conv_b, w_ffn_out, norm_final_g):
    b, s, d = x.shape
    l = PAD + s
    h = jnp.concatenate([jnp.zeros((b, PAD - N_META, d), x.dtype),
                         jnp.broadcast_to(meta[None].astype(x.dtype), (b, N_META, d)), x], axis=1)
    t = jnp.arange(l)
    valid = t >= PAD - N_META
    pos = t - (PAD - N_META)
    lb_soft = jax.nn.softmax(hg_lb.astype(F32), axis=0)
    lbs = jnp.cumsum(lb_soft, axis=0) - lb_soft[0]
    for li in range(DEPTH):
        lambda_init = 0.8 - 0.6 * math.exp(-0.3 * li)
        h = h + mixer(rms_norm(h, norm_mix_g[li]), w_in[li], w_branch[li], w_out[li], lbs[li],
                      da_lambda[li], da_subln_g[li], lambda_init, valid, pos)
        h = h + conv_ffn(rms_norm(h, norm_ffn_g[li]), w_ffn_in[li], ffn_conv_w[li], ffn_conv_b[li],
                         w_ffn_out[li], valid)
    h = rms_norm(h, norm_final_g)
    return h[:, PAD:]
```

```cpp
#include <hip/hip_runtime.h>
#include <hip/hip_cooperative_groups.h>
#include <cstdio>
#include <cstdint>
namespace cg = cooperative_groups;

typedef unsigned short bf16_t;
typedef __attribute__((ext_vector_type(8))) short bf16x8;
typedef __attribute__((ext_vector_type(4))) short bf16x4;
typedef __attribute__((ext_vector_type(4))) float f32x4;
typedef __attribute__((ext_vector_type(4))) unsigned u32x4;

#define DEV __device__ __forceinline__
#define MFMA(a, b, c) __builtin_amdgcn_mfma_f32_16x16x32_bf16(a, b, c, 0, 0, 0)

constexpr int LT = 8320;
constexpr int NCH = 65;
constexpr int NTHR = 512;
constexpr int LDS_BYTES = 144 * 1024;
constexpr int INW = 13312;
constexpr int DFF = 2816;

constexpr size_t SZ_ACT = (size_t)LT * 1024 * 2;
constexpr size_t OFF_WIN = 0;
constexpr size_t OFF_WB = OFF_WIN + (size_t)INW * 1024 * 2;
constexpr size_t OFF_WO = OFF_WB + (size_t)3 * 1024 * 1024 * 2;
constexpr size_t OFF_WFI = OFF_WO + (size_t)1024 * 1024 * 2;
constexpr size_t OFF_WFO = OFF_WFI + (size_t)5632 * 1024 * 2;
constexpr size_t OFF_H = OFF_WFO + (size_t)1024 * 2816 * 2;
constexpr size_t OFF_HN = OFF_H + (size_t)2 * LT * 1024 * 4;
constexpr size_t OFF_R128 = OFF_HN + SZ_ACT;
constexpr size_t OFF_R64 = OFF_R128 + (size_t)LT * 64 * 8;
constexpr size_t OFF_CTR = OFF_R64 + (size_t)LT * 32 * 8;
constexpr size_t OFF_ARENA = OFF_CTR + 256;
constexpr size_t OFF_RQ = OFF_ARENA;
constexpr size_t OFF_RK = OFF_RQ + SZ_ACT / 2;
constexpr size_t OFF_RKT = OFF_RK + SZ_ACT / 2;
constexpr size_t OFF_RVT = OFF_RKT + SZ_ACT / 2;
constexpr size_t OFF_HQ = OFF_RVT + SZ_ACT;
constexpr size_t OFF_HK = OFF_HQ + SZ_ACT;
constexpr size_t OFF_HCB = OFF_HK + SZ_ACT;
constexpr size_t OFF_HKET = OFF_HCB + 2 * SZ_ACT;
constexpr size_t OFF_HVT = OFF_HKET + SZ_ACT;
constexpr size_t OFF_DQ = OFF_HVT + SZ_ACT;
constexpr size_t OFF_DK = OFF_DQ + SZ_ACT;
constexpr size_t OFF_DVT = OFF_DK + SZ_ACT;
constexpr size_t OFF_ORET = OFF_DVT + SZ_ACT;
constexpr size_t OFF_OHG = OFF_ORET + SZ_ACT;
constexpr size_t OFF_STR = OFF_OHG + SZ_ACT;
constexpr size_t OFF_STH = OFF_STR + SZ_ACT;
constexpr size_t OFF_HDEC = OFF_STH + SZ_ACT;
constexpr size_t OFF_END = OFF_HDEC + (size_t)65 * 1024 * 4;
constexpr size_t OFF_G = OFF_RQ;
constexpr size_t OFF_Y = OFF_HK;
constexpr size_t OFF_ODA = OFF_HKET;
constexpr size_t OFF_U = OFF_ARENA;
constexpr size_t OFF_GF = OFF_U + (size_t)LT * 5632 * 2;

struct Params {
  const float* in[15];
  float* out;
  unsigned char* ws;
};

DEV int get_tid() { int t = threadIdx.x; asm volatile("" : "+v"(t)); return t; }
DEV int get_bid() { int b = blockIdx.x; asm volatile("" : "+s"(b)); return b; }
DEV bf16_t f2bf(float f) {
  unsigned u = __float_as_uint(f);
  u += 0x7fffu + ((u >> 16) & 1u);
  return (bf16_t)(u >> 16);
}
DEV float bf2f(bf16_t h) { return __uint_as_float(((unsigned)h) << 16); }
DEV unsigned pack2(float a, float b) { return (unsigned)f2bf(a) | ((unsigned)f2bf(b) << 16); }
DEV uint2 pack4(f32x4 v) { uint2 r; r.x = pack2(v[0], v[1]); r.y = pack2(v[2], v[3]); return r; }
DEV float silu_f(float x) { return x / (1.f + __expf(-x)); }
DEV float sigmoid_f(float x) { return 1.f / (1.f + __expf(-x)); }
DEV float ex2(float x) { return __builtin_amdgcn_exp2f(x); }
DEV bf16x8 ldfrag(const bf16_t* base, int stride, int row, int k) {
  return *(const bf16x8*)(base + row * stride + k);
}

template <int BN, bool TRANS>
DEV void gemm_compute(f32x4 (&acc)[2][BN / 32], const bf16_t* as, const bf16_t* bs) {
  constexpr int NJ = BN / 32, LS = 72;
#pragma unroll
  for (int ks = 0; ks < 2; ks++) {
    bf16x8 a0 = *(const bf16x8*)(as + ks * 32);
    bf16x8 a1 = *(const bf16x8*)(as + 16 * LS + ks * 32);
#pragma unroll
    for (int j = 0; j < NJ; j++) {
      bf16x8 bb = *(const bf16x8*)(bs + j * 16 * LS + ks * 32);
      if (TRANS) {
        acc[0][j] = MFMA(a0, bb, acc[0][j]);
        acc[1][j] = MFMA(a1, bb, acc[1][j]);
      } else {
        acc[0][j] = MFMA(bb, a0, acc[0][j]);
        acc[1][j] = MFMA(bb, a1, acc[1][j]);
      }
    }
  }
}

template <int BN, bool TRANS>
DEV void gemm_acc(f32x4 (&acc)[2][BN / 32], const bf16_t* __restrict__ A, int lda,
                  const bf16_t* __restrict__ Bt, int ldb, int K, bf16_t* lds) {
  constexpr int LS = 72, A_SZ = 128 * LS, B_SZ = BN * LS, NB = BN / 64;
  const int tid = get_tid(), lane = tid & 63, wave = tid >> 6, wm = wave >> 1, wn = wave & 1;
  const int lr = lane & 15, lg = lane >> 4;
  bf16_t* As = lds;
  bf16_t* Bs = lds + 2 * A_SZ;
  const int crow = tid >> 3, ckc = (tid & 7) * 8;
  const bf16_t* ga = A + (size_t)crow * lda + ckc;
  const bf16_t* gb = Bt + (size_t)crow * ldb + ckc;
  u32x4 ra0, ra1, rb0, rb1, rb2, rb3;
#define GLOAD(k0)                                                        \
  ra0 = *(const u32x4*)(ga + (k0));                                      \
  ra1 = *(const u32x4*)(ga + (size_t)64 * lda + (k0));                   \
  rb0 = *(const u32x4*)(gb + (k0));                                      \
  rb1 = *(const u32x4*)(gb + (size_t)64 * ldb + (k0));                   \
  if (NB == 4) {                                                         \
    rb2 = *(const u32x4*)(gb + (size_t)128 * ldb + (k0));                \
    rb3 = *(const u32x4*)(gb + (size_t)192 * ldb + (k0));                \
  }
#define LSTORE(buf)                                                      \
  *(u32x4*)(As + (buf) * A_SZ + crow * LS + ckc) = ra0;                  \
  *(u32x4*)(As + (buf) * A_SZ + (crow + 64) * LS + ckc) = ra1;           \
  *(u32x4*)(Bs + (buf) * B_SZ + crow * LS + ckc) = rb0;                  \
  *(u32x4*)(Bs + (buf) * B_SZ + (crow + 64) * LS + ckc) = rb1;           \
  if (NB == 4) {                                                         \
    *(u32x4*)(Bs + (buf) * B_SZ + (crow + 128) * LS + ckc) = rb2;        \
    *(u32x4*)(Bs + (buf) * B_SZ + (crow + 192) * LS + ckc) = rb3;        \
  }
  GLOAD(0)
  __syncthreads();
  LSTORE(0)
  __syncthreads();
  const int nk = K / 64;
  const int aoff = (wm * 32 + lr) * LS + lg * 8;
  const int boff = (wn * (BN / 2) + lr) * LS + lg * 8;
  for (int kt = 0; kt < nk - 1; kt++) {
    const int cur = kt & 1;
    GLOAD((kt + 1) * 64)
    gemm_compute<BN, TRANS>(acc, As + cur * A_SZ + aoff, Bs + cur * B_SZ + boff);
    LSTORE(cur ^ 1)
    __syncthreads();
  }
  {
    const int cur = (nk - 1) & 1;
    gemm_compute<BN, TRANS>(acc, As + cur * A_SZ + aoff, Bs + cur * B_SZ + boff);
    __syncthreads();
  }
#undef GLOAD
#undef LSTORE
}

DEV void tconv_tile(const float* __restrict__ src, int K, int N, bf16_t* __restrict__ dst, int tk, int tn, float* tile) {
  const int tid = get_tid();
  const int r = tid >> 4, c4 = (tid & 15) * 4;
#pragma unroll
  for (int i = 0; i < 2; i++) {
    const int rr = r + i * 32;
    float4 v = *(const float4*)(src + (size_t)(tk * 64 + rr) * N + tn * 64 + c4);
    tile[rr * 65 + c4 + 0] = v.x; tile[rr * 65 + c4 + 1] = v.y; tile[rr * 65 + c4 + 2] = v.z; tile[rr * 65 + c4 + 3] = v.w;
  }
  __syncthreads();
  const int n = tid >> 3, k8 = (tid & 7) * 8;
  uint4 o;
  o.x = pack2(tile[(k8 + 0) * 65 + n], tile[(k8 + 1) * 65 + n]);
  o.y = pack2(tile[(k8 + 2) * 65 + n], tile[(k8 + 3) * 65 + n]);
  o.z = pack2(tile[(k8 + 4) * 65 + n], tile[(k8 + 5) * 65 + n]);
  o.w = pack2(tile[(k8 + 6) * 65 + n], tile[(k8 + 7) * 65 + n]);
  *(uint4*)(dst + (size_t)(tn * 64 + n) * K + tk * 64 + k8) = o;
  __syncthreads();
}

DEV void phase_convert(const Params& p, int layer, unsigned char* lds) {
  unsigned char* ws = p.ws;
  float* tile = (float*)lds;
  for (int item = get_bid(); item < 6464; item += gridDim.x) {
    const float* src; bf16_t* dst; int K, N, idx;
    if (item < 3328) { idx = item; src = p.in[3] + (size_t)layer * 1024 * INW; K = 1024; N = INW; dst = (bf16_t*)(ws + OFF_WIN); }
    else if (item < 3328 + 768) { idx = item - 3328; int br = idx >> 8; idx &= 255; src = p.in[4] + ((size_t)layer * 3 + br) * 1024 * 1024; K = 1024; N = 1024; dst = (bf16_t*)(ws + OFF_WB) + (size_t)br * 1024 * 1024; }
    else if (item < 3328 + 1024) { idx = item - 4096; src = p.in[5] + (size_t)layer * 1024 * 1024; K = 1024; N = 1024; dst = (bf16_t*)(ws + OFF_WO); }
    else if (item < 4352 + 1408) { idx = item - 4352; src = p.in[10] + (size_t)layer * 1024 * 5632; K = 1024; N = 5632; dst = (bf16_t*)(ws + OFF_WFI); }
    else { idx = item - 5760; src = p.in[13] + (size_t)layer * 2816 * 1024; K = 2816; N = 1024; dst = (bf16_t*)(ws + OFF_WFO); }
    const int ntn = N / 64;
    tconv_tile(src, K, N, dst, idx / ntn, idx % ntn, tile);
  }
}

DEV void phase_init(const Params& p) {
  unsigned char* ws = p.ws;
  float* H = (float*)(ws + OFF_H);
  const int gt = get_bid() * NTHR + get_tid(), gs = gridDim.x * NTHR;
  for (int idx = gt; idx < 2 * LT * 256; idx += gs) {
    const int row = idx >> 8, c4 = (idx & 255) * 4;
    const int b = row / LT, t = row - b * LT;
    float4 v;
    if (t < 112) v = make_float4(0.f, 0.f, 0.f, 0.f);
    else if (t < 128) v = *(const float4*)(p.in[1] + (size_t)(t - 112) * 1024 + c4);
    else v = *(const float4*)(p.in[0] + ((size_t)b * 8192 + (t - 128)) * 1024 + c4);
    *(float4*)(H + (size_t)row * 1024 + c4) = v;
  }
  float2* R128 = (float2*)(ws + OFF_R128);
  float2* R64 = (float2*)(ws + OFF_R64);
  for (int idx = gt; idx < LT * 96; idx += gs) {
    const int t = idx / 96, f = idx - t * 96;
    float inv;
    if (f < 64) inv = powf(10000.f, -(float)(2 * f) / 128.f);
    else inv = powf(10000.f, -(float)(2 * (f - 64)) / 64.f);
    const float ang = (float)(t - 112) * inv;
    const double ad = (double)ang;
    const double n = rint(ad * 0.15915494309189535);
    const float rr = (float)(ad - n * 6.283185307179586);
    float2 cs; cs.x = __cosf(rr); cs.y = __sinf(rr);
    if (f < 64) R128[(size_t)t * 64 + f] = cs; else R64[(size_t)t * 32 + (f - 64)] = cs;
  }
}

DEV void phase_norm(const float* __restrict__ Hb, const float* __restrict__ g, bf16_t* __restrict__ dst) {
  const int lane = get_tid() & 63, wave = get_tid() >> 6;
  for (int row = get_bid() * 8 + wave; row < LT; row += gridDim.x * 8) {
    const float* src = Hb + (size_t)row * 1024;
    float4 v[4]; float ss = 0.f;
#pragma unroll
    for (int k = 0; k < 4; k++) { v[k] = *(const float4*)(src + k * 256 + lane * 4); ss += v[k].x * v[k].x + v[k].y * v[k].y + v[k].z * v[k].z + v[k].w * v[k].w; }
#pragma unroll
    for (int o = 1; o < 64; o <<= 1) ss += __shfl_xor(ss, o);
    const float rs = rsqrtf(ss * (1.f / 1024.f) + 1e-6f);
#pragma unroll
    for (int k = 0; k < 4; k++) {
      float4 gg = *(const float4*)(g + k * 256 + lane * 4);
      uint2 o; o.x = pack2(v[k].x * rs * gg.x, v[k].y * rs * gg.y); o.y = pack2(v[k].z * rs * gg.z, v[k].w * rs * gg.w);
      *(uint2*)(dst + (size_t)row * 1024 + k * 256 + lane * 4) = o;
    }
  }
}

DEV void phase_final(const Params& p) {
  const float* H = (const float*)(p.ws + OFF_H);
  const float* g = p.in[14];
  const int lane = get_tid() & 63, wave = get_tid() >> 6;
  for (int row = get_bid() * 8 + wave; row < 2 * 8192; row += gridDim.x * 8) {
    const int b = row >> 13, s = row & 8191;
    const float* src = H + ((size_t)b * LT + 128 + s) * 1024;
    float4 v[4]; float ss = 0.f;
#pragma unroll
    for (int k = 0; k < 4; k++) { v[k] = *(const float4*)(src + k * 256 + lane * 4); ss += v[k].x * v[k].x + v[k].y * v[k].y + v[k].z * v[k].z + v[k].w * v[k].w; }
#pragma unroll
    for (int o = 1; o < 64; o <<= 1) ss += __shfl_xor(ss, o);
    const float rs = rsqrtf(ss * (1.f / 1024.f) + 1e-6f);
#pragma unroll
    for (int k = 0; k < 4; k++) {
      float4 gg = *(const float4*)(g + k * 256 + lane * 4);
      float4 o = make_float4(v[k].x * rs * gg.x, v[k].y * rs * gg.y, v[k].z * rs * gg.z, v[k].w * rs * gg.w);
      *(float4*)(p.out + (size_t)row * 1024 + k * 256 + lane * 4) = o;
    }
  }
}

DEV void phase_projA(const Params& p, int layer, unsigned char* ldsraw) {
  unsigned char* ws = p.ws;
  bf16_t* lds = (bf16_t*)ldsraw;
  const bf16_t* HN = (const bf16_t*)(ws + OFF_HN);
  const bf16_t* WIN = (const bf16_t*)(ws + OFF_WIN);
  const float2* R128 = (const float2*)(ws + OFF_R128);
  const float2* R64 = (const float2*)(ws + OFF_R64);
  for (int item = get_bid(); item < 65 * 32; item += gridDim.x) {
    const int nt = item / 65, mt = item - nt * 65;
    int n0, seg, segstart;
    if (nt < 8) { n0 = nt * 256; seg = nt < 2 ? 0 : (nt < 4 ? 1 : 2); segstart = seg == 0 ? 0 : (seg == 1 ? 512 : 1024); }
    else if (nt < 20) { n0 = 3072 + (nt - 8) * 256; seg = 3 + (nt - 8) / 4; segstart = 3072 + (seg - 3) * 1024; }
    else { n0 = 7168 + (nt - 20) * 256; seg = 6 + (nt - 20) / 4; segstart = 7168 + (seg - 6) * 1024; }
    const bf16_t* A = HN + (size_t)mt * 128 * 1024;
    const bf16_t* Bt = WIN + (size_t)n0 * 1024;
    f32x4 acc[2][8];
#pragma unroll
    for (int i = 0; i < 2; i++)
#pragma unroll
      for (int j = 0; j < 8; j++) acc[i][j] = (f32x4){0.f, 0.f, 0.f, 0.f};
    if (seg == 0 || seg == 3 || seg == 6 || seg == 7) {
      gemm_acc<256, false>(acc, A, 1024, Bt, 1024, 1024, lds);
      const int tid = get_tid(), lane = tid & 63, wave = tid >> 6, wm = wave >> 1, wn = wave & 1; const int lr = lane & 15, lg = lane >> 4; (void)tid; (void)lane; (void)wm; (void)wn; (void)lr; (void)lg;
      const int cw = (n0 - segstart) + wn * 128;
      bf16_t* dstb; int ld;
      if (seg == 0) { dstb = (bf16_t*)(ws + OFF_RQ); ld = 512; }
      else if (seg == 3) { dstb = (bf16_t*)(ws + OFF_HQ); ld = 1024; }
      else if (seg == 6) { dstb = (bf16_t*)(ws + OFF_DQ); ld = 1024; }
      else { dstb = (bf16_t*)(ws + OFF_DK); ld = 1024; }
#pragma unroll
      for (int i = 0; i < 2; i++) {
        const int t = mt * 128 + wm * 32 + i * 16 + lr;
        if (seg == 0) {
          const float2* tab = R128 + (size_t)t * 64;
#pragma unroll
          for (int j = 0; j < 4; j++)
#pragma unroll
            for (int r = 0; r < 4; r++) {
              float2 cs = tab[j * 16 + lg * 4 + r];
              float x1 = acc[i][j][r], x2 = acc[i][j + 4][r];
              acc[i][j][r] = x1 * cs.x - x2 * cs.y;
              acc[i][j + 4][r] = x2 * cs.x + x1 * cs.y;
            }
        } else if (seg == 6 || seg == 7) {
          const float2* tab = R64 + (size_t)t * 32;
          const float sc = (seg == 6) ? (0.125f * 1.4426950408889634f) : 1.f;
#pragma unroll
          for (int jq = 0; jq < 4; jq++) {
            const int j = (jq & 1) + (jq >> 1) * 4;
#pragma unroll
            for (int r = 0; r < 4; r++) {
              float2 cs = tab[(jq & 1) * 16 + lg * 4 + r];
              float x1 = acc[i][j][r], x2 = acc[i][j + 2][r];
              acc[i][j][r] = (x1 * cs.x - x2 * cs.y) * sc;
              acc[i][j + 2][r] = (x2 * cs.x + x1 * cs.y) * sc;
            }
          }
        }
        bf16_t* dst = dstb + (size_t)t * ld + cw;
#pragma unroll
        for (int j = 0; j < 8; j++) *(uint2*)(dst + j * 16 + lg * 4) = pack4(acc[i][j]);
      }
    } else {
      gemm_acc<256, true>(acc, A, 1024, Bt, 1024, 1024, lds);
      const int tid = get_tid(), lane = tid & 63, wave = tid >> 6, wm = wave >> 1, wn = wave & 1; const int lr = lane & 15, lg = lane >> 4; (void)tid; (void)lane; (void)wm; (void)wn; (void)lr; (void)lg;
      const int cw = (n0 - segstart) + wn * 128;
      if (seg == 1) {
        bf16_t* RK = (bf16_t*)(ws + OFF_RK);
        bf16_t* RKT = (bf16_t*)(ws + OFF_RKT);
        const int h = cw >> 7;
        const float l2g = log2f(1.f - ex2(-5.f - (float)h));
#pragma unroll
        for (int i = 0; i < 2; i++) {
          const int mb = wm * 32 + i * 16 + lg * 4;
#pragma unroll
          for (int j = 0; j < 4; j++)
#pragma unroll
            for (int r = 0; r < 4; r++) {
              const int t = mt * 128 + mb + r;
              float2 cs = R128[(size_t)t * 64 + j * 16 + lr];
              const float sc = (t >= 112) ? 0.08838834764831845f : 0.f;
              float x1 = acc[i][j][r], x2 = acc[i][j + 4][r];
              acc[i][j][r] = (x1 * cs.x - x2 * cs.y) * sc;
              acc[i][j + 4][r] = (x2 * cs.x + x1 * cs.y) * sc;
            }
#pragma unroll
          for (int j = 0; j < 8; j++) {
            const int col = cw + j * 16 + lr;
            f32x4 kd;
#pragma unroll
            for (int r = 0; r < 4; r++) {
              const int t = mt * 128 + mb + r;
              RK[(size_t)t * 512 + col] = f2bf(acc[i][j][r]);
              kd[r] = acc[i][j][r] * ex2(l2g * (float)(127 - (mb + r)));
            }
            *(uint2*)(RKT + (size_t)col * LT + mt * 128 + mb) = pack4(kd);
          }
        }
      } else if (seg == 2 || seg == 5 || seg == 8) {
        bf16_t* dT = (bf16_t*)(ws + (seg == 2 ? OFF_RVT : (seg == 5 ? OFF_HVT : OFF_DVT)));
#pragma unroll
        for (int i = 0; i < 2; i++) {
          const int mb = wm * 32 + i * 16 + lg * 4;
#pragma unroll
          for (int j = 0; j < 8; j++) {
            const int col = cw + j * 16 + lr;
            f32x4 v = acc[i][j];
            if (seg == 5) {
#pragma unroll
              for (int r = 0; r < 4; r++) if (mt * 128 + mb + r < 112) v[r] = 0.f;
            }
            *(uint2*)(dT + (size_t)col * LT + mt * 128 + mb) = pack4(v);
          }
        }
      } else {
        float* Lf = (float*)ldsraw;
        float* HCB = (float*)(ws + OFF_HCB);
        bf16_t* HK = (bf16_t*)(ws + OFF_HK);
        bf16_t* HKET = (bf16_t*)(ws + OFF_HKET);
        float* HDEC = (float*)(ws + OFF_HDEC);
        const float* lbp = p.in[6];
#pragma unroll
        for (int j = 0; j < 8; j++) {
          const int col = cw + j * 16 + lr;
          float lb = 0.f;
          if (layer == 1) lb = 1.f / (1.f + __expf(lbp[col] - lbp[1024 + col]));
#pragma unroll
          for (int i = 0; i < 2; i++)
#pragma unroll
            for (int r = 0; r < 4; r++) {
              const int m = wm * 32 + i * 16 + lg * 4 + r;
              const float z = acc[i][j][r];
              const float kk = (1.f - lb) / (1.f + __expf(z));
              const float lf = fmaxf(log1pf(-kk), -69.0776f);
              acc[i][j][r] = kk;
              Lf[m * 260 + wn * 128 + j * 16 + lr] = lf;
            }
        }
        __syncthreads();
        {
          const int colL = tid & 255, half = tid >> 8;
          float run = 0.f;
          for (int rr = 0; rr < 64; rr++) {
            float* q = &Lf[(half * 64 + rr) * 260 + colL];
            run += *q; *q = run;
          }
        }
        __syncthreads();
#pragma unroll
        for (int j = 0; j < 8; j++) {
          const int colL = wn * 128 + j * 16 + lr;
          const int col = cw + j * 16 + lr;
          const float ft = Lf[63 * 260 + colL];
          const float cend = Lf[127 * 260 + colL] + ft;
#pragma unroll
          for (int i = 0; i < 2; i++) {
            const int mb = wm * 32 + i * 16 + lg * 4;
            f32x4 ke;
#pragma unroll
            for (int r = 0; r < 4; r++) {
              const int m = mb + r;
              const int t = mt * 128 + m;
              const float cb = Lf[m * 260 + colL] + (m >= 64 ? ft : 0.f);
              HCB[(size_t)t * 1024 + col] = cb;
              HK[(size_t)t * 1024 + col] = f2bf(acc[i][j][r]);
              ke[r] = acc[i][j][r] * __expf(cend - cb);
              if (m == 127) HDEC[mt * 1024 + col] = __expf(cend);
            }
            *(uint2*)(HKET + (size_t)col * LT + mt * 128 + mb) = pack4(ke);
          }
        }
        __syncthreads();
      }
    }
  }
}

DEV void phase_U(const Params& p, unsigned char* ldsraw) {
  unsigned char* ws = p.ws;
  bf16_t* lds = (bf16_t*)ldsraw;
  for (int item = get_bid(); item < 1040; item += gridDim.x) {
    const bf16_t *A, *Bt; bf16_t* dst;
    if (item < 520) {
      const int h = item & 3, rest = item >> 2, mh = rest & 1, c = rest >> 1;
      A = (const bf16_t*)(ws + OFF_RVT) + (size_t)(h * 256 + mh * 128) * LT + c * 128;
      Bt = (const bf16_t*)(ws + OFF_RKT) + (size_t)(h * 128) * LT + c * 128;
      dst = (bf16_t*)(ws + OFF_STR) + ((size_t)(h * 65 + c) * 256 + mh * 128) * 128;
    } else {
      const int it = item - 520, h = it & 7, c = it >> 3;
      A = (const bf16_t*)(ws + OFF_HVT) + (size_t)(h * 128) * LT + c * 128;
      Bt = (const bf16_t*)(ws + OFF_HKET) + (size_t)(h * 128) * LT + c * 128;
      dst = (bf16_t*)(ws + OFF_STH) + ((size_t)(h * 65 + c) * 128) * 128;
    }
    f32x4 acc[2][4];
#pragma unroll
    for (int i = 0; i < 2; i++)
#pragma unroll
      for (int j = 0; j < 4; j++) acc[i][j] = (f32x4){0.f, 0.f, 0.f, 0.f};
    gemm_acc<128, false>(acc, A, LT, Bt, LT, 128, lds);
      const int tid = get_tid(), lane = tid & 63, wave = tid >> 6, wm = wave >> 1, wn = wave & 1; const int lr = lane & 15, lg = lane >> 4; (void)tid; (void)lane; (void)wm; (void)wn; (void)lr; (void)lg;
#pragma unroll
    for (int i = 0; i < 2; i++)
#pragma unroll
      for (int j = 0; j < 4; j++)
        *(uint2*)(dst + (size_t)(wm * 32 + i * 16 + lr) * 128 + wn * 64 + j * 16 + lg * 4) = pack4(acc[i][j]);
  }
}

DEV void phase_scan(const Params& p) {
  unsigned char* ws = p.ws;
  const float* HDEC = (const float*)(ws + OFF_HDEC);
  for (int task = get_bid() * NTHR + get_tid(); task < 65536; task += gridDim.x * NTHR) {
    bf16_t* base; size_t stride; int h, d4; bool hg;
    float dec0 = 0.f;
    if (task < 32768) {
      const int v = task; d4 = (v & 31) * 4; const int e = (v >> 5) & 255; h = v >> 13; hg = false;
      base = (bf16_t*)(ws + OFF_STR) + ((size_t)(h * 65) * 256 + e) * 128 + d4; stride = 256 * 128;
      dec0 = ex2(128.f * log2f(1.f - ex2(-5.f - (float)h)));
    } else {
      const int v = task - 32768; d4 = (v & 31) * 4; const int e = (v >> 5) & 127; h = v >> 12; hg = true;
      base = (bf16_t*)(ws + OFF_STH) + ((size_t)(h * 65) * 128 + e) * 128 + d4; stride = 128 * 128;
    }
    float c0 = 0.f, c1 = 0.f, c2 = 0.f, c3 = 0.f;
    for (int cg0 = 0; cg0 < 65; cg0 += 5) {
      uint2 u[5]; float4 dc[5];
#pragma unroll
      for (int k = 0; k < 5; k++) {
        u[k] = *(const uint2*)(base + (size_t)(cg0 + k) * stride);
        if (hg) dc[k] = *(const float4*)(HDEC + (size_t)(cg0 + k) * 1024 + h * 128 + d4);
        else dc[k] = make_float4(dec0, dec0, dec0, dec0);
      }
#pragma unroll
      for (int k = 0; k < 5; k++) {
        uint2 o; o.x = pack2(c0, c1); o.y = pack2(c2, c3);
        *(uint2*)(base + (size_t)(cg0 + k) * stride) = o;
        c0 = dc[k].x * c0 + bf2f((bf16_t)(u[k].x & 0xffff));
        c1 = dc[k].y * c1 + bf2f((bf16_t)(u[k].x >> 16));
        c2 = dc[k].z * c2 + bf2f((bf16_t)(u[k].y & 0xffff));
        c3 = dc[k].w * c3 + bf2f((bf16_t)(u[k].y >> 16));
      }
    }
  }
}

template <int MP>
DEV void attn_pass(const bf16_t* __restrict__ DK, const bf16_t* __restrict__ DVT, int h, int qb, int qrow,
                   bf16_t* Ks, bf16_t* Vs, const bf16_t* Qs, f32x4 (&o)[8], int tid) {
  constexpr int PS = 136, PK = 72;
  const int lane = tid & 63, wave = tid >> 6, lr = lane & 15, lg = lane >> 4;
#pragma unroll
  for (int j = 0; j < 8; j++) o[j] = (f32x4){0.f, 0.f, 0.f, 0.f};
  float mrun = -1e30f, lrun = 0.f;
  const int krow = tid >> 3, kc8 = (tid & 7) * 8;
  const int vrow = tid >> 4, vc8 = (tid & 15) * 8;
  const bf16_t* gk = DK + (size_t)krow * 1024 + h * 128 + MP * 64 + kc8;
  const bf16_t* gv = DVT + (size_t)(h * 128 + vrow) * LT + vc8;
  u32x4 rk0, rk1, rv0, rv1, rv2, rv3;
#define ALOAD(kbn)                                                              \
  rk0 = *(const u32x4*)(gk + (size_t)((kbn) * 128) * 1024);                     \
  rk1 = *(const u32x4*)(gk + (size_t)((kbn) * 128 + 64) * 1024);                \
  rv0 = *(const u32x4*)(gv + (kbn) * 128);                                      \
  rv1 = *(const u32x4*)(gv + (size_t)32 * LT + (kbn) * 128);                    \
  rv2 = *(const u32x4*)(gv + (size_t)64 * LT + (kbn) * 128);                    \
  rv3 = *(const u32x4*)(gv + (size_t)96 * LT + (kbn) * 128);
  ALOAD(0)
  for (int kb = 0; kb <= qb; kb++) {
    __syncthreads();
    *(u32x4*)(Ks + (krow) * PK + kc8) = rk0;
    *(u32x4*)(Ks + (krow + 64) * PK + kc8) = rk1;
    *(u32x4*)(Vs + (vrow) * PS + vc8) = rv0;
    *(u32x4*)(Vs + (vrow + 32) * PS + vc8) = rv1;
    *(u32x4*)(Vs + (vrow + 64) * PS + vc8) = rv2;
    *(u32x4*)(Vs + (vrow + 96) * PS + vc8) = rv3;
    __syncthreads();
    {
      const int kbn = (kb < qb) ? kb + 1 : qb;
      ALOAD(kbn)
    }
    f32x4 s[8];
    {
      const bf16x8 aq0 = ldfrag(Qs, PS, wave * 16 + lr, MP * 64 + lg * 8);
      const bf16x8 aq1 = ldfrag(Qs, PS, wave * 16 + lr, MP * 64 + 32 + lg * 8);
#pragma unroll
      for (int j = 0; j < 8; j++) {
        s[j] = (f32x4){0.f, 0.f, 0.f, 0.f};
        bf16x8 kf0 = *(const bf16x8*)(Ks + (j * 16 + lr) * PK + lg * 8);
        bf16x8 kf1 = *(const bf16x8*)(Ks + (j * 16 + lr) * PK + 32 + lg * 8);
        s[j] = MFMA(kf0, aq0, s[j]);
        s[j] = MFMA(kf1, aq1, s[j]);
      }
    }
    __builtin_amdgcn_sched_barrier(0);
    if (kb == qb || kb == 0) {
#pragma unroll
      for (int j = 0; j < 8; j++)
#pragma unroll
        for (int r = 0; r < 4; r++) {
          const int key = kb * 128 + j * 16 + lg * 4 + r;
          if (key > qrow || key < 112) s[j][r] = -1e30f;
        }
    }
    float mx = -1e30f;
#pragma unroll
    for (int j = 0; j < 8; j++)
#pragma unroll
      for (int r = 0; r < 4; r++) mx = fmaxf(mx, s[j][r]);
    mx = fmaxf(mx, __shfl_xor(mx, 16));
    mx = fmaxf(mx, __shfl_xor(mx, 32));
    const float mnew = fmaxf(mrun, mx);
    const float alpha = ex2(mrun - mnew);
    mrun = mnew;
    float ps = 0.f;
#pragma unroll
    for (int j = 0; j < 8; j++)
#pragma unroll
      for (int r = 0; r < 4; r++) { const float pv = ex2(s[j][r] - mnew); s[j][r] = pv; ps += pv; }
    lrun = lrun * alpha + ps;
    float ao[4];
#pragma unroll
    for (int r = 0; r < 4; r++) ao[r] = __shfl(alpha, lg * 4 + r);
#pragma unroll
    for (int je = 0; je < 8; je++)
#pragma unroll
      for (int r = 0; r < 4; r++) o[je][r] *= ao[r];
#pragma unroll
    for (int ks = 0; ks < 4; ks++) {
      union { u32x4 u; bf16x8 v; } pf;
      pf.u[0] = pack2(s[2 * ks][0], s[2 * ks][1]);
      pf.u[1] = pack2(s[2 * ks][2], s[2 * ks][3]);
      pf.u[2] = pack2(s[2 * ks + 1][0], s[2 * ks + 1][1]);
      pf.u[3] = pack2(s[2 * ks + 1][2], s[2 * ks + 1][3]);
#pragma unroll
      for (int je = 0; je < 8; je++) {
        const bf16_t* vp = Vs + (je * 16 + lr) * PS + ks * 32 + lg * 4;
        union { uint2 u[2]; bf16x8 v; } vf;
        vf.u[0] = *(const uint2*)vp;
        vf.u[1] = *(const uint2*)(vp + 16);
        o[je] = MFMA(pf.v, vf.v, o[je]);
      }
    }
    __builtin_amdgcn_sched_barrier(0);
  }
#undef ALOAD
  float l = lrun;
  l += __shfl_xor(l, 16);
  l += __shfl_xor(l, 32);
  const float inv = l > 0.f ? 1.f / l : 0.f;
#pragma unroll
  for (int r = 0; r < 4; r++) {
    const float ir = __shfl(inv, lg * 4 + r);
#pragma unroll
    for (int je = 0; je < 8; je++) o[je][r] *= ir;
  }
}

DEV void attn_item(const Params& p, int layer, int h, int qb, float lam, bf16_t* lds) {
  unsigned char* ws = p.ws;
  const bf16_t* DQ = (const bf16_t*)(ws + OFF_DQ);
  bf16_t* ODA = (bf16_t*)(ws + OFF_ODA);
  const bf16_t* DK = (const bf16_t*)(ws + OFF_DK);
  const bf16_t* DVT = (const bf16_t*)(ws + OFF_DVT);
  constexpr int PS = 136;
  bf16_t* Ks = lds;
  bf16_t* Vs = lds + 128 * PS;
  bf16_t* Qs = lds + 2 * 128 * PS;
  const int tid = get_tid(), lane = tid & 63, wave = tid >> 6;
  const int lr = lane & 15, lg = lane >> 4;
  const int t0 = qb * 128;
  const int qrow = t0 + wave * 16 + lr;
  {
    const int qr = tid >> 4, qc = (tid & 15) * 8;
#pragma unroll
    for (int i = 0; i < 4; i++)
      *(u32x4*)(Qs + (qr + i * 32) * PS + qc) = *(const u32x4*)(DQ + (size_t)(t0 + qr + i * 32) * 1024 + h * 128 + qc);
  }
  f32x4 o0[8], o1[8];
  attn_pass<0>(DK, DVT, h, qb, qrow, Ks, Vs, Qs, o0, tid);
  attn_pass<1>(DK, DVT, h, qb, qrow, Ks, Vs, Qs, o1, tid);
  int ly = layer; asm volatile("" : "+s"(ly));
  const float li = (ly == 0) ? 0.2f : 0.35550906759f;
  const float* sg = p.in[8] + ly * 128;
  float ss[4] = {0.f, 0.f, 0.f, 0.f};
#pragma unroll
  for (int je = 0; je < 8; je++)
#pragma unroll
    for (int r = 0; r < 4; r++) {
      const float v = o0[je][r] - lam * o1[je][r];
      o0[je][r] = v; ss[r] += v * v;
    }
#pragma unroll
  for (int r = 0; r < 4; r++) {
    float s2 = ss[r];
    s2 += __shfl_xor(s2, 1); s2 += __shfl_xor(s2, 2); s2 += __shfl_xor(s2, 4); s2 += __shfl_xor(s2, 8);
    ss[r] = rsqrtf(s2 * (1.f / 128.f) + 1e-6f) * (1.f - li);
  }
#pragma unroll
  for (int je = 0; je < 8; je++) {
    const float g = sg[je * 16 + lr];
#pragma unroll
    for (int r = 0; r < 4; r++)
      ODA[(size_t)(t0 + wave * 16 + lg * 4 + r) * 1024 + h * 128 + je * 16 + lr] = f2bf(o0[je][r] * ss[r] * g);
  }
}

DEV void ret_item(const Params& p, int h, int c, bf16_t* lds) {
  unsigned char* ws = p.ws;
  const bf16_t* RQ = (const bf16_t*)(ws + OFF_RQ);
  const bf16_t* RK = (const bf16_t*)(ws + OFF_RK);
  const bf16_t* RVT = (const bf16_t*)(ws + OFF_RVT);
  const bf16_t* STR = (const bf16_t*)(ws + OFF_STR);
  bf16_t* ORET = (bf16_t*)(ws + OFF_ORET);
  constexpr int PS = 136;
  bf16_t* Qs = lds;
  bf16_t* Ks = lds + 128 * PS;
  bf16_t* Big = lds + 2 * 128 * PS;
  float* RED = (float*)(lds + 2 * 128 * PS + 256 * PS);
  const int tid = get_tid(), lane = tid & 63, wave = tid >> 6, wm = wave >> 1, wn = wave & 1;
  const int lr = lane & 15, lg = lane >> 4;
  const int t0 = c * 128;
  const int lrow = tid >> 4, lc8 = (tid & 15) * 8;
  const float l2g = log2f(1.f - ex2(-5.f - (float)h));
#pragma unroll
  for (int i = 0; i < 4; i++) {
    const int row = lrow + i * 32;
    *(uint4*)(Qs + row * PS + lc8) = *(const uint4*)(RQ + (size_t)(t0 + row) * 512 + h * 128 + lc8);
    *(uint4*)(Ks + row * PS + lc8) = *(const uint4*)(RK + (size_t)(t0 + row) * 512 + h * 128 + lc8);
  }
#pragma unroll
  for (int i = 0; i < 8; i++) {
    const int row = lrow + i * 32;
    *(uint4*)(Big + row * PS + lc8) = *(const uint4*)(STR + ((size_t)(h * 65 + c) * 256 + row) * 128 + lc8);
  }
  __syncthreads();
  f32x4 s[2][4];
  f32x4 o[2][8];
#pragma unroll
  for (int i = 0; i < 2; i++) {
#pragma unroll
    for (int j = 0; j < 4; j++) s[i][j] = (f32x4){0.f, 0.f, 0.f, 0.f};
#pragma unroll
    for (int j = 0; j < 8; j++) o[i][j] = (f32x4){0.f, 0.f, 0.f, 0.f};
  }
#pragma unroll
  for (int ks = 0; ks < 4; ks++) {
    bf16x8 a0 = ldfrag(Qs, PS, wm * 32 + lr, ks * 32 + lg * 8);
    bf16x8 a1 = ldfrag(Qs, PS, wm * 32 + 16 + lr, ks * 32 + lg * 8);
#pragma unroll
    for (int j = 0; j < 4; j++) {
      bf16x8 bb = ldfrag(Ks, PS, wn * 64 + j * 16 + lr, ks * 32 + lg * 8);
      s[0][j] = MFMA(bb, a0, s[0][j]);
      s[1][j] = MFMA(bb, a1, s[1][j]);
    }
#pragma unroll
    for (int j = 0; j < 8; j++) {
      bf16x8 bb = ldfrag(Big, PS, wn * 128 + j * 16 + lr, ks * 32 + lg * 8);
      o[0][j] = MFMA(bb, a0, o[0][j]);
      o[1][j] = MFMA(bb, a1, o[1][j]);
    }
    __builtin_amdgcn_sched_barrier(0);
  }
#pragma unroll
  for (int i = 0; i < 2; i++) {
    const int q = wm * 32 + i * 16 + lr;
    const float qd = ex2(l2g * (float)(q + 1));
#pragma unroll
    for (int j = 0; j < 8; j++)
#pragma unroll
      for (int r = 0; r < 4; r++) o[i][j][r] *= qd;
  }
  __syncthreads();
#pragma unroll
  for (int i = 0; i < 2; i++) {
    const int q = wm * 32 + i * 16 + lr;
#pragma unroll
    for (int j = 0; j < 4; j++) {
      f32x4 v;
#pragma unroll
      for (int r = 0; r < 4; r++) {
        const int key = wn * 64 + j * 16 + lg * 4 + r;
        v[r] = (key <= q) ? s[i][j][r] * ex2(l2g * (float)(q - key)) : 0.f;
      }
      *(uint2*)(Ks + q * PS + wn * 64 + j * 16 + lg * 4) = pack4(v);
    }
  }
#pragma unroll
  for (int i = 0; i < 8; i++) {
    const int row = lrow + i * 32;
    *(uint4*)(Big + row * PS + lc8) = *(const uint4*)(RVT + (size_t)(h * 256 + row) * LT + t0 + lc8);
  }
  __syncthreads();
#pragma unroll
  for (int ks = 0; ks < 4; ks++) {
    bf16x8 a0 = ldfrag(Ks, PS, wm * 32 + lr, ks * 32 + lg * 8);
    bf16x8 a1 = ldfrag(Ks, PS, wm * 32 + 16 + lr, ks * 32 + lg * 8);
#pragma unroll
    for (int j = 0; j < 8; j++) {
      bf16x8 bb = ldfrag(Big, PS, wn * 128 + j * 16 + lr, ks * 32 + lg * 8);
      o[0][j] = MFMA(bb, a0, o[0][j]);
      o[1][j] = MFMA(bb, a1, o[1][j]);
    }
    __builtin_amdgcn_sched_barrier(0);
  }
#pragma unroll
  for (int i = 0; i < 2; i++) {
    float ss = 0.f;
#pragma unroll
    for (int j = 0; j < 8; j++)
#pragma unroll
      for (int r = 0; r < 4; r++) ss += o[i][j][r] * o[i][j][r];
    ss += __shfl_xor(ss, 16);
    ss += __shfl_xor(ss, 32);
    if (lg == 0) RED[(wm * 32 + i * 16 + lr) * 2 + wn] = ss;
  }
  __syncthreads();
#pragma unroll
  for (int i = 0; i < 2; i++) {
    const int q = wm * 32 + i * 16 + lr;
    const float rs = rsqrtf((RED[q * 2] + RED[q * 2 + 1]) * (1.f / 256.f) + 1e-6f);
#pragma unroll
    for (int j = 0; j < 8; j++) {
      f32x4 v = o[i][j];
#pragma unroll
      for (int r = 0; r < 4; r++) v[r] *= rs;
      *(uint2*)(ORET + (size_t)(t0 + q) * 1024 + h * 256 + wn * 128 + j * 16 + lg * 4) = pack4(v);
    }
  }
}

DEV void hg_item(const Params& p, int h, int c, bf16_t* lds) {
  unsigned char* ws = p.ws;
  const bf16_t* HQ = (const bf16_t*)(ws + OFF_HQ);
  const bf16_t* HK = (const bf16_t*)(ws + OFF_HK);
  const float* HCB = (const float*)(ws + OFF_HCB);
  const bf16_t* HVT = (const bf16_t*)(ws + OFF_HVT);
  const bf16_t* STH = (const bf16_t*)(ws + OFF_STH);
  bf16_t* OHG = (bf16_t*)(ws + OFF_OHG);
  constexpr int PS = 136;
  bf16_t* Qp = lds;
  bf16_t* Kp = lds + 128 * PS;
  bf16_t* As = lds + 2 * 128 * PS;
  float* RED = (float*)(lds + 2 * 128 * PS + 256 * PS);
  const int tid = get_tid(), lane = tid & 63, wave = tid >> 6, wm = wave >> 1, wn = wave & 1;
  const int lr = lane & 15, lg = lane >> 4;
  const int t0 = c * 128, colb = h * 128;
  const int lrow = tid >> 4, lc8 = (tid & 15) * 8;
#pragma unroll
  for (int i = 0; i < 4; i++) {
    const int row = lrow + i * 32;
    const size_t g = (size_t)(t0 + row) * 1024 + colb + lc8;
    uint4 qv = *(const uint4*)(HQ + g);
    float4 c0 = *(const float4*)(HCB + g), c1 = *(const float4*)(HCB + g + 4);
    float4 r0 = make_float4(0.f, 0.f, 0.f, 0.f), r1 = r0;
    if (row >= 32) {
      const size_t gr = (size_t)(t0 + (row & ~31) - 1) * 1024 + colb + lc8;
      r0 = *(const float4*)(HCB + gr); r1 = *(const float4*)(HCB + gr + 4);
    }
    uint4 ov;
    ov.x = pack2(bf2f((bf16_t)(qv.x & 0xffff)) * __expf(c0.x - r0.x), bf2f((bf16_t)(qv.x >> 16)) * __expf(c0.y - r0.y));
    ov.y = pack2(bf2f((bf16_t)(qv.y & 0xffff)) * __expf(c0.z - r0.z), bf2f((bf16_t)(qv.y >> 16)) * __expf(c0.w - r0.w));
    ov.z = pack2(bf2f((bf16_t)(qv.z & 0xffff)) * __expf(c1.x - r1.x), bf2f((bf16_t)(qv.z >> 16)) * __expf(c1.y - r1.y));
    ov.w = pack2(bf2f((bf16_t)(qv.w & 0xffff)) * __expf(c1.z - r1.z), bf2f((bf16_t)(qv.w >> 16)) * __expf(c1.w - r1.w));
    *(uint4*)(Qp + row * PS + lc8) = ov;
  }
  for (int I = 0; I < 4; I++) {
    const int nrows = 32 * (I + 1);
    float4 r0 = make_float4(0.f, 0.f, 0.f, 0.f), r1 = r0;
    if (I > 0) {
      const size_t gr = (size_t)(t0 + 32 * I - 1) * 1024 + colb + lc8;
      r0 = *(const float4*)(HCB + gr); r1 = *(const float4*)(HCB + gr + 4);
    }
#pragma unroll
    for (int i = 0; i < 4; i++) {
      const int row = lrow + i * 32;
      if (row < nrows) {
        const size_t g = (size_t)(t0 + row) * 1024 + colb + lc8;
        uint4 kv = *(const uint4*)(HK + g);
        float4 c0 = *(const float4*)(HCB + g), c1 = *(const float4*)(HCB + g + 4);
        uint4 ov;
        ov.x = pack2(bf2f((bf16_t)(kv.x & 0xffff)) * __expf(fminf(r0.x - c0.x, 80.f)), bf2f((bf16_t)(kv.x >> 16)) * __expf(fminf(r0.y - c0.y, 80.f)));
        ov.y = pack2(bf2f((bf16_t)(kv.y & 0xffff)) * __expf(fminf(r0.z - c0.z, 80.f)), bf2f((bf16_t)(kv.y >> 16)) * __expf(fminf(r0.w - c0.w, 80.f)));
        ov.z = pack2(bf2f((bf16_t)(kv.z & 0xffff)) * __expf(fminf(r1.x - c1.x, 80.f)), bf2f((bf16_t)(kv.z >> 16)) * __expf(fminf(r1.y - c1.y, 80.f)));
        ov.w = pack2(bf2f((bf16_t)(kv.w & 0xffff)) * __expf(fminf(r1.z - c1.z, 80.f)), bf2f((bf16_t)(kv.w >> 16)) * __expf(fminf(r1.w - c1.w, 80.f)));
        *(uint4*)(Kp + row * PS + lc8) = ov;
      }
    }
    __syncthreads();
    if (wave * 16 < nrows) {
      f32x4 a2[2];
      a2[0] = (f32x4){0.f, 0.f, 0.f, 0.f}; a2[1] = a2[0];
#pragma unroll
      for (int ks = 0; ks < 4; ks++) {
        bf16x8 bb = ldfrag(Kp, PS, wave * 16 + lr, ks * 32 + lg * 8);
        bf16x8 a0 = ldfrag(Qp, PS, 32 * I + lr, ks * 32 + lg * 8);
        bf16x8 a1 = ldfrag(Qp, PS, 32 * I + 16 + lr, ks * 32 + lg * 8);
        a2[0] = MFMA(bb, a0, a2[0]);
        a2[1] = MFMA(bb, a1, a2[1]);
      }
#pragma unroll
      for (int i = 0; i < 2; i++) {
        const int q = 32 * I + i * 16 + lr;
        f32x4 v;
#pragma unroll
        for (int r = 0; r < 4; r++) { const int key = wave * 16 + lg * 4 + r; v[r] = (key <= q) ? a2[i][r] : 0.f; }
        *(uint2*)(As + q * PS + wave * 16 + lg * 4) = pack4(v);
      }
    } else {
#pragma unroll
      for (int i = 0; i < 2; i++) {
        const int q = 32 * I + i * 16 + lr;
        *(uint2*)(As + q * PS + wave * 16 + lg * 4) = make_uint2(0u, 0u);
      }
    }
    __syncthreads();
  }
#pragma unroll
  for (int i = 0; i < 4; i++) {
    const int row = lrow + i * 32;
    *(uint4*)(Kp + row * PS + lc8) = *(const uint4*)(HVT + (size_t)(colb + row) * LT + t0 + lc8);
  }
  __syncthreads();
  f32x4 o[2][4];
#pragma unroll
  for (int i = 0; i < 2; i++)
#pragma unroll
    for (int j = 0; j < 4; j++) o[i][j] = (f32x4){0.f, 0.f, 0.f, 0.f};
#pragma unroll
  for (int ks = 0; ks < 4; ks++) {
    bf16x8 a0 = ldfrag(As, PS, wm * 32 + lr, ks * 32 + lg * 8);
    bf16x8 a1 = ldfrag(As, PS, wm * 32 + 16 + lr, ks * 32 + lg * 8);
#pragma unroll
    for (int j = 0; j < 4; j++) {
      bf16x8 bb = ldfrag(Kp, PS, wn * 64 + j * 16 + lr, ks * 32 + lg * 8);
      o[0][j] = MFMA(bb, a0, o[0][j]);
      o[1][j] = MFMA(bb, a1, o[1][j]);
    }
    __builtin_amdgcn_sched_barrier(0);
  }
  __syncthreads();
#pragma unroll
  for (int i = 0; i < 4; i++) {
    const int row = lrow + i * 32;
    const size_t g = (size_t)(t0 + row) * 1024 + colb + lc8;
    uint4 qv = *(const uint4*)(HQ + g);
    float4 c0 = *(const float4*)(HCB + g), c1 = *(const float4*)(HCB + g + 4);
    uint4 ov;
    ov.x = pack2(bf2f((bf16_t)(qv.x & 0xffff)) * __expf(c0.x), bf2f((bf16_t)(qv.x >> 16)) * __expf(c0.y));
    ov.y = pack2(bf2f((bf16_t)(qv.y & 0xffff)) * __expf(c0.z), bf2f((bf16_t)(qv.y >> 16)) * __expf(c0.w));
    ov.z = pack2(bf2f((bf16_t)(qv.z & 0xffff)) * __expf(c1.x), bf2f((bf16_t)(qv.z >> 16)) * __expf(c1.y));
    ov.w = pack2(bf2f((bf16_t)(qv.w & 0xffff)) * __expf(c1.z), bf2f((bf16_t)(qv.w >> 16)) * __expf(c1.w));
    *(uint4*)(Qp + row * PS + lc8) = ov;
    *(uint4*)(Kp + row * PS + lc8) = *(const uint4*)(STH + ((size_t)(h * 65 + c) * 128 + row) * 128 + lc8);
  }
  __syncthreads();
#pragma unroll
  for (int ks = 0; ks < 4; ks++) {
    bf16x8 a0 = ldfrag(Qp, PS, wm * 32 + lr, ks * 32 + lg * 8);
    bf16x8 a1 = ldfrag(Qp, PS, wm * 32 + 16 + lr, ks * 32 + lg * 8);
#pragma unroll
    for (int j = 0; j < 4; j++) {
      bf16x8 bb = ldfrag(Kp, PS, wn * 64 + j * 16 + lr, ks * 32 + lg * 8);
      o[0][j] = MFMA(bb, a0, o[0][j]);
      o[1][j] = MFMA(bb, a1, o[1][j]);
    }
    __builtin_amdgcn_sched_barrier(0);
  }
#pragma unroll
  for (int i = 0; i < 2; i++) {
    float ss = 0.f;
#pragma unroll
    for (int j = 0; j < 4; j++)
#pragma unroll
      for (int r = 0; r < 4; r++) ss += o[i][j][r] * o[i][j][r];
    ss += __shfl_xor(ss, 16);
    ss += __shfl_xor(ss, 32);
    if (lg == 0) RED[(wm * 32 + i * 16 + lr) * 2 + wn] = ss;
  }
  __syncthreads();
#pragma unroll
  for (int i = 0; i < 2; i++) {
    const int q = wm * 32 + i * 16 + lr;
    const float rs = rsqrtf((RED[q * 2] + RED[q * 2 + 1]) * (1.f / 128.f) + 1e-6f);
#pragma unroll
    for (int j = 0; j < 4; j++) {
      f32x4 v = o[i][j];
#pragma unroll
      for (int r = 0; r < 4; r++) v[r] *= rs;
      *(uint2*)(OHG + (size_t)(t0 + q) * 1024 + colb + wn * 64 + j * 16 + lg * 4) = pack4(v);
    }
  }
}

DEV void phase_O(const Params& p, int layer, int qidx, unsigned char* ldsraw) {
  bf16_t* lds = (bf16_t*)ldsraw;
  int* ctr = (int*)(p.ws + OFF_CTR) + qidx;
  int* sitem = (int*)(ldsraw + LDS_BYTES - 16);
  const float* lp = p.in[7] + layer * 256;
  float d0 = 0.f, d1 = 0.f;
  for (int i = 0; i < 64; i++) { d0 += lp[i] * lp[64 + i]; d1 += lp[128 + i] * lp[192 + i]; }
  int ly = layer; asm volatile("" : "+s"(ly));
  const float li = (ly == 0) ? 0.2f : 0.35550906759f;
  const float lam = __uint_as_float(__builtin_amdgcn_readfirstlane(__float_as_uint(__expf(d0) - __expf(d1) + li)));
  for (int item = get_bid(); item < 1300; item += gridDim.x) {
    __syncthreads();
    if (item < 520) attn_item(p, layer, item & 7, 64 - (item >> 3), lam, lds);
    else if (item < 780) ret_item(p, (item - 520) & 3, (item - 520) >> 2, lds);
    else hg_item(p, (item - 780) & 7, (item - 780) >> 3, lds);
  }
}

DEV void phase_G(const Params& p, unsigned char* ldsraw) {
  unsigned char* ws = p.ws;
  bf16_t* lds = (bf16_t*)ldsraw;
  const bf16_t* HN = (const bf16_t*)(ws + OFF_HN);
  const bf16_t* WIN = (const bf16_t*)(ws + OFF_WIN);
  for (int item = get_bid(); item < 65 * 20; item += gridDim.x) {
    const int nt = item / 65, mt = item - nt * 65;
    int n0, cb; bf16_t* dst; int ld; bool gate;
    if (nt < 4) { n0 = 2048 + nt * 256; cb = nt * 256; dst = (bf16_t*)(ws + OFF_ORET); ld = 1024; gate = true; }
    else if (nt < 8) { n0 = 6144 + (nt - 4) * 256; cb = (nt - 4) * 256; dst = (bf16_t*)(ws + OFF_OHG); ld = 1024; gate = true; }
    else { n0 = 10240 + (nt - 8) * 256; cb = (nt - 8) * 256; dst = (bf16_t*)(ws + OFF_G); ld = 3072; gate = false; }
    f32x4 acc[2][8];
#pragma unroll
    for (int i = 0; i < 2; i++)
#pragma unroll
      for (int j = 0; j < 8; j++) acc[i][j] = (f32x4){0.f, 0.f, 0.f, 0.f};
    gemm_acc<256, false>(acc, HN + (size_t)mt * 128 * 1024, 1024, WIN + (size_t)n0 * 1024, 1024, 1024, lds);
      const int tid = get_tid(), lane = tid & 63, wave = tid >> 6, wm = wave >> 1, wn = wave & 1; const int lr = lane & 15, lg = lane >> 4; (void)tid; (void)lane; (void)wm; (void)wn; (void)lr; (void)lg;
#pragma unroll
    for (int i = 0; i < 2; i++) {
      const int t = mt * 128 + wm * 32 + i * 16 + lr;
#pragma unroll
      for (int j = 0; j < 8; j++) {
        bf16_t* d = dst + (size_t)t * ld + cb + wn * 128 + j * 16 + lg * 4;
        f32x4 v;
        if (gate) {
          uint2 ov = *(const uint2*)d;
          v[0] = bf2f((bf16_t)(ov.x & 0xffff)) * silu_f(acc[i][j][0]);
          v[1] = bf2f((bf16_t)(ov.x >> 16)) * silu_f(acc[i][j][1]);
          v[2] = bf2f((bf16_t)(ov.y & 0xffff)) * silu_f(acc[i][j][2]);
          v[3] = bf2f((bf16_t)(ov.y >> 16)) * silu_f(acc[i][j][3]);
        } else {
#pragma unroll
          for (int r = 0; r < 4; r++) v[r] = sigmoid_f(acc[i][j][r]);
        }
        *(uint2*)d = pack4(v);
      }
    }
  }
}

DEV void phase_Y(const Params& p, unsigned char* ldsraw) {
  unsigned char* ws = p.ws;
  bf16_t* lds = (bf16_t*)ldsraw;
  const bf16_t* WB = (const bf16_t*)(ws + OFF_WB);
  const bf16_t* G = (const bf16_t*)(ws + OFF_G);
  bf16_t* Y = (bf16_t*)(ws + OFF_Y);
  for (int item = get_bid(); item < 65 * 8; item += gridDim.x) {
    const int nt = item / 65, mt = item - nt * 65;
    f32x4 y[2][4];
#pragma unroll
    for (int i = 0; i < 2; i++)
#pragma unroll
      for (int j = 0; j < 4; j++) y[i][j] = (f32x4){0.f, 0.f, 0.f, 0.f};
#pragma unroll 1
    for (int br = 0; br < 3; br++) {
      const bf16_t* Ab = (const bf16_t*)(ws + (br == 0 ? OFF_ORET : (br == 1 ? OFF_OHG : OFF_ODA))) + (size_t)mt * 128 * 1024;
      f32x4 acc[2][4];
#pragma unroll
      for (int i = 0; i < 2; i++)
#pragma unroll
        for (int j = 0; j < 4; j++) acc[i][j] = (f32x4){0.f, 0.f, 0.f, 0.f};
      gemm_acc<128, false>(acc, Ab, 1024, WB + ((size_t)br * 1024 + nt * 128) * 1024, 1024, 1024, lds);
      const int tid = get_tid(), lane = tid & 63, wave = tid >> 6, wm = wave >> 1, wn = wave & 1; const int lr = lane & 15, lg = lane >> 4; (void)tid; (void)lane; (void)wm; (void)wn; (void)lr; (void)lg;
#pragma unroll
      for (int i = 0; i < 2; i++) {
        const int t = mt * 128 + wm * 32 + i * 16 + lr;
#pragma unroll
        for (int j = 0; j < 4; j++) {
          uint2 gv = *(const uint2*)(G + (size_t)t * 3072 + br * 1024 + nt * 128 + wn * 64 + j * 16 + lg * 4);
          y[i][j][0] += bf2f((bf16_t)(gv.x & 0xffff)) * acc[i][j][0];
          y[i][j][1] += bf2f((bf16_t)(gv.x >> 16)) * acc[i][j][1];
          y[i][j][2] += bf2f((bf16_t)(gv.y & 0xffff)) * acc[i][j][2];
          y[i][j][3] += bf2f((bf16_t)(gv.y >> 16)) * acc[i][j][3];
        }
      }
    }
    const int tid = get_tid(), lane = tid & 63, wave = tid >> 6, wm = wave >> 1, wn = wave & 1; const int lr = lane & 15, lg = lane >> 4;
#pragma unroll
    for (int i = 0; i < 2; i++) {
      const int t = mt * 128 + wm * 32 + i * 16 + lr;
#pragma unroll
      for (int j = 0; j < 4; j++)
        *(uint2*)(Y + (size_t)t * 1024 + nt * 128 + wn * 64 + j * 16 + lg * 4) = pack4(y[i][j]);
    }
  }
}

DEV void phase_resid(const Params& p, int b, const bf16_t* A, int K, const bf16_t* Wt, unsigned char* ldsraw) {
  bf16_t* lds = (bf16_t*)ldsraw;
  float* Hb = (float*)(p.ws + OFF_H) + (size_t)b * LT * 1024;
  for (int item = get_bid(); item < 65 * 8; item += gridDim.x) {
    const int nt = item / 65, mt = item - nt * 65;
    f32x4 acc[2][4];
#pragma unroll
    for (int i = 0; i < 2; i++)
#pragma unroll
      for (int j = 0; j < 4; j++) acc[i][j] = (f32x4){0.f, 0.f, 0.f, 0.f};
    gemm_acc<128, false>(acc, A + (size_t)mt * 128 * K, K, Wt + (size_t)nt * 128 * K, K, K, lds);
      const int tid = get_tid(), lane = tid & 63, wave = tid >> 6, wm = wave >> 1, wn = wave & 1; const int lr = lane & 15, lg = lane >> 4; (void)tid; (void)lane; (void)wm; (void)wn; (void)lr; (void)lg;
#pragma unroll
    for (int i = 0; i < 2; i++) {
      const int t = mt * 128 + wm * 32 + i * 16 + lr;
#pragma unroll
      for (int j = 0; j < 4; j++) {
        float4* d = (float4*)(Hb + (size_t)t * 1024 + nt * 128 + wn * 64 + j * 16 + lg * 4);
        float4 v = *d;
        v.x += acc[i][j][0]; v.y += acc[i][j][1]; v.z += acc[i][j][2]; v.w += acc[i][j][3];
        *d = v;
      }
    }
  }
}

DEV void phase_F1(const Params& p, unsigned char* ldsraw) {
  unsigned char* ws = p.ws;
  bf16_t* lds = (bf16_t*)ldsraw;
  const bf16_t* HN = (const bf16_t*)(ws + OFF_HN);
  const bf16_t* WFI = (const bf16_t*)(ws + OFF_WFI);
  bf16_t* U = (bf16_t*)(ws + OFF_U);
  for (int item = get_bid(); item < 65 * 22; item += gridDim.x) {
    const int nt = item / 65, mt = item - nt * 65;
    f32x4 acc[2][8];
#pragma unroll
    for (int i = 0; i < 2; i++)
#pragma unroll
      for (int j = 0; j < 8; j++) acc[i][j] = (f32x4){0.f, 0.f, 0.f, 0.f};
    gemm_acc<256, false>(acc, HN + (size_t)mt * 128 * 1024, 1024, WFI + (size_t)nt * 256 * 1024, 1024, 1024, lds);
      const int tid = get_tid(), lane = tid & 63, wave = tid >> 6, wm = wave >> 1, wn = wave & 1; const int lr = lane & 15, lg = lane >> 4; (void)tid; (void)lane; (void)wm; (void)wn; (void)lr; (void)lg;
#pragma unroll
    for (int i = 0; i < 2; i++) {
      const int t = mt * 128 + wm * 32 + i * 16 + lr;
      const float vm = (t >= 112) ? 1.f : 0.f;
#pragma unroll
      for (int j = 0; j < 8; j++) {
        f32x4 v = acc[i][j];
#pragma unroll
        for (int r = 0; r < 4; r++) v[r] *= vm;
        *(uint2*)(U + (size_t)t * 5632 + nt * 256 + wn * 128 + j * 16 + lg * 4) = pack4(v);
      }
    }
  }
}

DEV void phase_conv(const Params& p, int layer) {
  unsigned char* ws = p.ws;
  const bf16_t* U = (const bf16_t*)(ws + OFF_U);
  bf16_t* GF = (bf16_t*)(ws + OFF_GF);
  const float* cw = p.in[11] + (size_t)layer * 3 * 5632;
  const float* cbias = p.in[12] + (size_t)layer * 5632;
  for (int idx = get_bid() * NTHR + get_tid(); idx < LT * 352; idx += gridDim.x * NTHR) {
    const int t = idx / 352, c8 = (idx - t * 352) * 8;
    float g[8], v[8];
#pragma unroll
    for (int k = 0; k < 8; k++) { g[k] = cbias[c8 + k]; v[k] = cbias[2816 + c8 + k]; }
#pragma unroll
    for (int j = 0; j < 3; j++) {
      const int tt = t - 2 + j;
      if (tt >= 0) {
        uint4 ug = *(const uint4*)(U + (size_t)tt * 5632 + c8);
        uint4 uv = *(const uint4*)(U + (size_t)tt * 5632 + 2816 + c8);
        const float* wg = cw + j * 5632 + c8;
        const float* wv = cw + j * 5632 + 2816 + c8;
        const unsigned ugs[4] = {ug.x, ug.y, ug.z, ug.w};
        const unsigned uvs[4] = {uv.x, uv.y, uv.z, uv.w};
#pragma unroll
        for (int k = 0; k < 4; k++) {
          g[2 * k] += wg[2 * k] * bf2f((bf16_t)(ugs[k] & 0xffff));
          g[2 * k + 1] += wg[2 * k + 1] * bf2f((bf16_t)(ugs[k] >> 16));
          v[2 * k] += wv[2 * k] * bf2f((bf16_t)(uvs[k] & 0xffff));
          v[2 * k + 1] += wv[2 * k + 1] * bf2f((bf16_t)(uvs[k] >> 16));
        }
      }
    }
    uint4 o;
    o.x = pack2(silu_f(g[0]) * v[0], silu_f(g[1]) * v[1]);
    o.y = pack2(silu_f(g[2]) * v[2], silu_f(g[3]) * v[3]);
    o.z = pack2(silu_f(g[4]) * v[4], silu_f(g[5]) * v[5]);
    o.w = pack2(silu_f(g[6]) * v[6], silu_f(g[7]) * v[7]);
    *(uint4*)(GF + (size_t)t * 2816 + c8) = o;
  }
}

__global__ void __launch_bounds__(NTHR) fwd_megakernel(Params p) {
  extern __shared__ __attribute__((aligned(16))) unsigned char lds[];
  cg::grid_group grid = cg::this_grid();
  unsigned bar_target = 0;
  unsigned* bar_word = (unsigned*)(p.ws + OFF_CTR) + 32;
#define GRID_SYNC() do { \
    __threadfence(); asm volatile("s_waitcnt vmcnt(0) lgkmcnt(0)" ::: "memory"); \
    __syncthreads(); \
    bar_target += gridDim.x; \
    if (threadIdx.x == 0) { \
      __hip_atomic_fetch_add(bar_word, 1u, __ATOMIC_RELEASE, __HIP_MEMORY_SCOPE_AGENT); \
      while (__hip_atomic_load(bar_word, __ATOMIC_RELAXED, __HIP_MEMORY_SCOPE_AGENT) < bar_target) __builtin_amdgcn_s_sleep(2); \
    } \
    __syncthreads(); \
    __threadfence(); asm volatile("s_waitcnt vmcnt(0) lgkmcnt(0)" ::: "memory"); \
  } while (0)
  grid.sync();
  unsigned char* ws = p.ws;
  phase_init(p);
  phase_convert(p, 0, lds);
  GRID_SYNC();
  for (int layer = 0; layer < 2; layer++) {
    if (layer == 1) { phase_convert(p, 1, lds); GRID_SYNC(); }
    for (int b = 0; b < 2; b++) {
      const float* Hb = (const float*)(ws + OFF_H) + (size_t)b * LT * 1024;
      phase_norm(Hb, p.in[2] + layer * 1024, (bf16_t*)(ws + OFF_HN));
      GRID_SYNC();
      phase_projA(p, layer, lds);
      GRID_SYNC();
      phase_U(p, lds);
      GRID_SYNC();
      phase_scan(p);
      GRID_SYNC();
      phase_O(p, layer, layer * 2 + b, lds);
      GRID_SYNC();
      phase_G(p, lds);
      GRID_SYNC();
      phase_Y(p, lds);
      GRID_SYNC();
      phase_resid(p, b, (const bf16_t*)(ws + OFF_Y), 1024, (const bf16_t*)(ws + OFF_WO), lds);
      GRID_SYNC();
      phase_norm(Hb, p.in[9] + layer * 1024, (bf16_t*)(ws + OFF_HN));
      GRID_SYNC();
      phase_F1(p, lds);
      GRID_SYNC();
      phase_conv(p, layer);
      GRID_SYNC();
      phase_resid(p, b, (const bf16_t*)(ws + OFF_GF), DFF, (const bf16_t*)(ws + OFF_WFO), lds);
      GRID_SYNC();
    }
  }
  phase_final(p);
}

extern "C" void kernel_launch(void* const* d_in, const int* in_sizes, int n_in, void* d_out, int out_size,
                              void* d_ws, size_t ws_size, hipStream_t stream) {
  static int grid_blocks = 0;
  if (grid_blocks == 0) {
    if (n_in != 15 || ws_size < OFF_END) {
      fprintf(stderr, "kernel_launch: need 15 inputs and %zu bytes of workspace, got %d and %zu\n", (size_t)OFF_END, n_in, ws_size);
      grid_blocks = -1; return;
    }
    int dev = 0, cus = 0, per_cu = 0;
    hipGetDevice(&dev);
    hipDeviceGetAttribute(&cus, hipDeviceAttributeMultiprocessorCount, dev);
    if (hipFuncSetAttribute((const void*)fwd_megakernel, hipFuncAttributeMaxDynamicSharedMemorySize, LDS_BYTES) != hipSuccess) {
      fprintf(stderr, "kernel_launch: hipFuncSetAttribute failed\n"); grid_blocks = -1; return;
    }
    hipOccupancyMaxActiveBlocksPerMultiprocessor(&per_cu, (const void*)fwd_megakernel, NTHR, LDS_BYTES);
    if (per_cu < 1) per_cu = 1;
    if (per_cu > 1) per_cu = 1;
    grid_blocks = cus * per_cu;
  }
  if (grid_blocks < 0) return;
  hipMemsetAsync((char*)d_ws + OFF_CTR, 0, 256, stream);
  Params p{};
  for (int i = 0; i < 15; i++) p.in[i] = (const float*)d_in[i];
  p.out = (float*)d_out;
  p.ws = (unsigned char*)d_ws;
  void* args[] = {&p};
  hipError_t e = hipLaunchCooperativeKernel((const void*)fwd_megakernel, dim3(grid_blocks), dim3(NTHR), args, LDS_BYTES, stream);
  if (e != hipSuccess) fprintf(stderr, "cooperative launch failed: %s (grid %d)\n", hipGetErrorString(e), grid_blocks);
}
```

```cpp
#include <hip/hip_runtime.h>
#include <hip/hip_cooperative_groups.h>
#include <cstdio>
#include <cstdint>
namespace cg = cooperative_groups;

typedef unsigned short bf16_t;
typedef __attribute__((ext_vector_type(8))) short bf16x8;
typedef __attribute__((ext_vector_type(4))) short bf16x4;
typedef __attribute__((ext_vector_type(4))) float f32x4;
typedef __attribute__((ext_vector_type(4))) unsigned u32x4;

#define DEV __device__ __forceinline__
#define MFMA(a, b, c) __builtin_amdgcn_mfma_f32_16x16x32_bf16(a, b, c, 0, 0, 0)

constexpr int LT = 8320;
constexpr int NCH = 65;
constexpr int NTHR = 512;
constexpr int LDS_BYTES = 144 * 1024;
constexpr int INW = 13312;
constexpr int DFF = 2816;

constexpr size_t SZ_ACT = (size_t)LT * 1024 * 2;
constexpr size_t OFF_WIN = 0;
constexpr size_t OFF_WB = OFF_WIN + (size_t)INW * 1024 * 2;
constexpr size_t OFF_WO = OFF_WB + (size_t)3 * 1024 * 1024 * 2;
constexpr size_t OFF_WFI = OFF_WO + (size_t)1024 * 1024 * 2;
constexpr size_t OFF_WFO = OFF_WFI + (size_t)5632 * 1024 * 2;
constexpr size_t OFF_H = OFF_WFO + (size_t)1024 * 2816 * 2;
constexpr size_t OFF_HN = OFF_H + (size_t)2 * 128 * 1024 * 4;
constexpr size_t OFF_R128 = OFF_HN + SZ_ACT;
constexpr size_t OFF_R64 = OFF_R128 + (size_t)LT * 64 * 8;
constexpr size_t OFF_CTR = OFF_R64 + (size_t)LT * 32 * 8;
constexpr size_t OFF_ARENA = OFF_CTR + 256;
constexpr size_t OFF_RQ = OFF_ARENA;
constexpr size_t OFF_RK = OFF_RQ + SZ_ACT / 2;
constexpr size_t OFF_RKT = OFF_RK + SZ_ACT / 2;
constexpr size_t OFF_RVT = OFF_RKT + SZ_ACT / 2;
constexpr size_t OFF_HQ = OFF_RVT + SZ_ACT;
constexpr size_t OFF_HK = OFF_HQ + SZ_ACT;
constexpr size_t OFF_HCB = OFF_HK + SZ_ACT;
constexpr size_t OFF_HKET = OFF_HCB + 2 * SZ_ACT;
constexpr size_t OFF_HVT = OFF_HKET + SZ_ACT;
constexpr size_t OFF_DQ = OFF_HVT + SZ_ACT;
constexpr size_t OFF_DK = OFF_DQ + SZ_ACT;
constexpr size_t OFF_DVT = OFF_DK + SZ_ACT;
constexpr size_t OFF_ORET = OFF_DVT + SZ_ACT;
constexpr size_t OFF_OHG = OFF_ORET + SZ_ACT;
constexpr size_t OFF_STR = OFF_OHG + SZ_ACT;
constexpr size_t OFF_STH = OFF_STR + SZ_ACT;
constexpr size_t OFF_HDEC = OFF_STH + SZ_ACT;
constexpr size_t OFF_END = OFF_HDEC + (size_t)65 * 1024 * 4;
constexpr size_t OFF_G = OFF_RQ;
constexpr size_t OFF_Y = OFF_HK;
constexpr size_t OFF_ODA = OFF_HKET;
constexpr size_t OFF_U = OFF_ARENA;
constexpr size_t OFF_GF = OFF_U + (size_t)LT * 5632 * 2;

struct Params {
  const float* in[15];
  float* out;
  unsigned char* ws;
};

DEV int get_tid() { int t = threadIdx.x; asm volatile("" : "+v"(t)); return t; }
DEV int get_bid() { int b = blockIdx.x; asm volatile("" : "+s"(b)); return b; }
DEV float* hrow(const Params& p, int b, int t) {
  return (t < 128) ? (float*)(p.ws + OFF_H) + (size_t)(b * 128 + t) * 1024 : p.out + ((size_t)b * 8192 + (t - 128)) * 1024;
}
DEV bf16_t f2bf(float f) {
  unsigned u = __float_as_uint(f);
  u += 0x7fffu + ((u >> 16) & 1u);
  return (bf16_t)(u >> 16);
}
DEV float bf2f(bf16_t h) { return __uint_as_float(((unsigned)h) << 16); }
DEV unsigned pack2(float a, float b) { return (unsigned)f2bf(a) | ((unsigned)f2bf(b) << 16); }
DEV uint2 pack4(f32x4 v) { uint2 r; r.x = pack2(v[0], v[1]); r.y = pack2(v[2], v[3]); return r; }
DEV float silu_f(float x) { return x / (1.f + __expf(-x)); }
DEV float sigmoid_f(float x) { return 1.f / (1.f + __expf(-x)); }
DEV float ex2(float x) { return __builtin_amdgcn_exp2f(x); }
DEV bf16x8 ldfrag(const bf16_t* base, int stride, int row, int k) {
  return *(const bf16x8*)(base + row * stride + k);
}

template <int BN, bool TRANS>
DEV void gemm_compute(f32x4 (&acc)[2][BN / 32], const bf16_t* as, const bf16_t* bs) {
  constexpr int NJ = BN / 32, LS = 72;
#pragma unroll
  for (int ks = 0; ks < 2; ks++) {
    bf16x8 a0 = *(const bf16x8*)(as + ks * 32);
    bf16x8 a1 = *(const bf16x8*)(as + 16 * LS + ks * 32);
#pragma unroll
    for (int j = 0; j < NJ; j++) {
      bf16x8 bb = *(const bf16x8*)(bs + j * 16 * LS + ks * 32);
      if (TRANS) {
        acc[0][j] = MFMA(a0, bb, acc[0][j]);
        acc[1][j] = MFMA(a1, bb, acc[1][j]);
      } else {
        acc[0][j] = MFMA(bb, a0, acc[0][j]);
        acc[1][j] = MFMA(bb, a1, acc[1][j]);
      }
    }
  }
}

template <int BN, bool TRANS>
DEV void gemm_acc(f32x4 (&acc)[2][BN / 32], const bf16_t* __restrict__ A, int lda,
                  const bf16_t* __restrict__ Bt, int ldb, int K, bf16_t* lds) {
  constexpr int LS = 72, A_SZ = 128 * LS, B_SZ = BN * LS, NB = BN / 64;
  const int tid = get_tid(), lane = tid & 63, wave = tid >> 6, wm = wave >> 1, wn = wave & 1;
  const int lr = lane & 15, lg = lane >> 4;
  bf16_t* As = lds;
  bf16_t* Bs = lds + 2 * A_SZ;
  const int crow = tid >> 3, ckc = (tid & 7) * 8;
  const bf16_t* ga = A + (size_t)crow * lda + ckc;
  const bf16_t* gb = Bt + (size_t)crow * ldb + ckc;
  u32x4 ra0, ra1, rb0, rb1, rb2, rb3;
#define GLOAD(k0)                                                        \
  ra0 = *(const u32x4*)(ga + (k0));                                      \
  ra1 = *(const u32x4*)(ga + (size_t)64 * lda + (k0));                   \
  rb0 = *(const u32x4*)(gb + (k0));                                      \
  rb1 = *(const u32x4*)(gb + (size_t)64 * ldb + (k0));                   \
  if (NB == 4) {                                                         \
    rb2 = *(const u32x4*)(gb + (size_t)128 * ldb + (k0));                \
    rb3 = *(const u32x4*)(gb + (size_t)192 * ldb + (k0));                \
  }
#define LSTORE(buf)                                                      \
  *(u32x4*)(As + (buf) * A_SZ + crow * LS + ckc) = ra0;                  \
  *(u32x4*)(As + (buf) * A_SZ + (crow + 64) * LS + ckc) = ra1;           \
  *(u32x4*)(Bs + (buf) * B_SZ + crow * LS + ckc) = rb0;                  \
  *(u32x4*)(Bs + (buf) * B_SZ + (crow + 64) * LS + ckc) = rb1;           \
  if (NB == 4) {                                                         \
    *(u32x4*)(Bs + (buf) * B_SZ + (crow + 128) * LS + ckc) = rb2;        \
    *(u32x4*)(Bs + (buf) * B_SZ + (crow + 192) * LS + ckc) = rb3;        \
  }
  GLOAD(0)
  __syncthreads();
  LSTORE(0)
  __syncthreads();
  const int nk = K / 64;
  const int aoff = (wm * 32 + lr) * LS + lg * 8;
  const int boff = (wn * (BN / 2) + lr) * LS + lg * 8;
  for (int kt = 0; kt < nk - 1; kt++) {
    const int cur = kt & 1;
    GLOAD((kt + 1) * 64)
    gemm_compute<BN, TRANS>(acc, As + cur * A_SZ + aoff, Bs + cur * B_SZ + boff);
    LSTORE(cur ^ 1)
    __syncthreads();
  }
  {
    const int cur = (nk - 1) & 1;
    gemm_compute<BN, TRANS>(acc, As + cur * A_SZ + aoff, Bs + cur * B_SZ + boff);
    __syncthreads();
  }
#undef GLOAD
#undef LSTORE
}

DEV void tconv_tile(const float* __restrict__ src, int K, int N, bf16_t* __restrict__ dst, int tk, int tn, float* tile) {
  const int tid = get_tid();
  const int r = tid >> 4, c4 = (tid & 15) * 4;
#pragma unroll
  for (int i = 0; i < 2; i++) {
    const int rr = r + i * 32;
    float4 v = *(const float4*)(src + (size_t)(tk * 64 + rr) * N + tn * 64 + c4);
    tile[rr * 65 + c4 + 0] = v.x; tile[rr * 65 + c4 + 1] = v.y; tile[rr * 65 + c4 + 2] = v.z; tile[rr * 65 + c4 + 3] = v.w;
  }
  __syncthreads();
  const int n = tid >> 3, k8 = (tid & 7) * 8;
  uint4 o;
  o.x = pack2(tile[(k8 + 0) * 65 + n], tile[(k8 + 1) * 65 + n]);
  o.y = pack2(tile[(k8 + 2) * 65 + n], tile[(k8 + 3) * 65 + n]);
  o.z = pack2(tile[(k8 + 4) * 65 + n], tile[(k8 + 5) * 65 + n]);
  o.w = pack2(tile[(k8 + 6) * 65 + n], tile[(k8 + 7) * 65 + n]);
  *(uint4*)(dst + (size_t)(tn * 64 + n) * K + tk * 64 + k8) = o;
  __syncthreads();
}

DEV void phase_convert(const Params& p, int layer, unsigned char* lds) {
  unsigned char* ws = p.ws;
  float* tile = (float*)lds;
  for (int item = get_bid(); item < 6464; item += gridDim.x) {
    const float* src; bf16_t* dst; int K, N, idx;
    if (item < 3328) { idx = item; src = p.in[3] + (size_t)layer * 1024 * INW; K = 1024; N = INW; dst = (bf16_t*)(ws + OFF_WIN); }
    else if (item < 3328 + 768) { idx = item - 3328; int br = idx >> 8; idx &= 255; src = p.in[4] + ((size_t)layer * 3 + br) * 1024 * 1024; K = 1024; N = 1024; dst = (bf16_t*)(ws + OFF_WB) + (size_t)br * 1024 * 1024; }
    else if (item < 3328 + 1024) { idx = item - 4096; src = p.in[5] + (size_t)layer * 1024 * 1024; K = 1024; N = 1024; dst = (bf16_t*)(ws + OFF_WO); }
    else if (item < 4352 + 1408) { idx = item - 4352; src = p.in[10] + (size_t)layer * 1024 * 5632; K = 1024; N = 5632; dst = (bf16_t*)(ws + OFF_WFI); }
    else { idx = item - 5760; src = p.in[13] + (size_t)layer * 2816 * 1024; K = 2816; N = 1024; dst = (bf16_t*)(ws + OFF_WFO); }
    const int ntn = N / 64;
    tconv_tile(src, K, N, dst, idx / ntn, idx % ntn, tile);
  }
}

DEV void phase_init(const Params& p) {
  unsigned char* ws = p.ws;
  const int gt = get_bid() * NTHR + get_tid(), gs = gridDim.x * NTHR;
  for (int idx = gt; idx < 2 * LT * 256; idx += gs) {
    const int row = idx >> 8, c4 = (idx & 255) * 4;
    const int b = row / LT, t = row - b * LT;
    float4 v;
    if (t < 112) v = make_float4(0.f, 0.f, 0.f, 0.f);
    else if (t < 128) v = *(const float4*)(p.in[1] + (size_t)(t - 112) * 1024 + c4);
    else v = *(const float4*)(p.in[0] + ((size_t)b * 8192 + (t - 128)) * 1024 + c4);
    *(float4*)(hrow(p, b, t) + c4) = v;
  }
  float2* R128 = (float2*)(ws + OFF_R128);
  float2* R64 = (float2*)(ws + OFF_R64);
  for (int idx = gt; idx < LT * 96; idx += gs) {
    const int t = idx / 96, f = idx - t * 96;
    float inv;
    if (f < 64) inv = powf(10000.f, -(float)(2 * f) / 128.f);
    else inv = powf(10000.f, -(float)(2 * (f - 64)) / 64.f);
    const float ang = (float)(t - 112) * inv;
    const double ad = (double)ang;
    const double n = rint(ad * 0.15915494309189535);
    const float rr = (float)(ad - n * 6.283185307179586);
    float2 cs; cs.x = __cosf(rr); cs.y = __sinf(rr);
    if (f < 64) R128[(size_t)t * 64 + f] = cs; else R64[(size_t)t * 32 + (f - 64)] = cs;
  }
}

DEV void phase_norm(const Params& p, int b, const float* __restrict__ g, bf16_t* __restrict__ dst) {
  const int lane = get_tid() & 63, wave = get_tid() >> 6;
  for (int row = get_bid() * 8 + wave; row < LT; row += gridDim.x * 8) {
    const float* src = hrow(p, b, row);
    float4 v[4]; float ss = 0.f;
#pragma unroll
    for (int k = 0; k < 4; k++) { v[k] = *(const float4*)(src + k * 256 + lane * 4); ss += v[k].x * v[k].x + v[k].y * v[k].y + v[k].z * v[k].z + v[k].w * v[k].w; }
#pragma unroll
    for (int o = 1; o < 64; o <<= 1) ss += __shfl_xor(ss, o);
    const float rs = rsqrtf(ss * (1.f / 1024.f) + 1e-6f);
#pragma unroll
    for (int k = 0; k < 4; k++) {
      float4 gg = *(const float4*)(g + k * 256 + lane * 4);
      uint2 o; o.x = pack2(v[k].x * rs * gg.x, v[k].y * rs * gg.y); o.y = pack2(v[k].z * rs * gg.z, v[k].w * rs * gg.w);
      *(uint2*)(dst + (size_t)row * 1024 + k * 256 + lane * 4) = o;
    }
  }
}

DEV void phase_final(const Params& p) {
  const float* g = p.in[14];
  const int lane = get_tid() & 63, wave = get_tid() >> 6;
  for (int row = get_bid() * 8 + wave; row < 2 * 8192; row += gridDim.x * 8) {
    const float* src = p.out + (size_t)row * 1024;
    float4 v[4]; float ss = 0.f;
#pragma unroll
    for (int k = 0; k < 4; k++) { v[k] = *(const float4*)(src + k * 256 + lane * 4); ss += v[k].x * v[k].x + v[k].y * v[k].y + v[k].z * v[k].z + v[k].w * v[k].w; }
#pragma unroll
    for (int o = 1; o < 64; o <<= 1) ss += __shfl_xor(ss, o);
    const float rs = rsqrtf(ss * (1.f / 1024.f) + 1e-6f);
#pragma unroll
    for (int k = 0; k < 4; k++) {
      float4 gg = *(const float4*)(g + k * 256 + lane * 4);
      float4 o = make_float4(v[k].x * rs * gg.x, v[k].y * rs * gg.y, v[k].z * rs * gg.z, v[k].w * rs * gg.w);
      *(float4*)(p.out + (size_t)row * 1024 + k * 256 + lane * 4) = o;
    }
  }
}

DEV void phase_projA(const Params& p, int layer, unsigned char* ldsraw) {
  unsigned char* ws = p.ws;
  bf16_t* lds = (bf16_t*)ldsraw;
  const bf16_t* HN = (const bf16_t*)(ws + OFF_HN);
  const bf16_t* WIN = (const bf16_t*)(ws + OFF_WIN);
  const float2* R128 = (const float2*)(ws + OFF_R128);
  const float2* R64 = (const float2*)(ws + OFF_R64);
  for (int item = get_bid(); item < 65 * 32; item += gridDim.x) {
    const int nt = item / 65, mt = item - nt * 65;
    int n0, seg, segstart;
    if (nt < 8) { n0 = nt * 256; seg = nt < 2 ? 0 : (nt < 4 ? 1 : 2); segstart = seg == 0 ? 0 : (seg == 1 ? 512 : 1024); }
    else if (nt < 20) { n0 = 3072 + (nt - 8) * 256; seg = 3 + (nt - 8) / 4; segstart = 3072 + (seg - 3) * 1024; }
    else { n0 = 7168 + (nt - 20) * 256; seg = 6 + (nt - 20) / 4; segstart = 7168 + (seg - 6) * 1024; }
    const bf16_t* A = HN + (size_t)mt * 128 * 1024;
    const bf16_t* Bt = WIN + (size_t)n0 * 1024;
    f32x4 acc[2][8];
#pragma unroll
    for (int i = 0; i < 2; i++)
#pragma unroll
      for (int j = 0; j < 8; j++) acc[i][j] = (f32x4){0.f, 0.f, 0.f, 0.f};
    if (seg == 0 || seg == 3 || seg == 6 || seg == 7) {
      gemm_acc<256, false>(acc, A, 1024, Bt, 1024, 1024, lds);
      const int tid = get_tid(), lane = tid & 63, wave = tid >> 6, wm = wave >> 1, wn = wave & 1; const int lr = lane & 15, lg = lane >> 4; (void)tid; (void)lane; (void)wm; (void)wn; (void)lr; (void)lg;
      const int cw = (n0 - segstart) + wn * 128;
      bf16_t* dstb; int ld;
      if (seg == 0) { dstb = (bf16_t*)(ws + OFF_RQ); ld = 512; }
      else if (seg == 3) { dstb = (bf16_t*)(ws + OFF_HQ); ld = 1024; }
      else if (seg == 6) { dstb = (bf16_t*)(ws + OFF_DQ); ld = 1024; }
      else { dstb = (bf16_t*)(ws + OFF_DK); ld = 1024; }
#pragma unroll
      for (int i = 0; i < 2; i++) {
        const int t = mt * 128 + wm * 32 + i * 16 + lr;
        if (seg == 0) {
          const float2* tab = R128 + (size_t)t * 64;
#pragma unroll
          for (int j = 0; j < 4; j++)
#pragma unroll
            for (int r = 0; r < 4; r++) {
              float2 cs = tab[j * 16 + lg * 4 + r];
              float x1 = acc[i][j][r], x2 = acc[i][j + 4][r];
              acc[i][j][r] = x1 * cs.x - x2 * cs.y;
              acc[i][j + 4][r] = x2 * cs.x + x1 * cs.y;
            }
        } else if (seg == 6 || seg == 7) {
          const float2* tab = R64 + (size_t)t * 32;
          const float sc = (seg == 6) ? (0.125f * 1.4426950408889634f) : 1.f;
#pragma unroll
          for (int jq = 0; jq < 4; jq++) {
            const int j = (jq & 1) + (jq >> 1) * 4;
#pragma unroll
            for (int r = 0; r < 4; r++) {
              float2 cs = tab[(jq & 1) * 16 + lg * 4 + r];
              float x1 = acc[i][j][r], x2 = acc[i][j + 2][r];
              acc[i][j][r] = (x1 * cs.x - x2 * cs.y) * sc;
              acc[i][j + 2][r] = (x2 * cs.x + x1 * cs.y) * sc;
            }
          }
        }
        bf16_t* dst = dstb + (size_t)t * ld + cw;
#pragma unroll
        for (int j = 0; j < 8; j++) *(uint2*)(dst + j * 16 + lg * 4) = pack4(acc[i][j]);
      }
    } else {
      gemm_acc<256, true>(acc, A, 1024, Bt, 1024, 1024, lds);
      const int tid = get_tid(), lane = tid & 63, wave = tid >> 6, wm = wave >> 1, wn = wave & 1; const int lr = lane & 15, lg = lane >> 4; (void)tid; (void)lane; (void)wm; (void)wn; (void)lr; (void)lg;
      const int cw = (n0 - segstart) + wn * 128;
      if (seg == 1) {
        bf16_t* RK = (bf16_t*)(ws + OFF_RK);
        bf16_t* RKT = (bf16_t*)(ws + OFF_RKT);
        const int h = cw >> 7;
        const float l2g = log2f(1.f - ex2(-5.f - (float)h));
#pragma unroll
        for (int i = 0; i < 2; i++) {
          const int mb = wm * 32 + i * 16 + lg * 4;
#pragma unroll
          for (int j = 0; j < 4; j++)
#pragma unroll
            for (int r = 0; r < 4; r++) {
              const int t = mt * 128 + mb + r;
              float2 cs = R128[(size_t)t * 64 + j * 16 + lr];
              const float sc = (t >= 112) ? 0.08838834764831845f : 0.f;
              float x1 = acc[i][j][r], x2 = acc[i][j + 4][r];
              acc[i][j][r] = (x1 * cs.x - x2 * cs.y) * sc;
              acc[i][j + 4][r] = (x2 * cs.x + x1 * cs.y) * sc;
            }
#pragma unroll
          for (int j = 0; j < 8; j++) {
            const int col = cw + j * 16 + lr;
            f32x4 kd;
#pragma unroll
            for (int r = 0; r < 4; r++) {
              const int t = mt * 128 + mb + r;
              RK[(size_t)t * 512 + col] = f2bf(acc[i][j][r]);
              kd[r] = acc[i][j][r] * ex2(l2g * (float)(127 - (mb + r)));
            }
            *(uint2*)(RKT + (size_t)col * LT + mt * 128 + mb) = pack4(kd);
          }
        }
      } else if (seg == 2 || seg == 5 || seg == 8) {
        bf16_t* dT = (bf16_t*)(ws + (seg == 2 ? OFF_RVT : (seg == 5 ? OFF_HVT : OFF_DVT)));
#pragma unroll
        for (int i = 0; i < 2; i++) {
          const int mb = wm * 32 + i * 16 + lg * 4;
#pragma unroll
          for (int j = 0; j < 8; j++) {
            const int col = cw + j * 16 + lr;
            f32x4 v = acc[i][j];
            if (seg == 5) {
#pragma unroll
              for (int r = 0; r < 4; r++) if (mt * 128 + mb + r < 112) v[r] = 0.f;
            }
            *(uint2*)(dT + (size_t)col * LT + mt * 128 + mb) = pack4(v);
          }
        }
      } else {
        float* Lf = (float*)ldsraw;
        float* HCB = (float*)(ws + OFF_HCB);
        bf16_t* HK = (bf16_t*)(ws + OFF_HK);
        bf16_t* HKET = (bf16_t*)(ws + OFF_HKET);
        float* HDEC = (float*)(ws + OFF_HDEC);
        const float* lbp = p.in[6];
#pragma unroll
        for (int j = 0; j < 8; j++) {
          const int col = cw + j * 16 + lr;
          float lb = 0.f;
          if (layer == 1) lb = 1.f / (1.f + __expf(lbp[col] - lbp[1024 + col]));
#pragma unroll
          for (int i = 0; i < 2; i++)
#pragma unroll
            for (int r = 0; r < 4; r++) {
              const int m = wm * 32 + i * 16 + lg * 4 + r;
              const float z = acc[i][j][r];
              const float kk = (1.f - lb) / (1.f + __expf(z));
              const float lf = fmaxf(log1pf(-kk), -69.0776f);
              acc[i][j][r] = kk;
              Lf[m * 260 + wn * 128 + j * 16 + lr] = lf;
            }
        }
        __syncthreads();
        {
          const int colL = tid & 255, half = tid >> 8;
          float run = 0.f;
          for (int rr = 0; rr < 64; rr++) {
            float* q = &Lf[(half * 64 + rr) * 260 + colL];
            run += *q; *q = run;
          }
        }
        __syncthreads();
#pragma unroll
        for (int j = 0; j < 8; j++) {
          const int colL = wn * 128 + j * 16 + lr;
          const int col = cw + j * 16 + lr;
          const float ft = Lf[63 * 260 + colL];
          const float cend = Lf[127 * 260 + colL] + ft;
#pragma unroll
          for (int i = 0; i < 2; i++) {
            const int mb = wm * 32 + i * 16 + lg * 4;
            f32x4 ke;
#pragma unroll
            for (int r = 0; r < 4; r++) {
              const int m = mb + r;
              const int t = mt * 128 + m;
              const float cb = Lf[m * 260 + colL] + (m >= 64 ? ft : 0.f);
              HCB[(size_t)t * 1024 + col] = cb;
              HK[(size_t)t * 1024 + col] = f2bf(acc[i][j][r]);
              ke[r] = acc[i][j][r] * __expf(cend - cb);
              if (m == 127) HDEC[mt * 1024 + col] = __expf(cend);
            }
            *(uint2*)(HKET + (size_t)col * LT + mt * 128 + mb) = pack4(ke);
          }
        }
        __syncthreads();
      }
    }
  }
}

DEV void phase_U(const Params& p, unsigned char* ldsraw) {
  unsigned char* ws = p.ws;
  bf16_t* lds = (bf16_t*)ldsraw;
  for (int item = get_bid(); item < 1040; item += gridDim.x) {
    const bf16_t *A, *Bt; bf16_t* dst;
    if (item < 520) {
      const int h = item & 3, rest = item >> 2, mh = rest & 1, c = rest >> 1;
      A = (const bf16_t*)(ws + OFF_RVT) + (size_t)(h * 256 + mh * 128) * LT + c * 128;
      Bt = (const bf16_t*)(ws + OFF_RKT) + (size_t)(h * 128) * LT + c * 128;
      dst = (bf16_t*)(ws + OFF_STR) + ((size_t)(h * 65 + c) * 256 + mh * 128) * 128;
    } else {
      const int it = item - 520, h = it & 7, c = it >> 3;
      A = (const bf16_t*)(ws + OFF_HVT) + (size_t)(h * 128) * LT + c * 128;
      Bt = (const bf16_t*)(ws + OFF_HKET) + (size_t)(h * 128) * LT + c * 128;
      dst = (bf16_t*)(ws + OFF_STH) + ((size_t)(h * 65 + c) * 128) * 128;
    }
    f32x4 acc[2][4];
#pragma unroll
    for (int i = 0; i < 2; i++)
#pragma unroll
      for (int j = 0; j < 4; j++) acc[i][j] = (f32x4){0.f, 0.f, 0.f, 0.f};
    gemm_acc<128, false>(acc, A, LT, Bt, LT, 128, lds);
      const int tid = get_tid(), lane = tid & 63, wave = tid >> 6, wm = wave >> 1, wn = wave & 1; const int lr = lane & 15, lg = lane >> 4; (void)tid; (void)lane; (void)wm; (void)wn; (void)lr; (void)lg;
#pragma unroll
    for (int i = 0; i < 2; i++)
#pragma unroll
      for (int j = 0; j < 4; j++)
        *(uint2*)(dst + (size_t)(wm * 32 + i * 16 + lr) * 128 + wn * 64 + j * 16 + lg * 4) = pack4(acc[i][j]);
  }
}

DEV void phase_scan(const Params& p) {
  unsigned char* ws = p.ws;
  const float* HDEC = (const float*)(ws + OFF_HDEC);
  for (int task = get_bid() * NTHR + get_tid(); task < 65536; task += gridDim.x * NTHR) {
    bf16_t* base; size_t stride; int h, d4; bool hg;
    float dec0 = 0.f;
    if (task < 32768) {
      const int v = task; d4 = (v & 31) * 4; const int e = (v >> 5) & 255; h = v >> 13; hg = false;
      base = (bf16_t*)(ws + OFF_STR) + ((size_t)(h * 65) * 256 + e) * 128 + d4; stride = 256 * 128;
      dec0 = ex2(128.f * log2f(1.f - ex2(-5.f - (float)h)));
    } else {
      const int v = task - 32768; d4 = (v & 31) * 4; const int e = (v >> 5) & 127; h = v >> 12; hg = true;
      base = (bf16_t*)(ws + OFF_STH) + ((size_t)(h * 65) * 128 + e) * 128 + d4; stride = 128 * 128;
    }
    float c0 = 0.f, c1 = 0.f, c2 = 0.f, c3 = 0.f;
    for (int cg0 = 0; cg0 < 65; cg0 += 5) {
      uint2 u[5]; float4 dc[5];
#pragma unroll
      for (int k = 0; k < 5; k++) {
        u[k] = *(const uint2*)(base + (size_t)(cg0 + k) * stride);
        if (hg) dc[k] = *(const float4*)(HDEC + (size_t)(cg0 + k) * 1024 + h * 128 + d4);
        else dc[k] = make_float4(dec0, dec0, dec0, dec0);
      }
#pragma unroll
      for (int k = 0; k < 5; k++) {
        uint2 o; o.x = pack2(c0, c1); o.y = pack2(c2, c3);
        *(uint2*)(base + (size_t)(cg0 + k) * stride) = o;
        c0 = dc[k].x * c0 + bf2f((bf16_t)(u[k].x & 0xffff));
        c1 = dc[k].y * c1 + bf2f((bf16_t)(u[k].x >> 16));
        c2 = dc[k].z * c2 + bf2f((bf16_t)(u[k].y & 0xffff));
        c3 = dc[k].w * c3 + bf2f((bf16_t)(u[k].y >> 16));
      }
    }
  }
}

template <int MP>
DEV void attn_pass(const bf16_t* __restrict__ DK, const bf16_t* __restrict__ DVT, int h, int qb, int qrow,
                   bf16_t* Ks, bf16_t* Vs, const bf16_t* Qs, f32x4 (&o)[8], int tid) {
  constexpr int PS = 136, PK = 72;
  const int lane = tid & 63, wave = tid >> 6, lr = lane & 15, lg = lane >> 4;
#pragma unroll
  for (int j = 0; j < 8; j++) o[j] = (f32x4){0.f, 0.f, 0.f, 0.f};
  float mrun = -1e30f, lrun = 0.f;
  const int krow = tid >> 3, kc8 = (tid & 7) * 8;
  const int vrow = tid >> 4, vc8 = (tid & 15) * 8;
  const bf16_t* gk = DK + (size_t)krow * 1024 + h * 128 + MP * 64 + kc8;
  const bf16_t* gv = DVT + (size_t)(h * 128 + vrow) * LT + vc8;
  u32x4 rk0, rk1, rv0, rv1, rv2, rv3;
#define ALOAD(kbn)                                                              \
  rk0 = *(const u32x4*)(gk + (size_t)((kbn) * 128) * 1024);                     \
  rk1 = *(const u32x4*)(gk + (size_t)((kbn) * 128 + 64) * 1024);                \
  rv0 = *(const u32x4*)(gv + (kbn) * 128);                                      \
  rv1 = *(const u32x4*)(gv + (size_t)32 * LT + (kbn) * 128);                    \
  rv2 = *(const u32x4*)(gv + (size_t)64 * LT + (kbn) * 128);                    \
  rv3 = *(const u32x4*)(gv + (size_t)96 * LT + (kbn) * 128);
  ALOAD(0)
  for (int kb = 0; kb <= qb; kb++) {
    __syncthreads();
    *(u32x4*)(Ks + (krow) * PK + kc8) = rk0;
    *(u32x4*)(Ks + (krow + 64) * PK + kc8) = rk1;
    *(u32x4*)(Vs + (vrow) * PS + vc8) = rv0;
    *(u32x4*)(Vs + (vrow + 32) * PS + vc8) = rv1;
    *(u32x4*)(Vs + (vrow + 64) * PS + vc8) = rv2;
    *(u32x4*)(Vs + (vrow + 96) * PS + vc8) = rv3;
    __syncthreads();
    {
      const int kbn = (kb < qb) ? kb + 1 : qb;
      ALOAD(kbn)
    }
    f32x4 s[8];
    {
      const bf16x8 aq0 = ldfrag(Qs, PS, wave * 16 + lr, MP * 64 + lg * 8);
      const bf16x8 aq1 = ldfrag(Qs, PS, wave * 16 + lr, MP * 64 + 32 + lg * 8);
#pragma unroll
      for (int j = 0; j < 8; j++) {
        s[j] = (f32x4){0.f, 0.f, 0.f, 0.f};
        bf16x8 kf0 = *(const bf16x8*)(Ks + (j * 16 + lr) * PK + lg * 8);
        bf16x8 kf1 = *(const bf16x8*)(Ks + (j * 16 + lr) * PK + 32 + lg * 8);
        s[j] = MFMA(kf0, aq0, s[j]);
        s[j] = MFMA(kf1, aq1, s[j]);
      }
    }
    __builtin_amdgcn_sched_barrier(0);
    if (kb == qb || kb == 0) {
#pragma unroll
      for (int j = 0; j < 8; j++)
#pragma unroll
        for (int r = 0; r < 4; r++) {
          const int key = kb * 128 + j * 16 + lg * 4 + r;
          if (key > qrow || key < 112) s[j][r] = -1e30f;
        }
    }
    float mx = -1e30f;
#pragma unroll
    for (int j = 0; j < 8; j++)
#pragma unroll
      for (int r = 0; r < 4; r++) mx = fmaxf(mx, s[j][r]);
    mx = fmaxf(mx, __shfl_xor(mx, 16));
    mx = fmaxf(mx, __shfl_xor(mx, 32));
    const float mnew = fmaxf(mrun, mx);
    const float alpha = ex2(mrun - mnew);
    mrun = mnew;
    float ps = 0.f;
#pragma unroll
    for (int j = 0; j < 8; j++)
#pragma unroll
      for (int r = 0; r < 4; r++) { const float pv = ex2(s[j][r] - mnew); s[j][r] = pv; ps += pv; }
    lrun = lrun * alpha + ps;
    float ao[4];
#pragma unroll
    for (int r = 0; r < 4; r++) ao[r] = __shfl(alpha, lg * 4 + r);
#pragma unroll
    for (int je = 0; je < 8; je++)
#pragma unroll
      for (int r = 0; r < 4; r++) o[je][r] *= ao[r];
#pragma unroll
    for (int ks = 0; ks < 4; ks++) {
      union { u32x4 u; bf16x8 v; } pf;
      pf.u[0] = pack2(s[2 * ks][0], s[2 * ks][1]);
      pf.u[1] = pack2(s[2 * ks][2], s[2 * ks][3]);
      pf.u[2] = pack2(s[2 * ks + 1][0], s[2 * ks + 1][1]);
      pf.u[3] = pack2(s[2 * ks + 1][2], s[2 * ks + 1][3]);
#pragma unroll
      for (int je = 0; je < 8; je++) {
        const bf16_t* vp = Vs + (je * 16 + lr) * PS + ks * 32 + lg * 4;
        union { uint2 u[2]; bf16x8 v; } vf;
        vf.u[0] = *(const uint2*)vp;
        vf.u[1] = *(const uint2*)(vp + 16);
        o[je] = MFMA(pf.v, vf.v, o[je]);
      }
    }
    __builtin_amdgcn_sched_barrier(0);
  }
#undef ALOAD
  float l = lrun;
  l += __shfl_xor(l, 16);
  l += __shfl_xor(l, 32);
  const float inv = l > 0.f ? 1.f / l : 0.f;
#pragma unroll
  for (int r = 0; r < 4; r++) {
    const float ir = __shfl(inv, lg * 4 + r);
#pragma unroll
    for (int je = 0; je < 8; je++) o[je][r] *= ir;
  }
}

DEV void attn_item(const Params& p, int layer, int h, int qb, float lam, bf16_t* lds) {
  unsigned char* ws = p.ws;
  const bf16_t* DQ = (const bf16_t*)(ws + OFF_DQ);
  bf16_t* ODA = (bf16_t*)(ws + OFF_ODA);
  const bf16_t* DK = (const bf16_t*)(ws + OFF_DK);
  const bf16_t* DVT = (const bf16_t*)(ws + OFF_DVT);
  constexpr int PS = 136;
  bf16_t* Ks = lds;
  bf16_t* Vs = lds + 128 * PS;
  bf16_t* Qs = lds + 2 * 128 * PS;
  const int tid = get_tid(), lane = tid & 63, wave = tid >> 6;
  const int lr = lane & 15, lg = lane >> 4;
  const int t0 = qb * 128;
  const int qrow = t0 + wave * 16 + lr;
  {
    const int qr = tid >> 4, qc = (tid & 15) * 8;
#pragma unroll
    for (int i = 0; i < 4; i++)
      *(u32x4*)(Qs + (qr + i * 32) * PS + qc) = *(const u32x4*)(DQ + (size_t)(t0 + qr + i * 32) * 1024 + h * 128 + qc);
  }
  f32x4 o0[8], o1[8];
  attn_pass<0>(DK, DVT, h, qb, qrow, Ks, Vs, Qs, o0, tid);
  attn_pass<1>(DK, DVT, h, qb, qrow, Ks, Vs, Qs, o1, tid);
  int ly = layer; asm volatile("" : "+s"(ly));
  const float li = (ly == 0) ? 0.2f : 0.35550906759f;
  const float* sg = p.in[8] + ly * 128;
  float ss[4] = {0.f, 0.f, 0.f, 0.f};
#pragma unroll
  for (int je = 0; je < 8; je++)
#pragma unroll
    for (int r = 0; r < 4; r++) {
      const float v = o0[je][r] - lam * o1[je][r];
      o0[je][r] = v; ss[r] += v * v;
    }
#pragma unroll
  for (int r = 0; r < 4; r++) {
    float s2 = ss[r];
    s2 += __shfl_xor(s2, 1); s2 += __shfl_xor(s2, 2); s2 += __shfl_xor(s2, 4); s2 += __shfl_xor(s2, 8);
    ss[r] = rsqrtf(s2 * (1.f / 128.f) + 1e-6f) * (1.f - li);
  }
#pragma unroll
  for (int je = 0; je < 8; je++) {
    const float g = sg[je * 16 + lr];
#pragma unroll
    for (int r = 0; r < 4; r++)
      ODA[(size_t)(t0 + wave * 16 + lg * 4 + r) * 1024 + h * 128 + je * 16 + lr] = f2bf(o0[je][r] * ss[r] * g);
  }
}

DEV void ret_item(const Params& p, int h, int c, bf16_t* lds) {
  unsigned char* ws = p.ws;
  const bf16_t* RQ = (const bf16_t*)(ws + OFF_RQ);
  const bf16_t* RK = (const bf16_t*)(ws + OFF_RK);
  const bf16_t* RVT = (const bf16_t*)(ws + OFF_RVT);
  const bf16_t* STR = (const bf16_t*)(ws + OFF_STR);
  bf16_t* ORET = (bf16_t*)(ws + OFF_ORET);
  constexpr int PS = 136;
  bf16_t* Qs = lds;
  bf16_t* Ks = lds + 128 * PS;
  bf16_t* Big = lds + 2 * 128 * PS;
  float* RED = (float*)(lds + 2 * 128 * PS + 256 * PS);
  const int tid = get_tid(), lane = tid & 63, wave = tid >> 6, wm = wave >> 1, wn = wave & 1;
  const int lr = lane & 15, lg = lane >> 4;
  const int t0 = c * 128;
  const int lrow = tid >> 4, lc8 = (tid & 15) * 8;
  const float l2g = log2f(1.f - ex2(-5.f - (float)h));
#pragma unroll
  for (int i = 0; i < 4; i++) {
    const int row = lrow + i * 32;
    *(uint4*)(Qs + row * PS + lc8) = *(const uint4*)(RQ + (size_t)(t0 + row) * 512 + h * 128 + lc8);
    *(uint4*)(Ks + row * PS + lc8) = *(const uint4*)(RK + (size_t)(t0 + row) * 512 + h * 128 + lc8);
  }
#pragma unroll
  for (int i = 0; i < 8; i++) {
    const int row = lrow + i * 32;
    *(uint4*)(Big + row * PS + lc8) = *(const uint4*)(STR + ((size_t)(h * 65 + c) * 256 + row) * 128 + lc8);
  }
  __syncthreads();
  f32x4 s[2][4];
  f32x4 o[2][8];
#pragma unroll
  for (int i = 0; i < 2; i++) {
#pragma unroll
    for (int j = 0; j < 4; j++) s[i][j] = (f32x4){0.f, 0.f, 0.f, 0.f};
#pragma unroll
    for (int j = 0; j < 8; j++) o[i][j] = (f32x4){0.f, 0.f, 0.f, 0.f};
  }
#pragma unroll
  for (int ks = 0; ks < 4; ks++) {
    bf16x8 a0 = ldfrag(Qs, PS, wm * 32 + lr, ks * 32 + lg * 8);
    bf16x8 a1 = ldfrag(Qs, PS, wm * 32 + 16 + lr, ks * 32 + lg * 8);
#pragma unroll
    for (int j = 0; j < 4; j++) {
      bf16x8 bb = ldfrag(Ks, PS, wn * 64 + j * 16 + lr, ks * 32 + lg * 8);
      s[0][j] = MFMA(bb, a0, s[0][j]);
      s[1][j] = MFMA(bb, a1, s[1][j]);
    }
#pragma unroll
    for (int j = 0; j < 8; j++) {
      bf16x8 bb = ldfrag(Big, PS, wn * 128 + j * 16 + lr, ks * 32 + lg * 8);
      o[0][j] = MFMA(bb, a0, o[0][j]);
      o[1][j] = MFMA(bb, a1, o[1][j]);
    }
    __builtin_amdgcn_sched_barrier(0);
  }
#pragma unroll
  for (int i = 0; i < 2; i++) {
    const int q = wm * 32 + i * 16 + lr;
    const float qd = ex2(l2g * (float)(q + 1));
#pragma unroll
    for (int j = 0; j < 8; j++)
#pragma unroll
      for (int r = 0; r < 4; r++) o[i][j][r] *= qd;
  }
  __syncthreads();
#pragma unroll
  for (int i = 0; i < 2; i++) {
    const int q = wm * 32 + i * 16 + lr;
#pragma unroll
    for (int j = 0; j < 4; j++) {
      f32x4 v;
#pragma unroll
      for (int r = 0; r < 4; r++) {
        const int key = wn * 64 + j * 16 + lg * 4 + r;
        v[r] = (key <= q) ? s[i][j][r] * ex2(l2g * (float)(q - key)) : 0.f;
      }
      *(uint2*)(Ks + q * PS + wn * 64 + j * 16 + lg * 4) = pack4(v);
    }
  }
#pragma unroll
  for (int i = 0; i < 8; i++) {
    const int row = lrow + i * 32;
    *(uint4*)(Big + row * PS + lc8) = *(const uint4*)(RVT + (size_t)(h * 256 + row) * LT + t0 + lc8);
  }
  __syncthreads();
#pragma unroll
  for (int ks = 0; ks < 4; ks++) {
    bf16x8 a0 = ldfrag(Ks, PS, wm * 32 + lr, ks * 32 + lg * 8);
    bf16x8 a1 = ldfrag(Ks, PS, wm * 32 + 16 + lr, ks * 32 + lg * 8);
#pragma unroll
    for (int j = 0; j < 8; j++) {
      bf16x8 bb = ldfrag(Big, PS, wn * 128 + j * 16 + lr, ks * 32 + lg * 8);
      o[0][j] = MFMA(bb, a0, o[0][j]);
      o[1][j] = MFMA(bb, a1, o[1][j]);
    }
    __builtin_amdgcn_sched_barrier(0);
  }
#pragma unroll
  for (int i = 0; i < 2; i++) {
    float ss = 0.f;
#pragma unroll
    for (int j = 0; j < 8; j++)
#pragma unroll
      for (int r = 0; r < 4; r++) ss += o[i][j][r] * o[i][j][r];
    ss += __shfl_xor(ss, 16);
    ss += __shfl_xor(ss, 32);
    if (lg == 0) RED[(wm * 32 + i * 16 + lr) * 2 + wn] = ss;
  }
  __syncthreads();
#pragma unroll
  for (int i = 0; i < 2; i++) {
    const int q = wm * 32 + i * 16 + lr;
    const float rs = rsqrtf((RED[q * 2] + RED[q * 2 + 1]) * (1.f / 256.f) + 1e-6f);
#pragma unroll
    for (int j = 0; j < 8; j++) {
      f32x4 v = o[i][j];
#pragma unroll
      for (int r = 0; r < 4; r++) v[r] *= rs;
      *(uint2*)(ORET + (size_t)(t0 + q) * 1024 + h * 256 + wn * 128 + j * 16 + lg * 4) = pack4(v);
    }
  }
}

DEV void hg_item(const Params& p, int h, int c, bf16_t* lds) {
  unsigned char* ws = p.ws;
  const bf16_t* HQ = (const bf16_t*)(ws + OFF_HQ);
  const bf16_t* HK = (const bf16_t*)(ws + OFF_HK);
  const float* HCB = (const float*)(ws + OFF_HCB);
  const bf16_t* HVT = (const bf16_t*)(ws + OFF_HVT);
  const bf16_t* STH = (const bf16_t*)(ws + OFF_STH);
  bf16_t* OHG = (bf16_t*)(ws + OFF_OHG);
  constexpr int PS = 136;
  bf16_t* Qp = lds;
  bf16_t* Kp = lds + 128 * PS;
  bf16_t* As = lds + 2 * 128 * PS;
  float* RED = (float*)(lds + 2 * 128 * PS + 256 * PS);
  const int tid = get_tid(), lane = tid & 63, wave = tid >> 6, wm = wave >> 1, wn = wave & 1;
  const int lr = lane & 15, lg = lane >> 4;
  const int t0 = c * 128, colb = h * 128;
  const int lrow = tid >> 4, lc8 = (tid & 15) * 8;
#pragma unroll
  for (int i = 0; i < 4; i++) {
    const int row = lrow + i * 32;
    const size_t g = (size_t)(t0 + row) * 1024 + colb + lc8;
    uint4 qv = *(const uint4*)(HQ + g);
    float4 c0 = *(const float4*)(HCB + g), c1 = *(const float4*)(HCB + g + 4);
    float4 r0 = make_float4(0.f, 0.f, 0.f, 0.f), r1 = r0;
    if (row >= 32) {
      const size_t gr = (size_t)(t0 + (row & ~31) - 1) * 1024 + colb + lc8;
      r0 = *(const float4*)(HCB + gr); r1 = *(const float4*)(HCB + gr + 4);
    }
    uint4 ov;
    ov.x = pack2(bf2f((bf16_t)(qv.x & 0xffff)) * __expf(c0.x - r0.x), bf2f((bf16_t)(qv.x >> 16)) * __expf(c0.y - r0.y));
    ov.y = pack2(bf2f((bf16_t)(qv.y & 0xffff)) * __expf(c0.z - r0.z), bf2f((bf16_t)(qv.y >> 16)) * __expf(c0.w - r0.w));
    ov.z = pack2(bf2f((bf16_t)(qv.z & 0xffff)) * __expf(c1.x - r1.x), bf2f((bf16_t)(qv.z >> 16)) * __expf(c1.y - r1.y));
    ov.w = pack2(bf2f((bf16_t)(qv.w & 0xffff)) * __expf(c1.z - r1.z), bf2f((bf16_t)(qv.w >> 16)) * __expf(c1.w - r1.w));
    *(uint4*)(Qp + row * PS + lc8) = ov;
  }
  for (int I = 0; I < 4; I++) {
    const int nrows = 32 * (I + 1);
    float4 r0 = make_float4(0.f, 0.f, 0.f, 0.f), r1 = r0;
    if (I > 0) {
      const size_t gr = (size_t)(t0 + 32 * I - 1) * 1024 + colb + lc8;
      r0 = *(const float4*)(HCB + gr); r1 = *(const float4*)(HCB + gr + 4);
    }
#pragma unroll
    for (int i = 0; i < 4; i++) {
      const int row = lrow + i * 32;
      if (row < nrows) {
        const size_t g = (size_t)(t0 + row) * 1024 + colb + lc8;
        uint4 kv = *(const uint4*)(HK + g);
        float4 c0 = *(const float4*)(HCB + g), c1 = *(const float4*)(HCB + g + 4);
        uint4 ov;
        ov.x = pack2(bf2f((bf16_t)(kv.x & 0xffff)) * __expf(fminf(r0.x - c0.x, 80.f)), bf2f((bf16_t)(kv.x >> 16)) * __expf(fminf(r0.y - c0.y, 80.f)));
        ov.y = pack2(bf2f((bf16_t)(kv.y & 0xffff)) * __expf(fminf(r0.z - c0.z, 80.f)), bf2f((bf16_t)(kv.y >> 16)) * __expf(fminf(r0.w - c0.w, 80.f)));
        ov.z = pack2(bf2f((bf16_t)(kv.z & 0xffff)) * __expf(fminf(r1.x - c1.x, 80.f)), bf2f((bf16_t)(kv.z >> 16)) * __expf(fminf(r1.y - c1.y, 80.f)));
        ov.w = pack2(bf2f((bf16_t)(kv.w & 0xffff)) * __expf(fminf(r1.z - c1.z, 80.f)), bf2f((bf16_t)(kv.w >> 16)) * __expf(fminf(r1.w - c1.w, 80.f)));
        *(uint4*)(Kp + row * PS + lc8) = ov;
      }
    }
    __syncthreads();
    if (wave * 16 < nrows) {
      f32x4 a2[2];
      a2[0] = (f32x4){0.f, 0.f, 0.f, 0.f}; a2[1] = a2[0];
#pragma unroll
      for (int ks = 0; ks < 4; ks++) {
        bf16x8 bb = ldfrag(Kp, PS, wave * 16 + lr, ks * 32 + lg * 8);
        bf16x8 a0 = ldfrag(Qp, PS, 32 * I + lr, ks * 32 + lg * 8);
        bf16x8 a1 = ldfrag(Qp, PS, 32 * I + 16 + lr, ks * 32 + lg * 8);
        a2[0] = MFMA(bb, a0, a2[0]);
        a2[1] = MFMA(bb, a1, a2[1]);
      }
#pragma unroll
      for (int i = 0; i < 2; i++) {
        const int q = 32 * I + i * 16 + lr;
        f32x4 v;
#pragma unroll
        for (int r = 0; r < 4; r++) { const int key = wave * 16 + lg * 4 + r; v[r] = (key <= q) ? a2[i][r] : 0.f; }
        *(uint2*)(As + q * PS + wave * 16 + lg * 4) = pack4(v);
      }
    } else {
#pragma unroll
      for (int i = 0; i < 2; i++) {
        const int q = 32 * I + i * 16 + lr;
        *(uint2*)(As + q * PS + wave * 16 + lg * 4) = make_uint2(0u, 0u);
      }
    }
    __syncthreads();
  }
#pragma unroll
  for (int i = 0; i < 4; i++) {
    const int row = lrow + i * 32;
    *(uint4*)(Kp + row * PS + lc8) = *(const uint4*)(HVT + (size_t)(colb + row) * LT + t0 + lc8);
  }
  __syncthreads();
  f32x4 o[2][4];
#pragma unroll
  for (int i = 0; i < 2; i++)
#pragma unroll
    for (int j = 0; j < 4; j++) o[i][j] = (f32x4){0.f, 0.f, 0.f, 0.f};
#pragma unroll
  for (int ks = 0; ks < 4; ks++) {
    bf16x8 a0 = ldfrag(As, PS, wm * 32 + lr, ks * 32 + lg * 8);
    bf16x8 a1 = ldfrag(As, PS, wm * 32 + 16 + lr, ks * 32 + lg * 8);
#pragma unroll
    for (int j = 0; j < 4; j++) {
      bf16x8 bb = ldfrag(Kp, PS, wn * 64 + j * 16 + lr, ks * 32 + lg * 8);
      o[0][j] = MFMA(bb, a0, o[0][j]);
      o[1][j] = MFMA(bb, a1, o[1][j]);
    }
    __builtin_amdgcn_sched_barrier(0);
  }
  __syncthreads();
#pragma unroll
  for (int i = 0; i < 4; i++) {
    const int row = lrow + i * 32;
    const size_t g = (size_t)(t0 + row) * 1024 + colb + lc8;
    uint4 qv = *(const uint4*)(HQ + g);
    float4 c0 = *(const float4*)(HCB + g), c1 = *(const float4*)(HCB + g + 4);
    uint4 ov;
    ov.x = pack2(bf2f((bf16_t)(qv.x & 0xffff)) * __expf(c0.x), bf2f((bf16_t)(qv.x >> 16)) * __expf(c0.y));
    ov.y = pack2(bf2f((bf16_t)(qv.y & 0xffff)) * __expf(c0.z), bf2f((bf16_t)(qv.y >> 16)) * __expf(c0.w));
    ov.z = pack2(bf2f((bf16_t)(qv.z & 0xffff)) * __expf(c1.x), bf2f((bf16_t)(qv.z >> 16)) * __expf(c1.y));
    ov.w = pack2(bf2f((bf16_t)(qv.w & 0xffff)) * __expf(c1.z), bf2f((bf16_t)(qv.w >> 16)) * __expf(c1.w));
    *(uint4*)(Qp + row * PS + lc8) = ov;
    *(uint4*)(Kp + row * PS + lc8) = *(const uint4*)(STH + ((size_t)(h * 65 + c) * 128 + row) * 128 + lc8);
  }
  __syncthreads();
#pragma unroll
  for (int ks = 0; ks < 4; ks++) {
    bf16x8 a0 = ldfrag(Qp, PS, wm * 32 + lr, ks * 32 + lg * 8);
    bf16x8 a1 = ldfrag(Qp, PS, wm * 32 + 16 + lr, ks * 32 + lg * 8);
#pragma unroll
    for (int j = 0; j < 4; j++) {
      bf16x8 bb = ldfrag(Kp, PS, wn * 64 + j * 16 + lr, ks * 32 + lg * 8);
      o[0][j] = MFMA(bb, a0, o[0][j]);
      o[1][j] = MFMA(bb, a1, o[1][j]);
    }
    __builtin_amdgcn_sched_barrier(0);
  }
#pragma unroll
  for (int i = 0; i < 2; i++) {
    float ss = 0.f;
#pragma unroll
    for (int j = 0; j < 4; j++)
#pragma unroll
      for (int r = 0; r < 4; r++) ss += o[i][j][r] * o[i][j][r];
    ss += __shfl_xor(ss, 16);
    ss += __shfl_xor(ss, 32);
    if (lg == 0) RED[(wm * 32 + i * 16 + lr) * 2 + wn] = ss;
  }
  __syncthreads();
#pragma unroll
  for (int i = 0; i < 2; i++) {
    const int q = wm * 32 + i * 16 + lr;
    const float rs = rsqrtf((RED[q * 2] + RED[q * 2 + 1]) * (1.f / 128.f) + 1e-6f);
#pragma unroll
    for (int j = 0; j < 4; j++) {
      f32x4 v = o[i][j];
#pragma unroll
      for (int r = 0; r < 4; r++) v[r] *= rs;
      *(uint2*)(OHG + (size_t)(t0 + q) * 1024 + colb + wn * 64 + j * 16 + lg * 4) = pack4(v);
    }
  }
}

DEV void phase_O(const Params& p, int layer, int qidx, unsigned char* ldsraw) {
  bf16_t* lds = (bf16_t*)ldsraw;
  int* ctr = (int*)(p.ws + OFF_CTR) + qidx;
  int* sitem = (int*)(ldsraw + LDS_BYTES - 16);
  const float* lp = p.in[7] + layer * 256;
  float d0 = 0.f, d1 = 0.f;
  for (int i = 0; i < 64; i++) { d0 += lp[i] * lp[64 + i]; d1 += lp[128 + i] * lp[192 + i]; }
  int ly = layer; asm volatile("" : "+s"(ly));
  const float li = (ly == 0) ? 0.2f : 0.35550906759f;
  const float lam = __uint_as_float(__builtin_amdgcn_readfirstlane(__float_as_uint(__expf(d0) - __expf(d1) + li)));
  const int tid0 = get_tid();
  for (;;) {
    __syncthreads();
    if (tid0 == 0) *sitem = atomicAdd(ctr, 1);
    __syncthreads();
    const int item = __builtin_amdgcn_readfirstlane(*sitem);
    if (item >= 1300) break;
    if (item < 520) attn_item(p, layer, item & 7, 64 - (item >> 3), lam, lds);
    else if (item < 780) ret_item(p, (item - 520) & 3, (item - 520) >> 2, lds);
    else hg_item(p, (item - 780) & 7, (item - 780) >> 3, lds);
  }
}

DEV void phase_G(const Params& p, unsigned char* ldsraw) {
  unsigned char* ws = p.ws;
  bf16_t* lds = (bf16_t*)ldsraw;
  const bf16_t* HN = (const bf16_t*)(ws + OFF_HN);
  const bf16_t* WIN = (const bf16_t*)(ws + OFF_WIN);
  for (int item = get_bid(); item < 65 * 20; item += gridDim.x) {
    const int nt = item / 65, mt = item - nt * 65;
    int n0, cb; bf16_t* dst; int ld; bool gate;
    if (nt < 4) { n0 = 2048 + nt * 256; cb = nt * 256; dst = (bf16_t*)(ws + OFF_ORET); ld = 1024; gate = true; }
    else if (nt < 8) { n0 = 6144 + (nt - 4) * 256; cb = (nt - 4) * 256; dst = (bf16_t*)(ws + OFF_OHG); ld = 1024; gate = true; }
    else { n0 = 10240 + (nt - 8) * 256; cb = (nt - 8) * 256; dst = (bf16_t*)(ws + OFF_G); ld = 3072; gate = false; }
    f32x4 acc[2][8];
#pragma unroll
    for (int i = 0; i < 2; i++)
#pragma unroll
      for (int j = 0; j < 8; j++) acc[i][j] = (f32x4){0.f, 0.f, 0.f, 0.f};
    gemm_acc<256, false>(acc, HN + (size_t)mt * 128 * 1024, 1024, WIN + (size_t)n0 * 1024, 1024, 1024, lds);
      const int tid = get_tid(), lane = tid & 63, wave = tid >> 6, wm = wave >> 1, wn = wave & 1; const int lr = lane & 15, lg = lane >> 4; (void)tid; (void)lane; (void)wm; (void)wn; (void)lr; (void)lg;
#pragma unroll
    for (int i = 0; i < 2; i++) {
      const int t = mt * 128 + wm * 32 + i * 16 + lr;
#pragma unroll
      for (int j = 0; j < 8; j++) {
        bf16_t* d = dst + (size_t)t * ld + cb + wn * 128 + j * 16 + lg * 4;
        f32x4 v;
        if (gate) {
          uint2 ov = *(const uint2*)d;
          v[0] = bf2f((bf16_t)(ov.x & 0xffff)) * silu_f(acc[i][j][0]);
          v[1] = bf2f((bf16_t)(ov.x >> 16)) * silu_f(acc[i][j][1]);
          v[2] = bf2f((bf16_t)(ov.y & 0xffff)) * silu_f(acc[i][j][2]);
          v[3] = bf2f((bf16_t)(ov.y >> 16)) * silu_f(acc[i][j][3]);
        } else {
#pragma unroll
          for (int r = 0; r < 4; r++) v[r] = sigmoid_f(acc[i][j][r]);
        }
        *(uint2*)d = pack4(v);
      }
    }
  }
}

DEV void phase_Y(const Params& p, unsigned char* ldsraw) {
  unsigned char* ws = p.ws;
  bf16_t* lds = (bf16_t*)ldsraw;
  const bf16_t* WB = (const bf16_t*)(ws + OFF_WB);
  const bf16_t* G = (const bf16_t*)(ws + OFF_G);
  bf16_t* Y = (bf16_t*)(ws + OFF_Y);
  for (int item = get_bid(); item < 65 * 8; item += gridDim.x) {
    const int nt = item / 65, mt = item - nt * 65;
    f32x4 y[2][4];
#pragma unroll
    for (int i = 0; i < 2; i++)
#pragma unroll
      for (int j = 0; j < 4; j++) y[i][j] = (f32x4){0.f, 0.f, 0.f, 0.f};
#pragma unroll 1
    for (int br = 0; br < 3; br++) {
      const bf16_t* Ab = (const bf16_t*)(ws + (br == 0 ? OFF_ORET : (br == 1 ? OFF_OHG : OFF_ODA))) + (size_t)mt * 128 * 1024;
      f32x4 acc[2][4];
#pragma unroll
      for (int i = 0; i < 2; i++)
#pragma unroll
        for (int j = 0; j < 4; j++) acc[i][j] = (f32x4){0.f, 0.f, 0.f, 0.f};
      gemm_acc<128, false>(acc, Ab, 1024, WB + ((size_t)br * 1024 + nt * 128) * 1024, 1024, 1024, lds);
      const int tid = get_tid(), lane = tid & 63, wave = tid >> 6, wm = wave >> 1, wn = wave & 1; const int lr = lane & 15, lg = lane >> 4; (void)tid; (void)lane; (void)wm; (void)wn; (void)lr; (void)lg;
#pragma unroll
      for (int i = 0; i < 2; i++) {
        const int t = mt * 128 + wm * 32 + i * 16 + lr;
#pragma unroll
        for (int j = 0; j < 4; j++) {
          uint2 gv = *(const uint2*)(G + (size_t)t * 3072 + br * 1024 + nt * 128 + wn * 64 + j * 16 + lg * 4);
          y[i][j][0] += bf2f((bf16_t)(gv.x & 0xffff)) * acc[i][j][0];
          y[i][j][1] += bf2f((bf16_t)(gv.x >> 16)) * acc[i][j][1];
          y[i][j][2] += bf2f((bf16_t)(gv.y & 0xffff)) * acc[i][j][2];
          y[i][j][3] += bf2f((bf16_t)(gv.y >> 16)) * acc[i][j][3];
        }
      }
    }
    const int tid = get_tid(), lane = tid & 63, wave = tid >> 6, wm = wave >> 1, wn = wave & 1; const int lr = lane & 15, lg = lane >> 4;
#pragma unroll
    for (int i = 0; i < 2; i++) {
      const int t = mt * 128 + wm * 32 + i * 16 + lr;
#pragma unroll
      for (int j = 0; j < 4; j++)
        *(uint2*)(Y + (size_t)t * 1024 + nt * 128 + wn * 64 + j * 16 + lg * 4) = pack4(y[i][j]);
    }
  }
}

DEV void phase_resid(const Params& p, int b, const bf16_t* A, int K, const bf16_t* Wt, unsigned char* ldsraw) {
  bf16_t* lds = (bf16_t*)ldsraw;
  for (int item = get_bid(); item < 65 * 8; item += gridDim.x) {
    const int nt = item / 65, mt = item - nt * 65;
    f32x4 acc[2][4];
#pragma unroll
    for (int i = 0; i < 2; i++)
#pragma unroll
      for (int j = 0; j < 4; j++) acc[i][j] = (f32x4){0.f, 0.f, 0.f, 0.f};
    gemm_acc<128, false>(acc, A + (size_t)mt * 128 * K, K, Wt + (size_t)nt * 128 * K, K, K, lds);
      const int tid = get_tid(), lane = tid & 63, wave = tid >> 6, wm = wave >> 1, wn = wave & 1; const int lr = lane & 15, lg = lane >> 4; (void)tid; (void)lane; (void)wm; (void)wn; (void)lr; (void)lg;
#pragma unroll
    for (int i = 0; i < 2; i++) {
      const int t = mt * 128 + wm * 32 + i * 16 + lr;
#pragma unroll
      for (int j = 0; j < 4; j++) {
        float4* d = (float4*)(hrow(p, b, t) + nt * 128 + wn * 64 + j * 16 + lg * 4);
        float4 v = *d;
        v.x += acc[i][j][0]; v.y += acc[i][j][1]; v.z += acc[i][j][2]; v.w += acc[i][j][3];
        *d = v;
      }
    }
  }
}

DEV void phase_F1(const Params& p, unsigned char* ldsraw) {
  unsigned char* ws = p.ws;
  bf16_t* lds = (bf16_t*)ldsraw;
  const bf16_t* HN = (const bf16_t*)(ws + OFF_HN);
  const bf16_t* WFI = (const bf16_t*)(ws + OFF_WFI);
  bf16_t* U = (bf16_t*)(ws + OFF_U);
  for (int item = get_bid(); item < 65 * 22; item += gridDim.x) {
    const int nt = item / 65, mt = item - nt * 65;
    f32x4 acc[2][8];
#pragma unroll
    for (int i = 0; i < 2; i++)
#pragma unroll
      for (int j = 0; j < 8; j++) acc[i][j] = (f32x4){0.f, 0.f, 0.f, 0.f};
    gemm_acc<256, false>(acc, HN + (size_t)mt * 128 * 1024, 1024, WFI + (size_t)nt * 256 * 1024, 1024, 1024, lds);
      const int tid = get_tid(), lane = tid & 63, wave = tid >> 6, wm = wave >> 1, wn = wave & 1; const int lr = lane & 15, lg = lane >> 4; (void)tid; (void)lane; (void)wm; (void)wn; (void)lr; (void)lg;
#pragma unroll
    for (int i = 0; i < 2; i++) {
      const int t = mt * 128 + wm * 32 + i * 16 + lr;
      const float vm = (t >= 112) ? 1.f : 0.f;
#pragma unroll
      for (int j = 0; j < 8; j++) {
        f32x4 v = acc[i][j];
#pragma unroll
        for (int r = 0; r < 4; r++) v[r] *= vm;
        *(uint2*)(U + (size_t)t * 5632 + nt * 256 + wn * 128 + j * 16 + lg * 4) = pack4(v);
      }
    }
  }
}

DEV void phase_conv(const Params& p, int layer) {
  unsigned char* ws = p.ws;
  const bf16_t* U = (const bf16_t*)(ws + OFF_U);
  bf16_t* GF = (bf16_t*)(ws + OFF_GF);
  const float* cw = p.in[11] + (size_t)layer * 3 * 5632;
  const float* cbias = p.in[12] + (size_t)layer * 5632;
  for (int idx = get_bid() * NTHR + get_tid(); idx < LT * 352; idx += gridDim.x * NTHR) {
    const int t = idx / 352, c8 = (idx - t * 352) * 8;
    float g[8], v[8];
#pragma unroll
    for (int k = 0; k < 8; k++) { g[k] = cbias[c8 + k]; v[k] = cbias[2816 + c8 + k]; }
#pragma unroll
    for (int j = 0; j < 3; j++) {
      const int tt = t - 2 + j;
      if (tt >= 0) {
        uint4 ug = *(const uint4*)(U + (size_t)tt * 5632 + c8);
        uint4 uv = *(const uint4*)(U + (size_t)tt * 5632 + 2816 + c8);
        const float* wg = cw + j * 5632 + c8;
        const float* wv = cw + j * 5632 + 2816 + c8;
        const unsigned ugs[4] = {ug.x, ug.y, ug.z, ug.w};
        const unsigned uvs[4] = {uv.x, uv.y, uv.z, uv.w};
#pragma unroll
        for (int k = 0; k < 4; k++) {
          g[2 * k] += wg[2 * k] * bf2f((bf16_t)(ugs[k] & 0xffff));
          g[2 * k + 1] += wg[2 * k + 1] * bf2f((bf16_t)(ugs[k] >> 16));
          v[2 * k] += wv[2 * k] * bf2f((bf16_t)(uvs[k] & 0xffff));
          v[2 * k + 1] += wv[2 * k + 1] * bf2f((bf16_t)(uvs[k] >> 16));
        }
      }
    }
    uint4 o;
    o.x = pack2(silu_f(g[0]) * v[0], silu_f(g[1]) * v[1]);
    o.y = pack2(silu_f(g[2]) * v[2], silu_f(g[3]) * v[3]);
    o.z = pack2(silu_f(g[4]) * v[4], silu_f(g[5]) * v[5]);
    o.w = pack2(silu_f(g[6]) * v[6], silu_f(g[7]) * v[7]);
    *(uint4*)(GF + (size_t)t * 2816 + c8) = o;
  }
}

__global__ void __launch_bounds__(NTHR) fwd_megakernel(Params p) {
  extern __shared__ __attribute__((aligned(16))) unsigned char lds[];
  cg::grid_group grid = cg::this_grid();
  unsigned bar_target = 0;
  unsigned* bar_word = (unsigned*)(p.ws + OFF_CTR) + 32;
#define GRID_SYNC() do { \
    asm volatile("s_waitcnt vmcnt(0) lgkmcnt(0)" ::: "memory"); \
    __syncthreads(); \
    bar_target += gridDim.x; \
    if (threadIdx.x == 0) { \
      __builtin_amdgcn_fence(__ATOMIC_RELEASE, "agent"); \
      asm volatile("s_waitcnt vmcnt(0)" ::: "memory"); \
      __hip_atomic_fetch_add(bar_word, 1u, __ATOMIC_RELAXED, __HIP_MEMORY_SCOPE_AGENT); \
      while (__hip_atomic_load(bar_word, __ATOMIC_RELAXED, __HIP_MEMORY_SCOPE_AGENT) < bar_target) __builtin_amdgcn_s_sleep(1); \
      __builtin_amdgcn_fence(__ATOMIC_ACQUIRE, "agent"); \
      asm volatile("s_waitcnt vmcnt(0)" ::: "memory"); \
    } \
    __syncthreads(); \
  } while (0)
  grid.sync();
  unsigned char* ws = p.ws;
  phase_init(p);
  phase_convert(p, 0, lds);
  GRID_SYNC();
  for (int layer = 0; layer < 2; layer++) {
    if (layer == 1) { phase_convert(p, 1, lds); GRID_SYNC(); }
    for (int b = 0; b < 2; b++) {
      phase_norm(p, b, p.in[2] + layer * 1024, (bf16_t*)(ws + OFF_HN));
      GRID_SYNC();
      phase_projA(p, layer, lds);
      GRID_SYNC();
      phase_U(p, lds);
      GRID_SYNC();
      phase_scan(p);
      GRID_SYNC();
      phase_O(p, layer, layer * 2 + b, lds);
      GRID_SYNC();
      phase_G(p, lds);
      GRID_SYNC();
      phase_Y(p, lds);
      GRID_SYNC();
      phase_resid(p, b, (const bf16_t*)(ws + OFF_Y), 1024, (const bf16_t*)(ws + OFF_WO), lds);
      GRID_SYNC();
      phase_norm(p, b, p.in[9] + layer * 1024, (bf16_t*)(ws + OFF_HN));
      GRID_SYNC();
      phase_F1(p, lds);
      GRID_SYNC();
      phase_conv(p, layer);
      GRID_SYNC();
      phase_resid(p, b, (const bf16_t*)(ws + OFF_GF), DFF, (const bf16_t*)(ws + OFF_WFO), lds);
      GRID_SYNC();
    }
  }
  phase_final(p);
}

extern "C" void kernel_launch(void* const* d_in, const int* in_sizes, int n_in, void* d_out, int out_size,
                              void* d_ws, size_t ws_size, hipStream_t stream) {
  static int grid_blocks = 0;
  if (grid_blocks == 0) {
    if (n_in != 15 || ws_size < OFF_END) {
      fprintf(stderr, "kernel_launch: need 15 inputs and %zu bytes of workspace, got %d and %zu\n", (size_t)OFF_END, n_in, ws_size);
      grid_blocks = -1; return;
    }
    int dev = 0, cus = 0, per_cu = 0;
    hipGetDevice(&dev);
    hipDeviceGetAttribute(&cus, hipDeviceAttributeMultiprocessorCount, dev);
    if (hipFuncSetAttribute((const void*)fwd_megakernel, hipFuncAttributeMaxDynamicSharedMemorySize, LDS_BYTES) != hipSuccess) {
      fprintf(stderr, "kernel_launch: hipFuncSetAttribute failed\n"); grid_blocks = -1; return;
    }
    hipOccupancyMaxActiveBlocksPerMultiprocessor(&per_cu, (const void*)fwd_megakernel, NTHR, LDS_BYTES);
    if (per_cu < 1) per_cu = 1;
    if (per_cu > 1) per_cu = 1;
    grid_blocks = cus * per_cu;
  }
  if (grid_blocks < 0) return;
  hipMemsetAsync((char*)d_ws + OFF_CTR, 0, 256, stream);
  Params p{};
  for (int i = 0; i < 15; i++) p.in[i] = (const float*)d_in[i];
  p.out = (float*)d_out;
  p.ws = (unsigned char*)d_ws;
  void* args[] = {&p};
  hipError_t e = hipLaunchCooperativeKernel((const void*)fwd_megakernel, dim3(grid_blocks), dim3(NTHR), args, LDS_BYTES, stream);
  if (e != hipSuccess) fprintf(stderr, "cooperative launch failed: %s (grid %d)\n", hipGetErrorString(e), grid_blocks);
}
```

```cpp
#include <hip/hip_runtime.h>
#include <hip/hip_cooperative_groups.h>
#include <cstdio>
#include <cstdint>
namespace cg = cooperative_groups;

typedef unsigned short bf16_t;
typedef __attribute__((ext_vector_type(8))) short bf16x8;
typedef __attribute__((ext_vector_type(4))) short bf16x4;
typedef __attribute__((ext_vector_type(4))) float f32x4;
typedef __attribute__((ext_vector_type(4))) unsigned u32x4;

#define DEV __device__ __forceinline__
#define MFMA(a, b, c) __builtin_amdgcn_mfma_f32_16x16x32_bf16(a, b, c, 0, 0, 0)

constexpr int LT = 8320;
constexpr int NCH = 65;
constexpr int NTHR = 512;
constexpr int LDS_BYTES = 144 * 1024;
constexpr int INW = 13312;
constexpr int DFF = 2816;

constexpr size_t SZ_ACT = (size_t)LT * 1024 * 2;
constexpr size_t OFF_WIN = 0;
constexpr size_t OFF_WB = OFF_WIN + (size_t)INW * 1024 * 2;
constexpr size_t OFF_WO = OFF_WB + (size_t)3 * 1024 * 1024 * 2;
constexpr size_t OFF_WFI = OFF_WO + (size_t)1024 * 1024 * 2;
constexpr size_t OFF_WFO = OFF_WFI + (size_t)5632 * 1024 * 2;
constexpr size_t OFF_H = OFF_WFO + (size_t)1024 * 2816 * 2;
constexpr size_t OFF_HN = OFF_H + (size_t)2 * 128 * 1024 * 4;
constexpr size_t OFF_R128 = OFF_HN + SZ_ACT;
constexpr size_t OFF_R64 = OFF_R128 + (size_t)LT * 64 * 8;
constexpr size_t OFF_CTR = OFF_R64 + (size_t)LT * 32 * 8;
constexpr size_t OFF_ARENA = OFF_CTR + 256;
constexpr size_t OFF_RQ = OFF_ARENA;
constexpr size_t OFF_RK = OFF_RQ + SZ_ACT / 2;
constexpr size_t OFF_RKT = OFF_RK + SZ_ACT / 2;
constexpr size_t OFF_RVT = OFF_RKT + SZ_ACT / 2;
constexpr size_t OFF_HQ = OFF_RVT + SZ_ACT;
constexpr size_t OFF_HK = OFF_HQ + SZ_ACT;
constexpr size_t OFF_HCB = OFF_HK + SZ_ACT;
constexpr size_t OFF_HKET = OFF_HCB + 2 * SZ_ACT;
constexpr size_t OFF_HVT = OFF_HKET + SZ_ACT;
constexpr size_t OFF_DQ = OFF_HVT + SZ_ACT;
constexpr size_t OFF_DK = OFF_DQ + SZ_ACT;
constexpr size_t OFF_DVT = OFF_DK + SZ_ACT;
constexpr size_t OFF_ORET = OFF_DVT + SZ_ACT;
constexpr size_t OFF_OHG = OFF_ORET + SZ_ACT;
constexpr size_t OFF_STR = OFF_OHG + SZ_ACT;
constexpr size_t OFF_STH = OFF_STR + SZ_ACT;
constexpr size_t OFF_HDEC = OFF_STH + SZ_ACT;
constexpr size_t OFF_END = OFF_HDEC + (size_t)65 * 1024 * 4;
constexpr size_t OFF_G = OFF_RQ;
constexpr size_t OFF_Y = OFF_HK;
constexpr size_t OFF_ODA = OFF_HKET;
constexpr size_t OFF_U = OFF_ARENA;
constexpr size_t OFF_GF = OFF_U + (size_t)LT * 5632 * 2;

struct Params {
  const float* in[15];
  float* out;
  unsigned char* ws;
};

DEV int get_tid() { int t = threadIdx.x; asm volatile("" : "+v"(t)); return t; }
DEV int get_bid() { int b = blockIdx.x; asm volatile("" : "+s"(b)); return b; }
DEV float* hrow(const Params& p, int b, int t) {
  return (t < 128) ? (float*)(p.ws + OFF_H) + (size_t)(b * 128 + t) * 1024 : p.out + ((size_t)b * 8192 + (t - 128)) * 1024;
}
DEV bf16_t f2bf(float f) {
  unsigned u = __float_as_uint(f);
  u += 0x7fffu + ((u >> 16) & 1u);
  return (bf16_t)(u >> 16);
}
DEV float bf2f(bf16_t h) { return __uint_as_float(((unsigned)h) << 16); }
DEV unsigned pack2(float a, float b) { return (unsigned)f2bf(a) | ((unsigned)f2bf(b) << 16); }
DEV uint2 pack4(f32x4 v) { uint2 r; r.x = pack2(v[0], v[1]); r.y = pack2(v[2], v[3]); return r; }
DEV float silu_f(float x) { return x / (1.f + __expf(-x)); }
DEV float sigmoid_f(float x) { return 1.f / (1.f + __expf(-x)); }
DEV float ex2(float x) { return __builtin_amdgcn_exp2f(x); }
DEV bf16x8 ldfrag(const bf16_t* base, int stride, int row, int k) {
  return *(const bf16x8*)(base + row * stride + k);
}

template <int BN, bool TRANS>
DEV void gemm_compute(f32x4 (&acc)[2][BN / 32], const bf16_t* as, const bf16_t* bs) {
  constexpr int NJ = BN / 32, LS = 72;
#pragma unroll
  for (int ks = 0; ks < 2; ks++) {
    bf16x8 a0 = *(const bf16x8*)(as + ks * 32);
    bf16x8 a1 = *(const bf16x8*)(as + 16 * LS + ks * 32);
#pragma unroll
    for (int j = 0; j < NJ; j++) {
      bf16x8 bb = *(const bf16x8*)(bs + j * 16 * LS + ks * 32);
      if (TRANS) {
        acc[0][j] = MFMA(a0, bb, acc[0][j]);
        acc[1][j] = MFMA(a1, bb, acc[1][j]);
      } else {
        acc[0][j] = MFMA(bb, a0, acc[0][j]);
        acc[1][j] = MFMA(bb, a1, acc[1][j]);
      }
    }
  }
}

template <int BN, bool TRANS>
DEV void gemm_acc(f32x4 (&acc)[2][BN / 32], const bf16_t* __restrict__ A, int lda,
                  const bf16_t* __restrict__ Bt, int ldb, int K, bf16_t* lds) {
  constexpr int LS = 72, A_SZ = 128 * LS, B_SZ = BN * LS, NB = BN / 64;
  const int tid = get_tid(), lane = tid & 63, wave = tid >> 6, wm = wave >> 1, wn = wave & 1;
  const int lr = lane & 15, lg = lane >> 4;
  bf16_t* As = lds;
  bf16_t* Bs = lds + 2 * A_SZ;
  const int crow = tid >> 3, ckc = (tid & 7) * 8;
  const bf16_t* ga = A + (size_t)crow * lda + ckc;
  const bf16_t* gb = Bt + (size_t)crow * ldb + ckc;
  u32x4 ra0, ra1, rb0, rb1, rb2, rb3;
#define GLOAD(k0)                                                        \
  ra0 = *(const u32x4*)(ga + (k0));                                      \
  ra1 = *(const u32x4*)(ga + (size_t)64 * lda + (k0));                   \
  rb0 = *(const u32x4*)(gb + (k0));                                      \
  rb1 = *(const u32x4*)(gb + (size_t)64 * ldb + (k0));                   \
  if (NB == 4) {                                                         \
    rb2 = *(const u32x4*)(gb + (size_t)128 * ldb + (k0));                \
    rb3 = *(const u32x4*)(gb + (size_t)192 * ldb + (k0));                \
  }
#define LSTORE(buf)                                                      \
  *(u32x4*)(As + (buf) * A_SZ + crow * LS + ckc) = ra0;                  \
  *(u32x4*)(As + (buf) * A_SZ + (crow + 64) * LS + ckc) = ra1;           \
  *(u32x4*)(Bs + (buf) * B_SZ + crow * LS + ckc) = rb0;                  \
  *(u32x4*)(Bs + (buf) * B_SZ + (crow + 64) * LS + ckc) = rb1;           \
  if (NB == 4) {                                                         \
    *(u32x4*)(Bs + (buf) * B_SZ + (crow + 128) * LS + ckc) = rb2;        \
    *(u32x4*)(Bs + (buf) * B_SZ + (crow + 192) * LS + ckc) = rb3;        \
  }
  GLOAD(0)
  __syncthreads();
  LSTORE(0)
  __syncthreads();
  const int nk = K / 64;
  const int aoff = (wm * 32 + lr) * LS + lg * 8;
  const int boff = (wn * (BN / 2) + lr) * LS + lg * 8;
  for (int kt = 0; kt < nk - 1; kt++) {
    const int cur = kt & 1;
    GLOAD((kt + 1) * 64)
    gemm_compute<BN, TRANS>(acc, As + cur * A_SZ + aoff, Bs + cur * B_SZ + boff);
    LSTORE(cur ^ 1)
    __syncthreads();
  }
  {
    const int cur = (nk - 1) & 1;
    gemm_compute<BN, TRANS>(acc, As + cur * A_SZ + aoff, Bs + cur * B_SZ + boff);
    __syncthreads();
  }
#undef GLOAD
#undef LSTORE
}

DEV void gemm256_compute(f32x4 (&acc)[4][8], const bf16_t* as, const bf16_t* bs) {
  constexpr int LS = 72;
#pragma unroll
  for (int ks = 0; ks < 2; ks++) {
    bf16x8 a[4];
#pragma unroll
    for (int i = 0; i < 4; i++) a[i] = *(const bf16x8*)(as + i * 16 * LS + ks * 32);
#pragma unroll
    for (int j = 0; j < 8; j++) {
      bf16x8 bb = *(const bf16x8*)(bs + j * 16 * LS + ks * 32);
#pragma unroll
      for (int i = 0; i < 4; i++) acc[i][j] = MFMA(bb, a[i], acc[i][j]);
    }
  }
}

DEV void gemm256_acc(f32x4 (&acc)[4][8], const bf16_t* __restrict__ A, int lda, int m_valid,
                     const bf16_t* __restrict__ Bt, int ldb, int K, bf16_t* lds) {
  constexpr int LS = 72, T_SZ = 256 * LS;
  const int tid = get_tid(), lane = tid & 63, wave = tid >> 6, wm = wave >> 1, wn = wave & 1;
  const int lr = lane & 15, lg = lane >> 4;
  bf16_t* As = lds;
  bf16_t* Bs = lds + 2 * T_SZ;
  const int crow = tid >> 3, ckc = (tid & 7) * 8;
  const bf16_t* ga0 = A + (size_t)min(crow, m_valid - 1) * lda + ckc;
  const bf16_t* ga1 = A + (size_t)min(crow + 64, m_valid - 1) * lda + ckc;
  const bf16_t* ga2 = A + (size_t)min(crow + 128, m_valid - 1) * lda + ckc;
  const bf16_t* ga3 = A + (size_t)min(crow + 192, m_valid - 1) * lda + ckc;
  const bf16_t* gb = Bt + (size_t)crow * ldb + ckc;
  u32x4 ra0, ra1, ra2, ra3, rb0, rb1, rb2, rb3;
#define GLOAD(k0)                                                        \
  ra0 = *(const u32x4*)(ga0 + (k0));                                     \
  ra1 = *(const u32x4*)(ga1 + (k0));                                     \
  ra2 = *(const u32x4*)(ga2 + (k0));                                     \
  ra3 = *(const u32x4*)(ga3 + (k0));                                     \
  rb0 = *(const u32x4*)(gb + (k0));                                      \
  rb1 = *(const u32x4*)(gb + (size_t)64 * ldb + (k0));                   \
  rb2 = *(const u32x4*)(gb + (size_t)128 * ldb + (k0));                  \
  rb3 = *(const u32x4*)(gb + (size_t)192 * ldb + (k0));
#define LSTORE(buf)                                                      \
  *(u32x4*)(As + (buf) * T_SZ + crow * LS + ckc) = ra0;                  \
  *(u32x4*)(As + (buf) * T_SZ + (crow + 64) * LS + ckc) = ra1;           \
  *(u32x4*)(As + (buf) * T_SZ + (crow + 128) * LS + ckc) = ra2;          \
  *(u32x4*)(As + (buf) * T_SZ + (crow + 192) * LS + ckc) = ra3;          \
  *(u32x4*)(Bs + (buf) * T_SZ + crow * LS + ckc) = rb0;                  \
  *(u32x4*)(Bs + (buf) * T_SZ + (crow + 64) * LS + ckc) = rb1;           \
  *(u32x4*)(Bs + (buf) * T_SZ + (crow + 128) * LS + ckc) = rb2;          \
  *(u32x4*)(Bs + (buf) * T_SZ + (crow + 192) * LS + ckc) = rb3;
  GLOAD(0)
  __syncthreads();
  LSTORE(0)
  __syncthreads();
  const int nk = K / 64;
  const int aoff = (wm * 64 + lr) * LS + lg * 8;
  const int boff = (wn * 128 + lr) * LS + lg * 8;
  for (int kt = 0; kt < nk - 1; kt++) {
    const int cur = kt & 1;
    GLOAD((kt + 1) * 64)
    gemm256_compute(acc, As + cur * T_SZ + aoff, Bs + cur * T_SZ + boff);
    LSTORE(cur ^ 1)
    __syncthreads();
  }
  {
    const int cur = (nk - 1) & 1;
    gemm256_compute(acc, As + cur * T_SZ + aoff, Bs + cur * T_SZ + boff);
    __syncthreads();
  }
#undef GLOAD
#undef LSTORE
}

DEV void tconv_tile(const float* __restrict__ src, int K, int N, bf16_t* __restrict__ dst, int tk, int tn, float* tile) {
  const int tid = get_tid();
  const int r = tid >> 4, c4 = (tid & 15) * 4;
#pragma unroll
  for (int i = 0; i < 2; i++) {
    const int rr = r + i * 32;
    float4 v = *(const float4*)(src + (size_t)(tk * 64 + rr) * N + tn * 64 + c4);
    tile[rr * 65 + c4 + 0] = v.x; tile[rr * 65 + c4 + 1] = v.y; tile[rr * 65 + c4 + 2] = v.z; tile[rr * 65 + c4 + 3] = v.w;
  }
  __syncthreads();
  const int n = tid >> 3, k8 = (tid & 7) * 8;
  uint4 o;
  o.x = pack2(tile[(k8 + 0) * 65 + n], tile[(k8 + 1) * 65 + n]);
  o.y = pack2(tile[(k8 + 2) * 65 + n], tile[(k8 + 3) * 65 + n]);
  o.z = pack2(tile[(k8 + 4) * 65 + n], tile[(k8 + 5) * 65 + n]);
  o.w = pack2(tile[(k8 + 6) * 65 + n], tile[(k8 + 7) * 65 + n]);
  *(uint4*)(dst + (size_t)(tn * 64 + n) * K + tk * 64 + k8) = o;
  __syncthreads();
}

DEV void phase_convert(const Params& p, int layer, unsigned char* lds) {
  unsigned char* ws = p.ws;
  float* tile = (float*)lds;
  for (int item = get_bid(); item < 6464; item += gridDim.x) {
    const float* src; bf16_t* dst; int K, N, idx;
    if (item < 3328) { idx = item; src = p.in[3] + (size_t)layer * 1024 * INW; K = 1024; N = INW; dst = (bf16_t*)(ws + OFF_WIN); }
    else if (item < 3328 + 768) { idx = item - 3328; int br = idx >> 8; idx &= 255; src = p.in[4] + ((size_t)layer * 3 + br) * 1024 * 1024; K = 1024; N = 1024; dst = (bf16_t*)(ws + OFF_WB) + (size_t)br * 1024 * 1024; }
    else if (item < 3328 + 1024) { idx = item - 4096; src = p.in[5] + (size_t)layer * 1024 * 1024; K = 1024; N = 1024; dst = (bf16_t*)(ws + OFF_WO); }
    else if (item < 4352 + 1408) { idx = item - 4352; src = p.in[10] + (size_t)layer * 1024 * 5632; K = 1024; N = 5632; dst = (bf16_t*)(ws + OFF_WFI); }
    else { idx = item - 5760; src = p.in[13] + (size_t)layer * 2816 * 1024; K = 2816; N = 1024; dst = (bf16_t*)(ws + OFF_WFO); }
    const int ntn = N / 64;
    tconv_tile(src, K, N, dst, idx / ntn, idx % ntn, tile);
  }
}

DEV void phase_init(const Params& p) {
  unsigned char* ws = p.ws;
  const int gt = get_bid() * NTHR + get_tid(), gs = gridDim.x * NTHR;
  for (int idx = gt; idx < 2 * LT * 256; idx += gs) {
    const int row = idx >> 8, c4 = (idx & 255) * 4;
    const int b = row / LT, t = row - b * LT;
    float4 v;
    if (t < 112) v = make_float4(0.f, 0.f, 0.f, 0.f);
    else if (t < 128) v = *(const float4*)(p.in[1] + (size_t)(t - 112) * 1024 + c4);
    else v = *(const float4*)(p.in[0] + ((size_t)b * 8192 + (t - 128)) * 1024 + c4);
    *(float4*)(hrow(p, b, t) + c4) = v;
  }
  float2* R128 = (float2*)(ws + OFF_R128);
  float2* R64 = (float2*)(ws + OFF_R64);
  for (int idx = gt; idx < LT * 96; idx += gs) {
    const int t = idx / 96, f = idx - t * 96;
    float inv;
    if (f < 64) inv = powf(10000.f, -(float)(2 * f) / 128.f);
    else inv = powf(10000.f, -(float)(2 * (f - 64)) / 64.f);
    const float ang = (float)(t - 112) * inv;
    const double ad = (double)ang;
    const double n = rint(ad * 0.15915494309189535);
    const float rr = (float)(ad - n * 6.283185307179586);
    float2 cs; cs.x = __cosf(rr); cs.y = __sinf(rr);
    if (f < 64) R128[(size_t)t * 64 + f] = cs; else R64[(size_t)t * 32 + (f - 64)] = cs;
  }
}

DEV void phase_norm(const Params& p, int b, const float* __restrict__ g, bf16_t* __restrict__ dst) {
  const int lane = get_tid() & 63, wave = get_tid() >> 6;
  for (int row = get_bid() * 8 + wave; row < LT; row += gridDim.x * 8) {
    const float* src = hrow(p, b, row);
    float4 v[4]; float ss = 0.f;
#pragma unroll
    for (int k = 0; k < 4; k++) { v[k] = *(const float4*)(src + k * 256 + lane * 4); ss += v[k].x * v[k].x + v[k].y * v[k].y + v[k].z * v[k].z + v[k].w * v[k].w; }
#pragma unroll
    for (int o = 1; o < 64; o <<= 1) ss += __shfl_xor(ss, o);
    const float rs = rsqrtf(ss * (1.f / 1024.f) + 1e-6f);
#pragma unroll
    for (int k = 0; k < 4; k++) {
      float4 gg = *(const float4*)(g + k * 256 + lane * 4);
      uint2 o; o.x = pack2(v[k].x * rs * gg.x, v[k].y * rs * gg.y); o.y = pack2(v[k].z * rs * gg.z, v[k].w * rs * gg.w);
      *(uint2*)(dst + (size_t)row * 1024 + k * 256 + lane * 4) = o;
    }
  }
}

DEV void phase_final(const Params& p) {
  const float* g = p.in[14];
  const int lane = get_tid() & 63, wave = get_tid() >> 6;
  for (int row = get_bid() * 8 + wave; row < 2 * 8192; row += gridDim.x * 8) {
    const float* src = p.out + (size_t)row * 1024;
    float4 v[4]; float ss = 0.f;
#pragma unroll
    for (int k = 0; k < 4; k++) { v[k] = *(const float4*)(src + k * 256 + lane * 4); ss += v[k].x * v[k].x + v[k].y * v[k].y + v[k].z * v[k].z + v[k].w * v[k].w; }
#pragma unroll
    for (int o = 1; o < 64; o <<= 1) ss += __shfl_xor(ss, o);
    const float rs = rsqrtf(ss * (1.f / 1024.f) + 1e-6f);
#pragma unroll
    for (int k = 0; k < 4; k++) {
      float4 gg = *(const float4*)(g + k * 256 + lane * 4);
      float4 o = make_float4(v[k].x * rs * gg.x, v[k].y * rs * gg.y, v[k].z * rs * gg.z, v[k].w * rs * gg.w);
      *(float4*)(p.out + (size_t)row * 1024 + k * 256 + lane * 4) = o;
    }
  }
}

DEV void tile_map(int it, int MT, int NG, int& mt, int& nt) {
  const int ng = it / (MT * NG), rem = it - ng * (MT * NG);
  mt = rem / NG; nt = ng * NG + (rem - mt * NG);
}
DEV int vblock() { const int b = get_bid(), G = (int)gridDim.x; return ((G & 7) == 0) ? (b & 7) * (G >> 3) + (b >> 3) : b; }

DEV void phase_projA(const Params& p, int layer, unsigned char* ldsraw) {
  unsigned char* ws = p.ws;
  bf16_t* lds = (bf16_t*)ldsraw;
  const bf16_t* HN = (const bf16_t*)(ws + OFF_HN);
  const bf16_t* WIN = (const bf16_t*)(ws + OFF_WIN);
  const float2* R128 = (const float2*)(ws + OFF_R128);
  const float2* R64 = (const float2*)(ws + OFF_R64);
  for (int item = vblock(); item < 65 * 32; item += gridDim.x) {
    int nt, mt; tile_map(item, 65, 4, mt, nt);
    int n0, seg, segstart;
    if (nt < 8) { n0 = nt * 256; seg = nt < 2 ? 0 : (nt < 4 ? 1 : 2); segstart = seg == 0 ? 0 : (seg == 1 ? 512 : 1024); }
    else if (nt < 20) { n0 = 3072 + (nt - 8) * 256; seg = 3 + (nt - 8) / 4; segstart = 3072 + (seg - 3) * 1024; }
    else { n0 = 7168 + (nt - 20) * 256; seg = 6 + (nt - 20) / 4; segstart = 7168 + (seg - 6) * 1024; }
    const bf16_t* A = HN + (size_t)mt * 128 * 1024;
    const bf16_t* Bt = WIN + (size_t)n0 * 1024;
    f32x4 acc[2][8];
#pragma unroll
    for (int i = 0; i < 2; i++)
#pragma unroll
      for (int j = 0; j < 8; j++) acc[i][j] = (f32x4){0.f, 0.f, 0.f, 0.f};
    if (seg == 0 || seg == 3 || seg == 6 || seg == 7) {
      gemm_acc<256, false>(acc, A, 1024, Bt, 1024, 1024, lds);
      const int tid = get_tid(), lane = tid & 63, wave = tid >> 6, wm = wave >> 1, wn = wave & 1; const int lr = lane & 15, lg = lane >> 4; (void)tid; (void)lane; (void)wm; (void)wn; (void)lr; (void)lg;
      const int cw = (n0 - segstart) + wn * 128;
      bf16_t* dstb; int ld;
      if (seg == 0) { dstb = (bf16_t*)(ws + OFF_RQ); ld = 512; }
      else if (seg == 3) { dstb = (bf16_t*)(ws + OFF_HQ); ld = 1024; }
      else if (seg == 6) { dstb = (bf16_t*)(ws + OFF_DQ); ld = 1024; }
      else { dstb = (bf16_t*)(ws + OFF_DK); ld = 1024; }
#pragma unroll
      for (int i = 0; i < 2; i++) {
        const int t = mt * 128 + wm * 32 + i * 16 + lr;
        if (seg == 0) {
          const float2* tab = R128 + (size_t)t * 64;
#pragma unroll
          for (int j = 0; j < 4; j++)
#pragma unroll
            for (int r = 0; r < 4; r++) {
              float2 cs = tab[j * 16 + lg * 4 + r];
              float x1 = acc[i][j][r], x2 = acc[i][j + 4][r];
              acc[i][j][r] = x1 * cs.x - x2 * cs.y;
              acc[i][j + 4][r] = x2 * cs.x + x1 * cs.y;
            }
        } else if (seg == 6 || seg == 7) {
          const float2* tab = R64 + (size_t)t * 32;
          const float sc = (seg == 6) ? (0.125f * 1.4426950408889634f) : 1.f;
#pragma unroll
          for (int jq = 0; jq < 4; jq++) {
            const int j = (jq & 1) + (jq >> 1) * 4;
#pragma unroll
            for (int r = 0; r < 4; r++) {
              float2 cs = tab[(jq & 1) * 16 + lg * 4 + r];
              float x1 = acc[i][j][r], x2 = acc[i][j + 2][r];
              acc[i][j][r] = (x1 * cs.x - x2 * cs.y) * sc;
              acc[i][j + 2][r] = (x2 * cs.x + x1 * cs.y) * sc;
            }
          }
        }
        bf16_t* dst = dstb + (size_t)t * ld + cw;
#pragma unroll
        for (int j = 0; j < 8; j++) *(uint2*)(dst + j * 16 + lg * 4) = pack4(acc[i][j]);
      }
    } else {
      gemm_acc<256, true>(acc, A, 1024, Bt, 1024, 1024, lds);
      const int tid = get_tid(), lane = tid & 63, wave = tid >> 6, wm = wave >> 1, wn = wave & 1; const int lr = lane & 15, lg = lane >> 4; (void)tid; (void)lane; (void)wm; (void)wn; (void)lr; (void)lg;
      const int cw = (n0 - segstart) + wn * 128;
      if (seg == 1) {
        bf16_t* RK = (bf16_t*)(ws + OFF_RK);
        bf16_t* RKT = (bf16_t*)(ws + OFF_RKT);
        const int h = cw >> 7;
        const float l2g = log2f(1.f - ex2(-5.f - (float)h));
#pragma unroll
        for (int i = 0; i < 2; i++) {
          const int mb = wm * 32 + i * 16 + lg * 4;
#pragma unroll
          for (int j = 0; j < 4; j++)
#pragma unroll
            for (int r = 0; r < 4; r++) {
              const int t = mt * 128 + mb + r;
              float2 cs = R128[(size_t)t * 64 + j * 16 + lr];
              const float sc = (t >= 112) ? 0.08838834764831845f : 0.f;
              float x1 = acc[i][j][r], x2 = acc[i][j + 4][r];
              acc[i][j][r] = (x1 * cs.x - x2 * cs.y) * sc;
              acc[i][j + 4][r] = (x2 * cs.x + x1 * cs.y) * sc;
            }
#pragma unroll
          for (int j = 0; j < 8; j++) {
            const int col = cw + j * 16 + lr;
            f32x4 kd;
#pragma unroll
            for (int r = 0; r < 4; r++) {
              const int t = mt * 128 + mb + r;
              RK[(size_t)t * 512 + col] = f2bf(acc[i][j][r]);
              kd[r] = acc[i][j][r] * ex2(l2g * (float)(127 - (mb + r)));
            }
            *(uint2*)(RKT + (size_t)col * LT + mt * 128 + mb) = pack4(kd);
          }
        }
      } else if (seg == 2 || seg == 5 || seg == 8) {
        bf16_t* dT = (bf16_t*)(ws + (seg == 2 ? OFF_RVT : (seg == 5 ? OFF_HVT : OFF_DVT)));
#pragma unroll
        for (int i = 0; i < 2; i++) {
          const int mb = wm * 32 + i * 16 + lg * 4;
#pragma unroll
          for (int j = 0; j < 8; j++) {
            const int col = cw + j * 16 + lr;
            f32x4 v = acc[i][j];
            if (seg == 5) {
#pragma unroll
              for (int r = 0; r < 4; r++) if (mt * 128 + mb + r < 112) v[r] = 0.f;
            }
            *(uint2*)(dT + (size_t)col * LT + mt * 128 + mb) = pack4(v);
          }
        }
      } else {
        float* Lf = (float*)ldsraw;
        float* HCB = (float*)(ws + OFF_HCB);
        bf16_t* HK = (bf16_t*)(ws + OFF_HK);
        bf16_t* HKET = (bf16_t*)(ws + OFF_HKET);
        float* HDEC = (float*)(ws + OFF_HDEC);
        const float* lbp = p.in[6];
#pragma unroll
        for (int j = 0; j < 8; j++) {
          const int col = cw + j * 16 + lr;
          float lb = 0.f;
          if (layer == 1) lb = 1.f / (1.f + __expf(lbp[col] - lbp[1024 + col]));
#pragma unroll
          for (int i = 0; i < 2; i++)
#pragma unroll
            for (int r = 0; r < 4; r++) {
              const int m = wm * 32 + i * 16 + lg * 4 + r;
              const float z = acc[i][j][r];
              const float kk = (1.f - lb) / (1.f + __expf(z));
              const float lf = fmaxf(log1pf(-kk), -69.0776f);
              acc[i][j][r] = kk;
              Lf[m * 260 + wn * 128 + j * 16 + lr] = lf;
            }
        }
        __syncthreads();
        {
          const int colL = tid & 255, half = tid >> 8;
          float run = 0.f;
          for (int rr = 0; rr < 64; rr++) {
            float* q = &Lf[(half * 64 + rr) * 260 + colL];
            run += *q; *q = run;
          }
        }
        __syncthreads();
#pragma unroll
        for (int j = 0; j < 8; j++) {
          const int colL = wn * 128 + j * 16 + lr;
          const int col = cw + j * 16 + lr;
          const float ft = Lf[63 * 260 + colL];
          const float cend = Lf[127 * 260 + colL] + ft;
#pragma unroll
          for (int i = 0; i < 2; i++) {
            const int mb = wm * 32 + i * 16 + lg * 4;
            f32x4 ke;
#pragma unroll
            for (int r = 0; r < 4; r++) {
              const int m = mb + r;
              const int t = mt * 128 + m;
              const float cb = Lf[m * 260 + colL] + (m >= 64 ? ft : 0.f);
              HCB[(size_t)t * 1024 + col] = cb;
              HK[(size_t)t * 1024 + col] = f2bf(acc[i][j][r]);
              ke[r] = acc[i][j][r] * __expf(cend - cb);
              if (m == 127) HDEC[mt * 1024 + col] = __expf(cend);
            }
            *(uint2*)(HKET + (size_t)col * LT + mt * 128 + mb) = pack4(ke);
          }
        }
        __syncthreads();
      }
    }
  }
}

DEV void phase_U(const Params& p, unsigned char* ldsraw) {
  unsigned char* ws = p.ws;
  bf16_t* lds = (bf16_t*)ldsraw;
  for (int item = get_bid(); item < 1040; item += gridDim.x) {
    const bf16_t *A, *Bt; bf16_t* dst;
    if (item < 520) {
      const int h = item & 3, rest = item >> 2, mh = rest & 1, c = rest >> 1;
      A = (const bf16_t*)(ws + OFF_RVT) + (size_t)(h * 256 + mh * 128) * LT + c * 128;
      Bt = (const bf16_t*)(ws + OFF_RKT) + (size_t)(h * 128) * LT + c * 128;
      dst = (bf16_t*)(ws + OFF_STR) + ((size_t)(h * 65 + c) * 256 + mh * 128) * 128;
    } else {
      const int it = item - 520, h = it & 7, c = it >> 3;
      A = (const bf16_t*)(ws + OFF_HVT) + (size_t)(h * 128) * LT + c * 128;
      Bt = (const bf16_t*)(ws + OFF_HKET) + (size_t)(h * 128) * LT + c * 128;
      dst = (bf16_t*)(ws + OFF_STH) + ((size_t)(h * 65 + c) * 128) * 128;
    }
    f32x4 acc[2][4];
#pragma unroll
    for (int i = 0; i < 2; i++)
#pragma unroll
      for (int j = 0; j < 4; j++) acc[i][j] = (f32x4){0.f, 0.f, 0.f, 0.f};
    gemm_acc<128, false>(acc, A, LT, Bt, LT, 128, lds);
      const int tid = get_tid(), lane = tid & 63, wave = tid >> 6, wm = wave >> 1, wn = wave & 1; const int lr = lane & 15, lg = lane >> 4; (void)tid; (void)lane; (void)wm; (void)wn; (void)lr; (void)lg;
#pragma unroll
    for (int i = 0; i < 2; i++)
#pragma unroll
      for (int j = 0; j < 4; j++)
        *(uint2*)(dst + (size_t)(wm * 32 + i * 16 + lr) * 128 + wn * 64 + j * 16 + lg * 4) = pack4(acc[i][j]);
  }
}

DEV void phase_scan(const Params& p) {
  unsigned char* ws = p.ws;
  const float* HDEC = (const float*)(ws + OFF_HDEC);
  for (int task = get_bid() * NTHR + get_tid(); task < 65536; task += gridDim.x * NTHR) {
    bf16_t* base; size_t stride; int h, d4; bool hg;
    float dec0 = 0.f;
    if (task < 32768) {
      const int v = task; d4 = (v & 31) * 4; const int e = (v >> 5) & 255; h = v >> 13; hg = false;
      base = (bf16_t*)(ws + OFF_STR) + ((size_t)(h * 65) * 256 + e) * 128 + d4; stride = 256 * 128;
      dec0 = ex2(128.f * log2f(1.f - ex2(-5.f - (float)h)));
    } else {
      const int v = task - 32768; d4 = (v & 31) * 4; const int e = (v >> 5) & 127; h = v >> 12; hg = true;
      base = (bf16_t*)(ws + OFF_STH) + ((size_t)(h * 65) * 128 + e) * 128 + d4; stride = 128 * 128;
    }
    float c0 = 0.f, c1 = 0.f, c2 = 0.f, c3 = 0.f;
    for (int cg0 = 0; cg0 < 65; cg0 += 5) {
      uint2 u[5]; float4 dc[5];
#pragma unroll
      for (int k = 0; k < 5; k++) {
        u[k] = *(const uint2*)(base + (size_t)(cg0 + k) * stride);
        if (hg) dc[k] = *(const float4*)(HDEC + (size_t)(cg0 + k) * 1024 + h * 128 + d4);
        else dc[k] = make_float4(dec0, dec0, dec0, dec0);
      }
#pragma unroll
      for (int k = 0; k < 5; k++) {
        uint2 o; o.x = pack2(c0, c1); o.y = pack2(c2, c3);
        *(uint2*)(base + (size_t)(cg0 + k) * stride) = o;
        c0 = dc[k].x * c0 + bf2f((bf16_t)(u[k].x & 0xffff));
        c1 = dc[k].y * c1 + bf2f((bf16_t)(u[k].x >> 16));
        c2 = dc[k].z * c2 + bf2f((bf16_t)(u[k].y & 0xffff));
        c3 = dc[k].w * c3 + bf2f((bf16_t)(u[k].y >> 16));
      }
    }
  }
}

DEV void attn_item(const Params& p, int layer, int h, int qb, float lam, bf16_t* lds) {
  unsigned char* ws = p.ws;
  const bf16_t* DQ = (const bf16_t*)(ws + OFF_DQ);
  bf16_t* ODA = (bf16_t*)(ws + OFF_ODA);
  const bf16_t* DK = (const bf16_t*)(ws + OFF_DK);
  const bf16_t* DVT = (const bf16_t*)(ws + OFF_DVT);
  constexpr int PS = 136, XS = 132;
  bf16_t* Ks = lds;
  bf16_t* Vs = lds + 128 * PS;
  bf16_t* Qs = lds + 2 * 128 * PS;
  float* X = (float*)lds;
  const int tid = get_tid(), lane = tid & 63, wave = tid >> 6;
  const int lr = lane & 15, lg = lane >> 4;
  const int grp = wave >> 2, wq = wave & 3;
  const int t0 = qb * 128;
  const int lrow = tid >> 4, lc8 = (tid & 15) * 8;
#pragma unroll
  for (int i = 0; i < 4; i++)
    *(u32x4*)(Qs + (lrow + i * 32) * PS + lc8) = *(const u32x4*)(DQ + (size_t)(t0 + lrow + i * 32) * 1024 + h * 128 + lc8);
  f32x4 o[2][8];
#pragma unroll
  for (int i = 0; i < 2; i++)
#pragma unroll
    for (int j = 0; j < 8; j++) o[i][j] = (f32x4){0.f, 0.f, 0.f, 0.f};
  float mrun0 = -1e30f, mrun1 = -1e30f, lrun0 = 0.f, lrun1 = 0.f;
  u32x4 rk0, rk1, rk2, rk3, rv0, rv1, rv2, rv3;
  const bf16_t* gk = DK + (size_t)lrow * 1024 + h * 128 + lc8;
  const bf16_t* gv = DVT + (size_t)(h * 128 + lrow) * LT + lc8;
#define ALOAD(kbn)                                                              \
  rk0 = *(const u32x4*)(gk + (size_t)((kbn) * 128) * 1024);                     \
  rk1 = *(const u32x4*)(gk + (size_t)((kbn) * 128 + 32) * 1024);                \
  rk2 = *(const u32x4*)(gk + (size_t)((kbn) * 128 + 64) * 1024);                \
  rk3 = *(const u32x4*)(gk + (size_t)((kbn) * 128 + 96) * 1024);                \
  rv0 = *(const u32x4*)(gv + (kbn) * 128);                                      \
  rv1 = *(const u32x4*)(gv + (size_t)32 * LT + (kbn) * 128);                    \
  rv2 = *(const u32x4*)(gv + (size_t)64 * LT + (kbn) * 128);                    \
  rv3 = *(const u32x4*)(gv + (size_t)96 * LT + (kbn) * 128);
  ALOAD(0)
  const int qrow0 = t0 + wq * 32 + lr;
  for (int kb = 0; kb <= qb; kb++) {
    __syncthreads();
    *(u32x4*)(Ks + (lrow) * PS + lc8) = rk0;
    *(u32x4*)(Ks + (lrow + 32) * PS + lc8) = rk1;
    *(u32x4*)(Ks + (lrow + 64) * PS + lc8) = rk2;
    *(u32x4*)(Ks + (lrow + 96) * PS + lc8) = rk3;
    *(u32x4*)(Vs + (lrow) * PS + lc8) = rv0;
    *(u32x4*)(Vs + (lrow + 32) * PS + lc8) = rv1;
    *(u32x4*)(Vs + (lrow + 64) * PS + lc8) = rv2;
    *(u32x4*)(Vs + (lrow + 96) * PS + lc8) = rv3;
    __syncthreads();
    {
      const int kbn = (kb < qb) ? kb + 1 : qb;
      ALOAD(kbn)
    }
    f32x4 s[2][8];
    {
      const bf16x8 a00 = ldfrag(Qs, PS, wq * 32 + lr, grp * 64 + lg * 8);
      const bf16x8 a01 = ldfrag(Qs, PS, wq * 32 + lr, grp * 64 + 32 + lg * 8);
      const bf16x8 a10 = ldfrag(Qs, PS, wq * 32 + 16 + lr, grp * 64 + lg * 8);
      const bf16x8 a11 = ldfrag(Qs, PS, wq * 32 + 16 + lr, grp * 64 + 32 + lg * 8);
#pragma unroll
      for (int j = 0; j < 8; j++) {
        const bf16x8 kf0 = ldfrag(Ks, PS, j * 16 + lr, grp * 64 + lg * 8);
        const bf16x8 kf1 = ldfrag(Ks, PS, j * 16 + lr, grp * 64 + 32 + lg * 8);
        s[0][j] = MFMA(kf0, a00, ((f32x4){0.f, 0.f, 0.f, 0.f}));
        s[1][j] = MFMA(kf0, a10, ((f32x4){0.f, 0.f, 0.f, 0.f}));
        s[0][j] = MFMA(kf1, a01, s[0][j]);
        s[1][j] = MFMA(kf1, a11, s[1][j]);
      }
    }
    __builtin_amdgcn_sched_barrier(0);
    if (kb == qb || kb == 0) {
#pragma unroll
      for (int i = 0; i < 2; i++)
#pragma unroll
        for (int j = 0; j < 8; j++)
#pragma unroll
          for (int r = 0; r < 4; r++) {
            const int key = kb * 128 + j * 16 + lg * 4 + r;
            if (key > qrow0 + 16 * i || key < 112) s[i][j][r] = -1e30f;
          }
    }
    float al[2];
#pragma unroll
    for (int i = 0; i < 2; i++) {
      float mx = -1e30f;
#pragma unroll
      for (int j = 0; j < 8; j++)
#pragma unroll
        for (int r = 0; r < 4; r++) mx = fmaxf(mx, s[i][j][r]);
      mx = fmaxf(mx, __shfl_xor(mx, 16));
      mx = fmaxf(mx, __shfl_xor(mx, 32));
      const float mold = i == 0 ? mrun0 : mrun1;
      const float mnew = fmaxf(mold, mx);
      al[i] = ex2(mold - mnew);
      float ps = 0.f;
#pragma unroll
      for (int j = 0; j < 8; j++)
#pragma unroll
        for (int r = 0; r < 4; r++) { const float pv = ex2(s[i][j][r] - mnew); s[i][j][r] = pv; ps += pv; }
      if (i == 0) { mrun0 = mnew; lrun0 = lrun0 * al[0] + ps; } else { mrun1 = mnew; lrun1 = lrun1 * al[1] + ps; }
    }
#pragma unroll
    for (int i = 0; i < 2; i++) {
      float ao[4];
#pragma unroll
      for (int r = 0; r < 4; r++) ao[r] = __shfl(al[i], lg * 4 + r);
#pragma unroll
      for (int je = 0; je < 8; je++)
#pragma unroll
        for (int r = 0; r < 4; r++) o[i][je][r] *= ao[r];
    }
#pragma unroll
    for (int ks = 0; ks < 4; ks++) {
      union { u32x4 u; bf16x8 v; } pf0, pf1;
      pf0.u[0] = pack2(s[0][2 * ks][0], s[0][2 * ks][1]);
      pf0.u[1] = pack2(s[0][2 * ks][2], s[0][2 * ks][3]);
      pf0.u[2] = pack2(s[0][2 * ks + 1][0], s[0][2 * ks + 1][1]);
      pf0.u[3] = pack2(s[0][2 * ks + 1][2], s[0][2 * ks + 1][3]);
      pf1.u[0] = pack2(s[1][2 * ks][0], s[1][2 * ks][1]);
      pf1.u[1] = pack2(s[1][2 * ks][2], s[1][2 * ks][3]);
      pf1.u[2] = pack2(s[1][2 * ks + 1][0], s[1][2 * ks + 1][1]);
      pf1.u[3] = pack2(s[1][2 * ks + 1][2], s[1][2 * ks + 1][3]);
#pragma unroll
      for (int je = 0; je < 8; je++) {
        const bf16_t* vp = Vs + (je * 16 + lr) * PS + ks * 32 + lg * 4;
        union { uint2 u[2]; bf16x8 v; } vf;
        vf.u[0] = *(const uint2*)vp;
        vf.u[1] = *(const uint2*)(vp + 16);
        o[0][je] = MFMA(pf0.v, vf.v, o[0][je]);
        o[1][je] = MFMA(pf1.v, vf.v, o[1][je]);
      }
    }
    __builtin_amdgcn_sched_barrier(0);
  }
#undef ALOAD
#pragma unroll
  for (int i = 0; i < 2; i++) {
    float l = i == 0 ? lrun0 : lrun1;
    l += __shfl_xor(l, 16);
    l += __shfl_xor(l, 32);
    const float inv = l > 0.f ? 1.f / l : 0.f;
#pragma unroll
    for (int r = 0; r < 4; r++) {
      const float ir = __shfl(inv, lg * 4 + r);
#pragma unroll
      for (int je = 0; je < 8; je++) o[i][je][r] *= ir;
    }
  }
  __syncthreads();
  if (grp == 1) {
#pragma unroll
    for (int i = 0; i < 2; i++)
#pragma unroll
      for (int je = 0; je < 8; je++)
#pragma unroll
        for (int r = 0; r < 4; r++) X[(wq * 32 + i * 16 + lg * 4 + r) * XS + je * 16 + lr] = o[i][je][r];
  }
  __syncthreads();
  if (grp == 0) {
    int ly = layer; asm volatile("" : "+s"(ly));
    const float li = (ly == 0) ? 0.2f : 0.35550906759f;
    const float* sg = p.in[8] + ly * 128;
#pragma unroll
    for (int i = 0; i < 2; i++) {
      float ss[4] = {0.f, 0.f, 0.f, 0.f};
#pragma unroll
      for (int je = 0; je < 8; je++)
#pragma unroll
        for (int r = 0; r < 4; r++) {
          const float v = o[i][je][r] - lam * X[(wq * 32 + i * 16 + lg * 4 + r) * XS + je * 16 + lr];
          o[i][je][r] = v; ss[r] += v * v;
        }
#pragma unroll
      for (int r = 0; r < 4; r++) {
        float s2 = ss[r];
        s2 += __shfl_xor(s2, 1); s2 += __shfl_xor(s2, 2); s2 += __shfl_xor(s2, 4); s2 += __shfl_xor(s2, 8);
        ss[r] = rsqrtf(s2 * (1.f / 128.f) + 1e-6f) * (1.f - li);
      }
#pragma unroll
      for (int je = 0; je < 8; je++) {
        const float g = sg[je * 16 + lr];
#pragma unroll
        for (int r = 0; r < 4; r++)
          ODA[(size_t)(t0 + wq * 32 + i * 16 + lg * 4 + r) * 1024 + h * 128 + je * 16 + lr] = f2bf(o[i][je][r] * ss[r] * g);
      }
    }
  }
}

DEV void ret_item(const Params& p, int h, int c, bf16_t* lds) {
  unsigned char* ws = p.ws;
  const bf16_t* RQ = (const bf16_t*)(ws + OFF_RQ);
  const bf16_t* RK = (const bf16_t*)(ws + OFF_RK);
  const bf16_t* RVT = (const bf16_t*)(ws + OFF_RVT);
  const bf16_t* STR = (const bf16_t*)(ws + OFF_STR);
  bf16_t* ORET = (bf16_t*)(ws + OFF_ORET);
  constexpr int PS = 136;
  bf16_t* Qs = lds;
  bf16_t* Ks = lds + 128 * PS;
  bf16_t* Big = lds + 2 * 128 * PS;
  float* RED = (float*)(lds + 2 * 128 * PS + 256 * PS);
  const int tid = get_tid(), lane = tid & 63, wave = tid >> 6, wm = wave >> 1, wn = wave & 1;
  const int lr = lane & 15, lg = lane >> 4;
  const int t0 = c * 128;
  const int lrow = tid >> 4, lc8 = (tid & 15) * 8;
  const float l2g = log2f(1.f - ex2(-5.f - (float)h));
#pragma unroll
  for (int i = 0; i < 4; i++) {
    const int row = lrow + i * 32;
    *(uint4*)(Qs + row * PS + lc8) = *(const uint4*)(RQ + (size_t)(t0 + row) * 512 + h * 128 + lc8);
    *(uint4*)(Ks + row * PS + lc8) = *(const uint4*)(RK + (size_t)(t0 + row) * 512 + h * 128 + lc8);
  }
#pragma unroll
  for (int i = 0; i < 8; i++) {
    const int row = lrow + i * 32;
    *(uint4*)(Big + row * PS + lc8) = *(const uint4*)(STR + ((size_t)(h * 65 + c) * 256 + row) * 128 + lc8);
  }
  __syncthreads();
  f32x4 s[2][4];
  f32x4 o[2][8];
#pragma unroll
  for (int i = 0; i < 2; i++) {
#pragma unroll
    for (int j = 0; j < 4; j++) s[i][j] = (f32x4){0.f, 0.f, 0.f, 0.f};
#pragma unroll
    for (int j = 0; j < 8; j++) o[i][j] = (f32x4){0.f, 0.f, 0.f, 0.f};
  }
#pragma unroll
  for (int ks = 0; ks < 4; ks++) {
    bf16x8 a0 = ldfrag(Qs, PS, wm * 32 + lr, ks * 32 + lg * 8);
    bf16x8 a1 = ldfrag(Qs, PS, wm * 32 + 16 + lr, ks * 32 + lg * 8);
#pragma unroll
    for (int j = 0; j < 4; j++) {
      bf16x8 bb = ldfrag(Ks, PS, wn * 64 + j * 16 + lr, ks * 32 + lg * 8);
      s[0][j] = MFMA(bb, a0, s[0][j]);
      s[1][j] = MFMA(bb, a1, s[1][j]);
    }
#pragma unroll
    for (int j = 0; j < 8; j++) {
      bf16x8 bb = ldfrag(Big, PS, wn * 128 + j * 16 + lr, ks * 32 + lg * 8);
      o[0][j] = MFMA(bb, a0, o[0][j]);
      o[1][j] = MFMA(bb, a1, o[1][j]);
    }
    __builtin_amdgcn_sched_barrier(0);
  }
#pragma unroll
  for (int i = 0; i < 2; i++) {
    const int q = wm * 32 + i * 16 + lr;
    const float qd = ex2(l2g * (float)(q + 1));
#pragma unroll
    for (int j = 0; j < 8; j++)
#pragma unroll
      for (int r = 0; r < 4; r++) o[i][j][r] *= qd;
  }
  __syncthreads();
#pragma unroll
  for (int i = 0; i < 2; i++) {
    const int q = wm * 32 + i * 16 + lr;
#pragma unroll
    for (int j = 0; j < 4; j++) {
      f32x4 v;
#pragma unroll
      for (int r = 0; r < 4; r++) {
        const int key = wn * 64 + j * 16 + lg * 4 + r;
        v[r] = (key <= q) ? s[i][j][r] * ex2(l2g * (float)(q - key)) : 0.f;
      }
      *(uint2*)(Ks + q * PS + wn * 64 + j * 16 + lg * 4) = pack4(v);
    }
  }
#pragma unroll
  for (int i = 0; i < 8; i++) {
    const int row = lrow + i * 32;
    *(uint4*)(Big + row * PS + lc8) = *(const uint4*)(RVT + (size_t)(h * 256 + row) * LT + t0 + lc8);
  }
  __syncthreads();
#pragma unroll
  for (int ks = 0; ks < 4; ks++) {
    bf16x8 a0 = ldfrag(Ks, PS, wm * 32 + lr, ks * 32 + lg * 8);
    bf16x8 a1 = ldfrag(Ks, PS, wm * 32 + 16 + lr, ks * 32 + lg * 8);
#pragma unroll
    for (int j = 0; j < 8; j++) {
      bf16x8 bb = ldfrag(Big, PS, wn * 128 + j * 16 + lr, ks * 32 + lg * 8);
      o[0][j] = MFMA(bb, a0, o[0][j]);
      o[1][j] = MFMA(bb, a1, o[1][j]);
    }
    __builtin_amdgcn_sched_barrier(0);
  }
#pragma unroll
  for (int i = 0; i < 2; i++) {
    float ss = 0.f;
#pragma unroll
    for (int j = 0; j < 8; j++)
#pragma unroll
      for (int r = 0; r < 4; r++) ss += o[i][j][r] * o[i][j][r];
    ss += __shfl_xor(ss, 16);
    ss += __shfl_xor(ss, 32);
    if (lg == 0) RED[(wm * 32 + i * 16 + lr) * 2 + wn] = ss;
  }
  __syncthreads();
#pragma unroll
  for (int i = 0; i < 2; i++) {
    const int q = wm * 32 + i * 16 + lr;
    const float rs = rsqrtf((RED[q * 2] + RED[q * 2 + 1]) * (1.f / 256.f) + 1e-6f);
#pragma unroll
    for (int j = 0; j < 8; j++) {
      f32x4 v = o[i][j];
#pragma unroll
      for (int r = 0; r < 4; r++) v[r] *= rs;
      *(uint2*)(ORET + (size_t)(t0 + q) * 1024 + h * 256 + wn * 128 + j * 16 + lg * 4) = pack4(v);
    }
  }
}

DEV void hg_item(const Params& p, int h, int c, bf16_t* lds) {
  unsigned char* ws = p.ws;
  const bf16_t* HQ = (const bf16_t*)(ws + OFF_HQ);
  const bf16_t* HK = (const bf16_t*)(ws + OFF_HK);
  const float* HCB = (const float*)(ws + OFF_HCB);
  const bf16_t* HVT = (const bf16_t*)(ws + OFF_HVT);
  const bf16_t* STH = (const bf16_t*)(ws + OFF_STH);
  bf16_t* OHG = (bf16_t*)(ws + OFF_OHG);
  constexpr int PS = 136;
  bf16_t* Qp = lds;
  bf16_t* Kp = lds + 128 * PS;
  bf16_t* As = lds + 2 * 128 * PS;
  float* RED = (float*)(lds + 2 * 128 * PS + 256 * PS);
  const int tid = get_tid(), lane = tid & 63, wave = tid >> 6, wm = wave >> 1, wn = wave & 1;
  const int lr = lane & 15, lg = lane >> 4;
  const int t0 = c * 128, colb = h * 128;
  const int lrow = tid >> 4, lc8 = (tid & 15) * 8;
#pragma unroll
  for (int i = 0; i < 4; i++) {
    const int row = lrow + i * 32;
    const size_t g = (size_t)(t0 + row) * 1024 + colb + lc8;
    uint4 qv = *(const uint4*)(HQ + g);
    float4 c0 = *(const float4*)(HCB + g), c1 = *(const float4*)(HCB + g + 4);
    float4 r0 = make_float4(0.f, 0.f, 0.f, 0.f), r1 = r0;
    if (row >= 32) {
      const size_t gr = (size_t)(t0 + (row & ~31) - 1) * 1024 + colb + lc8;
      r0 = *(const float4*)(HCB + gr); r1 = *(const float4*)(HCB + gr + 4);
    }
    uint4 ov;
    ov.x = pack2(bf2f((bf16_t)(qv.x & 0xffff)) * __expf(c0.x - r0.x), bf2f((bf16_t)(qv.x >> 16)) * __expf(c0.y - r0.y));
    ov.y = pack2(bf2f((bf16_t)(qv.y & 0xffff)) * __expf(c0.z - r0.z), bf2f((bf16_t)(qv.y >> 16)) * __expf(c0.w - r0.w));
    ov.z = pack2(bf2f((bf16_t)(qv.z & 0xffff)) * __expf(c1.x - r1.x), bf2f((bf16_t)(qv.z >> 16)) * __expf(c1.y - r1.y));
    ov.w = pack2(bf2f((bf16_t)(qv.w & 0xffff)) * __expf(c1.z - r1.z), bf2f((bf16_t)(qv.w >> 16)) * __expf(c1.w - r1.w));
    *(uint4*)(Qp + row * PS + lc8) = ov;
  }
  for (int I = 0; I < 4; I++) {
    const int nrows = 32 * (I + 1);
    float4 r0 = make_float4(0.f, 0.f, 0.f, 0.f), r1 = r0;
    if (I > 0) {
      const size_t gr = (size_t)(t0 + 32 * I - 1) * 1024 + colb + lc8;
      r0 = *(const float4*)(HCB + gr); r1 = *(const float4*)(HCB + gr + 4);
    }
#pragma unroll
    for (int i = 0; i < 4; i++) {
      const int row = lrow + i * 32;
      if (row < nrows) {
        const size_t g = (size_t)(t0 + row) * 1024 + colb + lc8;
        uint4 kv = *(const uint4*)(HK + g);
        float4 c0 = *(const float4*)(HCB + g), c1 = *(const float4*)(HCB + g + 4);
        uint4 ov;
        ov.x = pack2(bf2f((bf16_t)(kv.x & 0xffff)) * __expf(fminf(r0.x - c0.x, 80.f)), bf2f((bf16_t)(kv.x >> 16)) * __expf(fminf(r0.y - c0.y, 80.f)));
        ov.y = pack2(bf2f((bf16_t)(kv.y & 0xffff)) * __expf(fminf(r0.z - c0.z, 80.f)), bf2f((bf16_t)(kv.y >> 16)) * __expf(fminf(r0.w - c0.w, 80.f)));
        ov.z = pack2(bf2f((bf16_t)(kv.z & 0xffff)) * __expf(fminf(r1.x - c1.x, 80.f)), bf2f((bf16_t)(kv.z >> 16)) * __expf(fminf(r1.y - c1.y, 80.f)));
        ov.w = pack2(bf2f((bf16_t)(kv.w & 0xffff)) * __expf(fminf(r1.z - c1.z, 80.f)), bf2f((bf16_t)(kv.w >> 16)) * __expf(fminf(r1.w - c1.w, 80.f)));
        *(uint4*)(Kp + row * PS + lc8) = ov;
      }
    }
    __syncthreads();
    if (wave * 16 < nrows) {
      f32x4 a2[2];
      a2[0] = (f32x4){0.f, 0.f, 0.f, 0.f}; a2[1] = a2[0];
#pragma unroll
      for (int ks = 0; ks < 4; ks++) {
        bf16x8 bb = ldfrag(Kp, PS, wave * 16 + lr, ks * 32 + lg * 8);
        bf16x8 a0 = ldfrag(Qp, PS, 32 * I + lr, ks * 32 + lg * 8);
        bf16x8 a1 = ldfrag(Qp, PS, 32 * I + 16 + lr, ks * 32 + lg * 8);
        a2[0] = MFMA(bb, a0, a2[0]);
        a2[1] = MFMA(bb, a1, a2[1]);
      }
#pragma unroll
      for (int i = 0; i < 2; i++) {
        const int q = 32 * I + i * 16 + lr;
        f32x4 v;
#pragma unroll
        for (int r = 0; r < 4; r++) { const int key = wave * 16 + lg * 4 + r; v[r] = (key <= q) ? a2[i][r] : 0.f; }
        *(uint2*)(As + q * PS + wave * 16 + lg * 4) = pack4(v);
      }
    } else {
#pragma unroll
      for (int i = 0; i < 2; i++) {
        const int q = 32 * I + i * 16 + lr;
        *(uint2*)(As + q * PS + wave * 16 + lg * 4) = make_uint2(0u, 0u);
      }
    }
    __syncthreads();
  }
#pragma unroll
  for (int i = 0; i < 4; i++) {
    const int row = lrow + i * 32;
    *(uint4*)(Kp + row * PS + lc8) = *(const uint4*)(HVT + (size_t)(colb + row) * LT + t0 + lc8);
  }
  __syncthreads();
  f32x4 o[2][4];
#pragma unroll
  for (int i = 0; i < 2; i++)
#pragma unroll
    for (int j = 0; j < 4; j++) o[i][j] = (f32x4){0.f, 0.f, 0.f, 0.f};
#pragma unroll
  for (int ks = 0; ks < 4; ks++) {
    bf16x8 a0 = ldfrag(As, PS, wm * 32 + lr, ks * 32 + lg * 8);
    bf16x8 a1 = ldfrag(As, PS, wm * 32 + 16 + lr, ks * 32 + lg * 8);
#pragma unroll
    for (int j = 0; j < 4; j++) {
      bf16x8 bb = ldfrag(Kp, PS, wn * 64 + j * 16 + lr, ks * 32 + lg * 8);
      o[0][j] = MFMA(bb, a0, o[0][j]);
      o[1][j] = MFMA(bb, a1, o[1][j]);
    }
    __builtin_amdgcn_sched_barrier(0);
  }
  __syncthreads();
#pragma unroll
  for (int i = 0; i < 4; i++) {
    const int row = lrow + i * 32;
    const size_t g = (size_t)(t0 + row) * 1024 + colb + lc8;
    uint4 qv = *(const uint4*)(HQ + g);
    float4 c0 = *(const float4*)(HCB + g), c1 = *(const float4*)(HCB + g + 4);
    uint4 ov;
    ov.x = pack2(bf2f((bf16_t)(qv.x & 0xffff)) * __expf(c0.x), bf2f((bf16_t)(qv.x >> 16)) * __expf(c0.y));
    ov.y = pack2(bf2f((bf16_t)(qv.y & 0xffff)) * __expf(c0.z), bf2f((bf16_t)(qv.y >> 16)) * __expf(c0.w));
    ov.z = pack2(bf2f((bf16_t)(qv.z & 0xffff)) * __expf(c1.x), bf2f((bf16_t)(qv.z >> 16)) * __expf(c1.y));
    ov.w = pack2(bf2f((bf16_t)(qv.w & 0xffff)) * __expf(c1.z), bf2f((bf16_t)(qv.w >> 16)) * __expf(c1.w));
    *(uint4*)(Qp + row * PS + lc8) = ov;
    *(uint4*)(Kp + row * PS + lc8) = *(const uint4*)(STH + ((size_t)(h * 65 + c) * 128 + row) * 128 + lc8);
  }
  __syncthreads();
#pragma unroll
  for (int ks = 0; ks < 4; ks++) {
    bf16x8 a0 = ldfrag(Qp, PS, wm * 32 + lr, ks * 32 + lg * 8);
    bf16x8 a1 = ldfrag(Qp, PS, wm * 32 + 16 + lr, ks * 32 + lg * 8);
#pragma unroll
    for (int j = 0; j < 4; j++) {
      bf16x8 bb = ldfrag(Kp, PS, wn * 64 + j * 16 + lr, ks * 32 + lg * 8);
      o[0][j] = MFMA(bb, a0, o[0][j]);
      o[1][j] = MFMA(bb, a1, o[1][j]);
    }
    __builtin_amdgcn_sched_barrier(0);
  }
#pragma unroll
  for (int i = 0; i < 2; i++) {
    float ss = 0.f;
#pragma unroll
    for (int j = 0; j < 4; j++)
#pragma unroll
      for (int r = 0; r < 4; r++) ss += o[i][j][r] * o[i][j][r];
    ss += __shfl_xor(ss, 16);
    ss += __shfl_xor(ss, 32);
    if (lg == 0) RED[(wm * 32 + i * 16 + lr) * 2 + wn] = ss;
  }
  __syncthreads();
#pragma unroll
  for (int i = 0; i < 2; i++) {
    const int q = wm * 32 + i * 16 + lr;
    const float rs = rsqrtf((RED[q * 2] + RED[q * 2 + 1]) * (1.f / 128.f) + 1e-6f);
#pragma unroll
    for (int j = 0; j < 4; j++) {
      f32x4 v = o[i][j];
#pragma unroll
      for (int r = 0; r < 4; r++) v[r] *= rs;
      *(uint2*)(OHG + (size_t)(t0 + q) * 1024 + colb + wn * 64 + j * 16 + lg * 4) = pack4(v);
    }
  }
}

DEV void phase_O(const Params& p, int layer, int qidx, unsigned char* ldsraw) {
  bf16_t* lds = (bf16_t*)ldsraw;
  int* ctr = (int*)(p.ws + OFF_CTR) + qidx;
  int* sitem = (int*)(ldsraw + LDS_BYTES - 16);
  const float* lp = p.in[7] + layer * 256;
  float d0 = 0.f, d1 = 0.f;
  for (int i = 0; i < 64; i++) { d0 += lp[i] * lp[64 + i]; d1 += lp[128 + i] * lp[192 + i]; }
  int ly = layer; asm volatile("" : "+s"(ly));
  const float li = (ly == 0) ? 0.2f : 0.35550906759f;
  const float lam = __uint_as_float(__builtin_amdgcn_readfirstlane(__float_as_uint(__expf(d0) - __expf(d1) + li)));
  const int tid0 = get_tid();
  for (;;) {
    __syncthreads();
    if (tid0 == 0) *sitem = atomicAdd(ctr, 1);
    __syncthreads();
    const int item = __builtin_amdgcn_readfirstlane(*sitem);
    if (item >= 1300) break;
    if (item < 520) attn_item(p, layer, item & 7, 64 - (item >> 3), lam, lds);
    else if (item < 780) ret_item(p, (item - 520) & 3, (item - 520) >> 2, lds);
    else hg_item(p, (item - 780) & 7, (item - 780) >> 3, lds);
  }
}

DEV void phase_G(const Params& p, unsigned char* ldsraw) {
  unsigned char* ws = p.ws;
  bf16_t* lds = (bf16_t*)ldsraw;
  const bf16_t* HN = (const bf16_t*)(ws + OFF_HN);
  const bf16_t* WIN = (const bf16_t*)(ws + OFF_WIN);
  for (int item = vblock(); item < 33 * 20; item += gridDim.x) {
    int nt, mt; tile_map(item, 33, 4, mt, nt);
    int n0, cb; bf16_t* dst; int ld; bool gate;
    if (nt < 4) { n0 = 2048 + nt * 256; cb = nt * 256; dst = (bf16_t*)(ws + OFF_ORET); ld = 1024; gate = true; }
    else if (nt < 8) { n0 = 6144 + (nt - 4) * 256; cb = (nt - 4) * 256; dst = (bf16_t*)(ws + OFF_OHG); ld = 1024; gate = true; }
    else { n0 = 10240 + (nt - 8) * 256; cb = (nt - 8) * 256; dst = (bf16_t*)(ws + OFF_G); ld = 3072; gate = false; }
    f32x4 acc[4][8];
#pragma unroll
    for (int i = 0; i < 4; i++)
#pragma unroll
      for (int j = 0; j < 8; j++) acc[i][j] = (f32x4){0.f, 0.f, 0.f, 0.f};
    gemm256_acc(acc, HN + (size_t)mt * 256 * 1024, 1024, LT - mt * 256, WIN + (size_t)n0 * 1024, 1024, 1024, lds);
    const int tid = get_tid(), lane = tid & 63, wave = tid >> 6, wm = wave >> 1, wn = wave & 1; const int lr = lane & 15, lg = lane >> 4;
#pragma unroll
    for (int i = 0; i < 4; i++) {
      const int t = mt * 256 + wm * 64 + i * 16 + lr;
      if (t < LT) {
#pragma unroll
        for (int j = 0; j < 8; j++) {
          bf16_t* d = dst + (size_t)t * ld + cb + wn * 128 + j * 16 + lg * 4;
          f32x4 v;
          if (gate) {
            uint2 ov = *(const uint2*)d;
            v[0] = bf2f((bf16_t)(ov.x & 0xffff)) * silu_f(acc[i][j][0]);
            v[1] = bf2f((bf16_t)(ov.x >> 16)) * silu_f(acc[i][j][1]);
            v[2] = bf2f((bf16_t)(ov.y & 0xffff)) * silu_f(acc[i][j][2]);
            v[3] = bf2f((bf16_t)(ov.y >> 16)) * silu_f(acc[i][j][3]);
          } else {
#pragma unroll
            for (int r = 0; r < 4; r++) v[r] = sigmoid_f(acc[i][j][r]);
          }
          *(uint2*)d = pack4(v);
        }
      }
    }
  }
}

DEV void phase_Y(const Params& p, unsigned char* ldsraw) {
  unsigned char* ws = p.ws;
  bf16_t* lds = (bf16_t*)ldsraw;
  const bf16_t* WB = (const bf16_t*)(ws + OFF_WB);
  const bf16_t* G = (const bf16_t*)(ws + OFF_G);
  bf16_t* Y = (bf16_t*)(ws + OFF_Y);
  for (int item = vblock(); item < 65 * 8; item += gridDim.x) {
    int nt, mt; tile_map(item, 65, 4, mt, nt);
    f32x4 y[2][4];
#pragma unroll
    for (int i = 0; i < 2; i++)
#pragma unroll
      for (int j = 0; j < 4; j++) y[i][j] = (f32x4){0.f, 0.f, 0.f, 0.f};
#pragma unroll 1
    for (int br = 0; br < 3; br++) {
      const bf16_t* Ab = (const bf16_t*)(ws + (br == 0 ? OFF_ORET : (br == 1 ? OFF_OHG : OFF_ODA))) + (size_t)mt * 128 * 1024;
      f32x4 acc[2][4];
#pragma unroll
      for (int i = 0; i < 2; i++)
#pragma unroll
        for (int j = 0; j < 4; j++) acc[i][j] = (f32x4){0.f, 0.f, 0.f, 0.f};
      gemm_acc<128, false>(acc, Ab, 1024, WB + ((size_t)br * 1024 + nt * 128) * 1024, 1024, 1024, lds);
      const int tid = get_tid(), lane = tid & 63, wave = tid >> 6, wm = wave >> 1, wn = wave & 1; const int lr = lane & 15, lg = lane >> 4; (void)tid; (void)lane; (void)wm; (void)wn; (void)lr; (void)lg;
#pragma unroll
      for (int i = 0; i < 2; i++) {
        const int t = mt * 128 + wm * 32 + i * 16 + lr;
#pragma unroll
        for (int j = 0; j < 4; j++) {
          uint2 gv = *(const uint2*)(G + (size_t)t * 3072 + br * 1024 + nt * 128 + wn * 64 + j * 16 + lg * 4);
          y[i][j][0] += bf2f((bf16_t)(gv.x & 0xffff)) * acc[i][j][0];
          y[i][j][1] += bf2f((bf16_t)(gv.x >> 16)) * acc[i][j][1];
          y[i][j][2] += bf2f((bf16_t)(gv.y & 0xffff)) * acc[i][j][2];
          y[i][j][3] += bf2f((bf16_t)(gv.y >> 16)) * acc[i][j][3];
        }
      }
    }
    const int tid = get_tid(), lane = tid & 63, wave = tid >> 6, wm = wave >> 1, wn = wave & 1; const int lr = lane & 15, lg = lane >> 4;
#pragma unroll
    for (int i = 0; i < 2; i++) {
      const int t = mt * 128 + wm * 32 + i * 16 + lr;
#pragma unroll
      for (int j = 0; j < 4; j++)
        *(uint2*)(Y + (size_t)t * 1024 + nt * 128 + wn * 64 + j * 16 + lg * 4) = pack4(y[i][j]);
    }
  }
}

DEV void phase_resid(const Params& p, int b, const bf16_t* A, int K, const bf16_t* Wt, unsigned char* ldsraw) {
  bf16_t* lds = (bf16_t*)ldsraw;
  for (int item = vblock(); item < 65 * 8; item += gridDim.x) {
    int nt, mt; tile_map(item, 65, 4, mt, nt);
    f32x4 acc[2][4];
#pragma unroll
    for (int i = 0; i < 2; i++)
#pragma unroll
      for (int j = 0; j < 4; j++) acc[i][j] = (f32x4){0.f, 0.f, 0.f, 0.f};
    gemm_acc<128, false>(acc, A + (size_t)mt * 128 * K, K, Wt + (size_t)nt * 128 * K, K, K, lds);
      const int tid = get_tid(), lane = tid & 63, wave = tid >> 6, wm = wave >> 1, wn = wave & 1; const int lr = lane & 15, lg = lane >> 4; (void)tid; (void)lane; (void)wm; (void)wn; (void)lr; (void)lg;
#pragma unroll
    for (int i = 0; i < 2; i++) {
      const int t = mt * 128 + wm * 32 + i * 16 + lr;
#pragma unroll
      for (int j = 0; j < 4; j++) {
        float4* d = (float4*)(hrow(p, b, t) + nt * 128 + wn * 64 + j * 16 + lg * 4);
        float4 v = *d;
        v.x += acc[i][j][0]; v.y += acc[i][j][1]; v.z += acc[i][j][2]; v.w += acc[i][j][3];
        *d = v;
      }
    }
  }
}

DEV void phase_F1(const Params& p, unsigned char* ldsraw) {
  unsigned char* ws = p.ws;
  bf16_t* lds = (bf16_t*)ldsraw;
  const bf16_t* HN = (const bf16_t*)(ws + OFF_HN);
  const bf16_t* WFI = (const bf16_t*)(ws + OFF_WFI);
  bf16_t* U = (bf16_t*)(ws + OFF_U);
  for (int item = vblock(); item < 33 * 22; item += gridDim.x) {
    int nt, mt; tile_map(item, 33, 2, mt, nt);
    f32x4 acc[4][8];
#pragma unroll
    for (int i = 0; i < 4; i++)
#pragma unroll
      for (int j = 0; j < 8; j++) acc[i][j] = (f32x4){0.f, 0.f, 0.f, 0.f};
    gemm256_acc(acc, HN + (size_t)mt * 256 * 1024, 1024, LT - mt * 256, WFI + (size_t)nt * 256 * 1024, 1024, 1024, lds);
    const int tid = get_tid(), lane = tid & 63, wave = tid >> 6, wm = wave >> 1, wn = wave & 1; const int lr = lane & 15, lg = lane >> 4;
#pragma unroll
    for (int i = 0; i < 4; i++) {
      const int t = mt * 256 + wm * 64 + i * 16 + lr;
      if (t < LT) {
        const float vm = (t >= 112) ? 1.f : 0.f;
#pragma unroll
        for (int j = 0; j < 8; j++) {
          f32x4 v = acc[i][j];
#pragma unroll
          for (int r = 0; r < 4; r++) v[r] *= vm;
          *(uint2*)(U + (size_t)t * 5632 + nt * 256 + wn * 128 + j * 16 + lg * 4) = pack4(v);
        }
      }
    }
  }
}

DEV void phase_conv(const Params& p, int layer) {
  unsigned char* ws = p.ws;
  const bf16_t* U = (const bf16_t*)(ws + OFF_U);
  bf16_t* GF = (bf16_t*)(ws + OFF_GF);
  const float* cw = p.in[11] + (size_t)layer * 3 * 5632;
  const float* cbias = p.in[12] + (size_t)layer * 5632;
  for (int idx = get_bid() * NTHR + get_tid(); idx < LT * 352; idx += gridDim.x * NTHR) {
    const int t = idx / 352, c8 = (idx - t * 352) * 8;
    float g[8], v[8];
#pragma unroll
    for (int k = 0; k < 8; k++) { g[k] = cbias[c8 + k]; v[k] = cbias[2816 + c8 + k]; }
#pragma unroll
    for (int j = 0; j < 3; j++) {
      const int tt = t - 2 + j;
      if (tt >= 0) {
        uint4 ug = *(const uint4*)(U + (size_t)tt * 5632 + c8);
        uint4 uv = *(const uint4*)(U + (size_t)tt * 5632 + 2816 + c8);
        const float* wg = cw + j * 5632 + c8;
        const float* wv = cw + j * 5632 + 2816 + c8;
        const unsigned ugs[4] = {ug.x, ug.y, ug.z, ug.w};
        const unsigned uvs[4] = {uv.x, uv.y, uv.z, uv.w};
#pragma unroll
        for (int k = 0; k < 4; k++) {
          g[2 * k] += wg[2 * k] * bf2f((bf16_t)(ugs[k] & 0xffff));
          g[2 * k + 1] += wg[2 * k + 1] * bf2f((bf16_t)(ugs[k] >> 16));
          v[2 * k] += wv[2 * k] * bf2f((bf16_t)(uvs[k] & 0xffff));
          v[2 * k + 1] += wv[2 * k + 1] * bf2f((bf16_t)(uvs[k] >> 16));
        }
      }
    }
    uint4 o;
    o.x = pack2(silu_f(g[0]) * v[0], silu_f(g[1]) * v[1]);
    o.y = pack2(silu_f(g[2]) * v[2], silu_f(g[3]) * v[3]);
    o.z = pack2(silu_f(g[4]) * v[4], silu_f(g[5]) * v[5]);
    o.w = pack2(silu_f(g[6]) * v[6], silu_f(g[7]) * v[7]);
    *(uint4*)(GF + (size_t)t * 2816 + c8) = o;
  }
}

__global__ void __launch_bounds__(NTHR) fwd_megakernel(Params p) {
  extern __shared__ __attribute__((aligned(16))) unsigned char lds[];
  cg::grid_group grid = cg::this_grid();
  unsigned bar_target = 0;
  unsigned* bar_word = (unsigned*)(p.ws + OFF_CTR) + 32;
#define GRID_SYNC() do { \
    asm volatile("s_waitcnt vmcnt(0) lgkmcnt(0)" ::: "memory"); \
    __syncthreads(); \
    bar_target += gridDim.x; \
    if (threadIdx.x == 0) { \
      __builtin_amdgcn_fence(__ATOMIC_RELEASE, "agent"); \
      asm volatile("s_waitcnt vmcnt(0)" ::: "memory"); \
      __hip_atomic_fetch_add(bar_word, 1u, __ATOMIC_RELAXED, __HIP_MEMORY_SCOPE_AGENT); \
      while (__hip_atomic_load(bar_word, __ATOMIC_RELAXED, __HIP_MEMORY_SCOPE_AGENT) < bar_target) __builtin_amdgcn_s_sleep(1); \
      __builtin_amdgcn_fence(__ATOMIC_ACQUIRE, "agent"); \
      asm volatile("s_waitcnt vmcnt(0)" ::: "memory"); \
    } \
    __syncthreads(); \
  } while (0)
  grid.sync();
  unsigned char* ws = p.ws;
  phase_init(p);
  phase_convert(p, 0, lds);
  GRID_SYNC();
  for (int layer = 0; layer < 2; layer++) {
    if (layer == 1) { phase_convert(p, 1, lds); GRID_SYNC(); }
    for (int b = 0; b < 2; b++) {
      phase_norm(p, b, p.in[2] + layer * 1024, (bf16_t*)(ws + OFF_HN));
      GRID_SYNC();
      phase_projA(p, layer, lds);
      GRID_SYNC();
      phase_U(p, lds);
      GRID_SYNC();
      phase_scan(p);
      GRID_SYNC();
      phase_O(p, layer, layer * 2 + b, lds);
      GRID_SYNC();
      phase_G(p, lds);
      GRID_SYNC();
      phase_Y(p, lds);
      GRID_SYNC();
      phase_resid(p, b, (const bf16_t*)(ws + OFF_Y), 1024, (const bf16_t*)(ws + OFF_WO), lds);
      GRID_SYNC();
      phase_norm(p, b, p.in[9] + layer * 1024, (bf16_t*)(ws + OFF_HN));
      GRID_SYNC();
      phase_F1(p, lds);
      GRID_SYNC();
      phase_conv(p, layer);
      GRID_SYNC();
      phase_resid(p, b, (const bf16_t*)(ws + OFF_GF), DFF, (const bf16_t*)(ws + OFF_WFO), lds);
      GRID_SYNC();
    }
  }
  phase_final(p);
}

extern "C" void kernel_launch(void* const* d_in, const int* in_sizes, int n_in, void* d_out, int out_size,
                              void* d_ws, size_t ws_size, hipStream_t stream) {
  static int grid_blocks = 0;
  if (grid_blocks == 0) {
    if (n_in != 15 || ws_size < OFF_END) {
      fprintf(stderr, "kernel_launch: need 15 inputs and %zu bytes of workspace, got %d and %zu\n", (size_t)OFF_END, n_in, ws_size);
      grid_blocks = -1; return;
    }
    int dev = 0, cus = 0, per_cu = 0;
    hipGetDevice(&dev);
    hipDeviceGetAttribute(&cus, hipDeviceAttributeMultiprocessorCount, dev);
    if (hipFuncSetAttribute((const void*)fwd_megakernel, hipFuncAttributeMaxDynamicSharedMemorySize, LDS_BYTES) != hipSuccess) {
      fprintf(stderr, "kernel_launch: hipFuncSetAttribute failed\n"); grid_blocks = -1; return;
    }
    hipOccupancyMaxActiveBlocksPerMultiprocessor(&per_cu, (const void*)fwd_megakernel, NTHR, LDS_BYTES);
    if (per_cu < 1) per_cu = 1;
    if (per_cu > 1) per_cu = 1;
    grid_blocks = cus * per_cu;
  }
  if (grid_blocks < 0) return;
  hipMemsetAsync((char*)d_ws + OFF_CTR, 0, 256, stream);
  Params p{};
  for (int i = 0; i < 15; i++) p.in[i] = (const float*)d_in[i];
  p.out = (float*)d_out;
  p.ws = (unsigned char*)d_ws;
  void* args[] = {&p};
  hipError_t e = hipLaunchCooperativeKernel((const void*)fwd_megakernel, dim3(grid_blocks), dim3(NTHR), args, LDS_BYTES, stream);
  if (e != hipSuccess) fprintf(stderr, "cooperative launch failed: %s (grid %d)\n", hipGetErrorString(e), grid_blocks);
}
```

```cpp
#include <hip/hip_runtime.h>
#include <hip/hip_cooperative_groups.h>
#include <cstdio>
#include <cstdint>
namespace cg = cooperative_groups;

typedef unsigned short bf16_t;
typedef __attribute__((ext_vector_type(8))) short bf16x8;
typedef __attribute__((ext_vector_type(4))) short bf16x4;
typedef __attribute__((ext_vector_type(4))) float f32x4;
typedef __attribute__((ext_vector_type(4))) unsigned u32x4;

#define DEV __device__ __forceinline__
#define MFMA(a, b, c) __builtin_amdgcn_mfma_f32_16x16x32_bf16(a, b, c, 0, 0, 0)

constexpr int LT = 8320;
constexpr int NCH = 65;
constexpr int NTHR = 512;
constexpr int LDS_BYTES = 144 * 1024;
constexpr int INW = 13312;
constexpr int DFF = 2816;

constexpr size_t SZ_ACT = (size_t)LT * 1024 * 2;
constexpr size_t OFF_WIN = 0;
constexpr size_t OFF_WB = OFF_WIN + (size_t)INW * 1024 * 2;
constexpr size_t OFF_WO = OFF_WB + (size_t)3 * 1024 * 1024 * 2;
constexpr size_t OFF_WFI = OFF_WO + (size_t)1024 * 1024 * 2;
constexpr size_t OFF_WFO = OFF_WFI + (size_t)5632 * 1024 * 2;
constexpr size_t OFF_H = OFF_WFO + (size_t)1024 * 2816 * 2;
constexpr size_t OFF_HN = OFF_H + (size_t)2 * 128 * 1024 * 4;
constexpr size_t OFF_R128 = OFF_HN + SZ_ACT;
constexpr size_t OFF_R64 = OFF_R128 + (size_t)LT * 64 * 8;
constexpr size_t OFF_CTR = OFF_R64 + (size_t)LT * 32 * 8;
constexpr size_t OFF_ARENA = OFF_CTR + 256;
constexpr size_t OFF_RQ = OFF_ARENA;
constexpr size_t OFF_RK = OFF_RQ + SZ_ACT / 2;
constexpr size_t OFF_RKT = OFF_RK + SZ_ACT / 2;
constexpr size_t OFF_RVT = OFF_RKT + SZ_ACT / 2;
constexpr size_t OFF_HQ = OFF_RVT + SZ_ACT;
constexpr size_t OFF_HK = OFF_HQ + SZ_ACT;
constexpr size_t OFF_HCB = OFF_HK + SZ_ACT;
constexpr size_t OFF_HKET = OFF_HCB + 2 * SZ_ACT;
constexpr size_t OFF_HVT = OFF_HKET + SZ_ACT;
constexpr size_t OFF_DQ = OFF_HVT + SZ_ACT;
constexpr size_t OFF_DK = OFF_DQ + SZ_ACT;
constexpr size_t OFF_DVT = OFF_DK + SZ_ACT;
constexpr size_t OFF_ORET = OFF_DVT + SZ_ACT;
constexpr size_t OFF_OHG = OFF_ORET + SZ_ACT;
constexpr size_t OFF_STR = OFF_OHG + SZ_ACT;
constexpr size_t OFF_STH = OFF_STR + SZ_ACT;
constexpr size_t OFF_HDEC = OFF_STH + SZ_ACT;
constexpr size_t OFF_END = OFF_HDEC + (size_t)65 * 1024 * 4;
constexpr size_t OFF_G = OFF_RQ;
constexpr size_t OFF_Y = OFF_HK;
constexpr size_t OFF_ODA = OFF_HKET;
constexpr size_t OFF_U = OFF_ARENA;
constexpr size_t OFF_GF = OFF_U + (size_t)LT * 5632 * 2;

struct Params {
  const float* in[15];
  float* out;
  unsigned char* ws;
};

DEV int get_tid() { int t = threadIdx.x; asm volatile("" : "+v"(t)); return t; }
DEV int get_bid() { int b = blockIdx.x; asm volatile("" : "+s"(b)); return b; }
DEV float* hrow(const Params& p, int b, int t) {
  return (t < 128) ? (float*)(p.ws + OFF_H) + (size_t)(b * 128 + t) * 1024 : p.out + ((size_t)b * 8192 + (t - 128)) * 1024;
}
DEV bf16_t f2bf(float f) {
  unsigned u = __float_as_uint(f);
  u += 0x7fffu + ((u >> 16) & 1u);
  return (bf16_t)(u >> 16);
}
DEV float bf2f(bf16_t h) { return __uint_as_float(((unsigned)h) << 16); }
DEV unsigned pack2(float a, float b) { return (unsigned)f2bf(a) | ((unsigned)f2bf(b) << 16); }
DEV uint2 pack4(f32x4 v) { uint2 r; r.x = pack2(v[0], v[1]); r.y = pack2(v[2], v[3]); return r; }
DEV float silu_f(float x) { return x / (1.f + __expf(-x)); }
DEV float sigmoid_f(float x) { return 1.f / (1.f + __expf(-x)); }
DEV float ex2(float x) { return __builtin_amdgcn_exp2f(x); }
DEV bf16x8 ldfrag(const bf16_t* base, int stride, int row, int k) {
  return *(const bf16x8*)(base + row * stride + k);
}

template <int BN, bool TRANS>
DEV void gemm_compute(f32x4 (&acc)[2][BN / 32], const bf16_t* as, const bf16_t* bs) {
  constexpr int NJ = BN / 32, LS = 72;
#pragma unroll
  for (int ks = 0; ks < 2; ks++) {
    bf16x8 a0 = *(const bf16x8*)(as + ks * 32);
    bf16x8 a1 = *(const bf16x8*)(as + 16 * LS + ks * 32);
#pragma unroll
    for (int j = 0; j < NJ; j++) {
      bf16x8 bb = *(const bf16x8*)(bs + j * 16 * LS + ks * 32);
      if (TRANS) {
        acc[0][j] = MFMA(a0, bb, acc[0][j]);
        acc[1][j] = MFMA(a1, bb, acc[1][j]);
      } else {
        acc[0][j] = MFMA(bb, a0, acc[0][j]);
        acc[1][j] = MFMA(bb, a1, acc[1][j]);
      }
    }
  }
}

template <int BN, bool TRANS>
DEV void gemm_acc(f32x4 (&acc)[2][BN / 32], const bf16_t* __restrict__ A, int lda,
                  const bf16_t* __restrict__ Bt, int ldb, int K, bf16_t* lds) {
  constexpr int LS = 72, A_SZ = 128 * LS, B_SZ = BN * LS, NB = BN / 64;
  const int tid = get_tid(), lane = tid & 63, wave = tid >> 6, wm = wave >> 1, wn = wave & 1;
  const int lr = lane & 15, lg = lane >> 4;
  bf16_t* As = lds;
  bf16_t* Bs = lds + 2 * A_SZ;
  const int crow = tid >> 3, ckc = (tid & 7) * 8;
  const bf16_t* ga = A + (size_t)crow * lda + ckc;
  const bf16_t* gb = Bt + (size_t)crow * ldb + ckc;
  u32x4 ra0, ra1, rb0, rb1, rb2, rb3;
#define GLOAD(k0)                                                        \
  ra0 = *(const u32x4*)(ga + (k0));                                      \
  ra1 = *(const u32x4*)(ga + (size_t)64 * lda + (k0));                   \
  rb0 = *(const u32x4*)(gb + (k0));                                      \
  rb1 = *(const u32x4*)(gb + (size_t)64 * ldb + (k0));                   \
  if (NB == 4) {                                                         \
    rb2 = *(const u32x4*)(gb + (size_t)128 * ldb + (k0));                \
    rb3 = *(const u32x4*)(gb + (size_t)192 * ldb + (k0));                \
  }
#define LSTORE(buf)                                                      \
  *(u32x4*)(As + (buf) * A_SZ + crow * LS + ckc) = ra0;                  \
  *(u32x4*)(As + (buf) * A_SZ + (crow + 64) * LS + ckc) = ra1;           \
  *(u32x4*)(Bs + (buf) * B_SZ + crow * LS + ckc) = rb0;                  \
  *(u32x4*)(Bs + (buf) * B_SZ + (crow + 64) * LS + ckc) = rb1;           \
  if (NB == 4) {                                                         \
    *(u32x4*)(Bs + (buf) * B_SZ + (crow + 128) * LS + ckc) = rb2;        \
    *(u32x4*)(Bs + (buf) * B_SZ + (crow + 192) * LS + ckc) = rb3;        \
  }
  GLOAD(0)
  __syncthreads();
  LSTORE(0)
  __syncthreads();
  const int nk = K / 64;
  const int aoff = (wm * 32 + lr) * LS + lg * 8;
  const int boff = (wn * (BN / 2) + lr) * LS + lg * 8;
  for (int kt = 0; kt < nk - 1; kt++) {
    const int cur = kt & 1;
    GLOAD((kt + 1) * 64)
    gemm_compute<BN, TRANS>(acc, As + cur * A_SZ + aoff, Bs + cur * B_SZ + boff);
    LSTORE(cur ^ 1)
    __syncthreads();
  }
  {
    const int cur = (nk - 1) & 1;
    gemm_compute<BN, TRANS>(acc, As + cur * A_SZ + aoff, Bs + cur * B_SZ + boff);
    __syncthreads();
  }
#undef GLOAD
#undef LSTORE
}

DEV void gemm256_compute(f32x4 (&acc)[4][8], const bf16_t* as, const bf16_t* bs) {
  constexpr int LS = 72;
#pragma unroll
  for (int ks = 0; ks < 2; ks++) {
    bf16x8 a[4];
#pragma unroll
    for (int i = 0; i < 4; i++) a[i] = *(const bf16x8*)(as + i * 16 * LS + ks * 32);
#pragma unroll
    for (int j = 0; j < 8; j++) {
      bf16x8 bb = *(const bf16x8*)(bs + j * 16 * LS + ks * 32);
#pragma unroll
      for (int i = 0; i < 4; i++) acc[i][j] = MFMA(bb, a[i], acc[i][j]);
    }
  }
}

DEV void gemm256_acc(f32x4 (&acc)[4][8], const bf16_t* __restrict__ A, int lda, int m_valid,
                     const bf16_t* __restrict__ Bt, int ldb, int K, bf16_t* lds) {
  constexpr int LS = 72, T_SZ = 256 * LS;
  const int tid = get_tid(), lane = tid & 63, wave = tid >> 6, wm = wave >> 1, wn = wave & 1;
  const int lr = lane & 15, lg = lane >> 4;
  bf16_t* As = lds;
  bf16_t* Bs = lds + 2 * T_SZ;
  const int crow = tid >> 3, ckc = (tid & 7) * 8;
  const bf16_t* ga0 = A + (size_t)min(crow, m_valid - 1) * lda + ckc;
  const bf16_t* ga1 = A + (size_t)min(crow + 64, m_valid - 1) * lda + ckc;
  const bf16_t* ga2 = A + (size_t)min(crow + 128, m_valid - 1) * lda + ckc;
  const bf16_t* ga3 = A + (size_t)min(crow + 192, m_valid - 1) * lda + ckc;
  const bf16_t* gb = Bt + (size_t)crow * ldb + ckc;
  u32x4 ra0, ra1, ra2, ra3, rb0, rb1, rb2, rb3;
#define GLOAD(k0)                                                        \
  ra0 = *(const u32x4*)(ga0 + (k0));                                     \
  ra1 = *(const u32x4*)(ga1 + (k0));                                     \
  ra2 = *(const u32x4*)(ga2 + (k0));                                     \
  ra3 = *(const u32x4*)(ga3 + (k0));                                     \
  rb0 = *(const u32x4*)(gb + (k0));                                      \
  rb1 = *(const u32x4*)(gb + (size_t)64 * ldb + (k0));                   \
  rb2 = *(const u32x4*)(gb + (size_t)128 * ldb + (k0));                  \
  rb3 = *(const u32x4*)(gb + (size_t)192 * ldb + (k0));
#define LSTORE(buf)                                                      \
  *(u32x4*)(As + (buf) * T_SZ + crow * LS + ckc) = ra0;                  \
  *(u32x4*)(As + (buf) * T_SZ + (crow + 64) * LS + ckc) = ra1;           \
  *(u32x4*)(As + (buf) * T_SZ + (crow + 128) * LS + ckc) = ra2;          \
  *(u32x4*)(As + (buf) * T_SZ + (crow + 192) * LS + ckc) = ra3;          \
  *(u32x4*)(Bs + (buf) * T_SZ + crow * LS + ckc) = rb0;                  \
  *(u32x4*)(Bs + (buf) * T_SZ + (crow + 64) * LS + ckc) = rb1;           \
  *(u32x4*)(Bs + (buf) * T_SZ + (crow + 128) * LS + ckc) = rb2;          \
  *(u32x4*)(Bs + (buf) * T_SZ + (crow + 192) * LS + ckc) = rb3;
  GLOAD(0)
  __syncthreads();
  LSTORE(0)
  __syncthreads();
  const int nk = K / 64;
  const int aoff = (wm * 64 + lr) * LS + lg * 8;
  const int boff = (wn * 128 + lr) * LS + lg * 8;
  for (int kt = 0; kt < nk - 1; kt++) {
    const int cur = kt & 1;
    GLOAD((kt + 1) * 64)
    gemm256_compute(acc, As + cur * T_SZ + aoff, Bs + cur * T_SZ + boff);
    LSTORE(cur ^ 1)
    __syncthreads();
  }
  {
    const int cur = (nk - 1) & 1;
    gemm256_compute(acc, As + cur * T_SZ + aoff, Bs + cur * T_SZ + boff);
    __syncthreads();
  }
#undef GLOAD
#undef LSTORE
}

DEV void tconv_tile(const float* __restrict__ src, int K, int N, bf16_t* __restrict__ dst, int tk, int tn, float* tile) {
  const int tid = get_tid();
  const int r = tid >> 4, c4 = (tid & 15) * 4;
#pragma unroll
  for (int i = 0; i < 2; i++) {
    const int rr = r + i * 32;
    float4 v = *(const float4*)(src + (size_t)(tk * 64 + rr) * N + tn * 64 + c4);
    tile[rr * 65 + c4 + 0] = v.x; tile[rr * 65 + c4 + 1] = v.y; tile[rr * 65 + c4 + 2] = v.z; tile[rr * 65 + c4 + 3] = v.w;
  }
  __syncthreads();
  const int n = tid >> 3, k8 = (tid & 7) * 8;
  uint4 o;
  o.x = pack2(tile[(k8 + 0) * 65 + n], tile[(k8 + 1) * 65 + n]);
  o.y = pack2(tile[(k8 + 2) * 65 + n], tile[(k8 + 3) * 65 + n]);
  o.z = pack2(tile[(k8 + 4) * 65 + n], tile[(k8 + 5) * 65 + n]);
  o.w = pack2(tile[(k8 + 6) * 65 + n], tile[(k8 + 7) * 65 + n]);
  *(uint4*)(dst + (size_t)(tn * 64 + n) * K + tk * 64 + k8) = o;
  __syncthreads();
}

DEV void phase_convert(const Params& p, int layer, unsigned char* lds) {
  unsigned char* ws = p.ws;
  float* tile = (float*)lds;
  for (int item = get_bid(); item < 6464; item += gridDim.x) {
    const float* src; bf16_t* dst; int K, N, idx;
    if (item < 3328) { idx = item; src = p.in[3] + (size_t)layer * 1024 * INW; K = 1024; N = INW; dst = (bf16_t*)(ws + OFF_WIN); }
    else if (item < 3328 + 768) { idx = item - 3328; int br = idx >> 8; idx &= 255; src = p.in[4] + ((size_t)layer * 3 + br) * 1024 * 1024; K = 1024; N = 1024; dst = (bf16_t*)(ws + OFF_WB) + (size_t)br * 1024 * 1024; }
    else if (item < 3328 + 1024) { idx = item - 4096; src = p.in[5] + (size_t)layer * 1024 * 1024; K = 1024; N = 1024; dst = (bf16_t*)(ws + OFF_WO); }
    else if (item < 4352 + 1408) { idx = item - 4352; src = p.in[10] + (size_t)layer * 1024 * 5632; K = 1024; N = 5632; dst = (bf16_t*)(ws + OFF_WFI); }
    else { idx = item - 5760; src = p.in[13] + (size_t)layer * 2816 * 1024; K = 2816; N = 1024; dst = (bf16_t*)(ws + OFF_WFO); }
    const int ntn = N / 64;
    tconv_tile(src, K, N, dst, idx / ntn, idx % ntn, tile);
  }
}

DEV void phase_init(const Params& p) {
  unsigned char* ws = p.ws;
  const int gt = get_bid() * NTHR + get_tid(), gs = gridDim.x * NTHR;
  for (int idx = gt; idx < 2 * LT * 256; idx += gs) {
    const int row = idx >> 8, c4 = (idx & 255) * 4;
    const int b = row / LT, t = row - b * LT;
    float4 v;
    if (t < 112) v = make_float4(0.f, 0.f, 0.f, 0.f);
    else if (t < 128) v = *(const float4*)(p.in[1] + (size_t)(t - 112) * 1024 + c4);
    else v = *(const float4*)(p.in[0] + ((size_t)b * 8192 + (t - 128)) * 1024 + c4);
    *(float4*)(hrow(p, b, t) + c4) = v;
  }
  float2* R128 = (float2*)(ws + OFF_R128);
  float2* R64 = (float2*)(ws + OFF_R64);
  for (int idx = gt; idx < LT * 96; idx += gs) {
    const int t = idx / 96, f = idx - t * 96;
    float inv;
    if (f < 64) inv = powf(10000.f, -(float)(2 * f) / 128.f);
    else inv = powf(10000.f, -(float)(2 * (f - 64)) / 64.f);
    const float ang = (float)(t - 112) * inv;
    const double ad = (double)ang;
    const double n = rint(ad * 0.15915494309189535);
    const float rr = (float)(ad - n * 6.283185307179586);
    float2 cs; cs.x = __cosf(rr); cs.y = __sinf(rr);
    if (f < 64) R128[(size_t)t * 64 + f] = cs; else R64[(size_t)t * 32 + (f - 64)] = cs;
  }
}

DEV void phase_norm(const Params& p, int b, const float* __restrict__ g, bf16_t* __restrict__ dst) {
  const int lane = get_tid() & 63, wave = get_tid() >> 6;
  for (int row = get_bid() * 8 + wave; row < LT; row += gridDim.x * 8) {
    const float* src = hrow(p, b, row);
    float4 v[4]; float ss = 0.f;
#pragma unroll
    for (int k = 0; k < 4; k++) { v[k] = *(const float4*)(src + k * 256 + lane * 4); ss += v[k].x * v[k].x + v[k].y * v[k].y + v[k].z * v[k].z + v[k].w * v[k].w; }
#pragma unroll
    for (int o = 1; o < 64; o <<= 1) ss += __shfl_xor(ss, o);
    const float rs = rsqrtf(ss * (1.f / 1024.f) + 1e-6f);
#pragma unroll
    for (int k = 0; k < 4; k++) {
      float4 gg = *(const float4*)(g + k * 256 + lane * 4);
      uint2 o; o.x = pack2(v[k].x * rs * gg.x, v[k].y * rs * gg.y); o.y = pack2(v[k].z * rs * gg.z, v[k].w * rs * gg.w);
      *(uint2*)(dst + (size_t)row * 1024 + k * 256 + lane * 4) = o;
    }
  }
}

DEV void phase_final(const Params& p) {
  const float* g = p.in[14];
  const int lane = get_tid() & 63, wave = get_tid() >> 6;
  for (int row = get_bid() * 8 + wave; row < 2 * 8192; row += gridDim.x * 8) {
    const float* src = p.out + (size_t)row * 1024;
    float4 v[4]; float ss = 0.f;
#pragma unroll
    for (int k = 0; k < 4; k++) { v[k] = *(const float4*)(src + k * 256 + lane * 4); ss += v[k].x * v[k].x + v[k].y * v[k].y + v[k].z * v[k].z + v[k].w * v[k].w; }
#pragma unroll
    for (int o = 1; o < 64; o <<= 1) ss += __shfl_xor(ss, o);
    const float rs = rsqrtf(ss * (1.f / 1024.f) + 1e-6f);
#pragma unroll
    for (int k = 0; k < 4; k++) {
      float4 gg = *(const float4*)(g + k * 256 + lane * 4);
      float4 o = make_float4(v[k].x * rs * gg.x, v[k].y * rs * gg.y, v[k].z * rs * gg.z, v[k].w * rs * gg.w);
      *(float4*)(p.out + (size_t)row * 1024 + k * 256 + lane * 4) = o;
    }
  }
}

DEV void tile_map(int it, int MT, int NG, int& mt, int& nt) {
  const int ng = it / (MT * NG), rem = it - ng * (MT * NG);
  mt = rem / NG; nt = ng * NG + (rem - mt * NG);
}
DEV int vblock() { const int b = get_bid(), G = (int)gridDim.x; return ((G & 7) == 0) ? (b & 7) * (G >> 3) + (b >> 3) : b; }

DEV void phase_projA(const Params& p, int layer, unsigned char* ldsraw) {
  unsigned char* ws = p.ws;
  bf16_t* lds = (bf16_t*)ldsraw;
  const bf16_t* HN = (const bf16_t*)(ws + OFF_HN);
  const bf16_t* WIN = (const bf16_t*)(ws + OFF_WIN);
  const float2* R128 = (const float2*)(ws + OFF_R128);
  const float2* R64 = (const float2*)(ws + OFF_R64);
  for (int item = vblock(); item < 65 * 32; item += gridDim.x) {
    int nt, mt; tile_map(item, 65, 4, mt, nt);
    int n0, seg, segstart;
    if (nt < 8) { n0 = nt * 256; seg = nt < 2 ? 0 : (nt < 4 ? 1 : 2); segstart = seg == 0 ? 0 : (seg == 1 ? 512 : 1024); }
    else if (nt < 20) { n0 = 3072 + (nt - 8) * 256; seg = 3 + (nt - 8) / 4; segstart = 3072 + (seg - 3) * 1024; }
    else { n0 = 7168 + (nt - 20) * 256; seg = 6 + (nt - 20) / 4; segstart = 7168 + (seg - 6) * 1024; }
    const bf16_t* A = HN + (size_t)mt * 128 * 1024;
    const bf16_t* Bt = WIN + (size_t)n0 * 1024;
    f32x4 acc[2][8];
#pragma unroll
    for (int i = 0; i < 2; i++)
#pragma unroll
      for (int j = 0; j < 8; j++) acc[i][j] = (f32x4){0.f, 0.f, 0.f, 0.f};
    if (seg == 0 || seg == 3 || seg == 6 || seg == 7) {
      gemm_acc<256, false>(acc, A, 1024, Bt, 1024, 1024, lds);
      const int tid = get_tid(), lane = tid & 63, wave = tid >> 6, wm = wave >> 1, wn = wave & 1; const int lr = lane & 15, lg = lane >> 4; (void)tid; (void)lane; (void)wm; (void)wn; (void)lr; (void)lg;
      const int cw = (n0 - segstart) + wn * 128;
      bf16_t* dstb; int ld;
      if (seg == 0) { dstb = (bf16_t*)(ws + OFF_RQ); ld = 512; }
      else if (seg == 3) { dstb = (bf16_t*)(ws + OFF_HQ); ld = 1024; }
      else if (seg == 6) { dstb = (bf16_t*)(ws + OFF_DQ); ld = 1024; }
      else { dstb = (bf16_t*)(ws + OFF_DK); ld = 1024; }
#pragma unroll
      for (int i = 0; i < 2; i++) {
        const int t = mt * 128 + wm * 32 + i * 16 + lr;
        if (seg == 0) {
          const float2* tab = R128 + (size_t)t * 64;
#pragma unroll
          for (int j = 0; j < 4; j++)
#pragma unroll
            for (int r = 0; r < 4; r++) {
              float2 cs = tab[j * 16 + lg * 4 + r];
              float x1 = acc[i][j][r], x2 = acc[i][j + 4][r];
              acc[i][j][r] = x1 * cs.x - x2 * cs.y;
              acc[i][j + 4][r] = x2 * cs.x + x1 * cs.y;
            }
        } else if (seg == 6 || seg == 7) {
          const float2* tab = R64 + (size_t)t * 32;
          const float sc = (seg == 6) ? (0.125f * 1.4426950408889634f) : 1.f;
#pragma unroll
          for (int jq = 0; jq < 4; jq++) {
            const int j = (jq & 1) + (jq >> 1) * 4;
#pragma unroll
            for (int r = 0; r < 4; r++) {
              float2 cs = tab[(jq & 1) * 16 + lg * 4 + r];
              float x1 = acc[i][j][r], x2 = acc[i][j + 2][r];
              acc[i][j][r] = (x1 * cs.x - x2 * cs.y) * sc;
              acc[i][j + 2][r] = (x2 * cs.x + x1 * cs.y) * sc;
            }
          }
        }
        bf16_t* dst = dstb + (size_t)t * ld + cw;
#pragma unroll
        for (int j = 0; j < 8; j++) *(uint2*)(dst + j * 16 + lg * 4) = pack4(acc[i][j]);
      }
    } else {
      gemm_acc<256, true>(acc, A, 1024, Bt, 1024, 1024, lds);
      const int tid = get_tid(), lane = tid & 63, wave = tid >> 6, wm = wave >> 1, wn = wave & 1; const int lr = lane & 15, lg = lane >> 4; (void)tid; (void)lane; (void)wm; (void)wn; (void)lr; (void)lg;
      const int cw = (n0 - segstart) + wn * 128;
      if (seg == 1) {
        bf16_t* RK = (bf16_t*)(ws + OFF_RK);
        bf16_t* RKT = (bf16_t*)(ws + OFF_RKT);
        const int h = cw >> 7;
        const float l2g = log2f(1.f - ex2(-5.f - (float)h));
#pragma unroll
        for (int i = 0; i < 2; i++) {
          const int mb = wm * 32 + i * 16 + lg * 4;
#pragma unroll
          for (int j = 0; j < 4; j++)
#pragma unroll
            for (int r = 0; r < 4; r++) {
              const int t = mt * 128 + mb + r;
              float2 cs = R128[(size_t)t * 64 + j * 16 + lr];
              const float sc = (t >= 112) ? 0.08838834764831845f : 0.f;
              float x1 = acc[i][j][r], x2 = acc[i][j + 4][r];
              acc[i][j][r] = (x1 * cs.x - x2 * cs.y) * sc;
              acc[i][j + 4][r] = (x2 * cs.x + x1 * cs.y) * sc;
            }
#pragma unroll
          for (int j = 0; j < 8; j++) {
            const int col = cw + j * 16 + lr;
            f32x4 kd;
#pragma unroll
            for (int r = 0; r < 4; r++) {
              const int t = mt * 128 + mb + r;
              RK[(size_t)t * 512 + col] = f2bf(acc[i][j][r]);
              kd[r] = acc[i][j][r] * ex2(l2g * (float)(127 - (mb + r)));
            }
            *(uint2*)(RKT + (size_t)col * LT + mt * 128 + mb) = pack4(kd);
          }
        }
      } else if (seg == 2 || seg == 5 || seg == 8) {
        bf16_t* dT = (bf16_t*)(ws + (seg == 2 ? OFF_RVT : (seg == 5 ? OFF_HVT : OFF_DVT)));
#pragma unroll
        for (int i = 0; i < 2; i++) {
          const int mb = wm * 32 + i * 16 + lg * 4;
#pragma unroll
          for (int j = 0; j < 8; j++) {
            const int col = cw + j * 16 + lr;
            f32x4 v = acc[i][j];
            if (seg == 5) {
#pragma unroll
              for (int r = 0; r < 4; r++) if (mt * 128 + mb + r < 112) v[r] = 0.f;
            }
            *(uint2*)(dT + (size_t)col * LT + mt * 128 + mb) = pack4(v);
          }
        }
      } else {
        float* Lf = (float*)ldsraw;
        float* HCB = (float*)(ws + OFF_HCB);
        bf16_t* HK = (bf16_t*)(ws + OFF_HK);
        bf16_t* HKET = (bf16_t*)(ws + OFF_HKET);
        float* HDEC = (float*)(ws + OFF_HDEC);
        const float* lbp = p.in[6];
#pragma unroll
        for (int j = 0; j < 8; j++) {
          const int col = cw + j * 16 + lr;
          float lb = 0.f;
          if (layer == 1) lb = 1.f / (1.f + __expf(lbp[col] - lbp[1024 + col]));
#pragma unroll
          for (int i = 0; i < 2; i++)
#pragma unroll
            for (int r = 0; r < 4; r++) {
              const int m = wm * 32 + i * 16 + lg * 4 + r;
              const float z = acc[i][j][r];
              const float kk = (1.f - lb) / (1.f + __expf(z));
              const float lf = fmaxf(log1pf(-kk), -69.0776f);
              acc[i][j][r] = kk;
              Lf[m * 260 + wn * 128 + j * 16 + lr] = lf;
            }
        }
        __syncthreads();
        {
          const int colL = tid & 255, half = tid >> 8;
          float run = 0.f;
          for (int rr = 0; rr < 64; rr++) {
            float* q = &Lf[(half * 64 + rr) * 260 + colL];
            run += *q; *q = run;
          }
        }
        __syncthreads();
#pragma unroll
        for (int j = 0; j < 8; j++) {
          const int colL = wn * 128 + j * 16 + lr;
          const int col = cw + j * 16 + lr;
          const float ft = Lf[63 * 260 + colL];
          const float cend = Lf[127 * 260 + colL] + ft;
#pragma unroll
          for (int i = 0; i < 2; i++) {
            const int mb = wm * 32 + i * 16 + lg * 4;
            f32x4 ke;
#pragma unroll
            for (int r = 0; r < 4; r++) {
              const int m = mb + r;
              const int t = mt * 128 + m;
              const float cb = Lf[m * 260 + colL] + (m >= 64 ? ft : 0.f);
              HCB[(size_t)t * 1024 + col] = cb;
              HK[(size_t)t * 1024 + col] = f2bf(acc[i][j][r]);
              ke[r] = acc[i][j][r] * __expf(cend - cb);
              if (m == 127) HDEC[mt * 1024 + col] = __expf(cend);
            }
            *(uint2*)(HKET + (size_t)col * LT + mt * 128 + mb) = pack4(ke);
          }
        }
        __syncthreads();
      }
    }
  }
}

DEV void phase_U(const Params& p, unsigned char* ldsraw) {
  unsigned char* ws = p.ws;
  bf16_t* lds = (bf16_t*)ldsraw;
  for (int item = get_bid(); item < 1040; item += gridDim.x) {
    const bf16_t *A, *Bt; bf16_t* dst;
    if (item < 520) {
      const int h = item & 3, rest = item >> 2, mh = rest & 1, c = rest >> 1;
      A = (const bf16_t*)(ws + OFF_RVT) + (size_t)(h * 256 + mh * 128) * LT + c * 128;
      Bt = (const bf16_t*)(ws + OFF_RKT) + (size_t)(h * 128) * LT + c * 128;
      dst = (bf16_t*)(ws + OFF_STR) + ((size_t)(h * 65 + c) * 256 + mh * 128) * 128;
    } else {
      const int it = item - 520, h = it & 7, c = it >> 3;
      A = (const bf16_t*)(ws + OFF_HVT) + (size_t)(h * 128) * LT + c * 128;
      Bt = (const bf16_t*)(ws + OFF_HKET) + (size_t)(h * 128) * LT + c * 128;
      dst = (bf16_t*)(ws + OFF_STH) + ((size_t)(h * 65 + c) * 128) * 128;
    }
    f32x4 acc[2][4];
#pragma unroll
    for (int i = 0; i < 2; i++)
#pragma unroll
      for (int j = 0; j < 4; j++) acc[i][j] = (f32x4){0.f, 0.f, 0.f, 0.f};
    gemm_acc<128, false>(acc, A, LT, Bt, LT, 128, lds);
      const int tid = get_tid(), lane = tid & 63, wave = tid >> 6, wm = wave >> 1, wn = wave & 1; const int lr = lane & 15, lg = lane >> 4; (void)tid; (void)lane; (void)wm; (void)wn; (void)lr; (void)lg;
#pragma unroll
    for (int i = 0; i < 2; i++)
#pragma unroll
      for (int j = 0; j < 4; j++)
        *(uint2*)(dst + (size_t)(wm * 32 + i * 16 + lr) * 128 + wn * 64 + j * 16 + lg * 4) = pack4(acc[i][j]);
  }
}

DEV void phase_scan(const Params& p) {
  unsigned char* ws = p.ws;
  const float* HDEC = (const float*)(ws + OFF_HDEC);
  for (int task = get_bid() * NTHR + get_tid(); task < 65536; task += gridDim.x * NTHR) {
    bf16_t* base; size_t stride; int h, d4; bool hg;
    float dec0 = 0.f;
    if (task < 32768) {
      const int v = task; d4 = (v & 31) * 4; const int e = (v >> 5) & 255; h = v >> 13; hg = false;
      base = (bf16_t*)(ws + OFF_STR) + ((size_t)(h * 65) * 256 + e) * 128 + d4; stride = 256 * 128;
      dec0 = ex2(128.f * log2f(1.f - ex2(-5.f - (float)h)));
    } else {
      const int v = task - 32768; d4 = (v & 31) * 4; const int e = (v >> 5) & 127; h = v >> 12; hg = true;
      base = (bf16_t*)(ws + OFF_STH) + ((size_t)(h * 65) * 128 + e) * 128 + d4; stride = 128 * 128;
    }
    float c0 = 0.f, c1 = 0.f, c2 = 0.f, c3 = 0.f;
    for (int cg0 = 0; cg0 < 65; cg0 += 13) {
      uint2 u[13]; float4 dc[13];
#pragma unroll
      for (int k = 0; k < 13; k++) {
        u[k] = *(const uint2*)(base + (size_t)(cg0 + k) * stride);
        if (hg) dc[k] = *(const float4*)(HDEC + (size_t)(cg0 + k) * 1024 + h * 128 + d4);
        else dc[k] = make_float4(dec0, dec0, dec0, dec0);
      }
#pragma unroll
      for (int k = 0; k < 13; k++) {
        uint2 o; o.x = pack2(c0, c1); o.y = pack2(c2, c3);
        *(uint2*)(base + (size_t)(cg0 + k) * stride) = o;
        c0 = dc[k].x * c0 + bf2f((bf16_t)(u[k].x & 0xffff));
        c1 = dc[k].y * c1 + bf2f((bf16_t)(u[k].x >> 16));
        c2 = dc[k].z * c2 + bf2f((bf16_t)(u[k].y & 0xffff));
        c3 = dc[k].w * c3 + bf2f((bf16_t)(u[k].y >> 16));
      }
    }
  }
}

DEV void attn_item(const Params& p, int layer, int h, int qb, float lam, bf16_t* lds) {
  unsigned char* ws = p.ws;
  const bf16_t* DQ = (const bf16_t*)(ws + OFF_DQ);
  bf16_t* ODA = (bf16_t*)(ws + OFF_ODA);
  const bf16_t* DK = (const bf16_t*)(ws + OFF_DK);
  const bf16_t* DVT = (const bf16_t*)(ws + OFF_DVT);
  constexpr int PS = 136, XS = 132;
  bf16_t* Ks = lds;
  bf16_t* Vs = lds + 128 * PS;
  bf16_t* Qs = lds + 2 * 128 * PS;
  float* X = (float*)lds;
  const int tid = get_tid(), lane = tid & 63, wave = tid >> 6;
  const int lr = lane & 15, lg = lane >> 4;
  const int grp = wave >> 2, wq = wave & 3;
  const int t0 = qb * 128;
  const int lrow = tid >> 4, lc8 = (tid & 15) * 8;
#pragma unroll
  for (int i = 0; i < 4; i++)
    *(u32x4*)(Qs + (lrow + i * 32) * PS + lc8) = *(const u32x4*)(DQ + (size_t)(t0 + lrow + i * 32) * 1024 + h * 128 + lc8);
  f32x4 o[2][8];
#pragma unroll
  for (int i = 0; i < 2; i++)
#pragma unroll
    for (int j = 0; j < 8; j++) o[i][j] = (f32x4){0.f, 0.f, 0.f, 0.f};
  float mrun0 = -1e30f, mrun1 = -1e30f, lrun0 = 0.f, lrun1 = 0.f;
  u32x4 rk0, rk1, rk2, rk3, rv0, rv1, rv2, rv3;
  const bf16_t* gk = DK + (size_t)lrow * 1024 + h * 128 + lc8;
  const bf16_t* gv = DVT + (size_t)(h * 128 + lrow) * LT + lc8;
#define ALOAD(kbn)                                                              \
  rk0 = *(const u32x4*)(gk + (size_t)((kbn) * 128) * 1024);                     \
  rk1 = *(const u32x4*)(gk + (size_t)((kbn) * 128 + 32) * 1024);                \
  rk2 = *(const u32x4*)(gk + (size_t)((kbn) * 128 + 64) * 1024);                \
  rk3 = *(const u32x4*)(gk + (size_t)((kbn) * 128 + 96) * 1024);                \
  rv0 = *(const u32x4*)(gv + (kbn) * 128);                                      \
  rv1 = *(const u32x4*)(gv + (size_t)32 * LT + (kbn) * 128);                    \
  rv2 = *(const u32x4*)(gv + (size_t)64 * LT + (kbn) * 128);                    \
  rv3 = *(const u32x4*)(gv + (size_t)96 * LT + (kbn) * 128);
  ALOAD(0)
  const int qrow0 = t0 + wq * 32 + lr;
  for (int kb = 0; kb <= qb; kb++) {
    __syncthreads();
    *(u32x4*)(Ks + (lrow) * PS + lc8) = rk0;
    *(u32x4*)(Ks + (lrow + 32) * PS + lc8) = rk1;
    *(u32x4*)(Ks + (lrow + 64) * PS + lc8) = rk2;
    *(u32x4*)(Ks + (lrow + 96) * PS + lc8) = rk3;
    *(u32x4*)(Vs + (lrow) * PS + lc8) = rv0;
    *(u32x4*)(Vs + (lrow + 32) * PS + lc8) = rv1;
    *(u32x4*)(Vs + (lrow + 64) * PS + lc8) = rv2;
    *(u32x4*)(Vs + (lrow + 96) * PS + lc8) = rv3;
    __syncthreads();
    {
      const int kbn = (kb < qb) ? kb + 1 : qb;
      ALOAD(kbn)
    }
    f32x4 s[2][8];
    {
      const bf16x8 a00 = ldfrag(Qs, PS, wq * 32 + lr, grp * 64 + lg * 8);
      const bf16x8 a01 = ldfrag(Qs, PS, wq * 32 + lr, grp * 64 + 32 + lg * 8);
      const bf16x8 a10 = ldfrag(Qs, PS, wq * 32 + 16 + lr, grp * 64 + lg * 8);
      const bf16x8 a11 = ldfrag(Qs, PS, wq * 32 + 16 + lr, grp * 64 + 32 + lg * 8);
#pragma unroll
      for (int j = 0; j < 8; j++) {
        const bf16x8 kf0 = ldfrag(Ks, PS, j * 16 + lr, grp * 64 + lg * 8);
        const bf16x8 kf1 = ldfrag(Ks, PS, j * 16 + lr, grp * 64 + 32 + lg * 8);
        s[0][j] = MFMA(kf0, a00, ((f32x4){0.f, 0.f, 0.f, 0.f}));
        s[1][j] = MFMA(kf0, a10, ((f32x4){0.f, 0.f, 0.f, 0.f}));
        s[0][j] = MFMA(kf1, a01, s[0][j]);
        s[1][j] = MFMA(kf1, a11, s[1][j]);
      }
    }
    __builtin_amdgcn_sched_barrier(0);
    if (kb == qb || kb == 0) {
#pragma unroll
      for (int i = 0; i < 2; i++)
#pragma unroll
        for (int j = 0; j < 8; j++)
#pragma unroll
          for (int r = 0; r < 4; r++) {
            const int key = kb * 128 + j * 16 + lg * 4 + r;
            if (key > qrow0 + 16 * i || key < 112) s[i][j][r] = -1e30f;
          }
    }
    float al[2];
#pragma unroll
    for (int i = 0; i < 2; i++) {
      float mx = -1e30f;
#pragma unroll
      for (int j = 0; j < 8; j++)
#pragma unroll
        for (int r = 0; r < 4; r++) mx = fmaxf(mx, s[i][j][r]);
      mx = fmaxf(mx, __shfl_xor(mx, 16));
      mx = fmaxf(mx, __shfl_xor(mx, 32));
      const float mold = i == 0 ? mrun0 : mrun1;
      const float mnew = fmaxf(mold, mx);
      al[i] = ex2(mold - mnew);
      float ps = 0.f;
#pragma unroll
      for (int j = 0; j < 8; j++)
#pragma unroll
        for (int r = 0; r < 4; r++) { const float pv = ex2(s[i][j][r] - mnew); s[i][j][r] = pv; ps += pv; }
      if (i == 0) { mrun0 = mnew; lrun0 = lrun0 * al[0] + ps; } else { mrun1 = mnew; lrun1 = lrun1 * al[1] + ps; }
    }
    if (__builtin_amdgcn_ballot_w64(al[0] != 1.f || al[1] != 1.f) != 0ull) {
#pragma unroll
      for (int i = 0; i < 2; i++) {
        float ao[4];
#pragma unroll
        for (int r = 0; r < 4; r++) ao[r] = __shfl(al[i], lg * 4 + r);
#pragma unroll
        for (int je = 0; je < 8; je++)
#pragma unroll
          for (int r = 0; r < 4; r++) o[i][je][r] *= ao[r];
      }
    }
#pragma unroll
    for (int ks = 0; ks < 4; ks++) {
      union { u32x4 u; bf16x8 v; } pf0, pf1;
      pf0.u[0] = pack2(s[0][2 * ks][0], s[0][2 * ks][1]);
      pf0.u[1] = pack2(s[0][2 * ks][2], s[0][2 * ks][3]);
      pf0.u[2] = pack2(s[0][2 * ks + 1][0], s[0][2 * ks + 1][1]);
      pf0.u[3] = pack2(s[0][2 * ks + 1][2], s[0][2 * ks + 1][3]);
      pf1.u[0] = pack2(s[1][2 * ks][0], s[1][2 * ks][1]);
      pf1.u[1] = pack2(s[1][2 * ks][2], s[1][2 * ks][3]);
      pf1.u[2] = pack2(s[1][2 * ks + 1][0], s[1][2 * ks + 1][1]);
      pf1.u[3] = pack2(s[1][2 * ks + 1][2], s[1][2 * ks + 1][3]);
#pragma unroll
      for (int je = 0; je < 8; je++) {
        const bf16_t* vp = Vs + (je * 16 + lr) * PS + ks * 32 + lg * 4;
        union { uint2 u[2]; bf16x8 v; } vf;
        vf.u[0] = *(const uint2*)vp;
        vf.u[1] = *(const uint2*)(vp + 16);
        o[0][je] = MFMA(pf0.v, vf.v, o[0][je]);
        o[1][je] = MFMA(pf1.v, vf.v, o[1][je]);
      }
    }
    __builtin_amdgcn_sched_barrier(0);
  }
#undef ALOAD
#pragma unroll
  for (int i = 0; i < 2; i++) {
    float l = i == 0 ? lrun0 : lrun1;
    l += __shfl_xor(l, 16);
    l += __shfl_xor(l, 32);
    const float inv = l > 0.f ? 1.f / l : 0.f;
#pragma unroll
    for (int r = 0; r < 4; r++) {
      const float ir = __shfl(inv, lg * 4 + r);
#pragma unroll
      for (int je = 0; je < 8; je++) o[i][je][r] *= ir;
    }
  }
  __syncthreads();
  if (grp == 1) {
#pragma unroll
    for (int i = 0; i < 2; i++)
#pragma unroll
      for (int je = 0; je < 8; je++)
#pragma unroll
        for (int r = 0; r < 4; r++) X[(wq * 32 + i * 16 + lg * 4 + r) * XS + je * 16 + lr] = o[i][je][r];
  }
  __syncthreads();
  if (grp == 0) {
    int ly = layer; asm volatile("" : "+s"(ly));
    const float li = (ly == 0) ? 0.2f : 0.35550906759f;
    const float* sg = p.in[8] + ly * 128;
#pragma unroll
    for (int i = 0; i < 2; i++) {
      float ss[4] = {0.f, 0.f, 0.f, 0.f};
#pragma unroll
      for (int je = 0; je < 8; je++)
#pragma unroll
        for (int r = 0; r < 4; r++) {
          const float v = o[i][je][r] - lam * X[(wq * 32 + i * 16 + lg * 4 + r) * XS + je * 16 + lr];
          o[i][je][r] = v; ss[r] += v * v;
        }
#pragma unroll
      for (int r = 0; r < 4; r++) {
        float s2 = ss[r];
        s2 += __shfl_xor(s2, 1); s2 += __shfl_xor(s2, 2); s2 += __shfl_xor(s2, 4); s2 += __shfl_xor(s2, 8);
        ss[r] = rsqrtf(s2 * (1.f / 128.f) + 1e-6f) * (1.f - li);
      }
#pragma unroll
      for (int je = 0; je < 8; je++) {
        const float g = sg[je * 16 + lr];
#pragma unroll
        for (int r = 0; r < 4; r++)
          ODA[(size_t)(t0 + wq * 32 + i * 16 + lg * 4 + r) * 1024 + h * 128 + je * 16 + lr] = f2bf(o[i][je][r] * ss[r] * g);
      }
    }
  }
}

DEV void ret_item(const Params& p, int h, int c, bf16_t* lds) {
  unsigned char* ws = p.ws;
  const bf16_t* RQ = (const bf16_t*)(ws + OFF_RQ);
  const bf16_t* RK = (const bf16_t*)(ws + OFF_RK);
  const bf16_t* RVT = (const bf16_t*)(ws + OFF_RVT);
  const bf16_t* STR = (const bf16_t*)(ws + OFF_STR);
  bf16_t* ORET = (bf16_t*)(ws + OFF_ORET);
  constexpr int PS = 136;
  bf16_t* Qs = lds;
  bf16_t* Ks = lds + 128 * PS;
  bf16_t* Big = lds + 2 * 128 * PS;
  float* RED = (float*)(lds + 2 * 128 * PS + 256 * PS);
  const int tid = get_tid(), lane = tid & 63, wave = tid >> 6, wm = wave >> 1, wn = wave & 1;
  const int lr = lane & 15, lg = lane >> 4;
  const int t0 = c * 128;
  const int lrow = tid >> 4, lc8 = (tid & 15) * 8;
  const float l2g = log2f(1.f - ex2(-5.f - (float)h));
#pragma unroll
  for (int i = 0; i < 4; i++) {
    const int row = lrow + i * 32;
    *(uint4*)(Qs + row * PS + lc8) = *(const uint4*)(RQ + (size_t)(t0 + row) * 512 + h * 128 + lc8);
    *(uint4*)(Ks + row * PS + lc8) = *(const uint4*)(RK + (size_t)(t0 + row) * 512 + h * 128 + lc8);
  }
#pragma unroll
  for (int i = 0; i < 8; i++) {
    const int row = lrow + i * 32;
    *(uint4*)(Big + row * PS + lc8) = *(const uint4*)(STR + ((size_t)(h * 65 + c) * 256 + row) * 128 + lc8);
  }
  __syncthreads();
  f32x4 s[2][4];
  f32x4 o[2][8];
#pragma unroll
  for (int i = 0; i < 2; i++) {
#pragma unroll
    for (int j = 0; j < 4; j++) s[i][j] = (f32x4){0.f, 0.f, 0.f, 0.f};
#pragma unroll
    for (int j = 0; j < 8; j++) o[i][j] = (f32x4){0.f, 0.f, 0.f, 0.f};
  }
#pragma unroll
  for (int ks = 0; ks < 4; ks++) {
    bf16x8 a0 = ldfrag(Qs, PS, wm * 32 + lr, ks * 32 + lg * 8);
    bf16x8 a1 = ldfrag(Qs, PS, wm * 32 + 16 + lr, ks * 32 + lg * 8);
#pragma unroll
    for (int j = 0; j < 4; j++) {
      bf16x8 bb = ldfrag(Ks, PS, wn * 64 + j * 16 + lr, ks * 32 + lg * 8);
      s[0][j] = MFMA(bb, a0, s[0][j]);
      s[1][j] = MFMA(bb, a1, s[1][j]);
    }
#pragma unroll
    for (int j = 0; j < 8; j++) {
      bf16x8 bb = ldfrag(Big, PS, wn * 128 + j * 16 + lr, ks * 32 + lg * 8);
      o[0][j] = MFMA(bb, a0, o[0][j]);
      o[1][j] = MFMA(bb, a1, o[1][j]);
    }
    __builtin_amdgcn_sched_barrier(0);
  }
#pragma unroll
  for (int i = 0; i < 2; i++) {
    const int q = wm * 32 + i * 16 + lr;
    const float qd = ex2(l2g * (float)(q + 1));
#pragma unroll
    for (int j = 0; j < 8; j++)
#pragma unroll
      for (int r = 0; r < 4; r++) o[i][j][r] *= qd;
  }
  __syncthreads();
#pragma unroll
  for (int i = 0; i < 2; i++) {
    const int q = wm * 32 + i * 16 + lr;
#pragma unroll
    for (int j = 0; j < 4; j++) {
      f32x4 v;
#pragma unroll
      for (int r = 0; r < 4; r++) {
        const int key = wn * 64 + j * 16 + lg * 4 + r;
        v[r] = (key <= q) ? s[i][j][r] * ex2(l2g * (float)(q - key)) : 0.f;
      }
      *(uint2*)(Ks + q * PS + wn * 64 + j * 16 + lg * 4) = pack4(v);
    }
  }
#pragma unroll
  for (int i = 0; i < 8; i++) {
    const int row = lrow + i * 32;
    *(uint4*)(Big + row * PS + lc8) = *(const uint4*)(RVT + (size_t)(h * 256 + row) * LT + t0 + lc8);
  }
  __syncthreads();
#pragma unroll
  for (int ks = 0; ks < 4; ks++) {
    bf16x8 a0 = ldfrag(Ks, PS, wm * 32 + lr, ks * 32 + lg * 8);
    bf16x8 a1 = ldfrag(Ks, PS, wm * 32 + 16 + lr, ks * 32 + lg * 8);
#pragma unroll
    for (int j = 0; j < 8; j++) {
      bf16x8 bb = ldfrag(Big, PS, wn * 128 + j * 16 + lr, ks * 32 + lg * 8);
      o[0][j] = MFMA(bb, a0, o[0][j]);
      o[1][j] = MFMA(bb, a1, o[1][j]);
    }
    __builtin_amdgcn_sched_barrier(0);
  }
#pragma unroll
  for (int i = 0; i < 2; i++) {
    float ss = 0.f;
#pragma unroll
    for (int j = 0; j < 8; j++)
#pragma unroll
      for (int r = 0; r < 4; r++) ss += o[i][j][r] * o[i][j][r];
    ss += __shfl_xor(ss, 16);
    ss += __shfl_xor(ss, 32);
    if (lg == 0) RED[(wm * 32 + i * 16 + lr) * 2 + wn] = ss;
  }
  __syncthreads();
#pragma unroll
  for (int i = 0; i < 2; i++) {
    const int q = wm * 32 + i * 16 + lr;
    const float rs = rsqrtf((RED[q * 2] + RED[q * 2 + 1]) * (1.f / 256.f) + 1e-6f);
#pragma unroll
    for (int j = 0; j < 8; j++) {
      f32x4 v = o[i][j];
#pragma unroll
      for (int r = 0; r < 4; r++) v[r] *= rs;
      *(uint2*)(ORET + (size_t)(t0 + q) * 1024 + h * 256 + wn * 128 + j * 16 + lg * 4) = pack4(v);
    }
  }
}

DEV void hg_item(const Params& p, int h, int c, bf16_t* lds) {
  unsigned char* ws = p.ws;
  const bf16_t* HQ = (const bf16_t*)(ws + OFF_HQ);
  const bf16_t* HK = (const bf16_t*)(ws + OFF_HK);
  const float* HCB = (const float*)(ws + OFF_HCB);
  const bf16_t* HVT = (const bf16_t*)(ws + OFF_HVT);
  const bf16_t* STH = (const bf16_t*)(ws + OFF_STH);
  bf16_t* OHG = (bf16_t*)(ws + OFF_OHG);
  constexpr int PS = 136;
  bf16_t* Qp = lds;
  bf16_t* Kp = lds + 128 * PS;
  bf16_t* As = lds + 2 * 128 * PS;
  float* RED = (float*)(lds + 2 * 128 * PS + 256 * PS);
  const int tid = get_tid(), lane = tid & 63, wave = tid >> 6, wm = wave >> 1, wn = wave & 1;
  const int lr = lane & 15, lg = lane >> 4;
  const int t0 = c * 128, colb = h * 128;
  const int lrow = tid >> 4, lc8 = (tid & 15) * 8;
#pragma unroll
  for (int i = 0; i < 4; i++) {
    const int row = lrow + i * 32;
    const size_t g = (size_t)(t0 + row) * 1024 + colb + lc8;
    uint4 qv = *(const uint4*)(HQ + g);
    float4 c0 = *(const float4*)(HCB + g), c1 = *(const float4*)(HCB + g + 4);
    float4 r0 = make_float4(0.f, 0.f, 0.f, 0.f), r1 = r0;
    if (row >= 32) {
      const size_t gr = (size_t)(t0 + (row & ~31) - 1) * 1024 + colb + lc8;
      r0 = *(const float4*)(HCB + gr); r1 = *(const float4*)(HCB + gr + 4);
    }
    uint4 ov;
    ov.x = pack2(bf2f((bf16_t)(qv.x & 0xffff)) * __expf(c0.x - r0.x), bf2f((bf16_t)(qv.x >> 16)) * __expf(c0.y - r0.y));
    ov.y = pack2(bf2f((bf16_t)(qv.y & 0xffff)) * __expf(c0.z - r0.z), bf2f((bf16_t)(qv.y >> 16)) * __expf(c0.w - r0.w));
    ov.z = pack2(bf2f((bf16_t)(qv.z & 0xffff)) * __expf(c1.x - r1.x), bf2f((bf16_t)(qv.z >> 16)) * __expf(c1.y - r1.y));
    ov.w = pack2(bf2f((bf16_t)(qv.w & 0xffff)) * __expf(c1.z - r1.z), bf2f((bf16_t)(qv.w >> 16)) * __expf(c1.w - r1.w));
    *(uint4*)(Qp + row * PS + lc8) = ov;
  }
  for (int I = 0; I < 4; I++) {
    const int nrows = 32 * (I + 1);
    float4 r0 = make_float4(0.f, 0.f, 0.f, 0.f), r1 = r0;
    if (I > 0) {
      const size_t gr = (size_t)(t0 + 32 * I - 1) * 1024 + colb + lc8;
      r0 = *(const float4*)(HCB + gr); r1 = *(const float4*)(HCB + gr + 4);
    }
#pragma unroll
    for (int i = 0; i < 4; i++) {
      const int row = lrow + i * 32;
      if (row < nrows) {
        const size_t g = (size_t)(t0 + row) * 1024 + colb + lc8;
        uint4 kv = *(const uint4*)(HK + g);
        float4 c0 = *(const float4*)(HCB + g), c1 = *(const float4*)(HCB + g + 4);
        uint4 ov;
        ov.x = pack2(bf2f((bf16_t)(kv.x & 0xffff)) * __expf(fminf(r0.x - c0.x, 80.f)), bf2f((bf16_t)(kv.x >> 16)) * __expf(fminf(r0.y - c0.y, 80.f)));
        ov.y = pack2(bf2f((bf16_t)(kv.y & 0xffff)) * __expf(fminf(r0.z - c0.z, 80.f)), bf2f((bf16_t)(kv.y >> 16)) * __expf(fminf(r0.w - c0.w, 80.f)));
        ov.z = pack2(bf2f((bf16_t)(kv.z & 0xffff)) * __expf(fminf(r1.x - c1.x, 80.f)), bf2f((bf16_t)(kv.z >> 16)) * __expf(fminf(r1.y - c1.y, 80.f)));
        ov.w = pack2(bf2f((bf16_t)(kv.w & 0xffff)) * __expf(fminf(r1.z - c1.z, 80.f)), bf2f((bf16_t)(kv.w >> 16)) * __expf(fminf(r1.w - c1.w, 80.f)));
        *(uint4*)(Kp + row * PS + lc8) = ov;
      }
    }
    __syncthreads();
    if (wave * 16 < nrows) {
      f32x4 a2[2];
      a2[0] = (f32x4){0.f, 0.f, 0.f, 0.f}; a2[1] = a2[0];
#pragma unroll
      for (int ks = 0; ks < 4; ks++) {
        bf16x8 bb = ldfrag(Kp, PS, wave * 16 + lr, ks * 32 + lg * 8);
        bf16x8 a0 = ldfrag(Qp, PS, 32 * I + lr, ks * 32 + lg * 8);
        bf16x8 a1 = ldfrag(Qp, PS, 32 * I + 16 + lr, ks * 32 + lg * 8);
        a2[0] = MFMA(bb, a0, a2[0]);
        a2[1] = MFMA(bb, a1, a2[1]);
      }
#pragma unroll
      for (int i = 0; i < 2; i++) {
        const int q = 32 * I + i * 16 + lr;
        f32x4 v;
#pragma unroll
        for (int r = 0; r < 4; r++) { const int key = wave * 16 + lg * 4 + r; v[r] = (key <= q) ? a2[i][r] : 0.f; }
        *(uint2*)(As + q * PS + wave * 16 + lg * 4) = pack4(v);
      }
    } else {
#pragma unroll
      for (int i = 0; i < 2; i++) {
        const int q = 32 * I + i * 16 + lr;
        *(uint2*)(As + q * PS + wave * 16 + lg * 4) = make_uint2(0u, 0u);
      }
    }
    __syncthreads();
  }
#pragma unroll
  for (int i = 0; i < 4; i++) {
    const int row = lrow + i * 32;
    *(uint4*)(Kp + row * PS + lc8) = *(const uint4*)(HVT + (size_t)(colb + row) * LT + t0 + lc8);
  }
  __syncthreads();
  f32x4 o[2][4];
#pragma unroll
  for (int i = 0; i < 2; i++)
#pragma unroll
    for (int j = 0; j < 4; j++) o[i][j] = (f32x4){0.f, 0.f, 0.f, 0.f};
#pragma unroll
  for (int ks = 0; ks < 4; ks++) {
    bf16x8 a0 = ldfrag(As, PS, wm * 32 + lr, ks * 32 + lg * 8);
    bf16x8 a1 = ldfrag(As, PS, wm * 32 + 16 + lr, ks * 32 + lg * 8);
#pragma unroll
    for (int j = 0; j < 4; j++) {
      bf16x8 bb = ldfrag(Kp, PS, wn * 64 + j * 16 + lr, ks * 32 + lg * 8);
      o[0][j] = MFMA(bb, a0, o[0][j]);
      o[1][j] = MFMA(bb, a1, o[1][j]);
    }
    __builtin_amdgcn_sched_barrier(0);
  }
  __syncthreads();
#pragma unroll
  for (int i = 0; i < 4; i++) {
    const int row = lrow + i * 32;
    const size_t g = (size_t)(t0 + row) * 1024 + colb + lc8;
    uint4 qv = *(const uint4*)(HQ + g);
    float4 c0 = *(const float4*)(HCB + g), c1 = *(const float4*)(HCB + g + 4);
    uint4 ov;
    ov.x = pack2(bf2f((bf16_t)(qv.x & 0xffff)) * __expf(c0.x), bf2f((bf16_t)(qv.x >> 16)) * __expf(c0.y));
    ov.y = pack2(bf2f((bf16_t)(qv.y & 0xffff)) * __expf(c0.z), bf2f((bf16_t)(qv.y >> 16)) * __expf(c0.w));
    ov.z = pack2(bf2f((bf16_t)(qv.z & 0xffff)) * __expf(c1.x), bf2f((bf16_t)(qv.z >> 16)) * __expf(c1.y));
    ov.w = pack2(bf2f((bf16_t)(qv.w & 0xffff)) * __expf(c1.z), bf2f((bf16_t)(qv.w >> 16)) * __expf(c1.w));
    *(uint4*)(Qp + row * PS + lc8) = ov;
    *(uint4*)(Kp + row * PS + lc8) = *(const uint4*)(STH + ((size_t)(h * 65 + c) * 128 + row) * 128 + lc8);
  }
  __syncthreads();
#pragma unroll
  for (int ks = 0; ks < 4; ks++) {
    bf16x8 a0 = ldfrag(Qp, PS, wm * 32 + lr, ks * 32 + lg * 8);
    bf16x8 a1 = ldfrag(Qp, PS, wm * 32 + 16 + lr, ks * 32 + lg * 8);
#pragma unroll
    for (int j = 0; j < 4; j++) {
      bf16x8 bb = ldfrag(Kp, PS, wn * 64 + j * 16 + lr, ks * 32 + lg * 8);
      o[0][j] = MFMA(bb, a0, o[0][j]);
      o[1][j] = MFMA(bb, a1, o[1][j]);
    }
    __builtin_amdgcn_sched_barrier(0);
  }
#pragma unroll
  for (int i = 0; i < 2; i++) {
    float ss = 0.f;
#pragma unroll
    for (int j = 0; j < 4; j++)
#pragma unroll
      for (int r = 0; r < 4; r++) ss += o[i][j][r] * o[i][j][r];
    ss += __shfl_xor(ss, 16);
    ss += __shfl_xor(ss, 32);
    if (lg == 0) RED[(wm * 32 + i * 16 + lr) * 2 + wn] = ss;
  }
  __syncthreads();
#pragma unroll
  for (int i = 0; i < 2; i++) {
    const int q = wm * 32 + i * 16 + lr;
    const float rs = rsqrtf((RED[q * 2] + RED[q * 2 + 1]) * (1.f / 128.f) + 1e-6f);
#pragma unroll
    for (int j = 0; j < 4; j++) {
      f32x4 v = o[i][j];
#pragma unroll
      for (int r = 0; r < 4; r++) v[r] *= rs;
      *(uint2*)(OHG + (size_t)(t0 + q) * 1024 + colb + wn * 64 + j * 16 + lg * 4) = pack4(v);
    }
  }
}

DEV void phase_O(const Params& p, int layer, int qidx, unsigned char* ldsraw) {
  bf16_t* lds = (bf16_t*)ldsraw;
  int* ctr = (int*)(p.ws + OFF_CTR) + qidx;
  int* sitem = (int*)(ldsraw + LDS_BYTES - 16);
  const float* lp = p.in[7] + layer * 256;
  float d0 = 0.f, d1 = 0.f;
  for (int i = 0; i < 64; i++) { d0 += lp[i] * lp[64 + i]; d1 += lp[128 + i] * lp[192 + i]; }
  int ly = layer; asm volatile("" : "+s"(ly));
  const float li = (ly == 0) ? 0.2f : 0.35550906759f;
  const float lam = __uint_as_float(__builtin_amdgcn_readfirstlane(__float_as_uint(__expf(d0) - __expf(d1) + li)));
  const int tid0 = get_tid();
  for (;;) {
    __syncthreads();
    if (tid0 == 0) *sitem = atomicAdd(ctr, 1);
    __syncthreads();
    const int item = __builtin_amdgcn_readfirstlane(*sitem);
    if (item >= 1300) break;
    if (item < 520) attn_item(p, layer, item & 7, 64 - (item >> 3), lam, lds);
    else if (item < 780) ret_item(p, (item - 520) & 3, (item - 520) >> 2, lds);
    else hg_item(p, (item - 780) & 7, (item - 780) >> 3, lds);
  }
}

DEV void phase_G(const Params& p, unsigned char* ldsraw) {
  unsigned char* ws = p.ws;
  bf16_t* lds = (bf16_t*)ldsraw;
  const bf16_t* HN = (const bf16_t*)(ws + OFF_HN);
  const bf16_t* WIN = (const bf16_t*)(ws + OFF_WIN);
  for (int item = vblock(); item < 33 * 20; item += gridDim.x) {
    int nt, mt; tile_map(item, 33, 4, mt, nt);
    int n0, cb; bf16_t* dst; int ld; bool gate;
    if (nt < 4) { n0 = 2048 + nt * 256; cb = nt * 256; dst = (bf16_t*)(ws + OFF_ORET); ld = 1024; gate = true; }
    else if (nt < 8) { n0 = 6144 + (nt - 4) * 256; cb = (nt - 4) * 256; dst = (bf16_t*)(ws + OFF_OHG); ld = 1024; gate = true; }
    else { n0 = 10240 + (nt - 8) * 256; cb = (nt - 8) * 256; dst = (bf16_t*)(ws + OFF_G); ld = 3072; gate = false; }
    f32x4 acc[4][8];
#pragma unroll
    for (int i = 0; i < 4; i++)
#pragma unroll
      for (int j = 0; j < 8; j++) acc[i][j] = (f32x4){0.f, 0.f, 0.f, 0.f};
    gemm256_acc(acc, HN + (size_t)mt * 256 * 1024, 1024, LT - mt * 256, WIN + (size_t)n0 * 1024, 1024, 1024, lds);
    const int tid = get_tid(), lane = tid & 63, wave = tid >> 6, wm = wave >> 1, wn = wave & 1; const int lr = lane & 15, lg = lane >> 4;
#pragma unroll
    for (int i = 0; i < 4; i++) {
      const int t = mt * 256 + wm * 64 + i * 16 + lr;
      if (t < LT) {
#pragma unroll
        for (int j = 0; j < 8; j++) {
          bf16_t* d = dst + (size_t)t * ld + cb + wn * 128 + j * 16 + lg * 4;
          f32x4 v;
          if (gate) {
            uint2 ov = *(const uint2*)d;
            v[0] = bf2f((bf16_t)(ov.x & 0xffff)) * silu_f(acc[i][j][0]);
            v[1] = bf2f((bf16_t)(ov.x >> 16)) * silu_f(acc[i][j][1]);
            v[2] = bf2f((bf16_t)(ov.y & 0xffff)) * silu_f(acc[i][j][2]);
            v[3] = bf2f((bf16_t)(ov.y >> 16)) * silu_f(acc[i][j][3]);
          } else {
#pragma unroll
            for (int r = 0; r < 4; r++) v[r] = sigmoid_f(acc[i][j][r]);
          }
          *(uint2*)d = pack4(v);
        }
      }
    }
  }
}

DEV f32x4 mini_gemm16(const bf16_t* __restrict__ A16, int lda, const bf16_t* __restrict__ Bt16, int ldb, int k0, int klen, int lane) {
  const int lr = lane & 15, lg = lane >> 4;
  const bf16_t* pa = A16 + (size_t)lr * lda + k0 + lg * 8;
  const bf16_t* pb = Bt16 + (size_t)lr * ldb + k0 + lg * 8;
  f32x4 acc = (f32x4){0.f, 0.f, 0.f, 0.f};
#pragma unroll 4
  for (int k = 0; k < klen; k += 32) {
    bf16x8 a = *(const bf16x8*)(pa + k);
    bf16x8 b = *(const bf16x8*)(pb + k);
    acc = MFMA(b, a, acc);
  }
  return acc;
}

DEV void phase_Y(const Params& p, unsigned char* ldsraw) {
  unsigned char* ws = p.ws;
  bf16_t* lds = (bf16_t*)ldsraw;
  const bf16_t* WB = (const bf16_t*)(ws + OFF_WB);
  const bf16_t* G = (const bf16_t*)(ws + OFF_G);
  bf16_t* Y = (bf16_t*)(ws + OFF_Y);
  for (int item = vblock(); item < 64 * 8 + 64; item += gridDim.x) {
    if (item >= 512) {
      const int lane = get_tid() & 63, wave = get_tid() >> 6, lr = lane & 15, lg = lane >> 4;
      const int n0 = (item - 512) * 16;
      f32x4* red = (f32x4*)ldsraw;
      __syncthreads();
#pragma unroll 1
      for (int br = 0; br < 3; br++) {
        const bf16_t* Ab = (const bf16_t*)(ws + (br == 0 ? OFF_ORET : (br == 1 ? OFF_OHG : OFF_ODA))) + (size_t)112 * 1024;
        red[(br * 8 + wave) * 64 + lane] = mini_gemm16(Ab, 1024, WB + ((size_t)br * 1024 + n0) * 1024, 1024, wave * 128, 128, lane);
      }
      __syncthreads();
      if (wave == 0) {
        f32x4 y = (f32x4){0.f, 0.f, 0.f, 0.f};
#pragma unroll
        for (int br = 0; br < 3; br++) {
          f32x4 a = red[(br * 8) * 64 + lane];
#pragma unroll
          for (int w = 1; w < 8; w++) a += red[(br * 8 + w) * 64 + lane];
          uint2 gv = *(const uint2*)(G + (size_t)(112 + lr) * 3072 + br * 1024 + n0 + lg * 4);
          y[0] += bf2f((bf16_t)(gv.x & 0xffff)) * a[0];
          y[1] += bf2f((bf16_t)(gv.x >> 16)) * a[1];
          y[2] += bf2f((bf16_t)(gv.y & 0xffff)) * a[2];
          y[3] += bf2f((bf16_t)(gv.y >> 16)) * a[3];
        }
        *(uint2*)(Y + (size_t)(112 + lr) * 1024 + n0 + lg * 4) = pack4(y);
      }
      continue;
    }
    int nt, mt; tile_map(item, 64, 4, mt, nt); mt += 1;
    f32x4 y[2][4];
#pragma unroll
    for (int i = 0; i < 2; i++)
#pragma unroll
      for (int j = 0; j < 4; j++) y[i][j] = (f32x4){0.f, 0.f, 0.f, 0.f};
#pragma unroll 1
    for (int br = 0; br < 3; br++) {
      const bf16_t* Ab = (const bf16_t*)(ws + (br == 0 ? OFF_ORET : (br == 1 ? OFF_OHG : OFF_ODA))) + (size_t)mt * 128 * 1024;
      f32x4 acc[2][4];
#pragma unroll
      for (int i = 0; i < 2; i++)
#pragma unroll
        for (int j = 0; j < 4; j++) acc[i][j] = (f32x4){0.f, 0.f, 0.f, 0.f};
      gemm_acc<128, false>(acc, Ab, 1024, WB + ((size_t)br * 1024 + nt * 128) * 1024, 1024, 1024, lds);
      const int tid = get_tid(), lane = tid & 63, wave = tid >> 6, wm = wave >> 1, wn = wave & 1; const int lr = lane & 15, lg = lane >> 4;
#pragma unroll
      for (int i = 0; i < 2; i++) {
        const int t = mt * 128 + wm * 32 + i * 16 + lr;
#pragma unroll
        for (int j = 0; j < 4; j++) {
          uint2 gv = *(const uint2*)(G + (size_t)t * 3072 + br * 1024 + nt * 128 + wn * 64 + j * 16 + lg * 4);
          y[i][j][0] += bf2f((bf16_t)(gv.x & 0xffff)) * acc[i][j][0];
          y[i][j][1] += bf2f((bf16_t)(gv.x >> 16)) * acc[i][j][1];
          y[i][j][2] += bf2f((bf16_t)(gv.y & 0xffff)) * acc[i][j][2];
          y[i][j][3] += bf2f((bf16_t)(gv.y >> 16)) * acc[i][j][3];
        }
      }
    }
    const int tid = get_tid(), lane = tid & 63, wave = tid >> 6, wm = wave >> 1, wn = wave & 1; const int lr = lane & 15, lg = lane >> 4;
#pragma unroll
    for (int i = 0; i < 2; i++) {
      const int t = mt * 128 + wm * 32 + i * 16 + lr;
#pragma unroll
      for (int j = 0; j < 4; j++)
        *(uint2*)(Y + (size_t)t * 1024 + nt * 128 + wn * 64 + j * 16 + lg * 4) = pack4(y[i][j]);
    }
  }
}

DEV void phase_resid(const Params& p, int b, const bf16_t* A, int K, const bf16_t* Wt, unsigned char* ldsraw) {
  bf16_t* lds = (bf16_t*)ldsraw;
  for (int item = vblock(); item < 64 * 8 + 64; item += gridDim.x) {
    if (item >= 512) {
      const int lane = get_tid() & 63, wave = get_tid() >> 6, lr = lane & 15, lg = lane >> 4;
      const int n0 = (item - 512) * 16;
      f32x4* red = (f32x4*)ldsraw;
      const int ks = K >> 3;
      __syncthreads();
      red[wave * 64 + lane] = mini_gemm16(A + (size_t)112 * K, K, Wt + (size_t)n0 * K, K, wave * ks, ks, lane);
      __syncthreads();
      if (wave == 0) {
        f32x4 a = red[lane];
#pragma unroll
        for (int w = 1; w < 8; w++) a += red[w * 64 + lane];
        float4* d = (float4*)(hrow(p, b, 112 + lr) + n0 + lg * 4);
        float4 v = *d;
        v.x += a[0]; v.y += a[1]; v.z += a[2]; v.w += a[3];
        *d = v;
      }
      continue;
    }
    int nt, mt; tile_map(item, 64, 4, mt, nt); mt += 1;
    f32x4 acc[2][4];
#pragma unroll
    for (int i = 0; i < 2; i++)
#pragma unroll
      for (int j = 0; j < 4; j++) acc[i][j] = (f32x4){0.f, 0.f, 0.f, 0.f};
    gemm_acc<128, false>(acc, A + (size_t)mt * 128 * K, K, Wt + (size_t)nt * 128 * K, K, K, lds);
    const int tid = get_tid(), lane = tid & 63, wave = tid >> 6, wm = wave >> 1, wn = wave & 1; const int lr = lane & 15, lg = lane >> 4;
#pragma unroll
    for (int i = 0; i < 2; i++) {
      const int t = mt * 128 + wm * 32 + i * 16 + lr;
#pragma unroll
      for (int j = 0; j < 4; j++) {
        float4* d = (float4*)(hrow(p, b, t) + nt * 128 + wn * 64 + j * 16 + lg * 4);
        float4 v = *d;
        v.x += acc[i][j][0]; v.y += acc[i][j][1]; v.z += acc[i][j][2]; v.w += acc[i][j][3];
        *d = v;
      }
    }
  }
}

DEV void phase_F1(const Params& p, unsigned char* ldsraw) {
  unsigned char* ws = p.ws;
  bf16_t* lds = (bf16_t*)ldsraw;
  const bf16_t* HN = (const bf16_t*)(ws + OFF_HN);
  const bf16_t* WFI = (const bf16_t*)(ws + OFF_WFI);
  bf16_t* U = (bf16_t*)(ws + OFF_U);
  for (int item = vblock(); item < 33 * 22; item += gridDim.x) {
    int nt, mt; tile_map(item, 33, 2, mt, nt);
    f32x4 acc[4][8];
#pragma unroll
    for (int i = 0; i < 4; i++)
#pragma unroll
      for (int j = 0; j < 8; j++) acc[i][j] = (f32x4){0.f, 0.f, 0.f, 0.f};
    gemm256_acc(acc, HN + (size_t)mt * 256 * 1024, 1024, LT - mt * 256, WFI + (size_t)nt * 256 * 1024, 1024, 1024, lds);
    const int tid = get_tid(), lane = tid & 63, wave = tid >> 6, wm = wave >> 1, wn = wave & 1; const int lr = lane & 15, lg = lane >> 4;
#pragma unroll
    for (int i = 0; i < 4; i++) {
      const int t = mt * 256 + wm * 64 + i * 16 + lr;
      if (t < LT) {
        const float vm = (t >= 112) ? 1.f : 0.f;
#pragma unroll
        for (int j = 0; j < 8; j++) {
          f32x4 v = acc[i][j];
#pragma unroll
          for (int r = 0; r < 4; r++) v[r] *= vm;
          *(uint2*)(U + (size_t)t * 5632 + nt * 256 + wn * 128 + j * 16 + lg * 4) = pack4(v);
        }
      }
    }
  }
}

DEV void unpack8(const u32x4 v, float (&f)[8]) {
#pragma unroll
  for (int k = 0; k < 4; k++) { f[2 * k] = bf2f((bf16_t)(v[k] & 0xffff)); f[2 * k + 1] = bf2f((bf16_t)(v[k] >> 16)); }
}
DEV void phase_conv(const Params& p, int layer) {
  unsigned char* ws = p.ws;
  const bf16_t* U = (const bf16_t*)(ws + OFF_U);
  bf16_t* GF = (bf16_t*)(ws + OFF_GF);
  const float* cw = p.in[11] + (size_t)layer * 3 * 5632;
  const float* cbias = p.in[12] + (size_t)layer * 5632;
  for (int idx = get_bid() * NTHR + get_tid(); idx < (LT / 8) * 352; idx += gridDim.x * NTHR) {
    const int tb = idx / 352, c8 = (idx - tb * 352) * 8;
    const int t0 = tb * 8;
    float wg[3][8], wv[3][8], bg[8], bv[8];
#pragma unroll
    for (int k = 0; k < 8; k++) {
      bg[k] = cbias[c8 + k]; bv[k] = cbias[2816 + c8 + k];
#pragma unroll
      for (int j = 0; j < 3; j++) { wg[j][k] = cw[j * 5632 + c8 + k]; wv[j][k] = cw[j * 5632 + 2816 + c8 + k]; }
    }
    float g0[8], g1[8], v0[8], v1[8];
    if (t0 >= 2) {
      unpack8(*(const u32x4*)(U + (size_t)(t0 - 2) * 5632 + c8), g0);
      unpack8(*(const u32x4*)(U + (size_t)(t0 - 2) * 5632 + 2816 + c8), v0);
      unpack8(*(const u32x4*)(U + (size_t)(t0 - 1) * 5632 + c8), g1);
      unpack8(*(const u32x4*)(U + (size_t)(t0 - 1) * 5632 + 2816 + c8), v1);
    } else {
#pragma unroll
      for (int k = 0; k < 8; k++) { g0[k] = 0.f; g1[k] = 0.f; v0[k] = 0.f; v1[k] = 0.f; }
    }
#pragma unroll
    for (int tt = 0; tt < 8; tt++) {
      float g2[8], v2[8];
      unpack8(*(const u32x4*)(U + (size_t)(t0 + tt) * 5632 + c8), g2);
      unpack8(*(const u32x4*)(U + (size_t)(t0 + tt) * 5632 + 2816 + c8), v2);
      float og[8];
#pragma unroll
      for (int k = 0; k < 8; k++) {
        const float gg = bg[k] + wg[0][k] * g0[k] + wg[1][k] * g1[k] + wg[2][k] * g2[k];
        const float vv = bv[k] + wv[0][k] * v0[k] + wv[1][k] * v1[k] + wv[2][k] * v2[k];
        og[k] = silu_f(gg) * vv;
        g0[k] = g1[k]; g1[k] = g2[k]; v0[k] = v1[k]; v1[k] = v2[k];
      }
      u32x4 o;
      o[0] = pack2(og[0], og[1]); o[1] = pack2(og[2], og[3]); o[2] = pack2(og[4], og[5]); o[3] = pack2(og[6], og[7]);
      *(u32x4*)(GF + (size_t)(t0 + tt) * 2816 + c8) = o;
    }
  }
}

__global__ void __launch_bounds__(NTHR) fwd_megakernel(Params p) {
  extern __shared__ __attribute__((aligned(16))) unsigned char lds[];
  cg::grid_group grid = cg::this_grid();
  unsigned bar_target = 0;
  unsigned* bar_word = (unsigned*)(p.ws + OFF_CTR) + 32;
#define GRID_SYNC() do { \
    asm volatile("s_waitcnt vmcnt(0) lgkmcnt(0)" ::: "memory"); \
    __syncthreads(); \
    bar_target += gridDim.x; \
    if (threadIdx.x == 0) { \
      __builtin_amdgcn_fence(__ATOMIC_RELEASE, "agent"); \
      asm volatile("s_waitcnt vmcnt(0)" ::: "memory"); \
      __hip_atomic_fetch_add(bar_word, 1u, __ATOMIC_RELAXED, __HIP_MEMORY_SCOPE_AGENT); \
      while (__hip_atomic_load(bar_word, __ATOMIC_RELAXED, __HIP_MEMORY_SCOPE_AGENT) < bar_target) __builtin_amdgcn_s_sleep(1); \
      __builtin_amdgcn_fence(__ATOMIC_ACQUIRE, "agent"); \
      asm volatile("s_waitcnt vmcnt(0)" ::: "memory"); \
    } \
    __syncthreads(); \
  } while (0)
  grid.sync();
  unsigned char* ws = p.ws;
  phase_init(p);
  phase_convert(p, 0, lds);
  GRID_SYNC();
  for (int layer = 0; layer < 2; layer++) {
    if (layer == 1) { phase_convert(p, 1, lds); GRID_SYNC(); }
    for (int b = 0; b < 2; b++) {
      phase_norm(p, b, p.in[2] + layer * 1024, (bf16_t*)(ws + OFF_HN));
      GRID_SYNC();
      phase_projA(p, layer, lds);
      GRID_SYNC();
      phase_U(p, lds);
      GRID_SYNC();
      phase_scan(p);
      GRID_SYNC();
      phase_O(p, layer, layer * 2 + b, lds);
      GRID_SYNC();
      phase_G(p, lds);
      GRID_SYNC();
      phase_Y(p, lds);
      GRID_SYNC();
      phase_resid(p, b, (const bf16_t*)(ws + OFF_Y), 1024, (const bf16_t*)(ws + OFF_WO), lds);
      GRID_SYNC();
      phase_norm(p, b, p.in[9] + layer * 1024, (bf16_t*)(ws + OFF_HN));
      GRID_SYNC();
      phase_F1(p, lds);
      GRID_SYNC();
      phase_conv(p, layer);
      GRID_SYNC();
      phase_resid(p, b, (const bf16_t*)(ws + OFF_GF), DFF, (const bf16_t*)(ws + OFF_WFO), lds);
      GRID_SYNC();
    }
  }
  phase_final(p);
}

extern "C" void kernel_launch(void* const* d_in, const int* in_sizes, int n_in, void* d_out, int out_size,
                              void* d_ws, size_t ws_size, hipStream_t stream) {
  static int grid_blocks = 0;
  if (grid_blocks == 0) {
    if (n_in != 15 || ws_size < OFF_END) {
      fprintf(stderr, "kernel_launch: need 15 inputs and %zu bytes of workspace, got %d and %zu\n", (size_t)OFF_END, n_in, ws_size);
      grid_blocks = -1; return;
    }
    int dev = 0, cus = 0, per_cu = 0;
    hipGetDevice(&dev);
    hipDeviceGetAttribute(&cus, hipDeviceAttributeMultiprocessorCount, dev);
    if (hipFuncSetAttribute((const void*)fwd_megakernel, hipFuncAttributeMaxDynamicSharedMemorySize, LDS_BYTES) != hipSuccess) {
      fprintf(stderr, "kernel_launch: hipFuncSetAttribute failed\n"); grid_blocks = -1; return;
    }
    hipOccupancyMaxActiveBlocksPerMultiprocessor(&per_cu, (const void*)fwd_megakernel, NTHR, LDS_BYTES);
    if (per_cu < 1) per_cu = 1;
    if (per_cu > 1) per_cu = 1;
    grid_blocks = cus * per_cu;
  }
  if (grid_blocks < 0) return;
  hipMemsetAsync((char*)d_ws + OFF_CTR, 0, 256, stream);
  Params p{};
  for (int i = 0; i < 15; i++) p.in[i] = (const float*)d_in[i];
  p.out = (float*)d_out;
  p.ws = (unsigned char*)d_ws;
  void* args[] = {&p};
  hipError_t e = hipLaunchCooperativeKernel((const void*)fwd_megakernel, dim3(grid_blocks), dim3(NTHR), args, LDS_BYTES, stream);
  if (e != hipSuccess) fprintf(stderr, "cooperative launch failed: %s (grid %d)\n", hipGetErrorString(e), grid_blocks);
}
```

```cpp
#include <hip/hip_runtime.h>
#include <hip/hip_cooperative_groups.h>
#include <cstdio>
#include <cstdint>
namespace cg = cooperative_groups;

typedef unsigned short bf16_t;
typedef __attribute__((ext_vector_type(8))) short bf16x8;
typedef __attribute__((ext_vector_type(4))) short bf16x4;
typedef __attribute__((ext_vector_type(4))) float f32x4;
typedef __attribute__((ext_vector_type(4))) unsigned u32x4;

#define DEV __device__ __forceinline__
#define MFMA(a, b, c) __builtin_amdgcn_mfma_f32_16x16x32_bf16(a, b, c, 0, 0, 0)

constexpr int LT = 8320;
constexpr int NCH = 65;
constexpr int NTHR = 512;
constexpr int LDS_BYTES = 144 * 1024;
constexpr int INW = 13312;
constexpr int DFF = 2816;

constexpr size_t SZ_ACT = (size_t)LT * 1024 * 2;
constexpr size_t OFF_WIN = 0;
constexpr size_t OFF_WB = OFF_WIN + (size_t)INW * 1024 * 2;
constexpr size_t OFF_WO = OFF_WB + (size_t)3 * 1024 * 1024 * 2;
constexpr size_t OFF_WFI = OFF_WO + (size_t)1024 * 1024 * 2;
constexpr size_t OFF_WFO = OFF_WFI + (size_t)5632 * 1024 * 2;
constexpr size_t OFF_H = OFF_WFO + (size_t)1024 * 2816 * 2;
constexpr size_t OFF_HN = OFF_H + (size_t)2 * 128 * 1024 * 4;
constexpr size_t OFF_R128 = OFF_HN + SZ_ACT;
constexpr size_t OFF_R64 = OFF_R128 + (size_t)LT * 64 * 8;
constexpr size_t OFF_CTR = OFF_R64 + (size_t)LT * 32 * 8;
constexpr size_t OFF_ARENA = OFF_CTR + 256;
constexpr size_t OFF_RQ = OFF_ARENA;
constexpr size_t OFF_RK = OFF_RQ + SZ_ACT / 2;
constexpr size_t OFF_RKT = OFF_RK + SZ_ACT / 2;
constexpr size_t OFF_RVT = OFF_RKT + SZ_ACT / 2;
constexpr size_t OFF_HQ = OFF_RVT + SZ_ACT;
constexpr size_t OFF_HK = OFF_HQ + SZ_ACT;
constexpr size_t OFF_HCB = OFF_HK + SZ_ACT;
constexpr size_t OFF_HKET = OFF_HCB + 2 * SZ_ACT;
constexpr size_t OFF_HVT = OFF_HKET + SZ_ACT;
constexpr size_t OFF_DQ = OFF_HVT + SZ_ACT;
constexpr size_t OFF_DK = OFF_DQ + SZ_ACT;
constexpr size_t OFF_DVT = OFF_DK + SZ_ACT;
constexpr size_t OFF_ORET = OFF_DVT + SZ_ACT;
constexpr size_t OFF_OHG = OFF_ORET + SZ_ACT;
constexpr size_t OFF_STR = OFF_OHG + SZ_ACT;
constexpr size_t OFF_STH = OFF_STR + SZ_ACT;
constexpr size_t OFF_HDEC = OFF_STH + SZ_ACT;
constexpr size_t OFF_END = OFF_HDEC + (size_t)65 * 1024 * 4;
constexpr size_t OFF_G = OFF_RQ;
constexpr size_t OFF_Y = OFF_HK;
constexpr size_t OFF_ODA = OFF_HKET;
constexpr size_t OFF_U = OFF_ARENA;
constexpr size_t OFF_GF = OFF_U + (size_t)LT * 5632 * 2;

struct Params {
  const float* in[15];
  float* out;
  unsigned char* ws;
};

DEV int get_tid() { int t = threadIdx.x; asm volatile("" : "+v"(t)); return t; }
DEV int get_bid() { int b = blockIdx.x; asm volatile("" : "+s"(b)); return b; }
DEV float* hrow(const Params& p, int b, int t) {
  return (t < 128) ? (float*)(p.ws + OFF_H) + (size_t)(b * 128 + t) * 1024 : p.out + ((size_t)b * 8192 + (t - 128)) * 1024;
}
typedef __bf16 hwbf16x2 __attribute__((ext_vector_type(2)));
typedef float hwf32x2 __attribute__((ext_vector_type(2)));
DEV unsigned pack2(float a, float b) {
  hwf32x2 f = {a, b};
  hwbf16x2 h = __builtin_convertvector(f, hwbf16x2);
  return __builtin_bit_cast(unsigned, h);
}
DEV bf16_t f2bf(float f) { return (bf16_t)(pack2(f, f) & 0xffffu); }
DEV float bf2f(bf16_t h) { return __uint_as_float(((unsigned)h) << 16); }
DEV uint2 pack4(f32x4 v) { uint2 r; r.x = pack2(v[0], v[1]); r.y = pack2(v[2], v[3]); return r; }
DEV float silu_f(float x) { return x / (1.f + __expf(-x)); }
DEV float sigmoid_f(float x) { return 1.f / (1.f + __expf(-x)); }
DEV float ex2(float x) { return __builtin_amdgcn_exp2f(x); }
DEV bf16x8 ldfrag(const bf16_t* base, int stride, int row, int k) {
  return *(const bf16x8*)(base + row * stride + k);
}

template <int BN, bool TRANS>
DEV void gemm_compute(f32x4 (&acc)[2][BN / 32], const bf16_t* as, const bf16_t* bs) {
  constexpr int NJ = BN / 32, LS = 72;
#pragma unroll
  for (int ks = 0; ks < 2; ks++) {
    bf16x8 a0 = *(const bf16x8*)(as + ks * 32);
    bf16x8 a1 = *(const bf16x8*)(as + 16 * LS + ks * 32);
#pragma unroll
    for (int j = 0; j < NJ; j++) {
      bf16x8 bb = *(const bf16x8*)(bs + j * 16 * LS + ks * 32);
      if (TRANS) {
        acc[0][j] = MFMA(a0, bb, acc[0][j]);
        acc[1][j] = MFMA(a1, bb, acc[1][j]);
      } else {
        acc[0][j] = MFMA(bb, a0, acc[0][j]);
        acc[1][j] = MFMA(bb, a1, acc[1][j]);
      }
    }
  }
}

template <int BN, bool TRANS>
DEV void gemm_acc(f32x4 (&acc)[2][BN / 32], const bf16_t* __restrict__ A, int lda,
                  const bf16_t* __restrict__ Bt, int ldb, int K, bf16_t* lds) {
  constexpr int LS = 72, A_SZ = 128 * LS, B_SZ = BN * LS, NB = BN / 64;
  const int tid = get_tid(), lane = tid & 63, wave = tid >> 6, wm = wave >> 1, wn = wave & 1;
  const int lr = lane & 15, lg = lane >> 4;
  bf16_t* As = lds;
  bf16_t* Bs = lds + 2 * A_SZ;
  const int crow = tid >> 3, ckc = (tid & 7) * 8;
  const bf16_t* ga = A + (size_t)crow * lda + ckc;
  const bf16_t* gb = Bt + (size_t)crow * ldb + ckc;
  u32x4 ra0, ra1, rb0, rb1, rb2, rb3;
#define GLOAD(k0)                                                        \
  ra0 = *(const u32x4*)(ga + (k0));                                      \
  ra1 = *(const u32x4*)(ga + (size_t)64 * lda + (k0));                   \
  rb0 = *(const u32x4*)(gb + (k0));                                      \
  rb1 = *(const u32x4*)(gb + (size_t)64 * ldb + (k0));                   \
  if (NB == 4) {                                                         \
    rb2 = *(const u32x4*)(gb + (size_t)128 * ldb + (k0));                \
    rb3 = *(const u32x4*)(gb + (size_t)192 * ldb + (k0));                \
  }
#define LSTORE(buf)                                                      \
  *(u32x4*)(As + (buf) * A_SZ + crow * LS + ckc) = ra0;                  \
  *(u32x4*)(As + (buf) * A_SZ + (crow + 64) * LS + ckc) = ra1;           \
  *(u32x4*)(Bs + (buf) * B_SZ + crow * LS + ckc) = rb0;                  \
  *(u32x4*)(Bs + (buf) * B_SZ + (crow + 64) * LS + ckc) = rb1;           \
  if (NB == 4) {                                                         \
    *(u32x4*)(Bs + (buf) * B_SZ + (crow + 128) * LS + ckc) = rb2;        \
    *(u32x4*)(Bs + (buf) * B_SZ + (crow + 192) * LS + ckc) = rb3;        \
  }
  const int nk = K / 64;
  const int aoff = (wm * 32 + lr) * LS + lg * 8;
  const int boff = (wn * (BN / 2) + lr) * LS + lg * 8;
  GLOAD(0)
  __syncthreads();
  LSTORE(0)
  GLOAD(64)
  __syncthreads();
  for (int kt = 0; kt < nk; kt++) {
    const int cur = kt & 1;
    LSTORE(cur ^ 1)
    {
      const int kn = (kt + 2 < nk) ? kt + 2 : nk - 1;
      GLOAD(kn * 64)
    }
    gemm_compute<BN, TRANS>(acc, As + cur * A_SZ + aoff, Bs + cur * B_SZ + boff);
    __syncthreads();
  }
#undef GLOAD
#undef LSTORE
}

DEV void gemm256_compute(f32x4 (&acc)[4][8], const bf16_t* as, const bf16_t* bs) {
  constexpr int LS = 72;
#pragma unroll
  for (int ks = 0; ks < 2; ks++) {
    bf16x8 a[4];
#pragma unroll
    for (int i = 0; i < 4; i++) a[i] = *(const bf16x8*)(as + i * 16 * LS + ks * 32);
#pragma unroll
    for (int j = 0; j < 8; j++) {
      bf16x8 bb = *(const bf16x8*)(bs + j * 16 * LS + ks * 32);
#pragma unroll
      for (int i = 0; i < 4; i++) acc[i][j] = MFMA(bb, a[i], acc[i][j]);
    }
  }
}

DEV void gemm256_acc(f32x4 (&acc)[4][8], const bf16_t* __restrict__ A, int lda, int m_valid,
                     const bf16_t* __restrict__ Bt, int ldb, int K, bf16_t* lds) {
  constexpr int LS = 72, T_SZ = 256 * LS;
  const int tid = get_tid(), lane = tid & 63, wave = tid >> 6, wm = wave >> 1, wn = wave & 1;
  const int lr = lane & 15, lg = lane >> 4;
  bf16_t* As = lds;
  bf16_t* Bs = lds + 2 * T_SZ;
  const int crow = tid >> 3, ckc = (tid & 7) * 8;
  const bf16_t* ga0 = A + (size_t)min(crow, m_valid - 1) * lda + ckc;
  const bf16_t* ga1 = A + (size_t)min(crow + 64, m_valid - 1) * lda + ckc;
  const bf16_t* ga2 = A + (size_t)min(crow + 128, m_valid - 1) * lda + ckc;
  const bf16_t* ga3 = A + (size_t)min(crow + 192, m_valid - 1) * lda + ckc;
  const bf16_t* gb = Bt + (size_t)crow * ldb + ckc;
  u32x4 ra0, ra1, ra2, ra3, rb0, rb1, rb2, rb3;
#define GLOAD(k0)                                                        \
  ra0 = *(const u32x4*)(ga0 + (k0));                                     \
  ra1 = *(const u32x4*)(ga1 + (k0));                                     \
  ra2 = *(const u32x4*)(ga2 + (k0));                                     \
  ra3 = *(const u32x4*)(ga3 + (k0));                                     \
  rb0 = *(const u32x4*)(gb + (k0));                                      \
  rb1 = *(const u32x4*)(gb + (size_t)64 * ldb + (k0));                   \
  rb2 = *(const u32x4*)(gb + (size_t)128 * ldb + (k0));                  \
  rb3 = *(const u32x4*)(gb + (size_t)192 * ldb + (k0));
#define LSTORE(buf)                                                      \
  *(u32x4*)(As + (buf) * T_SZ + crow * LS + ckc) = ra0;                  \
  *(u32x4*)(As + (buf) * T_SZ + (crow + 64) * LS + ckc) = ra1;           \
  *(u32x4*)(As + (buf) * T_SZ + (crow + 128) * LS + ckc) = ra2;          \
  *(u32x4*)(As + (buf) * T_SZ + (crow + 192) * LS + ckc) = ra3;          \
  *(u32x4*)(Bs + (buf) * T_SZ + crow * LS + ckc) = rb0;                  \
  *(u32x4*)(Bs + (buf) * T_SZ + (crow + 64) * LS + ckc) = rb1;           \
  *(u32x4*)(Bs + (buf) * T_SZ + (crow + 128) * LS + ckc) = rb2;          \
  *(u32x4*)(Bs + (buf) * T_SZ + (crow + 192) * LS + ckc) = rb3;
  const int nk = K / 64;
  const int aoff = (wm * 64 + lr) * LS + lg * 8;
  const int boff = (wn * 128 + lr) * LS + lg * 8;
  GLOAD(0)
  __syncthreads();
  LSTORE(0)
  GLOAD(64)
  __syncthreads();
  for (int kt = 0; kt < nk; kt++) {
    const int cur = kt & 1;
    LSTORE(cur ^ 1)
    {
      const int kn = (kt + 2 < nk) ? kt + 2 : nk - 1;
      GLOAD(kn * 64)
    }
    gemm256_compute(acc, As + cur * T_SZ + aoff, Bs + cur * T_SZ + boff);
    __syncthreads();
  }
#undef GLOAD
#undef LSTORE
}

DEV void tconv_tile(const float* __restrict__ src, int K, int N, bf16_t* __restrict__ dst, int tk, int tn, float* tile) {
  const int tid = get_tid();
  const int r = tid >> 4, c4 = (tid & 15) * 4;
#pragma unroll
  for (int i = 0; i < 2; i++) {
    const int rr = r + i * 32;
    float4 v = *(const float4*)(src + (size_t)(tk * 64 + rr) * N + tn * 64 + c4);
    tile[rr * 65 + c4 + 0] = v.x; tile[rr * 65 + c4 + 1] = v.y; tile[rr * 65 + c4 + 2] = v.z; tile[rr * 65 + c4 + 3] = v.w;
  }
  __syncthreads();
  const int n = tid >> 3, k8 = (tid & 7) * 8;
  uint4 o;
  o.x = pack2(tile[(k8 + 0) * 65 + n], tile[(k8 + 1) * 65 + n]);
  o.y = pack2(tile[(k8 + 2) * 65 + n], tile[(k8 + 3) * 65 + n]);
  o.z = pack2(tile[(k8 + 4) * 65 + n], tile[(k8 + 5) * 65 + n]);
  o.w = pack2(tile[(k8 + 6) * 65 + n], tile[(k8 + 7) * 65 + n]);
  *(uint4*)(dst + (size_t)(tn * 64 + n) * K + tk * 64 + k8) = o;
  __syncthreads();
}

DEV void phase_convert(const Params& p, int layer, unsigned char* lds) {
  unsigned char* ws = p.ws;
  float* tile = (float*)lds;
  for (int item = get_bid(); item < 6464; item += gridDim.x) {
    const float* src; bf16_t* dst; int K, N, idx;
    if (item < 3328) { idx = item; src = p.in[3] + (size_t)layer * 1024 * INW; K = 1024; N = INW; dst = (bf16_t*)(ws + OFF_WIN); }
    else if (item < 3328 + 768) { idx = item - 3328; int br = idx >> 8; idx &= 255; src = p.in[4] + ((size_t)layer * 3 + br) * 1024 * 1024; K = 1024; N = 1024; dst = (bf16_t*)(ws + OFF_WB) + (size_t)br * 1024 * 1024; }
    else if (item < 3328 + 1024) { idx = item - 4096; src = p.in[5] + (size_t)layer * 1024 * 1024; K = 1024; N = 1024; dst = (bf16_t*)(ws + OFF_WO); }
    else if (item < 4352 + 1408) { idx = item - 4352; src = p.in[10] + (size_t)layer * 1024 * 5632; K = 1024; N = 5632; dst = (bf16_t*)(ws + OFF_WFI); }
    else { idx = item - 5760; src = p.in[13] + (size_t)layer * 2816 * 1024; K = 2816; N = 1024; dst = (bf16_t*)(ws + OFF_WFO); }
    const int ntn = N / 64;
    tconv_tile(src, K, N, dst, idx / ntn, idx % ntn, tile);
  }
}

DEV void phase_init(const Params& p) {
  unsigned char* ws = p.ws;
  const int gt = get_bid() * NTHR + get_tid(), gs = gridDim.x * NTHR;
  for (int idx = gt; idx < 2 * LT * 256; idx += gs) {
    const int row = idx >> 8, c4 = (idx & 255) * 4;
    const int b = row / LT, t = row - b * LT;
    float4 v;
    if (t < 112) v = make_float4(0.f, 0.f, 0.f, 0.f);
    else if (t < 128) v = *(const float4*)(p.in[1] + (size_t)(t - 112) * 1024 + c4);
    else v = *(const float4*)(p.in[0] + ((size_t)b * 8192 + (t - 128)) * 1024 + c4);
    *(float4*)(hrow(p, b, t) + c4) = v;
  }
  float2* R128 = (float2*)(ws + OFF_R128);
  float2* R64 = (float2*)(ws + OFF_R64);
  for (int idx = gt; idx < LT * 96; idx += gs) {
    const int t = idx / 96, f = idx - t * 96;
    float inv;
    if (f < 64) inv = powf(10000.f, -(float)(2 * f) / 128.f);
    else inv = powf(10000.f, -(float)(2 * (f - 64)) / 64.f);
    const float ang = (float)(t - 112) * inv;
    const double ad = (double)ang;
    const double n = rint(ad * 0.15915494309189535);
    const float rr = (float)(ad - n * 6.283185307179586);
    float2 cs; cs.x = __cosf(rr); cs.y = __sinf(rr);
    if (f < 64) R128[(size_t)t * 64 + f] = cs; else R64[(size_t)t * 32 + (f - 64)] = cs;
  }
}

DEV void phase_norm(const Params& p, int b, const float* __restrict__ g, bf16_t* __restrict__ dst) {
  const int lane = get_tid() & 63, wave = get_tid() >> 6;
  for (int row = get_bid() * 8 + wave; row < LT; row += gridDim.x * 8) {
    const float* src = hrow(p, b, row);
    float4 v[4]; float ss = 0.f;
#pragma unroll
    for (int k = 0; k < 4; k++) { v[k] = *(const float4*)(src + k * 256 + lane * 4); ss += v[k].x * v[k].x + v[k].y * v[k].y + v[k].z * v[k].z + v[k].w * v[k].w; }
#pragma unroll
    for (int o = 1; o < 64; o <<= 1) ss += __shfl_xor(ss, o);
    const float rs = rsqrtf(ss * (1.f / 1024.f) + 1e-6f);
#pragma unroll
    for (int k = 0; k < 4; k++) {
      float4 gg = *(const float4*)(g + k * 256 + lane * 4);
      uint2 o; o.x = pack2(v[k].x * rs * gg.x, v[k].y * rs * gg.y); o.y = pack2(v[k].z * rs * gg.z, v[k].w * rs * gg.w);
      *(uint2*)(dst + (size_t)row * 1024 + k * 256 + lane * 4) = o;
    }
  }
}

DEV void phase_final(const Params& p) {
  const float* g = p.in[14];
  const int lane = get_tid() & 63, wave = get_tid() >> 6;
  for (int row = get_bid() * 8 + wave; row < 2 * 8192; row += gridDim.x * 8) {
    const float* src = p.out + (size_t)row * 1024;
    float4 v[4]; float ss = 0.f;
#pragma unroll
    for (int k = 0; k < 4; k++) { v[k] = *(const float4*)(src + k * 256 + lane * 4); ss += v[k].x * v[k].x + v[k].y * v[k].y + v[k].z * v[k].z + v[k].w * v[k].w; }
#pragma unroll
    for (int o = 1; o < 64; o <<= 1) ss += __shfl_xor(ss, o);
    const float rs = rsqrtf(ss * (1.f / 1024.f) + 1e-6f);
#pragma unroll
    for (int k = 0; k < 4; k++) {
      float4 gg = *(const float4*)(g + k * 256 + lane * 4);
      float4 o = make_float4(v[k].x * rs * gg.x, v[k].y * rs * gg.y, v[k].z * rs * gg.z, v[k].w * rs * gg.w);
      *(float4*)(p.out + (size_t)row * 1024 + k * 256 + lane * 4) = o;
    }
  }
}

DEV void tile_map(int it, int MT, int NG, int& mt, int& nt) {
  const int ng = it / (MT * NG), rem = it - ng * (MT * NG);
  mt = rem / NG; nt = ng * NG + (rem - mt * NG);
}
DEV int vblock() { const int b = get_bid(), G = (int)gridDim.x; return ((G & 7) == 0) ? (b & 7) * (G >> 3) + (b >> 3) : b; }

DEV void phase_projA(const Params& p, int layer, unsigned char* ldsraw) {
  unsigned char* ws = p.ws;
  bf16_t* lds = (bf16_t*)ldsraw;
  const bf16_t* HN = (const bf16_t*)(ws + OFF_HN);
  const bf16_t* WIN = (const bf16_t*)(ws + OFF_WIN);
  const float2* R128 = (const float2*)(ws + OFF_R128);
  const float2* R64 = (const float2*)(ws + OFF_R64);
  for (int item = vblock(); item < 65 * 32; item += gridDim.x) {
    int nt, mt; tile_map(item, 65, 4, mt, nt);
    int n0, seg, segstart;
    if (nt < 8) { n0 = nt * 256; seg = nt < 2 ? 0 : (nt < 4 ? 1 : 2); segstart = seg == 0 ? 0 : (seg == 1 ? 512 : 1024); }
    else if (nt < 20) { n0 = 3072 + (nt - 8) * 256; seg = 3 + (nt - 8) / 4; segstart = 3072 + (seg - 3) * 1024; }
    else { n0 = 7168 + (nt - 20) * 256; seg = 6 + (nt - 20) / 4; segstart = 7168 + (seg - 6) * 1024; }
    const bf16_t* A = HN + (size_t)mt * 128 * 1024;
    const bf16_t* Bt = WIN + (size_t)n0 * 1024;
    f32x4 acc[2][8];
#pragma unroll
    for (int i = 0; i < 2; i++)
#pragma unroll
      for (int j = 0; j < 8; j++) acc[i][j] = (f32x4){0.f, 0.f, 0.f, 0.f};
    if (seg == 0 || seg == 3 || seg == 6 || seg == 7) {
      gemm_acc<256, false>(acc, A, 1024, Bt, 1024, 1024, lds);
      const int tid = get_tid(), lane = tid & 63, wave = tid >> 6, wm = wave >> 1, wn = wave & 1; const int lr = lane & 15, lg = lane >> 4; (void)tid; (void)lane; (void)wm; (void)wn; (void)lr; (void)lg;
      const int cw = (n0 - segstart) + wn * 128;
      bf16_t* dstb; int ld;
      if (seg == 0) { dstb = (bf16_t*)(ws + OFF_RQ); ld = 512; }
      else if (seg == 3) { dstb = (bf16_t*)(ws + OFF_HQ); ld = 1024; }
      else if (seg == 6) { dstb = (bf16_t*)(ws + OFF_DQ); ld = 1024; }
      else { dstb = (bf16_t*)(ws + OFF_DK); ld = 1024; }
#pragma unroll
      for (int i = 0; i < 2; i++) {
        const int t = mt * 128 + wm * 32 + i * 16 + lr;
        if (seg == 0) {
          const float2* tab = R128 + (size_t)t * 64;
#pragma unroll
          for (int j = 0; j < 4; j++)
#pragma unroll
            for (int r = 0; r < 4; r++) {
              float2 cs = tab[j * 16 + lg * 4 + r];
              float x1 = acc[i][j][r], x2 = acc[i][j + 4][r];
              acc[i][j][r] = x1 * cs.x - x2 * cs.y;
              acc[i][j + 4][r] = x2 * cs.x + x1 * cs.y;
            }
        } else if (seg == 6 || seg == 7) {
          const float2* tab = R64 + (size_t)t * 32;
          const float sc = (seg == 6) ? (0.125f * 1.4426950408889634f) : 1.f;
#pragma unroll
          for (int jq = 0; jq < 4; jq++) {
            const int j = (jq & 1) + (jq >> 1) * 4;
#pragma unroll
            for (int r = 0; r < 4; r++) {
              float2 cs = tab[(jq & 1) * 16 + lg * 4 + r];
              float x1 = acc[i][j][r], x2 = acc[i][j + 2][r];
              acc[i][j][r] = (x1 * cs.x - x2 * cs.y) * sc;
              acc[i][j + 2][r] = (x2 * cs.x + x1 * cs.y) * sc;
            }
          }
        }
        bf16_t* dst = dstb + (size_t)t * ld + cw;
#pragma unroll
        for (int j = 0; j < 8; j++) *(uint2*)(dst + j * 16 + lg * 4) = pack4(acc[i][j]);
      }
    } else {
      gemm_acc<256, true>(acc, A, 1024, Bt, 1024, 1024, lds);
      const int tid = get_tid(), lane = tid & 63, wave = tid >> 6, wm = wave >> 1, wn = wave & 1; const int lr = lane & 15, lg = lane >> 4; (void)tid; (void)lane; (void)wm; (void)wn; (void)lr; (void)lg;
      const int cw = (n0 - segstart) + wn * 128;
      if (seg == 1) {
        bf16_t* RK = (bf16_t*)(ws + OFF_RK);
        bf16_t* RKT = (bf16_t*)(ws + OFF_RKT);
        const int h = cw >> 7;
        const float l2g = log2f(1.f - ex2(-5.f - (float)h));
#pragma unroll
        for (int i = 0; i < 2; i++) {
          const int mb = wm * 32 + i * 16 + lg * 4;
#pragma unroll
          for (int j = 0; j < 4; j++)
#pragma unroll
            for (int r = 0; r < 4; r++) {
              const int t = mt * 128 + mb + r;
              float2 cs = R128[(size_t)t * 64 + j * 16 + lr];
              const float sc = (t >= 112) ? 0.08838834764831845f : 0.f;
              float x1 = acc[i][j][r], x2 = acc[i][j + 4][r];
              acc[i][j][r] = (x1 * cs.x - x2 * cs.y) * sc;
              acc[i][j + 4][r] = (x2 * cs.x + x1 * cs.y) * sc;
            }
#pragma unroll
          for (int j = 0; j < 8; j++) {
            const int col = cw + j * 16 + lr;
            f32x4 kd;
#pragma unroll
            for (int r = 0; r < 4; r++) {
              const int t = mt * 128 + mb + r;
              RK[(size_t)t * 512 + col] = f2bf(acc[i][j][r]);
              kd[r] = acc[i][j][r] * ex2(l2g * (float)(127 - (mb + r)));
            }
            *(uint2*)(RKT + (size_t)col * LT + mt * 128 + mb) = pack4(kd);
          }
        }
      } else if (seg == 2 || seg == 5 || seg == 8) {
        bf16_t* dT = (bf16_t*)(ws + (seg == 2 ? OFF_RVT : (seg == 5 ? OFF_HVT : OFF_DVT)));
#pragma unroll
        for (int i = 0; i < 2; i++) {
          const int mb = wm * 32 + i * 16 + lg * 4;
#pragma unroll
          for (int j = 0; j < 8; j++) {
            const int col = cw + j * 16 + lr;
            f32x4 v = acc[i][j];
            if (seg == 5) {
#pragma unroll
              for (int r = 0; r < 4; r++) if (mt * 128 + mb + r < 112) v[r] = 0.f;
            }
            *(uint2*)(dT + (size_t)col * LT + mt * 128 + mb) = pack4(v);
          }
        }
      } else {
        float* Lf = (float*)ldsraw;
        float* HCB = (float*)(ws + OFF_HCB);
        bf16_t* HK = (bf16_t*)(ws + OFF_HK);
        bf16_t* HKET = (bf16_t*)(ws + OFF_HKET);
        float* HDEC = (float*)(ws + OFF_HDEC);
        const float* lbp = p.in[6];
#pragma unroll
        for (int j = 0; j < 8; j++) {
          const int col = cw + j * 16 + lr;
          float lb = 0.f;
          if (layer == 1) lb = 1.f / (1.f + __expf(lbp[col] - lbp[1024 + col]));
#pragma unroll
          for (int i = 0; i < 2; i++)
#pragma unroll
            for (int r = 0; r < 4; r++) {
              const int m = wm * 32 + i * 16 + lg * 4 + r;
              const float z = acc[i][j][r];
              const float kk = (1.f - lb) / (1.f + __expf(z));
              const float lf = fmaxf(log1pf(-kk), -69.0776f);
              acc[i][j][r] = kk;
              Lf[m * 260 + wn * 128 + j * 16 + lr] = lf;
            }
        }
        __syncthreads();
        {
          const int colL = tid & 255, half = tid >> 8;
          float run = 0.f;
          for (int rr = 0; rr < 64; rr++) {
            float* q = &Lf[(half * 64 + rr) * 260 + colL];
            run += *q; *q = run;
          }
        }
        __syncthreads();
#pragma unroll
        for (int j = 0; j < 8; j++) {
          const int colL = wn * 128 + j * 16 + lr;
          const int col = cw + j * 16 + lr;
          const float ft = Lf[63 * 260 + colL];
          const float cend = Lf[127 * 260 + colL] + ft;
#pragma unroll
          for (int i = 0; i < 2; i++) {
            const int mb = wm * 32 + i * 16 + lg * 4;
            f32x4 ke;
#pragma unroll
            for (int r = 0; r < 4; r++) {
              const int m = mb + r;
              const int t = mt * 128 + m;
              const float cb = Lf[m * 260 + colL] + (m >= 64 ? ft : 0.f);
              HCB[(size_t)t * 1024 + col] = cb;
              HK[(size_t)t * 1024 + col] = f2bf(acc[i][j][r]);
              ke[r] = acc[i][j][r] * __expf(cend - cb);
              if (m == 127) HDEC[mt * 1024 + col] = __expf(cend);
            }
            *(uint2*)(HKET + (size_t)col * LT + mt * 128 + mb) = pack4(ke);
          }
        }
        __syncthreads();
      }
    }
  }
}

DEV void phase_U(const Params& p, unsigned char* ldsraw) {
  unsigned char* ws = p.ws;
  bf16_t* lds = (bf16_t*)ldsraw;
  for (int item = get_bid(); item < 1040; item += gridDim.x) {
    const bf16_t *A, *Bt; bf16_t* dst;
    if (item < 520) {
      const int h = item & 3, rest = item >> 2, mh = rest & 1, c = rest >> 1;
      A = (const bf16_t*)(ws + OFF_RVT) + (size_t)(h * 256 + mh * 128) * LT + c * 128;
      Bt = (const bf16_t*)(ws + OFF_RKT) + (size_t)(h * 128) * LT + c * 128;
      dst = (bf16_t*)(ws + OFF_STR) + ((size_t)(h * 65 + c) * 256 + mh * 128) * 128;
    } else {
      const int it = item - 520, h = it & 7, c = it >> 3;
      A = (const bf16_t*)(ws + OFF_HVT) + (size_t)(h * 128) * LT + c * 128;
      Bt = (const bf16_t*)(ws + OFF_HKET) + (size_t)(h * 128) * LT + c * 128;
      dst = (bf16_t*)(ws + OFF_STH) + ((size_t)(h * 65 + c) * 128) * 128;
    }
    f32x4 acc[2][4];
#pragma unroll
    for (int i = 0; i < 2; i++)
#pragma unroll
      for (int j = 0; j < 4; j++) acc[i][j] = (f32x4){0.f, 0.f, 0.f, 0.f};
    gemm_acc<128, false>(acc, A, LT, Bt, LT, 128, lds);
      const int tid = get_tid(), lane = tid & 63, wave = tid >> 6, wm = wave >> 1, wn = wave & 1; const int lr = lane & 15, lg = lane >> 4; (void)tid; (void)lane; (void)wm; (void)wn; (void)lr; (void)lg;
#pragma unroll
    for (int i = 0; i < 2; i++)
#pragma unroll
      for (int j = 0; j < 4; j++)
        *(uint2*)(dst + (size_t)(wm * 32 + i * 16 + lr) * 128 + wn * 64 + j * 16 + lg * 4) = pack4(acc[i][j]);
  }
}

DEV void phase_scan(const Params& p) {
  unsigned char* ws = p.ws;
  const float* HDEC = (const float*)(ws + OFF_HDEC);
  for (int task = get_bid() * NTHR + get_tid(); task < 65536; task += gridDim.x * NTHR) {
    bf16_t* base; size_t stride; int h, d4; bool hg;
    float dec0 = 0.f;
    if (task < 32768) {
      const int v = task; d4 = (v & 31) * 4; const int e = (v >> 5) & 255; h = v >> 13; hg = false;
      base = (bf16_t*)(ws + OFF_STR) + ((size_t)(h * 65) * 256 + e) * 128 + d4; stride = 256 * 128;
      dec0 = ex2(128.f * log2f(1.f - ex2(-5.f - (float)h)));
    } else {
      const int v = task - 32768; d4 = (v & 31) * 4; const int e = (v >> 5) & 127; h = v >> 12; hg = true;
      base = (bf16_t*)(ws + OFF_STH) + ((size_t)(h * 65) * 128 + e) * 128 + d4; stride = 128 * 128;
    }
    float c0 = 0.f, c1 = 0.f, c2 = 0.f, c3 = 0.f;
    for (int cg0 = 0; cg0 < 65; cg0 += 13) {
      uint2 u[13]; float4 dc[13];
#pragma unroll
      for (int k = 0; k < 13; k++) {
        u[k] = *(const uint2*)(base + (size_t)(cg0 + k) * stride);
        if (hg) dc[k] = *(const float4*)(HDEC + (size_t)(cg0 + k) * 1024 + h * 128 + d4);
        else dc[k] = make_float4(dec0, dec0, dec0, dec0);
      }
#pragma unroll
      for (int k = 0; k < 13; k++) {
        uint2 o; o.x = pack2(c0, c1); o.y = pack2(c2, c3);
        *(uint2*)(base + (size_t)(cg0 + k) * stride) = o;
        c0 = dc[k].x * c0 + bf2f((bf16_t)(u[k].x & 0xffff));
        c1 = dc[k].y * c1 + bf2f((bf16_t)(u[k].x >> 16));
        c2 = dc[k].z * c2 + bf2f((bf16_t)(u[k].y & 0xffff));
        c3 = dc[k].w * c3 + bf2f((bf16_t)(u[k].y >> 16));
      }
    }
  }
}

DEV void attn_item(const Params& p, int layer, int h, int qb, float lam, bf16_t* lds) {
  unsigned char* ws = p.ws;
  const bf16_t* DQ = (const bf16_t*)(ws + OFF_DQ);
  bf16_t* ODA = (bf16_t*)(ws + OFF_ODA);
  const bf16_t* DK = (const bf16_t*)(ws + OFF_DK);
  const bf16_t* DVT = (const bf16_t*)(ws + OFF_DVT);
  constexpr int PS = 136, XS = 132;
  constexpr int TS = 128 * PS;
  bf16_t* KV = lds;
  float* X = (float*)lds;
  const int tid = get_tid(), lane = tid & 63, wave = tid >> 6;
  const int lr = lane & 15, lg = lane >> 4;
  const int grp = wave >> 2, wq = wave & 3;
  const int t0 = qb * 128;
  const int lrow = tid >> 4, lc8 = (tid & 15) * 8;
  const bf16_t* gq = DQ + (size_t)(t0 + wq * 32 + lr) * 1024 + h * 128 + grp * 64 + lg * 8;
  const bf16x8 a00 = *(const bf16x8*)(gq);
  const bf16x8 a01 = *(const bf16x8*)(gq + 32);
  const bf16x8 a10 = *(const bf16x8*)(gq + (size_t)16 * 1024);
  const bf16x8 a11 = *(const bf16x8*)(gq + (size_t)16 * 1024 + 32);
  f32x4 o[2][8];
#pragma unroll
  for (int i = 0; i < 2; i++)
#pragma unroll
    for (int j = 0; j < 8; j++) o[i][j] = (f32x4){0.f, 0.f, 0.f, 0.f};
  float mrun0 = -1e30f, mrun1 = -1e30f, lrun0 = 0.f, lrun1 = 0.f;
  u32x4 rk0, rk1, rk2, rk3, rv0, rv1, rv2, rv3;
  const unsigned ko = (unsigned)(lrow * 1024 + h * 128 + lc8);
  const unsigned vo = (unsigned)((h * 128 + lrow) * LT + lc8);
#define ALOAD(kbn)                                                              \
  rk0 = *(const u32x4*)(DK + (ko + (unsigned)(kbn) * 131072u));                 \
  rk1 = *(const u32x4*)(DK + (ko + (unsigned)(kbn) * 131072u + 32768u));        \
  rk2 = *(const u32x4*)(DK + (ko + (unsigned)(kbn) * 131072u + 65536u));        \
  rk3 = *(const u32x4*)(DK + (ko + (unsigned)(kbn) * 131072u + 98304u));        \
  rv0 = *(const u32x4*)(DVT + (vo + (unsigned)(kbn) * 128u));                   \
  rv1 = *(const u32x4*)(DVT + (vo + (unsigned)(kbn) * 128u + 32u * LT));        \
  rv2 = *(const u32x4*)(DVT + (vo + (unsigned)(kbn) * 128u + 64u * LT));        \
  rv3 = *(const u32x4*)(DVT + (vo + (unsigned)(kbn) * 128u + 96u * LT));
#define ASTORE(sp)                                                              \
  *(u32x4*)((sp)) = rk0;                                                        \
  *(u32x4*)((sp) + 32 * PS) = rk1;                                              \
  *(u32x4*)((sp) + 64 * PS) = rk2;                                              \
  *(u32x4*)((sp) + 96 * PS) = rk3;                                              \
  *(u32x4*)((sp) + 2 * TS) = rv0;                                               \
  *(u32x4*)((sp) + 2 * TS + 32 * PS) = rv1;                                     \
  *(u32x4*)((sp) + 2 * TS + 64 * PS) = rv2;                                     \
  *(u32x4*)((sp) + 2 * TS + 96 * PS) = rv3;
  ALOAD(0)
  const int qrow0 = t0 + wq * 32 + lr;
  __syncthreads();
  ASTORE(KV + lrow * PS + lc8)
  {
    const int kb1 = qb > 0 ? 1 : 0;
    ALOAD(kb1)
  }
  __syncthreads();
  for (int kb = 0; kb <= qb; kb++) {
    const int cur = kb & 1;
    const bf16_t* kp = KV + cur * TS + lr * PS + grp * 64 + lg * 8;
    const bf16_t* vq = KV + 2 * TS + cur * TS + lr * PS + lg * 4;
    {
      bf16_t* sp = KV + (cur ^ 1) * TS + lrow * PS + lc8;
      ASTORE(sp)
    }
    __builtin_amdgcn_sched_barrier(0);
    f32x4 s[2][8];
    {
#pragma unroll
      for (int j = 0; j < 8; j++) {
        const bf16x8 kf0 = *(const bf16x8*)(kp + j * 16 * PS);
        const bf16x8 kf1 = *(const bf16x8*)(kp + j * 16 * PS + 32);
        s[0][j] = MFMA(kf0, a00, ((f32x4){0.f, 0.f, 0.f, 0.f}));
        s[1][j] = MFMA(kf0, a10, ((f32x4){0.f, 0.f, 0.f, 0.f}));
        s[0][j] = MFMA(kf1, a01, s[0][j]);
        s[1][j] = MFMA(kf1, a11, s[1][j]);
      }
    }
    __builtin_amdgcn_sched_barrier(0);
    {
      const int kbn = (kb + 2 <= qb) ? kb + 2 : qb;
      ALOAD(kbn)
    }
    __builtin_amdgcn_sched_barrier(0);
    if (kb == qb || kb == 0) {
#pragma unroll
      for (int i = 0; i < 2; i++)
#pragma unroll
        for (int j = 0; j < 8; j++)
#pragma unroll
          for (int r = 0; r < 4; r++) {
            const int key = kb * 128 + j * 16 + lg * 4 + r;
            if (key > qrow0 + 16 * i || key < 112) s[i][j][r] = -1e30f;
          }
    }
    float al[2];
#pragma unroll
    for (int i = 0; i < 2; i++) {
      float mx = -1e30f;
#pragma unroll
      for (int j = 0; j < 8; j++)
#pragma unroll
        for (int r = 0; r < 4; r++) mx = fmaxf(mx, s[i][j][r]);
      mx = fmaxf(mx, __shfl_xor(mx, 16));
      mx = fmaxf(mx, __shfl_xor(mx, 32));
      const float mold = i == 0 ? mrun0 : mrun1;
      const float mnew = fmaxf(mold, mx);
      al[i] = ex2(mold - mnew);
      float ps = 0.f;
#pragma unroll
      for (int j = 0; j < 8; j++)
#pragma unroll
        for (int r = 0; r < 4; r++) { const float pv = ex2(s[i][j][r] - mnew); s[i][j][r] = pv; ps += pv; }
      if (i == 0) { mrun0 = mnew; lrun0 = lrun0 * al[0] + ps; } else { mrun1 = mnew; lrun1 = lrun1 * al[1] + ps; }
    }
    if (__builtin_amdgcn_ballot_w64(al[0] != 1.f || al[1] != 1.f) != 0ull) {
#pragma unroll
      for (int i = 0; i < 2; i++) {
        float ao[4];
#pragma unroll
        for (int r = 0; r < 4; r++) ao[r] = __shfl(al[i], lg * 4 + r);
#pragma unroll
        for (int je = 0; je < 8; je++)
#pragma unroll
          for (int r = 0; r < 4; r++) o[i][je][r] *= ao[r];
      }
    }
#pragma unroll
    for (int ks = 0; ks < 4; ks++) {
      union { u32x4 u; bf16x8 v; } pf0, pf1;
      pf0.u[0] = pack2(s[0][2 * ks][0], s[0][2 * ks][1]);
      pf0.u[1] = pack2(s[0][2 * ks][2], s[0][2 * ks][3]);
      pf0.u[2] = pack2(s[0][2 * ks + 1][0], s[0][2 * ks + 1][1]);
      pf0.u[3] = pack2(s[0][2 * ks + 1][2], s[0][2 * ks + 1][3]);
      pf1.u[0] = pack2(s[1][2 * ks][0], s[1][2 * ks][1]);
      pf1.u[1] = pack2(s[1][2 * ks][2], s[1][2 * ks][3]);
      pf1.u[2] = pack2(s[1][2 * ks + 1][0], s[1][2 * ks + 1][1]);
      pf1.u[3] = pack2(s[1][2 * ks + 1][2], s[1][2 * ks + 1][3]);
#pragma unroll
      for (int je = 0; je < 8; je++) {
        const bf16_t* vp = vq + je * 16 * PS + ks * 32;
        union { uint2 u[2]; bf16x8 v; } vf;
        vf.u[0] = *(const uint2*)vp;
        vf.u[1] = *(const uint2*)(vp + 16);
        o[0][je] = MFMA(pf0.v, vf.v, o[0][je]);
        o[1][je] = MFMA(pf1.v, vf.v, o[1][je]);
      }
    }
    __builtin_amdgcn_sched_barrier(0);
    __syncthreads();
  }
#undef ASTORE
#undef ALOAD
#pragma unroll
  for (int i = 0; i < 2; i++) {
    float l = i == 0 ? lrun0 : lrun1;
    l += __shfl_xor(l, 16);
    l += __shfl_xor(l, 32);
    const float inv = l > 0.f ? 1.f / l : 0.f;
#pragma unroll
    for (int r = 0; r < 4; r++) {
      const float ir = __shfl(inv, lg * 4 + r);
#pragma unroll
      for (int je = 0; je < 8; je++) o[i][je][r] *= ir;
    }
  }
  __syncthreads();
  if (grp == 1) {
#pragma unroll
    for (int i = 0; i < 2; i++)
#pragma unroll
      for (int je = 0; je < 8; je++)
#pragma unroll
        for (int r = 0; r < 4; r++) X[(wq * 32 + i * 16 + lg * 4 + r) * XS + je * 16 + lr] = o[i][je][r];
  }
  __syncthreads();
  if (grp == 0) {
    int ly = layer; asm volatile("" : "+s"(ly));
    const float li = (ly == 0) ? 0.2f : 0.35550906759f;
    const float* sg = p.in[8] + ly * 128;
#pragma unroll
    for (int i = 0; i < 2; i++) {
      float ss[4] = {0.f, 0.f, 0.f, 0.f};
#pragma unroll
      for (int je = 0; je < 8; je++)
#pragma unroll
        for (int r = 0; r < 4; r++) {
          const float v = o[i][je][r] - lam * X[(wq * 32 + i * 16 + lg * 4 + r) * XS + je * 16 + lr];
          o[i][je][r] = v; ss[r] += v * v;
        }
#pragma unroll
      for (int r = 0; r < 4; r++) {
        float s2 = ss[r];
        s2 += __shfl_xor(s2, 1); s2 += __shfl_xor(s2, 2); s2 += __shfl_xor(s2, 4); s2 += __shfl_xor(s2, 8);
        ss[r] = rsqrtf(s2 * (1.f / 128.f) + 1e-6f) * (1.f - li);
      }
#pragma unroll
      for (int je = 0; je < 8; je++) {
        const float g = sg[je * 16 + lr];
#pragma unroll
        for (int r = 0; r < 4; r++)
          ODA[(size_t)(t0 + wq * 32 + i * 16 + lg * 4 + r) * 1024 + h * 128 + je * 16 + lr] = f2bf(o[i][je][r] * ss[r] * g);
      }
    }
  }
}

DEV void ret_item(const Params& p, int h, int c, bf16_t* lds) {
  unsigned char* ws = p.ws;
  const bf16_t* RQ = (const bf16_t*)(ws + OFF_RQ);
  const bf16_t* RK = (const bf16_t*)(ws + OFF_RK);
  const bf16_t* RVT = (const bf16_t*)(ws + OFF_RVT);
  const bf16_t* STR = (const bf16_t*)(ws + OFF_STR);
  bf16_t* ORET = (bf16_t*)(ws + OFF_ORET);
  constexpr int PS = 136;
  bf16_t* Qs = lds;
  bf16_t* Ks = lds + 128 * PS;
  bf16_t* Big = lds + 2 * 128 * PS;
  float* RED = (float*)(lds + 2 * 128 * PS + 256 * PS);
  const int tid = get_tid(), lane = tid & 63, wave = tid >> 6, wm = wave >> 1, wn = wave & 1;
  const int lr = lane & 15, lg = lane >> 4;
  const int t0 = c * 128;
  const int lrow = tid >> 4, lc8 = (tid & 15) * 8;
  const float l2g = log2f(1.f - ex2(-5.f - (float)h));
#pragma unroll
  for (int i = 0; i < 4; i++) {
    const int row = lrow + i * 32;
    *(uint4*)(Qs + row * PS + lc8) = *(const uint4*)(RQ + (size_t)(t0 + row) * 512 + h * 128 + lc8);
    *(uint4*)(Ks + row * PS + lc8) = *(const uint4*)(RK + (size_t)(t0 + row) * 512 + h * 128 + lc8);
  }
#pragma unroll
  for (int i = 0; i < 8; i++) {
    const int row = lrow + i * 32;
    *(uint4*)(Big + row * PS + lc8) = *(const uint4*)(STR + ((size_t)(h * 65 + c) * 256 + row) * 128 + lc8);
  }
  __syncthreads();
  f32x4 s[2][4];
  f32x4 o[2][8];
#pragma unroll
  for (int i = 0; i < 2; i++) {
#pragma unroll
    for (int j = 0; j < 4; j++) s[i][j] = (f32x4){0.f, 0.f, 0.f, 0.f};
#pragma unroll
    for (int j = 0; j < 8; j++) o[i][j] = (f32x4){0.f, 0.f, 0.f, 0.f};
  }
#pragma unroll
  for (int ks = 0; ks < 4; ks++) {
    bf16x8 a0 = ldfrag(Qs, PS, wm * 32 + lr, ks * 32 + lg * 8);
    bf16x8 a1 = ldfrag(Qs, PS, wm * 32 + 16 + lr, ks * 32 + lg * 8);
#pragma unroll
    for (int j = 0; j < 4; j++) {
      bf16x8 bb = ldfrag(Ks, PS, wn * 64 + j * 16 + lr, ks * 32 + lg * 8);
      s[0][j] = MFMA(bb, a0, s[0][j]);
      s[1][j] = MFMA(bb, a1, s[1][j]);
    }
#pragma unroll
    for (int j = 0; j < 8; j++) {
      bf16x8 bb = ldfrag(Big, PS, wn * 128 + j * 16 + lr, ks * 32 + lg * 8);
      o[0][j] = MFMA(bb, a0, o[0][j]);
      o[1][j] = MFMA(bb, a1, o[1][j]);
    }
    __builtin_amdgcn_sched_barrier(0);
  }
#pragma unroll
  for (int i = 0; i < 2; i++) {
    const int q = wm * 32 + i * 16 + lr;
    const float qd = ex2(l2g * (float)(q + 1));
#pragma unroll
    for (int j = 0; j < 8; j++)
#pragma unroll
      for (int r = 0; r < 4; r++) o[i][j][r] *= qd;
  }
  __syncthreads();
#pragma unroll
  for (int i = 0; i < 2; i++) {
    const int q = wm * 32 + i * 16 + lr;
#pragma unroll
    for (int j = 0; j < 4; j++) {
      f32x4 v;
#pragma unroll
      for (int r = 0; r < 4; r++) {
        const int key = wn * 64 + j * 16 + lg * 4 + r;
        v[r] = (key <= q) ? s[i][j][r] * ex2(l2g * (float)(q - key)) : 0.f;
      }
      *(uint2*)(Ks + q * PS + wn * 64 + j * 16 + lg * 4) = pack4(v);
    }
  }
#pragma unroll
  for (int i = 0; i < 8; i++) {
    const int row = lrow + i * 32;
    *(uint4*)(Big + row * PS + lc8) = *(const uint4*)(RVT + (size_t)(h * 256 + row) * LT + t0 + lc8);
  }
  __syncthreads();
#pragma unroll
  for (int ks = 0; ks < 4; ks++) {
    bf16x8 a0 = ldfrag(Ks, PS, wm * 32 + lr, ks * 32 + lg * 8);
    bf16x8 a1 = ldfrag(Ks, PS, wm * 32 + 16 + lr, ks * 32 + lg * 8);
#pragma unroll
    for (int j = 0; j < 8; j++) {
      bf16x8 bb = ldfrag(Big, PS, wn * 128 + j * 16 + lr, ks * 32 + lg * 8);
      o[0][j] = MFMA(bb, a0, o[0][j]);
      o[1][j] = MFMA(bb, a1, o[1][j]);
    }
    __builtin_amdgcn_sched_barrier(0);
  }
#pragma unroll
  for (int i = 0; i < 2; i++) {
    float ss = 0.f;
#pragma unroll
    for (int j = 0; j < 8; j++)
#pragma unroll
      for (int r = 0; r < 4; r++) ss += o[i][j][r] * o[i][j][r];
    ss += __shfl_xor(ss, 16);
    ss += __shfl_xor(ss, 32);
    if (lg == 0) RED[(wm * 32 + i * 16 + lr) * 2 + wn] = ss;
  }
  __syncthreads();
#pragma unroll
  for (int i = 0; i < 2; i++) {
    const int q = wm * 32 + i * 16 + lr;
    const float rs = rsqrtf((RED[q * 2] + RED[q * 2 + 1]) * (1.f / 256.f) + 1e-6f);
#pragma unroll
    for (int j = 0; j < 8; j++) {
      f32x4 v = o[i][j];
#pragma unroll
      for (int r = 0; r < 4; r++) v[r] *= rs;
      *(uint2*)(ORET + (size_t)(t0 + q) * 1024 + h * 256 + wn * 128 + j * 16 + lg * 4) = pack4(v);
    }
  }
}

DEV void hg_item(const Params& p, int h, int c, bf16_t* lds) {
  unsigned char* ws = p.ws;
  const bf16_t* HQ = (const bf16_t*)(ws + OFF_HQ);
  const bf16_t* HK = (const bf16_t*)(ws + OFF_HK);
  const float* HCB = (const float*)(ws + OFF_HCB);
  const bf16_t* HVT = (const bf16_t*)(ws + OFF_HVT);
  const bf16_t* STH = (const bf16_t*)(ws + OFF_STH);
  bf16_t* OHG = (bf16_t*)(ws + OFF_OHG);
  constexpr int PS = 136;
  bf16_t* Qp = lds;
  bf16_t* Kp = lds + 128 * PS;
  bf16_t* As = lds + 2 * 128 * PS;
  float* RED = (float*)(lds + 2 * 128 * PS + 256 * PS);
  const int tid = get_tid(), lane = tid & 63, wave = tid >> 6, wm = wave >> 1, wn = wave & 1;
  const int lr = lane & 15, lg = lane >> 4;
  const int t0 = c * 128, colb = h * 128;
  const int lrow = tid >> 4, lc8 = (tid & 15) * 8;
#pragma unroll
  for (int i = 0; i < 4; i++) {
    const int row = lrow + i * 32;
    const size_t g = (size_t)(t0 + row) * 1024 + colb + lc8;
    uint4 qv = *(const uint4*)(HQ + g);
    float4 c0 = *(const float4*)(HCB + g), c1 = *(const float4*)(HCB + g + 4);
    float4 r0 = make_float4(0.f, 0.f, 0.f, 0.f), r1 = r0;
    if (row >= 32) {
      const size_t gr = (size_t)(t0 + (row & ~31) - 1) * 1024 + colb + lc8;
      r0 = *(const float4*)(HCB + gr); r1 = *(const float4*)(HCB + gr + 4);
    }
    uint4 ov;
    ov.x = pack2(bf2f((bf16_t)(qv.x & 0xffff)) * __expf(c0.x - r0.x), bf2f((bf16_t)(qv.x >> 16)) * __expf(c0.y - r0.y));
    ov.y = pack2(bf2f((bf16_t)(qv.y & 0xffff)) * __expf(c0.z - r0.z), bf2f((bf16_t)(qv.y >> 16)) * __expf(c0.w - r0.w));
    ov.z = pack2(bf2f((bf16_t)(qv.z & 0xffff)) * __expf(c1.x - r1.x), bf2f((bf16_t)(qv.z >> 16)) * __expf(c1.y - r1.y));
    ov.w = pack2(bf2f((bf16_t)(qv.w & 0xffff)) * __expf(c1.z - r1.z), bf2f((bf16_t)(qv.w >> 16)) * __expf(c1.w - r1.w));
    *(uint4*)(Qp + row * PS + lc8) = ov;
  }
  for (int I = 0; I < 4; I++) {
    const int nrows = 32 * (I + 1);
    float4 r0 = make_float4(0.f, 0.f, 0.f, 0.f), r1 = r0;
    if (I > 0) {
      const size_t gr = (size_t)(t0 + 32 * I - 1) * 1024 + colb + lc8;
      r0 = *(const float4*)(HCB + gr); r1 = *(const float4*)(HCB + gr + 4);
    }
#pragma unroll
    for (int i = 0; i < 4; i++) {
      const int row = lrow + i * 32;
      if (row < nrows) {
        const size_t g = (size_t)(t0 + row) * 1024 + colb + lc8;
        uint4 kv = *(const uint4*)(HK + g);
        float4 c0 = *(const float4*)(HCB + g), c1 = *(const float4*)(HCB + g + 4);
        uint4 ov;
        ov.x = pack2(bf2f((bf16_t)(kv.x & 0xffff)) * __expf(fminf(r0.x - c0.x, 80.f)), bf2f((bf16_t)(kv.x >> 16)) * __expf(fminf(r0.y - c0.y, 80.f)));
        ov.y = pack2(bf2f((bf16_t)(kv.y & 0xffff)) * __expf(fminf(r0.z - c0.z, 80.f)), bf2f((bf16_t)(kv.y >> 16)) * __expf(fminf(r0.w - c0.w, 80.f)));
        ov.z = pack2(bf2f((bf16_t)(kv.z & 0xffff)) * __expf(fminf(r1.x - c1.x, 80.f)), bf2f((bf16_t)(kv.z >> 16)) * __expf(fminf(r1.y - c1.y, 80.f)));
        ov.w = pack2(bf2f((bf16_t)(kv.w & 0xffff)) * __expf(fminf(r1.z - c1.z, 80.f)), bf2f((bf16_t)(kv.w >> 16)) * __expf(fminf(r1.w - c1.w, 80.f)));
        *(uint4*)(Kp + row * PS + lc8) = ov;
      }
    }
    __syncthreads();
    if (wave * 16 < nrows) {
      f32x4 a2[2];
      a2[0] = (f32x4){0.f, 0.f, 0.f, 0.f}; a2[1] = a2[0];
#pragma unroll
      for (int ks = 0; ks < 4; ks++) {
        bf16x8 bb = ldfrag(Kp, PS, wave * 16 + lr, ks * 32 + lg * 8);
        bf16x8 a0 = ldfrag(Qp, PS, 32 * I + lr, ks * 32 + lg * 8);
        bf16x8 a1 = ldfrag(Qp, PS, 32 * I + 16 + lr, ks * 32 + lg * 8);
        a2[0] = MFMA(bb, a0, a2[0]);
        a2[1] = MFMA(bb, a1, a2[1]);
      }
#pragma unroll
      for (int i = 0; i < 2; i++) {
        const int q = 32 * I + i * 16 + lr;
        f32x4 v;
#pragma unroll
        for (int r = 0; r < 4; r++) { const int key = wave * 16 + lg * 4 + r; v[r] = (key <= q) ? a2[i][r] : 0.f; }
        *(uint2*)(As + q * PS + wave * 16 + lg * 4) = pack4(v);
      }
    } else {
#pragma unroll
      for (int i = 0; i < 2; i++) {
        const int q = 32 * I + i * 16 + lr;
        *(uint2*)(As + q * PS + wave * 16 + lg * 4) = make_uint2(0u, 0u);
      }
    }
    __syncthreads();
  }
#pragma unroll
  for (int i = 0; i < 4; i++) {
    const int row = lrow + i * 32;
    *(uint4*)(Kp + row * PS + lc8) = *(const uint4*)(HVT + (size_t)(colb + row) * LT + t0 + lc8);
  }
  __syncthreads();
  f32x4 o[2][4];
#pragma unroll
  for (int i = 0; i < 2; i++)
#pragma unroll
    for (int j = 0; j < 4; j++) o[i][j] = (f32x4){0.f, 0.f, 0.f, 0.f};
#pragma unroll
  for (int ks = 0; ks < 4; ks++) {
    bf16x8 a0 = ldfrag(As, PS, wm * 32 + lr, ks * 32 + lg * 8);
    bf16x8 a1 = ldfrag(As, PS, wm * 32 + 16 + lr, ks * 32 + lg * 8);
#pragma unroll
    for (int j = 0; j < 4; j++) {
      bf16x8 bb = ldfrag(Kp, PS, wn * 64 + j * 16 + lr, ks * 32 + lg * 8);
      o[0][j] = MFMA(bb, a0, o[0][j]);
      o[1][j] = MFMA(bb, a1, o[1][j]);
    }
    __builtin_amdgcn_sched_barrier(0);
  }
  __syncthreads();
#pragma unroll
  for (int i = 0; i < 4; i++) {
    const int row = lrow + i * 32;
    const size_t g = (size_t)(t0 + row) * 1024 + colb + lc8;
    uint4 qv = *(const uint4*)(HQ + g);
    float4 c0 = *(const float4*)(HCB + g), c1 = *(const float4*)(HCB + g + 4);
    uint4 ov;
    ov.x = pack2(bf2f((bf16_t)(qv.x & 0xffff)) * __expf(c0.x), bf2f((bf16_t)(qv.x >> 16)) * __expf(c0.y));
    ov.y = pack2(bf2f((bf16_t)(qv.y & 0xffff)) * __expf(c0.z), bf2f((bf16_t)(qv.y >> 16)) * __expf(c0.w));
    ov.z = pack2(bf2f((bf16_t)(qv.z & 0xffff)) * __expf(c1.x), bf2f((bf16_t)(qv.z >> 16)) * __expf(c1.y));
    ov.w = pack2(bf2f((bf16_t)(qv.w & 0xffff)) * __expf(c1.z), bf2f((bf16_t)(qv.w >> 16)) * __expf(c1.w));
    *(uint4*)(Qp + row * PS + lc8) = ov;
    *(uint4*)(Kp + row * PS + lc8) = *(const uint4*)(STH + ((size_t)(h * 65 + c) * 128 + row) * 128 + lc8);
  }
  __syncthreads();
#pragma unroll
  for (int ks = 0; ks < 4; ks++) {
    bf16x8 a0 = ldfrag(Qp, PS, wm * 32 + lr, ks * 32 + lg * 8);
    bf16x8 a1 = ldfrag(Qp, PS, wm * 32 + 16 + lr, ks * 32 + lg * 8);
#pragma unroll
    for (int j = 0; j < 4; j++) {
      bf16x8 bb = ldfrag(Kp, PS, wn * 64 + j * 16 + lr, ks * 32 + lg * 8);
      o[0][j] = MFMA(bb, a0, o[0][j]);
      o[1][j] = MFMA(bb, a1, o[1][j]);
    }
    __builtin_amdgcn_sched_barrier(0);
  }
#pragma unroll
  for (int i = 0; i < 2; i++) {
    float ss = 0.f;
#pragma unroll
    for (int j = 0; j < 4; j++)
#pragma unroll
      for (int r = 0; r < 4; r++) ss += o[i][j][r] * o[i][j][r];
    ss += __shfl_xor(ss, 16);
    ss += __shfl_xor(ss, 32);
    if (lg == 0) RED[(wm * 32 + i * 16 + lr) * 2 + wn] = ss;
  }
  __syncthreads();
#pragma unroll
  for (int i = 0; i < 2; i++) {
    const int q = wm * 32 + i * 16 + lr;
    const float rs = rsqrtf((RED[q * 2] + RED[q * 2 + 1]) * (1.f / 128.f) + 1e-6f);
#pragma unroll
    for (int j = 0; j < 4; j++) {
      f32x4 v = o[i][j];
#pragma unroll
      for (int r = 0; r < 4; r++) v[r] *= rs;
      *(uint2*)(OHG + (size_t)(t0 + q) * 1024 + colb + wn * 64 + j * 16 + lg * 4) = pack4(v);
    }
  }
}

DEV void phase_O(const Params& p, int layer, int qidx, unsigned char* ldsraw) {
  bf16_t* lds = (bf16_t*)ldsraw;
  int* ctr = (int*)(p.ws + OFF_CTR) + qidx;
  int* sitem = (int*)(ldsraw + LDS_BYTES - 16);
  const float* lp = p.in[7] + layer * 256;
  float d0 = 0.f, d1 = 0.f;
  for (int i = 0; i < 64; i++) { d0 += lp[i] * lp[64 + i]; d1 += lp[128 + i] * lp[192 + i]; }
  int ly = layer; asm volatile("" : "+s"(ly));
  const float li = (ly == 0) ? 0.2f : 0.35550906759f;
  const float lam = __uint_as_float(__builtin_amdgcn_readfirstlane(__float_as_uint(__expf(d0) - __expf(d1) + li)));
  const int tid0 = get_tid();
  for (;;) {
    __syncthreads();
    if (tid0 == 0) *sitem = atomicAdd(ctr, 1);
    __syncthreads();
    const int item = __builtin_amdgcn_readfirstlane(*sitem);
    if (item >= 1300) break;
    if (item < 520) attn_item(p, layer, item & 7, 64 - (item >> 3), lam, lds);
    else if (item < 780) ret_item(p, (item - 520) & 3, (item - 520) >> 2, lds);
    else hg_item(p, (item - 780) & 7, (item - 780) >> 3, lds);
  }
}

DEV void phase_G(const Params& p, unsigned char* ldsraw) {
  unsigned char* ws = p.ws;
  bf16_t* lds = (bf16_t*)ldsraw;
  const bf16_t* HN = (const bf16_t*)(ws + OFF_HN);
  const bf16_t* WIN = (const bf16_t*)(ws + OFF_WIN);
  for (int item = vblock(); item < 33 * 20; item += gridDim.x) {
    int nt, mt; tile_map(item, 33, 4, mt, nt);
    int n0, cb; bf16_t* dst; int ld; bool gate;
    if (nt < 4) { n0 = 2048 + nt * 256; cb = nt * 256; dst = (bf16_t*)(ws + OFF_ORET); ld = 1024; gate = true; }
    else if (nt < 8) { n0 = 6144 + (nt - 4) * 256; cb = (nt - 4) * 256; dst = (bf16_t*)(ws + OFF_OHG); ld = 1024; gate = true; }
    else { n0 = 10240 + (nt - 8) * 256; cb = (nt - 8) * 256; dst = (bf16_t*)(ws + OFF_G); ld = 3072; gate = false; }
    f32x4 acc[4][8];
#pragma unroll
    for (int i = 0; i < 4; i++)
#pragma unroll
      for (int j = 0; j < 8; j++) acc[i][j] = (f32x4){0.f, 0.f, 0.f, 0.f};
    gemm256_acc(acc, HN + (size_t)mt * 256 * 1024, 1024, LT - mt * 256, WIN + (size_t)n0 * 1024, 1024, 1024, lds);
    const int tid = get_tid(), lane = tid & 63, wave = tid >> 6, wm = wave >> 1, wn = wave & 1; const int lr = lane & 15, lg = lane >> 4;
#pragma unroll
    for (int i = 0; i < 4; i++) {
      const int t = mt * 256 + wm * 64 + i * 16 + lr;
      if (t < LT) {
#pragma unroll
        for (int j = 0; j < 8; j++) {
          bf16_t* d = dst + (size_t)t * ld + cb + wn * 128 + j * 16 + lg * 4;
          f32x4 v;
          if (gate) {
            uint2 ov = *(const uint2*)d;
            v[0] = bf2f((bf16_t)(ov.x & 0xffff)) * silu_f(acc[i][j][0]);
            v[1] = bf2f((bf16_t)(ov.x >> 16)) * silu_f(acc[i][j][1]);
            v[2] = bf2f((bf16_t)(ov.y & 0xffff)) * silu_f(acc[i][j][2]);
            v[3] = bf2f((bf16_t)(ov.y >> 16)) * silu_f(acc[i][j][3]);
          } else {
#pragma unroll
            for (int r = 0; r < 4; r++) v[r] = sigmoid_f(acc[i][j][r]);
          }
          *(uint2*)d = pack4(v);
        }
      }
    }
  }
}

DEV f32x4 mini_gemm16(const bf16_t* __restrict__ A16, int lda, const bf16_t* __restrict__ Bt16, int ldb, int k0, int klen, int lane) {
  const int lr = lane & 15, lg = lane >> 4;
  const bf16_t* pa = A16 + (size_t)lr * lda + k0 + lg * 8;
  const bf16_t* pb = Bt16 + (size_t)lr * ldb + k0 + lg * 8;
  f32x4 acc = (f32x4){0.f, 0.f, 0.f, 0.f};
#pragma unroll 4
  for (int k = 0; k < klen; k += 32) {
    bf16x8 a = *(const bf16x8*)(pa + k);
    bf16x8 b = *(const bf16x8*)(pb + k);
    acc = MFMA(b, a, acc);
  }
  return acc;
}

DEV void phase_Y(const Params& p, unsigned char* ldsraw) {
  unsigned char* ws = p.ws;
  bf16_t* lds = (bf16_t*)ldsraw;
  const bf16_t* WB = (const bf16_t*)(ws + OFF_WB);
  const bf16_t* G = (const bf16_t*)(ws + OFF_G);
  bf16_t* Y = (bf16_t*)(ws + OFF_Y);
  for (int item = vblock(); item < 64 * 8 + 64; item += gridDim.x) {
    if (item >= 512) {
      const int lane = get_tid() & 63, wave = get_tid() >> 6, lr = lane & 15, lg = lane >> 4;
      const int n0 = (item - 512) * 16;
      f32x4* red = (f32x4*)ldsraw;
      __syncthreads();
#pragma unroll 1
      for (int br = 0; br < 3; br++) {
        const bf16_t* Ab = (const bf16_t*)(ws + (br == 0 ? OFF_ORET : (br == 1 ? OFF_OHG : OFF_ODA))) + (size_t)112 * 1024;
        red[(br * 8 + wave) * 64 + lane] = mini_gemm16(Ab, 1024, WB + ((size_t)br * 1024 + n0) * 1024, 1024, wave * 128, 128, lane);
      }
      __syncthreads();
      if (wave == 0) {
        f32x4 y = (f32x4){0.f, 0.f, 0.f, 0.f};
#pragma unroll
        for (int br = 0; br < 3; br++) {
          f32x4 a = red[(br * 8) * 64 + lane];
#pragma unroll
          for (int w = 1; w < 8; w++) a += red[(br * 8 + w) * 64 + lane];
          uint2 gv = *(const uint2*)(G + (size_t)(112 + lr) * 3072 + br * 1024 + n0 + lg * 4);
          y[0] += bf2f((bf16_t)(gv.x & 0xffff)) * a[0];
          y[1] += bf2f((bf16_t)(gv.x >> 16)) * a[1];
          y[2] += bf2f((bf16_t)(gv.y & 0xffff)) * a[2];
          y[3] += bf2f((bf16_t)(gv.y >> 16)) * a[3];
        }
        *(uint2*)(Y + (size_t)(112 + lr) * 1024 + n0 + lg * 4) = pack4(y);
      }
      continue;
    }
    int nt, mt; tile_map(item, 64, 4, mt, nt); mt += 1;
    f32x4 y[2][4];
#pragma unroll
    for (int i = 0; i < 2; i++)
#pragma unroll
      for (int j = 0; j < 4; j++) y[i][j] = (f32x4){0.f, 0.f, 0.f, 0.f};
#pragma unroll 1
    for (int br = 0; br < 3; br++) {
      const bf16_t* Ab = (const bf16_t*)(ws + (br == 0 ? OFF_ORET : (br == 1 ? OFF_OHG : OFF_ODA))) + (size_t)mt * 128 * 1024;
      f32x4 acc[2][4];
#pragma unroll
      for (int i = 0; i < 2; i++)
#pragma unroll
        for (int j = 0; j < 4; j++) acc[i][j] = (f32x4){0.f, 0.f, 0.f, 0.f};
      gemm_acc<128, false>(acc, Ab, 1024, WB + ((size_t)br * 1024 + nt * 128) * 1024, 1024, 1024, lds);
      const int tid = get_tid(), lane = tid & 63, wave = tid >> 6, wm = wave >> 1, wn = wave & 1; const int lr = lane & 15, lg = lane >> 4;
#pragma unroll
      for (int i = 0; i < 2; i++) {
        const int t = mt * 128 + wm * 32 + i * 16 + lr;
#pragma unroll
        for (int j = 0; j < 4; j++) {
          uint2 gv = *(const uint2*)(G + (size_t)t * 3072 + br * 1024 + nt * 128 + wn * 64 + j * 16 + lg * 4);
          y[i][j][0] += bf2f((bf16_t)(gv.x & 0xffff)) * acc[i][j][0];
          y[i][j][1] += bf2f((bf16_t)(gv.x >> 16)) * acc[i][j][1];
          y[i][j][2] += bf2f((bf16_t)(gv.y & 0xffff)) * acc[i][j][2];
          y[i][j][3] += bf2f((bf16_t)(gv.y >> 16)) * acc[i][j][3];
        }
      }
    }
    const int tid = get_tid(), lane = tid & 63, wave = tid >> 6, wm = wave >> 1, wn = wave & 1; const int lr = lane & 15, lg = lane >> 4;
#pragma unroll
    for (int i = 0; i < 2; i++) {
      const int t = mt * 128 + wm * 32 + i * 16 + lr;
#pragma unroll
      for (int j = 0; j < 4; j++)
        *(uint2*)(Y + (size_t)t * 1024 + nt * 128 + wn * 64 + j * 16 + lg * 4) = pack4(y[i][j]);
    }
  }
}

DEV void phase_resid(const Params& p, int b, const bf16_t* A, int K, const bf16_t* Wt, unsigned char* ldsraw) {
  bf16_t* lds = (bf16_t*)ldsraw;
  for (int item = vblock(); item < 64 * 8 + 64; item += gridDim.x) {
    if (item >= 512) {
      const int lane = get_tid() & 63, wave = get_tid() >> 6, lr = lane & 15, lg = lane >> 4;
      const int n0 = (item - 512) * 16;
      f32x4* red = (f32x4*)ldsraw;
      const int ks = K >> 3;
      __syncthreads();
      red[wave * 64 + lane] = mini_gemm16(A + (size_t)112 * K, K, Wt + (size_t)n0 * K, K, wave * ks, ks, lane);
      __syncthreads();
      if (wave == 0) {
        f32x4 a = red[lane];
#pragma unroll
        for (int w = 1; w < 8; w++) a += red[w * 64 + lane];
        float4* d = (float4*)(hrow(p, b, 112 + lr) + n0 + lg * 4);
        float4 v = *d;
        v.x += a[0]; v.y += a[1]; v.z += a[2]; v.w += a[3];
        *d = v;
      }
      continue;
    }
    int nt, mt; tile_map(item, 64, 4, mt, nt); mt += 1;
    f32x4 acc[2][4];
#pragma unroll
    for (int i = 0; i < 2; i++)
#pragma unroll
      for (int j = 0; j < 4; j++) acc[i][j] = (f32x4){0.f, 0.f, 0.f, 0.f};
    gemm_acc<128, false>(acc, A + (size_t)mt * 128 * K, K, Wt + (size_t)nt * 128 * K, K, K, lds);
    const int tid = get_tid(), lane = tid & 63, wave = tid >> 6, wm = wave >> 1, wn = wave & 1; const int lr = lane & 15, lg = lane >> 4;
#pragma unroll
    for (int i = 0; i < 2; i++) {
      const int t = mt * 128 + wm * 32 + i * 16 + lr;
#pragma unroll
      for (int j = 0; j < 4; j++) {
        float4* d = (float4*)(hrow(p, b, t) + nt * 128 + wn * 64 + j * 16 + lg * 4);
        float4 v = *d;
        v.x += acc[i][j][0]; v.y += acc[i][j][1]; v.z += acc[i][j][2]; v.w += acc[i][j][3];
        *d = v;
      }
    }
  }
}

DEV void phase_F1(const Params& p, unsigned char* ldsraw) {
  unsigned char* ws = p.ws;
  bf16_t* lds = (bf16_t*)ldsraw;
  const bf16_t* HN = (const bf16_t*)(ws + OFF_HN);
  const bf16_t* WFI = (const bf16_t*)(ws + OFF_WFI);
  bf16_t* U = (bf16_t*)(ws + OFF_U);
  for (int item = vblock(); item < 33 * 22; item += gridDim.x) {
    int nt, mt; tile_map(item, 33, 2, mt, nt);
    f32x4 acc[4][8];
#pragma unroll
    for (int i = 0; i < 4; i++)
#pragma unroll
      for (int j = 0; j < 8; j++) acc[i][j] = (f32x4){0.f, 0.f, 0.f, 0.f};
    gemm256_acc(acc, HN + (size_t)mt * 256 * 1024, 1024, LT - mt * 256, WFI + (size_t)nt * 256 * 1024, 1024, 1024, lds);
    const int tid = get_tid(), lane = tid & 63, wave = tid >> 6, wm = wave >> 1, wn = wave & 1; const int lr = lane & 15, lg = lane >> 4;
#pragma unroll
    for (int i = 0; i < 4; i++) {
      const int t = mt * 256 + wm * 64 + i * 16 + lr;
      if (t < LT) {
        const float vm = (t >= 112) ? 1.f : 0.f;
#pragma unroll
        for (int j = 0; j < 8; j++) {
          f32x4 v = acc[i][j];
#pragma unroll
          for (int r = 0; r < 4; r++) v[r] *= vm;
          *(uint2*)(U + (size_t)t * 5632 + nt * 256 + wn * 128 + j * 16 + lg * 4) = pack4(v);
        }
      }
    }
  }
}

DEV void unpack8(const u32x4 v, float (&f)[8]) {
#pragma unroll
  for (int k = 0; k < 4; k++) { f[2 * k] = bf2f((bf16_t)(v[k] & 0xffff)); f[2 * k + 1] = bf2f((bf16_t)(v[k] >> 16)); }
}
DEV void phase_conv(const Params& p, int layer) {
  unsigned char* ws = p.ws;
  const bf16_t* U = (const bf16_t*)(ws + OFF_U);
  bf16_t* GF = (bf16_t*)(ws + OFF_GF);
  const float* cw = p.in[11] + (size_t)layer * 3 * 5632;
  const float* cbias = p.in[12] + (size_t)layer * 5632;
  for (int idx = get_bid() * NTHR + get_tid(); idx < (LT / 8) * 352; idx += gridDim.x * NTHR) {
    const int tb = idx / 352, c8 = (idx - tb * 352) * 8;
    const int t0 = tb * 8;
    float wg[3][8], wv[3][8], bg[8], bv[8];
#pragma unroll
    for (int k = 0; k < 8; k++) {
      bg[k] = cbias[c8 + k]; bv[k] = cbias[2816 + c8 + k];
#pragma unroll
      for (int j = 0; j < 3; j++) { wg[j][k] = cw[j * 5632 + c8 + k]; wv[j][k] = cw[j * 5632 + 2816 + c8 + k]; }
    }
    float g0[8], g1[8], v0[8], v1[8];
    if (t0 >= 2) {
      unpack8(*(const u32x4*)(U + (size_t)(t0 - 2) * 5632 + c8), g0);
      unpack8(*(const u32x4*)(U + (size_t)(t0 - 2) * 5632 + 2816 + c8), v0);
      unpack8(*(const u32x4*)(U + (size_t)(t0 - 1) * 5632 + c8), g1);
      unpack8(*(const u32x4*)(U + (size_t)(t0 - 1) * 5632 + 2816 + c8), v1);
    } else {
#pragma unroll
      for (int k = 0; k < 8; k++) { g0[k] = 0.f; g1[k] = 0.f; v0[k] = 0.f; v1[k] = 0.f; }
    }
#pragma unroll
    for (int tt = 0; tt < 8; tt++) {
      float g2[8], v2[8];
      unpack8(*(const u32x4*)(U + (size_t)(t0 + tt) * 5632 + c8), g2);
      unpack8(*(const u32x4*)(U + (size_t)(t0 + tt) * 5632 + 2816 + c8), v2);
      float og[8];
#pragma unroll
      for (int k = 0; k < 8; k++) {
        const float gg = bg[k] + wg[0][k] * g0[k] + wg[1][k] * g1[k] + wg[2][k] * g2[k];
        const float vv = bv[k] + wv[0][k] * v0[k] + wv[1][k] * v1[k] + wv[2][k] * v2[k];
        og[k] = silu_f(gg) * vv;
        g0[k] = g1[k]; g1[k] = g2[k]; v0[k] = v1[k]; v1[k] = v2[k];
      }
      u32x4 o;
      o[0] = pack2(og[0], og[1]); o[1] = pack2(og[2], og[3]); o[2] = pack2(og[4], og[5]); o[3] = pack2(og[6], og[7]);
      *(u32x4*)(GF + (size_t)(t0 + tt) * 2816 + c8) = o;
    }
  }
}

__global__ void __launch_bounds__(NTHR) fwd_megakernel(Params p) {
  extern __shared__ __attribute__((aligned(16))) unsigned char lds[];
  cg::grid_group grid = cg::this_grid();
  unsigned bar_target = 0;
  unsigned* bar_word = (unsigned*)(p.ws + OFF_CTR) + 32;
#define GRID_SYNC() do { \
    asm volatile("s_waitcnt vmcnt(0) lgkmcnt(0)" ::: "memory"); \
    __syncthreads(); \
    bar_target += gridDim.x; \
    if (threadIdx.x == 0) { \
      __builtin_amdgcn_fence(__ATOMIC_RELEASE, "agent"); \
      asm volatile("s_waitcnt vmcnt(0)" ::: "memory"); \
      __hip_atomic_fetch_add(bar_word, 1u, __ATOMIC_RELAXED, __HIP_MEMORY_SCOPE_AGENT); \
      while (__hip_atomic_load(bar_word, __ATOMIC_RELAXED, __HIP_MEMORY_SCOPE_AGENT) < bar_target) __builtin_amdgcn_s_sleep(1); \
      __builtin_amdgcn_fence(__ATOMIC_ACQUIRE, "agent"); \
      asm volatile("s_waitcnt vmcnt(0)" ::: "memory"); \
    } \
    __syncthreads(); \
  } while (0)
  grid.sync();
  unsigned char* ws = p.ws;
  phase_init(p);
  phase_convert(p, 0, lds);
  GRID_SYNC();
  for (int layer = 0; layer < 2; layer++) {
    if (layer == 1) { phase_convert(p, 1, lds); GRID_SYNC(); }
    for (int b = 0; b < 2; b++) {
      phase_norm(p, b, p.in[2] + layer * 1024, (bf16_t*)(ws + OFF_HN));
      GRID_SYNC();
      phase_projA(p, layer, lds);
      GRID_SYNC();
      phase_U(p, lds);
      GRID_SYNC();
      phase_scan(p);
      GRID_SYNC();
      phase_O(p, layer, layer * 2 + b, lds);
      GRID_SYNC();
      phase_G(p, lds);
      GRID_SYNC();
      phase_Y(p, lds);
      GRID_SYNC();
      phase_resid(p, b, (const bf16_t*)(ws + OFF_Y), 1024, (const bf16_t*)(ws + OFF_WO), lds);
      GRID_SYNC();
      phase_norm(p, b, p.in[9] + layer * 1024, (bf16_t*)(ws + OFF_HN));
      GRID_SYNC();
      phase_F1(p, lds);
      GRID_SYNC();
      phase_conv(p, layer);
      GRID_SYNC();
      phase_resid(p, b, (const bf16_t*)(ws + OFF_GF), DFF, (const bf16_t*)(ws + OFF_WFO), lds);
      GRID_SYNC();
    }
  }
  phase_final(p);
}

extern "C" void kernel_launch(void* const* d_in, const int* in_sizes, int n_in, void* d_out, int out_size,
                              void* d_ws, size_t ws_size, hipStream_t stream) {
  static int grid_blocks = 0;
  if (grid_blocks == 0) {
    if (n_in != 15 || ws_size < OFF_END) {
      fprintf(stderr, "kernel_launch: need 15 inputs and %zu bytes of workspace, got %d and %zu\n", (size_t)OFF_END, n_in, ws_size);
      grid_blocks = -1; return;
    }
    int dev = 0, cus = 0, per_cu = 0;
    hipGetDevice(&dev);
    hipDeviceGetAttribute(&cus, hipDeviceAttributeMultiprocessorCount, dev);
    if (hipFuncSetAttribute((const void*)fwd_megakernel, hipFuncAttributeMaxDynamicSharedMemorySize, LDS_BYTES) != hipSuccess) {
      fprintf(stderr, "kernel_launch: hipFuncSetAttribute failed\n"); grid_blocks = -1; return;
    }
    hipOccupancyMaxActiveBlocksPerMultiprocessor(&per_cu, (const void*)fwd_megakernel, NTHR, LDS_BYTES);
    if (per_cu < 1) per_cu = 1;
    if (per_cu > 1) per_cu = 1;
    grid_blocks = cus * per_cu;
  }
  if (grid_blocks < 0) return;
  hipMemsetAsync((char*)d_ws + OFF_CTR, 0, 256, stream);
  Params p{};
  for (int i = 0; i < 15; i++) p.in[i] = (const float*)d_in[i];
  p.out = (float*)d_out;
  p.ws = (unsigned char*)d_ws;
  void* args[] = {&p};
  hipError_t e = hipLaunchCooperativeKernel((const void*)fwd_megakernel, dim3(grid_blocks), dim3(NTHR), args, LDS_BYTES, stream);
  if (e != hipSuccess) fprintf(stderr, "cooperative launch failed: %s (grid %d)\n", hipGetErrorString(e), grid_blocks);
}
```

```cpp
#include <hip/hip_runtime.h>
#include <hip/hip_cooperative_groups.h>
#include <cstdio>
#include <cstdint>
namespace cg = cooperative_groups;

typedef unsigned short bf16_t;
typedef __attribute__((ext_vector_type(8))) short bf16x8;
typedef __attribute__((ext_vector_type(4))) short bf16x4;
typedef __attribute__((ext_vector_type(4))) float f32x4;
typedef __attribute__((ext_vector_type(4))) unsigned u32x4;

#define DEV __device__ __forceinline__
#define MFMA(a, b, c) __builtin_amdgcn_mfma_f32_16x16x32_bf16(a, b, c, 0, 0, 0)

constexpr int LT = 8320;
constexpr int NCH = 65;
constexpr int NTHR = 512;
constexpr int LDS_BYTES = 144 * 1024;
constexpr int INW = 13312;
constexpr int DFF = 2816;

constexpr size_t SZ_ACT = (size_t)LT * 1024 * 2;
constexpr size_t OFF_WIN = 0;
constexpr size_t OFF_WB = OFF_WIN + (size_t)INW * 1024 * 2;
constexpr size_t OFF_WO = OFF_WB + (size_t)3 * 1024 * 1024 * 2;
constexpr size_t OFF_WFI = OFF_WO + (size_t)1024 * 1024 * 2;
constexpr size_t OFF_WFO = OFF_WFI + (size_t)5632 * 1024 * 2;
constexpr size_t OFF_H = OFF_WFO + (size_t)1024 * 2816 * 2;
constexpr size_t OFF_HN = OFF_H + (size_t)2 * 128 * 1024 * 4;
constexpr size_t OFF_R128 = OFF_HN + SZ_ACT;
constexpr size_t OFF_R64 = OFF_R128 + (size_t)LT * 64 * 8;
constexpr size_t OFF_CTR = OFF_R64 + (size_t)LT * 32 * 8;
constexpr size_t OFF_XBAR = OFF_CTR + 256;
constexpr size_t XBAR_BYTES = 3456 * 4;
constexpr size_t OFF_ARENA = OFF_XBAR + XBAR_BYTES;
constexpr size_t OFF_RQ = OFF_ARENA;
constexpr size_t OFF_RK = OFF_RQ + SZ_ACT / 2;
constexpr size_t OFF_RKT = OFF_RK + SZ_ACT / 2;
constexpr size_t OFF_RVT = OFF_RKT + SZ_ACT / 2;
constexpr size_t OFF_HQ = OFF_RVT + SZ_ACT;
constexpr size_t OFF_HK = OFF_HQ + SZ_ACT;
constexpr size_t OFF_HCB = OFF_HK + SZ_ACT;
constexpr size_t OFF_HKET = OFF_HCB + 2 * SZ_ACT;
constexpr size_t OFF_HVT = OFF_HKET + SZ_ACT;
constexpr size_t OFF_DQ = OFF_HVT + SZ_ACT;
constexpr size_t OFF_DK = OFF_DQ + SZ_ACT;
constexpr size_t OFF_DVT = OFF_DK + SZ_ACT;
constexpr size_t OFF_ORET = OFF_DVT + SZ_ACT;
constexpr size_t OFF_OHG = OFF_ORET + SZ_ACT;
constexpr size_t OFF_STR = OFF_OHG + SZ_ACT;
constexpr size_t OFF_STH = OFF_STR + SZ_ACT;
constexpr size_t OFF_HDEC = OFF_STH + SZ_ACT;
constexpr size_t OFF_END = OFF_HDEC + (size_t)65 * 1024 * 4;
constexpr size_t OFF_G = OFF_RQ;
constexpr size_t OFF_Y = OFF_HK;
constexpr size_t OFF_ODA = OFF_HKET;
constexpr size_t OFF_U = OFF_ARENA;
constexpr size_t OFF_GF = OFF_U + (size_t)LT * 5632 * 2;

struct Params {
  const float* in[15];
  float* out;
  unsigned char* ws;
};

DEV int get_tid() { int t = threadIdx.x; asm volatile("" : "+v"(t)); return t; }
DEV int get_bid() { int b = blockIdx.x; asm volatile("" : "+s"(b)); return b; }
DEV float* hrow(const Params& p, int b, int t) {
  return (t < 128) ? (float*)(p.ws + OFF_H) + (size_t)(b * 128 + t) * 1024 : p.out + ((size_t)b * 8192 + (t - 128)) * 1024;
}
typedef __bf16 hwbf16x2 __attribute__((ext_vector_type(2)));
typedef float hwf32x2 __attribute__((ext_vector_type(2)));
DEV unsigned pack2(float a, float b) {
  hwf32x2 f = {a, b};
  hwbf16x2 h = __builtin_convertvector(f, hwbf16x2);
  return __builtin_bit_cast(unsigned, h);
}
DEV bf16_t f2bf(float f) { return (bf16_t)(pack2(f, f) & 0xffffu); }
DEV float bf2f(bf16_t h) { return __uint_as_float(((unsigned)h) << 16); }
DEV uint2 pack4(f32x4 v) { uint2 r; r.x = pack2(v[0], v[1]); r.y = pack2(v[2], v[3]); return r; }
DEV float silu_f(float x) { return x / (1.f + __expf(-x)); }
DEV float sigmoid_f(float x) { return 1.f / (1.f + __expf(-x)); }
DEV float ex2(float x) { return __builtin_amdgcn_exp2f(x); }
DEV bf16x8 ldfrag(const bf16_t* base, int stride, int row, int k) {
  return *(const bf16x8*)(base + row * stride + k);
}

template <int BN, bool TRANS>
DEV void gemm_compute(f32x4 (&acc)[2][BN / 32], const bf16_t* as, const bf16_t* bs) {
  constexpr int NJ = BN / 32, LS = 72;
#pragma unroll
  for (int ks = 0; ks < 2; ks++) {
    bf16x8 a0 = *(const bf16x8*)(as + ks * 32);
    bf16x8 a1 = *(const bf16x8*)(as + 16 * LS + ks * 32);
#pragma unroll
    for (int j = 0; j < NJ; j++) {
      bf16x8 bb = *(const bf16x8*)(bs + j * 16 * LS + ks * 32);
      if (TRANS) {
        acc[0][j] = MFMA(a0, bb, acc[0][j]);
        acc[1][j] = MFMA(a1, bb, acc[1][j]);
      } else {
        acc[0][j] = MFMA(bb, a0, acc[0][j]);
        acc[1][j] = MFMA(bb, a1, acc[1][j]);
      }
    }
  }
}

template <int BN, bool TRANS>
DEV void gemm_acc(f32x4 (&acc)[2][BN / 32], const bf16_t* __restrict__ A, int lda,
                  const bf16_t* __restrict__ Bt, int ldb, int K, bf16_t* lds) {
  constexpr int LS = 72, A_SZ = 128 * LS, B_SZ = BN * LS, NB = BN / 64;
  const int tid = get_tid(), lane = tid & 63, wave = tid >> 6, wm = wave >> 1, wn = wave & 1;
  const int lr = lane & 15, lg = lane >> 4;
  bf16_t* As = lds;
  bf16_t* Bs = lds + 2 * A_SZ;
  const int crow = tid >> 3, ckc = (tid & 7) * 8;
  const bf16_t* ga = A + (size_t)crow * lda + ckc;
  const bf16_t* gb = Bt + (size_t)crow * ldb + ckc;
  u32x4 ra0, ra1, rb0, rb1, rb2, rb3;
#define GLOAD(k0)                                                        \
  ra0 = *(const u32x4*)(ga + (k0));                                      \
  ra1 = *(const u32x4*)(ga + (size_t)64 * lda + (k0));                   \
  rb0 = *(const u32x4*)(gb + (k0));                                      \
  rb1 = *(const u32x4*)(gb + (size_t)64 * ldb + (k0));                   \
  if (NB == 4) {                                                         \
    rb2 = *(const u32x4*)(gb + (size_t)128 * ldb + (k0));                \
    rb3 = *(const u32x4*)(gb + (size_t)192 * ldb + (k0));                \
  }
#define LSTORE(buf)                                                      \
  *(u32x4*)(As + (buf) * A_SZ + crow * LS + ckc) = ra0;                  \
  *(u32x4*)(As + (buf) * A_SZ + (crow + 64) * LS + ckc) = ra1;           \
  *(u32x4*)(Bs + (buf) * B_SZ + crow * LS + ckc) = rb0;                  \
  *(u32x4*)(Bs + (buf) * B_SZ + (crow + 64) * LS + ckc) = rb1;           \
  if (NB == 4) {                                                         \
    *(u32x4*)(Bs + (buf) * B_SZ + (crow + 128) * LS + ckc) = rb2;        \
    *(u32x4*)(Bs + (buf) * B_SZ + (crow + 192) * LS + ckc) = rb3;        \
  }
  const int nk = K / 64;
  const int aoff = (wm * 32 + lr) * LS + lg * 8;
  const int boff = (wn * (BN / 2) + lr) * LS + lg * 8;
  GLOAD(0)
  __syncthreads();
  LSTORE(0)
  GLOAD(64)
  __syncthreads();
  for (int kt = 0; kt < nk; kt++) {
    const int cur = kt & 1;
    LSTORE(cur ^ 1)
    {
      const int kn = (kt + 2 < nk) ? kt + 2 : nk - 1;
      GLOAD(kn * 64)
    }
    gemm_compute<BN, TRANS>(acc, As + cur * A_SZ + aoff, Bs + cur * B_SZ + boff);
    __syncthreads();
  }
#undef GLOAD
#undef LSTORE
}

DEV void gemm256_compute(f32x4 (&acc)[4][8], const bf16_t* as, const bf16_t* bs) {
  constexpr int LS = 72;
#pragma unroll
  for (int ks = 0; ks < 2; ks++) {
    bf16x8 a[4];
#pragma unroll
    for (int i = 0; i < 4; i++) a[i] = *(const bf16x8*)(as + i * 16 * LS + ks * 32);
#pragma unroll
    for (int j = 0; j < 8; j++) {
      bf16x8 bb = *(const bf16x8*)(bs + j * 16 * LS + ks * 32);
#pragma unroll
      for (int i = 0; i < 4; i++) acc[i][j] = MFMA(bb, a[i], acc[i][j]);
    }
  }
}

DEV void gemm256_acc(f32x4 (&acc)[4][8], const bf16_t* __restrict__ A, int lda, int m_valid,
                     const bf16_t* __restrict__ Bt, int ldb, int K, bf16_t* lds) {
  constexpr int LS = 72, T_SZ = 256 * LS;
  const int tid = get_tid(), lane = tid & 63, wave = tid >> 6, wm = wave >> 1, wn = wave & 1;
  const int lr = lane & 15, lg = lane >> 4;
  bf16_t* As = lds;
  bf16_t* Bs = lds + 2 * T_SZ;
  const int crow = tid >> 3, ckc = (tid & 7) * 8;
  const bf16_t* ga0 = A + (size_t)min(crow, m_valid - 1) * lda + ckc;
  const bf16_t* ga1 = A + (size_t)min(crow + 64, m_valid - 1) * lda + ckc;
  const bf16_t* ga2 = A + (size_t)min(crow + 128, m_valid - 1) * lda + ckc;
  const bf16_t* ga3 = A + (size_t)min(crow + 192, m_valid - 1) * lda + ckc;
  const bf16_t* gb = Bt + (size_t)crow * ldb + ckc;
  u32x4 ra0, ra1, ra2, ra3, rb0, rb1, rb2, rb3;
#define GLOAD(k0)                                                        \
  ra0 = *(const u32x4*)(ga0 + (k0));                                     \
  ra1 = *(const u32x4*)(ga1 + (k0));                                     \
  ra2 = *(const u32x4*)(ga2 + (k0));                                     \
  ra3 = *(const u32x4*)(ga3 + (k0));                                     \
  rb0 = *(const u32x4*)(gb + (k0));                                      \
  rb1 = *(const u32x4*)(gb + (size_t)64 * ldb + (k0));                   \
  rb2 = *(const u32x4*)(gb + (size_t)128 * ldb + (k0));                  \
  rb3 = *(const u32x4*)(gb + (size_t)192 * ldb + (k0));
#define LSTORE(buf)                                                      \
  *(u32x4*)(As + (buf) * T_SZ + crow * LS + ckc) = ra0;                  \
  *(u32x4*)(As + (buf) * T_SZ + (crow + 64) * LS + ckc) = ra1;           \
  *(u32x4*)(As + (buf) * T_SZ + (crow + 128) * LS + ckc) = ra2;          \
  *(u32x4*)(As + (buf) * T_SZ + (crow + 192) * LS + ckc) = ra3;          \
  *(u32x4*)(Bs + (buf) * T_SZ + crow * LS + ckc) = rb0;                  \
  *(u32x4*)(Bs + (buf) * T_SZ + (crow + 64) * LS + ckc) = rb1;           \
  *(u32x4*)(Bs + (buf) * T_SZ + (crow + 128) * LS + ckc) = rb2;          \
  *(u32x4*)(Bs + (buf) * T_SZ + (crow + 192) * LS + ckc) = rb3;
  const int nk = K / 64;
  const int aoff = (wm * 64 + lr) * LS + lg * 8;
  const int boff = (wn * 128 + lr) * LS + lg * 8;
  GLOAD(0)
  __syncthreads();
  LSTORE(0)
  GLOAD(64)
  __syncthreads();
  for (int kt = 0; kt < nk; kt++) {
    const int cur = kt & 1;
    LSTORE(cur ^ 1)
    {
      const int kn = (kt + 2 < nk) ? kt + 2 : nk - 1;
      GLOAD(kn * 64)
    }
    gemm256_compute(acc, As + cur * T_SZ + aoff, Bs + cur * T_SZ + boff);
    __syncthreads();
  }
#undef GLOAD
#undef LSTORE
}

DEV void tconv_tile(const float* __restrict__ src, int K, int N, bf16_t* __restrict__ dst, int tk, int tn, float* tile) {
  const int tid = get_tid();
  const int r = tid >> 4, c4 = (tid & 15) * 4;
#pragma unroll
  for (int i = 0; i < 2; i++) {
    const int rr = r + i * 32;
    float4 v = *(const float4*)(src + (size_t)(tk * 64 + rr) * N + tn * 64 + c4);
    tile[rr * 65 + c4 + 0] = v.x; tile[rr * 65 + c4 + 1] = v.y; tile[rr * 65 + c4 + 2] = v.z; tile[rr * 65 + c4 + 3] = v.w;
  }
  __syncthreads();
  const int n = tid >> 3, k8 = (tid & 7) * 8;
  uint4 o;
  o.x = pack2(tile[(k8 + 0) * 65 + n], tile[(k8 + 1) * 65 + n]);
  o.y = pack2(tile[(k8 + 2) * 65 + n], tile[(k8 + 3) * 65 + n]);
  o.z = pack2(tile[(k8 + 4) * 65 + n], tile[(k8 + 5) * 65 + n]);
  o.w = pack2(tile[(k8 + 6) * 65 + n], tile[(k8 + 7) * 65 + n]);
  *(uint4*)(dst + (size_t)(tn * 64 + n) * K + tk * 64 + k8) = o;
  __syncthreads();
}

DEV void phase_convert(const Params& p, int layer, unsigned char* lds) {
  unsigned char* ws = p.ws;
  float* tile = (float*)lds;
  for (int item = get_bid(); item < 6464; item += gridDim.x) {
    const float* src; bf16_t* dst; int K, N, idx;
    if (item < 3328) { idx = item; src = p.in[3] + (size_t)layer * 1024 * INW; K = 1024; N = INW; dst = (bf16_t*)(ws + OFF_WIN); }
    else if (item < 3328 + 768) { idx = item - 3328; int br = idx >> 8; idx &= 255; src = p.in[4] + ((size_t)layer * 3 + br) * 1024 * 1024; K = 1024; N = 1024; dst = (bf16_t*)(ws + OFF_WB) + (size_t)br * 1024 * 1024; }
    else if (item < 3328 + 1024) { idx = item - 4096; src = p.in[5] + (size_t)layer * 1024 * 1024; K = 1024; N = 1024; dst = (bf16_t*)(ws + OFF_WO); }
    else if (item < 4352 + 1408) { idx = item - 4352; src = p.in[10] + (size_t)layer * 1024 * 5632; K = 1024; N = 5632; dst = (bf16_t*)(ws + OFF_WFI); }
    else { idx = item - 5760; src = p.in[13] + (size_t)layer * 2816 * 1024; K = 2816; N = 1024; dst = (bf16_t*)(ws + OFF_WFO); }
    const int ntn = N / 64;
    tconv_tile(src, K, N, dst, idx / ntn, idx % ntn, tile);
  }
}

DEV void phase_init(const Params& p) {
  unsigned char* ws = p.ws;
  const int gt = get_bid() * NTHR + get_tid(), gs = gridDim.x * NTHR;
  for (int idx = gt; idx < 2 * LT * 256; idx += gs) {
    const int row = idx >> 8, c4 = (idx & 255) * 4;
    const int b = row / LT, t = row - b * LT;
    float4 v;
    if (t < 112) v = make_float4(0.f, 0.f, 0.f, 0.f);
    else if (t < 128) v = *(const float4*)(p.in[1] + (size_t)(t - 112) * 1024 + c4);
    else v = *(const float4*)(p.in[0] + ((size_t)b * 8192 + (t - 128)) * 1024 + c4);
    *(float4*)(hrow(p, b, t) + c4) = v;
  }
  float2* R128 = (float2*)(ws + OFF_R128);
  float2* R64 = (float2*)(ws + OFF_R64);
  for (int idx = gt; idx < LT * 96; idx += gs) {
    const int t = idx / 96, f = idx - t * 96;
    float inv;
    if (f < 64) inv = powf(10000.f, -(float)(2 * f) / 128.f);
    else inv = powf(10000.f, -(float)(2 * (f - 64)) / 64.f);
    const float ang = (float)(t - 112) * inv;
    const double ad = (double)ang;
    const double n = rint(ad * 0.15915494309189535);
    const float rr = (float)(ad - n * 6.283185307179586);
    float2 cs; cs.x = __cosf(rr); cs.y = __sinf(rr);
    if (f < 64) R128[(size_t)t * 64 + f] = cs; else R64[(size_t)t * 32 + (f - 64)] = cs;
  }
}

DEV void phase_norm(const Params& p, int b, const float* __restrict__ g, bf16_t* __restrict__ dst) {
  const int lane = get_tid() & 63, wave = get_tid() >> 6;
  for (int row = get_bid() * 8 + wave; row < LT; row += gridDim.x * 8) {
    const float* src = hrow(p, b, row);
    float4 v[4]; float ss = 0.f;
#pragma unroll
    for (int k = 0; k < 4; k++) { v[k] = *(const float4*)(src + k * 256 + lane * 4); ss += v[k].x * v[k].x + v[k].y * v[k].y + v[k].z * v[k].z + v[k].w * v[k].w; }
#pragma unroll
    for (int o = 1; o < 64; o <<= 1) ss += __shfl_xor(ss, o);
    const float rs = rsqrtf(ss * (1.f / 1024.f) + 1e-6f);
#pragma unroll
    for (int k = 0; k < 4; k++) {
      float4 gg = *(const float4*)(g + k * 256 + lane * 4);
      uint2 o; o.x = pack2(v[k].x * rs * gg.x, v[k].y * rs * gg.y); o.y = pack2(v[k].z * rs * gg.z, v[k].w * rs * gg.w);
      *(uint2*)(dst + (size_t)row * 1024 + k * 256 + lane * 4) = o;
    }
  }
}

DEV void phase_final(const Params& p) {
  const float* g = p.in[14];
  const int lane = get_tid() & 63, wave = get_tid() >> 6;
  for (int row = get_bid() * 8 + wave; row < 2 * 8192; row += gridDim.x * 8) {
    const float* src = p.out + (size_t)row * 1024;
    float4 v[4]; float ss = 0.f;
#pragma unroll
    for (int k = 0; k < 4; k++) { v[k] = *(const float4*)(src + k * 256 + lane * 4); ss += v[k].x * v[k].x + v[k].y * v[k].y + v[k].z * v[k].z + v[k].w * v[k].w; }
#pragma unroll
    for (int o = 1; o < 64; o <<= 1) ss += __shfl_xor(ss, o);
    const float rs = rsqrtf(ss * (1.f / 1024.f) + 1e-6f);
#pragma unroll
    for (int k = 0; k < 4; k++) {
      float4 gg = *(const float4*)(g + k * 256 + lane * 4);
      float4 o = make_float4(v[k].x * rs * gg.x, v[k].y * rs * gg.y, v[k].z * rs * gg.z, v[k].w * rs * gg.w);
      *(float4*)(p.out + (size_t)row * 1024 + k * 256 + lane * 4) = o;
    }
  }
}

DEV void tile_map(int it, int MT, int NG, int& mt, int& nt) {
  const int ng = it / (MT * NG), rem = it - ng * (MT * NG);
  mt = rem / NG; nt = ng * NG + (rem - mt * NG);
}
DEV int vblock() { const int b = get_bid(), G = (int)gridDim.x; return ((G & 7) == 0) ? (b & 7) * (G >> 3) + (b >> 3) : b; }

DEV void phase_projA(const Params& p, int layer, unsigned char* ldsraw) {
  unsigned char* ws = p.ws;
  bf16_t* lds = (bf16_t*)ldsraw;
  const bf16_t* HN = (const bf16_t*)(ws + OFF_HN);
  const bf16_t* WIN = (const bf16_t*)(ws + OFF_WIN);
  const float2* R128 = (const float2*)(ws + OFF_R128);
  const float2* R64 = (const float2*)(ws + OFF_R64);
  for (int item = vblock(); item < 65 * 32; item += gridDim.x) {
    int nt, mt; tile_map(item, 65, 4, mt, nt);
    int n0, seg, segstart;
    if (nt < 8) { n0 = nt * 256; seg = nt < 2 ? 0 : (nt < 4 ? 1 : 2); segstart = seg == 0 ? 0 : (seg == 1 ? 512 : 1024); }
    else if (nt < 20) { n0 = 3072 + (nt - 8) * 256; seg = 3 + (nt - 8) / 4; segstart = 3072 + (seg - 3) * 1024; }
    else { n0 = 7168 + (nt - 20) * 256; seg = 6 + (nt - 20) / 4; segstart = 7168 + (seg - 6) * 1024; }
    const bf16_t* A = HN + (size_t)mt * 128 * 1024;
    const bf16_t* Bt = WIN + (size_t)n0 * 1024;
    f32x4 acc[2][8];
#pragma unroll
    for (int i = 0; i < 2; i++)
#pragma unroll
      for (int j = 0; j < 8; j++) acc[i][j] = (f32x4){0.f, 0.f, 0.f, 0.f};
    if (seg == 0 || seg == 3 || seg == 6 || seg == 7) {
      gemm_acc<256, false>(acc, A, 1024, Bt, 1024, 1024, lds);
      const int tid = get_tid(), lane = tid & 63, wave = tid >> 6, wm = wave >> 1, wn = wave & 1; const int lr = lane & 15, lg = lane >> 4; (void)tid; (void)lane; (void)wm; (void)wn; (void)lr; (void)lg;
      const int cw = (n0 - segstart) + wn * 128;
      bf16_t* dstb; int ld;
      if (seg == 0) { dstb = (bf16_t*)(ws + OFF_RQ); ld = 512; }
      else if (seg == 3) { dstb = (bf16_t*)(ws + OFF_HQ); ld = 1024; }
      else if (seg == 6) { dstb = (bf16_t*)(ws + OFF_DQ); ld = 1024; }
      else { dstb = (bf16_t*)(ws + OFF_DK); ld = 1024; }
#pragma unroll
      for (int i = 0; i < 2; i++) {
        const int t = mt * 128 + wm * 32 + i * 16 + lr;
        if (seg == 0) {
          const float2* tab = R128 + (size_t)t * 64;
#pragma unroll
          for (int j = 0; j < 4; j++)
#pragma unroll
            for (int r = 0; r < 4; r++) {
              float2 cs = tab[j * 16 + lg * 4 + r];
              float x1 = acc[i][j][r], x2 = acc[i][j + 4][r];
              acc[i][j][r] = x1 * cs.x - x2 * cs.y;
              acc[i][j + 4][r] = x2 * cs.x + x1 * cs.y;
            }
        } else if (seg == 6 || seg == 7) {
          const float2* tab = R64 + (size_t)t * 32;
          const float sc = (seg == 6) ? (0.125f * 1.4426950408889634f) : 1.f;
#pragma unroll
          for (int jq = 0; jq < 4; jq++) {
            const int j = (jq & 1) + (jq >> 1) * 4;
#pragma unroll
            for (int r = 0; r < 4; r++) {
              float2 cs = tab[(jq & 1) * 16 + lg * 4 + r];
              float x1 = acc[i][j][r], x2 = acc[i][j + 2][r];
              acc[i][j][r] = (x1 * cs.x - x2 * cs.y) * sc;
              acc[i][j + 2][r] = (x2 * cs.x + x1 * cs.y) * sc;
            }
          }
        }
        bf16_t* dst = dstb + (size_t)t * ld + cw;
#pragma unroll
        for (int j = 0; j < 8; j++) *(uint2*)(dst + j * 16 + lg * 4) = pack4(acc[i][j]);
      }
    } else {
      gemm_acc<256, true>(acc, A, 1024, Bt, 1024, 1024, lds);
      const int tid = get_tid(), lane = tid & 63, wave = tid >> 6, wm = wave >> 1, wn = wave & 1; const int lr = lane & 15, lg = lane >> 4; (void)tid; (void)lane; (void)wm; (void)wn; (void)lr; (void)lg;
      const int cw = (n0 - segstart) + wn * 128;
      if (seg == 1) {
        bf16_t* RK = (bf16_t*)(ws + OFF_RK);
        bf16_t* RKT = (bf16_t*)(ws + OFF_RKT);
        const int h = cw >> 7;
        const float l2g = log2f(1.f - ex2(-5.f - (float)h));
#pragma unroll
        for (int i = 0; i < 2; i++) {
          const int mb = wm * 32 + i * 16 + lg * 4;
#pragma unroll
          for (int j = 0; j < 4; j++)
#pragma unroll
            for (int r = 0; r < 4; r++) {
              const int t = mt * 128 + mb + r;
              float2 cs = R128[(size_t)t * 64 + j * 16 + lr];
              const float sc = (t >= 112) ? 0.08838834764831845f : 0.f;
              float x1 = acc[i][j][r], x2 = acc[i][j + 4][r];
              acc[i][j][r] = (x1 * cs.x - x2 * cs.y) * sc;
              acc[i][j + 4][r] = (x2 * cs.x + x1 * cs.y) * sc;
            }
#pragma unroll
          for (int j = 0; j < 8; j++) {
            const int col = cw + j * 16 + lr;
            f32x4 kd;
#pragma unroll
            for (int r = 0; r < 4; r++) {
              const int t = mt * 128 + mb + r;
              RK[(size_t)t * 512 + col] = f2bf(acc[i][j][r]);
              kd[r] = acc[i][j][r] * ex2(l2g * (float)(127 - (mb + r)));
            }
            *(uint2*)(RKT + (size_t)col * LT + mt * 128 + mb) = pack4(kd);
          }
        }
      } else if (seg == 2 || seg == 5 || seg == 8) {
        bf16_t* dT = (bf16_t*)(ws + (seg == 2 ? OFF_RVT : (seg == 5 ? OFF_HVT : OFF_DVT)));
#pragma unroll
        for (int i = 0; i < 2; i++) {
          const int mb = wm * 32 + i * 16 + lg * 4;
#pragma unroll
          for (int j = 0; j < 8; j++) {
            const int col = cw + j * 16 + lr;
            f32x4 v = acc[i][j];
            if (seg == 5) {
#pragma unroll
              for (int r = 0; r < 4; r++) if (mt * 128 + mb + r < 112) v[r] = 0.f;
            }
            *(uint2*)(dT + (size_t)col * LT + mt * 128 + mb) = pack4(v);
          }
        }
      } else {
        float* Lf = (float*)ldsraw;
        float* HCB = (float*)(ws + OFF_HCB);
        bf16_t* HK = (bf16_t*)(ws + OFF_HK);
        bf16_t* HKET = (bf16_t*)(ws + OFF_HKET);
        float* HDEC = (float*)(ws + OFF_HDEC);
        const float* lbp = p.in[6];
#pragma unroll
        for (int j = 0; j < 8; j++) {
          const int col = cw + j * 16 + lr;
          float lb = 0.f;
          if (layer == 1) lb = 1.f / (1.f + __expf(lbp[col] - lbp[1024 + col]));
#pragma unroll
          for (int i = 0; i < 2; i++)
#pragma unroll
            for (int r = 0; r < 4; r++) {
              const int m = wm * 32 + i * 16 + lg * 4 + r;
              const float z = acc[i][j][r];
              const float kk = (1.f - lb) / (1.f + __expf(z));
              const float lf = fmaxf(log1pf(-kk), -69.0776f);
              acc[i][j][r] = kk;
              Lf[m * 260 + wn * 128 + j * 16 + lr] = lf;
            }
        }
        __syncthreads();
        {
          const int colL = tid & 255, half = tid >> 8;
          float run = 0.f;
          for (int rr = 0; rr < 64; rr++) {
            float* q = &Lf[(half * 64 + rr) * 260 + colL];
            run += *q; *q = run;
          }
        }
        __syncthreads();
#pragma unroll
        for (int j = 0; j < 8; j++) {
          const int colL = wn * 128 + j * 16 + lr;
          const int col = cw + j * 16 + lr;
          const float ft = Lf[63 * 260 + colL];
          const float cend = Lf[127 * 260 + colL] + ft;
#pragma unroll
          for (int i = 0; i < 2; i++) {
            const int mb = wm * 32 + i * 16 + lg * 4;
            f32x4 ke;
#pragma unroll
            for (int r = 0; r < 4; r++) {
              const int m = mb + r;
              const int t = mt * 128 + m;
              const float cb = Lf[m * 260 + colL] + (m >= 64 ? ft : 0.f);
              HCB[(size_t)t * 1024 + col] = cb;
              HK[(size_t)t * 1024 + col] = f2bf(acc[i][j][r]);
              ke[r] = acc[i][j][r] * __expf(cend - cb);
              if (m == 127) HDEC[mt * 1024 + col] = __expf(cend);
            }
            *(uint2*)(HKET + (size_t)col * LT + mt * 128 + mb) = pack4(ke);
          }
        }
        __syncthreads();
      }
    }
  }
}

DEV void phase_U(const Params& p, unsigned char* ldsraw) {
  unsigned char* ws = p.ws;
  bf16_t* lds = (bf16_t*)ldsraw;
  for (int item = get_bid(); item < 1040; item += gridDim.x) {
    const bf16_t *A, *Bt; bf16_t* dst;
    if (item < 520) {
      const int h = item & 3, rest = item >> 2, mh = rest & 1, c = rest >> 1;
      A = (const bf16_t*)(ws + OFF_RVT) + (size_t)(h * 256 + mh * 128) * LT + c * 128;
      Bt = (const bf16_t*)(ws + OFF_RKT) + (size_t)(h * 128) * LT + c * 128;
      dst = (bf16_t*)(ws + OFF_STR) + ((size_t)(h * 65 + c) * 256 + mh * 128) * 128;
    } else {
      const int it = item - 520, h = it & 7, c = it >> 3;
      A = (const bf16_t*)(ws + OFF_HVT) + (size_t)(h * 128) * LT + c * 128;
      Bt = (const bf16_t*)(ws + OFF_HKET) + (size_t)(h * 128) * LT + c * 128;
      dst = (bf16_t*)(ws + OFF_STH) + ((size_t)(h * 65 + c) * 128) * 128;
    }
    f32x4 acc[2][4];
#pragma unroll
    for (int i = 0; i < 2; i++)
#pragma unroll
      for (int j = 0; j < 4; j++) acc[i][j] = (f32x4){0.f, 0.f, 0.f, 0.f};
    gemm_acc<128, false>(acc, A, LT, Bt, LT, 128, lds);
      const int tid = get_tid(), lane = tid & 63, wave = tid >> 6, wm = wave >> 1, wn = wave & 1; const int lr = lane & 15, lg = lane >> 4; (void)tid; (void)lane; (void)wm; (void)wn; (void)lr; (void)lg;
#pragma unroll
    for (int i = 0; i < 2; i++)
#pragma unroll
      for (int j = 0; j < 4; j++)
        *(uint2*)(dst + (size_t)(wm * 32 + i * 16 + lr) * 128 + wn * 64 + j * 16 + lg * 4) = pack4(acc[i][j]);
  }
}

DEV void phase_scan(const Params& p) {
  unsigned char* ws = p.ws;
  const float* HDEC = (const float*)(ws + OFF_HDEC);
  for (int task = get_bid() * NTHR + get_tid(); task < 65536; task += gridDim.x * NTHR) {
    bf16_t* base; size_t stride; int h, d4; bool hg;
    float dec0 = 0.f;
    if (task < 32768) {
      const int v = task; d4 = (v & 31) * 4; const int e = (v >> 5) & 255; h = v >> 13; hg = false;
      base = (bf16_t*)(ws + OFF_STR) + ((size_t)(h * 65) * 256 + e) * 128 + d4; stride = 256 * 128;
      dec0 = ex2(128.f * log2f(1.f - ex2(-5.f - (float)h)));
    } else {
      const int v = task - 32768; d4 = (v & 31) * 4; const int e = (v >> 5) & 127; h = v >> 12; hg = true;
      base = (bf16_t*)(ws + OFF_STH) + ((size_t)(h * 65) * 128 + e) * 128 + d4; stride = 128 * 128;
    }
    float c0 = 0.f, c1 = 0.f, c2 = 0.f, c3 = 0.f;
    for (int cg0 = 0; cg0 < 65; cg0 += 13) {
      uint2 u[13]; float4 dc[13];
#pragma unroll
      for (int k = 0; k < 13; k++) {
        u[k] = *(const uint2*)(base + (size_t)(cg0 + k) * stride);
        if (hg) dc[k] = *(const float4*)(HDEC + (size_t)(cg0 + k) * 1024 + h * 128 + d4);
        else dc[k] = make_float4(dec0, dec0, dec0, dec0);
      }
#pragma unroll
      for (int k = 0; k < 13; k++) {
        uint2 o; o.x = pack2(c0, c1); o.y = pack2(c2, c3);
        *(uint2*)(base + (size_t)(cg0 + k) * stride) = o;
        c0 = dc[k].x * c0 + bf2f((bf16_t)(u[k].x & 0xffff));
        c1 = dc[k].y * c1 + bf2f((bf16_t)(u[k].x >> 16));
        c2 = dc[k].z * c2 + bf2f((bf16_t)(u[k].y & 0xffff));
        c3 = dc[k].w * c3 + bf2f((bf16_t)(u[k].y >> 16));
      }
    }
  }
}

DEV void attn_item(const Params& p, int layer, int h, int qb, float lam, bf16_t* lds) {
  unsigned char* ws = p.ws;
  const bf16_t* DQ = (const bf16_t*)(ws + OFF_DQ);
  bf16_t* ODA = (bf16_t*)(ws + OFF_ODA);
  const bf16_t* DK = (const bf16_t*)(ws + OFF_DK);
  const bf16_t* DVT = (const bf16_t*)(ws + OFF_DVT);
  constexpr int PS = 136, XS = 132;
  constexpr int TS = 128 * PS;
  bf16_t* KV = lds;
  float* X = (float*)lds;
  const int tid = get_tid(), lane = tid & 63, wave = tid >> 6;
  const int lr = lane & 15, lg = lane >> 4;
  const int grp = wave >> 2, wq = wave & 3;
  const int t0 = qb * 128;
  const int lrow = tid >> 4, lc8 = (tid & 15) * 8;
  const bf16_t* gq = DQ + (size_t)(t0 + wq * 32 + lr) * 1024 + h * 128 + grp * 64 + lg * 8;
  const bf16x8 a00 = *(const bf16x8*)(gq);
  const bf16x8 a01 = *(const bf16x8*)(gq + 32);
  const bf16x8 a10 = *(const bf16x8*)(gq + (size_t)16 * 1024);
  const bf16x8 a11 = *(const bf16x8*)(gq + (size_t)16 * 1024 + 32);
  f32x4 o[2][8];
#pragma unroll
  for (int i = 0; i < 2; i++)
#pragma unroll
    for (int j = 0; j < 8; j++) o[i][j] = (f32x4){0.f, 0.f, 0.f, 0.f};
  float mrun0 = -1e30f, mrun1 = -1e30f, lrun0 = 0.f, lrun1 = 0.f;
  u32x4 rk0, rk1, rk2, rk3, rv0, rv1, rv2, rv3;
  const unsigned ko = (unsigned)(lrow * 1024 + h * 128 + lc8);
  const unsigned vo = (unsigned)((h * 128 + lrow) * LT + lc8);
#define ALOAD(kbn)                                                              \
  rk0 = *(const u32x4*)(DK + (ko + (unsigned)(kbn) * 131072u));                 \
  rk1 = *(const u32x4*)(DK + (ko + (unsigned)(kbn) * 131072u + 32768u));        \
  rk2 = *(const u32x4*)(DK + (ko + (unsigned)(kbn) * 131072u + 65536u));        \
  rk3 = *(const u32x4*)(DK + (ko + (unsigned)(kbn) * 131072u + 98304u));        \
  rv0 = *(const u32x4*)(DVT + (vo + (unsigned)(kbn) * 128u));                   \
  rv1 = *(const u32x4*)(DVT + (vo + (unsigned)(kbn) * 128u + 32u * LT));        \
  rv2 = *(const u32x4*)(DVT + (vo + (unsigned)(kbn) * 128u + 64u * LT));        \
  rv3 = *(const u32x4*)(DVT + (vo + (unsigned)(kbn) * 128u + 96u * LT));
#define ASTORE(sp)                                                              \
  *(u32x4*)((sp)) = rk0;                                                        \
  *(u32x4*)((sp) + 32 * PS) = rk1;                                              \
  *(u32x4*)((sp) + 64 * PS) = rk2;                                              \
  *(u32x4*)((sp) + 96 * PS) = rk3;                                              \
  *(u32x4*)((sp) + 2 * TS) = rv0;                                               \
  *(u32x4*)((sp) + 2 * TS + 32 * PS) = rv1;                                     \
  *(u32x4*)((sp) + 2 * TS + 64 * PS) = rv2;                                     \
  *(u32x4*)((sp) + 2 * TS + 96 * PS) = rv3;
  ALOAD(0)
  const int qrow0 = t0 + wq * 32 + lr;
  __syncthreads();
  ASTORE(KV + lrow * PS + lc8)
  {
    const int kb1 = qb > 0 ? 1 : 0;
    ALOAD(kb1)
  }
  __syncthreads();
  for (int kb = 0; kb <= qb; kb++) {
    const int cur = kb & 1;
    const bf16_t* kp = KV + cur * TS + lr * PS + grp * 64 + lg * 8;
    const bf16_t* vq = KV + 2 * TS + cur * TS + lr * PS + lg * 4;
    {
      bf16_t* sp = KV + (cur ^ 1) * TS + lrow * PS + lc8;
      ASTORE(sp)
    }
    __builtin_amdgcn_sched_barrier(0);
    f32x4 s[2][8];
    {
#pragma unroll
      for (int j = 0; j < 8; j++) {
        const bf16x8 kf0 = *(const bf16x8*)(kp + j * 16 * PS);
        const bf16x8 kf1 = *(const bf16x8*)(kp + j * 16 * PS + 32);
        s[0][j] = MFMA(kf0, a00, ((f32x4){0.f, 0.f, 0.f, 0.f}));
        s[1][j] = MFMA(kf0, a10, ((f32x4){0.f, 0.f, 0.f, 0.f}));
        s[0][j] = MFMA(kf1, a01, s[0][j]);
        s[1][j] = MFMA(kf1, a11, s[1][j]);
      }
    }
    __builtin_amdgcn_sched_barrier(0);
    {
      const int kbn = (kb + 2 <= qb) ? kb + 2 : qb;
      ALOAD(kbn)
    }
    __builtin_amdgcn_sched_barrier(0);
    if (kb == qb || kb == 0) {
#pragma unroll
      for (int i = 0; i < 2; i++)
#pragma unroll
        for (int j = 0; j < 8; j++)
#pragma unroll
          for (int r = 0; r < 4; r++) {
            const int key = kb * 128 + j * 16 + lg * 4 + r;
            if (key > qrow0 + 16 * i || key < 112) s[i][j][r] = -1e30f;
          }
    }
    float al[2];
#pragma unroll
    for (int i = 0; i < 2; i++) {
      float mx = -1e30f;
#pragma unroll
      for (int j = 0; j < 8; j++)
#pragma unroll
        for (int r = 0; r < 4; r++) mx = fmaxf(mx, s[i][j][r]);
      mx = fmaxf(mx, __shfl_xor(mx, 16));
      mx = fmaxf(mx, __shfl_xor(mx, 32));
      const float mold = i == 0 ? mrun0 : mrun1;
      const float mnew = fmaxf(mold, mx);
      al[i] = ex2(mold - mnew);
      float ps = 0.f;
#pragma unroll
      for (int j = 0; j < 8; j++)
#pragma unroll
        for (int r = 0; r < 4; r++) { const float pv = ex2(s[i][j][r] - mnew); s[i][j][r] = pv; ps += pv; }
      if (i == 0) { mrun0 = mnew; lrun0 = lrun0 * al[0] + ps; } else { mrun1 = mnew; lrun1 = lrun1 * al[1] + ps; }
    }
    if (__builtin_amdgcn_ballot_w64(al[0] != 1.f || al[1] != 1.f) != 0ull) {
#pragma unroll
      for (int i = 0; i < 2; i++) {
        float ao[4];
#pragma unroll
        for (int r = 0; r < 4; r++) ao[r] = __shfl(al[i], lg * 4 + r);
#pragma unroll
        for (int je = 0; je < 8; je++)
#pragma unroll
          for (int r = 0; r < 4; r++) o[i][je][r] *= ao[r];
      }
    }
#pragma unroll
    for (int ks = 0; ks < 4; ks++) {
      union { u32x4 u; bf16x8 v; } pf0, pf1;
      pf0.u[0] = pack2(s[0][2 * ks][0], s[0][2 * ks][1]);
      pf0.u[1] = pack2(s[0][2 * ks][2], s[0][2 * ks][3]);
      pf0.u[2] = pack2(s[0][2 * ks + 1][0], s[0][2 * ks + 1][1]);
      pf0.u[3] = pack2(s[0][2 * ks + 1][2], s[0][2 * ks + 1][3]);
      pf1.u[0] = pack2(s[1][2 * ks][0], s[1][2 * ks][1]);
      pf1.u[1] = pack2(s[1][2 * ks][2], s[1][2 * ks][3]);
      pf1.u[2] = pack2(s[1][2 * ks + 1][0], s[1][2 * ks + 1][1]);
      pf1.u[3] = pack2(s[1][2 * ks + 1][2], s[1][2 * ks + 1][3]);
#pragma unroll
      for (int je = 0; je < 8; je++) {
        const bf16_t* vp = vq + je * 16 * PS + ks * 32;
        union { uint2 u[2]; bf16x8 v; } vf;
        vf.u[0] = *(const uint2*)vp;
        vf.u[1] = *(const uint2*)(vp + 16);
        o[0][je] = MFMA(pf0.v, vf.v, o[0][je]);
        o[1][je] = MFMA(pf1.v, vf.v, o[1][je]);
      }
    }
    __builtin_amdgcn_sched_barrier(0);
    __syncthreads();
  }
#undef ASTORE
#undef ALOAD
#pragma unroll
  for (int i = 0; i < 2; i++) {
    float l = i == 0 ? lrun0 : lrun1;
    l += __shfl_xor(l, 16);
    l += __shfl_xor(l, 32);
    const float inv = l > 0.f ? 1.f / l : 0.f;
#pragma unroll
    for (int r = 0; r < 4; r++) {
      const float ir = __shfl(inv, lg * 4 + r);
#pragma unroll
      for (int je = 0; je < 8; je++) o[i][je][r] *= ir;
    }
  }
  __syncthreads();
  if (grp == 1) {
#pragma unroll
    for (int i = 0; i < 2; i++)
#pragma unroll
      for (int je = 0; je < 8; je++)
#pragma unroll
        for (int r = 0; r < 4; r++) X[(wq * 32 + i * 16 + lg * 4 + r) * XS + je * 16 + lr] = o[i][je][r];
  }
  __syncthreads();
  if (grp == 0) {
    int ly = layer; asm volatile("" : "+s"(ly));
    const float li = (ly == 0) ? 0.2f : 0.35550906759f;
    const float* sg = p.in[8] + ly * 128;
#pragma unroll
    for (int i = 0; i < 2; i++) {
      float ss[4] = {0.f, 0.f, 0.f, 0.f};
#pragma unroll
      for (int je = 0; je < 8; je++)
#pragma unroll
        for (int r = 0; r < 4; r++) {
          const float v = o[i][je][r] - lam * X[(wq * 32 + i * 16 + lg * 4 + r) * XS + je * 16 + lr];
          o[i][je][r] = v; ss[r] += v * v;
        }
#pragma unroll
      for (int r = 0; r < 4; r++) {
        float s2 = ss[r];
        s2 += __shfl_xor(s2, 1); s2 += __shfl_xor(s2, 2); s2 += __shfl_xor(s2, 4); s2 += __shfl_xor(s2, 8);
        ss[r] = rsqrtf(s2 * (1.f / 128.f) + 1e-6f) * (1.f - li);
      }
#pragma unroll
      for (int je = 0; je < 8; je++) {
        const float g = sg[je * 16 + lr];
#pragma unroll
        for (int r = 0; r < 4; r++)
          ODA[(size_t)(t0 + wq * 32 + i * 16 + lg * 4 + r) * 1024 + h * 128 + je * 16 + lr] = f2bf(o[i][je][r] * ss[r] * g);
      }
    }
  }
}

DEV void ret_item(const Params& p, int h, int c, bf16_t* lds) {
  unsigned char* ws = p.ws;
  const bf16_t* RQ = (const bf16_t*)(ws + OFF_RQ);
  const bf16_t* RK = (const bf16_t*)(ws + OFF_RK);
  const bf16_t* RVT = (const bf16_t*)(ws + OFF_RVT);
  const bf16_t* STR = (const bf16_t*)(ws + OFF_STR);
  bf16_t* ORET = (bf16_t*)(ws + OFF_ORET);
  constexpr int PS = 136;
  bf16_t* Qs = lds;
  bf16_t* Ks = lds + 128 * PS;
  bf16_t* Big = lds + 2 * 128 * PS;
  float* RED = (float*)(lds + 2 * 128 * PS + 256 * PS);
  const int tid = get_tid(), lane = tid & 63, wave = tid >> 6, wm = wave >> 1, wn = wave & 1;
  const int lr = lane & 15, lg = lane >> 4;
  const int t0 = c * 128;
  const int lrow = tid >> 4, lc8 = (tid & 15) * 8;
  const float l2g = log2f(1.f - ex2(-5.f - (float)h));
#pragma unroll
  for (int i = 0; i < 4; i++) {
    const int row = lrow + i * 32;
    *(uint4*)(Qs + row * PS + lc8) = *(const uint4*)(RQ + (size_t)(t0 + row) * 512 + h * 128 + lc8);
    *(uint4*)(Ks + row * PS + lc8) = *(const uint4*)(RK + (size_t)(t0 + row) * 512 + h * 128 + lc8);
  }
#pragma unroll
  for (int i = 0; i < 8; i++) {
    const int row = lrow + i * 32;
    *(uint4*)(Big + row * PS + lc8) = *(const uint4*)(STR + ((size_t)(h * 65 + c) * 256 + row) * 128 + lc8);
  }
  __syncthreads();
  f32x4 s[2][4];
  f32x4 o[2][8];
#pragma unroll
  for (int i = 0; i < 2; i++) {
#pragma unroll
    for (int j = 0; j < 4; j++) s[i][j] = (f32x4){0.f, 0.f, 0.f, 0.f};
#pragma unroll
    for (int j = 0; j < 8; j++) o[i][j] = (f32x4){0.f, 0.f, 0.f, 0.f};
  }
#pragma unroll
  for (int ks = 0; ks < 4; ks++) {
    bf16x8 a0 = ldfrag(Qs, PS, wm * 32 + lr, ks * 32 + lg * 8);
    bf16x8 a1 = ldfrag(Qs, PS, wm * 32 + 16 + lr, ks * 32 + lg * 8);
#pragma unroll
    for (int j = 0; j < 4; j++) {
      bf16x8 bb = ldfrag(Ks, PS, wn * 64 + j * 16 + lr, ks * 32 + lg * 8);
      s[0][j] = MFMA(bb, a0, s[0][j]);
      s[1][j] = MFMA(bb, a1, s[1][j]);
    }
#pragma unroll
    for (int j = 0; j < 8; j++) {
      bf16x8 bb = ldfrag(Big, PS, wn * 128 + j * 16 + lr, ks * 32 + lg * 8);
      o[0][j] = MFMA(bb, a0, o[0][j]);
      o[1][j] = MFMA(bb, a1, o[1][j]);
    }
    __builtin_amdgcn_sched_barrier(0);
  }
#pragma unroll
  for (int i = 0; i < 2; i++) {
    const int q = wm * 32 + i * 16 + lr;
    const float qd = ex2(l2g * (float)(q + 1));
#pragma unroll
    for (int j = 0; j < 8; j++)
#pragma unroll
      for (int r = 0; r < 4; r++) o[i][j][r] *= qd;
  }
  __syncthreads();
#pragma unroll
  for (int i = 0; i < 2; i++) {
    const int q = wm * 32 + i * 16 + lr;
#pragma unroll
    for (int j = 0; j < 4; j++) {
      f32x4 v;
#pragma unroll
      for (int r = 0; r < 4; r++) {
        const int key = wn * 64 + j * 16 + lg * 4 + r;
        v[r] = (key <= q) ? s[i][j][r] * ex2(l2g * (float)(q - key)) : 0.f;
      }
      *(uint2*)(Ks + q * PS + wn * 64 + j * 16 + lg * 4) = pack4(v);
    }
  }
#pragma unroll
  for (int i = 0; i < 8; i++) {
    const int row = lrow + i * 32;
    *(uint4*)(Big + row * PS + lc8) = *(const uint4*)(RVT + (size_t)(h * 256 + row) * LT + t0 + lc8);
  }
  __syncthreads();
#pragma unroll
  for (int ks = 0; ks < 4; ks++) {
    bf16x8 a0 = ldfrag(Ks, PS, wm * 32 + lr, ks * 32 + lg * 8);
    bf16x8 a1 = ldfrag(Ks, PS, wm * 32 + 16 + lr, ks * 32 + lg * 8);
#pragma unroll
    for (int j = 0; j < 8; j++) {
      bf16x8 bb = ldfrag(Big, PS, wn * 128 + j * 16 + lr, ks * 32 + lg * 8);
      o[0][j] = MFMA(bb, a0, o[0][j]);
      o[1][j] = MFMA(bb, a1, o[1][j]);
    }
    __builtin_amdgcn_sched_barrier(0);
  }
#pragma unroll
  for (int i = 0; i < 2; i++) {
    float ss = 0.f;
#pragma unroll
    for (int j = 0; j < 8; j++)
#pragma unroll
      for (int r = 0; r < 4; r++) ss += o[i][j][r] * o[i][j][r];
    ss += __shfl_xor(ss, 16);
    ss += __shfl_xor(ss, 32);
    if (lg == 0) RED[(wm * 32 + i * 16 + lr) * 2 + wn] = ss;
  }
  __syncthreads();
#pragma unroll
  for (int i = 0; i < 2; i++) {
    const int q = wm * 32 + i * 16 + lr;
    const float rs = rsqrtf((RED[q * 2] + RED[q * 2 + 1]) * (1.f / 256.f) + 1e-6f);
#pragma unroll
    for (int j = 0; j < 8; j++) {
      f32x4 v = o[i][j];
#pragma unroll
      for (int r = 0; r < 4; r++) v[r] *= rs;
      *(uint2*)(ORET + (size_t)(t0 + q) * 1024 + h * 256 + wn * 128 + j * 16 + lg * 4) = pack4(v);
    }
  }
}

DEV void hg_item(const Params& p, int h, int c, bf16_t* lds) {
  unsigned char* ws = p.ws;
  const bf16_t* HQ = (const bf16_t*)(ws + OFF_HQ);
  const bf16_t* HK = (const bf16_t*)(ws + OFF_HK);
  const float* HCB = (const float*)(ws + OFF_HCB);
  const bf16_t* HVT = (const bf16_t*)(ws + OFF_HVT);
  const bf16_t* STH = (const bf16_t*)(ws + OFF_STH);
  bf16_t* OHG = (bf16_t*)(ws + OFF_OHG);
  constexpr int PS = 136;
  bf16_t* Qp = lds;
  bf16_t* Kp = lds + 128 * PS;
  bf16_t* As = lds + 2 * 128 * PS;
  float* RED = (float*)(lds + 2 * 128 * PS + 256 * PS);
  const int tid = get_tid(), lane = tid & 63, wave = tid >> 6, wm = wave >> 1, wn = wave & 1;
  const int lr = lane & 15, lg = lane >> 4;
  const int t0 = c * 128, colb = h * 128;
  const int lrow = tid >> 4, lc8 = (tid & 15) * 8;
#pragma unroll
  for (int i = 0; i < 4; i++) {
    const int row = lrow + i * 32;
    const size_t g = (size_t)(t0 + row) * 1024 + colb + lc8;
    uint4 qv = *(const uint4*)(HQ + g);
    float4 c0 = *(const float4*)(HCB + g), c1 = *(const float4*)(HCB + g + 4);
    float4 r0 = make_float4(0.f, 0.f, 0.f, 0.f), r1 = r0;
    if (row >= 32) {
      const size_t gr = (size_t)(t0 + (row & ~31) - 1) * 1024 + colb + lc8;
      r0 = *(const float4*)(HCB + gr); r1 = *(const float4*)(HCB + gr + 4);
    }
    uint4 ov;
    ov.x = pack2(bf2f((bf16_t)(qv.x & 0xffff)) * __expf(c0.x - r0.x), bf2f((bf16_t)(qv.x >> 16)) * __expf(c0.y - r0.y));
    ov.y = pack2(bf2f((bf16_t)(qv.y & 0xffff)) * __expf(c0.z - r0.z), bf2f((bf16_t)(qv.y >> 16)) * __expf(c0.w - r0.w));
    ov.z = pack2(bf2f((bf16_t)(qv.z & 0xffff)) * __expf(c1.x - r1.x), bf2f((bf16_t)(qv.z >> 16)) * __expf(c1.y - r1.y));
    ov.w = pack2(bf2f((bf16_t)(qv.w & 0xffff)) * __expf(c1.z - r1.z), bf2f((bf16_t)(qv.w >> 16)) * __expf(c1.w - r1.w));
    *(uint4*)(Qp + row * PS + lc8) = ov;
  }
  for (int I = 0; I < 4; I++) {
    const int nrows = 32 * (I + 1);
    float4 r0 = make_float4(0.f, 0.f, 0.f, 0.f), r1 = r0;
    if (I > 0) {
      const size_t gr = (size_t)(t0 + 32 * I - 1) * 1024 + colb + lc8;
      r0 = *(const float4*)(HCB + gr); r1 = *(const float4*)(HCB + gr + 4);
    }
#pragma unroll
    for (int i = 0; i < 4; i++) {
      const int row = lrow + i * 32;
      if (row < nrows) {
        const size_t g = (size_t)(t0 + row) * 1024 + colb + lc8;
        uint4 kv = *(const uint4*)(HK + g);
        float4 c0 = *(const float4*)(HCB + g), c1 = *(const float4*)(HCB + g + 4);
        uint4 ov;
        ov.x = pack2(bf2f((bf16_t)(kv.x & 0xffff)) * __expf(fminf(r0.x - c0.x, 80.f)), bf2f((bf16_t)(kv.x >> 16)) * __expf(fminf(r0.y - c0.y, 80.f)));
        ov.y = pack2(bf2f((bf16_t)(kv.y & 0xffff)) * __expf(fminf(r0.z - c0.z, 80.f)), bf2f((bf16_t)(kv.y >> 16)) * __expf(fminf(r0.w - c0.w, 80.f)));
        ov.z = pack2(bf2f((bf16_t)(kv.z & 0xffff)) * __expf(fminf(r1.x - c1.x, 80.f)), bf2f((bf16_t)(kv.z >> 16)) * __expf(fminf(r1.y - c1.y, 80.f)));
        ov.w = pack2(bf2f((bf16_t)(kv.w & 0xffff)) * __expf(fminf(r1.z - c1.z, 80.f)), bf2f((bf16_t)(kv.w >> 16)) * __expf(fminf(r1.w - c1.w, 80.f)));
        *(uint4*)(Kp + row * PS + lc8) = ov;
      }
    }
    __syncthreads();
    if (wave * 16 < nrows) {
      f32x4 a2[2];
      a2[0] = (f32x4){0.f, 0.f, 0.f, 0.f}; a2[1] = a2[0];
#pragma unroll
      for (int ks = 0; ks < 4; ks++) {
        bf16x8 bb = ldfrag(Kp, PS, wave * 16 + lr, ks * 32 + lg * 8);
        bf16x8 a0 = ldfrag(Qp, PS, 32 * I + lr, ks * 32 + lg * 8);
        bf16x8 a1 = ldfrag(Qp, PS, 32 * I + 16 + lr, ks * 32 + lg * 8);
        a2[0] = MFMA(bb, a0, a2[0]);
        a2[1] = MFMA(bb, a1, a2[1]);
      }
#pragma unroll
      for (int i = 0; i < 2; i++) {
        const int q = 32 * I + i * 16 + lr;
        f32x4 v;
#pragma unroll
        for (int r = 0; r < 4; r++) { const int key = wave * 16 + lg * 4 + r; v[r] = (key <= q) ? a2[i][r] : 0.f; }
        *(uint2*)(As + q * PS + wave * 16 + lg * 4) = pack4(v);
      }
    } else {
#pragma unroll
      for (int i = 0; i < 2; i++) {
        const int q = 32 * I + i * 16 + lr;
        *(uint2*)(As + q * PS + wave * 16 + lg * 4) = make_uint2(0u, 0u);
      }
    }
    __syncthreads();
  }
#pragma unroll
  for (int i = 0; i < 4; i++) {
    const int row = lrow + i * 32;
    *(uint4*)(Kp + row * PS + lc8) = *(const uint4*)(HVT + (size_t)(colb + row) * LT + t0 + lc8);
  }
  __syncthreads();
  f32x4 o[2][4];
#pragma unroll
  for (int i = 0; i < 2; i++)
#pragma unroll
    for (int j = 0; j < 4; j++) o[i][j] = (f32x4){0.f, 0.f, 0.f, 0.f};
#pragma unroll
  for (int ks = 0; ks < 4; ks++) {
    bf16x8 a0 = ldfrag(As, PS, wm * 32 + lr, ks * 32 + lg * 8);
    bf16x8 a1 = ldfrag(As, PS, wm * 32 + 16 + lr, ks * 32 + lg * 8);
#pragma unroll
    for (int j = 0; j < 4; j++) {
      bf16x8 bb = ldfrag(Kp, PS, wn * 64 + j * 16 + lr, ks * 32 + lg * 8);
      o[0][j] = MFMA(bb, a0, o[0][j]);
      o[1][j] = MFMA(bb, a1, o[1][j]);
    }
    __builtin_amdgcn_sched_barrier(0);
  }
  __syncthreads();
#pragma unroll
  for (int i = 0; i < 4; i++) {
    const int row = lrow + i * 32;
    const size_t g = (size_t)(t0 + row) * 1024 + colb + lc8;
    uint4 qv = *(const uint4*)(HQ + g);
    float4 c0 = *(const float4*)(HCB + g), c1 = *(const float4*)(HCB + g + 4);
    uint4 ov;
    ov.x = pack2(bf2f((bf16_t)(qv.x & 0xffff)) * __expf(c0.x), bf2f((bf16_t)(qv.x >> 16)) * __expf(c0.y));
    ov.y = pack2(bf2f((bf16_t)(qv.y & 0xffff)) * __expf(c0.z), bf2f((bf16_t)(qv.y >> 16)) * __expf(c0.w));
    ov.z = pack2(bf2f((bf16_t)(qv.z & 0xffff)) * __expf(c1.x), bf2f((bf16_t)(qv.z >> 16)) * __expf(c1.y));
    ov.w = pack2(bf2f((bf16_t)(qv.w & 0xffff)) * __expf(c1.z), bf2f((bf16_t)(qv.w >> 16)) * __expf(c1.w));
    *(uint4*)(Qp + row * PS + lc8) = ov;
    *(uint4*)(Kp + row * PS + lc8) = *(const uint4*)(STH + ((size_t)(h * 65 + c) * 128 + row) * 128 + lc8);
  }
  __syncthreads();
#pragma unroll
  for (int ks = 0; ks < 4; ks++) {
    bf16x8 a0 = ldfrag(Qp, PS, wm * 32 + lr, ks * 32 + lg * 8);
    bf16x8 a1 = ldfrag(Qp, PS, wm * 32 + 16 + lr, ks * 32 + lg * 8);
#pragma unroll
    for (int j = 0; j < 4; j++) {
      bf16x8 bb = ldfrag(Kp, PS, wn * 64 + j * 16 + lr, ks * 32 + lg * 8);
      o[0][j] = MFMA(bb, a0, o[0][j]);
      o[1][j] = MFMA(bb, a1, o[1][j]);
    }
    __builtin_amdgcn_sched_barrier(0);
  }
#pragma unroll
  for (int i = 0; i < 2; i++) {
    float ss = 0.f;
#pragma unroll
    for (int j = 0; j < 4; j++)
#pragma unroll
      for (int r = 0; r < 4; r++) ss += o[i][j][r] * o[i][j][r];
    ss += __shfl_xor(ss, 16);
    ss += __shfl_xor(ss, 32);
    if (lg == 0) RED[(wm * 32 + i * 16 + lr) * 2 + wn] = ss;
  }
  __syncthreads();
#pragma unroll
  for (int i = 0; i < 2; i++) {
    const int q = wm * 32 + i * 16 + lr;
    const float rs = rsqrtf((RED[q * 2] + RED[q * 2 + 1]) * (1.f / 128.f) + 1e-6f);
#pragma unroll
    for (int j = 0; j < 4; j++) {
      f32x4 v = o[i][j];
#pragma unroll
      for (int r = 0; r < 4; r++) v[r] *= rs;
      *(uint2*)(OHG + (size_t)(t0 + q) * 1024 + colb + wn * 64 + j * 16 + lg * 4) = pack4(v);
    }
  }
}

DEV void phase_O(const Params& p, int layer, int qidx, unsigned char* ldsraw) {
  bf16_t* lds = (bf16_t*)ldsraw;
  int* ctr = (int*)(p.ws + OFF_CTR) + qidx;
  int* sitem = (int*)(ldsraw + LDS_BYTES - 16);
  const float* lp = p.in[7] + layer * 256;
  float d0 = 0.f, d1 = 0.f;
  for (int i = 0; i < 64; i++) { d0 += lp[i] * lp[64 + i]; d1 += lp[128 + i] * lp[192 + i]; }
  int ly = layer; asm volatile("" : "+s"(ly));
  const float li = (ly == 0) ? 0.2f : 0.35550906759f;
  const float lam = __uint_as_float(__builtin_amdgcn_readfirstlane(__float_as_uint(__expf(d0) - __expf(d1) + li)));
  const int tid0 = get_tid();
  for (;;) {
    __syncthreads();
    if (tid0 == 0) *sitem = atomicAdd(ctr, 1);
    __syncthreads();
    const int item = __builtin_amdgcn_readfirstlane(*sitem);
    if (item >= 1300) break;
    if (item < 520) attn_item(p, layer, item & 7, 64 - (item >> 3), lam, lds);
    else if (item < 780) ret_item(p, (item - 520) & 3, (item - 520) >> 2, lds);
    else hg_item(p, (item - 780) & 7, (item - 780) >> 3, lds);
  }
}

DEV void phase_G(const Params& p, unsigned char* ldsraw) {
  unsigned char* ws = p.ws;
  bf16_t* lds = (bf16_t*)ldsraw;
  const bf16_t* HN = (const bf16_t*)(ws + OFF_HN);
  const bf16_t* WIN = (const bf16_t*)(ws + OFF_WIN);
  for (int item = vblock(); item < 33 * 20; item += gridDim.x) {
    int nt, mt; tile_map(item, 33, 4, mt, nt);
    int n0, cb; bf16_t* dst; int ld; bool gate;
    if (nt < 4) { n0 = 2048 + nt * 256; cb = nt * 256; dst = (bf16_t*)(ws + OFF_ORET); ld = 1024; gate = true; }
    else if (nt < 8) { n0 = 6144 + (nt - 4) * 256; cb = (nt - 4) * 256; dst = (bf16_t*)(ws + OFF_OHG); ld = 1024; gate = true; }
    else { n0 = 10240 + (nt - 8) * 256; cb = (nt - 8) * 256; dst = (bf16_t*)(ws + OFF_G); ld = 3072; gate = false; }
    f32x4 acc[4][8];
#pragma unroll
    for (int i = 0; i < 4; i++)
#pragma unroll
      for (int j = 0; j < 8; j++) acc[i][j] = (f32x4){0.f, 0.f, 0.f, 0.f};
    gemm256_acc(acc, HN + (size_t)mt * 256 * 1024, 1024, LT - mt * 256, WIN + (size_t)n0 * 1024, 1024, 1024, lds);
    const int tid = get_tid(), lane = tid & 63, wave = tid >> 6, wm = wave >> 1, wn = wave & 1; const int lr = lane & 15, lg = lane >> 4;
#pragma unroll
    for (int i = 0; i < 4; i++) {
      const int t = mt * 256 + wm * 64 + i * 16 + lr;
      if (t < LT) {
#pragma unroll
        for (int j = 0; j < 8; j++) {
          bf16_t* d = dst + (size_t)t * ld + cb + wn * 128 + j * 16 + lg * 4;
          f32x4 v;
          if (gate) {
            uint2 ov = *(const uint2*)d;
            v[0] = bf2f((bf16_t)(ov.x & 0xffff)) * silu_f(acc[i][j][0]);
            v[1] = bf2f((bf16_t)(ov.x >> 16)) * silu_f(acc[i][j][1]);
            v[2] = bf2f((bf16_t)(ov.y & 0xffff)) * silu_f(acc[i][j][2]);
            v[3] = bf2f((bf16_t)(ov.y >> 16)) * silu_f(acc[i][j][3]);
          } else {
#pragma unroll
            for (int r = 0; r < 4; r++) v[r] = sigmoid_f(acc[i][j][r]);
          }
          *(uint2*)d = pack4(v);
        }
      }
    }
  }
}

DEV f32x4 mini_gemm16(const bf16_t* __restrict__ A16, int lda, const bf16_t* __restrict__ Bt16, int ldb, int k0, int klen, int lane) {
  const int lr = lane & 15, lg = lane >> 4;
  const bf16_t* pa = A16 + (size_t)lr * lda + k0 + lg * 8;
  const bf16_t* pb = Bt16 + (size_t)lr * ldb + k0 + lg * 8;
  f32x4 acc = (f32x4){0.f, 0.f, 0.f, 0.f};
#pragma unroll 4
  for (int k = 0; k < klen; k += 32) {
    bf16x8 a = *(const bf16x8*)(pa + k);
    bf16x8 b = *(const bf16x8*)(pb + k);
    acc = MFMA(b, a, acc);
  }
  return acc;
}

DEV void phase_Y(const Params& p, unsigned char* ldsraw) {
  unsigned char* ws = p.ws;
  bf16_t* lds = (bf16_t*)ldsraw;
  const bf16_t* WB = (const bf16_t*)(ws + OFF_WB);
  const bf16_t* G = (const bf16_t*)(ws + OFF_G);
  bf16_t* Y = (bf16_t*)(ws + OFF_Y);
  for (int item = vblock(); item < 64 * 8 + 64; item += gridDim.x) {
    if (item >= 512) {
      const int lane = get_tid() & 63, wave = get_tid() >> 6, lr = lane & 15, lg = lane >> 4;
      const int n0 = (item - 512) * 16;
      f32x4* red = (f32x4*)ldsraw;
      __syncthreads();
#pragma unroll 1
      for (int br = 0; br < 3; br++) {
        const bf16_t* Ab = (const bf16_t*)(ws + (br == 0 ? OFF_ORET : (br == 1 ? OFF_OHG : OFF_ODA))) + (size_t)112 * 1024;
        red[(br * 8 + wave) * 64 + lane] = mini_gemm16(Ab, 1024, WB + ((size_t)br * 1024 + n0) * 1024, 1024, wave * 128, 128, lane);
      }
      __syncthreads();
      if (wave == 0) {
        f32x4 y = (f32x4){0.f, 0.f, 0.f, 0.f};
#pragma unroll
        for (int br = 0; br < 3; br++) {
          f32x4 a = red[(br * 8) * 64 + lane];
#pragma unroll
          for (int w = 1; w < 8; w++) a += red[(br * 8 + w) * 64 + lane];
          uint2 gv = *(const uint2*)(G + (size_t)(112 + lr) * 3072 + br * 1024 + n0 + lg * 4);
          y[0] += bf2f((bf16_t)(gv.x & 0xffff)) * a[0];
          y[1] += bf2f((bf16_t)(gv.x >> 16)) * a[1];
          y[2] += bf2f((bf16_t)(gv.y & 0xffff)) * a[2];
          y[3] += bf2f((bf16_t)(gv.y >> 16)) * a[3];
        }
        *(uint2*)(Y + (size_t)(112 + lr) * 1024 + n0 + lg * 4) = pack4(y);
      }
      continue;
    }
    int nt, mt; tile_map(item, 64, 4, mt, nt); mt += 1;
    f32x4 y[2][4];
#pragma unroll
    for (int i = 0; i < 2; i++)
#pragma unroll
      for (int j = 0; j < 4; j++) y[i][j] = (f32x4){0.f, 0.f, 0.f, 0.f};
#pragma unroll 1
    for (int br = 0; br < 3; br++) {
      const bf16_t* Ab = (const bf16_t*)(ws + (br == 0 ? OFF_ORET : (br == 1 ? OFF_OHG : OFF_ODA))) + (size_t)mt * 128 * 1024;
      f32x4 acc[2][4];
#pragma unroll
      for (int i = 0; i < 2; i++)
#pragma unroll
        for (int j = 0; j < 4; j++) acc[i][j] = (f32x4){0.f, 0.f, 0.f, 0.f};
      gemm_acc<128, false>(acc, Ab, 1024, WB + ((size_t)br * 1024 + nt * 128) * 1024, 1024, 1024, lds);
      const int tid = get_tid(), lane = tid & 63, wave = tid >> 6, wm = wave >> 1, wn = wave & 1; const int lr = lane & 15, lg = lane >> 4;
#pragma unroll
      for (int i = 0; i < 2; i++) {
        const int t = mt * 128 + wm * 32 + i * 16 + lr;
#pragma unroll
        for (int j = 0; j < 4; j++) {
          uint2 gv = *(const uint2*)(G + (size_t)t * 3072 + br * 1024 + nt * 128 + wn * 64 + j * 16 + lg * 4);
          y[i][j][0] += bf2f((bf16_t)(gv.x & 0xffff)) * acc[i][j][0];
          y[i][j][1] += bf2f((bf16_t)(gv.x >> 16)) * acc[i][j][1];
          y[i][j][2] += bf2f((bf16_t)(gv.y & 0xffff)) * acc[i][j][2];
          y[i][j][3] += bf2f((bf16_t)(gv.y >> 16)) * acc[i][j][3];
        }
      }
    }
    const int tid = get_tid(), lane = tid & 63, wave = tid >> 6, wm = wave >> 1, wn = wave & 1; const int lr = lane & 15, lg = lane >> 4;
#pragma unroll
    for (int i = 0; i < 2; i++) {
      const int t = mt * 128 + wm * 32 + i * 16 + lr;
#pragma unroll
      for (int j = 0; j < 4; j++)
        *(uint2*)(Y + (size_t)t * 1024 + nt * 128 + wn * 64 + j * 16 + lg * 4) = pack4(y[i][j]);
    }
  }
}

DEV void phase_resid(const Params& p, int b, const bf16_t* A, int K, const bf16_t* Wt, unsigned char* ldsraw) {
  bf16_t* lds = (bf16_t*)ldsraw;
  for (int item = vblock(); item < 64 * 8 + 64; item += gridDim.x) {
    if (item >= 512) {
      const int lane = get_tid() & 63, wave = get_tid() >> 6, lr = lane & 15, lg = lane >> 4;
      const int n0 = (item - 512) * 16;
      f32x4* red = (f32x4*)ldsraw;
      const int ks = K >> 3;
      __syncthreads();
      red[wave * 64 + lane] = mini_gemm16(A + (size_t)112 * K, K, Wt + (size_t)n0 * K, K, wave * ks, ks, lane);
      __syncthreads();
      if (wave == 0) {
        f32x4 a = red[lane];
#pragma unroll
        for (int w = 1; w < 8; w++) a += red[w * 64 + lane];
        float4* d = (float4*)(hrow(p, b, 112 + lr) + n0 + lg * 4);
        float4 v = *d;
        v.x += a[0]; v.y += a[1]; v.z += a[2]; v.w += a[3];
        *d = v;
      }
      continue;
    }
    int nt, mt; tile_map(item, 64, 4, mt, nt); mt += 1;
    f32x4 acc[2][4];
#pragma unroll
    for (int i = 0; i < 2; i++)
#pragma unroll
      for (int j = 0; j < 4; j++) acc[i][j] = (f32x4){0.f, 0.f, 0.f, 0.f};
    gemm_acc<128, false>(acc, A + (size_t)mt * 128 * K, K, Wt + (size_t)nt * 128 * K, K, K, lds);
    const int tid = get_tid(), lane = tid & 63, wave = tid >> 6, wm = wave >> 1, wn = wave & 1; const int lr = lane & 15, lg = lane >> 4;
#pragma unroll
    for (int i = 0; i < 2; i++) {
      const int t = mt * 128 + wm * 32 + i * 16 + lr;
#pragma unroll
      for (int j = 0; j < 4; j++) {
        float4* d = (float4*)(hrow(p, b, t) + nt * 128 + wn * 64 + j * 16 + lg * 4);
        float4 v = *d;
        v.x += acc[i][j][0]; v.y += acc[i][j][1]; v.z += acc[i][j][2]; v.w += acc[i][j][3];
        *d = v;
      }
    }
  }
}

DEV void phase_F1(const Params& p, unsigned char* ldsraw) {
  unsigned char* ws = p.ws;
  bf16_t* lds = (bf16_t*)ldsraw;
  const bf16_t* HN = (const bf16_t*)(ws + OFF_HN);
  const bf16_t* WFI = (const bf16_t*)(ws + OFF_WFI);
  bf16_t* U = (bf16_t*)(ws + OFF_U);
  for (int item = vblock(); item < 33 * 22; item += gridDim.x) {
    int nt, mt; tile_map(item, 33, 2, mt, nt);
    f32x4 acc[4][8];
#pragma unroll
    for (int i = 0; i < 4; i++)
#pragma unroll
      for (int j = 0; j < 8; j++) acc[i][j] = (f32x4){0.f, 0.f, 0.f, 0.f};
    gemm256_acc(acc, HN + (size_t)mt * 256 * 1024, 1024, LT - mt * 256, WFI + (size_t)nt * 256 * 1024, 1024, 1024, lds);
    const int tid = get_tid(), lane = tid & 63, wave = tid >> 6, wm = wave >> 1, wn = wave & 1; const int lr = lane & 15, lg = lane >> 4;
#pragma unroll
    for (int i = 0; i < 4; i++) {
      const int t = mt * 256 + wm * 64 + i * 16 + lr;
      if (t < LT) {
        const float vm = (t >= 112) ? 1.f : 0.f;
#pragma unroll
        for (int j = 0; j < 8; j++) {
          f32x4 v = acc[i][j];
#pragma unroll
          for (int r = 0; r < 4; r++) v[r] *= vm;
          *(uint2*)(U + (size_t)t * 5632 + nt * 256 + wn * 128 + j * 16 + lg * 4) = pack4(v);
        }
      }
    }
  }
}

DEV void unpack8(const u32x4 v, float (&f)[8]) {
#pragma unroll
  for (int k = 0; k < 4; k++) { f[2 * k] = bf2f((bf16_t)(v[k] & 0xffff)); f[2 * k + 1] = bf2f((bf16_t)(v[k] >> 16)); }
}
DEV void phase_conv(const Params& p, int layer) {
  unsigned char* ws = p.ws;
  const bf16_t* U = (const bf16_t*)(ws + OFF_U);
  bf16_t* GF = (bf16_t*)(ws + OFF_GF);
  const float* cw = p.in[11] + (size_t)layer * 3 * 5632;
  const float* cbias = p.in[12] + (size_t)layer * 5632;
  for (int idx = get_bid() * NTHR + get_tid(); idx < (LT / 8) * 352; idx += gridDim.x * NTHR) {
    const int tb = idx / 352, c8 = (idx - tb * 352) * 8;
    const int t0 = tb * 8;
    float wg[3][8], wv[3][8], bg[8], bv[8];
#pragma unroll
    for (int k = 0; k < 8; k++) {
      bg[k] = cbias[c8 + k]; bv[k] = cbias[2816 + c8 + k];
#pragma unroll
      for (int j = 0; j < 3; j++) { wg[j][k] = cw[j * 5632 + c8 + k]; wv[j][k] = cw[j * 5632 + 2816 + c8 + k]; }
    }
    float g0[8], g1[8], v0[8], v1[8];
    if (t0 >= 2) {
      unpack8(*(const u32x4*)(U + (size_t)(t0 - 2) * 5632 + c8), g0);
      unpack8(*(const u32x4*)(U + (size_t)(t0 - 2) * 5632 + 2816 + c8), v0);
      unpack8(*(const u32x4*)(U + (size_t)(t0 - 1) * 5632 + c8), g1);
      unpack8(*(const u32x4*)(U + (size_t)(t0 - 1) * 5632 + 2816 + c8), v1);
    } else {
#pragma unroll
      for (int k = 0; k < 8; k++) { g0[k] = 0.f; g1[k] = 0.f; v0[k] = 0.f; v1[k] = 0.f; }
    }
#pragma unroll
    for (int tt = 0; tt < 8; tt++) {
      float g2[8], v2[8];
      unpack8(*(const u32x4*)(U + (size_t)(t0 + tt) * 5632 + c8), g2);
      unpack8(*(const u32x4*)(U + (size_t)(t0 + tt) * 5632 + 2816 + c8), v2);
      float og[8];
#pragma unroll
      for (int k = 0; k < 8; k++) {
        const float gg = bg[k] + wg[0][k] * g0[k] + wg[1][k] * g1[k] + wg[2][k] * g2[k];
        const float vv = bv[k] + wv[0][k] * v0[k] + wv[1][k] * v1[k] + wv[2][k] * v2[k];
        og[k] = silu_f(gg) * vv;
        g0[k] = g1[k]; g1[k] = g2[k]; v0[k] = v1[k]; v1[k] = v2[k];
      }
      u32x4 o;
      o[0] = pack2(og[0], og[1]); o[1] = pack2(og[2], og[3]); o[2] = pack2(og[4], og[5]); o[3] = pack2(og[6], og[7]);
      *(u32x4*)(GF + (size_t)(t0 + tt) * 2816 + c8) = o;
    }
  }
}

#define XB_TMO      128
#define XB_XCNT(j)  (256  + 64 * (j))
#define XB_XSUB(j)  (1280 + 64 * (j))
#define XB_XGEN(j)  (2304 + 64 * (j))
#define XB_TOP      3328
#define XB_TOPGEN   3392
#define XB_SPIN_CAP (1u << 18)
#define LAS __attribute__((address_space(3)))
DEV unsigned xb_ld(unsigned* p) { return __hip_atomic_load(p, __ATOMIC_RELAXED, __HIP_MEMORY_SCOPE_AGENT); }
DEV unsigned xb_add(unsigned* p, unsigned v) { return __hip_atomic_fetch_add(p, v, __ATOMIC_RELAXED, __HIP_MEMORY_SCOPE_AGENT); }
DEV unsigned xb_xcc_id() { return (unsigned)__builtin_amdgcn_s_getreg((3 << 11) | 20) & 0xFu; }
#define XB_SPIN(cond, bar) do { unsigned _sp = 0; while (cond) { __builtin_amdgcn_s_sleep(1); \
    if ((++_sp & 255u) == 0u) { if (xb_ld(&(bar)[XB_TMO])) break; if (_sp > XB_SPIN_CAP) { atomicAdd(&(bar)[XB_TMO], 1u); break; } } } } while (0)
struct XcdBarrier { unsigned* bar; unsigned x; volatile LAS unsigned* st; };
DEV XcdBarrier xcd_barrier_post(unsigned* bar, volatile LAS unsigned* st) {
  XcdBarrier b; b.bar = bar; b.x = xb_xcc_id(); b.st = st;
  if (threadIdx.x == 0) (void)xb_add(&bar[XB_XCNT(b.x)], 1u);
  return b;
}
DEV void xcd_barrier_complete(unsigned* bar, unsigned x, unsigned& nloc, unsigned& nx) {
  const unsigned G = gridDim.x;
  unsigned sum, cnt, mine, sp = 0u;
  for (;;) {
    sum = 0u; cnt = 0u; mine = 0u;
#pragma unroll
    for (unsigned j = 0; j < 16; ++j) { const unsigned c = xb_ld(&bar[XB_XCNT(j)]); sum += c; cnt += (c > 0u) ? 1u : 0u; mine = (j == x) ? c : mine; }
    if (sum == G) break;
    __builtin_amdgcn_s_sleep(1);
    if ((++sp & 255u) == 0u) { if (xb_ld(&bar[XB_TMO])) break; if (sp > XB_SPIN_CAP) { atomicAdd(&bar[XB_TMO], 1u); break; } }
  }
  nloc = mine > 0u ? mine : 1u; nx = cnt > 0u ? cnt : 1u;
}
DEV void xcd_barrier(const XcdBarrier& b) {
  asm volatile("s_waitcnt vmcnt(0)" ::: "memory");
  __syncthreads();
  if (threadIdx.x == 0) {
    unsigned* bar = b.bar;
    __builtin_amdgcn_s_waitcnt(0);
    unsigned nloc = b.st[0], nx = b.st[1];
    if (nloc == 0u) { xcd_barrier_complete(bar, b.x, nloc, nx); b.st[0] = nloc; b.st[1] = nx; }
    const unsigned old = xb_add(&bar[XB_XSUB(b.x)], 1u);
    const unsigned gen = old / nloc;
    if (old + 1u == (gen + 1u) * nloc) {
      __builtin_amdgcn_fence(__ATOMIC_RELEASE, "agent");
      asm volatile("s_waitcnt vmcnt(0)" ::: "memory");
      const unsigned og = xb_add(&bar[XB_TOP], 1u);
      const unsigned tg = og / nx;
      if (og + 1u == (tg + 1u) * nx) xb_add(&bar[XB_TOPGEN], 1u);
      else XB_SPIN(xb_ld(&bar[XB_TOPGEN]) == tg, bar);
      __builtin_amdgcn_fence(__ATOMIC_ACQUIRE, "agent");
      xb_add(&bar[XB_XGEN(b.x)], 1u);
      asm volatile("s_waitcnt vmcnt(0)" ::: "memory");
    } else {
      XB_SPIN(xb_ld(&bar[XB_XGEN(b.x)]) == gen, bar);
      __builtin_amdgcn_fence(__ATOMIC_ACQUIRE, "agent");
      asm volatile("s_waitcnt vmcnt(0)" ::: "memory");
    }
  }
  __syncthreads();
}

__global__ void __launch_bounds__(NTHR) fwd_megakernel(Params p) {
  extern __shared__ __attribute__((aligned(16))) unsigned char lds[];
  cg::grid_group grid = cg::this_grid();
  volatile LAS unsigned* xst = (volatile LAS unsigned*)(lds + LDS_BYTES - 12);
  if (threadIdx.x == 0) { xst[0] = 0u; xst[1] = 0u; }
  __syncthreads();
  (void)xcd_barrier_post((unsigned*)(p.ws + OFF_XBAR), xst);
#define GRID_SYNC() do { XcdBarrier xb_; xb_.bar = (unsigned*)(p.ws + OFF_XBAR); xb_.x = xb_xcc_id(); \
    xb_.st = (volatile LAS unsigned*)(lds + LDS_BYTES - 12); xcd_barrier(xb_); } while (0)
  grid.sync();
  unsigned char* ws = p.ws;
  phase_init(p);
  phase_convert(p, 0, lds);
  GRID_SYNC();
  for (int layer = 0; layer < 2; layer++) {
    if (layer == 1) { phase_convert(p, 1, lds); GRID_SYNC(); }
    for (int b = 0; b < 2; b++) {
      phase_norm(p, b, p.in[2] + layer * 1024, (bf16_t*)(ws + OFF_HN));
      GRID_SYNC();
      phase_projA(p, layer, lds);
      GRID_SYNC();
      phase_U(p, lds);
      GRID_SYNC();
      phase_scan(p);
      GRID_SYNC();
      phase_O(p, layer, layer * 2 + b, lds);
      GRID_SYNC();
      phase_G(p, lds);
      GRID_SYNC();
      phase_Y(p, lds);
      GRID_SYNC();
      phase_resid(p, b, (const bf16_t*)(ws + OFF_Y), 1024, (const bf16_t*)(ws + OFF_WO), lds);
      GRID_SYNC();
      phase_norm(p, b, p.in[9] + layer * 1024, (bf16_t*)(ws + OFF_HN));
      GRID_SYNC();
      phase_F1(p, lds);
      GRID_SYNC();
      phase_conv(p, layer);
      GRID_SYNC();
      phase_resid(p, b, (const bf16_t*)(ws + OFF_GF), DFF, (const bf16_t*)(ws + OFF_WFO), lds);
      GRID_SYNC();
    }
  }
  phase_final(p);
}

extern "C" void kernel_launch(void* const* d_in, const int* in_sizes, int n_in, void* d_out, int out_size,
                              void* d_ws, size_t ws_size, hipStream_t stream) {
  static int grid_blocks = 0;
  if (grid_blocks == 0) {
    if (n_in != 15 || ws_size < OFF_END) {
      fprintf(stderr, "kernel_launch: need 15 inputs and %zu bytes of workspace, got %d and %zu\n", (size_t)OFF_END, n_in, ws_size);
      grid_blocks = -1; return;
    }
    int dev = 0, cus = 0, per_cu = 0;
    hipGetDevice(&dev);
    hipDeviceGetAttribute(&cus, hipDeviceAttributeMultiprocessorCount, dev);
    if (hipFuncSetAttribute((const void*)fwd_megakernel, hipFuncAttributeMaxDynamicSharedMemorySize, LDS_BYTES) != hipSuccess) {
      fprintf(stderr, "kernel_launch: hipFuncSetAttribute failed\n"); grid_blocks = -1; return;
    }
    hipOccupancyMaxActiveBlocksPerMultiprocessor(&per_cu, (const void*)fwd_megakernel, NTHR, LDS_BYTES);
    if (per_cu < 1) per_cu = 1;
    if (per_cu > 1) per_cu = 1;
    grid_blocks = cus * per_cu;
  }
  if (grid_blocks < 0) return;
  hipMemsetAsync((char*)d_ws + OFF_CTR, 0, 256 + XBAR_BYTES, stream);
  Params p{};
  for (int i = 0; i < 15; i++) p.in[i] = (const float*)d_in[i];
  p.out = (float*)d_out;
  p.ws = (unsigned char*)d_ws;
  void* args[] = {&p};
  hipError_t e = hipLaunchCooperativeKernel((const void*)fwd_megakernel, dim3(grid_blocks), dim3(NTHR), args, LDS_BYTES, stream);
  if (e != hipSuccess) fprintf(stderr, "cooperative launch failed: %s (grid %d)\n", hipGetErrorString(e), grid_blocks);
}
```

```cpp
#include <hip/hip_runtime.h>
#include <hip/hip_cooperative_groups.h>
#include <cstdio>
#include <cstdint>
namespace cg = cooperative_groups;

typedef unsigned short bf16_t;
typedef __attribute__((ext_vector_type(8))) short bf16x8;
typedef __attribute__((ext_vector_type(4))) short bf16x4;
typedef __attribute__((ext_vector_type(4))) float f32x4;
typedef __attribute__((ext_vector_type(4))) unsigned u32x4;

#define DEV __device__ __forceinline__
#define MFMA(a, b, c) __builtin_amdgcn_mfma_f32_16x16x32_bf16(a, b, c, 0, 0, 0)

constexpr int LT = 8320;
constexpr int NCH = 65;
constexpr int NTHR = 512;
constexpr int LDS_BYTES = 144 * 1024;
constexpr int INW = 13312;
constexpr int DFF = 2816;

constexpr size_t SZ_ACT = (size_t)LT * 1024 * 2;
constexpr size_t OFF_WIN = 0;
constexpr size_t OFF_WB = OFF_WIN + (size_t)INW * 1024 * 2;
constexpr size_t OFF_WO = OFF_WB + (size_t)3 * 1024 * 1024 * 2;
constexpr size_t OFF_WFI = OFF_WO + (size_t)1024 * 1024 * 2;
constexpr size_t OFF_WFO = OFF_WFI + (size_t)5632 * 1024 * 2;
constexpr size_t OFF_H = OFF_WFO + (size_t)1024 * 2816 * 2;
constexpr size_t OFF_HN = OFF_H + (size_t)2 * 128 * 1024 * 4;
constexpr size_t OFF_R128 = OFF_HN + 2 * SZ_ACT;
constexpr size_t OFF_R64 = OFF_R128 + (size_t)LT * 64 * 8;
constexpr size_t OFF_CTR = OFF_R64 + (size_t)LT * 32 * 8;
constexpr size_t OFF_XBAR = OFF_CTR + 256;
constexpr size_t XBAR_BYTES = 3456 * 4;
constexpr size_t OFF_ARENA = OFF_XBAR + XBAR_BYTES;
constexpr size_t OFF_RQ = OFF_ARENA;
constexpr size_t OFF_RK = OFF_RQ + SZ_ACT / 2;
constexpr size_t OFF_RKT = OFF_RK + SZ_ACT / 2;
constexpr size_t OFF_RVT = OFF_RKT + SZ_ACT / 2;
constexpr size_t OFF_HQ = OFF_RVT + SZ_ACT;
constexpr size_t OFF_HK = OFF_HQ + SZ_ACT;
constexpr size_t OFF_HCB = OFF_HK + SZ_ACT;
constexpr size_t OFF_HKET = OFF_HCB + 2 * SZ_ACT;
constexpr size_t OFF_HVT = OFF_HKET + SZ_ACT;
constexpr size_t OFF_DQ = OFF_HVT + SZ_ACT;
constexpr size_t OFF_DK = OFF_DQ + SZ_ACT;
constexpr size_t OFF_DVT = OFF_DK + SZ_ACT;
constexpr size_t OFF_ORET = OFF_DVT + SZ_ACT;
constexpr size_t OFF_OHG = OFF_ORET + SZ_ACT;
constexpr size_t OFF_STR = OFF_OHG + SZ_ACT;
constexpr size_t OFF_STH = OFF_STR + SZ_ACT;
constexpr size_t OFF_HDEC = OFF_STH + SZ_ACT;
constexpr size_t OFF_END = OFF_HDEC + (size_t)65 * 1024 * 4;
constexpr size_t OFF_G = OFF_RQ;
constexpr size_t OFF_Y = OFF_HK;
constexpr size_t OFF_ODA = OFF_HKET;
constexpr size_t OFF_U = OFF_ARENA;
constexpr size_t OFF_GF = OFF_U + (size_t)LT * 5632 * 2;

struct Params {
  const float* in[15];
  float* out;
  unsigned char* ws;
};

DEV int get_tid() { int t = threadIdx.x; asm volatile("" : "+v"(t)); return t; }
DEV int get_bid() { int b = blockIdx.x; asm volatile("" : "+s"(b)); return b; }
DEV float shfl_xor_l(float v, int m, int lane) { return __int_as_float(__builtin_amdgcn_ds_bpermute((lane ^ m) << 2, __float_as_int(v))); }
DEV float shfl_l(float v, int srclane) { return __int_as_float(__builtin_amdgcn_ds_bpermute(srclane << 2, __float_as_int(v))); }
DEV float* hrow(const Params& p, int b, int t) {
  return (t < 128) ? (float*)(p.ws + OFF_H) + (size_t)(b * 128 + t) * 1024 : p.out + ((size_t)b * 8192 + (t - 128)) * 1024;
}
typedef __bf16 hwbf16x2 __attribute__((ext_vector_type(2)));
typedef float hwf32x2 __attribute__((ext_vector_type(2)));
DEV unsigned pack2(float a, float b) {
  hwf32x2 f = {a, b};
  hwbf16x2 h = __builtin_convertvector(f, hwbf16x2);
  return __builtin_bit_cast(unsigned, h);
}
DEV bf16_t f2bf(float f) { return (bf16_t)(pack2(f, f) & 0xffffu); }
DEV float bf2f(bf16_t h) { return __uint_as_float(((unsigned)h) << 16); }
DEV uint2 pack4(f32x4 v) { uint2 r; r.x = pack2(v[0], v[1]); r.y = pack2(v[2], v[3]); return r; }
DEV float silu_f(float x) { return x / (1.f + __expf(-x)); }
DEV float sigmoid_f(float x) { return 1.f / (1.f + __expf(-x)); }
DEV float ex2(float x) { return __builtin_amdgcn_exp2f(x); }
DEV bf16x8 ldfrag(const bf16_t* base, int stride, int row, int k) {
  return *(const bf16x8*)(base + row * stride + k);
}

template <int BN, bool TRANS>
DEV void gemm_compute(f32x4 (&acc)[2][BN / 32], const bf16_t* as, const bf16_t* bs) {
  constexpr int NJ = BN / 32, LS = 72;
#pragma unroll
  for (int ks = 0; ks < 2; ks++) {
    bf16x8 a0 = *(const bf16x8*)(as + ks * 32);
    bf16x8 a1 = *(const bf16x8*)(as + 16 * LS + ks * 32);
#pragma unroll
    for (int j = 0; j < NJ; j++) {
      bf16x8 bb = *(const bf16x8*)(bs + j * 16 * LS + ks * 32);
      if (TRANS) {
        acc[0][j] = MFMA(a0, bb, acc[0][j]);
        acc[1][j] = MFMA(a1, bb, acc[1][j]);
      } else {
        acc[0][j] = MFMA(bb, a0, acc[0][j]);
        acc[1][j] = MFMA(bb, a1, acc[1][j]);
      }
    }
  }
}

template <int BN, bool TRANS>
DEV void gemm_acc(f32x4 (&acc)[2][BN / 32], const bf16_t* __restrict__ A, int lda,
                  const bf16_t* __restrict__ Bt, int ldb, int K, bf16_t* lds) {
  constexpr int LS = 72, A_SZ = 128 * LS, B_SZ = BN * LS, NB = BN / 64;
  const int tid = get_tid(), lane = tid & 63, wave = tid >> 6, wm = wave >> 1, wn = wave & 1;
  const int lr = lane & 15, lg = lane >> 4;
  bf16_t* As = lds;
  bf16_t* Bs = lds + 2 * A_SZ;
  const int crow = tid >> 3, ckc = (tid & 7) * 8;
  const bf16_t* ga = A + (size_t)crow * lda + ckc;
  const bf16_t* gb = Bt + (size_t)crow * ldb + ckc;
  u32x4 ra0, ra1, rb0, rb1, rb2, rb3;
#define GLOAD(k0)                                                        \
  ra0 = *(const u32x4*)(ga + (k0));                                      \
  ra1 = *(const u32x4*)(ga + (size_t)64 * lda + (k0));                   \
  rb0 = *(const u32x4*)(gb + (k0));                                      \
  rb1 = *(const u32x4*)(gb + (size_t)64 * ldb + (k0));                   \
  if (NB == 4) {                                                         \
    rb2 = *(const u32x4*)(gb + (size_t)128 * ldb + (k0));                \
    rb3 = *(const u32x4*)(gb + (size_t)192 * ldb + (k0));                \
  }
#define LSTORE(buf)                                                      \
  *(u32x4*)(As + (buf) * A_SZ + crow * LS + ckc) = ra0;                  \
  *(u32x4*)(As + (buf) * A_SZ + (crow + 64) * LS + ckc) = ra1;           \
  *(u32x4*)(Bs + (buf) * B_SZ + crow * LS + ckc) = rb0;                  \
  *(u32x4*)(Bs + (buf) * B_SZ + (crow + 64) * LS + ckc) = rb1;           \
  if (NB == 4) {                                                         \
    *(u32x4*)(Bs + (buf) * B_SZ + (crow + 128) * LS + ckc) = rb2;        \
    *(u32x4*)(Bs + (buf) * B_SZ + (crow + 192) * LS + ckc) = rb3;        \
  }
  const int nk = K / 64;
  const int aoff = (wm * 32 + lr) * LS + lg * 8;
  const int boff = (wn * (BN / 2) + lr) * LS + lg * 8;
  GLOAD(0)
  __syncthreads();
  LSTORE(0)
  GLOAD(64)
  __syncthreads();
  for (int kt = 0; kt < nk; kt++) {
    const int cur = kt & 1;
    LSTORE(cur ^ 1)
    {
      const int kn = (kt + 2 < nk) ? kt + 2 : nk - 1;
      GLOAD(kn * 64)
    }
    gemm_compute<BN, TRANS>(acc, As + cur * A_SZ + aoff, Bs + cur * B_SZ + boff);
    __syncthreads();
  }
#undef GLOAD
#undef LSTORE
}

template <int BN>
DEV void gemm256_compute(f32x4 (&acc)[4][BN / 32], const bf16_t* as, const bf16_t* bs) {
  constexpr int LS = 72, NJ = BN / 32;
#pragma unroll
  for (int ks = 0; ks < 2; ks++) {
    bf16x8 a[4];
#pragma unroll
    for (int i = 0; i < 4; i++) a[i] = *(const bf16x8*)(as + i * 16 * LS + ks * 32);
#pragma unroll
    for (int j = 0; j < NJ; j++) {
      bf16x8 bb = *(const bf16x8*)(bs + j * 16 * LS + ks * 32);
#pragma unroll
      for (int i = 0; i < 4; i++) acc[i][j] = MFMA(bb, a[i], acc[i][j]);
    }
  }
}

template <int BN>
DEV void gemm256_acc(f32x4 (&acc)[4][BN / 32], const bf16_t* __restrict__ A, int lda, int m_valid,
                     const bf16_t* __restrict__ Bt, int ldb, int K, bf16_t* lds) {
  constexpr int LS = 72, A_SZ = 256 * LS, B_SZ = BN * LS, NB = BN / 64;
  const int tid = get_tid(), lane = tid & 63, wave = tid >> 6, wm = wave >> 1, wn = wave & 1;
  const int lr = lane & 15, lg = lane >> 4;
  bf16_t* As = lds;
  bf16_t* Bs = lds + 2 * A_SZ;
  const int crow = tid >> 3, ckc = (tid & 7) * 8;
  const bf16_t* ga0 = A + (size_t)min(crow, m_valid - 1) * lda + ckc;
  const bf16_t* ga1 = A + (size_t)min(crow + 64, m_valid - 1) * lda + ckc;
  const bf16_t* ga2 = A + (size_t)min(crow + 128, m_valid - 1) * lda + ckc;
  const bf16_t* ga3 = A + (size_t)min(crow + 192, m_valid - 1) * lda + ckc;
  const bf16_t* gb = Bt + (size_t)crow * ldb + ckc;
  u32x4 ra0, ra1, ra2, ra3, rb0, rb1, rb2, rb3;
#define GLOAD(k0)                                                        \
  ra0 = *(const u32x4*)(ga0 + (k0));                                     \
  ra1 = *(const u32x4*)(ga1 + (k0));                                     \
  ra2 = *(const u32x4*)(ga2 + (k0));                                     \
  ra3 = *(const u32x4*)(ga3 + (k0));                                     \
  rb0 = *(const u32x4*)(gb + (k0));                                      \
  rb1 = *(const u32x4*)(gb + (size_t)64 * ldb + (k0));                   \
  if (NB == 4) {                                                         \
    rb2 = *(const u32x4*)(gb + (size_t)128 * ldb + (k0));                \
    rb3 = *(const u32x4*)(gb + (size_t)192 * ldb + (k0));                \
  }
#define LSTORE(buf)                                                      \
  *(u32x4*)(As + (buf) * A_SZ + crow * LS + ckc) = ra0;                  \
  *(u32x4*)(As + (buf) * A_SZ + (crow + 64) * LS + ckc) = ra1;           \
  *(u32x4*)(As + (buf) * A_SZ + (crow + 128) * LS + ckc) = ra2;          \
  *(u32x4*)(As + (buf) * A_SZ + (crow + 192) * LS + ckc) = ra3;          \
  *(u32x4*)(Bs + (buf) * B_SZ + crow * LS + ckc) = rb0;                  \
  *(u32x4*)(Bs + (buf) * B_SZ + (crow + 64) * LS + ckc) = rb1;           \
  if (NB == 4) {                                                         \
    *(u32x4*)(Bs + (buf) * B_SZ + (crow + 128) * LS + ckc) = rb2;        \
    *(u32x4*)(Bs + (buf) * B_SZ + (crow + 192) * LS + ckc) = rb3;        \
  }
  const int nk = K / 64;
  const int aoff = (wm * 64 + lr) * LS + lg * 8;
  const int boff = (wn * (BN / 2) + lr) * LS + lg * 8;
  GLOAD(0)
  __syncthreads();
  LSTORE(0)
  GLOAD(64)
  __syncthreads();
  for (int kt = 0; kt < nk; kt++) {
    const int cur = kt & 1;
    LSTORE(cur ^ 1)
    {
      const int kn = (kt + 2 < nk) ? kt + 2 : nk - 1;
      GLOAD(kn * 64)
    }
    gemm256_compute<BN>(acc, As + cur * A_SZ + aoff, Bs + cur * B_SZ + boff);
    __syncthreads();
  }
#undef GLOAD
#undef LSTORE
}

DEV void tconv_tiles4(const float* __restrict__ src, int K, int N, bf16_t* __restrict__ dst, int idx0, int ntn, float* tile) {
  const int tid = get_tid();
  const int r = tid >> 4, c4 = (tid & 15) * 4;
  float4 v[4][2];
#pragma unroll
  for (int u = 0; u < 4; u++) {
    const int idx = idx0 + u, tk = idx / ntn, tn = idx - tk * ntn;
#pragma unroll
    for (int i = 0; i < 2; i++) v[u][i] = *(const float4*)(src + (size_t)(tk * 64 + r + i * 32) * N + tn * 64 + c4);
  }
  __syncthreads();
#pragma unroll
  for (int u = 0; u < 4; u++)
#pragma unroll
    for (int i = 0; i < 2; i++) {
      float* t = tile + u * (64 * 65) + (r + i * 32) * 65 + c4;
      t[0] = v[u][i].x; t[1] = v[u][i].y; t[2] = v[u][i].z; t[3] = v[u][i].w;
    }
  __syncthreads();
  const int n = tid >> 3, k8 = (tid & 7) * 8;
#pragma unroll
  for (int u = 0; u < 4; u++) {
    const int idx = idx0 + u, tk = idx / ntn, tn = idx - tk * ntn;
    const float* t = tile + u * (64 * 65);
    u32x4 o;
    o[0] = pack2(t[(k8 + 0) * 65 + n], t[(k8 + 1) * 65 + n]);
    o[1] = pack2(t[(k8 + 2) * 65 + n], t[(k8 + 3) * 65 + n]);
    o[2] = pack2(t[(k8 + 4) * 65 + n], t[(k8 + 5) * 65 + n]);
    o[3] = pack2(t[(k8 + 6) * 65 + n], t[(k8 + 7) * 65 + n]);
    *(u32x4*)(dst + (size_t)(tn * 64 + n) * K + tk * 64 + k8) = o;
  }
}

DEV void phase_convert(const Params& p, int layer, unsigned char* lds) {
  unsigned char* ws = p.ws;
  float* tile = (float*)lds;
  for (int g = get_bid(); g < 1616; g += gridDim.x) {
    const float* src; bf16_t* dst; int K, N, gi;
    if (g < 832) { gi = g; src = p.in[3] + (size_t)layer * 1024 * INW; K = 1024; N = INW; dst = (bf16_t*)(ws + OFF_WIN); }
    else if (g < 832 + 192) { gi = g - 832; const int br = gi >> 6; gi &= 63; src = p.in[4] + ((size_t)layer * 3 + br) * 1024 * 1024; K = 1024; N = 1024; dst = (bf16_t*)(ws + OFF_WB) + (size_t)br * 1024 * 1024; }
    else if (g < 1088) { gi = g - 1024; src = p.in[5] + (size_t)layer * 1024 * 1024; K = 1024; N = 1024; dst = (bf16_t*)(ws + OFF_WO); }
    else if (g < 1440) { gi = g - 1088; src = p.in[10] + (size_t)layer * 1024 * 5632; K = 1024; N = 5632; dst = (bf16_t*)(ws + OFF_WFI); }
    else { gi = g - 1440; src = p.in[13] + (size_t)layer * 2816 * 1024; K = 2816; N = 1024; dst = (bf16_t*)(ws + OFF_WFO); }
    tconv_tiles4(src, K, N, dst, gi * 4, N / 64, (float*)tile);
  }
}

DEV void phase_init(const Params& p) {
  unsigned char* ws = p.ws;
  const int gt = get_bid() * NTHR + get_tid(), gs = gridDim.x * NTHR;
  {
    const int lane = get_tid() & 63, wave = get_tid() >> 6;
    const float* g = p.in[2];
    for (int row = get_bid() * 8 + wave; row < 2 * LT; row += gridDim.x * 8) {
      const int b = row / LT, t = row - b * LT;
      float4 v[4]; float ss = 0.f;
#pragma unroll
      for (int k = 0; k < 4; k++) {
        const int c4 = k * 256 + lane * 4;
        if (t < 112) v[k] = make_float4(0.f, 0.f, 0.f, 0.f);
        else if (t < 128) v[k] = *(const float4*)(p.in[1] + (size_t)(t - 112) * 1024 + c4);
        else v[k] = *(const float4*)(p.in[0] + ((size_t)b * 8192 + (t - 128)) * 1024 + c4);
        *(float4*)(hrow(p, b, t) + c4) = v[k];
        ss += v[k].x * v[k].x + v[k].y * v[k].y + v[k].z * v[k].z + v[k].w * v[k].w;
      }
#pragma unroll
      for (int o = 1; o < 64; o <<= 1) ss += shfl_xor_l(ss, o, lane);
      const float rs = rsqrtf(ss * (1.f / 1024.f) + 1e-6f);
      bf16_t* dst = (bf16_t*)(ws + OFF_HN) + (size_t)b * LT * 1024 + (size_t)t * 1024;
#pragma unroll
      for (int k = 0; k < 4; k++) {
        float4 gg = *(const float4*)(g + k * 256 + lane * 4);
        uint2 o; o.x = pack2(v[k].x * rs * gg.x, v[k].y * rs * gg.y); o.y = pack2(v[k].z * rs * gg.z, v[k].w * rs * gg.w);
        *(uint2*)(dst + k * 256 + lane * 4) = o;
      }
    }
  }
  float2* R128 = (float2*)(ws + OFF_R128);
  float2* R64 = (float2*)(ws + OFF_R64);
  for (int idx = gt; idx < LT * 96; idx += gs) {
    const int t = idx / 96, f = idx - t * 96;
    float inv;
    if (f < 64) inv = powf(10000.f, -(float)(2 * f) / 128.f);
    else inv = powf(10000.f, -(float)(2 * (f - 64)) / 64.f);
    const float ang = (float)(t - 112) * inv;
    const double ad = (double)ang;
    const double n = rint(ad * 0.15915494309189535);
    const float rr = (float)(ad - n * 6.283185307179586);
    float2 cs; cs.x = __cosf(rr); cs.y = __sinf(rr);
    if (f < 64) R128[(size_t)t * 64 + f] = cs; else R64[(size_t)t * 32 + (f - 64)] = cs;
  }
}

DEV void phase_norm(const Params& p, int b, const float* __restrict__ g, bf16_t* __restrict__ dst) {
  const int lane = get_tid() & 63, wave = get_tid() >> 6;
  for (int row = get_bid() * 8 + wave; row < LT; row += gridDim.x * 8) {
    const float* src = hrow(p, b, row);
    float4 v[4]; float ss = 0.f;
#pragma unroll
    for (int k = 0; k < 4; k++) { v[k] = *(const float4*)(src + k * 256 + lane * 4); ss += v[k].x * v[k].x + v[k].y * v[k].y + v[k].z * v[k].z + v[k].w * v[k].w; }
#pragma unroll
    for (int o = 1; o < 64; o <<= 1) ss += shfl_xor_l(ss, o, lane);
    const float rs = rsqrtf(ss * (1.f / 1024.f) + 1e-6f);
#pragma unroll
    for (int k = 0; k < 4; k++) {
      float4 gg = *(const float4*)(g + k * 256 + lane * 4);
      uint2 o; o.x = pack2(v[k].x * rs * gg.x, v[k].y * rs * gg.y); o.y = pack2(v[k].z * rs * gg.z, v[k].w * rs * gg.w);
      *(uint2*)(dst + (size_t)row * 1024 + k * 256 + lane * 4) = o;
    }
  }
}

DEV void phase_final(const Params& p) {
  const float* g = p.in[14];
  const int lane = get_tid() & 63, wave = get_tid() >> 6;
  for (int row = get_bid() * 8 + wave; row < 2 * 8192; row += gridDim.x * 8) {
    const float* src = p.out + (size_t)row * 1024;
    float4 v[4]; float ss = 0.f;
#pragma unroll
    for (int k = 0; k < 4; k++) { v[k] = *(const float4*)(src + k * 256 + lane * 4); ss += v[k].x * v[k].x + v[k].y * v[k].y + v[k].z * v[k].z + v[k].w * v[k].w; }
#pragma unroll
    for (int o = 1; o < 64; o <<= 1) ss += shfl_xor_l(ss, o, lane);
    const float rs = rsqrtf(ss * (1.f / 1024.f) + 1e-6f);
#pragma unroll
    for (int k = 0; k < 4; k++) {
      float4 gg = *(const float4*)(g + k * 256 + lane * 4);
      float4 o = make_float4(v[k].x * rs * gg.x, v[k].y * rs * gg.y, v[k].z * rs * gg.z, v[k].w * rs * gg.w);
      *(float4*)(p.out + (size_t)row * 1024 + k * 256 + lane * 4) = o;
    }
  }
}

DEV void tile_map(int it, int MT, int NG, int& mt, int& nt) {
  const int ng = it / (MT * NG), rem = it - ng * (MT * NG);
  mt = rem / NG; nt = ng * NG + (rem - mt * NG);
}
DEV int vblock() { const int b = get_bid(), G = (int)gridDim.x; return ((G & 7) == 0) ? (b & 7) * (G >> 3) + (b >> 3) : b; }

DEV void phase_projA(const Params& p, int layer, int b, unsigned char* ldsraw) {
  unsigned char* ws = p.ws;
  bf16_t* lds = (bf16_t*)ldsraw;
  const bf16_t* HN = (const bf16_t*)(ws + OFF_HN) + (size_t)b * LT * 1024;
  const bf16_t* WIN = (const bf16_t*)(ws + OFF_WIN);
  const float2* R128 = (const float2*)(ws + OFF_R128);
  const float2* R64 = (const float2*)(ws + OFF_R64);
  for (int item = vblock(); item < 65 * 32; item += gridDim.x) {
    int nt, mt; tile_map(item, 65, 4, mt, nt);
    int n0, seg, segstart;
    if (nt < 8) { n0 = nt * 256; seg = nt < 2 ? 0 : (nt < 4 ? 1 : 2); segstart = seg == 0 ? 0 : (seg == 1 ? 512 : 1024); }
    else if (nt < 20) { n0 = 3072 + (nt - 8) * 256; seg = 3 + (nt - 8) / 4; segstart = 3072 + (seg - 3) * 1024; }
    else { n0 = 7168 + (nt - 20) * 256; seg = 6 + (nt - 20) / 4; segstart = 7168 + (seg - 6) * 1024; }
    const bf16_t* A = HN + (size_t)mt * 128 * 1024;
    const bf16_t* Bt = WIN + (size_t)n0 * 1024;
    f32x4 acc[2][8];
#pragma unroll
    for (int i = 0; i < 2; i++)
#pragma unroll
      for (int j = 0; j < 8; j++) acc[i][j] = (f32x4){0.f, 0.f, 0.f, 0.f};
    if (seg == 0 || seg == 3 || seg == 6 || seg == 7) {
      gemm_acc<256, false>(acc, A, 1024, Bt, 1024, 1024, lds);
      const int tid = get_tid(), lane = tid & 63, wave = tid >> 6, wm = wave >> 1, wn = wave & 1; const int lr = lane & 15, lg = lane >> 4; (void)tid; (void)lane; (void)wm; (void)wn; (void)lr; (void)lg;
      const int cw = (n0 - segstart) + wn * 128;
      bf16_t* dstb; int ld;
      if (seg == 0) { dstb = (bf16_t*)(ws + OFF_RQ); ld = 512; }
      else if (seg == 3) { dstb = (bf16_t*)(ws + OFF_HQ); ld = 1024; }
      else if (seg == 6) { dstb = (bf16_t*)(ws + OFF_DQ); ld = 1024; }
      else { dstb = (bf16_t*)(ws + OFF_DK); ld = 1024; }
#pragma unroll
      for (int i = 0; i < 2; i++) {
        const int t = mt * 128 + wm * 32 + i * 16 + lr;
        if (seg == 0) {
          const float2* tab = R128 + (size_t)t * 64;
#pragma unroll
          for (int j = 0; j < 4; j++)
#pragma unroll
            for (int r = 0; r < 4; r++) {
              float2 cs = tab[j * 16 + lg * 4 + r];
              float x1 = acc[i][j][r], x2 = acc[i][j + 4][r];
              acc[i][j][r] = x1 * cs.x - x2 * cs.y;
              acc[i][j + 4][r] = x2 * cs.x + x1 * cs.y;
            }
        } else if (seg == 6 || seg == 7) {
          const float2* tab = R64 + (size_t)t * 32;
          const float sc = (seg == 6) ? (0.125f * 1.4426950408889634f) : 1.f;
#pragma unroll
          for (int jq = 0; jq < 4; jq++) {
            const int j = (jq & 1) + (jq >> 1) * 4;
#pragma unroll
            for (int r = 0; r < 4; r++) {
              float2 cs = tab[(jq & 1) * 16 + lg * 4 + r];
              float x1 = acc[i][j][r], x2 = acc[i][j + 2][r];
              acc[i][j][r] = (x1 * cs.x - x2 * cs.y) * sc;
              acc[i][j + 2][r] = (x2 * cs.x + x1 * cs.y) * sc;
            }
          }
        }
        bf16_t* dst = dstb + (size_t)t * ld + cw;
#pragma unroll
        for (int j = 0; j < 8; j++) *(uint2*)(dst + j * 16 + lg * 4) = pack4(acc[i][j]);
      }
    } else {
      gemm_acc<256, true>(acc, A, 1024, Bt, 1024, 1024, lds);
      const int tid = get_tid(), lane = tid & 63, wave = tid >> 6, wm = wave >> 1, wn = wave & 1; const int lr = lane & 15, lg = lane >> 4; (void)tid; (void)lane; (void)wm; (void)wn; (void)lr; (void)lg;
      const int cw = (n0 - segstart) + wn * 128;
      if (seg == 1) {
        bf16_t* RK = (bf16_t*)(ws + OFF_RK);
        bf16_t* RKT = (bf16_t*)(ws + OFF_RKT);
        const int h = cw >> 7;
        const float l2g = log2f(1.f - ex2(-5.f - (float)h));
#pragma unroll
        for (int i = 0; i < 2; i++) {
          const int mb = wm * 32 + i * 16 + lg * 4;
#pragma unroll
          for (int j = 0; j < 4; j++)
#pragma unroll
            for (int r = 0; r < 4; r++) {
              const int t = mt * 128 + mb + r;
              float2 cs = R128[(size_t)t * 64 + j * 16 + lr];
              const float sc = (t >= 112) ? 0.08838834764831845f : 0.f;
              float x1 = acc[i][j][r], x2 = acc[i][j + 4][r];
              acc[i][j][r] = (x1 * cs.x - x2 * cs.y) * sc;
              acc[i][j + 4][r] = (x2 * cs.x + x1 * cs.y) * sc;
            }
#pragma unroll
          for (int j = 0; j < 8; j++) {
            const int col = cw + j * 16 + lr;
            f32x4 kd;
#pragma unroll
            for (int r = 0; r < 4; r++) {
              const int t = mt * 128 + mb + r;
              RK[(size_t)t * 512 + col] = f2bf(acc[i][j][r]);
              kd[r] = acc[i][j][r] * ex2(l2g * (float)(127 - (mb + r)));
            }
            *(uint2*)(RKT + (size_t)col * LT + mt * 128 + mb) = pack4(kd);
          }
        }
      } else if (seg == 2 || seg == 5 || seg == 8) {
        bf16_t* dT = (bf16_t*)(ws + (seg == 2 ? OFF_RVT : (seg == 5 ? OFF_HVT : OFF_DVT)));
#pragma unroll
        for (int i = 0; i < 2; i++) {
          const int mb = wm * 32 + i * 16 + lg * 4;
#pragma unroll
          for (int j = 0; j < 8; j++) {
            const int col = cw + j * 16 + lr;
            f32x4 v = acc[i][j];
            if (seg == 5) {
#pragma unroll
              for (int r = 0; r < 4; r++) if (mt * 128 + mb + r < 112) v[r] = 0.f;
            }
            *(uint2*)(dT + (size_t)col * LT + mt * 128 + mb) = pack4(v);
          }
        }
      } else {
        float* Lf = (float*)ldsraw;
        float* HCB = (float*)(ws + OFF_HCB);
        bf16_t* HK = (bf16_t*)(ws + OFF_HK);
        bf16_t* HKET = (bf16_t*)(ws + OFF_HKET);
        float* HDEC = (float*)(ws + OFF_HDEC);
        const float* lbp = p.in[6];
#pragma unroll
        for (int j = 0; j < 8; j++) {
          const int col = cw + j * 16 + lr;
          float lb = 0.f;
          if (layer == 1) lb = 1.f / (1.f + __expf(lbp[col] - lbp[1024 + col]));
#pragma unroll
          for (int i = 0; i < 2; i++)
#pragma unroll
            for (int r = 0; r < 4; r++) {
              const int m = wm * 32 + i * 16 + lg * 4 + r;
              const float z = acc[i][j][r];
              const float kk = (1.f - lb) / (1.f + __expf(z));
              const float lf = fmaxf(log1pf(-kk), -69.0776f);
              acc[i][j][r] = kk;
              Lf[m * 260 + wn * 128 + j * 16 + lr] = lf;
            }
        }
        __syncthreads();
        {
          const int colL = tid & 255, half = tid >> 8;
          float run = 0.f;
          for (int rr = 0; rr < 64; rr++) {
            float* q = &Lf[(half * 64 + rr) * 260 + colL];
            run += *q; *q = run;
          }
        }
        __syncthreads();
#pragma unroll
        for (int j = 0; j < 8; j++) {
          const int colL = wn * 128 + j * 16 + lr;
          const int col = cw + j * 16 + lr;
          const float ft = Lf[63 * 260 + colL];
          const float cend = Lf[127 * 260 + colL] + ft;
#pragma unroll
          for (int i = 0; i < 2; i++) {
            const int mb = wm * 32 + i * 16 + lg * 4;
            f32x4 ke;
#pragma unroll
            for (int r = 0; r < 4; r++) {
              const int m = mb + r;
              const int t = mt * 128 + m;
              const float cb = Lf[m * 260 + colL] + (m >= 64 ? ft : 0.f);
              HCB[(size_t)t * 1024 + col] = cb;
              HK[(size_t)t * 1024 + col] = f2bf(acc[i][j][r]);
              ke[r] = acc[i][j][r] * __expf(cend - cb);
              if (m == 127) HDEC[mt * 1024 + col] = __expf(cend);
            }
            *(uint2*)(HKET + (size_t)col * LT + mt * 128 + mb) = pack4(ke);
          }
        }
        __syncthreads();
      }
    }
  }
}

DEV void phase_U(const Params& p, unsigned char* ldsraw) {
  unsigned char* ws = p.ws;
  bf16_t* lds = (bf16_t*)ldsraw;
  for (int item = get_bid(); item < 1040; item += gridDim.x) {
    const bf16_t *A, *Bt; bf16_t* dst;
    if (item < 520) {
      const int h = item & 3, rest = item >> 2, mh = rest & 1, c = rest >> 1;
      A = (const bf16_t*)(ws + OFF_RVT) + (size_t)(h * 256 + mh * 128) * LT + c * 128;
      Bt = (const bf16_t*)(ws + OFF_RKT) + (size_t)(h * 128) * LT + c * 128;
      dst = (bf16_t*)(ws + OFF_STR) + ((size_t)(h * 65 + c) * 256 + mh * 128) * 128;
    } else {
      const int it = item - 520, h = it & 7, c = it >> 3;
      A = (const bf16_t*)(ws + OFF_HVT) + (size_t)(h * 128) * LT + c * 128;
      Bt = (const bf16_t*)(ws + OFF_HKET) + (size_t)(h * 128) * LT + c * 128;
      dst = (bf16_t*)(ws + OFF_STH) + ((size_t)(h * 65 + c) * 128) * 128;
    }
    f32x4 acc[2][4];
#pragma unroll
    for (int i = 0; i < 2; i++)
#pragma unroll
      for (int j = 0; j < 4; j++) acc[i][j] = (f32x4){0.f, 0.f, 0.f, 0.f};
    gemm_acc<128, false>(acc, A, LT, Bt, LT, 128, lds);
      const int tid = get_tid(), lane = tid & 63, wave = tid >> 6, wm = wave >> 1, wn = wave & 1; const int lr = lane & 15, lg = lane >> 4; (void)tid; (void)lane; (void)wm; (void)wn; (void)lr; (void)lg;
#pragma unroll
    for (int i = 0; i < 2; i++)
#pragma unroll
      for (int j = 0; j < 4; j++)
        *(uint2*)(dst + (size_t)(wm * 32 + i * 16 + lr) * 128 + wn * 64 + j * 16 + lg * 4) = pack4(acc[i][j]);
  }
}

DEV void phase_scan(const Params& p) {
  unsigned char* ws = p.ws;
  const float* HDEC = (const float*)(ws + OFF_HDEC);
  for (int task = get_bid() * NTHR + get_tid(); task < 65536; task += gridDim.x * NTHR) {
    bf16_t* base; size_t stride; int h, d4; bool hg;
    float dec0 = 0.f;
    if (task < 32768) {
      const int v = task; d4 = (v & 31) * 4; const int e = (v >> 5) & 255; h = v >> 13; hg = false;
      base = (bf16_t*)(ws + OFF_STR) + ((size_t)(h * 65) * 256 + e) * 128 + d4; stride = 256 * 128;
      dec0 = ex2(128.f * log2f(1.f - ex2(-5.f - (float)h)));
    } else {
      const int v = task - 32768; d4 = (v & 31) * 4; const int e = (v >> 5) & 127; h = v >> 12; hg = true;
      base = (bf16_t*)(ws + OFF_STH) + ((size_t)(h * 65) * 128 + e) * 128 + d4; stride = 128 * 128;
    }
    float c0 = 0.f, c1 = 0.f, c2 = 0.f, c3 = 0.f;
    for (int cg0 = 0; cg0 < 65; cg0 += 13) {
      uint2 u[13]; float4 dc[13];
#pragma unroll
      for (int k = 0; k < 13; k++) {
        u[k] = *(const uint2*)(base + (size_t)(cg0 + k) * stride);
        if (hg) dc[k] = *(const float4*)(HDEC + (size_t)(cg0 + k) * 1024 + h * 128 + d4);
        else dc[k] = make_float4(dec0, dec0, dec0, dec0);
      }
#pragma unroll
      for (int k = 0; k < 13; k++) {
        uint2 o; o.x = pack2(c0, c1); o.y = pack2(c2, c3);
        *(uint2*)(base + (size_t)(cg0 + k) * stride) = o;
        c0 = dc[k].x * c0 + bf2f((bf16_t)(u[k].x & 0xffff));
        c1 = dc[k].y * c1 + bf2f((bf16_t)(u[k].x >> 16));
        c2 = dc[k].z * c2 + bf2f((bf16_t)(u[k].y & 0xffff));
        c3 = dc[k].w * c3 + bf2f((bf16_t)(u[k].y >> 16));
      }
    }
  }
}

DEV void attn_item(const Params& p, int layer, int h, int qb, float lam, bf16_t* lds) {
  unsigned char* ws = p.ws;
  const bf16_t* DQ = (const bf16_t*)(ws + OFF_DQ);
  bf16_t* ODA = (bf16_t*)(ws + OFF_ODA);
  const bf16_t* DK = (const bf16_t*)(ws + OFF_DK);
  const bf16_t* DVT = (const bf16_t*)(ws + OFF_DVT);
  constexpr int PS = 136, XS = 132;
  constexpr int TS = 128 * PS;
  bf16_t* KV = lds;
  float* X = (float*)lds;
  const int tid = get_tid(), lane = tid & 63, wave = tid >> 6;
  const int lr = lane & 15, lg = lane >> 4;
  const int grp = wave >> 2, wq = wave & 3;
  const int t0 = qb * 128;
  const int lrow = tid >> 4, lc8 = (tid & 15) * 8;
  const bf16_t* gq = DQ + (size_t)(t0 + wq * 32 + lr) * 1024 + h * 128 + grp * 64 + lg * 8;
  const bf16x8 a00 = *(const bf16x8*)(gq);
  const bf16x8 a01 = *(const bf16x8*)(gq + 32);
  const bf16x8 a10 = *(const bf16x8*)(gq + (size_t)16 * 1024);
  const bf16x8 a11 = *(const bf16x8*)(gq + (size_t)16 * 1024 + 32);
  f32x4 o[2][8];
#pragma unroll
  for (int i = 0; i < 2; i++)
#pragma unroll
    for (int j = 0; j < 8; j++) o[i][j] = (f32x4){0.f, 0.f, 0.f, 0.f};
  float mrun0 = -1e30f, mrun1 = -1e30f, lrun0 = 0.f, lrun1 = 0.f;
  u32x4 rk0, rk1, rk2, rk3, rv0, rv1, rv2, rv3;
  const unsigned ko = (unsigned)(lrow * 1024 + h * 128 + lc8);
  const unsigned vo = (unsigned)((h * 128 + lrow) * LT + lc8);
#define ALOAD(kbn)                                                              \
  rk0 = *(const u32x4*)(DK + (ko + (unsigned)(kbn) * 131072u));                 \
  rk1 = *(const u32x4*)(DK + (ko + (unsigned)(kbn) * 131072u + 32768u));        \
  rk2 = *(const u32x4*)(DK + (ko + (unsigned)(kbn) * 131072u + 65536u));        \
  rk3 = *(const u32x4*)(DK + (ko + (unsigned)(kbn) * 131072u + 98304u));        \
  rv0 = *(const u32x4*)(DVT + (vo + (unsigned)(kbn) * 128u));                   \
  rv1 = *(const u32x4*)(DVT + (vo + (unsigned)(kbn) * 128u + 32u * LT));        \
  rv2 = *(const u32x4*)(DVT + (vo + (unsigned)(kbn) * 128u + 64u * LT));        \
  rv3 = *(const u32x4*)(DVT + (vo + (unsigned)(kbn) * 128u + 96u * LT));
#define ASTORE(sp)                                                              \
  *(u32x4*)((sp)) = rk0;                                                        \
  *(u32x4*)((sp) + 32 * PS) = rk1;                                              \
  *(u32x4*)((sp) + 64 * PS) = rk2;                                              \
  *(u32x4*)((sp) + 96 * PS) = rk3;                                              \
  *(u32x4*)((sp) + 2 * TS) = rv0;                                               \
  *(u32x4*)((sp) + 2 * TS + 32 * PS) = rv1;                                     \
  *(u32x4*)((sp) + 2 * TS + 64 * PS) = rv2;                                     \
  *(u32x4*)((sp) + 2 * TS + 96 * PS) = rv3;
  ALOAD(0)
  const int qrow0 = t0 + wq * 32 + lr;
  __syncthreads();
  ASTORE(KV + lrow * PS + lc8)
  {
    const int kb1 = qb > 0 ? 1 : 0;
    ALOAD(kb1)
  }
  __syncthreads();
  for (int kb = 0; kb <= qb; kb++) {
    const int cur = kb & 1;
    const bf16_t* kp = KV + cur * TS + lr * PS + grp * 64 + lg * 8;
    const bf16_t* vq = KV + 2 * TS + cur * TS + lr * PS + lg * 4;
    {
      bf16_t* sp = KV + (cur ^ 1) * TS + lrow * PS + lc8;
      ASTORE(sp)
    }
    __builtin_amdgcn_sched_barrier(0);
    f32x4 s[2][8];
    {
#pragma unroll
      for (int j = 0; j < 8; j++) {
        const bf16x8 kf0 = *(const bf16x8*)(kp + j * 16 * PS);
        const bf16x8 kf1 = *(const bf16x8*)(kp + j * 16 * PS + 32);
        s[0][j] = MFMA(kf0, a00, ((f32x4){0.f, 0.f, 0.f, 0.f}));
        s[1][j] = MFMA(kf0, a10, ((f32x4){0.f, 0.f, 0.f, 0.f}));
        s[0][j] = MFMA(kf1, a01, s[0][j]);
        s[1][j] = MFMA(kf1, a11, s[1][j]);
      }
    }
    __builtin_amdgcn_sched_barrier(0);
    {
      const int kbn = (kb + 2 <= qb) ? kb + 2 : qb;
      ALOAD(kbn)
    }
    __builtin_amdgcn_sched_barrier(0);
    if (kb == qb || kb == 0) {
#pragma unroll
      for (int i = 0; i < 2; i++)
#pragma unroll
        for (int j = 0; j < 8; j++)
#pragma unroll
          for (int r = 0; r < 4; r++) {
            const int key = kb * 128 + j * 16 + lg * 4 + r;
            if (key > qrow0 + 16 * i || key < 112) s[i][j][r] = -1e30f;
          }
    }
    float al[2];
#pragma unroll
    for (int i = 0; i < 2; i++) {
      float mx = -1e30f;
#pragma unroll
      for (int j = 0; j < 8; j++)
#pragma unroll
        for (int r = 0; r < 4; r++) mx = fmaxf(mx, s[i][j][r]);
      mx = fmaxf(mx, shfl_xor_l(mx, 16, lane));
      mx = fmaxf(mx, shfl_xor_l(mx, 32, lane));
      const float mold = i == 0 ? mrun0 : mrun1;
      const float mnew = fmaxf(mold, mx);
      al[i] = ex2(mold - mnew);
      float ps = 0.f;
#pragma unroll
      for (int j = 0; j < 8; j++)
#pragma unroll
        for (int r = 0; r < 4; r++) { const float pv = ex2(s[i][j][r] - mnew); s[i][j][r] = pv; ps += pv; }
      if (i == 0) { mrun0 = mnew; lrun0 = lrun0 * al[0] + ps; } else { mrun1 = mnew; lrun1 = lrun1 * al[1] + ps; }
    }
    if (__builtin_amdgcn_ballot_w64(al[0] != 1.f || al[1] != 1.f) != 0ull) {
#pragma unroll
      for (int i = 0; i < 2; i++) {
        float ao[4];
#pragma unroll
        for (int r = 0; r < 4; r++) ao[r] = shfl_l(al[i], lg * 4 + r);
#pragma unroll
        for (int je = 0; je < 8; je++)
#pragma unroll
          for (int r = 0; r < 4; r++) o[i][je][r] *= ao[r];
      }
    }
#pragma unroll
    for (int ks = 0; ks < 4; ks++) {
      union { u32x4 u; bf16x8 v; } pf0, pf1;
      pf0.u[0] = pack2(s[0][2 * ks][0], s[0][2 * ks][1]);
      pf0.u[1] = pack2(s[0][2 * ks][2], s[0][2 * ks][3]);
      pf0.u[2] = pack2(s[0][2 * ks + 1][0], s[0][2 * ks + 1][1]);
      pf0.u[3] = pack2(s[0][2 * ks + 1][2], s[0][2 * ks + 1][3]);
      pf1.u[0] = pack2(s[1][2 * ks][0], s[1][2 * ks][1]);
      pf1.u[1] = pack2(s[1][2 * ks][2], s[1][2 * ks][3]);
      pf1.u[2] = pack2(s[1][2 * ks + 1][0], s[1][2 * ks + 1][1]);
      pf1.u[3] = pack2(s[1][2 * ks + 1][2], s[1][2 * ks + 1][3]);
#pragma unroll
      for (int je = 0; je < 8; je++) {
        const bf16_t* vp = vq + je * 16 * PS + ks * 32;
        union { uint2 u[2]; bf16x8 v; } vf;
        vf.u[0] = *(const uint2*)vp;
        vf.u[1] = *(const uint2*)(vp + 16);
        o[0][je] = MFMA(pf0.v, vf.v, o[0][je]);
        o[1][je] = MFMA(pf1.v, vf.v, o[1][je]);
      }
    }
    __builtin_amdgcn_sched_barrier(0);
    __syncthreads();
  }
#undef ASTORE
#undef ALOAD
#pragma unroll
  for (int i = 0; i < 2; i++) {
    float l = i == 0 ? lrun0 : lrun1;
    l += shfl_xor_l(l, 16, lane);
    l += shfl_xor_l(l, 32, lane);
    const float inv = l > 0.f ? 1.f / l : 0.f;
#pragma unroll
    for (int r = 0; r < 4; r++) {
      const float ir = shfl_l(inv, lg * 4 + r);
#pragma unroll
      for (int je = 0; je < 8; je++) o[i][je][r] *= ir;
    }
  }
  __syncthreads();
  if (grp == 1) {
#pragma unroll
    for (int i = 0; i < 2; i++)
#pragma unroll
      for (int je = 0; je < 8; je++)
#pragma unroll
        for (int r = 0; r < 4; r++) X[(wq * 32 + i * 16 + lg * 4 + r) * XS + je * 16 + lr] = o[i][je][r];
  }
  __syncthreads();
  if (grp == 0) {
    int ly = layer; asm volatile("" : "+s"(ly));
    const float li = (ly == 0) ? 0.2f : 0.35550906759f;
    const float* sg = p.in[8] + ly * 128;
#pragma unroll
    for (int i = 0; i < 2; i++) {
      float ss[4] = {0.f, 0.f, 0.f, 0.f};
#pragma unroll
      for (int je = 0; je < 8; je++)
#pragma unroll
        for (int r = 0; r < 4; r++) {
          const float v = o[i][je][r] - lam * X[(wq * 32 + i * 16 + lg * 4 + r) * XS + je * 16 + lr];
          o[i][je][r] = v; ss[r] += v * v;
        }
#pragma unroll
      for (int r = 0; r < 4; r++) {
        float s2 = ss[r];
        s2 += shfl_xor_l(s2, 1, lane); s2 += shfl_xor_l(s2, 2, lane); s2 += shfl_xor_l(s2, 4, lane); s2 += shfl_xor_l(s2, 8, lane);
        ss[r] = rsqrtf(s2 * (1.f / 128.f) + 1e-6f) * (1.f - li);
      }
#pragma unroll
      for (int je = 0; je < 8; je++) {
        const float g = sg[je * 16 + lr];
#pragma unroll
        for (int r = 0; r < 4; r++)
          ODA[(size_t)(t0 + wq * 32 + i * 16 + lg * 4 + r) * 1024 + h * 128 + je * 16 + lr] = f2bf(o[i][je][r] * ss[r] * g);
      }
    }
  }
}

DEV void ret_item(const Params& p, int h, int c, bf16_t* lds) {
  unsigned char* ws = p.ws;
  const bf16_t* RQ = (const bf16_t*)(ws + OFF_RQ);
  const bf16_t* RK = (const bf16_t*)(ws + OFF_RK);
  const bf16_t* RVT = (const bf16_t*)(ws + OFF_RVT);
  const bf16_t* STR = (const bf16_t*)(ws + OFF_STR);
  bf16_t* ORET = (bf16_t*)(ws + OFF_ORET);
  constexpr int PS = 136;
  bf16_t* Qs = lds;
  bf16_t* Ks = lds + 128 * PS;
  bf16_t* Big = lds + 2 * 128 * PS;
  float* RED = (float*)(lds + 2 * 128 * PS + 256 * PS);
  const int tid = get_tid(), lane = tid & 63, wave = tid >> 6, wm = wave >> 1, wn = wave & 1;
  const int lr = lane & 15, lg = lane >> 4;
  const int t0 = c * 128;
  const int lrow = tid >> 4, lc8 = (tid & 15) * 8;
  const float l2g = log2f(1.f - ex2(-5.f - (float)h));
#pragma unroll
  for (int i = 0; i < 4; i++) {
    const int row = lrow + i * 32;
    *(uint4*)(Qs + row * PS + lc8) = *(const uint4*)(RQ + (size_t)(t0 + row) * 512 + h * 128 + lc8);
    *(uint4*)(Ks + row * PS + lc8) = *(const uint4*)(RK + (size_t)(t0 + row) * 512 + h * 128 + lc8);
  }
#pragma unroll
  for (int i = 0; i < 8; i++) {
    const int row = lrow + i * 32;
    *(uint4*)(Big + row * PS + lc8) = *(const uint4*)(STR + ((size_t)(h * 65 + c) * 256 + row) * 128 + lc8);
  }
  __syncthreads();
  f32x4 s[2][4];
  f32x4 o[2][8];
#pragma unroll
  for (int i = 0; i < 2; i++) {
#pragma unroll
    for (int j = 0; j < 4; j++) s[i][j] = (f32x4){0.f, 0.f, 0.f, 0.f};
#pragma unroll
    for (int j = 0; j < 8; j++) o[i][j] = (f32x4){0.f, 0.f, 0.f, 0.f};
  }
#pragma unroll
  for (int ks = 0; ks < 4; ks++) {
    bf16x8 a0 = ldfrag(Qs, PS, wm * 32 + lr, ks * 32 + lg * 8);
    bf16x8 a1 = ldfrag(Qs, PS, wm * 32 + 16 + lr, ks * 32 + lg * 8);
#pragma unroll
    for (int j = 0; j < 4; j++) {
      bf16x8 bb = ldfrag(Ks, PS, wn * 64 + j * 16 + lr, ks * 32 + lg * 8);
      s[0][j] = MFMA(bb, a0, s[0][j]);
      s[1][j] = MFMA(bb, a1, s[1][j]);
    }
#pragma unroll
    for (int j = 0; j < 8; j++) {
      bf16x8 bb = ldfrag(Big, PS, wn * 128 + j * 16 + lr, ks * 32 + lg * 8);
      o[0][j] = MFMA(bb, a0, o[0][j]);
      o[1][j] = MFMA(bb, a1, o[1][j]);
    }
    __builtin_amdgcn_sched_barrier(0);
  }
#pragma unroll
  for (int i = 0; i < 2; i++) {
    const int q = wm * 32 + i * 16 + lr;
    const float qd = ex2(l2g * (float)(q + 1));
#pragma unroll
    for (int j = 0; j < 8; j++)
#pragma unroll
      for (int r = 0; r < 4; r++) o[i][j][r] *= qd;
  }
  __syncthreads();
#pragma unroll
  for (int i = 0; i < 2; i++) {
    const int q = wm * 32 + i * 16 + lr;
#pragma unroll
    for (int j = 0; j < 4; j++) {
      f32x4 v;
#pragma unroll
      for (int r = 0; r < 4; r++) {
        const int key = wn * 64 + j * 16 + lg * 4 + r;
        v[r] = (key <= q) ? s[i][j][r] * ex2(l2g * (float)(q - key)) : 0.f;
      }
      *(uint2*)(Ks + q * PS + wn * 64 + j * 16 + lg * 4) = pack4(v);
    }
  }
#pragma unroll
  for (int i = 0; i < 8; i++) {
    const int row = lrow + i * 32;
    *(uint4*)(Big + row * PS + lc8) = *(const uint4*)(RVT + (size_t)(h * 256 + row) * LT + t0 + lc8);
  }
  __syncthreads();
#pragma unroll
  for (int ks = 0; ks < 4; ks++) {
    bf16x8 a0 = ldfrag(Ks, PS, wm * 32 + lr, ks * 32 + lg * 8);
    bf16x8 a1 = ldfrag(Ks, PS, wm * 32 + 16 + lr, ks * 32 + lg * 8);
#pragma unroll
    for (int j = 0; j < 8; j++) {
      bf16x8 bb = ldfrag(Big, PS, wn * 128 + j * 16 + lr, ks * 32 + lg * 8);
      o[0][j] = MFMA(bb, a0, o[0][j]);
      o[1][j] = MFMA(bb, a1, o[1][j]);
    }
    __builtin_amdgcn_sched_barrier(0);
  }
#pragma unroll
  for (int i = 0; i < 2; i++) {
    float ss = 0.f;
#pragma unroll
    for (int j = 0; j < 8; j++)
#pragma unroll
      for (int r = 0; r < 4; r++) ss += o[i][j][r] * o[i][j][r];
    ss += shfl_xor_l(ss, 16, lane);
    ss += shfl_xor_l(ss, 32, lane);
    if (lg == 0) RED[(wm * 32 + i * 16 + lr) * 2 + wn] = ss;
  }
  __syncthreads();
#pragma unroll
  for (int i = 0; i < 2; i++) {
    const int q = wm * 32 + i * 16 + lr;
    const float rs = rsqrtf((RED[q * 2] + RED[q * 2 + 1]) * (1.f / 256.f) + 1e-6f);
#pragma unroll
    for (int j = 0; j < 8; j++) {
      f32x4 v = o[i][j];
#pragma unroll
      for (int r = 0; r < 4; r++) v[r] *= rs;
      *(uint2*)(ORET + (size_t)(t0 + q) * 1024 + h * 256 + wn * 128 + j * 16 + lg * 4) = pack4(v);
    }
  }
}

DEV void hg_item(const Params& p, int h, int c, bf16_t* lds) {
  unsigned char* ws = p.ws;
  const bf16_t* HQ = (const bf16_t*)(ws + OFF_HQ);
  const bf16_t* HK = (const bf16_t*)(ws + OFF_HK);
  const float* HCB = (const float*)(ws + OFF_HCB);
  const bf16_t* HVT = (const bf16_t*)(ws + OFF_HVT);
  const bf16_t* STH = (const bf16_t*)(ws + OFF_STH);
  bf16_t* OHG = (bf16_t*)(ws + OFF_OHG);
  constexpr int PS = 136;
  bf16_t* Qp = lds;
  bf16_t* Kp = lds + 128 * PS;
  bf16_t* As = lds + 2 * 128 * PS;
  float* RED = (float*)(lds + 2 * 128 * PS + 256 * PS);
  const int tid = get_tid(), lane = tid & 63, wave = tid >> 6, wm = wave >> 1, wn = wave & 1;
  const int lr = lane & 15, lg = lane >> 4;
  const int t0 = c * 128, colb = h * 128;
  const int lrow = tid >> 4, lc8 = (tid & 15) * 8;
#pragma unroll
  for (int i = 0; i < 4; i++) {
    const int row = lrow + i * 32;
    const size_t g = (size_t)(t0 + row) * 1024 + colb + lc8;
    uint4 qv = *(const uint4*)(HQ + g);
    float4 c0 = *(const float4*)(HCB + g), c1 = *(const float4*)(HCB + g + 4);
    float4 r0 = make_float4(0.f, 0.f, 0.f, 0.f), r1 = r0;
    if (row >= 32) {
      const size_t gr = (size_t)(t0 + (row & ~31) - 1) * 1024 + colb + lc8;
      r0 = *(const float4*)(HCB + gr); r1 = *(const float4*)(HCB + gr + 4);
    }
    uint4 ov;
    ov.x = pack2(bf2f((bf16_t)(qv.x & 0xffff)) * __expf(c0.x - r0.x), bf2f((bf16_t)(qv.x >> 16)) * __expf(c0.y - r0.y));
    ov.y = pack2(bf2f((bf16_t)(qv.y & 0xffff)) * __expf(c0.z - r0.z), bf2f((bf16_t)(qv.y >> 16)) * __expf(c0.w - r0.w));
    ov.z = pack2(bf2f((bf16_t)(qv.z & 0xffff)) * __expf(c1.x - r1.x), bf2f((bf16_t)(qv.z >> 16)) * __expf(c1.y - r1.y));
    ov.w = pack2(bf2f((bf16_t)(qv.w & 0xffff)) * __expf(c1.z - r1.z), bf2f((bf16_t)(qv.w >> 16)) * __expf(c1.w - r1.w));
    *(uint4*)(Qp + row * PS + lc8) = ov;
  }
  for (int I = 0; I < 4; I++) {
    const int nrows = 32 * (I + 1);
    float4 r0 = make_float4(0.f, 0.f, 0.f, 0.f), r1 = r0;
    if (I > 0) {
      const size_t gr = (size_t)(t0 + 32 * I - 1) * 1024 + colb + lc8;
      r0 = *(const float4*)(HCB + gr); r1 = *(const float4*)(HCB + gr + 4);
    }
#pragma unroll
    for (int i = 0; i < 4; i++) {
      const int row = lrow + i * 32;
      if (row < nrows) {
        const size_t g = (size_t)(t0 + row) * 1024 + colb + lc8;
        uint4 kv = *(const uint4*)(HK + g);
        float4 c0 = *(const float4*)(HCB + g), c1 = *(const float4*)(HCB + g + 4);
        uint4 ov;
        ov.x = pack2(bf2f((bf16_t)(kv.x & 0xffff)) * __expf(fminf(r0.x - c0.x, 80.f)), bf2f((bf16_t)(kv.x >> 16)) * __expf(fminf(r0.y - c0.y, 80.f)));
        ov.y = pack2(bf2f((bf16_t)(kv.y & 0xffff)) * __expf(fminf(r0.z - c0.z, 80.f)), bf2f((bf16_t)(kv.y >> 16)) * __expf(fminf(r0.w - c0.w, 80.f)));
        ov.z = pack2(bf2f((bf16_t)(kv.z & 0xffff)) * __expf(fminf(r1.x - c1.x, 80.f)), bf2f((bf16_t)(kv.z >> 16)) * __expf(fminf(r1.y - c1.y, 80.f)));
        ov.w = pack2(bf2f((bf16_t)(kv.w & 0xffff)) * __expf(fminf(r1.z - c1.z, 80.f)), bf2f((bf16_t)(kv.w >> 16)) * __expf(fminf(r1.w - c1.w, 80.f)));
        *(uint4*)(Kp + row * PS + lc8) = ov;
      }
    }
    __syncthreads();
    if (wave * 16 < nrows) {
      f32x4 a2[2];
      a2[0] = (f32x4){0.f, 0.f, 0.f, 0.f}; a2[1] = a2[0];
#pragma unroll
      for (int ks = 0; ks < 4; ks++) {
        bf16x8 bb = ldfrag(Kp, PS, wave * 16 + lr, ks * 32 + lg * 8);
        bf16x8 a0 = ldfrag(Qp, PS, 32 * I + lr, ks * 32 + lg * 8);
        bf16x8 a1 = ldfrag(Qp, PS, 32 * I + 16 + lr, ks * 32 + lg * 8);
        a2[0] = MFMA(bb, a0, a2[0]);
        a2[1] = MFMA(bb, a1, a2[1]);
      }
#pragma unroll
      for (int i = 0; i < 2; i++) {
        const int q = 32 * I + i * 16 + lr;
        f32x4 v;
#pragma unroll
        for (int r = 0; r < 4; r++) { const int key = wave * 16 + lg * 4 + r; v[r] = (key <= q) ? a2[i][r] : 0.f; }
        *(uint2*)(As + q * PS + wave * 16 + lg * 4) = pack4(v);
      }
    } else {
#pragma unroll
      for (int i = 0; i < 2; i++) {
        const int q = 32 * I + i * 16 + lr;
        *(uint2*)(As + q * PS + wave * 16 + lg * 4) = make_uint2(0u, 0u);
      }
    }
    __syncthreads();
  }
#pragma unroll
  for (int i = 0; i < 4; i++) {
    const int row = lrow + i * 32;
    *(uint4*)(Kp + row * PS + lc8) = *(const uint4*)(HVT + (size_t)(colb + row) * LT + t0 + lc8);
  }
  __syncthreads();
  f32x4 o[2][4];
#pragma unroll
  for (int i = 0; i < 2; i++)
#pragma unroll
    for (int j = 0; j < 4; j++) o[i][j] = (f32x4){0.f, 0.f, 0.f, 0.f};
#pragma unroll
  for (int ks = 0; ks < 4; ks++) {
    bf16x8 a0 = ldfrag(As, PS, wm * 32 + lr, ks * 32 + lg * 8);
    bf16x8 a1 = ldfrag(As, PS, wm * 32 + 16 + lr, ks * 32 + lg * 8);
#pragma unroll
    for (int j = 0; j < 4; j++) {
      bf16x8 bb = ldfrag(Kp, PS, wn * 64 + j * 16 + lr, ks * 32 + lg * 8);
      o[0][j] = MFMA(bb, a0, o[0][j]);
      o[1][j] = MFMA(bb, a1, o[1][j]);
    }
    __builtin_amdgcn_sched_barrier(0);
  }
  __syncthreads();
#pragma unroll
  for (int i = 0; i < 4; i++) {
    const int row = lrow + i * 32;
    const size_t g = (size_t)(t0 + row) * 1024 + colb + lc8;
    uint4 qv = *(const uint4*)(HQ + g);
    float4 c0 = *(const float4*)(HCB + g), c1 = *(const float4*)(HCB + g + 4);
    uint4 ov;
    ov.x = pack2(bf2f((bf16_t)(qv.x & 0xffff)) * __expf(c0.x), bf2f((bf16_t)(qv.x >> 16)) * __expf(c0.y));
    ov.y = pack2(bf2f((bf16_t)(qv.y & 0xffff)) * __expf(c0.z), bf2f((bf16_t)(qv.y >> 16)) * __expf(c0.w));
    ov.z = pack2(bf2f((bf16_t)(qv.z & 0xffff)) * __expf(c1.x), bf2f((bf16_t)(qv.z >> 16)) * __expf(c1.y));
    ov.w = pack2(bf2f((bf16_t)(qv.w & 0xffff)) * __expf(c1.z), bf2f((bf16_t)(qv.w >> 16)) * __expf(c1.w));
    *(uint4*)(Qp + row * PS + lc8) = ov;
    *(uint4*)(Kp + row * PS + lc8) = *(const uint4*)(STH + ((size_t)(h * 65 + c) * 128 + row) * 128 + lc8);
  }
  __syncthreads();
#pragma unroll
  for (int ks = 0; ks < 4; ks++) {
    bf16x8 a0 = ldfrag(Qp, PS, wm * 32 + lr, ks * 32 + lg * 8);
    bf16x8 a1 = ldfrag(Qp, PS, wm * 32 + 16 + lr, ks * 32 + lg * 8);
#pragma unroll
    for (int j = 0; j < 4; j++) {
      bf16x8 bb = ldfrag(Kp, PS, wn * 64 + j * 16 + lr, ks * 32 + lg * 8);
      o[0][j] = MFMA(bb, a0, o[0][j]);
      o[1][j] = MFMA(bb, a1, o[1][j]);
    }
    __builtin_amdgcn_sched_barrier(0);
  }
#pragma unroll
  for (int i = 0; i < 2; i++) {
    float ss = 0.f;
#pragma unroll
    for (int j = 0; j < 4; j++)
#pragma unroll
      for (int r = 0; r < 4; r++) ss += o[i][j][r] * o[i][j][r];
    ss += shfl_xor_l(ss, 16, lane);
    ss += shfl_xor_l(ss, 32, lane);
    if (lg == 0) RED[(wm * 32 + i * 16 + lr) * 2 + wn] = ss;
  }
  __syncthreads();
#pragma unroll
  for (int i = 0; i < 2; i++) {
    const int q = wm * 32 + i * 16 + lr;
    const float rs = rsqrtf((RED[q * 2] + RED[q * 2 + 1]) * (1.f / 128.f) + 1e-6f);
#pragma unroll
    for (int j = 0; j < 4; j++) {
      f32x4 v = o[i][j];
#pragma unroll
      for (int r = 0; r < 4; r++) v[r] *= rs;
      *(uint2*)(OHG + (size_t)(t0 + q) * 1024 + colb + wn * 64 + j * 16 + lg * 4) = pack4(v);
    }
  }
}

DEV void phase_O(const Params& p, int layer, int qidx, unsigned char* ldsraw) {
  bf16_t* lds = (bf16_t*)ldsraw;
  int* ctr = (int*)(p.ws + OFF_CTR) + qidx;
  int* sitem = (int*)(ldsraw + LDS_BYTES - 16);
  const float* lp = p.in[7] + layer * 256;
  float d0 = 0.f, d1 = 0.f;
  for (int i = 0; i < 64; i++) { d0 += lp[i] * lp[64 + i]; d1 += lp[128 + i] * lp[192 + i]; }
  int ly = layer; asm volatile("" : "+s"(ly));
  const float li = (ly == 0) ? 0.2f : 0.35550906759f;
  const float lam = __uint_as_float(__builtin_amdgcn_readfirstlane(__float_as_uint(__expf(d0) - __expf(d1) + li)));
  const int tid0 = get_tid();
  for (;;) {
    __syncthreads();
    if (tid0 == 0) *sitem = atomicAdd(ctr, 1);
    __syncthreads();
    const int item = __builtin_amdgcn_readfirstlane(*sitem);
    if (item >= 1300) break;
    if (item < 520) attn_item(p, layer, item & 7, 64 - (item >> 3), lam, lds);
    else if (item < 780) ret_item(p, (item - 520) & 3, (item - 520) >> 2, lds);
    else hg_item(p, (item - 780) & 7, (item - 780) >> 3, lds);
  }
}

DEV void phase_G(const Params& p, int b, unsigned char* ldsraw) {
  unsigned char* ws = p.ws;
  bf16_t* lds = (bf16_t*)ldsraw;
  const bf16_t* HN = (const bf16_t*)(ws + OFF_HN) + (size_t)b * LT * 1024;
  const bf16_t* WIN = (const bf16_t*)(ws + OFF_WIN);
  for (int item = vblock(); item < 33 * 20; item += gridDim.x) {
    int nt, mt; tile_map(item, 33, 4, mt, nt);
    int n0, cb; bf16_t* dst; int ld; bool gate;
    if (nt < 4) { n0 = 2048 + nt * 256; cb = nt * 256; dst = (bf16_t*)(ws + OFF_ORET); ld = 1024; gate = true; }
    else if (nt < 8) { n0 = 6144 + (nt - 4) * 256; cb = (nt - 4) * 256; dst = (bf16_t*)(ws + OFF_OHG); ld = 1024; gate = true; }
    else { n0 = 10240 + (nt - 8) * 256; cb = (nt - 8) * 256; dst = (bf16_t*)(ws + OFF_G); ld = 3072; gate = false; }
    f32x4 acc[4][8];
#pragma unroll
    for (int i = 0; i < 4; i++)
#pragma unroll
      for (int j = 0; j < 8; j++) acc[i][j] = (f32x4){0.f, 0.f, 0.f, 0.f};
    gemm256_acc<256>(acc, HN + (size_t)mt * 256 * 1024, 1024, LT - mt * 256, WIN + (size_t)n0 * 1024, 1024, 1024, lds);
    const int tid = get_tid(), lane = tid & 63, wave = tid >> 6, wm = wave >> 1, wn = wave & 1; const int lr = lane & 15, lg = lane >> 4;
#pragma unroll
    for (int i = 0; i < 4; i++) {
      const int t = mt * 256 + wm * 64 + i * 16 + lr;
      if (t < LT) {
#pragma unroll
        for (int j = 0; j < 8; j++) {
          bf16_t* d = dst + (size_t)t * ld + cb + wn * 128 + j * 16 + lg * 4;
          f32x4 v;
          if (gate) {
            uint2 ov = *(const uint2*)d;
            v[0] = bf2f((bf16_t)(ov.x & 0xffff)) * silu_f(acc[i][j][0]);
            v[1] = bf2f((bf16_t)(ov.x >> 16)) * silu_f(acc[i][j][1]);
            v[2] = bf2f((bf16_t)(ov.y & 0xffff)) * silu_f(acc[i][j][2]);
            v[3] = bf2f((bf16_t)(ov.y >> 16)) * silu_f(acc[i][j][3]);
          } else {
#pragma unroll
            for (int r = 0; r < 4; r++) v[r] = sigmoid_f(acc[i][j][r]);
          }
          *(uint2*)d = pack4(v);
        }
      }
    }
  }
}

DEV f32x4 mini_gemm16(const bf16_t* __restrict__ A16, int lda, const bf16_t* __restrict__ Bt16, int ldb, int k0, int klen, int lane) {
  const int lr = lane & 15, lg = lane >> 4;
  const bf16_t* pa = A16 + (size_t)lr * lda + k0 + lg * 8;
  const bf16_t* pb = Bt16 + (size_t)lr * ldb + k0 + lg * 8;
  f32x4 acc = (f32x4){0.f, 0.f, 0.f, 0.f};
#pragma unroll 4
  for (int k = 0; k < klen; k += 32) {
    bf16x8 a = *(const bf16x8*)(pa + k);
    bf16x8 b = *(const bf16x8*)(pb + k);
    acc = MFMA(b, a, acc);
  }
  return acc;
}

DEV void phase_Y(const Params& p, unsigned char* ldsraw) {
  unsigned char* ws = p.ws;
  bf16_t* lds = (bf16_t*)ldsraw;
  const bf16_t* WB = (const bf16_t*)(ws + OFF_WB);
  const bf16_t* G = (const bf16_t*)(ws + OFF_G);
  bf16_t* Y = (bf16_t*)(ws + OFF_Y);
  for (int item = vblock(); item < 32 * 8 + 64; item += gridDim.x) {
    if (item >= 256) {
      const int lane = get_tid() & 63, wave = get_tid() >> 6, lr = lane & 15, lg = lane >> 4;
      const int n0 = (item - 256) * 16;
      f32x4* red = (f32x4*)ldsraw;
      __syncthreads();
#pragma unroll 1
      for (int br = 0; br < 3; br++) {
        const bf16_t* Ab = (const bf16_t*)(ws + (br == 0 ? OFF_ORET : (br == 1 ? OFF_OHG : OFF_ODA))) + (size_t)112 * 1024;
        red[(br * 8 + wave) * 64 + lane] = mini_gemm16(Ab, 1024, WB + ((size_t)br * 1024 + n0) * 1024, 1024, wave * 128, 128, lane);
      }
      __syncthreads();
      if (wave == 0) {
        f32x4 y = (f32x4){0.f, 0.f, 0.f, 0.f};
#pragma unroll
        for (int br = 0; br < 3; br++) {
          f32x4 a = red[(br * 8) * 64 + lane];
#pragma unroll
          for (int w = 1; w < 8; w++) a += red[(br * 8 + w) * 64 + lane];
          uint2 gv = *(const uint2*)(G + (size_t)(112 + lr) * 3072 + br * 1024 + n0 + lg * 4);
          y[0] += bf2f((bf16_t)(gv.x & 0xffff)) * a[0];
          y[1] += bf2f((bf16_t)(gv.x >> 16)) * a[1];
          y[2] += bf2f((bf16_t)(gv.y & 0xffff)) * a[2];
          y[3] += bf2f((bf16_t)(gv.y >> 16)) * a[3];
        }
        *(uint2*)(Y + (size_t)(112 + lr) * 1024 + n0 + lg * 4) = pack4(y);
      }
      continue;
    }
    int nt, mt; tile_map(item, 32, 4, mt, nt);
    const int row0 = 128 + mt * 256;
    f32x4 y[4][4];
#pragma unroll
    for (int i = 0; i < 4; i++)
#pragma unroll
      for (int j = 0; j < 4; j++) y[i][j] = (f32x4){0.f, 0.f, 0.f, 0.f};
#pragma unroll 1
    for (int br = 0; br < 3; br++) {
      const bf16_t* Ab = (const bf16_t*)(ws + (br == 0 ? OFF_ORET : (br == 1 ? OFF_OHG : OFF_ODA))) + (size_t)row0 * 1024;
      f32x4 acc[4][4];
#pragma unroll
      for (int i = 0; i < 4; i++)
#pragma unroll
        for (int j = 0; j < 4; j++) acc[i][j] = (f32x4){0.f, 0.f, 0.f, 0.f};
      gemm256_acc<128>(acc, Ab, 1024, 256, WB + ((size_t)br * 1024 + nt * 128) * 1024, 1024, 1024, lds);
      const int tid = get_tid(), lane = tid & 63, wave = tid >> 6, wm = wave >> 1, wn = wave & 1; const int lr = lane & 15, lg = lane >> 4;
#pragma unroll
      for (int i = 0; i < 4; i++) {
        const int t = row0 + wm * 64 + i * 16 + lr;
#pragma unroll
        for (int j = 0; j < 4; j++) {
          uint2 gv = *(const uint2*)(G + (size_t)t * 3072 + br * 1024 + nt * 128 + wn * 64 + j * 16 + lg * 4);
          y[i][j][0] += bf2f((bf16_t)(gv.x & 0xffff)) * acc[i][j][0];
          y[i][j][1] += bf2f((bf16_t)(gv.x >> 16)) * acc[i][j][1];
          y[i][j][2] += bf2f((bf16_t)(gv.y & 0xffff)) * acc[i][j][2];
          y[i][j][3] += bf2f((bf16_t)(gv.y >> 16)) * acc[i][j][3];
        }
      }
    }
    const int tid = get_tid(), lane = tid & 63, wave = tid >> 6, wm = wave >> 1, wn = wave & 1; const int lr = lane & 15, lg = lane >> 4;
#pragma unroll
    for (int i = 0; i < 4; i++) {
      const int t = row0 + wm * 64 + i * 16 + lr;
#pragma unroll
      for (int j = 0; j < 4; j++)
        *(uint2*)(Y + (size_t)t * 1024 + nt * 128 + wn * 64 + j * 16 + lg * 4) = pack4(y[i][j]);
    }
  }
}

DEV void phase_resid(const Params& p, int b, const bf16_t* A, int K, const bf16_t* Wt, unsigned char* ldsraw) {
  bf16_t* lds = (bf16_t*)ldsraw;
  for (int item = vblock(); item < 32 * 8 + 64; item += gridDim.x) {
    if (item >= 256) {
      const int lane = get_tid() & 63, wave = get_tid() >> 6, lr = lane & 15, lg = lane >> 4;
      const int n0 = (item - 256) * 16;
      f32x4* red = (f32x4*)ldsraw;
      const int ks = K >> 3;
      __syncthreads();
      red[wave * 64 + lane] = mini_gemm16(A + (size_t)112 * K, K, Wt + (size_t)n0 * K, K, wave * ks, ks, lane);
      __syncthreads();
      if (wave == 0) {
        f32x4 a = red[lane];
#pragma unroll
        for (int w = 1; w < 8; w++) a += red[w * 64 + lane];
        float4* d = (float4*)(hrow(p, b, 112 + lr) + n0 + lg * 4);
        float4 v = *d;
        v.x += a[0]; v.y += a[1]; v.z += a[2]; v.w += a[3];
        *d = v;
      }
      continue;
    }
    int nt, mt; tile_map(item, 32, 4, mt, nt);
    const int row0 = 128 + mt * 256;
    f32x4 acc[4][4];
#pragma unroll
    for (int i = 0; i < 4; i++)
#pragma unroll
      for (int j = 0; j < 4; j++) acc[i][j] = (f32x4){0.f, 0.f, 0.f, 0.f};
    gemm256_acc<128>(acc, A + (size_t)row0 * K, K, 256, Wt + (size_t)nt * 128 * K, K, K, lds);
    const int tid = get_tid(), lane = tid & 63, wave = tid >> 6, wm = wave >> 1, wn = wave & 1; const int lr = lane & 15, lg = lane >> 4;
#pragma unroll
    for (int i = 0; i < 4; i++) {
      const int t = row0 + wm * 64 + i * 16 + lr;
#pragma unroll
      for (int j = 0; j < 4; j++) {
        float4* d = (float4*)(hrow(p, b, t) + nt * 128 + wn * 64 + j * 16 + lg * 4);
        float4 v = *d;
        v.x += acc[i][j][0]; v.y += acc[i][j][1]; v.z += acc[i][j][2]; v.w += acc[i][j][3];
        *d = v;
      }
    }
  }
}

DEV void phase_F1(const Params& p, int b, unsigned char* ldsraw) {
  unsigned char* ws = p.ws;
  bf16_t* lds = (bf16_t*)ldsraw;
  const bf16_t* HN = (const bf16_t*)(ws + OFF_HN) + (size_t)b * LT * 1024;
  const bf16_t* WFI = (const bf16_t*)(ws + OFF_WFI);
  bf16_t* U = (bf16_t*)(ws + OFF_U);
  for (int item = vblock(); item < 33 * 22; item += gridDim.x) {
    int nt, mt; tile_map(item, 33, 2, mt, nt);
    f32x4 acc[4][8];
#pragma unroll
    for (int i = 0; i < 4; i++)
#pragma unroll
      for (int j = 0; j < 8; j++) acc[i][j] = (f32x4){0.f, 0.f, 0.f, 0.f};
    gemm256_acc<256>(acc, HN + (size_t)mt * 256 * 1024, 1024, LT - mt * 256, WFI + (size_t)nt * 256 * 1024, 1024, 1024, lds);
    const int tid = get_tid(), lane = tid & 63, wave = tid >> 6, wm = wave >> 1, wn = wave & 1; const int lr = lane & 15, lg = lane >> 4;
#pragma unroll
    for (int i = 0; i < 4; i++) {
      const int t = mt * 256 + wm * 64 + i * 16 + lr;
      if (t < LT) {
        const float vm = (t >= 112) ? 1.f : 0.f;
#pragma unroll
        for (int j = 0; j < 8; j++) {
          f32x4 v = acc[i][j];
#pragma unroll
          for (int r = 0; r < 4; r++) v[r] *= vm;
          *(uint2*)(U + (size_t)t * 5632 + nt * 256 + wn * 128 + j * 16 + lg * 4) = pack4(v);
        }
      }
    }
  }
}

DEV void unpack8(const u32x4 v, float (&f)[8]) {
#pragma unroll
  for (int k = 0; k < 4; k++) { f[2 * k] = bf2f((bf16_t)(v[k] & 0xffff)); f[2 * k + 1] = bf2f((bf16_t)(v[k] >> 16)); }
}
DEV void phase_conv(const Params& p, int layer) {
  unsigned char* ws = p.ws;
  const bf16_t* U = (const bf16_t*)(ws + OFF_U);
  bf16_t* GF = (bf16_t*)(ws + OFF_GF);
  const float* cw = p.in[11] + (size_t)layer * 3 * 5632;
  const float* cbias = p.in[12] + (size_t)layer * 5632;
  for (int idx = get_bid() * NTHR + get_tid(); idx < (LT / 8) * 352; idx += gridDim.x * NTHR) {
    const int tb = idx / 352, c8 = (idx - tb * 352) * 8;
    const int t0 = tb * 8;
    float wg[3][8], wv[3][8], bg[8], bv[8];
#pragma unroll
    for (int k = 0; k < 8; k++) {
      bg[k] = cbias[c8 + k]; bv[k] = cbias[2816 + c8 + k];
#pragma unroll
      for (int j = 0; j < 3; j++) { wg[j][k] = cw[j * 5632 + c8 + k]; wv[j][k] = cw[j * 5632 + 2816 + c8 + k]; }
    }
    float g0[8], g1[8], v0[8], v1[8];
    if (t0 >= 2) {
      unpack8(*(const u32x4*)(U + (size_t)(t0 - 2) * 5632 + c8), g0);
      unpack8(*(const u32x4*)(U + (size_t)(t0 - 2) * 5632 + 2816 + c8), v0);
      unpack8(*(const u32x4*)(U + (size_t)(t0 - 1) * 5632 + c8), g1);
      unpack8(*(const u32x4*)(U + (size_t)(t0 - 1) * 5632 + 2816 + c8), v1);
    } else {
#pragma unroll
      for (int k = 0; k < 8; k++) { g0[k] = 0.f; g1[k] = 0.f; v0[k] = 0.f; v1[k] = 0.f; }
    }
#pragma unroll
    for (int tt = 0; tt < 8; tt++) {
      float g2[8], v2[8];
      unpack8(*(const u32x4*)(U + (size_t)(t0 + tt) * 5632 + c8), g2);
      unpack8(*(const u32x4*)(U + (size_t)(t0 + tt) * 5632 + 2816 + c8), v2);
      float og[8];
#pragma unroll
      for (int k = 0; k < 8; k++) {
        const float gg = bg[k] + wg[0][k] * g0[k] + wg[1][k] * g1[k] + wg[2][k] * g2[k];
        const float vv = bv[k] + wv[0][k] * v0[k] + wv[1][k] * v1[k] + wv[2][k] * v2[k];
        og[k] = silu_f(gg) * vv;
        g0[k] = g1[k]; g1[k] = g2[k]; v0[k] = v1[k]; v1[k] = v2[k];
      }
      u32x4 o;
      o[0] = pack2(og[0], og[1]); o[1] = pack2(og[2], og[3]); o[2] = pack2(og[4], og[5]); o[3] = pack2(og[6], og[7]);
      *(u32x4*)(GF + (size_t)(t0 + tt) * 2816 + c8) = o;
    }
  }
}

#define XB_TMO      128
#define XB_XCNT(j)  (256  + 64 * (j))
#define XB_XSUB(j)  (1280 + 64 * (j))
#define XB_XGEN(j)  (2304 + 64 * (j))
#define XB_TOP      3328
#define XB_TOPGEN   3392
#define XB_SPIN_CAP (1u << 18)
#define LAS __attribute__((address_space(3)))
DEV unsigned xb_ld(unsigned* p) { return __hip_atomic_load(p, __ATOMIC_RELAXED, __HIP_MEMORY_SCOPE_AGENT); }
DEV unsigned xb_add(unsigned* p, unsigned v) { return __hip_atomic_fetch_add(p, v, __ATOMIC_RELAXED, __HIP_MEMORY_SCOPE_AGENT); }
DEV unsigned xb_xcc_id() { return (unsigned)__builtin_amdgcn_s_getreg((3 << 11) | 20) & 0xFu; }
#define XB_SPIN(cond, bar) do { unsigned _sp = 0; while (cond) { __builtin_amdgcn_s_sleep(1); \
    if ((++_sp & 255u) == 0u) { if (xb_ld(&(bar)[XB_TMO])) break; if (_sp > XB_SPIN_CAP) { atomicAdd(&(bar)[XB_TMO], 1u); break; } } } } while (0)
struct XcdBarrier { unsigned* bar; unsigned x; volatile LAS unsigned* st; };
DEV XcdBarrier xcd_barrier_post(unsigned* bar, volatile LAS unsigned* st) {
  XcdBarrier b; b.bar = bar; b.x = xb_xcc_id(); b.st = st;
  if (threadIdx.x == 0) (void)xb_add(&bar[XB_XCNT(b.x)], 1u);
  return b;
}
DEV void xcd_barrier_complete(unsigned* bar, unsigned x, unsigned& nloc, unsigned& nx) {
  const unsigned G = gridDim.x;
  unsigned sum, cnt, mine, sp = 0u;
  for (;;) {
    sum = 0u; cnt = 0u; mine = 0u;
#pragma unroll
    for (unsigned j = 0; j < 16; ++j) { const unsigned c = xb_ld(&bar[XB_XCNT(j)]); sum += c; cnt += (c > 0u) ? 1u : 0u; mine = (j == x) ? c : mine; }
    if (sum == G) break;
    __builtin_amdgcn_s_sleep(1);
    if ((++sp & 255u) == 0u) { if (xb_ld(&bar[XB_TMO])) break; if (sp > XB_SPIN_CAP) { atomicAdd(&bar[XB_TMO], 1u); break; } }
  }
  nloc = mine > 0u ? mine : 1u; nx = cnt > 0u ? cnt : 1u;
}
DEV void xcd_barrier(const XcdBarrier& b) {
  asm volatile("s_waitcnt vmcnt(0)" ::: "memory");
  __syncthreads();
  if (threadIdx.x == 0) {
    unsigned* bar = b.bar;
    __builtin_amdgcn_s_waitcnt(0);
    unsigned nloc = b.st[0], nx = b.st[1];
    if (nloc == 0u) { xcd_barrier_complete(bar, b.x, nloc, nx); b.st[0] = nloc; b.st[1] = nx; }
    const unsigned old = xb_add(&bar[XB_XSUB(b.x)], 1u);
    const unsigned gen = old / nloc;
    if (old + 1u == (gen + 1u) * nloc) {
      __builtin_amdgcn_fence(__ATOMIC_RELEASE, "agent");
      asm volatile("s_waitcnt vmcnt(0)" ::: "memory");
      const unsigned og = xb_add(&bar[XB_TOP], 1u);
      const unsigned tg = og / nx;
      if (og + 1u == (tg + 1u) * nx) xb_add(&bar[XB_TOPGEN], 1u);
      else XB_SPIN(xb_ld(&bar[XB_TOPGEN]) == tg, bar);
      __builtin_amdgcn_fence(__ATOMIC_ACQUIRE, "agent");
      xb_add(&bar[XB_XGEN(b.x)], 1u);
      asm volatile("s_waitcnt vmcnt(0)" ::: "memory");
    } else {
      XB_SPIN(xb_ld(&bar[XB_XGEN(b.x)]) == gen, bar);
      __builtin_amdgcn_fence(__ATOMIC_ACQUIRE, "agent");
      asm volatile("s_waitcnt vmcnt(0)" ::: "memory");
    }
  }
  __syncthreads();
}

__global__ void __launch_bounds__(NTHR) fwd_megakernel(Params p) {
  extern __shared__ __attribute__((aligned(16))) unsigned char lds[];
  cg::grid_group grid = cg::this_grid();
  volatile LAS unsigned* xst = (volatile LAS unsigned*)(lds + LDS_BYTES - 12);
  if (threadIdx.x == 0) { xst[0] = 0u; xst[1] = 0u; }
  __syncthreads();
  (void)xcd_barrier_post((unsigned*)(p.ws + OFF_XBAR), xst);
#define GRID_SYNC() do { XcdBarrier xb_; xb_.bar = (unsigned*)(p.ws + OFF_XBAR); xb_.x = xb_xcc_id(); \
    xb_.st = (volatile LAS unsigned*)(lds + LDS_BYTES - 12); xcd_barrier(xb_); } while (0)
  grid.sync();
  unsigned char* ws = p.ws;
  phase_init(p);
  phase_convert(p, 0, lds);
  GRID_SYNC();
  for (int layer = 0; layer < 2; layer++) {
    if (layer == 1) {
      phase_convert(p, 1, lds);
#pragma unroll 1
      for (int bb = 0; bb < 2; bb++)
        phase_norm(p, bb, p.in[2] + 1024, (bf16_t*)(ws + OFF_HN) + (size_t)bb * LT * 1024);
      GRID_SYNC();
    }
    for (int b = 0; b < 2; b++) {
      bf16_t* HNb = (bf16_t*)(ws + OFF_HN) + (size_t)b * LT * 1024;
      phase_projA(p, layer, b, lds);
      GRID_SYNC();
      phase_U(p, lds);
      GRID_SYNC();
      phase_scan(p);
      GRID_SYNC();
      phase_O(p, layer, layer * 2 + b, lds);
      GRID_SYNC();
      phase_G(p, b, lds);
      GRID_SYNC();
      phase_Y(p, lds);
      GRID_SYNC();
      phase_resid(p, b, (const bf16_t*)(ws + OFF_Y), 1024, (const bf16_t*)(ws + OFF_WO), lds);
      GRID_SYNC();
      phase_norm(p, b, p.in[9] + layer * 1024, HNb);
      GRID_SYNC();
      phase_F1(p, b, lds);
      GRID_SYNC();
      phase_conv(p, layer);
      GRID_SYNC();
      phase_resid(p, b, (const bf16_t*)(ws + OFF_GF), DFF, (const bf16_t*)(ws + OFF_WFO), lds);
      GRID_SYNC();
    }
  }
  phase_final(p);
}

extern "C" void kernel_launch(void* const* d_in, const int* in_sizes, int n_in, void* d_out, int out_size,
                              void* d_ws, size_t ws_size, hipStream_t stream) {
  static int grid_blocks = 0;
  if (grid_blocks == 0) {
    if (n_in != 15 || ws_size < OFF_END) {
      fprintf(stderr, "kernel_launch: need 15 inputs and %zu bytes of workspace, got %d and %zu\n", (size_t)OFF_END, n_in, ws_size);
      grid_blocks = -1; return;
    }
    int dev = 0, cus = 0, per_cu = 0;
    hipGetDevice(&dev);
    hipDeviceGetAttribute(&cus, hipDeviceAttributeMultiprocessorCount, dev);
    if (hipFuncSetAttribute((const void*)fwd_megakernel, hipFuncAttributeMaxDynamicSharedMemorySize, LDS_BYTES) != hipSuccess) {
      fprintf(stderr, "kernel_launch: hipFuncSetAttribute failed\n"); grid_blocks = -1; return;
    }
    hipOccupancyMaxActiveBlocksPerMultiprocessor(&per_cu, (const void*)fwd_megakernel, NTHR, LDS_BYTES);
    if (per_cu < 1) per_cu = 1;
    if (per_cu > 1) per_cu = 1;
    grid_blocks = cus * per_cu;
  }
  if (grid_blocks < 0) return;
  hipMemsetAsync((char*)d_ws + OFF_CTR, 0, 256 + XBAR_BYTES, stream);
  Params p{};
  for (int i = 0; i < 15; i++) p.in[i] = (const float*)d_in[i];
  p.out = (float*)d_out;
  p.ws = (unsigned char*)d_ws;
  void* args[] = {&p};
  hipError_t e = hipLaunchCooperativeKernel((const void*)fwd_megakernel, dim3(grid_blocks), dim3(NTHR), args, LDS_BYTES, stream);
  if (e != hipSuccess) fprintf(stderr, "cooperative launch failed: %s (grid %d)\n", hipGetErrorString(e), grid_blocks);
}
```

```cpp
#include <hip/hip_runtime.h>
#include <hip/hip_cooperative_groups.h>
#include <cstdio>
#include <cstdint>
namespace cg = cooperative_groups;

typedef unsigned short bf16_t;
typedef __attribute__((ext_vector_type(8))) short bf16x8;
typedef __attribute__((ext_vector_type(4))) short bf16x4;
typedef __attribute__((ext_vector_type(4))) float f32x4;
typedef __attribute__((ext_vector_type(4))) unsigned u32x4;

#define DEV __device__ __forceinline__
#define MFMA(a, b, c) __builtin_amdgcn_mfma_f32_16x16x32_bf16(a, b, c, 0, 0, 0)

constexpr int LT = 8320;
constexpr int NCH = 65;
constexpr int NTHR = 512;
constexpr int LDS_BYTES = 144 * 1024;
constexpr int INW = 13312;
constexpr int DFF = 2816;

constexpr size_t SZ_ACT = (size_t)LT * 1024 * 2;
constexpr size_t OFF_WIN = 0;
constexpr size_t OFF_WB = OFF_WIN + (size_t)INW * 1024 * 2;
constexpr size_t OFF_WO = OFF_WB + (size_t)3 * 1024 * 1024 * 2;
constexpr size_t OFF_WFI = OFF_WO + (size_t)1024 * 1024 * 2;
constexpr size_t OFF_WFO = OFF_WFI + (size_t)5632 * 1024 * 2;
constexpr size_t OFF_H = OFF_WFO + (size_t)1024 * 2816 * 2;
constexpr size_t OFF_HN = OFF_H + (size_t)2 * 128 * 1024 * 4;
constexpr size_t OFF_R128 = OFF_HN + 2 * SZ_ACT;
constexpr size_t OFF_R64 = OFF_R128 + (size_t)LT * 64 * 8;
constexpr size_t OFF_CTR = OFF_R64 + (size_t)LT * 32 * 8;
constexpr size_t OFF_XBAR = OFF_CTR + 256;
constexpr size_t XBAR_BYTES = 3456 * 4;
constexpr size_t OFF_ARENA = OFF_XBAR + XBAR_BYTES;
constexpr size_t OFF_RQ = OFF_ARENA;
constexpr size_t OFF_RK = OFF_RQ + SZ_ACT / 2;
constexpr size_t OFF_RKT = OFF_RK + SZ_ACT / 2;
constexpr size_t OFF_RVT = OFF_RKT + SZ_ACT / 2;
constexpr size_t OFF_HQ = OFF_RVT + SZ_ACT;
constexpr size_t OFF_HK = OFF_HQ + SZ_ACT;
constexpr size_t OFF_HCB = OFF_HK + SZ_ACT;
constexpr size_t OFF_HKET = OFF_HCB + 2 * SZ_ACT;
constexpr size_t OFF_HVT = OFF_HKET + SZ_ACT;
constexpr size_t OFF_DQ = OFF_HVT + SZ_ACT;
constexpr size_t OFF_DK = OFF_DQ + SZ_ACT;
constexpr size_t OFF_DVT = OFF_DK + SZ_ACT;
constexpr size_t OFF_ORET = OFF_DVT + SZ_ACT;
constexpr size_t OFF_OHG = OFF_ORET + SZ_ACT;
constexpr size_t OFF_STR = OFF_OHG + SZ_ACT;
constexpr size_t OFF_STH = OFF_STR + SZ_ACT;
constexpr size_t OFF_HDEC = OFF_STH + SZ_ACT;
constexpr size_t OFF_END = OFF_HDEC + (size_t)65 * 1024 * 4;
constexpr size_t OFF_G = OFF_RQ;
constexpr size_t OFF_Y = OFF_HK;
constexpr size_t OFF_ODA = OFF_HKET;
constexpr size_t OFF_U = OFF_ARENA;
constexpr size_t OFF_GF = OFF_U + (size_t)LT * 5632 * 2;

struct Params {
  const float* in[15];
  float* out;
  unsigned char* ws;
};

DEV int get_tid() { int t = threadIdx.x; asm volatile("" : "+v"(t)); return t; }
DEV int get_bid() { int b = blockIdx.x; asm volatile("" : "+s"(b)); return b; }
DEV float shfl_xor_l(float v, int m, int lane) { return __int_as_float(__builtin_amdgcn_ds_bpermute((lane ^ m) << 2, __float_as_int(v))); }
DEV float shfl_l(float v, int srclane) { return __int_as_float(__builtin_amdgcn_ds_bpermute(srclane << 2, __float_as_int(v))); }
DEV float* hrow(const Params& p, int b, int t) {
  return (t < 128) ? (float*)(p.ws + OFF_H) + (size_t)(b * 128 + t) * 1024 : p.out + ((size_t)b * 8192 + (t - 128)) * 1024;
}
typedef __bf16 hwbf16x2 __attribute__((ext_vector_type(2)));
typedef float hwf32x2 __attribute__((ext_vector_type(2)));
DEV unsigned pack2(float a, float b) {
  hwf32x2 f = {a, b};
  hwbf16x2 h = __builtin_convertvector(f, hwbf16x2);
  return __builtin_bit_cast(unsigned, h);
}
DEV bf16_t f2bf(float f) { return (bf16_t)(pack2(f, f) & 0xffffu); }
DEV float bf2f(bf16_t h) { return __uint_as_float(((unsigned)h) << 16); }
DEV uint2 pack4(f32x4 v) { uint2 r; r.x = pack2(v[0], v[1]); r.y = pack2(v[2], v[3]); return r; }
DEV float silu_f(float x) { return x / (1.f + __expf(-x)); }
DEV float sigmoid_f(float x) { return 1.f / (1.f + __expf(-x)); }
DEV float ex2(float x) { return __builtin_amdgcn_exp2f(x); }
DEV bf16x8 ldfrag(const bf16_t* base, int stride, int row, int k) {
  return *(const bf16x8*)(base + row * stride + k);
}

template <int BN, bool TRANS>
DEV void gemm_compute(f32x4 (&acc)[2][BN / 32], const bf16_t* as, const bf16_t* bs) {
  constexpr int NJ = BN / 32, LS = 72;
#pragma unroll
  for (int ks = 0; ks < 2; ks++) {
    bf16x8 a0 = *(const bf16x8*)(as + ks * 32);
    bf16x8 a1 = *(const bf16x8*)(as + 16 * LS + ks * 32);
#pragma unroll
    for (int j = 0; j < NJ; j++) {
      bf16x8 bb = *(const bf16x8*)(bs + j * 16 * LS + ks * 32);
      if (TRANS) {
        acc[0][j] = MFMA(a0, bb, acc[0][j]);
        acc[1][j] = MFMA(a1, bb, acc[1][j]);
      } else {
        acc[0][j] = MFMA(bb, a0, acc[0][j]);
        acc[1][j] = MFMA(bb, a1, acc[1][j]);
      }
    }
  }
}

template <int BN, bool TRANS>
DEV void gemm_acc(f32x4 (&acc)[2][BN / 32], const bf16_t* __restrict__ A, int lda,
                  const bf16_t* __restrict__ Bt, int ldb, int K, bf16_t* lds) {
  constexpr int LS = 72, A_SZ = 128 * LS, B_SZ = BN * LS, NB = BN / 64;
  const int tid = get_tid(), lane = tid & 63, wave = tid >> 6, wm = wave >> 1, wn = wave & 1;
  const int lr = lane & 15, lg = lane >> 4;
  bf16_t* As = lds;
  bf16_t* Bs = lds + 2 * A_SZ;
  const int crow = tid >> 3, ckc = (tid & 7) * 8;
  const bf16_t* ga = A + (size_t)crow * lda + ckc;
  const bf16_t* gb = Bt + (size_t)crow * ldb + ckc;
  u32x4 ra0, ra1, rb0, rb1, rb2, rb3;
#define GLOAD(k0)                                                        \
  ra0 = *(const u32x4*)(ga + (k0));                                      \
  ra1 = *(const u32x4*)(ga + (size_t)64 * lda + (k0));                   \
  rb0 = *(const u32x4*)(gb + (k0));                                      \
  rb1 = *(const u32x4*)(gb + (size_t)64 * ldb + (k0));                   \
  if (NB == 4) {                                                         \
    rb2 = *(const u32x4*)(gb + (size_t)128 * ldb + (k0));                \
    rb3 = *(const u32x4*)(gb + (size_t)192 * ldb + (k0));                \
  }
#define LSTORE(buf)                                                      \
  *(u32x4*)(As + (buf) * A_SZ + crow * LS + ckc) = ra0;                  \
  *(u32x4*)(As + (buf) * A_SZ + (crow + 64) * LS + ckc) = ra1;           \
  *(u32x4*)(Bs + (buf) * B_SZ + crow * LS + ckc) = rb0;                  \
  *(u32x4*)(Bs + (buf) * B_SZ + (crow + 64) * LS + ckc) = rb1;           \
  if (NB == 4) {                                                         \
    *(u32x4*)(Bs + (buf) * B_SZ + (crow + 128) * LS + ckc) = rb2;        \
    *(u32x4*)(Bs + (buf) * B_SZ + (crow + 192) * LS + ckc) = rb3;        \
  }
  const int nk = K / 64;
  const int aoff = (wm * 32 + lr) * LS + lg * 8;
  const int boff = (wn * (BN / 2) + lr) * LS + lg * 8;
  GLOAD(0)
  __syncthreads();
  LSTORE(0)
  GLOAD(64)
  __syncthreads();
  for (int kt = 0; kt < nk; kt++) {
    const int cur = kt & 1;
    LSTORE(cur ^ 1)
    {
      const int kn = (kt + 2 < nk) ? kt + 2 : nk - 1;
      GLOAD(kn * 64)
    }
    __builtin_amdgcn_sched_barrier(0);
    gemm_compute<BN, TRANS>(acc, As + cur * A_SZ + aoff, Bs + cur * B_SZ + boff);
    __syncthreads();
  }
#undef GLOAD
#undef LSTORE
}

template <int BN>
DEV void gemm256_compute(f32x4 (&acc)[4][BN / 32], const bf16_t* as, const bf16_t* bs) {
  constexpr int LS = 72, NJ = BN / 32;
#pragma unroll
  for (int ks = 0; ks < 2; ks++) {
    bf16x8 a[4];
#pragma unroll
    for (int i = 0; i < 4; i++) a[i] = *(const bf16x8*)(as + i * 16 * LS + ks * 32);
#pragma unroll
    for (int j = 0; j < NJ; j++) {
      bf16x8 bb = *(const bf16x8*)(bs + j * 16 * LS + ks * 32);
#pragma unroll
      for (int i = 0; i < 4; i++) acc[i][j] = MFMA(bb, a[i], acc[i][j]);
    }
  }
}

template <int BN>
DEV void gemm256_acc(f32x4 (&acc)[4][BN / 32], const bf16_t* __restrict__ A, int lda, int m_valid,
                     const bf16_t* __restrict__ Bt, int ldb, int K, bf16_t* lds) {
  constexpr int LS = 72, A_SZ = 256 * LS, B_SZ = BN * LS, NB = BN / 64;
  const int tid = get_tid(), lane = tid & 63, wave = tid >> 6, wm = wave >> 1, wn = wave & 1;
  const int lr = lane & 15, lg = lane >> 4;
  bf16_t* As = lds;
  bf16_t* Bs = lds + 2 * A_SZ;
  const int crow = tid >> 3, ckc = (tid & 7) * 8;
  const bf16_t* ga0 = A + (size_t)min(crow, m_valid - 1) * lda + ckc;
  const bf16_t* ga1 = A + (size_t)min(crow + 64, m_valid - 1) * lda + ckc;
  const bf16_t* ga2 = A + (size_t)min(crow + 128, m_valid - 1) * lda + ckc;
  const bf16_t* ga3 = A + (size_t)min(crow + 192, m_valid - 1) * lda + ckc;
  const bf16_t* gb = Bt + (size_t)crow * ldb + ckc;
  u32x4 ra0, ra1, ra2, ra3, rb0, rb1, rb2, rb3;
#define GLOAD(k0)                                                        \
  ra0 = *(const u32x4*)(ga0 + (k0));                                     \
  ra1 = *(const u32x4*)(ga1 + (k0));                                     \
  ra2 = *(const u32x4*)(ga2 + (k0));                                     \
  ra3 = *(const u32x4*)(ga3 + (k0));                                     \
  rb0 = *(const u32x4*)(gb + (k0));                                      \
  rb1 = *(const u32x4*)(gb + (size_t)64 * ldb + (k0));                   \
  if (NB == 4) {                                                         \
    rb2 = *(const u32x4*)(gb + (size_t)128 * ldb + (k0));                \
    rb3 = *(const u32x4*)(gb + (size_t)192 * ldb + (k0));                \
  }
#define LSTORE(buf)                                                      \
  *(u32x4*)(As + (buf) * A_SZ + crow * LS + ckc) = ra0;                  \
  *(u32x4*)(As + (buf) * A_SZ + (crow + 64) * LS + ckc) = ra1;           \
  *(u32x4*)(As + (buf) * A_SZ + (crow + 128) * LS + ckc) = ra2;          \
  *(u32x4*)(As + (buf) * A_SZ + (crow + 192) * LS + ckc) = ra3;          \
  *(u32x4*)(Bs + (buf) * B_SZ + crow * LS + ckc) = rb0;                  \
  *(u32x4*)(Bs + (buf) * B_SZ + (crow + 64) * LS + ckc) = rb1;           \
  if (NB == 4) {                                                         \
    *(u32x4*)(Bs + (buf) * B_SZ + (crow + 128) * LS + ckc) = rb2;        \
    *(u32x4*)(Bs + (buf) * B_SZ + (crow + 192) * LS + ckc) = rb3;        \
  }
  const int nk = K / 64;
  const int aoff = (wm * 64 + lr) * LS + lg * 8;
  const int boff = (wn * (BN / 2) + lr) * LS + lg * 8;
  GLOAD(0)
  __syncthreads();
  LSTORE(0)
  GLOAD(64)
  __syncthreads();
  for (int kt = 0; kt < nk; kt++) {
    const int cur = kt & 1;
    LSTORE(cur ^ 1)
    {
      const int kn = (kt + 2 < nk) ? kt + 2 : nk - 1;
      GLOAD(kn * 64)
    }
    __builtin_amdgcn_sched_barrier(0);
    gemm256_compute<BN>(acc, As + cur * A_SZ + aoff, Bs + cur * B_SZ + boff);
    __syncthreads();
  }
#undef GLOAD
#undef LSTORE
}

DEV void tconv_tiles4(const float* __restrict__ src, int K, int N, bf16_t* __restrict__ dst, int idx0, int ntn, float* tile) {
  const int tid = get_tid();
  const int r = tid >> 4, c4 = (tid & 15) * 4;
  float4 v[4][2];
#pragma unroll
  for (int u = 0; u < 4; u++) {
    const int idx = idx0 + u, tk = idx / ntn, tn = idx - tk * ntn;
#pragma unroll
    for (int i = 0; i < 2; i++) v[u][i] = *(const float4*)(src + (size_t)(tk * 64 + r + i * 32) * N + tn * 64 + c4);
  }
  __syncthreads();
#pragma unroll
  for (int u = 0; u < 4; u++)
#pragma unroll
    for (int i = 0; i < 2; i++) {
      float* t = tile + u * (64 * 65) + (r + i * 32) * 65 + c4;
      t[0] = v[u][i].x; t[1] = v[u][i].y; t[2] = v[u][i].z; t[3] = v[u][i].w;
    }
  __syncthreads();
  const int n = tid >> 3, k8 = (tid & 7) * 8;
#pragma unroll
  for (int u = 0; u < 4; u++) {
    const int idx = idx0 + u, tk = idx / ntn, tn = idx - tk * ntn;
    const float* t = tile + u * (64 * 65);
    u32x4 o;
    o[0] = pack2(t[(k8 + 0) * 65 + n], t[(k8 + 1) * 65 + n]);
    o[1] = pack2(t[(k8 + 2) * 65 + n], t[(k8 + 3) * 65 + n]);
    o[2] = pack2(t[(k8 + 4) * 65 + n], t[(k8 + 5) * 65 + n]);
    o[3] = pack2(t[(k8 + 6) * 65 + n], t[(k8 + 7) * 65 + n]);
    *(u32x4*)(dst + (size_t)(tn * 64 + n) * K + tk * 64 + k8) = o;
  }
}

DEV void phase_convert(const Params& p, int layer, unsigned char* lds) {
  unsigned char* ws = p.ws;
  float* tile = (float*)lds;
  for (int g = get_bid(); g < 1616; g += gridDim.x) {
    const float* src; bf16_t* dst; int K, N, gi;
    if (g < 832) { gi = g; src = p.in[3] + (size_t)layer * 1024 * INW; K = 1024; N = INW; dst = (bf16_t*)(ws + OFF_WIN); }
    else if (g < 832 + 192) { gi = g - 832; const int br = gi >> 6; gi &= 63; src = p.in[4] + ((size_t)layer * 3 + br) * 1024 * 1024; K = 1024; N = 1024; dst = (bf16_t*)(ws + OFF_WB) + (size_t)br * 1024 * 1024; }
    else if (g < 1088) { gi = g - 1024; src = p.in[5] + (size_t)layer * 1024 * 1024; K = 1024; N = 1024; dst = (bf16_t*)(ws + OFF_WO); }
    else if (g < 1440) { gi = g - 1088; src = p.in[10] + (size_t)layer * 1024 * 5632; K = 1024; N = 5632; dst = (bf16_t*)(ws + OFF_WFI); }
    else { gi = g - 1440; src = p.in[13] + (size_t)layer * 2816 * 1024; K = 2816; N = 1024; dst = (bf16_t*)(ws + OFF_WFO); }
    tconv_tiles4(src, K, N, dst, gi * 4, N / 64, (float*)tile);
  }
}

DEV void phase_init(const Params& p) {
  unsigned char* ws = p.ws;
  const int gt = get_bid() * NTHR + get_tid(), gs = gridDim.x * NTHR;
  {
    const int lane = get_tid() & 63, wave = get_tid() >> 6;
    const float* g = p.in[2];
    for (int row = get_bid() * 8 + wave; row < 2 * LT; row += gridDim.x * 8) {
      const int b = row / LT, t = row - b * LT;
      float4 v[4]; float ss = 0.f;
#pragma unroll
      for (int k = 0; k < 4; k++) {
        const int c4 = k * 256 + lane * 4;
        if (t < 112) v[k] = make_float4(0.f, 0.f, 0.f, 0.f);
        else if (t < 128) v[k] = *(const float4*)(p.in[1] + (size_t)(t - 112) * 1024 + c4);
        else v[k] = *(const float4*)(p.in[0] + ((size_t)b * 8192 + (t - 128)) * 1024 + c4);
        *(float4*)(hrow(p, b, t) + c4) = v[k];
        ss += v[k].x * v[k].x + v[k].y * v[k].y + v[k].z * v[k].z + v[k].w * v[k].w;
      }
#pragma unroll
      for (int o = 1; o < 64; o <<= 1) ss += shfl_xor_l(ss, o, lane);
      const float rs = rsqrtf(ss * (1.f / 1024.f) + 1e-6f);
      bf16_t* dst = (bf16_t*)(ws + OFF_HN) + (size_t)b * LT * 1024 + (size_t)t * 1024;
#pragma unroll
      for (int k = 0; k < 4; k++) {
        float4 gg = *(const float4*)(g + k * 256 + lane * 4);
        uint2 o; o.x = pack2(v[k].x * rs * gg.x, v[k].y * rs * gg.y); o.y = pack2(v[k].z * rs * gg.z, v[k].w * rs * gg.w);
        *(uint2*)(dst + k * 256 + lane * 4) = o;
      }
    }
  }
  float2* R128 = (float2*)(ws + OFF_R128);
  float2* R64 = (float2*)(ws + OFF_R64);
  for (int idx = gt; idx < LT * 96; idx += gs) {
    const int t = idx / 96, f = idx - t * 96;
    float inv;
    if (f < 64) inv = powf(10000.f, -(float)(2 * f) / 128.f);
    else inv = powf(10000.f, -(float)(2 * (f - 64)) / 64.f);
    const float ang = (float)(t - 112) * inv;
    const double ad = (double)ang;
    const double n = rint(ad * 0.15915494309189535);
    const float rr = (float)(ad - n * 6.283185307179586);
    float2 cs; cs.x = __cosf(rr); cs.y = __sinf(rr);
    if (f < 64) R128[(size_t)t * 64 + f] = cs; else R64[(size_t)t * 32 + (f - 64)] = cs;
  }
}

DEV void phase_norm(const Params& p, int b, const float* __restrict__ g, bf16_t* __restrict__ dst) {
  const int lane = get_tid() & 63, wave = get_tid() >> 6;
  for (int row = get_bid() * 8 + wave; row < LT; row += gridDim.x * 8) {
    const float* src = hrow(p, b, row);
    float4 v[4]; float ss = 0.f;
#pragma unroll
    for (int k = 0; k < 4; k++) { v[k] = *(const float4*)(src + k * 256 + lane * 4); ss += v[k].x * v[k].x + v[k].y * v[k].y + v[k].z * v[k].z + v[k].w * v[k].w; }
#pragma unroll
    for (int o = 1; o < 64; o <<= 1) ss += shfl_xor_l(ss, o, lane);
    const float rs = rsqrtf(ss * (1.f / 1024.f) + 1e-6f);
#pragma unroll
    for (int k = 0; k < 4; k++) {
      float4 gg = *(const float4*)(g + k * 256 + lane * 4);
      uint2 o; o.x = pack2(v[k].x * rs * gg.x, v[k].y * rs * gg.y); o.y = pack2(v[k].z * rs * gg.z, v[k].w * rs * gg.w);
      *(uint2*)(dst + (size_t)row * 1024 + k * 256 + lane * 4) = o;
    }
  }
}

DEV void phase_final(const Params& p) {
  const float* g = p.in[14];
  const int lane = get_tid() & 63, wave = get_tid() >> 6;
  for (int row = get_bid() * 8 + wave; row < 2 * 8192; row += gridDim.x * 8) {
    const float* src = p.out + (size_t)row * 1024;
    float4 v[4]; float ss = 0.f;
#pragma unroll
    for (int k = 0; k < 4; k++) { v[k] = *(const float4*)(src + k * 256 + lane * 4); ss += v[k].x * v[k].x + v[k].y * v[k].y + v[k].z * v[k].z + v[k].w * v[k].w; }
#pragma unroll
    for (int o = 1; o < 64; o <<= 1) ss += shfl_xor_l(ss, o, lane);
    const float rs = rsqrtf(ss * (1.f / 1024.f) + 1e-6f);
#pragma unroll
    for (int k = 0; k < 4; k++) {
      float4 gg = *(const float4*)(g + k * 256 + lane * 4);
      float4 o = make_float4(v[k].x * rs * gg.x, v[k].y * rs * gg.y, v[k].z * rs * gg.z, v[k].w * rs * gg.w);
      *(float4*)(p.out + (size_t)row * 1024 + k * 256 + lane * 4) = o;
    }
  }
}

DEV void tile_map(int it, int MT, int NG, int& mt, int& nt) {
  const int ng = it / (MT * NG), rem = it - ng * (MT * NG);
  mt = rem / NG; nt = ng * NG + (rem - mt * NG);
}
DEV int vblock() { const int b = get_bid(), G = (int)gridDim.x; return ((G & 7) == 0) ? (b & 7) * (G >> 3) + (b >> 3) : b; }

DEV void phase_projA(const Params& p, int layer, int b, unsigned char* ldsraw) {
  unsigned char* ws = p.ws;
  bf16_t* lds = (bf16_t*)ldsraw;
  const bf16_t* HN = (const bf16_t*)(ws + OFF_HN) + (size_t)b * LT * 1024;
  const bf16_t* WIN = (const bf16_t*)(ws + OFF_WIN);
  const float2* R128 = (const float2*)(ws + OFF_R128);
  const float2* R64 = (const float2*)(ws + OFF_R64);
  for (int item = vblock(); item < 65 * 32; item += gridDim.x) {
    int nt, mt; tile_map(item, 65, 4, mt, nt);
    int n0, seg, segstart;
    if (nt < 8) { n0 = nt * 256; seg = nt < 2 ? 0 : (nt < 4 ? 1 : 2); segstart = seg == 0 ? 0 : (seg == 1 ? 512 : 1024); }
    else if (nt < 20) { n0 = 3072 + (nt - 8) * 256; seg = 3 + (nt - 8) / 4; segstart = 3072 + (seg - 3) * 1024; }
    else { n0 = 7168 + (nt - 20) * 256; seg = 6 + (nt - 20) / 4; segstart = 7168 + (seg - 6) * 1024; }
    const bf16_t* A = HN + (size_t)mt * 128 * 1024;
    const bf16_t* Bt = WIN + (size_t)n0 * 1024;
    f32x4 acc[2][8];
#pragma unroll
    for (int i = 0; i < 2; i++)
#pragma unroll
      for (int j = 0; j < 8; j++) acc[i][j] = (f32x4){0.f, 0.f, 0.f, 0.f};
    if (seg == 0 || seg == 3 || seg == 6 || seg == 7) {
      gemm_acc<256, false>(acc, A, 1024, Bt, 1024, 1024, lds);
      const int tid = get_tid(), lane = tid & 63, wave = tid >> 6, wm = wave >> 1, wn = wave & 1; const int lr = lane & 15, lg = lane >> 4; (void)tid; (void)lane; (void)wm; (void)wn; (void)lr; (void)lg;
      const int cw = (n0 - segstart) + wn * 128;
      bf16_t* dstb; int ld;
      if (seg == 0) { dstb = (bf16_t*)(ws + OFF_RQ); ld = 512; }
      else if (seg == 3) { dstb = (bf16_t*)(ws + OFF_HQ); ld = 1024; }
      else if (seg == 6) { dstb = (bf16_t*)(ws + OFF_DQ); ld = 1024; }
      else { dstb = (bf16_t*)(ws + OFF_DK); ld = 1024; }
#pragma unroll
      for (int i = 0; i < 2; i++) {
        const int t = mt * 128 + wm * 32 + i * 16 + lr;
        if (seg == 0) {
          const float2* tab = R128 + (size_t)t * 64;
#pragma unroll
          for (int j = 0; j < 4; j++)
#pragma unroll
            for (int r = 0; r < 4; r++) {
              float2 cs = tab[j * 16 + lg * 4 + r];
              float x1 = acc[i][j][r], x2 = acc[i][j + 4][r];
              acc[i][j][r] = x1 * cs.x - x2 * cs.y;
              acc[i][j + 4][r] = x2 * cs.x + x1 * cs.y;
            }
        } else if (seg == 6 || seg == 7) {
          const float2* tab = R64 + (size_t)t * 32;
          const float sc = (seg == 6) ? (0.125f * 1.4426950408889634f) : 1.f;
#pragma unroll
          for (int jq = 0; jq < 4; jq++) {
            const int j = (jq & 1) + (jq >> 1) * 4;
#pragma unroll
            for (int r = 0; r < 4; r++) {
              float2 cs = tab[(jq & 1) * 16 + lg * 4 + r];
              float x1 = acc[i][j][r], x2 = acc[i][j + 2][r];
              acc[i][j][r] = (x1 * cs.x - x2 * cs.y) * sc;
              acc[i][j + 2][r] = (x2 * cs.x + x1 * cs.y) * sc;
            }
          }
        }
        bf16_t* dst = dstb + (size_t)t * ld + cw;
#pragma unroll
        for (int j = 0; j < 8; j++) *(uint2*)(dst + j * 16 + lg * 4) = pack4(acc[i][j]);
      }
    } else {
      gemm_acc<256, true>(acc, A, 1024, Bt, 1024, 1024, lds);
      const int tid = get_tid(), lane = tid & 63, wave = tid >> 6, wm = wave >> 1, wn = wave & 1; const int lr = lane & 15, lg = lane >> 4; (void)tid; (void)lane; (void)wm; (void)wn; (void)lr; (void)lg;
      const int cw = (n0 - segstart) + wn * 128;
      if (seg == 1) {
        bf16_t* RK = (bf16_t*)(ws + OFF_RK);
        bf16_t* RKT = (bf16_t*)(ws + OFF_RKT);
        const int h = cw >> 7;
        const float l2g = log2f(1.f - ex2(-5.f - (float)h));
#pragma unroll
        for (int i = 0; i < 2; i++) {
          const int mb = wm * 32 + i * 16 + lg * 4;
#pragma unroll
          for (int j = 0; j < 4; j++)
#pragma unroll
            for (int r = 0; r < 4; r++) {
              const int t = mt * 128 + mb + r;
              float2 cs = R128[(size_t)t * 64 + j * 16 + lr];
              const float sc = (t >= 112) ? 0.08838834764831845f : 0.f;
              float x1 = acc[i][j][r], x2 = acc[i][j + 4][r];
              acc[i][j][r] = (x1 * cs.x - x2 * cs.y) * sc;
              acc[i][j + 4][r] = (x2 * cs.x + x1 * cs.y) * sc;
            }
#pragma unroll
          for (int j = 0; j < 8; j++) {
            const int col = cw + j * 16 + lr;
            f32x4 kd;
#pragma unroll
            for (int r = 0; r < 4; r++) {
              const int t = mt * 128 + mb + r;
              RK[(size_t)t * 512 + col] = f2bf(acc[i][j][r]);
              kd[r] = acc[i][j][r] * ex2(l2g * (float)(127 - (mb + r)));
            }
            *(uint2*)(RKT + (size_t)col * LT + mt * 128 + mb) = pack4(kd);
          }
        }
      } else if (seg == 2 || seg == 5 || seg == 8) {
        bf16_t* dT = (bf16_t*)(ws + (seg == 2 ? OFF_RVT : (seg == 5 ? OFF_HVT : OFF_DVT)));
#pragma unroll
        for (int i = 0; i < 2; i++) {
          const int mb = wm * 32 + i * 16 + lg * 4;
#pragma unroll
          for (int j = 0; j < 8; j++) {
            const int col = cw + j * 16 + lr;
            f32x4 v = acc[i][j];
            if (seg == 5) {
#pragma unroll
              for (int r = 0; r < 4; r++) if (mt * 128 + mb + r < 112) v[r] = 0.f;
            }
            *(uint2*)(dT + (size_t)col * LT + mt * 128 + mb) = pack4(v);
          }
        }
      } else {
        float* Lf = (float*)ldsraw;
        float* HCB = (float*)(ws + OFF_HCB);
        bf16_t* HK = (bf16_t*)(ws + OFF_HK);
        bf16_t* HKET = (bf16_t*)(ws + OFF_HKET);
        float* HDEC = (float*)(ws + OFF_HDEC);
        const float* lbp = p.in[6];
#pragma unroll
        for (int j = 0; j < 8; j++) {
          const int col = cw + j * 16 + lr;
          float lb = 0.f;
          if (layer == 1) lb = 1.f / (1.f + __expf(lbp[col] - lbp[1024 + col]));
#pragma unroll
          for (int i = 0; i < 2; i++)
#pragma unroll
            for (int r = 0; r < 4; r++) {
              const int m = wm * 32 + i * 16 + lg * 4 + r;
              const float z = acc[i][j][r];
              const float kk = (1.f - lb) / (1.f + __expf(z));
              const float lf = fmaxf(log1pf(-kk), -69.0776f);
              acc[i][j][r] = kk;
              Lf[m * 260 + wn * 128 + j * 16 + lr] = lf;
            }
        }
        __syncthreads();
        {
          const int colL = tid & 255, half = tid >> 8;
          float run = 0.f;
          for (int rr = 0; rr < 64; rr++) {
            float* q = &Lf[(half * 64 + rr) * 260 + colL];
            run += *q; *q = run;
          }
        }
        __syncthreads();
#pragma unroll
        for (int j = 0; j < 8; j++) {
          const int colL = wn * 128 + j * 16 + lr;
          const int col = cw + j * 16 + lr;
          const float ft = Lf[63 * 260 + colL];
          const float cend = Lf[127 * 260 + colL] + ft;
#pragma unroll
          for (int i = 0; i < 2; i++) {
            const int mb = wm * 32 + i * 16 + lg * 4;
            f32x4 ke;
#pragma unroll
            for (int r = 0; r < 4; r++) {
              const int m = mb + r;
              const int t = mt * 128 + m;
              const float cb = Lf[m * 260 + colL] + (m >= 64 ? ft : 0.f);
              HCB[(size_t)t * 1024 + col] = cb;
              HK[(size_t)t * 1024 + col] = f2bf(acc[i][j][r]);
              ke[r] = acc[i][j][r] * __expf(cend - cb);
              if (m == 127) HDEC[mt * 1024 + col] = __expf(cend);
            }
            *(uint2*)(HKET + (size_t)col * LT + mt * 128 + mb) = pack4(ke);
          }
        }
        __syncthreads();
      }
    }
  }
}

DEV void phase_U(const Params& p, unsigned char* ldsraw) {
  unsigned char* ws = p.ws;
  bf16_t* lds = (bf16_t*)ldsraw;
  for (int item = get_bid(); item < 1040; item += gridDim.x) {
    const bf16_t *A, *Bt; bf16_t* dst;
    if (item < 520) {
      const int h = item & 3, rest = item >> 2, mh = rest & 1, c = rest >> 1;
      A = (const bf16_t*)(ws + OFF_RVT) + (size_t)(h * 256 + mh * 128) * LT + c * 128;
      Bt = (const bf16_t*)(ws + OFF_RKT) + (size_t)(h * 128) * LT + c * 128;
      dst = (bf16_t*)(ws + OFF_STR) + ((size_t)(h * 65 + c) * 256 + mh * 128) * 128;
    } else {
      const int it = item - 520, h = it & 7, c = it >> 3;
      A = (const bf16_t*)(ws + OFF_HVT) + (size_t)(h * 128) * LT + c * 128;
      Bt = (const bf16_t*)(ws + OFF_HKET) + (size_t)(h * 128) * LT + c * 128;
      dst = (bf16_t*)(ws + OFF_STH) + ((size_t)(h * 65 + c) * 128) * 128;
    }
    f32x4 acc[2][4];
#pragma unroll
    for (int i = 0; i < 2; i++)
#pragma unroll
      for (int j = 0; j < 4; j++) acc[i][j] = (f32x4){0.f, 0.f, 0.f, 0.f};
    gemm_acc<128, false>(acc, A, LT, Bt, LT, 128, lds);
      const int tid = get_tid(), lane = tid & 63, wave = tid >> 6, wm = wave >> 1, wn = wave & 1; const int lr = lane & 15, lg = lane >> 4; (void)tid; (void)lane; (void)wm; (void)wn; (void)lr; (void)lg;
#pragma unroll
    for (int i = 0; i < 2; i++)
#pragma unroll
      for (int j = 0; j < 4; j++)
        *(uint2*)(dst + (size_t)(wm * 32 + i * 16 + lr) * 128 + wn * 64 + j * 16 + lg * 4) = pack4(acc[i][j]);
  }
}

DEV void phase_scan(const Params& p) {
  unsigned char* ws = p.ws;
  const float* HDEC = (const float*)(ws + OFF_HDEC);
  for (int task = get_bid() * NTHR + get_tid(); task < 65536; task += gridDim.x * NTHR) {
    bf16_t* base; size_t stride; int h, d4; bool hg;
    float dec0 = 0.f;
    if (task < 32768) {
      const int v = task; d4 = (v & 31) * 4; const int e = (v >> 5) & 255; h = v >> 13; hg = false;
      base = (bf16_t*)(ws + OFF_STR) + ((size_t)(h * 65) * 256 + e) * 128 + d4; stride = 256 * 128;
      dec0 = ex2(128.f * log2f(1.f - ex2(-5.f - (float)h)));
    } else {
      const int v = task - 32768; d4 = (v & 31) * 4; const int e = (v >> 5) & 127; h = v >> 12; hg = true;
      base = (bf16_t*)(ws + OFF_STH) + ((size_t)(h * 65) * 128 + e) * 128 + d4; stride = 128 * 128;
    }
    float c0 = 0.f, c1 = 0.f, c2 = 0.f, c3 = 0.f;
    for (int cg0 = 0; cg0 < 65; cg0 += 13) {
      uint2 u[13]; float4 dc[13];
#pragma unroll
      for (int k = 0; k < 13; k++) {
        u[k] = *(const uint2*)(base + (size_t)(cg0 + k) * stride);
        if (hg) dc[k] = *(const float4*)(HDEC + (size_t)(cg0 + k) * 1024 + h * 128 + d4);
        else dc[k] = make_float4(dec0, dec0, dec0, dec0);
      }
#pragma unroll
      for (int k = 0; k < 13; k++) {
        uint2 o; o.x = pack2(c0, c1); o.y = pack2(c2, c3);
        *(uint2*)(base + (size_t)(cg0 + k) * stride) = o;
        c0 = dc[k].x * c0 + bf2f((bf16_t)(u[k].x & 0xffff));
        c1 = dc[k].y * c1 + bf2f((bf16_t)(u[k].x >> 16));
        c2 = dc[k].z * c2 + bf2f((bf16_t)(u[k].y & 0xffff));
        c3 = dc[k].w * c3 + bf2f((bf16_t)(u[k].y >> 16));
      }
    }
  }
}

DEV void attn_item(const Params& p, int layer, int h, int qb, float lam, bf16_t* lds) {
  unsigned char* ws = p.ws;
  const bf16_t* DQ = (const bf16_t*)(ws + OFF_DQ);
  bf16_t* ODA = (bf16_t*)(ws + OFF_ODA);
  const bf16_t* DK = (const bf16_t*)(ws + OFF_DK);
  const bf16_t* DVT = (const bf16_t*)(ws + OFF_DVT);
  constexpr int PS = 136, XS = 132;
  constexpr int TS = 128 * PS;
  bf16_t* KV = lds;
  float* X = (float*)lds;
  const int tid = get_tid(), lane = tid & 63, wave = tid >> 6;
  const int lr = lane & 15, lg = lane >> 4;
  const int grp = wave >> 2, wq = wave & 3;
  const int t0 = qb * 128;
  const int lrow = tid >> 4, lc8 = (tid & 15) * 8;
  const bf16_t* gq = DQ + (size_t)(t0 + wq * 32 + lr) * 1024 + h * 128 + grp * 64 + lg * 8;
  const bf16x8 a00 = *(const bf16x8*)(gq);
  const bf16x8 a01 = *(const bf16x8*)(gq + 32);
  const bf16x8 a10 = *(const bf16x8*)(gq + (size_t)16 * 1024);
  const bf16x8 a11 = *(const bf16x8*)(gq + (size_t)16 * 1024 + 32);
  f32x4 o[2][8];
#pragma unroll
  for (int i = 0; i < 2; i++)
#pragma unroll
    for (int j = 0; j < 8; j++) o[i][j] = (f32x4){0.f, 0.f, 0.f, 0.f};
  float mrun0 = -1e30f, mrun1 = -1e30f, lrun0 = 0.f, lrun1 = 0.f;
  u32x4 rk0, rk1, rk2, rk3, rv0, rv1, rv2, rv3;
  const unsigned ko = (unsigned)(lrow * 1024 + h * 128 + lc8);
  const unsigned vo = (unsigned)((h * 128 + lrow) * LT + lc8);
#define ALOAD(kbn)                                                              \
  rk0 = *(const u32x4*)(DK + (ko + (unsigned)(kbn) * 131072u));                 \
  rk1 = *(const u32x4*)(DK + (ko + (unsigned)(kbn) * 131072u + 32768u));        \
  rk2 = *(const u32x4*)(DK + (ko + (unsigned)(kbn) * 131072u + 65536u));        \
  rk3 = *(const u32x4*)(DK + (ko + (unsigned)(kbn) * 131072u + 98304u));        \
  rv0 = *(const u32x4*)(DVT + (vo + (unsigned)(kbn) * 128u));                   \
  rv1 = *(const u32x4*)(DVT + (vo + (unsigned)(kbn) * 128u + 32u * LT));        \
  rv2 = *(const u32x4*)(DVT + (vo + (unsigned)(kbn) * 128u + 64u * LT));        \
  rv3 = *(const u32x4*)(DVT + (vo + (unsigned)(kbn) * 128u + 96u * LT));
#define ASTORE(sp)                                                              \
  *(u32x4*)((sp)) = rk0;                                                        \
  *(u32x4*)((sp) + 32 * PS) = rk1;                                              \
  *(u32x4*)((sp) + 64 * PS) = rk2;                                              \
  *(u32x4*)((sp) + 96 * PS) = rk3;                                              \
  *(u32x4*)((sp) + 2 * TS) = rv0;                                               \
  *(u32x4*)((sp) + 2 * TS + 32 * PS) = rv1;                                     \
  *(u32x4*)((sp) + 2 * TS + 64 * PS) = rv2;                                     \
  *(u32x4*)((sp) + 2 * TS + 96 * PS) = rv3;
  ALOAD(0)
  const int qrow0 = t0 + wq * 32 + lr;
  __syncthreads();
  ASTORE(KV + lrow * PS + lc8)
  {
    const int kb1 = qb > 0 ? 1 : 0;
    ALOAD(kb1)
  }
  __syncthreads();
  for (int kb = 0; kb <= qb; kb++) {
    const int cur = kb & 1;
    const bf16_t* kp = KV + cur * TS + lr * PS + grp * 64 + lg * 8;
    const bf16_t* vq = KV + 2 * TS + cur * TS + lr * PS + lg * 4;
    {
      bf16_t* sp = KV + (cur ^ 1) * TS + lrow * PS + lc8;
      ASTORE(sp)
    }
    __builtin_amdgcn_sched_barrier(0);
    f32x4 s[2][8];
    {
#pragma unroll
      for (int j = 0; j < 8; j++) {
        const bf16x8 kf0 = *(const bf16x8*)(kp + j * 16 * PS);
        const bf16x8 kf1 = *(const bf16x8*)(kp + j * 16 * PS + 32);
        s[0][j] = MFMA(kf0, a00, ((f32x4){0.f, 0.f, 0.f, 0.f}));
        s[1][j] = MFMA(kf0, a10, ((f32x4){0.f, 0.f, 0.f, 0.f}));
        s[0][j] = MFMA(kf1, a01, s[0][j]);
        s[1][j] = MFMA(kf1, a11, s[1][j]);
      }
    }
    __builtin_amdgcn_sched_barrier(0);
    {
      const int kbn = (kb + 2 <= qb) ? kb + 2 : qb;
      ALOAD(kbn)
    }
    __builtin_amdgcn_sched_barrier(0);
    if (kb == qb || kb == 0) {
#pragma unroll
      for (int i = 0; i < 2; i++)
#pragma unroll
        for (int j = 0; j < 8; j++)
#pragma unroll
          for (int r = 0; r < 4; r++) {
            const int key = kb * 128 + j * 16 + lg * 4 + r;
            if (key > qrow0 + 16 * i || key < 112) s[i][j][r] = -1e30f;
          }
    }
    float al[2];
#pragma unroll
    for (int i = 0; i < 2; i++) {
      float mx = -1e30f;
#pragma unroll
      for (int j = 0; j < 8; j++)
#pragma unroll
        for (int r = 0; r < 4; r++) mx = fmaxf(mx, s[i][j][r]);
      mx = fmaxf(mx, shfl_xor_l(mx, 16, lane));
      mx = fmaxf(mx, shfl_xor_l(mx, 32, lane));
      const float mold = i == 0 ? mrun0 : mrun1;
      const float mnew = fmaxf(mold, mx);
      al[i] = ex2(mold - mnew);
      float ps = 0.f;
#pragma unroll
      for (int j = 0; j < 8; j++)
#pragma unroll
        for (int r = 0; r < 4; r++) { const float pv = ex2(s[i][j][r] - mnew); s[i][j][r] = pv; ps += pv; }
      if (i == 0) { mrun0 = mnew; lrun0 = lrun0 * al[0] + ps; } else { mrun1 = mnew; lrun1 = lrun1 * al[1] + ps; }
    }
    if (__builtin_amdgcn_ballot_w64(al[0] != 1.f || al[1] != 1.f) != 0ull) {
#pragma unroll
      for (int i = 0; i < 2; i++) {
        float ao[4];
#pragma unroll
        for (int r = 0; r < 4; r++) ao[r] = shfl_l(al[i], lg * 4 + r);
#pragma unroll
        for (int je = 0; je < 8; je++)
#pragma unroll
          for (int r = 0; r < 4; r++) o[i][je][r] *= ao[r];
      }
    }
#pragma unroll
    for (int ks = 0; ks < 4; ks++) {
      union { u32x4 u; bf16x8 v; } pf0, pf1;
      pf0.u[0] = pack2(s[0][2 * ks][0], s[0][2 * ks][1]);
      pf0.u[1] = pack2(s[0][2 * ks][2], s[0][2 * ks][3]);
      pf0.u[2] = pack2(s[0][2 * ks + 1][0], s[0][2 * ks + 1][1]);
      pf0.u[3] = pack2(s[0][2 * ks + 1][2], s[0][2 * ks + 1][3]);
      pf1.u[0] = pack2(s[1][2 * ks][0], s[1][2 * ks][1]);
      pf1.u[1] = pack2(s[1][2 * ks][2], s[1][2 * ks][3]);
      pf1.u[2] = pack2(s[1][2 * ks + 1][0], s[1][2 * ks + 1][1]);
      pf1.u[3] = pack2(s[1][2 * ks + 1][2], s[1][2 * ks + 1][3]);
#pragma unroll
      for (int je = 0; je < 8; je++) {
        const bf16_t* vp = vq + je * 16 * PS + ks * 32;
        union { uint2 u[2]; bf16x8 v; } vf;
        vf.u[0] = *(const uint2*)vp;
        vf.u[1] = *(const uint2*)(vp + 16);
        o[0][je] = MFMA(pf0.v, vf.v, o[0][je]);
        o[1][je] = MFMA(pf1.v, vf.v, o[1][je]);
      }
    }
    __builtin_amdgcn_sched_barrier(0);
    __syncthreads();
  }
#undef ASTORE
#undef ALOAD
#pragma unroll
  for (int i = 0; i < 2; i++) {
    float l = i == 0 ? lrun0 : lrun1;
    l += shfl_xor_l(l, 16, lane);
    l += shfl_xor_l(l, 32, lane);
    const float inv = l > 0.f ? 1.f / l : 0.f;
#pragma unroll
    for (int r = 0; r < 4; r++) {
      const float ir = shfl_l(inv, lg * 4 + r);
#pragma unroll
      for (int je = 0; je < 8; je++) o[i][je][r] *= ir;
    }
  }
  __syncthreads();
  if (grp == 1) {
#pragma unroll
    for (int i = 0; i < 2; i++)
#pragma unroll
      for (int je = 0; je < 8; je++)
#pragma unroll
        for (int r = 0; r < 4; r++) X[(wq * 32 + i * 16 + lg * 4 + r) * XS + je * 16 + lr] = o[i][je][r];
  }
  __syncthreads();
  if (grp == 0) {
    int ly = layer; asm volatile("" : "+s"(ly));
    const float li = (ly == 0) ? 0.2f : 0.35550906759f;
    const float* sg = p.in[8] + ly * 128;
#pragma unroll
    for (int i = 0; i < 2; i++) {
      float ss[4] = {0.f, 0.f, 0.f, 0.f};
#pragma unroll
      for (int je = 0; je < 8; je++)
#pragma unroll
        for (int r = 0; r < 4; r++) {
          const float v = o[i][je][r] - lam * X[(wq * 32 + i * 16 + lg * 4 + r) * XS + je * 16 + lr];
          o[i][je][r] = v; ss[r] += v * v;
        }
#pragma unroll
      for (int r = 0; r < 4; r++) {
        float s2 = ss[r];
        s2 += shfl_xor_l(s2, 1, lane); s2 += shfl_xor_l(s2, 2, lane); s2 += shfl_xor_l(s2, 4, lane); s2 += shfl_xor_l(s2, 8, lane);
        ss[r] = rsqrtf(s2 * (1.f / 128.f) + 1e-6f) * (1.f - li);
      }
#pragma unroll
      for (int je = 0; je < 8; je++) {
        const float g = sg[je * 16 + lr];
#pragma unroll
        for (int r = 0; r < 4; r++)
          ODA[(size_t)(t0 + wq * 32 + i * 16 + lg * 4 + r) * 1024 + h * 128 + je * 16 + lr] = f2bf(o[i][je][r] * ss[r] * g);
      }
    }
  }
}

DEV void ret_item(const Params& p, int h, int c, bf16_t* lds) {
  unsigned char* ws = p.ws;
  const bf16_t* RQ = (const bf16_t*)(ws + OFF_RQ);
  const bf16_t* RK = (const bf16_t*)(ws + OFF_RK);
  const bf16_t* RVT = (const bf16_t*)(ws + OFF_RVT);
  const bf16_t* STR = (const bf16_t*)(ws + OFF_STR);
  bf16_t* ORET = (bf16_t*)(ws + OFF_ORET);
  constexpr int PS = 136;
  bf16_t* Qs = lds;
  bf16_t* Ks = lds + 128 * PS;
  bf16_t* Big = lds + 2 * 128 * PS;
  float* RED = (float*)(lds + 2 * 128 * PS + 256 * PS);
  const int tid = get_tid(), lane = tid & 63, wave = tid >> 6, wm = wave >> 1, wn = wave & 1;
  const int lr = lane & 15, lg = lane >> 4;
  const int t0 = c * 128;
  const int lrow = tid >> 4, lc8 = (tid & 15) * 8;
  const float l2g = log2f(1.f - ex2(-5.f - (float)h));
#pragma unroll
  for (int i = 0; i < 4; i++) {
    const int row = lrow + i * 32;
    *(uint4*)(Qs + row * PS + lc8) = *(const uint4*)(RQ + (size_t)(t0 + row) * 512 + h * 128 + lc8);
    *(uint4*)(Ks + row * PS + lc8) = *(const uint4*)(RK + (size_t)(t0 + row) * 512 + h * 128 + lc8);
  }
#pragma unroll
  for (int i = 0; i < 8; i++) {
    const int row = lrow + i * 32;
    *(uint4*)(Big + row * PS + lc8) = *(const uint4*)(STR + ((size_t)(h * 65 + c) * 256 + row) * 128 + lc8);
  }
  __syncthreads();
  f32x4 s[2][4];
  f32x4 o[2][8];
#pragma unroll
  for (int i = 0; i < 2; i++) {
#pragma unroll
    for (int j = 0; j < 4; j++) s[i][j] = (f32x4){0.f, 0.f, 0.f, 0.f};
#pragma unroll
    for (int j = 0; j < 8; j++) o[i][j] = (f32x4){0.f, 0.f, 0.f, 0.f};
  }
#pragma unroll
  for (int ks = 0; ks < 4; ks++) {
    bf16x8 a0 = ldfrag(Qs, PS, wm * 32 + lr, ks * 32 + lg * 8);
    bf16x8 a1 = ldfrag(Qs, PS, wm * 32 + 16 + lr, ks * 32 + lg * 8);
#pragma unroll
    for (int j = 0; j < 4; j++) {
      bf16x8 bb = ldfrag(Ks, PS, wn * 64 + j * 16 + lr, ks * 32 + lg * 8);
      s[0][j] = MFMA(bb, a0, s[0][j]);
      s[1][j] = MFMA(bb, a1, s[1][j]);
    }
#pragma unroll
    for (int j = 0; j < 8; j++) {
      bf16x8 bb = ldfrag(Big, PS, wn * 128 + j * 16 + lr, ks * 32 + lg * 8);
      o[0][j] = MFMA(bb, a0, o[0][j]);
      o[1][j] = MFMA(bb, a1, o[1][j]);
    }
    __builtin_amdgcn_sched_barrier(0);
  }
#pragma unroll
  for (int i = 0; i < 2; i++) {
    const int q = wm * 32 + i * 16 + lr;
    const float qd = ex2(l2g * (float)(q + 1));
#pragma unroll
    for (int j = 0; j < 8; j++)
#pragma unroll
      for (int r = 0; r < 4; r++) o[i][j][r] *= qd;
  }
  __syncthreads();
#pragma unroll
  for (int i = 0; i < 2; i++) {
    const int q = wm * 32 + i * 16 + lr;
#pragma unroll
    for (int j = 0; j < 4; j++) {
      f32x4 v;
#pragma unroll
      for (int r = 0; r < 4; r++) {
        const int key = wn * 64 + j * 16 + lg * 4 + r;
        v[r] = (key <= q) ? s[i][j][r] * ex2(l2g * (float)(q - key)) : 0.f;
      }
      *(uint2*)(Ks + q * PS + wn * 64 + j * 16 + lg * 4) = pack4(v);
    }
  }
#pragma unroll
  for (int i = 0; i < 8; i++) {
    const int row = lrow + i * 32;
    *(uint4*)(Big + row * PS + lc8) = *(const uint4*)(RVT + (size_t)(h * 256 + row) * LT + t0 + lc8);
  }
  __syncthreads();
#pragma unroll
  for (int ks = 0; ks < 4; ks++) {
    bf16x8 a0 = ldfrag(Ks, PS, wm * 32 + lr, ks * 32 + lg * 8);
    bf16x8 a1 = ldfrag(Ks, PS, wm * 32 + 16 + lr, ks * 32 + lg * 8);
#pragma unroll
    for (int j = 0; j < 8; j++) {
      bf16x8 bb = ldfrag(Big, PS, wn * 128 + j * 16 + lr, ks * 32 + lg * 8);
      o[0][j] = MFMA(bb, a0, o[0][j]);
      o[1][j] = MFMA(bb, a1, o[1][j]);
    }
    __builtin_amdgcn_sched_barrier(0);
  }
#pragma unroll
  for (int i = 0; i < 2; i++) {
    float ss = 0.f;
#pragma unroll
    for (int j = 0; j < 8; j++)
#pragma unroll
      for (int r = 0; r < 4; r++) ss += o[i][j][r] * o[i][j][r];
    ss += shfl_xor_l(ss, 16, lane);
    ss += shfl_xor_l(ss, 32, lane);
    if (lg == 0) RED[(wm * 32 + i * 16 + lr) * 2 + wn] = ss;
  }
  __syncthreads();
#pragma unroll
  for (int i = 0; i < 2; i++) {
    const int q = wm * 32 + i * 16 + lr;
    const float rs = rsqrtf((RED[q * 2] + RED[q * 2 + 1]) * (1.f / 256.f) + 1e-6f);
#pragma unroll
    for (int j = 0; j < 8; j++) {
      f32x4 v = o[i][j];
#pragma unroll
      for (int r = 0; r < 4; r++) v[r] *= rs;
      *(uint2*)(ORET + (size_t)(t0 + q) * 1024 + h * 256 + wn * 128 + j * 16 + lg * 4) = pack4(v);
    }
  }
}

DEV void hg_item(const Params& p, int h, int c, bf16_t* lds) {
  unsigned char* ws = p.ws;
  const bf16_t* HQ = (const bf16_t*)(ws + OFF_HQ);
  const bf16_t* HK = (const bf16_t*)(ws + OFF_HK);
  const float* HCB = (const float*)(ws + OFF_HCB);
  const bf16_t* HVT = (const bf16_t*)(ws + OFF_HVT);
  const bf16_t* STH = (const bf16_t*)(ws + OFF_STH);
  bf16_t* OHG = (bf16_t*)(ws + OFF_OHG);
  constexpr int PS = 136;
  bf16_t* Qp = lds;
  bf16_t* Kp = lds + 128 * PS;
  bf16_t* As = lds + 2 * 128 * PS;
  float* RED = (float*)(lds + 2 * 128 * PS + 256 * PS);
  const int tid = get_tid(), lane = tid & 63, wave = tid >> 6, wm = wave >> 1, wn = wave & 1;
  const int lr = lane & 15, lg = lane >> 4;
  const int t0 = c * 128, colb = h * 128;
  const int lrow = tid >> 4, lc8 = (tid & 15) * 8;
#pragma unroll
  for (int i = 0; i < 4; i++) {
    const int row = lrow + i * 32;
    const size_t g = (size_t)(t0 + row) * 1024 + colb + lc8;
    uint4 qv = *(const uint4*)(HQ + g);
    float4 c0 = *(const float4*)(HCB + g), c1 = *(const float4*)(HCB + g + 4);
    float4 r0 = make_float4(0.f, 0.f, 0.f, 0.f), r1 = r0;
    if (row >= 32) {
      const size_t gr = (size_t)(t0 + (row & ~31) - 1) * 1024 + colb + lc8;
      r0 = *(const float4*)(HCB + gr); r1 = *(const float4*)(HCB + gr + 4);
    }
    uint4 ov;
    ov.x = pack2(bf2f((bf16_t)(qv.x & 0xffff)) * __expf(c0.x - r0.x), bf2f((bf16_t)(qv.x >> 16)) * __expf(c0.y - r0.y));
    ov.y = pack2(bf2f((bf16_t)(qv.y & 0xffff)) * __expf(c0.z - r0.z), bf2f((bf16_t)(qv.y >> 16)) * __expf(c0.w - r0.w));
    ov.z = pack2(bf2f((bf16_t)(qv.z & 0xffff)) * __expf(c1.x - r1.x), bf2f((bf16_t)(qv.z >> 16)) * __expf(c1.y - r1.y));
    ov.w = pack2(bf2f((bf16_t)(qv.w & 0xffff)) * __expf(c1.z - r1.z), bf2f((bf16_t)(qv.w >> 16)) * __expf(c1.w - r1.w));
    *(uint4*)(Qp + row * PS + lc8) = ov;
  }
  for (int I = 0; I < 4; I++) {
    const int nrows = 32 * (I + 1);
    float4 r0 = make_float4(0.f, 0.f, 0.f, 0.f), r1 = r0;
    if (I > 0) {
      const size_t gr = (size_t)(t0 + 32 * I - 1) * 1024 + colb + lc8;
      r0 = *(const float4*)(HCB + gr); r1 = *(const float4*)(HCB + gr + 4);
    }
#pragma unroll
    for (int i = 0; i < 4; i++) {
      const int row = lrow + i * 32;
      if (row < nrows) {
        const size_t g = (size_t)(t0 + row) * 1024 + colb + lc8;
        uint4 kv = *(const uint4*)(HK + g);
        float4 c0 = *(const float4*)(HCB + g), c1 = *(const float4*)(HCB + g + 4);
        uint4 ov;
        ov.x = pack2(bf2f((bf16_t)(kv.x & 0xffff)) * __expf(fminf(r0.x - c0.x, 80.f)), bf2f((bf16_t)(kv.x >> 16)) * __expf(fminf(r0.y - c0.y, 80.f)));
        ov.y = pack2(bf2f((bf16_t)(kv.y & 0xffff)) * __expf(fminf(r0.z - c0.z, 80.f)), bf2f((bf16_t)(kv.y >> 16)) * __expf(fminf(r0.w - c0.w, 80.f)));
        ov.z = pack2(bf2f((bf16_t)(kv.z & 0xffff)) * __expf(fminf(r1.x - c1.x, 80.f)), bf2f((bf16_t)(kv.z >> 16)) * __expf(fminf(r1.y - c1.y, 80.f)));
        ov.w = pack2(bf2f((bf16_t)(kv.w & 0xffff)) * __expf(fminf(r1.z - c1.z, 80.f)), bf2f((bf16_t)(kv.w >> 16)) * __expf(fminf(r1.w - c1.w, 80.f)));
        *(uint4*)(Kp + row * PS + lc8) = ov;
      }
    }
    __syncthreads();
    if (wave * 16 < nrows) {
      f32x4 a2[2];
      a2[0] = (f32x4){0.f, 0.f, 0.f, 0.f}; a2[1] = a2[0];
#pragma unroll
      for (int ks = 0; ks < 4; ks++) {
        bf16x8 bb = ldfrag(Kp, PS, wave * 16 + lr, ks * 32 + lg * 8);
        bf16x8 a0 = ldfrag(Qp, PS, 32 * I + lr, ks * 32 + lg * 8);
        bf16x8 a1 = ldfrag(Qp, PS, 32 * I + 16 + lr, ks * 32 + lg * 8);
        a2[0] = MFMA(bb, a0, a2[0]);
        a2[1] = MFMA(bb, a1, a2[1]);
      }
#pragma unroll
      for (int i = 0; i < 2; i++) {
        const int q = 32 * I + i * 16 + lr;
        f32x4 v;
#pragma unroll
        for (int r = 0; r < 4; r++) { const int key = wave * 16 + lg * 4 + r; v[r] = (key <= q) ? a2[i][r] : 0.f; }
        *(uint2*)(As + q * PS + wave * 16 + lg * 4) = pack4(v);
      }
    } else {
#pragma unroll
      for (int i = 0; i < 2; i++) {
        const int q = 32 * I + i * 16 + lr;
        *(uint2*)(As + q * PS + wave * 16 + lg * 4) = make_uint2(0u, 0u);
      }
    }
    __syncthreads();
  }
#pragma unroll
  for (int i = 0; i < 4; i++) {
    const int row = lrow + i * 32;
    *(uint4*)(Kp + row * PS + lc8) = *(const uint4*)(HVT + (size_t)(colb + row) * LT + t0 + lc8);
  }
  __syncthreads();
  f32x4 o[2][4];
#pragma unroll
  for (int i = 0; i < 2; i++)
#pragma unroll
    for (int j = 0; j < 4; j++) o[i][j] = (f32x4){0.f, 0.f, 0.f, 0.f};
#pragma unroll
  for (int ks = 0; ks < 4; ks++) {
    bf16x8 a0 = ldfrag(As, PS, wm * 32 + lr, ks * 32 + lg * 8);
    bf16x8 a1 = ldfrag(As, PS, wm * 32 + 16 + lr, ks * 32 + lg * 8);
#pragma unroll
    for (int j = 0; j < 4; j++) {
      bf16x8 bb = ldfrag(Kp, PS, wn * 64 + j * 16 + lr, ks * 32 + lg * 8);
      o[0][j] = MFMA(bb, a0, o[0][j]);
      o[1][j] = MFMA(bb, a1, o[1][j]);
    }
    __builtin_amdgcn_sched_barrier(0);
  }
  __syncthreads();
#pragma unroll
  for (int i = 0; i < 4; i++) {
    const int row = lrow + i * 32;
    const size_t g = (size_t)(t0 + row) * 1024 + colb + lc8;
    uint4 qv = *(const uint4*)(HQ + g);
    float4 c0 = *(const float4*)(HCB + g), c1 = *(const float4*)(HCB + g + 4);
    uint4 ov;
    ov.x = pack2(bf2f((bf16_t)(qv.x & 0xffff)) * __expf(c0.x), bf2f((bf16_t)(qv.x >> 16)) * __expf(c0.y));
    ov.y = pack2(bf2f((bf16_t)(qv.y & 0xffff)) * __expf(c0.z), bf2f((bf16_t)(qv.y >> 16)) * __expf(c0.w));
    ov.z = pack2(bf2f((bf16_t)(qv.z & 0xffff)) * __expf(c1.x), bf2f((bf16_t)(qv.z >> 16)) * __expf(c1.y));
    ov.w = pack2(bf2f((bf16_t)(qv.w & 0xffff)) * __expf(c1.z), bf2f((bf16_t)(qv.w >> 16)) * __expf(c1.w));
    *(uint4*)(Qp + row * PS + lc8) = ov;
    *(uint4*)(Kp + row * PS + lc8) = *(const uint4*)(STH + ((size_t)(h * 65 + c) * 128 + row) * 128 + lc8);
  }
  __syncthreads();
#pragma unroll
  for (int ks = 0; ks < 4; ks++) {
    bf16x8 a0 = ldfrag(Qp, PS, wm * 32 + lr, ks * 32 + lg * 8);
    bf16x8 a1 = ldfrag(Qp, PS, wm * 32 + 16 + lr, ks * 32 + lg * 8);
#pragma unroll
    for (int j = 0; j < 4; j++) {
      bf16x8 bb = ldfrag(Kp, PS, wn * 64 + j * 16 + lr, ks * 32 + lg * 8);
      o[0][j] = MFMA(bb, a0, o[0][j]);
      o[1][j] = MFMA(bb, a1, o[1][j]);
    }
    __builtin_amdgcn_sched_barrier(0);
  }
#pragma unroll
  for (int i = 0; i < 2; i++) {
    float ss = 0.f;
#pragma unroll
    for (int j = 0; j < 4; j++)
#pragma unroll
      for (int r = 0; r < 4; r++) ss += o[i][j][r] * o[i][j][r];
    ss += shfl_xor_l(ss, 16, lane);
    ss += shfl_xor_l(ss, 32, lane);
    if (lg == 0) RED[(wm * 32 + i * 16 + lr) * 2 + wn] = ss;
  }
  __syncthreads();
#pragma unroll
  for (int i = 0; i < 2; i++) {
    const int q = wm * 32 + i * 16 + lr;
    const float rs = rsqrtf((RED[q * 2] + RED[q * 2 + 1]) * (1.f / 128.f) + 1e-6f);
#pragma unroll
    for (int j = 0; j < 4; j++) {
      f32x4 v = o[i][j];
#pragma unroll
      for (int r = 0; r < 4; r++) v[r] *= rs;
      *(uint2*)(OHG + (size_t)(t0 + q) * 1024 + colb + wn * 64 + j * 16 + lg * 4) = pack4(v);
    }
  }
}

DEV void phase_O(const Params& p, int layer, int qidx, unsigned char* ldsraw) {
  bf16_t* lds = (bf16_t*)ldsraw;
  int* ctr = (int*)(p.ws + OFF_CTR) + qidx;
  int* sitem = (int*)(ldsraw + LDS_BYTES - 16);
  const float* lp = p.in[7] + layer * 256;
  float d0 = 0.f, d1 = 0.f;
  for (int i = 0; i < 64; i++) { d0 += lp[i] * lp[64 + i]; d1 += lp[128 + i] * lp[192 + i]; }
  int ly = layer; asm volatile("" : "+s"(ly));
  const float li = (ly == 0) ? 0.2f : 0.35550906759f;
  const float lam = __uint_as_float(__builtin_amdgcn_readfirstlane(__float_as_uint(__expf(d0) - __expf(d1) + li)));
  const int tid0 = get_tid();
  for (;;) {
    __syncthreads();
    if (tid0 == 0) *sitem = atomicAdd(ctr, 1);
    __syncthreads();
    const int item = __builtin_amdgcn_readfirstlane(*sitem);
    if (item >= 1300) break;
    if (item < 520) attn_item(p, layer, item & 7, 64 - (item >> 3), lam, lds);
    else if (item < 780) ret_item(p, (item - 520) & 3, (item - 520) >> 2, lds);
    else hg_item(p, (item - 780) & 7, (item - 780) >> 3, lds);
  }
}

DEV void phase_G(const Params& p, int b, unsigned char* ldsraw) {
  unsigned char* ws = p.ws;
  bf16_t* lds = (bf16_t*)ldsraw;
  const bf16_t* HN = (const bf16_t*)(ws + OFF_HN) + (size_t)b * LT * 1024;
  const bf16_t* WIN = (const bf16_t*)(ws + OFF_WIN);
  for (int item = vblock(); item < 33 * 20; item += gridDim.x) {
    int nt, mt; tile_map(item, 33, 4, mt, nt);
    int n0, cb; bf16_t* dst; int ld; bool gate;
    if (nt < 4) { n0 = 2048 + nt * 256; cb = nt * 256; dst = (bf16_t*)(ws + OFF_ORET); ld = 1024; gate = true; }
    else if (nt < 8) { n0 = 6144 + (nt - 4) * 256; cb = (nt - 4) * 256; dst = (bf16_t*)(ws + OFF_OHG); ld = 1024; gate = true; }
    else { n0 = 10240 + (nt - 8) * 256; cb = (nt - 8) * 256; dst = (bf16_t*)(ws + OFF_G); ld = 3072; gate = false; }
    f32x4 acc[4][8];
#pragma unroll
    for (int i = 0; i < 4; i++)
#pragma unroll
      for (int j = 0; j < 8; j++) acc[i][j] = (f32x4){0.f, 0.f, 0.f, 0.f};
    gemm256_acc<256>(acc, HN + (size_t)mt * 256 * 1024, 1024, LT - mt * 256, WIN + (size_t)n0 * 1024, 1024, 1024, lds);
    const int tid = get_tid(), lane = tid & 63, wave = tid >> 6, wm = wave >> 1, wn = wave & 1; const int lr = lane & 15, lg = lane >> 4;
#pragma unroll
    for (int i = 0; i < 4; i++) {
      const int t = mt * 256 + wm * 64 + i * 16 + lr;
      if (t < LT) {
#pragma unroll
        for (int j = 0; j < 8; j++) {
          bf16_t* d = dst + (size_t)t * ld + cb + wn * 128 + j * 16 + lg * 4;
          f32x4 v;
          if (gate) {
            uint2 ov = *(const uint2*)d;
            v[0] = bf2f((bf16_t)(ov.x & 0xffff)) * silu_f(acc[i][j][0]);
            v[1] = bf2f((bf16_t)(ov.x >> 16)) * silu_f(acc[i][j][1]);
            v[2] = bf2f((bf16_t)(ov.y & 0xffff)) * silu_f(acc[i][j][2]);
            v[3] = bf2f((bf16_t)(ov.y >> 16)) * silu_f(acc[i][j][3]);
          } else {
#pragma unroll
            for (int r = 0; r < 4; r++) v[r] = sigmoid_f(acc[i][j][r]);
          }
          *(uint2*)d = pack4(v);
        }
      }
    }
  }
}

DEV f32x4 mini_gemm16(const bf16_t* __restrict__ A16, int lda, const bf16_t* __restrict__ Bt16, int ldb, int k0, int klen, int lane) {
  const int lr = lane & 15, lg = lane >> 4;
  const bf16_t* pa = A16 + (size_t)lr * lda + k0 + lg * 8;
  const bf16_t* pb = Bt16 + (size_t)lr * ldb + k0 + lg * 8;
  f32x4 acc = (f32x4){0.f, 0.f, 0.f, 0.f};
#pragma unroll 4
  for (int k = 0; k < klen; k += 32) {
    bf16x8 a = *(const bf16x8*)(pa + k);
    bf16x8 b = *(const bf16x8*)(pb + k);
    acc = MFMA(b, a, acc);
  }
  return acc;
}

DEV void phase_Y(const Params& p, unsigned char* ldsraw) {
  unsigned char* ws = p.ws;
  bf16_t* lds = (bf16_t*)ldsraw;
  const bf16_t* WB = (const bf16_t*)(ws + OFF_WB);
  const bf16_t* G = (const bf16_t*)(ws + OFF_G);
  bf16_t* Y = (bf16_t*)(ws + OFF_Y);
  for (int item = vblock(); item < 32 * 8 + 64; item += gridDim.x) {
    if (item >= 256) {
      const int lane = get_tid() & 63, wave = get_tid() >> 6, lr = lane & 15, lg = lane >> 4;
      const int n0 = (item - 256) * 16;
      f32x4* red = (f32x4*)ldsraw;
      __syncthreads();
#pragma unroll 1
      for (int br = 0; br < 3; br++) {
        const bf16_t* Ab = (const bf16_t*)(ws + (br == 0 ? OFF_ORET : (br == 1 ? OFF_OHG : OFF_ODA))) + (size_t)112 * 1024;
        red[(br * 8 + wave) * 64 + lane] = mini_gemm16(Ab, 1024, WB + ((size_t)br * 1024 + n0) * 1024, 1024, wave * 128, 128, lane);
      }
      __syncthreads();
      if (wave == 0) {
        f32x4 y = (f32x4){0.f, 0.f, 0.f, 0.f};
#pragma unroll
        for (int br = 0; br < 3; br++) {
          f32x4 a = red[(br * 8) * 64 + lane];
#pragma unroll
          for (int w = 1; w < 8; w++) a += red[(br * 8 + w) * 64 + lane];
          uint2 gv = *(const uint2*)(G + (size_t)(112 + lr) * 3072 + br * 1024 + n0 + lg * 4);
          y[0] += bf2f((bf16_t)(gv.x & 0xffff)) * a[0];
          y[1] += bf2f((bf16_t)(gv.x >> 16)) * a[1];
          y[2] += bf2f((bf16_t)(gv.y & 0xffff)) * a[2];
          y[3] += bf2f((bf16_t)(gv.y >> 16)) * a[3];
        }
        *(uint2*)(Y + (size_t)(112 + lr) * 1024 + n0 + lg * 4) = pack4(y);
      }
      continue;
    }
    int nt, mt; tile_map(item, 32, 4, mt, nt);
    const int row0 = 128 + mt * 256;
    f32x4 y[4][4];
#pragma unroll
    for (int i = 0; i < 4; i++)
#pragma unroll
      for (int j = 0; j < 4; j++) y[i][j] = (f32x4){0.f, 0.f, 0.f, 0.f};
#pragma unroll 1
    for (int br = 0; br < 3; br++) {
      const bf16_t* Ab = (const bf16_t*)(ws + (br == 0 ? OFF_ORET : (br == 1 ? OFF_OHG : OFF_ODA))) + (size_t)row0 * 1024;
      f32x4 acc[4][4];
#pragma unroll
      for (int i = 0; i < 4; i++)
#pragma unroll
        for (int j = 0; j < 4; j++) acc[i][j] = (f32x4){0.f, 0.f, 0.f, 0.f};
      gemm256_acc<128>(acc, Ab, 1024, 256, WB + ((size_t)br * 1024 + nt * 128) * 1024, 1024, 1024, lds);
      const int tid = get_tid(), lane = tid & 63, wave = tid >> 6, wm = wave >> 1, wn = wave & 1; const int lr = lane & 15, lg = lane >> 4;
#pragma unroll
      for (int i = 0; i < 4; i++) {
        const int t = row0 + wm * 64 + i * 16 + lr;
#pragma unroll
        for (int j = 0; j < 4; j++) {
          uint2 gv = *(const uint2*)(G + (size_t)t * 3072 + br * 1024 + nt * 128 + wn * 64 + j * 16 + lg * 4);
          y[i][j][0] += bf2f((bf16_t)(gv.x & 0xffff)) * acc[i][j][0];
          y[i][j][1] += bf2f((bf16_t)(gv.x >> 16)) * acc[i][j][1];
          y[i][j][2] += bf2f((bf16_t)(gv.y & 0xffff)) * acc[i][j][2];
          y[i][j][3] += bf2f((bf16_t)(gv.y >> 16)) * acc[i][j][3];
        }
      }
    }
    const int tid = get_tid(), lane = tid & 63, wave = tid >> 6, wm = wave >> 1, wn = wave & 1; const int lr = lane & 15, lg = lane >> 4;
#pragma unroll
    for (int i = 0; i < 4; i++) {
      const int t = row0 + wm * 64 + i * 16 + lr;
#pragma unroll
      for (int j = 0; j < 4; j++)
        *(uint2*)(Y + (size_t)t * 1024 + nt * 128 + wn * 64 + j * 16 + lg * 4) = pack4(y[i][j]);
    }
  }
}

DEV void phase_resid(const Params& p, int b, const bf16_t* A, int K, const bf16_t* Wt, unsigned char* ldsraw) {
  bf16_t* lds = (bf16_t*)ldsraw;
  for (int item = vblock(); item < 32 * 8 + 64; item += gridDim.x) {
    if (item >= 256) {
      const int lane = get_tid() & 63, wave = get_tid() >> 6, lr = lane & 15, lg = lane >> 4;
      const int n0 = (item - 256) * 16;
      f32x4* red = (f32x4*)ldsraw;
      const int ks = K >> 3;
      __syncthreads();
      red[wave * 64 + lane] = mini_gemm16(A + (size_t)112 * K, K, Wt + (size_t)n0 * K, K, wave * ks, ks, lane);
      __syncthreads();
      if (wave == 0) {
        f32x4 a = red[lane];
#pragma unroll
        for (int w = 1; w < 8; w++) a += red[w * 64 + lane];
        float4* d = (float4*)(hrow(p, b, 112 + lr) + n0 + lg * 4);
        float4 v = *d;
        v.x += a[0]; v.y += a[1]; v.z += a[2]; v.w += a[3];
        *d = v;
      }
      continue;
    }
    int nt, mt; tile_map(item, 32, 4, mt, nt);
    const int row0 = 128 + mt * 256;
    f32x4 acc[4][4];
#pragma unroll
    for (int i = 0; i < 4; i++)
#pragma unroll
      for (int j = 0; j < 4; j++) acc[i][j] = (f32x4){0.f, 0.f, 0.f, 0.f};
    gemm256_acc<128>(acc, A + (size_t)row0 * K, K, 256, Wt + (size_t)nt * 128 * K, K, K, lds);
    const int tid = get_tid(), lane = tid & 63, wave = tid >> 6, wm = wave >> 1, wn = wave & 1; const int lr = lane & 15, lg = lane >> 4;
#pragma unroll
    for (int i = 0; i < 4; i++) {
      const int t = row0 + wm * 64 + i * 16 + lr;
#pragma unroll
      for (int j = 0; j < 4; j++) {
        float4* d = (float4*)(hrow(p, b, t) + nt * 128 + wn * 64 + j * 16 + lg * 4);
        float4 v = *d;
        v.x += acc[i][j][0]; v.y += acc[i][j][1]; v.z += acc[i][j][2]; v.w += acc[i][j][3];
        *d = v;
      }
    }
  }
}

DEV void phase_F1(const Params& p, int b, unsigned char* ldsraw) {
  unsigned char* ws = p.ws;
  bf16_t* lds = (bf16_t*)ldsraw;
  const bf16_t* HN = (const bf16_t*)(ws + OFF_HN) + (size_t)b * LT * 1024;
  const bf16_t* WFI = (const bf16_t*)(ws + OFF_WFI);
  bf16_t* U = (bf16_t*)(ws + OFF_U);
  for (int item = vblock(); item < 33 * 22; item += gridDim.x) {
    int nt, mt; tile_map(item, 33, 2, mt, nt);
    f32x4 acc[4][8];
#pragma unroll
    for (int i = 0; i < 4; i++)
#pragma unroll
      for (int j = 0; j < 8; j++) acc[i][j] = (f32x4){0.f, 0.f, 0.f, 0.f};
    gemm256_acc<256>(acc, HN + (size_t)mt * 256 * 1024, 1024, LT - mt * 256, WFI + (size_t)nt * 256 * 1024, 1024, 1024, lds);
    const int tid = get_tid(), lane = tid & 63, wave = tid >> 6, wm = wave >> 1, wn = wave & 1; const int lr = lane & 15, lg = lane >> 4;
#pragma unroll
    for (int i = 0; i < 4; i++) {
      const int t = mt * 256 + wm * 64 + i * 16 + lr;
      if (t < LT) {
        const float vm = (t >= 112) ? 1.f : 0.f;
#pragma unroll
        for (int j = 0; j < 8; j++) {
          f32x4 v = acc[i][j];
#pragma unroll
          for (int r = 0; r < 4; r++) v[r] *= vm;
          *(uint2*)(U + (size_t)t * 5632 + nt * 256 + wn * 128 + j * 16 + lg * 4) = pack4(v);
        }
      }
    }
  }
}

DEV void unpack8(const u32x4 v, float (&f)[8]) {
#pragma unroll
  for (int k = 0; k < 4; k++) { f[2 * k] = bf2f((bf16_t)(v[k] & 0xffff)); f[2 * k + 1] = bf2f((bf16_t)(v[k] >> 16)); }
}
DEV void phase_conv(const Params& p, int layer) {
  unsigned char* ws = p.ws;
  const bf16_t* U = (const bf16_t*)(ws + OFF_U);
  bf16_t* GF = (bf16_t*)(ws + OFF_GF);
  const float* cw = p.in[11] + (size_t)layer * 3 * 5632;
  const float* cbias = p.in[12] + (size_t)layer * 5632;
  for (int idx = get_bid() * NTHR + get_tid(); idx < (LT / 8) * 352; idx += gridDim.x * NTHR) {
    const int tb = idx / 352, c8 = (idx - tb * 352) * 8;
    const int t0 = tb * 8;
    float wg[3][8], wv[3][8], bg[8], bv[8];
#pragma unroll
    for (int k = 0; k < 8; k++) {
      bg[k] = cbias[c8 + k]; bv[k] = cbias[2816 + c8 + k];
#pragma unroll
      for (int j = 0; j < 3; j++) { wg[j][k] = cw[j * 5632 + c8 + k]; wv[j][k] = cw[j * 5632 + 2816 + c8 + k]; }
    }
    float g0[8], g1[8], v0[8], v1[8];
    if (t0 >= 2) {
      unpack8(*(const u32x4*)(U + (size_t)(t0 - 2) * 5632 + c8), g0);
      unpack8(*(const u32x4*)(U + (size_t)(t0 - 2) * 5632 + 2816 + c8), v0);
      unpack8(*(const u32x4*)(U + (size_t)(t0 - 1) * 5632 + c8), g1);
      unpack8(*(const u32x4*)(U + (size_t)(t0 - 1) * 5632 + 2816 + c8), v1);
    } else {
#pragma unroll
      for (int k = 0; k < 8; k++) { g0[k] = 0.f; g1[k] = 0.f; v0[k] = 0.f; v1[k] = 0.f; }
    }
#pragma unroll
    for (int tt = 0; tt < 8; tt++) {
      float g2[8], v2[8];
      unpack8(*(const u32x4*)(U + (size_t)(t0 + tt) * 5632 + c8), g2);
      unpack8(*(const u32x4*)(U + (size_t)(t0 + tt) * 5632 + 2816 + c8), v2);
      float og[8];
#pragma unroll
      for (int k = 0; k < 8; k++) {
        const float gg = bg[k] + wg[0][k] * g0[k] + wg[1][k] * g1[k] + wg[2][k] * g2[k];
        const float vv = bv[k] + wv[0][k] * v0[k] + wv[1][k] * v1[k] + wv[2][k] * v2[k];
        og[k] = silu_f(gg) * vv;
        g0[k] = g1[k]; g1[k] = g2[k]; v0[k] = v1[k]; v1[k] = v2[k];
      }
      u32x4 o;
      o[0] = pack2(og[0], og[1]); o[1] = pack2(og[2], og[3]); o[2] = pack2(og[4], og[5]); o[3] = pack2(og[6], og[7]);
      *(u32x4*)(GF + (size_t)(t0 + tt) * 2816 + c8) = o;
    }
  }
}

#define XB_TMO      128
#define XB_XCNT(j)  (256  + 64 * (j))
#define XB_XSUB(j)  (1280 + 64 * (j))
#define XB_XGEN(j)  (2304 + 64 * (j))
#define XB_TOP      3328
#define XB_TOPGEN   3392
#define XB_SPIN_CAP (1u << 18)
#define LAS __attribute__((address_space(3)))
DEV unsigned xb_ld(unsigned* p) { return __hip_atomic_load(p, __ATOMIC_RELAXED, __HIP_MEMORY_SCOPE_AGENT); }
DEV unsigned xb_add(unsigned* p, unsigned v) { return __hip_atomic_fetch_add(p, v, __ATOMIC_RELAXED, __HIP_MEMORY_SCOPE_AGENT); }
DEV unsigned xb_xcc_id() { return (unsigned)__builtin_amdgcn_s_getreg((3 << 11) | 20) & 0xFu; }
#define XB_SPIN(cond, bar) do { unsigned _sp = 0; while (cond) { __builtin_amdgcn_s_sleep(1); \
    if ((++_sp & 255u) == 0u) { if (xb_ld(&(bar)[XB_TMO])) break; if (_sp > XB_SPIN_CAP) { atomicAdd(&(bar)[XB_TMO], 1u); break; } } } } while (0)
struct XcdBarrier { unsigned* bar; unsigned x; volatile LAS unsigned* st; };
DEV XcdBarrier xcd_barrier_post(unsigned* bar, volatile LAS unsigned* st) {
  XcdBarrier b; b.bar = bar; b.x = xb_xcc_id(); b.st = st;
  if (threadIdx.x == 0) (void)xb_add(&bar[XB_XCNT(b.x)], 1u);
  return b;
}
DEV void xcd_barrier_complete(unsigned* bar, unsigned x, unsigned& nloc, unsigned& nx) {
  const unsigned G = gridDim.x;
  unsigned sum, cnt, mine, sp = 0u;
  for (;;) {
    sum = 0u; cnt = 0u; mine = 0u;
#pragma unroll
    for (unsigned j = 0; j < 16; ++j) { const unsigned c = xb_ld(&bar[XB_XCNT(j)]); sum += c; cnt += (c > 0u) ? 1u : 0u; mine = (j == x) ? c : mine; }
    if (sum == G) break;
    __builtin_amdgcn_s_sleep(1);
    if ((++sp & 255u) == 0u) { if (xb_ld(&bar[XB_TMO])) break; if (sp > XB_SPIN_CAP) { atomicAdd(&bar[XB_TMO], 1u); break; } }
  }
  nloc = mine > 0u ? mine : 1u; nx = cnt > 0u ? cnt : 1u;
}
DEV void xcd_barrier(const XcdBarrier& b) {
  asm volatile("s_waitcnt vmcnt(0)" ::: "memory");
  __syncthreads();
  if (threadIdx.x == 0) {
    unsigned* bar = b.bar;
    __builtin_amdgcn_s_waitcnt(0);
    unsigned nloc = b.st[0], nx = b.st[1];
    if (nloc == 0u) { xcd_barrier_complete(bar, b.x, nloc, nx); b.st[0] = nloc; b.st[1] = nx; }
    const unsigned old = xb_add(&bar[XB_XSUB(b.x)], 1u);
    const unsigned gen = old / nloc;
    if (old + 1u == (gen + 1u) * nloc) {
      __builtin_amdgcn_fence(__ATOMIC_RELEASE, "agent");
      asm volatile("s_waitcnt vmcnt(0)" ::: "memory");
      const unsigned og = xb_add(&bar[XB_TOP], 1u);
      const unsigned tg = og / nx;
      if (og + 1u == (tg + 1u) * nx) xb_add(&bar[XB_TOPGEN], 1u);
      else XB_SPIN(xb_ld(&bar[XB_TOPGEN]) == tg, bar);
      __builtin_amdgcn_fence(__ATOMIC_ACQUIRE, "agent");
      xb_add(&bar[XB_XGEN(b.x)], 1u);
      asm volatile("s_waitcnt vmcnt(0)" ::: "memory");
    } else {
      XB_SPIN(xb_ld(&bar[XB_XGEN(b.x)]) == gen, bar);
      __builtin_amdgcn_fence(__ATOMIC_ACQUIRE, "agent");
      asm volatile("s_waitcnt vmcnt(0)" ::: "memory");
    }
  }
  __syncthreads();
}

__global__ void __launch_bounds__(NTHR) fwd_megakernel(Params p) {
  extern __shared__ __attribute__((aligned(16))) unsigned char lds[];
  cg::grid_group grid = cg::this_grid();
  volatile LAS unsigned* xst = (volatile LAS unsigned*)(lds + LDS_BYTES - 12);
  if (threadIdx.x == 0) { xst[0] = 0u; xst[1] = 0u; }
  __syncthreads();
  (void)xcd_barrier_post((unsigned*)(p.ws + OFF_XBAR), xst);
#define GRID_SYNC() do { XcdBarrier xb_; xb_.bar = (unsigned*)(p.ws + OFF_XBAR); xb_.x = xb_xcc_id(); \
    xb_.st = (volatile LAS unsigned*)(lds + LDS_BYTES - 12); xcd_barrier(xb_); } while (0)
  grid.sync();
  unsigned char* ws = p.ws;
  phase_init(p);
  phase_convert(p, 0, lds);
  GRID_SYNC();
  for (int layer = 0; layer < 2; layer++) {
    if (layer == 1) {
      phase_convert(p, 1, lds);
#pragma unroll 1
      for (int bb = 0; bb < 2; bb++)
        phase_norm(p, bb, p.in[2] + 1024, (bf16_t*)(ws + OFF_HN) + (size_t)bb * LT * 1024);
      GRID_SYNC();
    }
    for (int b = 0; b < 2; b++) {
      bf16_t* HNb = (bf16_t*)(ws + OFF_HN) + (size_t)b * LT * 1024;
      phase_projA(p, layer, b, lds);
      GRID_SYNC();
      phase_U(p, lds);
      GRID_SYNC();
      phase_scan(p);
      GRID_SYNC();
      phase_O(p, layer, layer * 2 + b, lds);
      GRID_SYNC();
      phase_G(p, b, lds);
      GRID_SYNC();
      phase_Y(p, lds);
      GRID_SYNC();
      phase_resid(p, b, (const bf16_t*)(ws + OFF_Y), 1024, (const bf16_t*)(ws + OFF_WO), lds);
      GRID_SYNC();
      phase_norm(p, b, p.in[9] + layer * 1024, HNb);
      GRID_SYNC();
      phase_F1(p, b, lds);
      GRID_SYNC();
      phase_conv(p, layer);
      GRID_SYNC();
      phase_resid(p, b, (const bf16_t*)(ws + OFF_GF), DFF, (const bf16_t*)(ws + OFF_WFO), lds);
      GRID_SYNC();
    }
  }
  phase_final(p);
}

extern "C" void kernel_launch(void* const* d_in, const int* in_sizes, int n_in, void* d_out, int out_size,
                              void* d_ws, size_t ws_size, hipStream_t stream) {
  static int grid_blocks = 0;
  if (grid_blocks == 0) {
    if (n_in != 15 || ws_size < OFF_END) {
      fprintf(stderr, "kernel_launch: need 15 inputs and %zu bytes of workspace, got %d and %zu\n", (size_t)OFF_END, n_in, ws_size);
      grid_blocks = -1; return;
    }
    int dev = 0, cus = 0, per_cu = 0;
    hipGetDevice(&dev);
    hipDeviceGetAttribute(&cus, hipDeviceAttributeMultiprocessorCount, dev);
    if (hipFuncSetAttribute((const void*)fwd_megakernel, hipFuncAttributeMaxDynamicSharedMemorySize, LDS_BYTES) != hipSuccess) {
      fprintf(stderr, "kernel_launch: hipFuncSetAttribute failed\n"); grid_blocks = -1; return;
    }
    hipOccupancyMaxActiveBlocksPerMultiprocessor(&per_cu, (const void*)fwd_megakernel, NTHR, LDS_BYTES);
    if (per_cu < 1) per_cu = 1;
    if (per_cu > 1) per_cu = 1;
    grid_blocks = cus * per_cu;
  }
  if (grid_blocks < 0) return;
  hipMemsetAsync((char*)d_ws + OFF_CTR, 0, 256 + XBAR_BYTES, stream);
  Params p{};
  for (int i = 0; i < 15; i++) p.in[i] = (const float*)d_in[i];
  p.out = (float*)d_out;
  p.ws = (unsigned char*)d_ws;
  void* args[] = {&p};
  hipError_t e = hipLaunchCooperativeKernel((const void*)fwd_megakernel, dim3(grid_blocks), dim3(NTHR), args, LDS_BYTES, stream);
  if (e != hipSuccess) fprintf(stderr, "cooperative launch failed: %s (grid %d)\n", hipGetErrorString(e), grid_blocks);
}
```

```cpp
#include <hip/hip_runtime.h>
#include <hip/hip_cooperative_groups.h>
#include <cstdio>
#include <cstdint>
namespace cg = cooperative_groups;

typedef unsigned short bf16_t;
typedef __attribute__((ext_vector_type(8))) short bf16x8;
typedef __attribute__((ext_vector_type(4))) short bf16x4;
typedef __attribute__((ext_vector_type(4))) float f32x4;
typedef __attribute__((ext_vector_type(4))) unsigned u32x4;

#define DEV __device__ __forceinline__
#define MFMA(a, b, c) __builtin_amdgcn_mfma_f32_16x16x32_bf16(a, b, c, 0, 0, 0)

constexpr int LT = 8320;
constexpr int NCH = 65;
constexpr int NTHR = 512;
constexpr int LDS_BYTES = 144 * 1024;
constexpr int INW = 13312;
constexpr int DFF = 2816;

constexpr size_t SZ_ACT = (size_t)LT * 1024 * 2;
constexpr size_t OFF_WIN = 0;
constexpr size_t OFF_WB = OFF_WIN + (size_t)INW * 1024 * 2;
constexpr size_t OFF_WO = OFF_WB + (size_t)3 * 1024 * 1024 * 2;
constexpr size_t OFF_WFI = OFF_WO + (size_t)1024 * 1024 * 2;
constexpr size_t OFF_WFO = OFF_WFI + (size_t)5632 * 1024 * 2;
constexpr size_t OFF_H = OFF_WFO + (size_t)1024 * 2816 * 2;
constexpr size_t OFF_HN = OFF_H + (size_t)2 * 128 * 1024 * 4;
constexpr size_t OFF_R128 = OFF_HN + 2 * SZ_ACT;
constexpr size_t OFF_R64 = OFF_R128 + (size_t)LT * 64 * 8;
constexpr size_t OFF_CTR = OFF_R64 + (size_t)LT * 32 * 8;
constexpr size_t OFF_XBAR = OFF_CTR + 256;
constexpr size_t XBAR_BYTES = 3456 * 4;
constexpr size_t OFF_ARENA = OFF_XBAR + XBAR_BYTES;
constexpr size_t OFF_RQ = OFF_ARENA;
constexpr size_t OFF_RK = OFF_RQ + SZ_ACT / 2;
constexpr size_t OFF_RKT = OFF_RK + SZ_ACT / 2;
constexpr size_t OFF_RVT = OFF_RKT + SZ_ACT / 2;
constexpr size_t OFF_HQ = OFF_RVT + SZ_ACT;
constexpr size_t OFF_HK = OFF_HQ + SZ_ACT;
constexpr size_t OFF_HCB = OFF_HK + SZ_ACT;
constexpr size_t OFF_HKET = OFF_HCB + 2 * SZ_ACT;
constexpr size_t OFF_HVT = OFF_HKET + SZ_ACT;
constexpr size_t OFF_DQ = OFF_HVT + SZ_ACT;
constexpr size_t OFF_DK = OFF_DQ + SZ_ACT;
constexpr size_t OFF_DVT = OFF_DK + SZ_ACT;
constexpr size_t OFF_ORET = OFF_DVT + SZ_ACT;
constexpr size_t OFF_OHG = OFF_ORET + SZ_ACT;
constexpr size_t OFF_STR = OFF_OHG + SZ_ACT;
constexpr size_t OFF_STH = OFF_STR + SZ_ACT;
constexpr size_t OFF_HDEC = OFF_STH + SZ_ACT;
constexpr size_t OFF_END = OFF_HDEC + (size_t)65 * 1024 * 4;
constexpr size_t OFF_G = OFF_RQ;
constexpr size_t OFF_Y = OFF_HK;
constexpr size_t OFF_ODA = OFF_HKET;
constexpr size_t OFF_U = OFF_ARENA;
constexpr size_t OFF_GF = OFF_U + (size_t)LT * 5632 * 2;

struct Params {
  const float* in[15];
  float* out;
  unsigned char* ws;
};

DEV int get_tid() { int t = threadIdx.x; asm volatile("" : "+v"(t)); return t; }
DEV int get_bid() { int b = blockIdx.x; asm volatile("" : "+s"(b)); return b; }
DEV float shfl_xor_l(float v, int m, int lane) { return __int_as_float(__builtin_amdgcn_ds_bpermute((lane ^ m) << 2, __float_as_int(v))); }
DEV float shfl_l(float v, int srclane) { return __int_as_float(__builtin_amdgcn_ds_bpermute(srclane << 2, __float_as_int(v))); }
DEV float* hrow(const Params& p, int b, int t) {
  return (t < 128) ? (float*)(p.ws + OFF_H) + (size_t)(b * 128 + t) * 1024 : p.out + ((size_t)b * 8192 + (t - 128)) * 1024;
}
typedef __bf16 hwbf16x2 __attribute__((ext_vector_type(2)));
typedef float hwf32x2 __attribute__((ext_vector_type(2)));
DEV unsigned pack2(float a, float b) {
  hwf32x2 f = {a, b};
  hwbf16x2 h = __builtin_convertvector(f, hwbf16x2);
  return __builtin_bit_cast(unsigned, h);
}
DEV bf16_t f2bf(float f) { return (bf16_t)(pack2(f, f) & 0xffffu); }
DEV float bf2f(bf16_t h) { return __uint_as_float(((unsigned)h) << 16); }
DEV uint2 pack4(f32x4 v) { uint2 r; r.x = pack2(v[0], v[1]); r.y = pack2(v[2], v[3]); return r; }
DEV float silu_f(float x) { return x / (1.f + __expf(-x)); }
DEV float sigmoid_f(float x) { return 1.f / (1.f + __expf(-x)); }
DEV float ex2(float x) { return __builtin_amdgcn_exp2f(x); }
DEV bf16x8 ldfrag(const bf16_t* base, int stride, int row, int k) {
  return *(const bf16x8*)(base + row * stride + k);
}

template <int BN, bool TRANS>
DEV void gemm_compute(f32x4 (&acc)[2][BN / 32], const bf16_t* as, const bf16_t* bs, int sw0, int sw1) {
  constexpr int NJ = BN / 32, LS = 64;
#pragma unroll
  for (int ks = 0; ks < 2; ks++) {
    const int sw = ks == 0 ? sw0 : sw1;
    bf16x8 a0 = *(const bf16x8*)(as + sw);
    bf16x8 a1 = *(const bf16x8*)(as + 16 * LS + sw);
#pragma unroll
    for (int j = 0; j < NJ; j++) {
      bf16x8 bb = *(const bf16x8*)(bs + j * 16 * LS + sw);
      if (TRANS) {
        acc[0][j] = MFMA(a0, bb, acc[0][j]);
        acc[1][j] = MFMA(a1, bb, acc[1][j]);
      } else {
        acc[0][j] = MFMA(bb, a0, acc[0][j]);
        acc[1][j] = MFMA(bb, a1, acc[1][j]);
      }
    }
  }
}

template <int BN, bool TRANS>
DEV void gemm_acc(f32x4 (&acc)[2][BN / 32], const bf16_t* __restrict__ A, int lda,
                  const bf16_t* __restrict__ Bt, int ldb, int K, bf16_t* lds) {
  constexpr int LS = 64, A_SZ = 128 * LS, B_SZ = BN * LS, NB = BN / 64;
  const int tid = get_tid(), lane = tid & 63, wave = tid >> 6, wm = wave >> 1, wn = wave & 1;
  const int lr = lane & 15, lg = lane >> 4;
  bf16_t* As = lds;
  bf16_t* Bs = lds + 2 * A_SZ;
  const int crow = tid >> 3, ckc = (tid & 7) * 8;
  const int cks = ((tid & 7) ^ ((crow >> 1) & 7)) * 8;
  const int sw0 = (lg ^ ((lr >> 1) & 7)) * 8, sw1 = sw0 ^ 32;
  const bf16_t* ga = A + (size_t)crow * lda + ckc;
  const bf16_t* gb = Bt + (size_t)crow * ldb + ckc;
  u32x4 ra0, ra1, rb0, rb1, rb2, rb3;
#define GLOAD(k0)                                                        \
  ra0 = *(const u32x4*)(ga + (k0));                                      \
  ra1 = *(const u32x4*)(ga + (size_t)64 * lda + (k0));                   \
  rb0 = *(const u32x4*)(gb + (k0));                                      \
  rb1 = *(const u32x4*)(gb + (size_t)64 * ldb + (k0));                   \
  if (NB == 4) {                                                         \
    rb2 = *(const u32x4*)(gb + (size_t)128 * ldb + (k0));                \
    rb3 = *(const u32x4*)(gb + (size_t)192 * ldb + (k0));                \
  }
#define LSTORE(buf)                                                      \
  *(u32x4*)(As + (buf) * A_SZ + crow * LS + cks) = ra0;                  \
  *(u32x4*)(As + (buf) * A_SZ + (crow + 64) * LS + cks) = ra1;           \
  *(u32x4*)(Bs + (buf) * B_SZ + crow * LS + cks) = rb0;                  \
  *(u32x4*)(Bs + (buf) * B_SZ + (crow + 64) * LS + cks) = rb1;           \
  if (NB == 4) {                                                         \
    *(u32x4*)(Bs + (buf) * B_SZ + (crow + 128) * LS + cks) = rb2;        \
    *(u32x4*)(Bs + (buf) * B_SZ + (crow + 192) * LS + cks) = rb3;        \
  }
  const int nk = K / 64;
  const int aoff = (wm * 32 + lr) * LS;
  const int boff = (wn * (BN / 2) + lr) * LS;
  GLOAD(0)
  __syncthreads();
  LSTORE(0)
  GLOAD(64)
  __syncthreads();
  for (int kt = 0; kt < nk; kt++) {
    const int cur = kt & 1;
    LSTORE(cur ^ 1)
    {
      const int kn = (kt + 2 < nk) ? kt + 2 : nk - 1;
      GLOAD(kn * 64)
    }
    __builtin_amdgcn_sched_barrier(0);
    gemm_compute<BN, TRANS>(acc, As + cur * A_SZ + aoff, Bs + cur * B_SZ + boff, sw0, sw1);
    __syncthreads();
  }
#undef GLOAD
#undef LSTORE
}

template <int BN>
DEV void gemm256_compute(f32x4 (&acc)[4][BN / 32], const bf16_t* as, const bf16_t* bs, int sw0, int sw1) {
  constexpr int LS = 64, NJ = BN / 32;
#pragma unroll
  for (int ks = 0; ks < 2; ks++) {
    const int sw = ks == 0 ? sw0 : sw1;
    bf16x8 a[4];
#pragma unroll
    for (int i = 0; i < 4; i++) a[i] = *(const bf16x8*)(as + i * 16 * LS + sw);
#pragma unroll
    for (int j = 0; j < NJ; j++) {
      bf16x8 bb = *(const bf16x8*)(bs + j * 16 * LS + sw);
#pragma unroll
      for (int i = 0; i < 4; i++) acc[i][j] = MFMA(bb, a[i], acc[i][j]);
    }
  }
}

template <int BN>
DEV void gemm256_acc(f32x4 (&acc)[4][BN / 32], const bf16_t* __restrict__ A, int lda, int m_valid,
                     const bf16_t* __restrict__ Bt, int ldb, int K, bf16_t* lds) {
  constexpr int LS = 64, A_SZ = 256 * LS, B_SZ = BN * LS, NB = BN / 64;
  const int tid = get_tid(), lane = tid & 63, wave = tid >> 6, wm = wave >> 1, wn = wave & 1;
  const int lr = lane & 15, lg = lane >> 4;
  bf16_t* As = lds;
  bf16_t* Bs = lds + 2 * A_SZ;
  const int crow = tid >> 3, ckc = (tid & 7) * 8;
  const int cks = ((tid & 7) ^ ((crow >> 1) & 7)) * 8;
  const int sw0 = (lg ^ ((lr >> 1) & 7)) * 8, sw1 = sw0 ^ 32;
  const bf16_t* ga0 = A + (size_t)min(crow, m_valid - 1) * lda + ckc;
  const bf16_t* ga1 = A + (size_t)min(crow + 64, m_valid - 1) * lda + ckc;
  const bf16_t* ga2 = A + (size_t)min(crow + 128, m_valid - 1) * lda + ckc;
  const bf16_t* ga3 = A + (size_t)min(crow + 192, m_valid - 1) * lda + ckc;
  const bf16_t* gb = Bt + (size_t)crow * ldb + ckc;
  u32x4 ra0, ra1, ra2, ra3, rb0, rb1, rb2, rb3;
#define GLOAD(k0)                                                        \
  ra0 = *(const u32x4*)(ga0 + (k0));                                     \
  ra1 = *(const u32x4*)(ga1 + (k0));                                     \
  ra2 = *(const u32x4*)(ga2 + (k0));                                     \
  ra3 = *(const u32x4*)(ga3 + (k0));                                     \
  rb0 = *(const u32x4*)(gb + (k0));                                      \
  rb1 = *(const u32x4*)(gb + (size_t)64 * ldb + (k0));                   \
  if (NB == 4) {                                                         \
    rb2 = *(const u32x4*)(gb + (size_t)128 * ldb + (k0));                \
    rb3 = *(const u32x4*)(gb + (size_t)192 * ldb + (k0));                \
  }
#define LSTORE(buf)                                                      \
  *(u32x4*)(As + (buf) * A_SZ + crow * LS + cks) = ra0;                  \
  *(u32x4*)(As + (buf) * A_SZ + (crow + 64) * LS + cks) = ra1;           \
  *(u32x4*)(As + (buf) * A_SZ + (crow + 128) * LS + cks) = ra2;          \
  *(u32x4*)(As + (buf) * A_SZ + (crow + 192) * LS + cks) = ra3;          \
  *(u32x4*)(Bs + (buf) * B_SZ + crow * LS + cks) = rb0;                  \
  *(u32x4*)(Bs + (buf) * B_SZ + (crow + 64) * LS + cks) = rb1;           \
  if (NB == 4) {                                                         \
    *(u32x4*)(Bs + (buf) * B_SZ + (crow + 128) * LS + cks) = rb2;        \
    *(u32x4*)(Bs + (buf) * B_SZ + (crow + 192) * LS + cks) = rb3;        \
  }
  const int nk = K / 64;
  const int aoff = (wm * 64 + lr) * LS;
  const int boff = (wn * (BN / 2) + lr) * LS;
  GLOAD(0)
  __syncthreads();
  LSTORE(0)
  GLOAD(64)
  __syncthreads();
  for (int kt = 0; kt < nk; kt++) {
    const int cur = kt & 1;
    LSTORE(cur ^ 1)
    {
      const int kn = (kt + 2 < nk) ? kt + 2 : nk - 1;
      GLOAD(kn * 64)
    }
    __builtin_amdgcn_sched_barrier(0);
    gemm256_compute<BN>(acc, As + cur * A_SZ + aoff, Bs + cur * B_SZ + boff, sw0, sw1);
    __syncthreads();
  }
#undef GLOAD
#undef LSTORE
}

DEV void tconv_tiles4(const float* __restrict__ src, int K, int N, bf16_t* __restrict__ dst, int idx0, int ntn, float* tile) {
  const int tid = get_tid();
  const int r = tid >> 4, c4 = (tid & 15) * 4;
  float4 v[4][2];
#pragma unroll
  for (int u = 0; u < 4; u++) {
    const int idx = idx0 + u, tk = idx / ntn, tn = idx - tk * ntn;
#pragma unroll
    for (int i = 0; i < 2; i++) v[u][i] = *(const float4*)(src + (size_t)(tk * 64 + r + i * 32) * N + tn * 64 + c4);
  }
  __syncthreads();
#pragma unroll
  for (int u = 0; u < 4; u++)
#pragma unroll
    for (int i = 0; i < 2; i++) {
      float* t = tile + u * (64 * 65) + (r + i * 32) * 65 + c4;
      t[0] = v[u][i].x; t[1] = v[u][i].y; t[2] = v[u][i].z; t[3] = v[u][i].w;
    }
  __syncthreads();
  const int n = tid >> 3, k8 = (tid & 7) * 8;
#pragma unroll
  for (int u = 0; u < 4; u++) {
    const int idx = idx0 + u, tk = idx / ntn, tn = idx - tk * ntn;
    const float* t = tile + u * (64 * 65);
    u32x4 o;
    o[0] = pack2(t[(k8 + 0) * 65 + n], t[(k8 + 1) * 65 + n]);
    o[1] = pack2(t[(k8 + 2) * 65 + n], t[(k8 + 3) * 65 + n]);
    o[2] = pack2(t[(k8 + 4) * 65 + n], t[(k8 + 5) * 65 + n]);
    o[3] = pack2(t[(k8 + 6) * 65 + n], t[(k8 + 7) * 65 + n]);
    *(u32x4*)(dst + (size_t)(tn * 64 + n) * K + tk * 64 + k8) = o;
  }
}

DEV void phase_convert(const Params& p, int layer, unsigned char* lds) {
  unsigned char* ws = p.ws;
  float* tile = (float*)lds;
  for (int g = get_bid(); g < 1616; g += gridDim.x) {
    const float* src; bf16_t* dst; int K, N, gi;
    if (g < 832) { gi = g; src = p.in[3] + (size_t)layer * 1024 * INW; K = 1024; N = INW; dst = (bf16_t*)(ws + OFF_WIN); }
    else if (g < 832 + 192) { gi = g - 832; const int br = gi >> 6; gi &= 63; src = p.in[4] + ((size_t)layer * 3 + br) * 1024 * 1024; K = 1024; N = 1024; dst = (bf16_t*)(ws + OFF_WB) + (size_t)br * 1024 * 1024; }
    else if (g < 1088) { gi = g - 1024; src = p.in[5] + (size_t)layer * 1024 * 1024; K = 1024; N = 1024; dst = (bf16_t*)(ws + OFF_WO); }
    else if (g < 1440) { gi = g - 1088; src = p.in[10] + (size_t)layer * 1024 * 5632; K = 1024; N = 5632; dst = (bf16_t*)(ws + OFF_WFI); }
    else { gi = g - 1440; src = p.in[13] + (size_t)layer * 2816 * 1024; K = 2816; N = 1024; dst = (bf16_t*)(ws + OFF_WFO); }
    tconv_tiles4(src, K, N, dst, gi * 4, N / 64, (float*)tile);
  }
}

DEV void phase_init(const Params& p) {
  unsigned char* ws = p.ws;
  const int gt = get_bid() * NTHR + get_tid(), gs = gridDim.x * NTHR;
  {
    const int lane = get_tid() & 63, wave = get_tid() >> 6;
    const float* g = p.in[2];
    for (int row = get_bid() * 8 + wave; row < 2 * LT; row += gridDim.x * 8) {
      const int b = row / LT, t = row - b * LT;
      float4 v[4]; float ss = 0.f;
#pragma unroll
      for (int k = 0; k < 4; k++) {
        const int c4 = k * 256 + lane * 4;
        if (t < 112) v[k] = make_float4(0.f, 0.f, 0.f, 0.f);
        else if (t < 128) v[k] = *(const float4*)(p.in[1] + (size_t)(t - 112) * 1024 + c4);
        else v[k] = *(const float4*)(p.in[0] + ((size_t)b * 8192 + (t - 128)) * 1024 + c4);
        *(float4*)(hrow(p, b, t) + c4) = v[k];
        ss += v[k].x * v[k].x + v[k].y * v[k].y + v[k].z * v[k].z + v[k].w * v[k].w;
      }
#pragma unroll
      for (int o = 1; o < 64; o <<= 1) ss += shfl_xor_l(ss, o, lane);
      const float rs = rsqrtf(ss * (1.f / 1024.f) + 1e-6f);
      bf16_t* dst = (bf16_t*)(ws + OFF_HN) + (size_t)b * LT * 1024 + (size_t)t * 1024;
#pragma unroll
      for (int k = 0; k < 4; k++) {
        float4 gg = *(const float4*)(g + k * 256 + lane * 4);
        uint2 o; o.x = pack2(v[k].x * rs * gg.x, v[k].y * rs * gg.y); o.y = pack2(v[k].z * rs * gg.z, v[k].w * rs * gg.w);
        *(uint2*)(dst + k * 256 + lane * 4) = o;
      }
    }
  }
  float2* R128 = (float2*)(ws + OFF_R128);
  float2* R64 = (float2*)(ws + OFF_R64);
  for (int idx = gt; idx < LT * 96; idx += gs) {
    const int t = idx / 96, f = idx - t * 96;
    float inv;
    if (f < 64) inv = powf(10000.f, -(float)(2 * f) / 128.f);
    else inv = powf(10000.f, -(float)(2 * (f - 64)) / 64.f);
    const float ang = (float)(t - 112) * inv;
    const double ad = (double)ang;
    const double n = rint(ad * 0.15915494309189535);
    const float rr = (float)(ad - n * 6.283185307179586);
    float2 cs; cs.x = __cosf(rr); cs.y = __sinf(rr);
    if (f < 64) R128[(size_t)t * 64 + f] = cs; else R64[(size_t)t * 32 + (f - 64)] = cs;
  }
}

DEV void phase_norm(const Params& p, int b, const float* __restrict__ g, bf16_t* __restrict__ dst) {
  const int lane = get_tid() & 63, wave = get_tid() >> 6;
  for (int row = get_bid() * 8 + wave; row < LT; row += gridDim.x * 8) {
    const float* src = hrow(p, b, row);
    float4 v[4]; float ss = 0.f;
#pragma unroll
    for (int k = 0; k < 4; k++) { v[k] = *(const float4*)(src + k * 256 + lane * 4); ss += v[k].x * v[k].x + v[k].y * v[k].y + v[k].z * v[k].z + v[k].w * v[k].w; }
#pragma unroll
    for (int o = 1; o < 64; o <<= 1) ss += shfl_xor_l(ss, o, lane);
    const float rs = rsqrtf(ss * (1.f / 1024.f) + 1e-6f);
#pragma unroll
    for (int k = 0; k < 4; k++) {
      float4 gg = *(const float4*)(g + k * 256 + lane * 4);
      uint2 o; o.x = pack2(v[k].x * rs * gg.x, v[k].y * rs * gg.y); o.y = pack2(v[k].z * rs * gg.z, v[k].w * rs * gg.w);
      *(uint2*)(dst + (size_t)row * 1024 + k * 256 + lane * 4) = o;
    }
  }
}

DEV void phase_final(const Params& p) {
  const float* g = p.in[14];
  const int lane = get_tid() & 63, wave = get_tid() >> 6;
  for (int row = get_bid() * 8 + wave; row < 2 * 8192; row += gridDim.x * 8) {
    const float* src = p.out + (size_t)row * 1024;
    float4 v[4]; float ss = 0.f;
#pragma unroll
    for (int k = 0; k < 4; k++) { v[k] = *(const float4*)(src + k * 256 + lane * 4); ss += v[k].x * v[k].x + v[k].y * v[k].y + v[k].z * v[k].z + v[k].w * v[k].w; }
#pragma unroll
    for (int o = 1; o < 64; o <<= 1) ss += shfl_xor_l(ss, o, lane);
    const float rs = rsqrtf(ss * (1.f / 1024.f) + 1e-6f);
#pragma unroll
    for (int k = 0; k < 4; k++) {
      float4 gg = *(const float4*)(g + k * 256 + lane * 4);
      float4 o = make_float4(v[k].x * rs * gg.x, v[k].y * rs * gg.y, v[k].z * rs * gg.z, v[k].w * rs * gg.w);
      *(float4*)(p.out + (size_t)row * 1024 + k * 256 + lane * 4) = o;
    }
  }
}

DEV void tile_map(int it, int MT, int NG, int& mt, int& nt) {
  const int ng = it / (MT * NG), rem = it - ng * (MT * NG);
  mt = rem / NG; nt = ng * NG + (rem - mt * NG);
}
DEV int vblock() { const int b = get_bid(), G = (int)gridDim.x; return ((G & 7) == 0) ? (b & 7) * (G >> 3) + (b >> 3) : b; }

DEV void phase_projA(const Params& p, int layer, int b, unsigned char* ldsraw) {
  unsigned char* ws = p.ws;
  bf16_t* lds = (bf16_t*)ldsraw;
  const bf16_t* HN = (const bf16_t*)(ws + OFF_HN) + (size_t)b * LT * 1024;
  const bf16_t* WIN = (const bf16_t*)(ws + OFF_WIN);
  const float2* R128 = (const float2*)(ws + OFF_R128);
  const float2* R64 = (const float2*)(ws + OFF_R64);
  for (int item = vblock(); item < 65 * 32; item += gridDim.x) {
    int nt, mt; tile_map(item, 65, 4, mt, nt);
    int n0, seg, segstart;
    if (nt < 8) { n0 = nt * 256; seg = nt < 2 ? 0 : (nt < 4 ? 1 : 2); segstart = seg == 0 ? 0 : (seg == 1 ? 512 : 1024); }
    else if (nt < 20) { n0 = 3072 + (nt - 8) * 256; seg = 3 + (nt - 8) / 4; segstart = 3072 + (seg - 3) * 1024; }
    else { n0 = 7168 + (nt - 20) * 256; seg = 6 + (nt - 20) / 4; segstart = 7168 + (seg - 6) * 1024; }
    const bf16_t* A = HN + (size_t)mt * 128 * 1024;
    const bf16_t* Bt = WIN + (size_t)n0 * 1024;
    f32x4 acc[2][8];
#pragma unroll
    for (int i = 0; i < 2; i++)
#pragma unroll
      for (int j = 0; j < 8; j++) acc[i][j] = (f32x4){0.f, 0.f, 0.f, 0.f};
    if (seg == 0 || seg == 3 || seg == 6 || seg == 7) {
      gemm_acc<256, false>(acc, A, 1024, Bt, 1024, 1024, lds);
      const int tid = get_tid(), lane = tid & 63, wave = tid >> 6, wm = wave >> 1, wn = wave & 1; const int lr = lane & 15, lg = lane >> 4; (void)tid; (void)lane; (void)wm; (void)wn; (void)lr; (void)lg;
      const int cw = (n0 - segstart) + wn * 128;
      bf16_t* dstb; int ld;
      if (seg == 0) { dstb = (bf16_t*)(ws + OFF_RQ); ld = 512; }
      else if (seg == 3) { dstb = (bf16_t*)(ws + OFF_HQ); ld = 1024; }
      else if (seg == 6) { dstb = (bf16_t*)(ws + OFF_DQ); ld = 1024; }
      else { dstb = (bf16_t*)(ws + OFF_DK); ld = 1024; }
#pragma unroll
      for (int i = 0; i < 2; i++) {
        const int t = mt * 128 + wm * 32 + i * 16 + lr;
        if (seg == 0) {
          const float2* tab = R128 + (size_t)t * 64;
#pragma unroll
          for (int j = 0; j < 4; j++)
#pragma unroll
            for (int r = 0; r < 4; r++) {
              float2 cs = tab[j * 16 + lg * 4 + r];
              float x1 = acc[i][j][r], x2 = acc[i][j + 4][r];
              acc[i][j][r] = x1 * cs.x - x2 * cs.y;
              acc[i][j + 4][r] = x2 * cs.x + x1 * cs.y;
            }
        } else if (seg == 6 || seg == 7) {
          const float2* tab = R64 + (size_t)t * 32;
          const float sc = (seg == 6) ? (0.125f * 1.4426950408889634f) : 1.f;
#pragma unroll
          for (int jq = 0; jq < 4; jq++) {
            const int j = (jq & 1) + (jq >> 1) * 4;
#pragma unroll
            for (int r = 0; r < 4; r++) {
              float2 cs = tab[(jq & 1) * 16 + lg * 4 + r];
              float x1 = acc[i][j][r], x2 = acc[i][j + 2][r];
              acc[i][j][r] = (x1 * cs.x - x2 * cs.y) * sc;
              acc[i][j + 2][r] = (x2 * cs.x + x1 * cs.y) * sc;
            }
          }
        }
        bf16_t* dst = dstb + (size_t)t * ld + cw;
#pragma unroll
        for (int j = 0; j < 8; j++) *(uint2*)(dst + j * 16 + lg * 4) = pack4(acc[i][j]);
      }
    } else {
      gemm_acc<256, true>(acc, A, 1024, Bt, 1024, 1024, lds);
      const int tid = get_tid(), lane = tid & 63, wave = tid >> 6, wm = wave >> 1, wn = wave & 1; const int lr = lane & 15, lg = lane >> 4; (void)tid; (void)lane; (void)wm; (void)wn; (void)lr; (void)lg;
      const int cw = (n0 - segstart) + wn * 128;
      if (seg == 1) {
        bf16_t* RK = (bf16_t*)(ws + OFF_RK);
        bf16_t* RKT = (bf16_t*)(ws + OFF_RKT);
        const int h = cw >> 7;
        const float l2g = log2f(1.f - ex2(-5.f - (float)h));
#pragma unroll
        for (int i = 0; i < 2; i++) {
          const int mb = wm * 32 + i * 16 + lg * 4;
#pragma unroll
          for (int j = 0; j < 4; j++)
#pragma unroll
            for (int r = 0; r < 4; r++) {
              const int t = mt * 128 + mb + r;
              float2 cs = R128[(size_t)t * 64 + j * 16 + lr];
              const float sc = (t >= 112) ? 0.08838834764831845f : 0.f;
              float x1 = acc[i][j][r], x2 = acc[i][j + 4][r];
              acc[i][j][r] = (x1 * cs.x - x2 * cs.y) * sc;
              acc[i][j + 4][r] = (x2 * cs.x + x1 * cs.y) * sc;
            }
#pragma unroll
          for (int j = 0; j < 8; j++) {
            const int col = cw + j * 16 + lr;
            f32x4 kd;
#pragma unroll
            for (int r = 0; r < 4; r++) {
              const int t = mt * 128 + mb + r;
              RK[(size_t)t * 512 + col] = f2bf(acc[i][j][r]);
              kd[r] = acc[i][j][r] * ex2(l2g * (float)(127 - (mb + r)));
            }
            *(uint2*)(RKT + (size_t)col * LT + mt * 128 + mb) = pack4(kd);
          }
        }
      } else if (seg == 2 || seg == 5 || seg == 8) {
        bf16_t* dT = (bf16_t*)(ws + (seg == 2 ? OFF_RVT : (seg == 5 ? OFF_HVT : OFF_DVT)));
#pragma unroll
        for (int i = 0; i < 2; i++) {
          const int mb = wm * 32 + i * 16 + lg * 4;
#pragma unroll
          for (int j = 0; j < 8; j++) {
            const int col = cw + j * 16 + lr;
            f32x4 v = acc[i][j];
            if (seg == 5) {
#pragma unroll
              for (int r = 0; r < 4; r++) if (mt * 128 + mb + r < 112) v[r] = 0.f;
            }
            *(uint2*)(dT + (size_t)col * LT + mt * 128 + mb) = pack4(v);
          }
        }
      } else {
        float* Lf = (float*)ldsraw;
        float* HCB = (float*)(ws + OFF_HCB);
        bf16_t* HK = (bf16_t*)(ws + OFF_HK);
        bf16_t* HKET = (bf16_t*)(ws + OFF_HKET);
        float* HDEC = (float*)(ws + OFF_HDEC);
        const float* lbp = p.in[6];
#pragma unroll
        for (int j = 0; j < 8; j++) {
          const int col = cw + j * 16 + lr;
          float lb = 0.f;
          if (layer == 1) lb = 1.f / (1.f + __expf(lbp[col] - lbp[1024 + col]));
#pragma unroll
          for (int i = 0; i < 2; i++)
#pragma unroll
            for (int r = 0; r < 4; r++) {
              const int m = wm * 32 + i * 16 + lg * 4 + r;
              const float z = acc[i][j][r];
              const float kk = (1.f - lb) / (1.f + __expf(z));
              const float lf = fmaxf(log1pf(-kk), -69.0776f);
              acc[i][j][r] = kk;
              Lf[m * 260 + wn * 128 + j * 16 + lr] = lf;
            }
        }
        __syncthreads();
        {
          const int colL = tid & 255, half = tid >> 8;
          float run = 0.f;
          for (int rr = 0; rr < 64; rr++) {
            float* q = &Lf[(half * 64 + rr) * 260 + colL];
            run += *q; *q = run;
          }
        }
        __syncthreads();
#pragma unroll
        for (int j = 0; j < 8; j++) {
          const int colL = wn * 128 + j * 16 + lr;
          const int col = cw + j * 16 + lr;
          const float ft = Lf[63 * 260 + colL];
          const float cend = Lf[127 * 260 + colL] + ft;
#pragma unroll
          for (int i = 0; i < 2; i++) {
            const int mb = wm * 32 + i * 16 + lg * 4;
            f32x4 ke;
#pragma unroll
            for (int r = 0; r < 4; r++) {
              const int m = mb + r;
              const int t = mt * 128 + m;
              const float cb = Lf[m * 260 + colL] + (m >= 64 ? ft : 0.f);
              HCB[(size_t)t * 1024 + col] = cb;
              HK[(size_t)t * 1024 + col] = f2bf(acc[i][j][r]);
              ke[r] = acc[i][j][r] * __expf(cend - cb);
              if (m == 127) HDEC[mt * 1024 + col] = __expf(cend);
            }
            *(uint2*)(HKET + (size_t)col * LT + mt * 128 + mb) = pack4(ke);
          }
        }
        __syncthreads();
      }
    }
  }
}

DEV void phase_U(const Params& p, unsigned char* ldsraw) {
  unsigned char* ws = p.ws;
  bf16_t* lds = (bf16_t*)ldsraw;
  for (int item = get_bid(); item < 1040; item += gridDim.x) {
    const bf16_t *A, *Bt; bf16_t* dst;
    if (item < 520) {
      const int h = item & 3, rest = item >> 2, mh = rest & 1, c = rest >> 1;
      A = (const bf16_t*)(ws + OFF_RVT) + (size_t)(h * 256 + mh * 128) * LT + c * 128;
      Bt = (const bf16_t*)(ws + OFF_RKT) + (size_t)(h * 128) * LT + c * 128;
      dst = (bf16_t*)(ws + OFF_STR) + ((size_t)(h * 65 + c) * 256 + mh * 128) * 128;
    } else {
      const int it = item - 520, h = it & 7, c = it >> 3;
      A = (const bf16_t*)(ws + OFF_HVT) + (size_t)(h * 128) * LT + c * 128;
      Bt = (const bf16_t*)(ws + OFF_HKET) + (size_t)(h * 128) * LT + c * 128;
      dst = (bf16_t*)(ws + OFF_STH) + ((size_t)(h * 65 + c) * 128) * 128;
    }
    f32x4 acc[2][4];
#pragma unroll
    for (int i = 0; i < 2; i++)
#pragma unroll
      for (int j = 0; j < 4; j++) acc[i][j] = (f32x4){0.f, 0.f, 0.f, 0.f};
    gemm_acc<128, false>(acc, A, LT, Bt, LT, 128, lds);
      const int tid = get_tid(), lane = tid & 63, wave = tid >> 6, wm = wave >> 1, wn = wave & 1; const int lr = lane & 15, lg = lane >> 4; (void)tid; (void)lane; (void)wm; (void)wn; (void)lr; (void)lg;
#pragma unroll
    for (int i = 0; i < 2; i++)
#pragma unroll
      for (int j = 0; j < 4; j++)
        *(uint2*)(dst + (size_t)(wm * 32 + i * 16 + lr) * 128 + wn * 64 + j * 16 + lg * 4) = pack4(acc[i][j]);
  }
}

DEV void phase_scan(const Params& p) {
  unsigned char* ws = p.ws;
  const float* HDEC = (const float*)(ws + OFF_HDEC);
  for (int task = get_bid() * NTHR + get_tid(); task < 65536; task += gridDim.x * NTHR) {
    bf16_t* base; size_t stride; int h, d4; bool hg;
    float dec0 = 0.f;
    if (task < 32768) {
      const int v = task; d4 = (v & 31) * 4; const int e = (v >> 5) & 255; h = v >> 13; hg = false;
      base = (bf16_t*)(ws + OFF_STR) + ((size_t)(h * 65) * 256 + e) * 128 + d4; stride = 256 * 128;
      dec0 = ex2(128.f * log2f(1.f - ex2(-5.f - (float)h)));
    } else {
      const int v = task - 32768; d4 = (v & 31) * 4; const int e = (v >> 5) & 127; h = v >> 12; hg = true;
      base = (bf16_t*)(ws + OFF_STH) + ((size_t)(h * 65) * 128 + e) * 128 + d4; stride = 128 * 128;
    }
    float c0 = 0.f, c1 = 0.f, c2 = 0.f, c3 = 0.f;
    for (int cg0 = 0; cg0 < 65; cg0 += 13) {
      uint2 u[13]; float4 dc[13];
#pragma unroll
      for (int k = 0; k < 13; k++) {
        u[k] = *(const uint2*)(base + (size_t)(cg0 + k) * stride);
        if (hg) dc[k] = *(const float4*)(HDEC + (size_t)(cg0 + k) * 1024 + h * 128 + d4);
        else dc[k] = make_float4(dec0, dec0, dec0, dec0);
      }
#pragma unroll
      for (int k = 0; k < 13; k++) {
        uint2 o; o.x = pack2(c0, c1); o.y = pack2(c2, c3);
        *(uint2*)(base + (size_t)(cg0 + k) * stride) = o;
        c0 = dc[k].x * c0 + bf2f((bf16_t)(u[k].x & 0xffff));
        c1 = dc[k].y * c1 + bf2f((bf16_t)(u[k].x >> 16));
        c2 = dc[k].z * c2 + bf2f((bf16_t)(u[k].y & 0xffff));
        c3 = dc[k].w * c3 + bf2f((bf16_t)(u[k].y >> 16));
      }
    }
  }
}

DEV void attn_item(const Params& p, int layer, int h, int qb, float lam, bf16_t* lds) {
  unsigned char* ws = p.ws;
  const bf16_t* DQ = (const bf16_t*)(ws + OFF_DQ);
  bf16_t* ODA = (bf16_t*)(ws + OFF_ODA);
  const bf16_t* DK = (const bf16_t*)(ws + OFF_DK);
  const bf16_t* DVT = (const bf16_t*)(ws + OFF_DVT);
  constexpr int PS = 136, XS = 132;
  constexpr int TS = 128 * PS;
  bf16_t* KV = lds;
  float* X = (float*)lds;
  const int tid = get_tid(), lane = tid & 63, wave = tid >> 6;
  const int lr = lane & 15, lg = lane >> 4;
  const int grp = wave >> 2, wq = wave & 3;
  const int t0 = qb * 128;
  const int lrow = tid >> 4, lc8 = (tid & 15) * 8;
  const bf16_t* gq = DQ + (size_t)(t0 + wq * 32 + lr) * 1024 + h * 128 + grp * 64 + lg * 8;
  const bf16x8 a00 = *(const bf16x8*)(gq);
  const bf16x8 a01 = *(const bf16x8*)(gq + 32);
  const bf16x8 a10 = *(const bf16x8*)(gq + (size_t)16 * 1024);
  const bf16x8 a11 = *(const bf16x8*)(gq + (size_t)16 * 1024 + 32);
  f32x4 o[2][8];
#pragma unroll
  for (int i = 0; i < 2; i++)
#pragma unroll
    for (int j = 0; j < 8; j++) o[i][j] = (f32x4){0.f, 0.f, 0.f, 0.f};
  float mrun0 = -1e30f, mrun1 = -1e30f, lrun0 = 0.f, lrun1 = 0.f;
  u32x4 rk0, rk1, rk2, rk3, rv0, rv1, rv2, rv3;
  const unsigned ko = (unsigned)(lrow * 1024 + h * 128 + lc8);
  const unsigned vo = (unsigned)((h * 128 + lrow) * LT + lc8);
#define ALOAD(kbn)                                                              \
  rk0 = *(const u32x4*)(DK + (ko + (unsigned)(kbn) * 131072u));                 \
  rk1 = *(const u32x4*)(DK + (ko + (unsigned)(kbn) * 131072u + 32768u));        \
  rk2 = *(const u32x4*)(DK + (ko + (unsigned)(kbn) * 131072u + 65536u));        \
  rk3 = *(const u32x4*)(DK + (ko + (unsigned)(kbn) * 131072u + 98304u));        \
  rv0 = *(const u32x4*)(DVT + (vo + (unsigned)(kbn) * 128u));                   \
  rv1 = *(const u32x4*)(DVT + (vo + (unsigned)(kbn) * 128u + 32u * LT));        \
  rv2 = *(const u32x4*)(DVT + (vo + (unsigned)(kbn) * 128u + 64u * LT));        \
  rv3 = *(const u32x4*)(DVT + (vo + (unsigned)(kbn) * 128u + 96u * LT));
#define ASTORE(sp)                                                              \
  *(u32x4*)((sp)) = rk0;                                                        \
  *(u32x4*)((sp) + 32 * PS) = rk1;                                              \
  *(u32x4*)((sp) + 64 * PS) = rk2;                                              \
  *(u32x4*)((sp) + 96 * PS) = rk3;                                              \
  *(u32x4*)((sp) + 2 * TS) = rv0;                                               \
  *(u32x4*)((sp) + 2 * TS + 32 * PS) = rv1;                                     \
  *(u32x4*)((sp) + 2 * TS + 64 * PS) = rv2;                                     \
  *(u32x4*)((sp) + 2 * TS + 96 * PS) = rv3;
  ALOAD(0)
  const int qrow0 = t0 + wq * 32 + lr;
  __syncthreads();
  ASTORE(KV + lrow * PS + lc8)
  {
    const int kb1 = qb > 0 ? 1 : 0;
    ALOAD(kb1)
  }
  __syncthreads();
  for (int kb = 0; kb <= qb; kb++) {
    const int cur = kb & 1;
    const bf16_t* kp = KV + cur * TS + lr * PS + grp * 64 + lg * 8;
    const bf16_t* vq = KV + 2 * TS + cur * TS + lr * PS + lg * 4;
    {
      bf16_t* sp = KV + (cur ^ 1) * TS + lrow * PS + lc8;
      ASTORE(sp)
    }
    __builtin_amdgcn_sched_barrier(0);
    f32x4 s[2][8];
    {
#pragma unroll
      for (int j = 0; j < 8; j++) {
        const bf16x8 kf0 = *(const bf16x8*)(kp + j * 16 * PS);
        const bf16x8 kf1 = *(const bf16x8*)(kp + j * 16 * PS + 32);
        s[0][j] = MFMA(kf0, a00, ((f32x4){0.f, 0.f, 0.f, 0.f}));
        s[1][j] = MFMA(kf0, a10, ((f32x4){0.f, 0.f, 0.f, 0.f}));
        s[0][j] = MFMA(kf1, a01, s[0][j]);
        s[1][j] = MFMA(kf1, a11, s[1][j]);
      }
    }
    __builtin_amdgcn_sched_barrier(0);
    {
      const int kbn = (kb + 2 <= qb) ? kb + 2 : qb;
      ALOAD(kbn)
    }
    __builtin_amdgcn_sched_barrier(0);
    if (kb == qb || kb == 0) {
#pragma unroll
      for (int i = 0; i < 2; i++)
#pragma unroll
        for (int j = 0; j < 8; j++)
#pragma unroll
          for (int r = 0; r < 4; r++) {
            const int key = kb * 128 + j * 16 + lg * 4 + r;
            if (key > qrow0 + 16 * i || key < 112) s[i][j][r] = -1e30f;
          }
    }
    float al[2];
#pragma unroll
    for (int i = 0; i < 2; i++) {
      float mx = -1e30f;
#pragma unroll
      for (int j = 0; j < 8; j++)
#pragma unroll
        for (int r = 0; r < 4; r++) mx = fmaxf(mx, s[i][j][r]);
      mx = fmaxf(mx, shfl_xor_l(mx, 16, lane));
      mx = fmaxf(mx, shfl_xor_l(mx, 32, lane));
      const float mold = i == 0 ? mrun0 : mrun1;
      const float mnew = fmaxf(mold, mx);
      al[i] = ex2(mold - mnew);
      float ps = 0.f;
#pragma unroll
      for (int j = 0; j < 8; j++)
#pragma unroll
        for (int r = 0; r < 4; r++) { const float pv = ex2(s[i][j][r] - mnew); s[i][j][r] = pv; ps += pv; }
      if (i == 0) { mrun0 = mnew; lrun0 = lrun0 * al[0] + ps; } else { mrun1 = mnew; lrun1 = lrun1 * al[1] + ps; }
    }
    if (__builtin_amdgcn_ballot_w64(al[0] != 1.f || al[1] != 1.f) != 0ull) {
#pragma unroll
      for (int i = 0; i < 2; i++) {
        float ao[4];
#pragma unroll
        for (int r = 0; r < 4; r++) ao[r] = shfl_l(al[i], lg * 4 + r);
#pragma unroll
        for (int je = 0; je < 8; je++)
#pragma unroll
          for (int r = 0; r < 4; r++) o[i][je][r] *= ao[r];
      }
    }
#pragma unroll
    for (int ks = 0; ks < 4; ks++) {
      union { u32x4 u; bf16x8 v; } pf0, pf1;
      pf0.u[0] = pack2(s[0][2 * ks][0], s[0][2 * ks][1]);
      pf0.u[1] = pack2(s[0][2 * ks][2], s[0][2 * ks][3]);
      pf0.u[2] = pack2(s[0][2 * ks + 1][0], s[0][2 * ks + 1][1]);
      pf0.u[3] = pack2(s[0][2 * ks + 1][2], s[0][2 * ks + 1][3]);
      pf1.u[0] = pack2(s[1][2 * ks][0], s[1][2 * ks][1]);
      pf1.u[1] = pack2(s[1][2 * ks][2], s[1][2 * ks][3]);
      pf1.u[2] = pack2(s[1][2 * ks + 1][0], s[1][2 * ks + 1][1]);
      pf1.u[3] = pack2(s[1][2 * ks + 1][2], s[1][2 * ks + 1][3]);
#pragma unroll
      for (int je = 0; je < 8; je++) {
        const bf16_t* vp = vq + je * 16 * PS + ks * 32;
        union { uint2 u[2]; bf16x8 v; } vf;
        vf.u[0] = *(const uint2*)vp;
        vf.u[1] = *(const uint2*)(vp + 16);
        o[0][je] = MFMA(pf0.v, vf.v, o[0][je]);
        o[1][je] = MFMA(pf1.v, vf.v, o[1][je]);
      }
    }
    __builtin_amdgcn_sched_barrier(0);
    __syncthreads();
  }
#undef ASTORE
#undef ALOAD
#pragma unroll
  for (int i = 0; i < 2; i++) {
    float l = i == 0 ? lrun0 : lrun1;
    l += shfl_xor_l(l, 16, lane);
    l += shfl_xor_l(l, 32, lane);
    const float inv = l > 0.f ? 1.f / l : 0.f;
#pragma unroll
    for (int r = 0; r < 4; r++) {
      const float ir = shfl_l(inv, lg * 4 + r);
#pragma unroll
      for (int je = 0; je < 8; je++) o[i][je][r] *= ir;
    }
  }
  __syncthreads();
  if (grp == 1) {
#pragma unroll
    for (int i = 0; i < 2; i++)
#pragma unroll
      for (int je = 0; je < 8; je++)
#pragma unroll
        for (int r = 0; r < 4; r++) X[(wq * 32 + i * 16 + lg * 4 + r) * XS + je * 16 + lr] = o[i][je][r];
  }
  __syncthreads();
  if (grp == 0) {
    int ly = layer; asm volatile("" : "+s"(ly));
    const float li = (ly == 0) ? 0.2f : 0.35550906759f;
    const float* sg = p.in[8] + ly * 128;
#pragma unroll
    for (int i = 0; i < 2; i++) {
      float ss[4] = {0.f, 0.f, 0.f, 0.f};
#pragma unroll
      for (int je = 0; je < 8; je++)
#pragma unroll
        for (int r = 0; r < 4; r++) {
          const float v = o[i][je][r] - lam * X[(wq * 32 + i * 16 + lg * 4 + r) * XS + je * 16 + lr];
          o[i][je][r] = v; ss[r] += v * v;
        }
#pragma unroll
      for (int r = 0; r < 4; r++) {
        float s2 = ss[r];
        s2 += shfl_xor_l(s2, 1, lane); s2 += shfl_xor_l(s2, 2, lane); s2 += shfl_xor_l(s2, 4, lane); s2 += shfl_xor_l(s2, 8, lane);
        ss[r] = rsqrtf(s2 * (1.f / 128.f) + 1e-6f) * (1.f - li);
      }
#pragma unroll
      for (int je = 0; je < 8; je++) {
        const float g = sg[je * 16 + lr];
#pragma unroll
        for (int r = 0; r < 4; r++)
          ODA[(size_t)(t0 + wq * 32 + i * 16 + lg * 4 + r) * 1024 + h * 128 + je * 16 + lr] = f2bf(o[i][je][r] * ss[r] * g);
      }
    }
  }
}

DEV void ret_item(const Params& p, int h, int c, bf16_t* lds) {
  unsigned char* ws = p.ws;
  const bf16_t* RQ = (const bf16_t*)(ws + OFF_RQ);
  const bf16_t* RK = (const bf16_t*)(ws + OFF_RK);
  const bf16_t* RVT = (const bf16_t*)(ws + OFF_RVT);
  const bf16_t* STR = (const bf16_t*)(ws + OFF_STR);
  bf16_t* ORET = (bf16_t*)(ws + OFF_ORET);
  constexpr int PS = 136;
  bf16_t* Qs = lds;
  bf16_t* Ks = lds + 128 * PS;
  bf16_t* Big = lds + 2 * 128 * PS;
  float* RED = (float*)(lds + 2 * 128 * PS + 256 * PS);
  const int tid = get_tid(), lane = tid & 63, wave = tid >> 6, wm = wave >> 1, wn = wave & 1;
  const int lr = lane & 15, lg = lane >> 4;
  const int t0 = c * 128;
  const int lrow = tid >> 4, lc8 = (tid & 15) * 8;
  const float l2g = log2f(1.f - ex2(-5.f - (float)h));
#pragma unroll
  for (int i = 0; i < 4; i++) {
    const int row = lrow + i * 32;
    *(uint4*)(Qs + row * PS + lc8) = *(const uint4*)(RQ + (size_t)(t0 + row) * 512 + h * 128 + lc8);
    *(uint4*)(Ks + row * PS + lc8) = *(const uint4*)(RK + (size_t)(t0 + row) * 512 + h * 128 + lc8);
  }
#pragma unroll
  for (int i = 0; i < 8; i++) {
    const int row = lrow + i * 32;
    *(uint4*)(Big + row * PS + lc8) = *(const uint4*)(STR + ((size_t)(h * 65 + c) * 256 + row) * 128 + lc8);
  }
  __syncthreads();
  f32x4 s[2][4];
  f32x4 o[2][8];
#pragma unroll
  for (int i = 0; i < 2; i++) {
#pragma unroll
    for (int j = 0; j < 4; j++) s[i][j] = (f32x4){0.f, 0.f, 0.f, 0.f};
#pragma unroll
    for (int j = 0; j < 8; j++) o[i][j] = (f32x4){0.f, 0.f, 0.f, 0.f};
  }
#pragma unroll
  for (int ks = 0; ks < 4; ks++) {
    bf16x8 a0 = ldfrag(Qs, PS, wm * 32 + lr, ks * 32 + lg * 8);
    bf16x8 a1 = ldfrag(Qs, PS, wm * 32 + 16 + lr, ks * 32 + lg * 8);
#pragma unroll
    for (int j = 0; j < 4; j++) {
      bf16x8 bb = ldfrag(Ks, PS, wn * 64 + j * 16 + lr, ks * 32 + lg * 8);
      s[0][j] = MFMA(bb, a0, s[0][j]);
      s[1][j] = MFMA(bb, a1, s[1][j]);
    }
#pragma unroll
    for (int j = 0; j < 8; j++) {
      bf16x8 bb = ldfrag(Big, PS, wn * 128 + j * 16 + lr, ks * 32 + lg * 8);
      o[0][j] = MFMA(bb, a0, o[0][j]);
      o[1][j] = MFMA(bb, a1, o[1][j]);
    }
    __builtin_amdgcn_sched_barrier(0);
  }
#pragma unroll
  for (int i = 0; i < 2; i++) {
    const int q = wm * 32 + i * 16 + lr;
    const float qd = ex2(l2g * (float)(q + 1));
#pragma unroll
    for (int j = 0; j < 8; j++)
#pragma unroll
      for (int r = 0; r < 4; r++) o[i][j][r] *= qd;
  }
  __syncthreads();
#pragma unroll
  for (int i = 0; i < 2; i++) {
    const int q = wm * 32 + i * 16 + lr;
#pragma unroll
    for (int j = 0; j < 4; j++) {
      f32x4 v;
#pragma unroll
      for (int r = 0; r < 4; r++) {
        const int key = wn * 64 + j * 16 + lg * 4 + r;
        v[r] = (key <= q) ? s[i][j][r] * ex2(l2g * (float)(q - key)) : 0.f;
      }
      *(uint2*)(Ks + q * PS + wn * 64 + j * 16 + lg * 4) = pack4(v);
    }
  }
#pragma unroll
  for (int i = 0; i < 8; i++) {
    const int row = lrow + i * 32;
    *(uint4*)(Big + row * PS + lc8) = *(const uint4*)(RVT + (size_t)(h * 256 + row) * LT + t0 + lc8);
  }
  __syncthreads();
#pragma unroll
  for (int ks = 0; ks < 4; ks++) {
    bf16x8 a0 = ldfrag(Ks, PS, wm * 32 + lr, ks * 32 + lg * 8);
    bf16x8 a1 = ldfrag(Ks, PS, wm * 32 + 16 + lr, ks * 32 + lg * 8);
#pragma unroll
    for (int j = 0; j < 8; j++) {
      bf16x8 bb = ldfrag(Big, PS, wn * 128 + j * 16 + lr, ks * 32 + lg * 8);
      o[0][j] = MFMA(bb, a0, o[0][j]);
      o[1][j] = MFMA(bb, a1, o[1][j]);
    }
    __builtin_amdgcn_sched_barrier(0);
  }
#pragma unroll
  for (int i = 0; i < 2; i++) {
    float ss = 0.f;
#pragma unroll
    for (int j = 0; j < 8; j++)
#pragma unroll
      for (int r = 0; r < 4; r++) ss += o[i][j][r] * o[i][j][r];
    ss += shfl_xor_l(ss, 16, lane);
    ss += shfl_xor_l(ss, 32, lane);
    if (lg == 0) RED[(wm * 32 + i * 16 + lr) * 2 + wn] = ss;
  }
  __syncthreads();
#pragma unroll
  for (int i = 0; i < 2; i++) {
    const int q = wm * 32 + i * 16 + lr;
    const float rs = rsqrtf((RED[q * 2] + RED[q * 2 + 1]) * (1.f / 256.f) + 1e-6f);
#pragma unroll
    for (int j = 0; j < 8; j++) {
      f32x4 v = o[i][j];
#pragma unroll
      for (int r = 0; r < 4; r++) v[r] *= rs;
      *(uint2*)(ORET + (size_t)(t0 + q) * 1024 + h * 256 + wn * 128 + j * 16 + lg * 4) = pack4(v);
    }
  }
}

DEV void hg_item(const Params& p, int h, int c, bf16_t* lds) {
  unsigned char* ws = p.ws;
  const bf16_t* HQ = (const bf16_t*)(ws + OFF_HQ);
  const bf16_t* HK = (const bf16_t*)(ws + OFF_HK);
  const float* HCB = (const float*)(ws + OFF_HCB);
  const bf16_t* HVT = (const bf16_t*)(ws + OFF_HVT);
  const bf16_t* STH = (const bf16_t*)(ws + OFF_STH);
  bf16_t* OHG = (bf16_t*)(ws + OFF_OHG);
  constexpr int PS = 136;
  bf16_t* Qp = lds;
  bf16_t* Kp = lds + 128 * PS;
  bf16_t* As = lds + 2 * 128 * PS;
  float* RED = (float*)(lds + 2 * 128 * PS + 256 * PS);
  const int tid = get_tid(), lane = tid & 63, wave = tid >> 6, wm = wave >> 1, wn = wave & 1;
  const int lr = lane & 15, lg = lane >> 4;
  const int t0 = c * 128, colb = h * 128;
  const int lrow = tid >> 4, lc8 = (tid & 15) * 8;
#pragma unroll
  for (int i = 0; i < 4; i++) {
    const int row = lrow + i * 32;
    const size_t g = (size_t)(t0 + row) * 1024 + colb + lc8;
    uint4 qv = *(const uint4*)(HQ + g);
    float4 c0 = *(const float4*)(HCB + g), c1 = *(const float4*)(HCB + g + 4);
    float4 r0 = make_float4(0.f, 0.f, 0.f, 0.f), r1 = r0;
    if (row >= 32) {
      const size_t gr = (size_t)(t0 + (row & ~31) - 1) * 1024 + colb + lc8;
      r0 = *(const float4*)(HCB + gr); r1 = *(const float4*)(HCB + gr + 4);
    }
    uint4 ov;
    ov.x = pack2(bf2f((bf16_t)(qv.x & 0xffff)) * __expf(c0.x - r0.x), bf2f((bf16_t)(qv.x >> 16)) * __expf(c0.y - r0.y));
    ov.y = pack2(bf2f((bf16_t)(qv.y & 0xffff)) * __expf(c0.z - r0.z), bf2f((bf16_t)(qv.y >> 16)) * __expf(c0.w - r0.w));
    ov.z = pack2(bf2f((bf16_t)(qv.z & 0xffff)) * __expf(c1.x - r1.x), bf2f((bf16_t)(qv.z >> 16)) * __expf(c1.y - r1.y));
    ov.w = pack2(bf2f((bf16_t)(qv.w & 0xffff)) * __expf(c1.z - r1.z), bf2f((bf16_t)(qv.w >> 16)) * __expf(c1.w - r1.w));
    *(uint4*)(Qp + row * PS + lc8) = ov;
  }
  for (int I = 0; I < 4; I++) {
    const int nrows = 32 * (I + 1);
    float4 r0 = make_float4(0.f, 0.f, 0.f, 0.f), r1 = r0;
    if (I > 0) {
      const size_t gr = (size_t)(t0 + 32 * I - 1) * 1024 + colb + lc8;
      r0 = *(const float4*)(HCB + gr); r1 = *(const float4*)(HCB + gr + 4);
    }
#pragma unroll
    for (int i = 0; i < 4; i++) {
      const int row = lrow + i * 32;
      if (row < nrows) {
        const size_t g = (size_t)(t0 + row) * 1024 + colb + lc8;
        uint4 kv = *(const uint4*)(HK + g);
        float4 c0 = *(const float4*)(HCB + g), c1 = *(const float4*)(HCB + g + 4);
        uint4 ov;
        ov.x = pack2(bf2f((bf16_t)(kv.x & 0xffff)) * __expf(fminf(r0.x - c0.x, 80.f)), bf2f((bf16_t)(kv.x >> 16)) * __expf(fminf(r0.y - c0.y, 80.f)));
        ov.y = pack2(bf2f((bf16_t)(kv.y & 0xffff)) * __expf(fminf(r0.z - c0.z, 80.f)), bf2f((bf16_t)(kv.y >> 16)) * __expf(fminf(r0.w - c0.w, 80.f)));
        ov.z = pack2(bf2f((bf16_t)(kv.z & 0xffff)) * __expf(fminf(r1.x - c1.x, 80.f)), bf2f((bf16_t)(kv.z >> 16)) * __expf(fminf(r1.y - c1.y, 80.f)));
        ov.w = pack2(bf2f((bf16_t)(kv.w & 0xffff)) * __expf(fminf(r1.z - c1.z, 80.f)), bf2f((bf16_t)(kv.w >> 16)) * __expf(fminf(r1.w - c1.w, 80.f)));
        *(uint4*)(Kp + row * PS + lc8) = ov;
      }
    }
    __syncthreads();
    if (wave * 16 < nrows) {
      f32x4 a2[2];
      a2[0] = (f32x4){0.f, 0.f, 0.f, 0.f}; a2[1] = a2[0];
#pragma unroll
      for (int ks = 0; ks < 4; ks++) {
        bf16x8 bb = ldfrag(Kp, PS, wave * 16 + lr, ks * 32 + lg * 8);
        bf16x8 a0 = ldfrag(Qp, PS, 32 * I + lr, ks * 32 + lg * 8);
        bf16x8 a1 = ldfrag(Qp, PS, 32 * I + 16 + lr, ks * 32 + lg * 8);
        a2[0] = MFMA(bb, a0, a2[0]);
        a2[1] = MFMA(bb, a1, a2[1]);
      }
#pragma unroll
      for (int i = 0; i < 2; i++) {
        const int q = 32 * I + i * 16 + lr;
        f32x4 v;
#pragma unroll
        for (int r = 0; r < 4; r++) { const int key = wave * 16 + lg * 4 + r; v[r] = (key <= q) ? a2[i][r] : 0.f; }
        *(uint2*)(As + q * PS + wave * 16 + lg * 4) = pack4(v);
      }
    } else {
#pragma unroll
      for (int i = 0; i < 2; i++) {
        const int q = 32 * I + i * 16 + lr;
        *(uint2*)(As + q * PS + wave * 16 + lg * 4) = make_uint2(0u, 0u);
      }
    }
    __syncthreads();
  }
#pragma unroll
  for (int i = 0; i < 4; i++) {
    const int row = lrow + i * 32;
    *(uint4*)(Kp + row * PS + lc8) = *(const uint4*)(HVT + (size_t)(colb + row) * LT + t0 + lc8);
  }
  __syncthreads();
  f32x4 o[2][4];
#pragma unroll
  for (int i = 0; i < 2; i++)
#pragma unroll
    for (int j = 0; j < 4; j++) o[i][j] = (f32x4){0.f, 0.f, 0.f, 0.f};
#pragma unroll
  for (int ks = 0; ks < 4; ks++) {
    bf16x8 a0 = ldfrag(As, PS, wm * 32 + lr, ks * 32 + lg * 8);
    bf16x8 a1 = ldfrag(As, PS, wm * 32 + 16 + lr, ks * 32 + lg * 8);
#pragma unroll
    for (int j = 0; j < 4; j++) {
      bf16x8 bb = ldfrag(Kp, PS, wn * 64 + j * 16 + lr, ks * 32 + lg * 8);
      o[0][j] = MFMA(bb, a0, o[0][j]);
      o[1][j] = MFMA(bb, a1, o[1][j]);
    }
    __builtin_amdgcn_sched_barrier(0);
  }
  __syncthreads();
#pragma unroll
  for (int i = 0; i < 4; i++) {
    const int row = lrow + i * 32;
    const size_t g = (size_t)(t0 + row) * 1024 + colb + lc8;
    uint4 qv = *(const uint4*)(HQ + g);
    float4 c0 = *(const float4*)(HCB + g), c1 = *(const float4*)(HCB + g + 4);
    uint4 ov;
    ov.x = pack2(bf2f((bf16_t)(qv.x & 0xffff)) * __expf(c0.x), bf2f((bf16_t)(qv.x >> 16)) * __expf(c0.y));
    ov.y = pack2(bf2f((bf16_t)(qv.y & 0xffff)) * __expf(c0.z), bf2f((bf16_t)(qv.y >> 16)) * __expf(c0.w));
    ov.z = pack2(bf2f((bf16_t)(qv.z & 0xffff)) * __expf(c1.x), bf2f((bf16_t)(qv.z >> 16)) * __expf(c1.y));
    ov.w = pack2(bf2f((bf16_t)(qv.w & 0xffff)) * __expf(c1.z), bf2f((bf16_t)(qv.w >> 16)) * __expf(c1.w));
    *(uint4*)(Qp + row * PS + lc8) = ov;
    *(uint4*)(Kp + row * PS + lc8) = *(const uint4*)(STH + ((size_t)(h * 65 + c) * 128 + row) * 128 + lc8);
  }
  __syncthreads();
#pragma unroll
  for (int ks = 0; ks < 4; ks++) {
    bf16x8 a0 = ldfrag(Qp, PS, wm * 32 + lr, ks * 32 + lg * 8);
    bf16x8 a1 = ldfrag(Qp, PS, wm * 32 + 16 + lr, ks * 32 + lg * 8);
#pragma unroll
    for (int j = 0; j < 4; j++) {
      bf16x8 bb = ldfrag(Kp, PS, wn * 64 + j * 16 + lr, ks * 32 + lg * 8);
      o[0][j] = MFMA(bb, a0, o[0][j]);
      o[1][j] = MFMA(bb, a1, o[1][j]);
    }
    __builtin_amdgcn_sched_barrier(0);
  }
#pragma unroll
  for (int i = 0; i < 2; i++) {
    float ss = 0.f;
#pragma unroll
    for (int j = 0; j < 4; j++)
#pragma unroll
      for (int r = 0; r < 4; r++) ss += o[i][j][r] * o[i][j][r];
    ss += shfl_xor_l(ss, 16, lane);
    ss += shfl_xor_l(ss, 32, lane);
    if (lg == 0) RED[(wm * 32 + i * 16 + lr) * 2 + wn] = ss;
  }
  __syncthreads();
#pragma unroll
  for (int i = 0; i < 2; i++) {
    const int q = wm * 32 + i * 16 + lr;
    const float rs = rsqrtf((RED[q * 2] + RED[q * 2 + 1]) * (1.f / 128.f) + 1e-6f);
#pragma unroll
    for (int j = 0; j < 4; j++) {
      f32x4 v = o[i][j];
#pragma unroll
      for (int r = 0; r < 4; r++) v[r] *= rs;
      *(uint2*)(OHG + (size_t)(t0 + q) * 1024 + colb + wn * 64 + j * 16 + lg * 4) = pack4(v);
    }
  }
}

DEV void phase_O(const Params& p, int layer, int qidx, unsigned char* ldsraw) {
  bf16_t* lds = (bf16_t*)ldsraw;
  int* ctr = (int*)(p.ws + OFF_CTR) + qidx;
  int* sitem = (int*)(ldsraw + LDS_BYTES - 16);
  const float* lp = p.in[7] + layer * 256;
  float d0 = 0.f, d1 = 0.f;
  for (int i = 0; i < 64; i++) { d0 += lp[i] * lp[64 + i]; d1 += lp[128 + i] * lp[192 + i]; }
  int ly = layer; asm volatile("" : "+s"(ly));
  const float li = (ly == 0) ? 0.2f : 0.35550906759f;
  const float lam = __uint_as_float(__builtin_amdgcn_readfirstlane(__float_as_uint(__expf(d0) - __expf(d1) + li)));
  const int tid0 = get_tid();
  for (;;) {
    __syncthreads();
    if (tid0 == 0) *sitem = atomicAdd(ctr, 1);
    __syncthreads();
    const int item = __builtin_amdgcn_readfirstlane(*sitem);
    if (item >= 1300) break;
    if (item < 520) attn_item(p, layer, item & 7, 64 - (item >> 3), lam, lds);
    else if (item < 780) ret_item(p, (item - 520) & 3, (item - 520) >> 2, lds);
    else hg_item(p, (item - 780) & 7, (item - 780) >> 3, lds);
  }
}

DEV void phase_G(const Params& p, int b, unsigned char* ldsraw) {
  unsigned char* ws = p.ws;
  bf16_t* lds = (bf16_t*)ldsraw;
  const bf16_t* HN = (const bf16_t*)(ws + OFF_HN) + (size_t)b * LT * 1024;
  const bf16_t* WIN = (const bf16_t*)(ws + OFF_WIN);
  for (int item = vblock(); item < 33 * 20; item += gridDim.x) {
    int nt, mt; tile_map(item, 33, 4, mt, nt);
    int n0, cb; bf16_t* dst; int ld; bool gate;
    if (nt < 4) { n0 = 2048 + nt * 256; cb = nt * 256; dst = (bf16_t*)(ws + OFF_ORET); ld = 1024; gate = true; }
    else if (nt < 8) { n0 = 6144 + (nt - 4) * 256; cb = (nt - 4) * 256; dst = (bf16_t*)(ws + OFF_OHG); ld = 1024; gate = true; }
    else { n0 = 10240 + (nt - 8) * 256; cb = (nt - 8) * 256; dst = (bf16_t*)(ws + OFF_G); ld = 3072; gate = false; }
    f32x4 acc[4][8];
#pragma unroll
    for (int i = 0; i < 4; i++)
#pragma unroll
      for (int j = 0; j < 8; j++) acc[i][j] = (f32x4){0.f, 0.f, 0.f, 0.f};
    gemm256_acc<256>(acc, HN + (size_t)mt * 256 * 1024, 1024, LT - mt * 256, WIN + (size_t)n0 * 1024, 1024, 1024, lds);
    const int tid = get_tid(), lane = tid & 63, wave = tid >> 6, wm = wave >> 1, wn = wave & 1; const int lr = lane & 15, lg = lane >> 4;
#pragma unroll
    for (int i = 0; i < 4; i++) {
      const int t = mt * 256 + wm * 64 + i * 16 + lr;
      if (t < LT) {
#pragma unroll
        for (int j = 0; j < 8; j++) {
          bf16_t* d = dst + (size_t)t * ld + cb + wn * 128 + j * 16 + lg * 4;
          f32x4 v;
          if (gate) {
            uint2 ov = *(const uint2*)d;
            v[0] = bf2f((bf16_t)(ov.x & 0xffff)) * silu_f(acc[i][j][0]);
            v[1] = bf2f((bf16_t)(ov.x >> 16)) * silu_f(acc[i][j][1]);
            v[2] = bf2f((bf16_t)(ov.y & 0xffff)) * silu_f(acc[i][j][2]);
            v[3] = bf2f((bf16_t)(ov.y >> 16)) * silu_f(acc[i][j][3]);
          } else {
#pragma unroll
            for (int r = 0; r < 4; r++) v[r] = sigmoid_f(acc[i][j][r]);
          }
          *(uint2*)d = pack4(v);
        }
      }
    }
  }
}

DEV f32x4 mini_gemm16(const bf16_t* __restrict__ A16, int lda, const bf16_t* __restrict__ Bt16, int ldb, int k0, int klen, int lane) {
  const int lr = lane & 15, lg = lane >> 4;
  const bf16_t* pa = A16 + (size_t)lr * lda + k0 + lg * 8;
  const bf16_t* pb = Bt16 + (size_t)lr * ldb + k0 + lg * 8;
  f32x4 acc = (f32x4){0.f, 0.f, 0.f, 0.f};
#pragma unroll 4
  for (int k = 0; k < klen; k += 32) {
    bf16x8 a = *(const bf16x8*)(pa + k);
    bf16x8 b = *(const bf16x8*)(pb + k);
    acc = MFMA(b, a, acc);
  }
  return acc;
}

DEV void phase_Y(const Params& p, unsigned char* ldsraw) {
  unsigned char* ws = p.ws;
  bf16_t* lds = (bf16_t*)ldsraw;
  const bf16_t* WB = (const bf16_t*)(ws + OFF_WB);
  const bf16_t* G = (const bf16_t*)(ws + OFF_G);
  bf16_t* Y = (bf16_t*)(ws + OFF_Y);
  for (int item = vblock(); item < 32 * 8 + 64; item += gridDim.x) {
    if (item >= 256) {
      const int lane = get_tid() & 63, wave = get_tid() >> 6, lr = lane & 15, lg = lane >> 4;
      const int n0 = (item - 256) * 16;
      f32x4* red = (f32x4*)ldsraw;
      __syncthreads();
#pragma unroll 1
      for (int br = 0; br < 3; br++) {
        const bf16_t* Ab = (const bf16_t*)(ws + (br == 0 ? OFF_ORET : (br == 1 ? OFF_OHG : OFF_ODA))) + (size_t)112 * 1024;
        red[(br * 8 + wave) * 64 + lane] = mini_gemm16(Ab, 1024, WB + ((size_t)br * 1024 + n0) * 1024, 1024, wave * 128, 128, lane);
      }
      __syncthreads();
      if (wave == 0) {
        f32x4 y = (f32x4){0.f, 0.f, 0.f, 0.f};
#pragma unroll
        for (int br = 0; br < 3; br++) {
          f32x4 a = red[(br * 8) * 64 + lane];
#pragma unroll
          for (int w = 1; w < 8; w++) a += red[(br * 8 + w) * 64 + lane];
          uint2 gv = *(const uint2*)(G + (size_t)(112 + lr) * 3072 + br * 1024 + n0 + lg * 4);
          y[0] += bf2f((bf16_t)(gv.x & 0xffff)) * a[0];
          y[1] += bf2f((bf16_t)(gv.x >> 16)) * a[1];
          y[2] += bf2f((bf16_t)(gv.y & 0xffff)) * a[2];
          y[3] += bf2f((bf16_t)(gv.y >> 16)) * a[3];
        }
        *(uint2*)(Y + (size_t)(112 + lr) * 1024 + n0 + lg * 4) = pack4(y);
      }
      continue;
    }
    int nt, mt; tile_map(item, 32, 4, mt, nt);
    const int row0 = 128 + mt * 256;
    f32x4 y[4][4];
#pragma unroll
    for (int i = 0; i < 4; i++)
#pragma unroll
      for (int j = 0; j < 4; j++) y[i][j] = (f32x4){0.f, 0.f, 0.f, 0.f};
#pragma unroll 1
    for (int br = 0; br < 3; br++) {
      const bf16_t* Ab = (const bf16_t*)(ws + (br == 0 ? OFF_ORET : (br == 1 ? OFF_OHG : OFF_ODA))) + (size_t)row0 * 1024;
      f32x4 acc[4][4];
#pragma unroll
      for (int i = 0; i < 4; i++)
#pragma unroll
        for (int j = 0; j < 4; j++) acc[i][j] = (f32x4){0.f, 0.f, 0.f, 0.f};
      gemm256_acc<128>(acc, Ab, 1024, 256, WB + ((size_t)br * 1024 + nt * 128) * 1024, 1024, 1024, lds);
      const int tid = get_tid(), lane = tid & 63, wave = tid >> 6, wm = wave >> 1, wn = wave & 1; const int lr = lane & 15, lg = lane >> 4;
#pragma unroll
      for (int i = 0; i < 4; i++) {
        const int t = row0 + wm * 64 + i * 16 + lr;
#pragma unroll
        for (int j = 0; j < 4; j++) {
          uint2 gv = *(const uint2*)(G + (size_t)t * 3072 + br * 1024 + nt * 128 + wn * 64 + j * 16 + lg * 4);
          y[i][j][0] += bf2f((bf16_t)(gv.x & 0xffff)) * acc[i][j][0];
          y[i][j][1] += bf2f((bf16_t)(gv.x >> 16)) * acc[i][j][1];
          y[i][j][2] += bf2f((bf16_t)(gv.y & 0xffff)) * acc[i][j][2];
          y[i][j][3] += bf2f((bf16_t)(gv.y >> 16)) * acc[i][j][3];
        }
      }
    }
    const int tid = get_tid(), lane = tid & 63, wave = tid >> 6, wm = wave >> 1, wn = wave & 1; const int lr = lane & 15, lg = lane >> 4;
#pragma unroll
    for (int i = 0; i < 4; i++) {
      const int t = row0 + wm * 64 + i * 16 + lr;
#pragma unroll
      for (int j = 0; j < 4; j++)
        *(uint2*)(Y + (size_t)t * 1024 + nt * 128 + wn * 64 + j * 16 + lg * 4) = pack4(y[i][j]);
    }
  }
}

DEV void phase_resid(const Params& p, int b, const bf16_t* A, int K, const bf16_t* Wt, unsigned char* ldsraw) {
  bf16_t* lds = (bf16_t*)ldsraw;
  for (int item = vblock(); item < 32 * 8 + 64; item += gridDim.x) {
    if (item >= 256) {
      const int lane = get_tid() & 63, wave = get_tid() >> 6, lr = lane & 15, lg = lane >> 4;
      const int n0 = (item - 256) * 16;
      f32x4* red = (f32x4*)ldsraw;
      const int ks = K >> 3;
      __syncthreads();
      red[wave * 64 + lane] = mini_gemm16(A + (size_t)112 * K, K, Wt + (size_t)n0 * K, K, wave * ks, ks, lane);
      __syncthreads();
      if (wave == 0) {
        f32x4 a = red[lane];
#pragma unroll
        for (int w = 1; w < 8; w++) a += red[w * 64 + lane];
        float4* d = (float4*)(hrow(p, b, 112 + lr) + n0 + lg * 4);
        float4 v = *d;
        v.x += a[0]; v.y += a[1]; v.z += a[2]; v.w += a[3];
        *d = v;
      }
      continue;
    }
    int nt, mt; tile_map(item, 32, 4, mt, nt);
    const int row0 = 128 + mt * 256;
    f32x4 acc[4][4];
#pragma unroll
    for (int i = 0; i < 4; i++)
#pragma unroll
      for (int j = 0; j < 4; j++) acc[i][j] = (f32x4){0.f, 0.f, 0.f, 0.f};
    gemm256_acc<128>(acc, A + (size_t)row0 * K, K, 256, Wt + (size_t)nt * 128 * K, K, K, lds);
    const int tid = get_tid(), lane = tid & 63, wave = tid >> 6, wm = wave >> 1, wn = wave & 1; const int lr = lane & 15, lg = lane >> 4;
#pragma unroll
    for (int i = 0; i < 4; i++) {
      const int t = row0 + wm * 64 + i * 16 + lr;
#pragma unroll
      for (int j = 0; j < 4; j++) {
        float4* d = (float4*)(hrow(p, b, t) + nt * 128 + wn * 64 + j * 16 + lg * 4);
        float4 v = *d;
        v.x += acc[i][j][0]; v.y += acc[i][j][1]; v.z += acc[i][j][2]; v.w += acc[i][j][3];
        *d = v;
      }
    }
  }
}

DEV void phase_F1(const Params& p, int b, unsigned char* ldsraw) {
  unsigned char* ws = p.ws;
  bf16_t* lds = (bf16_t*)ldsraw;
  const bf16_t* HN = (const bf16_t*)(ws + OFF_HN) + (size_t)b * LT * 1024;
  const bf16_t* WFI = (const bf16_t*)(ws + OFF_WFI);
  bf16_t* U = (bf16_t*)(ws + OFF_U);
  for (int item = vblock(); item < 33 * 22; item += gridDim.x) {
    int nt, mt; tile_map(item, 33, 2, mt, nt);
    f32x4 acc[4][8];
#pragma unroll
    for (int i = 0; i < 4; i++)
#pragma unroll
      for (int j = 0; j < 8; j++) acc[i][j] = (f32x4){0.f, 0.f, 0.f, 0.f};
    gemm256_acc<256>(acc, HN + (size_t)mt * 256 * 1024, 1024, LT - mt * 256, WFI + (size_t)nt * 256 * 1024, 1024, 1024, lds);
    const int tid = get_tid(), lane = tid & 63, wave = tid >> 6, wm = wave >> 1, wn = wave & 1; const int lr = lane & 15, lg = lane >> 4;
#pragma unroll
    for (int i = 0; i < 4; i++) {
      const int t = mt * 256 + wm * 64 + i * 16 + lr;
      if (t < LT) {
        const float vm = (t >= 112) ? 1.f : 0.f;
#pragma unroll
        for (int j = 0; j < 8; j++) {
          f32x4 v = acc[i][j];
#pragma unroll
          for (int r = 0; r < 4; r++) v[r] *= vm;
          *(uint2*)(U + (size_t)t * 5632 + nt * 256 + wn * 128 + j * 16 + lg * 4) = pack4(v);
        }
      }
    }
  }
}

DEV void unpack8(const u32x4 v, float (&f)[8]) {
#pragma unroll
  for (int k = 0; k < 4; k++) { f[2 * k] = bf2f((bf16_t)(v[k] & 0xffff)); f[2 * k + 1] = bf2f((bf16_t)(v[k] >> 16)); }
}
DEV void phase_conv(const Params& p, int layer) {
  unsigned char* ws = p.ws;
  const bf16_t* U = (const bf16_t*)(ws + OFF_U);
  bf16_t* GF = (bf16_t*)(ws + OFF_GF);
  const float* cw = p.in[11] + (size_t)layer * 3 * 5632;
  const float* cbias = p.in[12] + (size_t)layer * 5632;
  for (int idx = get_bid() * NTHR + get_tid(); idx < (LT / 8) * 352; idx += gridDim.x * NTHR) {
    const int tb = idx / 352, c8 = (idx - tb * 352) * 8;
    const int t0 = tb * 8;
    float wg[3][8], wv[3][8], bg[8], bv[8];
#pragma unroll
    for (int k = 0; k < 8; k++) {
      bg[k] = cbias[c8 + k]; bv[k] = cbias[2816 + c8 + k];
#pragma unroll
      for (int j = 0; j < 3; j++) { wg[j][k] = cw[j * 5632 + c8 + k]; wv[j][k] = cw[j * 5632 + 2816 + c8 + k]; }
    }
    float g0[8], g1[8], v0[8], v1[8];
    if (t0 >= 2) {
      unpack8(*(const u32x4*)(U + (size_t)(t0 - 2) * 5632 + c8), g0);
      unpack8(*(const u32x4*)(U + (size_t)(t0 - 2) * 5632 + 2816 + c8), v0);
      unpack8(*(const u32x4*)(U + (size_t)(t0 - 1) * 5632 + c8), g1);
      unpack8(*(const u32x4*)(U + (size_t)(t0 - 1) * 5632 + 2816 + c8), v1);
    } else {
#pragma unroll
      for (int k = 0; k < 8; k++) { g0[k] = 0.f; g1[k] = 0.f; v0[k] = 0.f; v1[k] = 0.f; }
    }
#pragma unroll
    for (int tt = 0; tt < 8; tt++) {
      float g2[8], v2[8];
      unpack8(*(const u32x4*)(U + (size_t)(t0 + tt) * 5632 + c8), g2);
      unpack8(*(const u32x4*)(U + (size_t)(t0 + tt) * 5632 + 2816 + c8), v2);
      float og[8];
#pragma unroll
      for (int k = 0; k < 8; k++) {
        const float gg = bg[k] + wg[0][k] * g0[k] + wg[1][k] * g1[k] + wg[2][k] * g2[k];
        const float vv = bv[k] + wv[0][k] * v0[k] + wv[1][k] * v1[k] + wv[2][k] * v2[k];
        og[k] = silu_f(gg) * vv;
        g0[k] = g1[k]; g1[k] = g2[k]; v0[k] = v1[k]; v1[k] = v2[k];
      }
      u32x4 o;
      o[0] = pack2(og[0], og[1]); o[1] = pack2(og[2], og[3]); o[2] = pack2(og[4], og[5]); o[3] = pack2(og[6], og[7]);
      *(u32x4*)(GF + (size_t)(t0 + tt) * 2816 + c8) = o;
    }
  }
}

#define XB_TMO      128
#define XB_XCNT(j)  (256  + 64 * (j))
#define XB_XSUB(j)  (1280 + 64 * (j))
#define XB_XGEN(j)  (2304 + 64 * (j))
#define XB_TOP      3328
#define XB_TOPGEN   3392
#define XB_SPIN_CAP (1u << 18)
#define LAS __attribute__((address_space(3)))
DEV unsigned xb_ld(unsigned* p) { return __hip_atomic_load(p, __ATOMIC_RELAXED, __HIP_MEMORY_SCOPE_AGENT); }
DEV unsigned xb_add(unsigned* p, unsigned v) { return __hip_atomic_fetch_add(p, v, __ATOMIC_RELAXED, __HIP_MEMORY_SCOPE_AGENT); }
DEV unsigned xb_xcc_id() { return (unsigned)__builtin_amdgcn_s_getreg((3 << 11) | 20) & 0xFu; }
#define XB_SPIN(cond, bar) do { unsigned _sp = 0; while (cond) { __builtin_amdgcn_s_sleep(1); \
    if ((++_sp & 255u) == 0u) { if (xb_ld(&(bar)[XB_TMO])) break; if (_sp > XB_SPIN_CAP) { atomicAdd(&(bar)[XB_TMO], 1u); break; } } } } while (0)
struct XcdBarrier { unsigned* bar; unsigned x; volatile LAS unsigned* st; };
DEV XcdBarrier xcd_barrier_post(unsigned* bar, volatile LAS unsigned* st) {
  XcdBarrier b; b.bar = bar; b.x = xb_xcc_id(); b.st = st;
  if (threadIdx.x == 0) (void)xb_add(&bar[XB_XCNT(b.x)], 1u);
  return b;
}
DEV void xcd_barrier_complete(unsigned* bar, unsigned x, unsigned& nloc, unsigned& nx) {
  const unsigned G = gridDim.x;
  unsigned sum, cnt, mine, sp = 0u;
  for (;;) {
    sum = 0u; cnt = 0u; mine = 0u;
#pragma unroll
    for (unsigned j = 0; j < 16; ++j) { const unsigned c = xb_ld(&bar[XB_XCNT(j)]); sum += c; cnt += (c > 0u) ? 1u : 0u; mine = (j == x) ? c : mine; }
    if (sum == G) break;
    __builtin_amdgcn_s_sleep(1);
    if ((++sp & 255u) == 0u) { if (xb_ld(&bar[XB_TMO])) break; if (sp > XB_SPIN_CAP) { atomicAdd(&bar[XB_TMO], 1u); break; } }
  }
  nloc = mine > 0u ? mine : 1u; nx = cnt > 0u ? cnt : 1u;
}
DEV void xcd_barrier(const XcdBarrier& b) {
  asm volatile("s_waitcnt vmcnt(0)" ::: "memory");
  __syncthreads();
  if (threadIdx.x == 0) {
    unsigned* bar = b.bar;
    __builtin_amdgcn_s_waitcnt(0);
    unsigned nloc = b.st[0], nx = b.st[1];
    if (nloc == 0u) { xcd_barrier_complete(bar, b.x, nloc, nx); b.st[0] = nloc; b.st[1] = nx; }
    const unsigned old = xb_add(&bar[XB_XSUB(b.x)], 1u);
    const unsigned gen = old / nloc;
    if (old + 1u == (gen + 1u) * nloc) {
      __builtin_amdgcn_fence(__ATOMIC_RELEASE, "agent");
      asm volatile("s_waitcnt vmcnt(0)" ::: "memory");
      const unsigned og = xb_add(&bar[XB_TOP], 1u);
      const unsigned tg = og / nx;
      if (og + 1u == (tg + 1u) * nx) xb_add(&bar[XB_TOPGEN], 1u);
      else XB_SPIN(xb_ld(&bar[XB_TOPGEN]) == tg, bar);
      __builtin_amdgcn_fence(__ATOMIC_ACQUIRE, "agent");
      xb_add(&bar[XB_XGEN(b.x)], 1u);
      asm volatile("s_waitcnt vmcnt(0)" ::: "memory");
    } else {
      XB_SPIN(xb_ld(&bar[XB_XGEN(b.x)]) == gen, bar);
      __builtin_amdgcn_fence(__ATOMIC_ACQUIRE, "agent");
      asm volatile("s_waitcnt vmcnt(0)" ::: "memory");
    }
  }
  __syncthreads();
}

__global__ void __launch_bounds__(NTHR) fwd_megakernel(Params p) {
  extern __shared__ __attribute__((aligned(16))) unsigned char lds[];
  cg::grid_group grid = cg::this_grid();
  volatile LAS unsigned* xst = (volatile LAS unsigned*)(lds + LDS_BYTES - 12);
  if (threadIdx.x == 0) { xst[0] = 0u; xst[1] = 0u; }
  __syncthreads();
  (void)xcd_barrier_post((unsigned*)(p.ws + OFF_XBAR), xst);
#define GRID_SYNC() do { XcdBarrier xb_; xb_.bar = (unsigned*)(p.ws + OFF_XBAR); xb_.x = xb_xcc_id(); \
    xb_.st = (volatile LAS unsigned*)(lds + LDS_BYTES - 12); xcd_barrier(xb_); } while (0)
  grid.sync();
  unsigned char* ws = p.ws;
  phase_init(p);
  phase_convert(p, 0, lds);
  GRID_SYNC();
  for (int layer = 0; layer < 2; layer++) {
    if (layer == 1) {
      phase_convert(p, 1, lds);
#pragma unroll 1
      for (int bb = 0; bb < 2; bb++)
        phase_norm(p, bb, p.in[2] + 1024, (bf16_t*)(ws + OFF_HN) + (size_t)bb * LT * 1024);
      GRID_SYNC();
    }
    for (int b = 0; b < 2; b++) {
      bf16_t* HNb = (bf16_t*)(ws + OFF_HN) + (size_t)b * LT * 1024;
      phase_projA(p, layer, b, lds);
      GRID_SYNC();
      phase_U(p, lds);
      GRID_SYNC();
      phase_scan(p);
      GRID_SYNC();
      phase_O(p, layer, layer * 2 + b, lds);
      GRID_SYNC();
      phase_G(p, b, lds);
      GRID_SYNC();
      phase_Y(p, lds);
      GRID_SYNC();
      phase_resid(p, b, (const bf16_t*)(ws + OFF_Y), 1024, (const bf16_t*)(ws + OFF_WO), lds);
      GRID_SYNC();
      phase_norm(p, b, p.in[9] + layer * 1024, HNb);
      GRID_SYNC();
      phase_F1(p, b, lds);
      GRID_SYNC();
      phase_conv(p, layer);
      GRID_SYNC();
      phase_resid(p, b, (const bf16_t*)(ws + OFF_GF), DFF, (const bf16_t*)(ws + OFF_WFO), lds);
      GRID_SYNC();
    }
  }
  phase_final(p);
}

extern "C" void kernel_launch(void* const* d_in, const int* in_sizes, int n_in, void* d_out, int out_size,
                              void* d_ws, size_t ws_size, hipStream_t stream) {
  static int grid_blocks = 0;
  if (grid_blocks == 0) {
    if (n_in != 15 || ws_size < OFF_END) {
      fprintf(stderr, "kernel_launch: need 15 inputs and %zu bytes of workspace, got %d and %zu\n", (size_t)OFF_END, n_in, ws_size);
      grid_blocks = -1; return;
    }
    int dev = 0, cus = 0, per_cu = 0;
    hipGetDevice(&dev);
    hipDeviceGetAttribute(&cus, hipDeviceAttributeMultiprocessorCount, dev);
    if (hipFuncSetAttribute((const void*)fwd_megakernel, hipFuncAttributeMaxDynamicSharedMemorySize, LDS_BYTES) != hipSuccess) {
      fprintf(stderr, "kernel_launch: hipFuncSetAttribute failed\n"); grid_blocks = -1; return;
    }
    hipOccupancyMaxActiveBlocksPerMultiprocessor(&per_cu, (const void*)fwd_megakernel, NTHR, LDS_BYTES);
    if (per_cu < 1) per_cu = 1;
    if (per_cu > 1) per_cu = 1;
    grid_blocks = cus * per_cu;
  }
  if (grid_blocks < 0) return;
  hipMemsetAsync((char*)d_ws + OFF_CTR, 0, 256 + XBAR_BYTES, stream);
  Params p{};
  for (int i = 0; i < 15; i++) p.in[i] = (const float*)d_in[i];
  p.out = (float*)d_out;
  p.ws = (unsigned char*)d_ws;
  void* args[] = {&p};
  hipError_t e = hipLaunchCooperativeKernel((const void*)fwd_megakernel, dim3(grid_blocks), dim3(NTHR), args, LDS_BYTES, stream);
  if (e != hipSuccess) fprintf(stderr, "cooperative launch failed: %s (grid %d)\n", hipGetErrorString(e), grid_blocks);
}
```

```cpp
#include <hip/hip_runtime.h>
#include <hip/hip_cooperative_groups.h>
#include <cstdio>
#include <cstdint>
namespace cg = cooperative_groups;

typedef unsigned short bf16_t;
typedef __attribute__((ext_vector_type(8))) short bf16x8;
typedef __attribute__((ext_vector_type(4))) short bf16x4;
typedef __attribute__((ext_vector_type(4))) float f32x4;
typedef __attribute__((ext_vector_type(4))) unsigned u32x4;

#define DEV __device__ __forceinline__
#define MFMA(a, b, c) __builtin_amdgcn_mfma_f32_16x16x32_bf16(a, b, c, 0, 0, 0)

constexpr int LT = 8320;
constexpr int NCH = 65;
constexpr int NTHR = 512;
constexpr int LDS_BYTES = 144 * 1024;
constexpr int INW = 13312;
constexpr int DFF = 2816;

constexpr size_t SZ_ACT = (size_t)LT * 1024 * 2;
constexpr size_t OFF_WIN = 0;
constexpr size_t OFF_WB = OFF_WIN + (size_t)INW * 1024 * 2;
constexpr size_t OFF_WO = OFF_WB + (size_t)3 * 1024 * 1024 * 2;
constexpr size_t OFF_WFI = OFF_WO + (size_t)1024 * 1024 * 2;
constexpr size_t OFF_WFO = OFF_WFI + (size_t)5632 * 1024 * 2;
constexpr size_t OFF_H = OFF_WFO + (size_t)1024 * 2816 * 2;
constexpr size_t OFF_HN = OFF_H + (size_t)2 * 128 * 1024 * 4;
constexpr size_t OFF_R128 = OFF_HN + 2 * SZ_ACT;
constexpr size_t OFF_R64 = OFF_R128 + (size_t)LT * 64 * 8;
constexpr size_t OFF_CTR = OFF_R64 + (size_t)LT * 32 * 8;
constexpr size_t OFF_XBAR = OFF_CTR + 256;
constexpr size_t XBAR_BYTES = 3456 * 4;
constexpr size_t OFF_ARENA = OFF_XBAR + XBAR_BYTES;
constexpr size_t OFF_RQ = OFF_ARENA;
constexpr size_t OFF_RK = OFF_RQ + SZ_ACT / 2;
constexpr size_t OFF_RKT = OFF_RK + SZ_ACT / 2;
constexpr size_t OFF_RVT = OFF_RKT + SZ_ACT / 2;
constexpr size_t OFF_HQ = OFF_RVT + SZ_ACT;
constexpr size_t OFF_HK = OFF_HQ + SZ_ACT;
constexpr size_t OFF_HCB = OFF_HK + SZ_ACT;
constexpr size_t OFF_HKET = OFF_HCB + 2 * SZ_ACT;
constexpr size_t OFF_HVT = OFF_HKET + SZ_ACT;
constexpr size_t OFF_DQ = OFF_HVT + SZ_ACT;
constexpr size_t OFF_DK = OFF_DQ + SZ_ACT;
constexpr size_t OFF_DVT = OFF_DK + SZ_ACT;
constexpr size_t OFF_ORET = OFF_DVT + SZ_ACT;
constexpr size_t OFF_OHG = OFF_ORET + SZ_ACT;
constexpr size_t OFF_STR = OFF_OHG + SZ_ACT;
constexpr size_t OFF_STH = OFF_STR + SZ_ACT;
constexpr size_t OFF_HDEC = OFF_STH + SZ_ACT;
constexpr size_t OFF_END = OFF_HDEC + (size_t)65 * 1024 * 4;
constexpr size_t OFF_G = OFF_RQ;
constexpr size_t OFF_Y = OFF_HK;
constexpr size_t OFF_ODA = OFF_HKET;
constexpr size_t OFF_U = OFF_ARENA;
constexpr size_t OFF_GF = OFF_U + (size_t)LT * 5632 * 2;

struct Params {
  const float* in[15];
  float* out;
  unsigned char* ws;
};

DEV int get_tid() { int t = threadIdx.x; asm volatile("" : "+v"(t)); return t; }
DEV int get_bid() { int b = blockIdx.x; asm volatile("" : "+s"(b)); return b; }
DEV float shfl_xor_l(float v, int m, int lane) { return __int_as_float(__builtin_amdgcn_ds_bpermute((lane ^ m) << 2, __float_as_int(v))); }
DEV float shfl_l(float v, int srclane) { return __int_as_float(__builtin_amdgcn_ds_bpermute(srclane << 2, __float_as_int(v))); }
DEV float* hrow(const Params& p, int b, int t) {
  return (t < 128) ? (float*)(p.ws + OFF_H) + (size_t)(b * 128 + t) * 1024 : p.out + ((size_t)b * 8192 + (t - 128)) * 1024;
}
typedef __bf16 hwbf16x2 __attribute__((ext_vector_type(2)));
typedef float hwf32x2 __attribute__((ext_vector_type(2)));
DEV unsigned pack2(float a, float b) {
  hwf32x2 f = {a, b};
  hwbf16x2 h = __builtin_convertvector(f, hwbf16x2);
  return __builtin_bit_cast(unsigned, h);
}
DEV bf16_t f2bf(float f) { return (bf16_t)(pack2(f, f) & 0xffffu); }
DEV float bf2f(bf16_t h) { return __uint_as_float(((unsigned)h) << 16); }
DEV uint2 pack4(f32x4 v) { uint2 r; r.x = pack2(v[0], v[1]); r.y = pack2(v[2], v[3]); return r; }
DEV float silu_f(float x) { return x / (1.f + __expf(-x)); }
DEV float sigmoid_f(float x) { return 1.f / (1.f + __expf(-x)); }
DEV float ex2(float x) { return __builtin_amdgcn_exp2f(x); }
DEV bf16x8 ldfrag(const bf16_t* base, int stride, int row, int k) {
  return *(const bf16x8*)(base + row * stride + k);
}

template <int BN, bool TRANS>
DEV void gemm_compute(f32x4 (&acc)[2][BN / 32], const bf16_t* as, const bf16_t* bs, int sw0, int sw1) {
  constexpr int NJ = BN / 32, LS = 64;
#pragma unroll
  for (int ks = 0; ks < 2; ks++) {
    const int sw = ks == 0 ? sw0 : sw1;
    bf16x8 a0 = *(const bf16x8*)(as + sw);
    bf16x8 a1 = *(const bf16x8*)(as + 16 * LS + sw);
#pragma unroll
    for (int j = 0; j < NJ; j++) {
      bf16x8 bb = *(const bf16x8*)(bs + j * 16 * LS + sw);
      if (TRANS) {
        acc[0][j] = MFMA(a0, bb, acc[0][j]);
        acc[1][j] = MFMA(a1, bb, acc[1][j]);
      } else {
        acc[0][j] = MFMA(bb, a0, acc[0][j]);
        acc[1][j] = MFMA(bb, a1, acc[1][j]);
      }
    }
  }
}

template <int BN, bool TRANS>
DEV void gemm_acc(f32x4 (&acc)[2][BN / 32], const bf16_t* __restrict__ A, int lda,
                  const bf16_t* __restrict__ Bt, int ldb, int K, bf16_t* lds) {
  constexpr int LS = 64, A_SZ = 128 * LS, B_SZ = BN * LS, NB = BN / 64;
  const int tid = get_tid(), lane = tid & 63, wave = tid >> 6, wm = wave >> 1, wn = wave & 1;
  const int lr = lane & 15, lg = lane >> 4;
  bf16_t* As = lds;
  bf16_t* Bs = lds + 2 * A_SZ;
  const int crow = tid >> 3, ckc = (tid & 7) * 8;
  const int cks = ((tid & 7) ^ ((crow >> 1) & 7)) * 8;
  const int sw0 = (lg ^ ((lr >> 1) & 7)) * 8, sw1 = sw0 ^ 32;
  const bf16_t* ga = A + (size_t)crow * lda + ckc;
  const bf16_t* gb = Bt + (size_t)crow * ldb + ckc;
  u32x4 ra0, ra1, rb0, rb1, rb2, rb3;
#define GLOAD(k0)                                                        \
  ra0 = *(const u32x4*)(ga + (k0));                                      \
  ra1 = *(const u32x4*)(ga + (size_t)64 * lda + (k0));                   \
  rb0 = *(const u32x4*)(gb + (k0));                                      \
  rb1 = *(const u32x4*)(gb + (size_t)64 * ldb + (k0));                   \
  if (NB == 4) {                                                         \
    rb2 = *(const u32x4*)(gb + (size_t)128 * ldb + (k0));                \
    rb3 = *(const u32x4*)(gb + (size_t)192 * ldb + (k0));                \
  }
#define LSTORE(buf)                                                      \
  *(u32x4*)(As + (buf) * A_SZ + crow * LS + cks) = ra0;                  \
  *(u32x4*)(As + (buf) * A_SZ + (crow + 64) * LS + cks) = ra1;           \
  *(u32x4*)(Bs + (buf) * B_SZ + crow * LS + cks) = rb0;                  \
  *(u32x4*)(Bs + (buf) * B_SZ + (crow + 64) * LS + cks) = rb1;           \
  if (NB == 4) {                                                         \
    *(u32x4*)(Bs + (buf) * B_SZ + (crow + 128) * LS + cks) = rb2;        \
    *(u32x4*)(Bs + (buf) * B_SZ + (crow + 192) * LS + cks) = rb3;        \
  }
  const int nk = K / 64;
  const int aoff = (wm * 32 + lr) * LS;
  const int boff = (wn * (BN / 2) + lr) * LS;
  GLOAD(0)
  __syncthreads();
  LSTORE(0)
  GLOAD(64)
  __syncthreads();
  for (int kt = 0; kt < nk; kt++) {
    const int cur = kt & 1;
    LSTORE(cur ^ 1)
    {
      const int kn = (kt + 2 < nk) ? kt + 2 : nk - 1;
      GLOAD(kn * 64)
    }
    __builtin_amdgcn_sched_barrier(0);
    gemm_compute<BN, TRANS>(acc, As + cur * A_SZ + aoff, Bs + cur * B_SZ + boff, sw0, sw1);
    __syncthreads();
  }
#undef GLOAD
#undef LSTORE
}

template <int BN, bool TRANS>
DEV void gemm256_compute(f32x4 (&acc)[4][BN / 32], const bf16_t* as, const bf16_t* bs, int sw0, int sw1) {
  constexpr int LS = 64, NJ = BN / 32;
#pragma unroll
  for (int ks = 0; ks < 2; ks++) {
    const int sw = ks == 0 ? sw0 : sw1;
    bf16x8 a[4];
#pragma unroll
    for (int i = 0; i < 4; i++) a[i] = *(const bf16x8*)(as + i * 16 * LS + sw);
#pragma unroll
    for (int j = 0; j < NJ; j++) {
      bf16x8 bb = *(const bf16x8*)(bs + j * 16 * LS + sw);
#pragma unroll
      for (int i = 0; i < 4; i++) acc[i][j] = TRANS ? MFMA(a[i], bb, acc[i][j]) : MFMA(bb, a[i], acc[i][j]);
    }
  }
}

template <int BN, bool TRANS = false>
DEV void gemm256_acc(f32x4 (&acc)[4][BN / 32], const bf16_t* __restrict__ A, int lda, int m_valid,
                     const bf16_t* __restrict__ Bt, int ldb, int K, bf16_t* lds) {
  constexpr int LS = 64, A_SZ = 256 * LS, B_SZ = BN * LS, NB = BN / 64;
  const int tid = get_tid(), lane = tid & 63, wave = tid >> 6, wm = wave >> 1, wn = wave & 1;
  const int lr = lane & 15, lg = lane >> 4;
  bf16_t* As = lds;
  bf16_t* Bs = lds + 2 * A_SZ;
  const int crow = tid >> 3, ckc = (tid & 7) * 8;
  const int cks = ((tid & 7) ^ ((crow >> 1) & 7)) * 8;
  const int sw0 = (lg ^ ((lr >> 1) & 7)) * 8, sw1 = sw0 ^ 32;
  const bf16_t* ga0 = A + (size_t)min(crow, m_valid - 1) * lda + ckc;
  const bf16_t* ga1 = A + (size_t)min(crow + 64, m_valid - 1) * lda + ckc;
  const bf16_t* ga2 = A + (size_t)min(crow + 128, m_valid - 1) * lda + ckc;
  const bf16_t* ga3 = A + (size_t)min(crow + 192, m_valid - 1) * lda + ckc;
  const bf16_t* gb = Bt + (size_t)crow * ldb + ckc;
  u32x4 ra0, ra1, ra2, ra3, rb0, rb1, rb2, rb3;
#define GLOAD(k0)                                                        \
  ra0 = *(const u32x4*)(ga0 + (k0));                                     \
  ra1 = *(const u32x4*)(ga1 + (k0));                                     \
  ra2 = *(const u32x4*)(ga2 + (k0));                                     \
  ra3 = *(const u32x4*)(ga3 + (k0));                                     \
  rb0 = *(const u32x4*)(gb + (k0));                                      \
  rb1 = *(const u32x4*)(gb + (size_t)64 * ldb + (k0));                   \
  if (NB == 4) {                                                         \
    rb2 = *(const u32x4*)(gb + (size_t)128 * ldb + (k0));                \
    rb3 = *(const u32x4*)(gb + (size_t)192 * ldb + (k0));                \
  }
#define LSTORE(buf)                                                      \
  *(u32x4*)(As + (buf) * A_SZ + crow * LS + cks) = ra0;                  \
  *(u32x4*)(As + (buf) * A_SZ + (crow + 64) * LS + cks) = ra1;           \
  *(u32x4*)(As + (buf) * A_SZ + (crow + 128) * LS + cks) = ra2;          \
  *(u32x4*)(As + (buf) * A_SZ + (crow + 192) * LS + cks) = ra3;          \
  *(u32x4*)(Bs + (buf) * B_SZ + crow * LS + cks) = rb0;                  \
  *(u32x4*)(Bs + (buf) * B_SZ + (crow + 64) * LS + cks) = rb1;           \
  if (NB == 4) {                                                         \
    *(u32x4*)(Bs + (buf) * B_SZ + (crow + 128) * LS + cks) = rb2;        \
    *(u32x4*)(Bs + (buf) * B_SZ + (crow + 192) * LS + cks) = rb3;        \
  }
  const int nk = K / 64;
  const int aoff = (wm * 64 + lr) * LS;
  const int boff = (wn * (BN / 2) + lr) * LS;
  GLOAD(0)
  __syncthreads();
  LSTORE(0)
  GLOAD(64)
  __syncthreads();
  for (int kt = 0; kt < nk; kt++) {
    const int cur = kt & 1;
    LSTORE(cur ^ 1)
    {
      const int kn = (kt + 2 < nk) ? kt + 2 : nk - 1;
      GLOAD(kn * 64)
    }
    __builtin_amdgcn_sched_barrier(0);
    gemm256_compute<BN, TRANS>(acc, As + cur * A_SZ + aoff, Bs + cur * B_SZ + boff, sw0, sw1);
    __syncthreads();
  }
#undef GLOAD
#undef LSTORE
}

DEV void tconv_tiles4(const float* __restrict__ src, int K, int N, bf16_t* __restrict__ dst, int idx0, int ntn, float* tile) {
  const int tid = get_tid();
  const int r = tid >> 4, c4 = (tid & 15) * 4;
  float4 v[4][2];
#pragma unroll
  for (int u = 0; u < 4; u++) {
    const int idx = idx0 + u, tk = idx / ntn, tn = idx - tk * ntn;
#pragma unroll
    for (int i = 0; i < 2; i++) v[u][i] = *(const float4*)(src + (size_t)(tk * 64 + r + i * 32) * N + tn * 64 + c4);
  }
  __syncthreads();
#pragma unroll
  for (int u = 0; u < 4; u++)
#pragma unroll
    for (int i = 0; i < 2; i++) {
      float* t = tile + u * (64 * 65) + (r + i * 32) * 65 + c4;
      t[0] = v[u][i].x; t[1] = v[u][i].y; t[2] = v[u][i].z; t[3] = v[u][i].w;
    }
  __syncthreads();
  const int n = tid >> 3, k8 = (tid & 7) * 8;
#pragma unroll
  for (int u = 0; u < 4; u++) {
    const int idx = idx0 + u, tk = idx / ntn, tn = idx - tk * ntn;
    const float* t = tile + u * (64 * 65);
    u32x4 o;
    o[0] = pack2(t[(k8 + 0) * 65 + n], t[(k8 + 1) * 65 + n]);
    o[1] = pack2(t[(k8 + 2) * 65 + n], t[(k8 + 3) * 65 + n]);
    o[2] = pack2(t[(k8 + 4) * 65 + n], t[(k8 + 5) * 65 + n]);
    o[3] = pack2(t[(k8 + 6) * 65 + n], t[(k8 + 7) * 65 + n]);
    *(u32x4*)(dst + (size_t)(tn * 64 + n) * K + tk * 64 + k8) = o;
  }
}

DEV void phase_convert(const Params& p, int layer, unsigned char* lds) {
  unsigned char* ws = p.ws;
  float* tile = (float*)lds;
  for (int g = get_bid(); g < 1616; g += gridDim.x) {
    const float* src; bf16_t* dst; int K, N, gi;
    if (g < 832) { gi = g; src = p.in[3] + (size_t)layer * 1024 * INW; K = 1024; N = INW; dst = (bf16_t*)(ws + OFF_WIN); }
    else if (g < 832 + 192) { gi = g - 832; const int br = gi >> 6; gi &= 63; src = p.in[4] + ((size_t)layer * 3 + br) * 1024 * 1024; K = 1024; N = 1024; dst = (bf16_t*)(ws + OFF_WB) + (size_t)br * 1024 * 1024; }
    else if (g < 1088) { gi = g - 1024; src = p.in[5] + (size_t)layer * 1024 * 1024; K = 1024; N = 1024; dst = (bf16_t*)(ws + OFF_WO); }
    else if (g < 1440) { gi = g - 1088; src = p.in[10] + (size_t)layer * 1024 * 5632; K = 1024; N = 5632; dst = (bf16_t*)(ws + OFF_WFI); }
    else { gi = g - 1440; src = p.in[13] + (size_t)layer * 2816 * 1024; K = 2816; N = 1024; dst = (bf16_t*)(ws + OFF_WFO); }
    tconv_tiles4(src, K, N, dst, gi * 4, N / 64, (float*)tile);
  }
}

DEV void phase_init(const Params& p) {
  unsigned char* ws = p.ws;
  const int gt = get_bid() * NTHR + get_tid(), gs = gridDim.x * NTHR;
  {
    const int lane = get_tid() & 63, wave = get_tid() >> 6;
    const float* g = p.in[2];
    for (int row = get_bid() * 8 + wave; row < 2 * LT; row += gridDim.x * 8) {
      const int b = row / LT, t = row - b * LT;
      float4 v[4]; float ss = 0.f;
#pragma unroll
      for (int k = 0; k < 4; k++) {
        const int c4 = k * 256 + lane * 4;
        if (t < 112) v[k] = make_float4(0.f, 0.f, 0.f, 0.f);
        else if (t < 128) v[k] = *(const float4*)(p.in[1] + (size_t)(t - 112) * 1024 + c4);
        else v[k] = *(const float4*)(p.in[0] + ((size_t)b * 8192 + (t - 128)) * 1024 + c4);
        *(float4*)(hrow(p, b, t) + c4) = v[k];
        ss += v[k].x * v[k].x + v[k].y * v[k].y + v[k].z * v[k].z + v[k].w * v[k].w;
      }
#pragma unroll
      for (int o = 1; o < 64; o <<= 1) ss += shfl_xor_l(ss, o, lane);
      const float rs = rsqrtf(ss * (1.f / 1024.f) + 1e-6f);
      bf16_t* dst = (bf16_t*)(ws + OFF_HN) + (size_t)b * LT * 1024 + (size_t)t * 1024;
#pragma unroll
      for (int k = 0; k < 4; k++) {
        float4 gg = *(const float4*)(g + k * 256 + lane * 4);
        uint2 o; o.x = pack2(v[k].x * rs * gg.x, v[k].y * rs * gg.y); o.y = pack2(v[k].z * rs * gg.z, v[k].w * rs * gg.w);
        *(uint2*)(dst + k * 256 + lane * 4) = o;
      }
    }
  }
  float2* R128 = (float2*)(ws + OFF_R128);
  float2* R64 = (float2*)(ws + OFF_R64);
  for (int idx = gt; idx < LT * 96; idx += gs) {
    const int t = idx / 96, f = idx - t * 96;
    float inv;
    if (f < 64) inv = powf(10000.f, -(float)(2 * f) / 128.f);
    else inv = powf(10000.f, -(float)(2 * (f - 64)) / 64.f);
    const float ang = (float)(t - 112) * inv;
    const double ad = (double)ang;
    const double n = rint(ad * 0.15915494309189535);
    const float rr = (float)(ad - n * 6.283185307179586);
    float2 cs; cs.x = __cosf(rr); cs.y = __sinf(rr);
    if (f < 64) R128[(size_t)t * 64 + f] = cs; else R64[(size_t)t * 32 + (f - 64)] = cs;
  }
}

DEV void phase_norm(const Params& p, int b, const float* __restrict__ g, bf16_t* __restrict__ dst) {
  const int lane = get_tid() & 63, wave = get_tid() >> 6;
  for (int row = get_bid() * 8 + wave; row < LT; row += gridDim.x * 8) {
    const float* src = hrow(p, b, row);
    float4 v[4]; float ss = 0.f;
#pragma unroll
    for (int k = 0; k < 4; k++) { v[k] = *(const float4*)(src + k * 256 + lane * 4); ss += v[k].x * v[k].x + v[k].y * v[k].y + v[k].z * v[k].z + v[k].w * v[k].w; }
#pragma unroll
    for (int o = 1; o < 64; o <<= 1) ss += shfl_xor_l(ss, o, lane);
    const float rs = rsqrtf(ss * (1.f / 1024.f) + 1e-6f);
#pragma unroll
    for (int k = 0; k < 4; k++) {
      float4 gg = *(const float4*)(g + k * 256 + lane * 4);
      uint2 o; o.x = pack2(v[k].x * rs * gg.x, v[k].y * rs * gg.y); o.y = pack2(v[k].z * rs * gg.z, v[k].w * rs * gg.w);
      *(uint2*)(dst + (size_t)row * 1024 + k * 256 + lane * 4) = o;
    }
  }
}

DEV void phase_final(const Params& p) {
  const float* g = p.in[14];
  const int lane = get_tid() & 63, wave = get_tid() >> 6;
  for (int row = get_bid() * 8 + wave; row < 2 * 8192; row += gridDim.x * 8) {
    const float* src = p.out + (size_t)row * 1024;
    float4 v[4]; float ss = 0.f;
#pragma unroll
    for (int k = 0; k < 4; k++) { v[k] = *(const float4*)(src + k * 256 + lane * 4); ss += v[k].x * v[k].x + v[k].y * v[k].y + v[k].z * v[k].z + v[k].w * v[k].w; }
#pragma unroll
    for (int o = 1; o < 64; o <<= 1) ss += shfl_xor_l(ss, o, lane);
    const float rs = rsqrtf(ss * (1.f / 1024.f) + 1e-6f);
#pragma unroll
    for (int k = 0; k < 4; k++) {
      float4 gg = *(const float4*)(g + k * 256 + lane * 4);
      float4 o = make_float4(v[k].x * rs * gg.x, v[k].y * rs * gg.y, v[k].z * rs * gg.z, v[k].w * rs * gg.w);
      *(float4*)(p.out + (size_t)row * 1024 + k * 256 + lane * 4) = o;
    }
  }
}

DEV void tile_map(int it, int MT, int NG, int& mt, int& nt) {
  const int ng = it / (MT * NG), rem = it - ng * (MT * NG);
  mt = rem / NG; nt = ng * NG + (rem - mt * NG);
}
DEV int vblock() { const int b = get_bid(), G = (int)gridDim.x; return ((G & 7) == 0) ? (b & 7) * (G >> 3) + (b >> 3) : b; }

template <int NI>
DEV void projA_epiN(const Params& p, f32x4 (&acc)[NI][8], int seg, int cw, int trow0, int lr, int lg) {
  unsigned char* ws = p.ws;
  const float2* R128 = (const float2*)(ws + OFF_R128);
  const float2* R64 = (const float2*)(ws + OFF_R64);
  bf16_t* dstb; int ld;
  if (seg == 0) { dstb = (bf16_t*)(ws + OFF_RQ); ld = 512; }
  else if (seg == 3) { dstb = (bf16_t*)(ws + OFF_HQ); ld = 1024; }
  else if (seg == 6) { dstb = (bf16_t*)(ws + OFF_DQ); ld = 1024; }
  else { dstb = (bf16_t*)(ws + OFF_DK); ld = 1024; }
#pragma unroll
  for (int i = 0; i < NI; i++) {
    const int t = trow0 + i * 16 + lr;
    if (seg == 0) {
      const float2* tab = R128 + (size_t)t * 64;
#pragma unroll
      for (int j = 0; j < 4; j++)
#pragma unroll
        for (int r = 0; r < 4; r++) {
          float2 cs = tab[j * 16 + lg * 4 + r];
          float x1 = acc[i][j][r], x2 = acc[i][j + 4][r];
          acc[i][j][r] = x1 * cs.x - x2 * cs.y;
          acc[i][j + 4][r] = x2 * cs.x + x1 * cs.y;
        }
    } else if (seg == 6 || seg == 7) {
      const float2* tab = R64 + (size_t)t * 32;
      const float sc = (seg == 6) ? (0.125f * 1.4426950408889634f) : 1.f;
#pragma unroll
      for (int jq = 0; jq < 4; jq++) {
        const int j = (jq & 1) + (jq >> 1) * 4;
#pragma unroll
        for (int r = 0; r < 4; r++) {
          float2 cs = tab[(jq & 1) * 16 + lg * 4 + r];
          float x1 = acc[i][j][r], x2 = acc[i][j + 2][r];
          acc[i][j][r] = (x1 * cs.x - x2 * cs.y) * sc;
          acc[i][j + 2][r] = (x2 * cs.x + x1 * cs.y) * sc;
        }
      }
    }
    bf16_t* dst = dstb + (size_t)t * ld + cw;
#pragma unroll
    for (int j = 0; j < 8; j++) *(uint2*)(dst + j * 16 + lg * 4) = pack4(acc[i][j]);
    __builtin_amdgcn_sched_barrier(0);
  }
}

template <int NI>
DEV void projA_epiT(const Params& p, int layer, f32x4 (&acc)[NI][8], int seg, int cw, int trow0, int wn,
                    int mloc0, int lr, int lg, int tid, unsigned char* ldsraw) {
  unsigned char* ws = p.ws;
  const float2* R128 = (const float2*)(ws + OFF_R128);
  if (seg == 1) {
    bf16_t* RK = (bf16_t*)(ws + OFF_RK);
    bf16_t* RKT = (bf16_t*)(ws + OFF_RKT);
    const int h = cw >> 7;
    const float l2g = log2f(1.f - ex2(-5.f - (float)h));
#pragma unroll
    for (int i = 0; i < NI; i++) {
      const int tb = trow0 + i * 16 + lg * 4;
#pragma unroll
      for (int j = 0; j < 4; j++)
#pragma unroll
        for (int r = 0; r < 4; r++) {
          const int t = tb + r;
          float2 cs = R128[(size_t)t * 64 + j * 16 + lr];
          const float sc = (t >= 112) ? 0.08838834764831845f : 0.f;
          float x1 = acc[i][j][r], x2 = acc[i][j + 4][r];
          acc[i][j][r] = (x1 * cs.x - x2 * cs.y) * sc;
          acc[i][j + 4][r] = (x2 * cs.x + x1 * cs.y) * sc;
        }
#pragma unroll
      for (int j = 0; j < 8; j++) {
        const int col = cw + j * 16 + lr;
        f32x4 kd;
#pragma unroll
        for (int r = 0; r < 4; r++) {
          const int t = tb + r;
          RK[(size_t)t * 512 + col] = f2bf(acc[i][j][r]);
          kd[r] = acc[i][j][r] * ex2(l2g * (float)(127 - (t & 127)));
        }
        *(uint2*)(RKT + (size_t)col * LT + tb) = pack4(kd);
      }
      __builtin_amdgcn_sched_barrier(0);
    }
  } else if (seg == 2 || seg == 5 || seg == 8) {
    bf16_t* dT = (bf16_t*)(ws + (seg == 2 ? OFF_RVT : (seg == 5 ? OFF_HVT : OFF_DVT)));
#pragma unroll
    for (int i = 0; i < NI; i++) {
      const int tb = trow0 + i * 16 + lg * 4;
#pragma unroll
      for (int j = 0; j < 8; j++) {
        const int col = cw + j * 16 + lr;
        f32x4 v = acc[i][j];
        if (seg == 5) {
#pragma unroll
          for (int r = 0; r < 4; r++) if (tb + r < 112) v[r] = 0.f;
        }
        *(uint2*)(dT + (size_t)col * LT + tb) = pack4(v);
      }
      __builtin_amdgcn_sched_barrier(0);
    }
  } else if constexpr (NI == 2) {
    float* Lf = (float*)ldsraw;
    float* HCB = (float*)(ws + OFF_HCB);
    bf16_t* HK = (bf16_t*)(ws + OFF_HK);
    bf16_t* HKET = (bf16_t*)(ws + OFF_HKET);
    float* HDEC = (float*)(ws + OFF_HDEC);
    const float* lbp = p.in[6];
#pragma unroll
    for (int j = 0; j < 8; j++) {
      const int col = cw + j * 16 + lr;
      float lb = 0.f;
      if (layer == 1) lb = 1.f / (1.f + __expf(lbp[col] - lbp[1024 + col]));
#pragma unroll
      for (int i = 0; i < 2; i++)
#pragma unroll
        for (int r = 0; r < 4; r++) {
          const int m = mloc0 + i * 16 + lg * 4 + r;
          const float z = acc[i][j][r];
          const float kk = (1.f - lb) / (1.f + __expf(z));
          const float lf = fmaxf(log1pf(-kk), -69.0776f);
          acc[i][j][r] = kk;
          Lf[m * 260 + wn * 128 + j * 16 + lr] = lf;
        }
    }
    __syncthreads();
    {
      const int colL = tid & 255, half = tid >> 8;
      float run = 0.f;
      for (int rr = 0; rr < 64; rr++) {
        float* q = &Lf[(half * 64 + rr) * 260 + colL];
        run += *q; *q = run;
      }
    }
    __syncthreads();
#pragma unroll
    for (int j = 0; j < 8; j++) {
      const int colL = wn * 128 + j * 16 + lr;
      const int col = cw + j * 16 + lr;
      const float ft = Lf[63 * 260 + colL];
      const float cend = Lf[127 * 260 + colL] + ft;
#pragma unroll
      for (int i = 0; i < 2; i++) {
        const int mb = mloc0 + i * 16 + lg * 4;
        const int tb = trow0 + i * 16 + lg * 4;
        f32x4 ke;
#pragma unroll
        for (int r = 0; r < 4; r++) {
          const int m = mb + r;
          const int t = tb + r;
          const float cb = Lf[m * 260 + colL] + (m >= 64 ? ft : 0.f);
          HCB[(size_t)t * 1024 + col] = cb;
          HK[(size_t)t * 1024 + col] = f2bf(acc[i][j][r]);
          ke[r] = acc[i][j][r] * __expf(cend - cb);
          if (m == 127) HDEC[(t >> 7) * 1024 + col] = __expf(cend);
        }
        *(uint2*)(HKET + (size_t)col * LT + tb) = pack4(ke);
      }
    }
    __syncthreads();
  }
}

DEV void projA_seg(int nt, int& n0, int& seg, int& segstart) {
  if (nt < 8) { n0 = nt * 256; seg = nt < 2 ? 0 : (nt < 4 ? 1 : 2); segstart = seg == 0 ? 0 : (seg == 1 ? 512 : 1024); }
  else if (nt < 20) { n0 = 3072 + (nt - 8) * 256; seg = 3 + (nt - 8) / 4; segstart = 3072 + (seg - 3) * 1024; }
  else { n0 = 7168 + (nt - 20) * 256; seg = 6 + (nt - 20) / 4; segstart = 7168 + (seg - 6) * 1024; }
}

DEV void phase_projA(const Params& p, int layer, int b, unsigned char* ldsraw) {
  unsigned char* ws = p.ws;
  bf16_t* lds = (bf16_t*)ldsraw;
  const bf16_t* HN = (const bf16_t*)(ws + OFF_HN) + (size_t)b * LT * 1024;
  const bf16_t* WIN = (const bf16_t*)(ws + OFF_WIN);
  const int G = (int)gridDim.x, vb = vblock();
  for (int item = vb; item < 32 * 28; item += G) {
    int ntb, mt; tile_map(item, 32, 4, mt, ntb);
    const int nt = ntb < 12 ? ntb : ntb + 4;
    int n0, seg, segstart; projA_seg(nt, n0, seg, segstart);
    const int row0 = 128 + mt * 256;
    const bf16_t* A = HN + (size_t)row0 * 1024;
    const bf16_t* Bt = WIN + (size_t)n0 * 1024;
    f32x4 acc[4][8];
#pragma unroll
    for (int i = 0; i < 4; i++)
#pragma unroll
      for (int j = 0; j < 8; j++) acc[i][j] = (f32x4){0.f, 0.f, 0.f, 0.f};
    if (seg == 0 || seg == 3 || seg == 6 || seg == 7) {
      gemm256_acc<256, false>(acc, A, 1024, 256, Bt, 1024, 1024, lds);
      const int tid = get_tid(), lane = tid & 63, wave = tid >> 6, wm = wave >> 1, wn = wave & 1; const int lr = lane & 15, lg = lane >> 4;
      projA_epiN<4>(p, acc, seg, (n0 - segstart) + wn * 128, row0 + wm * 64, lr, lg);
    } else {
      gemm256_acc<256, true>(acc, A, 1024, 256, Bt, 1024, 1024, lds);
      const int tid = get_tid(), lane = tid & 63, wave = tid >> 6, wm = wave >> 1, wn = wave & 1; const int lr = lane & 15, lg = lane >> 4;
      projA_epiT<4>(p, layer, acc, seg, (n0 - segstart) + wn * 128, row0 + wm * 64, wn, (wm & 1) * 64, lr, lg, tid, ldsraw);
    }
  }
  for (int s = (vb + G / 2) % G; s < 288; s += G) {
    int nt, mt;
    if (s < 28) { mt = 0; nt = s < 12 ? s : s + 4; }
    else { const int q = s - 28; mt = q >> 2; nt = 12 + (q & 3); }
    int n0, seg, segstart; projA_seg(nt, n0, seg, segstart);
    const bf16_t* A = HN + (size_t)mt * 128 * 1024;
    const bf16_t* Bt = WIN + (size_t)n0 * 1024;
    f32x4 acc[2][8];
#pragma unroll
    for (int i = 0; i < 2; i++)
#pragma unroll
      for (int j = 0; j < 8; j++) acc[i][j] = (f32x4){0.f, 0.f, 0.f, 0.f};
    if (seg == 0 || seg == 3 || seg == 6 || seg == 7) {
      gemm_acc<256, false>(acc, A, 1024, Bt, 1024, 1024, lds);
      const int tid = get_tid(), lane = tid & 63, wave = tid >> 6, wm = wave >> 1, wn = wave & 1; const int lr = lane & 15, lg = lane >> 4;
      projA_epiN<2>(p, acc, seg, (n0 - segstart) + wn * 128, mt * 128 + wm * 32, lr, lg);
    } else {
      gemm_acc<256, true>(acc, A, 1024, Bt, 1024, 1024, lds);
      const int tid = get_tid(), lane = tid & 63, wave = tid >> 6, wm = wave >> 1, wn = wave & 1; const int lr = lane & 15, lg = lane >> 4;
      projA_epiT<2>(p, layer, acc, seg, (n0 - segstart) + wn * 128, mt * 128 + wm * 32, wn, wm * 32, lr, lg, tid, ldsraw);
    }
  }
}

DEV void phase_U(const Params& p, unsigned char* ldsraw) {
  unsigned char* ws = p.ws;
  bf16_t* lds = (bf16_t*)ldsraw;
  for (int item = get_bid(); item < 1040; item += gridDim.x) {
    const bf16_t *A, *Bt; bf16_t* dst;
    if (item < 520) {
      const int h = item & 3, rest = item >> 2, mh = rest & 1, c = rest >> 1;
      A = (const bf16_t*)(ws + OFF_RVT) + (size_t)(h * 256 + mh * 128) * LT + c * 128;
      Bt = (const bf16_t*)(ws + OFF_RKT) + (size_t)(h * 128) * LT + c * 128;
      dst = (bf16_t*)(ws + OFF_STR) + ((size_t)(h * 65 + c) * 256 + mh * 128) * 128;
    } else {
      const int it = item - 520, h = it & 7, c = it >> 3;
      A = (const bf16_t*)(ws + OFF_HVT) + (size_t)(h * 128) * LT + c * 128;
      Bt = (const bf16_t*)(ws + OFF_HKET) + (size_t)(h * 128) * LT + c * 128;
      dst = (bf16_t*)(ws + OFF_STH) + ((size_t)(h * 65 + c) * 128) * 128;
    }
    f32x4 acc[2][4];
#pragma unroll
    for (int i = 0; i < 2; i++)
#pragma unroll
      for (int j = 0; j < 4; j++) acc[i][j] = (f32x4){0.f, 0.f, 0.f, 0.f};
    gemm_acc<128, false>(acc, A, LT, Bt, LT, 128, lds);
      const int tid = get_tid(), lane = tid & 63, wave = tid >> 6, wm = wave >> 1, wn = wave & 1; const int lr = lane & 15, lg = lane >> 4; (void)tid; (void)lane; (void)wm; (void)wn; (void)lr; (void)lg;
#pragma unroll
    for (int i = 0; i < 2; i++)
#pragma unroll
      for (int j = 0; j < 4; j++)
        *(uint2*)(dst + (size_t)(wm * 32 + i * 16 + lr) * 128 + wn * 64 + j * 16 + lg * 4) = pack4(acc[i][j]);
  }
}

DEV void phase_scan(const Params& p) {
  unsigned char* ws = p.ws;
  const float* HDEC = (const float*)(ws + OFF_HDEC);
  for (int task = get_bid() * NTHR + get_tid(); task < 65536; task += gridDim.x * NTHR) {
    bf16_t* base; size_t stride; int h, d4; bool hg;
    float dec0 = 0.f;
    if (task < 32768) {
      const int v = task; d4 = (v & 31) * 4; const int e = (v >> 5) & 255; h = v >> 13; hg = false;
      base = (bf16_t*)(ws + OFF_STR) + ((size_t)(h * 65) * 256 + e) * 128 + d4; stride = 256 * 128;
      dec0 = ex2(128.f * log2f(1.f - ex2(-5.f - (float)h)));
    } else {
      const int v = task - 32768; d4 = (v & 31) * 4; const int e = (v >> 5) & 127; h = v >> 12; hg = true;
      base = (bf16_t*)(ws + OFF_STH) + ((size_t)(h * 65) * 128 + e) * 128 + d4; stride = 128 * 128;
    }
    float c0 = 0.f, c1 = 0.f, c2 = 0.f, c3 = 0.f;
    for (int cg0 = 0; cg0 < 65; cg0 += 13) {
      uint2 u[13]; float4 dc[13];
#pragma unroll
      for (int k = 0; k < 13; k++) {
        u[k] = *(const uint2*)(base + (size_t)(cg0 + k) * stride);
        if (hg) dc[k] = *(const float4*)(HDEC + (size_t)(cg0 + k) * 1024 + h * 128 + d4);
        else dc[k] = make_float4(dec0, dec0, dec0, dec0);
      }
#pragma unroll
      for (int k = 0; k < 13; k++) {
        uint2 o; o.x = pack2(c0, c1); o.y = pack2(c2, c3);
        *(uint2*)(base + (size_t)(cg0 + k) * stride) = o;
        c0 = dc[k].x * c0 + bf2f((bf16_t)(u[k].x & 0xffff));
        c1 = dc[k].y * c1 + bf2f((bf16_t)(u[k].x >> 16));
        c2 = dc[k].z * c2 + bf2f((bf16_t)(u[k].y & 0xffff));
        c3 = dc[k].w * c3 + bf2f((bf16_t)(u[k].y >> 16));
      }
    }
  }
}

DEV void attn_item(const Params& p, int layer, int h, int qb, float lam, bf16_t* lds) {
  unsigned char* ws = p.ws;
  const bf16_t* DQ = (const bf16_t*)(ws + OFF_DQ);
  bf16_t* ODA = (bf16_t*)(ws + OFF_ODA);
  const bf16_t* DK = (const bf16_t*)(ws + OFF_DK);
  const bf16_t* DVT = (const bf16_t*)(ws + OFF_DVT);
  constexpr int PS = 136, XS = 132;
  constexpr int TS = 128 * PS;
  bf16_t* KV = lds;
  float* X = (float*)lds;
  const int tid = get_tid(), lane = tid & 63, wave = tid >> 6;
  const int lr = lane & 15, lg = lane >> 4;
  const int grp = wave >> 2, wq = wave & 3;
  const int t0 = qb * 128;
  const int lrow = tid >> 4, lc8 = (tid & 15) * 8;
  const bf16_t* gq = DQ + (size_t)(t0 + wq * 32 + lr) * 1024 + h * 128 + grp * 64 + lg * 8;
  const bf16x8 a00 = *(const bf16x8*)(gq);
  const bf16x8 a01 = *(const bf16x8*)(gq + 32);
  const bf16x8 a10 = *(const bf16x8*)(gq + (size_t)16 * 1024);
  const bf16x8 a11 = *(const bf16x8*)(gq + (size_t)16 * 1024 + 32);
  f32x4 o[2][8];
#pragma unroll
  for (int i = 0; i < 2; i++)
#pragma unroll
    for (int j = 0; j < 8; j++) o[i][j] = (f32x4){0.f, 0.f, 0.f, 0.f};
  float mrun0 = -1e30f, mrun1 = -1e30f, lrun0 = 0.f, lrun1 = 0.f;
  u32x4 rk0, rk1, rk2, rk3, rv0, rv1, rv2, rv3;
  const unsigned ko = (unsigned)(lrow * 1024 + h * 128 + lc8);
  const unsigned vo = (unsigned)((h * 128 + lrow) * LT + lc8);
#define ALOAD(kbn)                                                              \
  rk0 = *(const u32x4*)(DK + (ko + (unsigned)(kbn) * 131072u));                 \
  rk1 = *(const u32x4*)(DK + (ko + (unsigned)(kbn) * 131072u + 32768u));        \
  rk2 = *(const u32x4*)(DK + (ko + (unsigned)(kbn) * 131072u + 65536u));        \
  rk3 = *(const u32x4*)(DK + (ko + (unsigned)(kbn) * 131072u + 98304u));        \
  rv0 = *(const u32x4*)(DVT + (vo + (unsigned)(kbn) * 128u));                   \
  rv1 = *(const u32x4*)(DVT + (vo + (unsigned)(kbn) * 128u + 32u * LT));        \
  rv2 = *(const u32x4*)(DVT + (vo + (unsigned)(kbn) * 128u + 64u * LT));        \
  rv3 = *(const u32x4*)(DVT + (vo + (unsigned)(kbn) * 128u + 96u * LT));
#define ASTORE(sp)                                                              \
  *(u32x4*)((sp)) = rk0;                                                        \
  *(u32x4*)((sp) + 32 * PS) = rk1;                                              \
  *(u32x4*)((sp) + 64 * PS) = rk2;                                              \
  *(u32x4*)((sp) + 96 * PS) = rk3;                                              \
  *(u32x4*)((sp) + 2 * TS) = rv0;                                               \
  *(u32x4*)((sp) + 2 * TS + 32 * PS) = rv1;                                     \
  *(u32x4*)((sp) + 2 * TS + 64 * PS) = rv2;                                     \
  *(u32x4*)((sp) + 2 * TS + 96 * PS) = rv3;
  ALOAD(0)
  const int qrow0 = t0 + wq * 32 + lr;
  __syncthreads();
  ASTORE(KV + lrow * PS + lc8)
  {
    const int kb1 = qb > 0 ? 1 : 0;
    ALOAD(kb1)
  }
  __syncthreads();
  for (int kb = 0; kb <= qb; kb++) {
    const int cur = kb & 1;
    const bf16_t* kp = KV + cur * TS + lr * PS + grp * 64 + lg * 8;
    const bf16_t* vq = KV + 2 * TS + cur * TS + lr * PS + lg * 4;
    {
      bf16_t* sp = KV + (cur ^ 1) * TS + lrow * PS + lc8;
      ASTORE(sp)
    }
    __builtin_amdgcn_sched_barrier(0);
    f32x4 s[2][8];
    {
#pragma unroll
      for (int j = 0; j < 8; j++) {
        const bf16x8 kf0 = *(const bf16x8*)(kp + j * 16 * PS);
        const bf16x8 kf1 = *(const bf16x8*)(kp + j * 16 * PS + 32);
        s[0][j] = MFMA(kf0, a00, ((f32x4){0.f, 0.f, 0.f, 0.f}));
        s[1][j] = MFMA(kf0, a10, ((f32x4){0.f, 0.f, 0.f, 0.f}));
        s[0][j] = MFMA(kf1, a01, s[0][j]);
        s[1][j] = MFMA(kf1, a11, s[1][j]);
      }
    }
    __builtin_amdgcn_sched_barrier(0);
    {
      const int kbn = (kb + 2 <= qb) ? kb + 2 : qb;
      ALOAD(kbn)
    }
    __builtin_amdgcn_sched_barrier(0);
    if (kb == qb || kb == 0) {
#pragma unroll
      for (int i = 0; i < 2; i++)
#pragma unroll
        for (int j = 0; j < 8; j++)
#pragma unroll
          for (int r = 0; r < 4; r++) {
            const int key = kb * 128 + j * 16 + lg * 4 + r;
            if (key > qrow0 + 16 * i || key < 112) s[i][j][r] = -1e30f;
          }
    }
    float al[2];
#pragma unroll
    for (int i = 0; i < 2; i++) {
      float mx = -1e30f;
#pragma unroll
      for (int j = 0; j < 8; j++)
#pragma unroll
        for (int r = 0; r < 4; r++) mx = fmaxf(mx, s[i][j][r]);
      mx = fmaxf(mx, shfl_xor_l(mx, 16, lane));
      mx = fmaxf(mx, shfl_xor_l(mx, 32, lane));
      const float mold = i == 0 ? mrun0 : mrun1;
      const float mnew = (mx > mold + 8.f) ? mx : mold;
      al[i] = ex2(mold - mnew);
      float ps = 0.f;
#pragma unroll
      for (int j = 0; j < 8; j++)
#pragma unroll
        for (int r = 0; r < 4; r++) { const float pv = ex2(s[i][j][r] - mnew); s[i][j][r] = pv; ps += pv; }
      if (i == 0) { mrun0 = mnew; lrun0 = lrun0 * al[0] + ps; } else { mrun1 = mnew; lrun1 = lrun1 * al[1] + ps; }
    }
    if (__builtin_amdgcn_ballot_w64(al[0] != 1.f || al[1] != 1.f) != 0ull) {
#pragma unroll
      for (int i = 0; i < 2; i++) {
        float ao[4];
#pragma unroll
        for (int r = 0; r < 4; r++) ao[r] = shfl_l(al[i], lg * 4 + r);
#pragma unroll
        for (int je = 0; je < 8; je++)
#pragma unroll
          for (int r = 0; r < 4; r++) o[i][je][r] *= ao[r];
      }
    }
#pragma unroll
    for (int ks = 0; ks < 4; ks++) {
      union { u32x4 u; bf16x8 v; } pf0, pf1;
      pf0.u[0] = pack2(s[0][2 * ks][0], s[0][2 * ks][1]);
      pf0.u[1] = pack2(s[0][2 * ks][2], s[0][2 * ks][3]);
      pf0.u[2] = pack2(s[0][2 * ks + 1][0], s[0][2 * ks + 1][1]);
      pf0.u[3] = pack2(s[0][2 * ks + 1][2], s[0][2 * ks + 1][3]);
      pf1.u[0] = pack2(s[1][2 * ks][0], s[1][2 * ks][1]);
      pf1.u[1] = pack2(s[1][2 * ks][2], s[1][2 * ks][3]);
      pf1.u[2] = pack2(s[1][2 * ks + 1][0], s[1][2 * ks + 1][1]);
      pf1.u[3] = pack2(s[1][2 * ks + 1][2], s[1][2 * ks + 1][3]);
#pragma unroll
      for (int je = 0; je < 8; je++) {
        const bf16_t* vp = vq + je * 16 * PS + ks * 32;
        union { uint2 u[2]; bf16x8 v; } vf;
        vf.u[0] = *(const uint2*)vp;
        vf.u[1] = *(const uint2*)(vp + 16);
        o[0][je] = MFMA(pf0.v, vf.v, o[0][je]);
        o[1][je] = MFMA(pf1.v, vf.v, o[1][je]);
      }
    }
    __builtin_amdgcn_sched_barrier(0);
    __syncthreads();
  }
#undef ASTORE
#undef ALOAD
#pragma unroll
  for (int i = 0; i < 2; i++) {
    float l = i == 0 ? lrun0 : lrun1;
    l += shfl_xor_l(l, 16, lane);
    l += shfl_xor_l(l, 32, lane);
    const float inv = l > 0.f ? 1.f / l : 0.f;
#pragma unroll
    for (int r = 0; r < 4; r++) {
      const float ir = shfl_l(inv, lg * 4 + r);
#pragma unroll
      for (int je = 0; je < 8; je++) o[i][je][r] *= ir;
    }
  }
  __syncthreads();
  if (grp == 1) {
#pragma unroll
    for (int i = 0; i < 2; i++)
#pragma unroll
      for (int je = 0; je < 8; je++)
#pragma unroll
        for (int r = 0; r < 4; r++) X[(wq * 32 + i * 16 + lg * 4 + r) * XS + je * 16 + lr] = o[i][je][r];
  }
  __syncthreads();
  if (grp == 0) {
    int ly = layer; asm volatile("" : "+s"(ly));
    const float li = (ly == 0) ? 0.2f : 0.35550906759f;
    const float* sg = p.in[8] + ly * 128;
#pragma unroll
    for (int i = 0; i < 2; i++) {
      float ss[4] = {0.f, 0.f, 0.f, 0.f};
#pragma unroll
      for (int je = 0; je < 8; je++)
#pragma unroll
        for (int r = 0; r < 4; r++) {
          const float v = o[i][je][r] - lam * X[(wq * 32 + i * 16 + lg * 4 + r) * XS + je * 16 + lr];
          o[i][je][r] = v; ss[r] += v * v;
        }
#pragma unroll
      for (int r = 0; r < 4; r++) {
        float s2 = ss[r];
        s2 += shfl_xor_l(s2, 1, lane); s2 += shfl_xor_l(s2, 2, lane); s2 += shfl_xor_l(s2, 4, lane); s2 += shfl_xor_l(s2, 8, lane);
        ss[r] = rsqrtf(s2 * (1.f / 128.f) + 1e-6f) * (1.f - li);
      }
#pragma unroll
      for (int je = 0; je < 8; je++) {
        const float g = sg[je * 16 + lr];
#pragma unroll
        for (int r = 0; r < 4; r++)
          ODA[(size_t)(t0 + wq * 32 + i * 16 + lg * 4 + r) * 1024 + h * 128 + je * 16 + lr] = f2bf(o[i][je][r] * ss[r] * g);
      }
    }
  }
}

DEV void ret_item(const Params& p, int h, int c, bf16_t* lds) {
  unsigned char* ws = p.ws;
  const bf16_t* RQ = (const bf16_t*)(ws + OFF_RQ);
  const bf16_t* RK = (const bf16_t*)(ws + OFF_RK);
  const bf16_t* RVT = (const bf16_t*)(ws + OFF_RVT);
  const bf16_t* STR = (const bf16_t*)(ws + OFF_STR);
  bf16_t* ORET = (bf16_t*)(ws + OFF_ORET);
  constexpr int PS = 136;
  bf16_t* Qs = lds;
  bf16_t* Ks = lds + 128 * PS;
  bf16_t* Big = lds + 2 * 128 * PS;
  float* RED = (float*)(lds + 2 * 128 * PS + 256 * PS);
  const int tid = get_tid(), lane = tid & 63, wave = tid >> 6, wm = wave >> 1, wn = wave & 1;
  const int lr = lane & 15, lg = lane >> 4;
  const int t0 = c * 128;
  const int lrow = tid >> 4, lc8 = (tid & 15) * 8;
  const float l2g = log2f(1.f - ex2(-5.f - (float)h));
#pragma unroll
  for (int i = 0; i < 4; i++) {
    const int row = lrow + i * 32;
    *(uint4*)(Qs + row * PS + lc8) = *(const uint4*)(RQ + (size_t)(t0 + row) * 512 + h * 128 + lc8);
    *(uint4*)(Ks + row * PS + lc8) = *(const uint4*)(RK + (size_t)(t0 + row) * 512 + h * 128 + lc8);
  }
#pragma unroll
  for (int i = 0; i < 8; i++) {
    const int row = lrow + i * 32;
    *(uint4*)(Big + row * PS + lc8) = *(const uint4*)(STR + ((size_t)(h * 65 + c) * 256 + row) * 128 + lc8);
  }
  __syncthreads();
  f32x4 s[2][4];
  f32x4 o[2][8];
#pragma unroll
  for (int i = 0; i < 2; i++) {
#pragma unroll
    for (int j = 0; j < 4; j++) s[i][j] = (f32x4){0.f, 0.f, 0.f, 0.f};
#pragma unroll
    for (int j = 0; j < 8; j++) o[i][j] = (f32x4){0.f, 0.f, 0.f, 0.f};
  }
#pragma unroll
  for (int ks = 0; ks < 4; ks++) {
    bf16x8 a0 = ldfrag(Qs, PS, wm * 32 + lr, ks * 32 + lg * 8);
    bf16x8 a1 = ldfrag(Qs, PS, wm * 32 + 16 + lr, ks * 32 + lg * 8);
#pragma unroll
    for (int j = 0; j < 4; j++) {
      bf16x8 bb = ldfrag(Ks, PS, wn * 64 + j * 16 + lr, ks * 32 + lg * 8);
      s[0][j] = MFMA(bb, a0, s[0][j]);
      s[1][j] = MFMA(bb, a1, s[1][j]);
    }
#pragma unroll
    for (int j = 0; j < 8; j++) {
      bf16x8 bb = ldfrag(Big, PS, wn * 128 + j * 16 + lr, ks * 32 + lg * 8);
      o[0][j] = MFMA(bb, a0, o[0][j]);
      o[1][j] = MFMA(bb, a1, o[1][j]);
    }
    __builtin_amdgcn_sched_barrier(0);
  }
#pragma unroll
  for (int i = 0; i < 2; i++) {
    const int q = wm * 32 + i * 16 + lr;
    const float qd = ex2(l2g * (float)(q + 1));
#pragma unroll
    for (int j = 0; j < 8; j++)
#pragma unroll
      for (int r = 0; r < 4; r++) o[i][j][r] *= qd;
  }
  __syncthreads();
#pragma unroll
  for (int i = 0; i < 2; i++) {
    const int q = wm * 32 + i * 16 + lr;
#pragma unroll
    for (int j = 0; j < 4; j++) {
      f32x4 v;
#pragma unroll
      for (int r = 0; r < 4; r++) {
        const int key = wn * 64 + j * 16 + lg * 4 + r;
        v[r] = (key <= q) ? s[i][j][r] * ex2(l2g * (float)(q - key)) : 0.f;
      }
      *(uint2*)(Ks + q * PS + wn * 64 + j * 16 + lg * 4) = pack4(v);
    }
  }
#pragma unroll
  for (int i = 0; i < 8; i++) {
    const int row = lrow + i * 32;
    *(uint4*)(Big + row * PS + lc8) = *(const uint4*)(RVT + (size_t)(h * 256 + row) * LT + t0 + lc8);
  }
  __syncthreads();
#pragma unroll
  for (int ks = 0; ks < 4; ks++) {
    bf16x8 a0 = ldfrag(Ks, PS, wm * 32 + lr, ks * 32 + lg * 8);
    bf16x8 a1 = ldfrag(Ks, PS, wm * 32 + 16 + lr, ks * 32 + lg * 8);
#pragma unroll
    for (int j = 0; j < 8; j++) {
      bf16x8 bb = ldfrag(Big, PS, wn * 128 + j * 16 + lr, ks * 32 + lg * 8);
      o[0][j] = MFMA(bb, a0, o[0][j]);
      o[1][j] = MFMA(bb, a1, o[1][j]);
    }
    __builtin_amdgcn_sched_barrier(0);
  }
#pragma unroll
  for (int i = 0; i < 2; i++) {
    float ss = 0.f;
#pragma unroll
    for (int j = 0; j < 8; j++)
#pragma unroll
      for (int r = 0; r < 4; r++) ss += o[i][j][r] * o[i][j][r];
    ss += shfl_xor_l(ss, 16, lane);
    ss += shfl_xor_l(ss, 32, lane);
    if (lg == 0) RED[(wm * 32 + i * 16 + lr) * 2 + wn] = ss;
  }
  __syncthreads();
#pragma unroll
  for (int i = 0; i < 2; i++) {
    const int q = wm * 32 + i * 16 + lr;
    const float rs = rsqrtf((RED[q * 2] + RED[q * 2 + 1]) * (1.f / 256.f) + 1e-6f);
#pragma unroll
    for (int j = 0; j < 8; j++) {
      f32x4 v = o[i][j];
#pragma unroll
      for (int r = 0; r < 4; r++) v[r] *= rs;
      *(uint2*)(ORET + (size_t)(t0 + q) * 1024 + h * 256 + wn * 128 + j * 16 + lg * 4) = pack4(v);
    }
  }
}

DEV void hg_item(const Params& p, int h, int c, bf16_t* lds) {
  unsigned char* ws = p.ws;
  const bf16_t* HQ = (const bf16_t*)(ws + OFF_HQ);
  const bf16_t* HK = (const bf16_t*)(ws + OFF_HK);
  const float* HCB = (const float*)(ws + OFF_HCB);
  const bf16_t* HVT = (const bf16_t*)(ws + OFF_HVT);
  const bf16_t* STH = (const bf16_t*)(ws + OFF_STH);
  bf16_t* OHG = (bf16_t*)(ws + OFF_OHG);
  constexpr int PS = 136;
  bf16_t* Qp = lds;
  bf16_t* Kp = lds + 128 * PS;
  bf16_t* As = lds + 2 * 128 * PS;
  float* RED = (float*)(lds + 2 * 128 * PS + 256 * PS);
  const int tid = get_tid(), lane = tid & 63, wave = tid >> 6, wm = wave >> 1, wn = wave & 1;
  const int lr = lane & 15, lg = lane >> 4;
  const int t0 = c * 128, colb = h * 128;
  const int lrow = tid >> 4, lc8 = (tid & 15) * 8;
#pragma unroll
  for (int i = 0; i < 4; i++) {
    const int row = lrow + i * 32;
    const size_t g = (size_t)(t0 + row) * 1024 + colb + lc8;
    uint4 qv = *(const uint4*)(HQ + g);
    float4 c0 = *(const float4*)(HCB + g), c1 = *(const float4*)(HCB + g + 4);
    float4 r0 = make_float4(0.f, 0.f, 0.f, 0.f), r1 = r0;
    if (row >= 32) {
      const size_t gr = (size_t)(t0 + (row & ~31) - 1) * 1024 + colb + lc8;
      r0 = *(const float4*)(HCB + gr); r1 = *(const float4*)(HCB + gr + 4);
    }
    uint4 ov;
    ov.x = pack2(bf2f((bf16_t)(qv.x & 0xffff)) * __expf(c0.x - r0.x), bf2f((bf16_t)(qv.x >> 16)) * __expf(c0.y - r0.y));
    ov.y = pack2(bf2f((bf16_t)(qv.y & 0xffff)) * __expf(c0.z - r0.z), bf2f((bf16_t)(qv.y >> 16)) * __expf(c0.w - r0.w));
    ov.z = pack2(bf2f((bf16_t)(qv.z & 0xffff)) * __expf(c1.x - r1.x), bf2f((bf16_t)(qv.z >> 16)) * __expf(c1.y - r1.y));
    ov.w = pack2(bf2f((bf16_t)(qv.w & 0xffff)) * __expf(c1.z - r1.z), bf2f((bf16_t)(qv.w >> 16)) * __expf(c1.w - r1.w));
    *(uint4*)(Qp + row * PS + lc8) = ov;
  }
  for (int I = 0; I < 4; I++) {
    const int nrows = 32 * (I + 1);
    float4 r0 = make_float4(0.f, 0.f, 0.f, 0.f), r1 = r0;
    if (I > 0) {
      const size_t gr = (size_t)(t0 + 32 * I - 1) * 1024 + colb + lc8;
      r0 = *(const float4*)(HCB + gr); r1 = *(const float4*)(HCB + gr + 4);
    }
#pragma unroll
    for (int i = 0; i < 4; i++) {
      const int row = lrow + i * 32;
      if (row < nrows) {
        const size_t g = (size_t)(t0 + row) * 1024 + colb + lc8;
        uint4 kv = *(const uint4*)(HK + g);
        float4 c0 = *(const float4*)(HCB + g), c1 = *(const float4*)(HCB + g + 4);
        uint4 ov;
        ov.x = pack2(bf2f((bf16_t)(kv.x & 0xffff)) * __expf(fminf(r0.x - c0.x, 80.f)), bf2f((bf16_t)(kv.x >> 16)) * __expf(fminf(r0.y - c0.y, 80.f)));
        ov.y = pack2(bf2f((bf16_t)(kv.y & 0xffff)) * __expf(fminf(r0.z - c0.z, 80.f)), bf2f((bf16_t)(kv.y >> 16)) * __expf(fminf(r0.w - c0.w, 80.f)));
        ov.z = pack2(bf2f((bf16_t)(kv.z & 0xffff)) * __expf(fminf(r1.x - c1.x, 80.f)), bf2f((bf16_t)(kv.z >> 16)) * __expf(fminf(r1.y - c1.y, 80.f)));
        ov.w = pack2(bf2f((bf16_t)(kv.w & 0xffff)) * __expf(fminf(r1.z - c1.z, 80.f)), bf2f((bf16_t)(kv.w >> 16)) * __expf(fminf(r1.w - c1.w, 80.f)));
        *(uint4*)(Kp + row * PS + lc8) = ov;
      }
    }
    __syncthreads();
    if (wave * 16 < nrows) {
      f32x4 a2[2];
      a2[0] = (f32x4){0.f, 0.f, 0.f, 0.f}; a2[1] = a2[0];
#pragma unroll
      for (int ks = 0; ks < 4; ks++) {
        bf16x8 bb = ldfrag(Kp, PS, wave * 16 + lr, ks * 32 + lg * 8);
        bf16x8 a0 = ldfrag(Qp, PS, 32 * I + lr, ks * 32 + lg * 8);
        bf16x8 a1 = ldfrag(Qp, PS, 32 * I + 16 + lr, ks * 32 + lg * 8);
        a2[0] = MFMA(bb, a0, a2[0]);
        a2[1] = MFMA(bb, a1, a2[1]);
      }
#pragma unroll
      for (int i = 0; i < 2; i++) {
        const int q = 32 * I + i * 16 + lr;
        f32x4 v;
#pragma unroll
        for (int r = 0; r < 4; r++) { const int key = wave * 16 + lg * 4 + r; v[r] = (key <= q) ? a2[i][r] : 0.f; }
        *(uint2*)(As + q * PS + wave * 16 + lg * 4) = pack4(v);
      }
    } else {
#pragma unroll
      for (int i = 0; i < 2; i++) {
        const int q = 32 * I + i * 16 + lr;
        *(uint2*)(As + q * PS + wave * 16 + lg * 4) = make_uint2(0u, 0u);
      }
    }
    __syncthreads();
  }
#pragma unroll
  for (int i = 0; i < 4; i++) {
    const int row = lrow + i * 32;
    *(uint4*)(Kp + row * PS + lc8) = *(const uint4*)(HVT + (size_t)(colb + row) * LT + t0 + lc8);
  }
  __syncthreads();
  f32x4 o[2][4];
#pragma unroll
  for (int i = 0; i < 2; i++)
#pragma unroll
    for (int j = 0; j < 4; j++) o[i][j] = (f32x4){0.f, 0.f, 0.f, 0.f};
#pragma unroll
  for (int ks = 0; ks < 4; ks++) {
    bf16x8 a0 = ldfrag(As, PS, wm * 32 + lr, ks * 32 + lg * 8);
    bf16x8 a1 = ldfrag(As, PS, wm * 32 + 16 + lr, ks * 32 + lg * 8);
#pragma unroll
    for (int j = 0; j < 4; j++) {
      bf16x8 bb = ldfrag(Kp, PS, wn * 64 + j * 16 + lr, ks * 32 + lg * 8);
      o[0][j] = MFMA(bb, a0, o[0][j]);
      o[1][j] = MFMA(bb, a1, o[1][j]);
    }
    __builtin_amdgcn_sched_barrier(0);
  }
  __syncthreads();
#pragma unroll
  for (int i = 0; i < 4; i++) {
    const int row = lrow + i * 32;
    const size_t g = (size_t)(t0 + row) * 1024 + colb + lc8;
    uint4 qv = *(const uint4*)(HQ + g);
    float4 c0 = *(const float4*)(HCB + g), c1 = *(const float4*)(HCB + g + 4);
    uint4 ov;
    ov.x = pack2(bf2f((bf16_t)(qv.x & 0xffff)) * __expf(c0.x), bf2f((bf16_t)(qv.x >> 16)) * __expf(c0.y));
    ov.y = pack2(bf2f((bf16_t)(qv.y & 0xffff)) * __expf(c0.z), bf2f((bf16_t)(qv.y >> 16)) * __expf(c0.w));
    ov.z = pack2(bf2f((bf16_t)(qv.z & 0xffff)) * __expf(c1.x), bf2f((bf16_t)(qv.z >> 16)) * __expf(c1.y));
    ov.w = pack2(bf2f((bf16_t)(qv.w & 0xffff)) * __expf(c1.z), bf2f((bf16_t)(qv.w >> 16)) * __expf(c1.w));
    *(uint4*)(Qp + row * PS + lc8) = ov;
    *(uint4*)(Kp + row * PS + lc8) = *(const uint4*)(STH + ((size_t)(h * 65 + c) * 128 + row) * 128 + lc8);
  }
  __syncthreads();
#pragma unroll
  for (int ks = 0; ks < 4; ks++) {
    bf16x8 a0 = ldfrag(Qp, PS, wm * 32 + lr, ks * 32 + lg * 8);
    bf16x8 a1 = ldfrag(Qp, PS, wm * 32 + 16 + lr, ks * 32 + lg * 8);
#pragma unroll
    for (int j = 0; j < 4; j++) {
      bf16x8 bb = ldfrag(Kp, PS, wn * 64 + j * 16 + lr, ks * 32 + lg * 8);
      o[0][j] = MFMA(bb, a0, o[0][j]);
      o[1][j] = MFMA(bb, a1, o[1][j]);
    }
    __builtin_amdgcn_sched_barrier(0);
  }
#pragma unroll
  for (int i = 0; i < 2; i++) {
    float ss = 0.f;
#pragma unroll
    for (int j = 0; j < 4; j++)
#pragma unroll
      for (int r = 0; r < 4; r++) ss += o[i][j][r] * o[i][j][r];
    ss += shfl_xor_l(ss, 16, lane);
    ss += shfl_xor_l(ss, 32, lane);
    if (lg == 0) RED[(wm * 32 + i * 16 + lr) * 2 + wn] = ss;
  }
  __syncthreads();
#pragma unroll
  for (int i = 0; i < 2; i++) {
    const int q = wm * 32 + i * 16 + lr;
    const float rs = rsqrtf((RED[q * 2] + RED[q * 2 + 1]) * (1.f / 128.f) + 1e-6f);
#pragma unroll
    for (int j = 0; j < 4; j++) {
      f32x4 v = o[i][j];
#pragma unroll
      for (int r = 0; r < 4; r++) v[r] *= rs;
      *(uint2*)(OHG + (size_t)(t0 + q) * 1024 + colb + wn * 64 + j * 16 + lg * 4) = pack4(v);
    }
  }
}

DEV void phase_O(const Params& p, int layer, int qidx, unsigned char* ldsraw) {
  bf16_t* lds = (bf16_t*)ldsraw;
  int* ctr = (int*)(p.ws + OFF_CTR) + qidx;
  int* sitem = (int*)(ldsraw + LDS_BYTES - 16);
  const float* lp = p.in[7] + layer * 256;
  float d0 = 0.f, d1 = 0.f;
  for (int i = 0; i < 64; i++) { d0 += lp[i] * lp[64 + i]; d1 += lp[128 + i] * lp[192 + i]; }
  int ly = layer; asm volatile("" : "+s"(ly));
  const float li = (ly == 0) ? 0.2f : 0.35550906759f;
  const float lam = __uint_as_float(__builtin_amdgcn_readfirstlane(__float_as_uint(__expf(d0) - __expf(d1) + li)));
  const int tid0 = get_tid();
  for (;;) {
    __syncthreads();
    if (tid0 == 0) *sitem = atomicAdd(ctr, 1);
    __syncthreads();
    const int item = __builtin_amdgcn_readfirstlane(*sitem);
    if (item >= 1300) break;
    if (item < 520) attn_item(p, layer, item & 7, 64 - (item >> 3), lam, lds);
    else if (item < 780) ret_item(p, (item - 520) & 3, (item - 520) >> 2, lds);
    else hg_item(p, (item - 780) & 7, (item - 780) >> 3, lds);
  }
}

DEV void phase_G(const Params& p, int b, unsigned char* ldsraw) {
  unsigned char* ws = p.ws;
  bf16_t* lds = (bf16_t*)ldsraw;
  const bf16_t* HN = (const bf16_t*)(ws + OFF_HN) + (size_t)b * LT * 1024;
  const bf16_t* WIN = (const bf16_t*)(ws + OFF_WIN);
  for (int item = vblock(); item < 33 * 20; item += gridDim.x) {
    int nt, mt; tile_map(item, 33, 4, mt, nt);
    int n0, cb; bf16_t* dst; int ld; bool gate;
    if (nt < 4) { n0 = 2048 + nt * 256; cb = nt * 256; dst = (bf16_t*)(ws + OFF_ORET); ld = 1024; gate = true; }
    else if (nt < 8) { n0 = 6144 + (nt - 4) * 256; cb = (nt - 4) * 256; dst = (bf16_t*)(ws + OFF_OHG); ld = 1024; gate = true; }
    else { n0 = 10240 + (nt - 8) * 256; cb = (nt - 8) * 256; dst = (bf16_t*)(ws + OFF_G); ld = 3072; gate = false; }
    f32x4 acc[4][8];
#pragma unroll
    for (int i = 0; i < 4; i++)
#pragma unroll
      for (int j = 0; j < 8; j++) acc[i][j] = (f32x4){0.f, 0.f, 0.f, 0.f};
    gemm256_acc<256>(acc, HN + (size_t)mt * 256 * 1024, 1024, LT - mt * 256, WIN + (size_t)n0 * 1024, 1024, 1024, lds);
    const int tid = get_tid(), lane = tid & 63, wave = tid >> 6, wm = wave >> 1, wn = wave & 1; const int lr = lane & 15, lg = lane >> 4;
#pragma unroll
    for (int i = 0; i < 4; i++) {
      const int t = mt * 256 + wm * 64 + i * 16 + lr;
      if (t < LT) {
#pragma unroll
        for (int j = 0; j < 8; j++) {
          bf16_t* d = dst + (size_t)t * ld + cb + wn * 128 + j * 16 + lg * 4;
          f32x4 v;
          if (gate) {
            uint2 ov = *(const uint2*)d;
            v[0] = bf2f((bf16_t)(ov.x & 0xffff)) * silu_f(acc[i][j][0]);
            v[1] = bf2f((bf16_t)(ov.x >> 16)) * silu_f(acc[i][j][1]);
            v[2] = bf2f((bf16_t)(ov.y & 0xffff)) * silu_f(acc[i][j][2]);
            v[3] = bf2f((bf16_t)(ov.y >> 16)) * silu_f(acc[i][j][3]);
          } else {
#pragma unroll
            for (int r = 0; r < 4; r++) v[r] = sigmoid_f(acc[i][j][r]);
          }
          *(uint2*)d = pack4(v);
        }
      }
    }
  }
}

DEV f32x4 mini_gemm16(const bf16_t* __restrict__ A16, int lda, const bf16_t* __restrict__ Bt16, int ldb, int k0, int klen, int lane) {
  const int lr = lane & 15, lg = lane >> 4;
  const bf16_t* pa = A16 + (size_t)lr * lda + k0 + lg * 8;
  const bf16_t* pb = Bt16 + (size_t)lr * ldb + k0 + lg * 8;
  f32x4 acc = (f32x4){0.f, 0.f, 0.f, 0.f};
#pragma unroll 4
  for (int k = 0; k < klen; k += 32) {
    bf16x8 a = *(const bf16x8*)(pa + k);
    bf16x8 b = *(const bf16x8*)(pb + k);
    acc = MFMA(b, a, acc);
  }
  return acc;
}

DEV void phase_Y(const Params& p, unsigned char* ldsraw) {
  unsigned char* ws = p.ws;
  bf16_t* lds = (bf16_t*)ldsraw;
  const bf16_t* WB = (const bf16_t*)(ws + OFF_WB);
  const bf16_t* G = (const bf16_t*)(ws + OFF_G);
  bf16_t* Y = (bf16_t*)(ws + OFF_Y);
  for (int item = vblock(); item < 32 * 8 + 64; item += gridDim.x) {
    if (item >= 256) {
      const int lane = get_tid() & 63, wave = get_tid() >> 6, lr = lane & 15, lg = lane >> 4;
      const int n0 = (item - 256) * 16;
      f32x4* red = (f32x4*)ldsraw;
      __syncthreads();
#pragma unroll 1
      for (int br = 0; br < 3; br++) {
        const bf16_t* Ab = (const bf16_t*)(ws + (br == 0 ? OFF_ORET : (br == 1 ? OFF_OHG : OFF_ODA))) + (size_t)112 * 1024;
        red[(br * 8 + wave) * 64 + lane] = mini_gemm16(Ab, 1024, WB + ((size_t)br * 1024 + n0) * 1024, 1024, wave * 128, 128, lane);
      }
      __syncthreads();
      if (wave == 0) {
        f32x4 y = (f32x4){0.f, 0.f, 0.f, 0.f};
#pragma unroll
        for (int br = 0; br < 3; br++) {
          f32x4 a = red[(br * 8) * 64 + lane];
#pragma unroll
          for (int w = 1; w < 8; w++) a += red[(br * 8 + w) * 64 + lane];
          uint2 gv = *(const uint2*)(G + (size_t)(112 + lr) * 3072 + br * 1024 + n0 + lg * 4);
          y[0] += bf2f((bf16_t)(gv.x & 0xffff)) * a[0];
          y[1] += bf2f((bf16_t)(gv.x >> 16)) * a[1];
          y[2] += bf2f((bf16_t)(gv.y & 0xffff)) * a[2];
          y[3] += bf2f((bf16_t)(gv.y >> 16)) * a[3];
        }
        *(uint2*)(Y + (size_t)(112 + lr) * 1024 + n0 + lg * 4) = pack4(y);
      }
      continue;
    }
    int nt, mt; tile_map(item, 32, 4, mt, nt);
    const int row0 = 128 + mt * 256;
    f32x4 y[4][4];
#pragma unroll
    for (int i = 0; i < 4; i++)
#pragma unroll
      for (int j = 0; j < 4; j++) y[i][j] = (f32x4){0.f, 0.f, 0.f, 0.f};
#pragma unroll 1
    for (int br = 0; br < 3; br++) {
      const bf16_t* Ab = (const bf16_t*)(ws + (br == 0 ? OFF_ORET : (br == 1 ? OFF_OHG : OFF_ODA))) + (size_t)row0 * 1024;
      f32x4 acc[4][4];
#pragma unroll
      for (int i = 0; i < 4; i++)
#pragma unroll
        for (int j = 0; j < 4; j++) acc[i][j] = (f32x4){0.f, 0.f, 0.f, 0.f};
      gemm256_acc<128>(acc, Ab, 1024, 256, WB + ((size_t)br * 1024 + nt * 128) * 1024, 1024, 1024, lds);
      const int tid = get_tid(), lane = tid & 63, wave = tid >> 6, wm = wave >> 1, wn = wave & 1; const int lr = lane & 15, lg = lane >> 4;
#pragma unroll
      for (int i = 0; i < 4; i++) {
        const int t = row0 + wm * 64 + i * 16 + lr;
#pragma unroll
        for (int j = 0; j < 4; j++) {
          uint2 gv = *(const uint2*)(G + (size_t)t * 3072 + br * 1024 + nt * 128 + wn * 64 + j * 16 + lg * 4);
          y[i][j][0] += bf2f((bf16_t)(gv.x & 0xffff)) * acc[i][j][0];
          y[i][j][1] += bf2f((bf16_t)(gv.x >> 16)) * acc[i][j][1];
          y[i][j][2] += bf2f((bf16_t)(gv.y & 0xffff)) * acc[i][j][2];
          y[i][j][3] += bf2f((bf16_t)(gv.y >> 16)) * acc[i][j][3];
        }
      }
    }
    const int tid = get_tid(), lane = tid & 63, wave = tid >> 6, wm = wave >> 1, wn = wave & 1; const int lr = lane & 15, lg = lane >> 4;
#pragma unroll
    for (int i = 0; i < 4; i++) {
      const int t = row0 + wm * 64 + i * 16 + lr;
#pragma unroll
      for (int j = 0; j < 4; j++)
        *(uint2*)(Y + (size_t)t * 1024 + nt * 128 + wn * 64 + j * 16 + lg * 4) = pack4(y[i][j]);
    }
  }
}

DEV void phase_resid(const Params& p, int b, const bf16_t* A, int K, const bf16_t* Wt, unsigned char* ldsraw) {
  bf16_t* lds = (bf16_t*)ldsraw;
  for (int item = vblock(); item < 32 * 8 + 64; item += gridDim.x) {
    if (item >= 256) {
      const int lane = get_tid() & 63, wave = get_tid() >> 6, lr = lane & 15, lg = lane >> 4;
      const int n0 = (item - 256) * 16;
      f32x4* red = (f32x4*)ldsraw;
      const int ks = K >> 3;
      __syncthreads();
      red[wave * 64 + lane] = mini_gemm16(A + (size_t)112 * K, K, Wt + (size_t)n0 * K, K, wave * ks, ks, lane);
      __syncthreads();
      if (wave == 0) {
        f32x4 a = red[lane];
#pragma unroll
        for (int w = 1; w < 8; w++) a += red[w * 64 + lane];
        float4* d = (float4*)(hrow(p, b, 112 + lr) + n0 + lg * 4);
        float4 v = *d;
        v.x += a[0]; v.y += a[1]; v.z += a[2]; v.w += a[3];
        *d = v;
      }
      continue;
    }
    int nt, mt; tile_map(item, 32, 4, mt, nt);
    const int row0 = 128 + mt * 256;
    f32x4 acc[4][4];
#pragma unroll
    for (int i = 0; i < 4; i++)
#pragma unroll
      for (int j = 0; j < 4; j++) acc[i][j] = (f32x4){0.f, 0.f, 0.f, 0.f};
    gemm256_acc<128>(acc, A + (size_t)row0 * K, K, 256, Wt + (size_t)nt * 128 * K, K, K, lds);
    const int tid = get_tid(), lane = tid & 63, wave = tid >> 6, wm = wave >> 1, wn = wave & 1; const int lr = lane & 15, lg = lane >> 4;
#pragma unroll
    for (int i = 0; i < 4; i++) {
      const int t = row0 + wm * 64 + i * 16 + lr;
#pragma unroll
      for (int j = 0; j < 4; j++) {
        float4* d = (float4*)(hrow(p, b, t) + nt * 128 + wn * 64 + j * 16 + lg * 4);
        float4 v = *d;
        v.x += acc[i][j][0]; v.y += acc[i][j][1]; v.z += acc[i][j][2]; v.w += acc[i][j][3];
        *d = v;
      }
    }
  }
}

DEV void phase_F1(const Params& p, int b, unsigned char* ldsraw) {
  unsigned char* ws = p.ws;
  bf16_t* lds = (bf16_t*)ldsraw;
  const bf16_t* HN = (const bf16_t*)(ws + OFF_HN) + (size_t)b * LT * 1024;
  const bf16_t* WFI = (const bf16_t*)(ws + OFF_WFI);
  bf16_t* U = (bf16_t*)(ws + OFF_U);
  for (int item = vblock(); item < 33 * 22; item += gridDim.x) {
    int nt, mt; tile_map(item, 33, 2, mt, nt);
    f32x4 acc[4][8];
#pragma unroll
    for (int i = 0; i < 4; i++)
#pragma unroll
      for (int j = 0; j < 8; j++) acc[i][j] = (f32x4){0.f, 0.f, 0.f, 0.f};
    gemm256_acc<256>(acc, HN + (size_t)mt * 256 * 1024, 1024, LT - mt * 256, WFI + (size_t)nt * 256 * 1024, 1024, 1024, lds);
    const int tid = get_tid(), lane = tid & 63, wave = tid >> 6, wm = wave >> 1, wn = wave & 1; const int lr = lane & 15, lg = lane >> 4;
#pragma unroll
    for (int i = 0; i < 4; i++) {
      const int t = mt * 256 + wm * 64 + i * 16 + lr;
      if (t < LT) {
        const float vm = (t >= 112) ? 1.f : 0.f;
#pragma unroll
        for (int j = 0; j < 8; j++) {
          f32x4 v = acc[i][j];
#pragma unroll
          for (int r = 0; r < 4; r++) v[r] *= vm;
          *(uint2*)(U + (size_t)t * 5632 + nt * 256 + wn * 128 + j * 16 + lg * 4) = pack4(v);
        }
      }
    }
  }
}

DEV void unpack8(const u32x4 v, float (&f)[8]) {
#pragma unroll
  for (int k = 0; k < 4; k++) { f[2 * k] = bf2f((bf16_t)(v[k] & 0xffff)); f[2 * k + 1] = bf2f((bf16_t)(v[k] >> 16)); }
}
DEV void phase_conv(const Params& p, int layer) {
  unsigned char* ws = p.ws;
  const bf16_t* U = (const bf16_t*)(ws + OFF_U);
  bf16_t* GF = (bf16_t*)(ws + OFF_GF);
  const float* cw = p.in[11] + (size_t)layer * 3 * 5632;
  const float* cbias = p.in[12] + (size_t)layer * 5632;
  for (int idx = get_bid() * NTHR + get_tid(); idx < (LT / 8) * 352; idx += gridDim.x * NTHR) {
    const int tb = idx / 352, c8 = (idx - tb * 352) * 8;
    const int t0 = tb * 8;
    float wg[3][8], wv[3][8], bg[8], bv[8];
#pragma unroll
    for (int k = 0; k < 8; k++) {
      bg[k] = cbias[c8 + k]; bv[k] = cbias[2816 + c8 + k];
#pragma unroll
      for (int j = 0; j < 3; j++) { wg[j][k] = cw[j * 5632 + c8 + k]; wv[j][k] = cw[j * 5632 + 2816 + c8 + k]; }
    }
    float g0[8], g1[8], v0[8], v1[8];
    if (t0 >= 2) {
      unpack8(*(const u32x4*)(U + (size_t)(t0 - 2) * 5632 + c8), g0);
      unpack8(*(const u32x4*)(U + (size_t)(t0 - 2) * 5632 + 2816 + c8), v0);
      unpack8(*(const u32x4*)(U + (size_t)(t0 - 1) * 5632 + c8), g1);
      unpack8(*(const u32x4*)(U + (size_t)(t0 - 1) * 5632 + 2816 + c8), v1);
    } else {
#pragma unroll
      for (int k = 0; k < 8; k++) { g0[k] = 0.f; g1[k] = 0.f; v0[k] = 0.f; v1[k] = 0.f; }
    }
#pragma unroll
    for (int tt = 0; tt < 8; tt++) {
      float g2[8], v2[8];
      unpack8(*(const u32x4*)(U + (size_t)(t0 + tt) * 5632 + c8), g2);
      unpack8(*(const u32x4*)(U + (size_t)(t0 + tt) * 5632 + 2816 + c8), v2);
      float og[8];
#pragma unroll
      for (int k = 0; k < 8; k++) {
        const float gg = bg[k] + wg[0][k] * g0[k] + wg[1][k] * g1[k] + wg[2][k] * g2[k];
        const float vv = bv[k] + wv[0][k] * v0[k] + wv[1][k] * v1[k] + wv[2][k] * v2[k];
        og[k] = silu_f(gg) * vv;
        g0[k] = g1[k]; g1[k] = g2[k]; v0[k] = v1[k]; v1[k] = v2[k];
      }
      u32x4 o;
      o[0] = pack2(og[0], og[1]); o[1] = pack2(og[2], og[3]); o[2] = pack2(og[4], og[5]); o[3] = pack2(og[6], og[7]);
      *(u32x4*)(GF + (size_t)(t0 + tt) * 2816 + c8) = o;
    }
  }
}

#define XB_TMO      128
#define XB_XCNT(j)  (256  + 64 * (j))
#define XB_XSUB(j)  (1280 + 64 * (j))
#define XB_XGEN(j)  (2304 + 64 * (j))
#define XB_TOP      3328
#define XB_TOPGEN   3392
#define XB_SPIN_CAP (1u << 18)
#define LAS __attribute__((address_space(3)))
DEV unsigned xb_ld(unsigned* p) { return __hip_atomic_load(p, __ATOMIC_RELAXED, __HIP_MEMORY_SCOPE_AGENT); }
DEV unsigned xb_add(unsigned* p, unsigned v) { return __hip_atomic_fetch_add(p, v, __ATOMIC_RELAXED, __HIP_MEMORY_SCOPE_AGENT); }
DEV unsigned xb_xcc_id() { return (unsigned)__builtin_amdgcn_s_getreg((3 << 11) | 20) & 0xFu; }
#define XB_SPIN(cond, bar) do { unsigned _sp = 0; while (cond) { __builtin_amdgcn_s_sleep(1); \
    if ((++_sp & 255u) == 0u) { if (xb_ld(&(bar)[XB_TMO])) break; if (_sp > XB_SPIN_CAP) { atomicAdd(&(bar)[XB_TMO], 1u); break; } } } } while (0)
struct XcdBarrier { unsigned* bar; unsigned x; volatile LAS unsigned* st; };
DEV XcdBarrier xcd_barrier_post(unsigned* bar, volatile LAS unsigned* st) {
  XcdBarrier b; b.bar = bar; b.x = xb_xcc_id(); b.st = st;
  if (threadIdx.x == 0) (void)xb_add(&bar[XB_XCNT(b.x)], 1u);
  return b;
}
DEV void xcd_barrier_complete(unsigned* bar, unsigned x, unsigned& nloc, unsigned& nx) {
  const unsigned G = gridDim.x;
  unsigned sum, cnt, mine, sp = 0u;
  for (;;) {
    sum = 0u; cnt = 0u; mine = 0u;
#pragma unroll
    for (unsigned j = 0; j < 16; ++j) { const unsigned c = xb_ld(&bar[XB_XCNT(j)]); sum += c; cnt += (c > 0u) ? 1u : 0u; mine = (j == x) ? c : mine; }
    if (sum == G) break;
    __builtin_amdgcn_s_sleep(1);
    if ((++sp & 255u) == 0u) { if (xb_ld(&bar[XB_TMO])) break; if (sp > XB_SPIN_CAP) { atomicAdd(&bar[XB_TMO], 1u); break; } }
  }
  nloc = mine > 0u ? mine : 1u; nx = cnt > 0u ? cnt : 1u;
}
DEV void xcd_barrier(const XcdBarrier& b) {
  asm volatile("s_waitcnt vmcnt(0)" ::: "memory");
  __syncthreads();
  if (threadIdx.x == 0) {
    unsigned* bar = b.bar;
    __builtin_amdgcn_s_waitcnt(0);
    unsigned nloc = b.st[0], nx = b.st[1];
    if (nloc == 0u) { xcd_barrier_complete(bar, b.x, nloc, nx); b.st[0] = nloc; b.st[1] = nx; }
    const unsigned old = xb_add(&bar[XB_XSUB(b.x)], 1u);
    const unsigned gen = old / nloc;
    if (old + 1u == (gen + 1u) * nloc) {
      __builtin_amdgcn_fence(__ATOMIC_RELEASE, "agent");
      asm volatile("s_waitcnt vmcnt(0)" ::: "memory");
      const unsigned og = xb_add(&bar[XB_TOP], 1u);
      const unsigned tg = og / nx;
      if (og + 1u == (tg + 1u) * nx) xb_add(&bar[XB_TOPGEN], 1u);
      else XB_SPIN(xb_ld(&bar[XB_TOPGEN]) == tg, bar);
      __builtin_amdgcn_fence(__ATOMIC_ACQUIRE, "agent");
      xb_add(&bar[XB_XGEN(b.x)], 1u);
      asm volatile("s_waitcnt vmcnt(0)" ::: "memory");
    } else {
      XB_SPIN(xb_ld(&bar[XB_XGEN(b.x)]) == gen, bar);
      __builtin_amdgcn_fence(__ATOMIC_ACQUIRE, "agent");
      asm volatile("s_waitcnt vmcnt(0)" ::: "memory");
    }
  }
  __syncthreads();
}

__global__ void __launch_bounds__(NTHR) fwd_megakernel(Params p) {
  extern __shared__ __attribute__((aligned(16))) unsigned char lds[];
  cg::grid_group grid = cg::this_grid();
  volatile LAS unsigned* xst = (volatile LAS unsigned*)(lds + LDS_BYTES - 12);
  if (threadIdx.x == 0) { xst[0] = 0u; xst[1] = 0u; }
  __syncthreads();
  (void)xcd_barrier_post((unsigned*)(p.ws + OFF_XBAR), xst);
#define GRID_SYNC() do { XcdBarrier xb_; xb_.bar = (unsigned*)(p.ws + OFF_XBAR); xb_.x = xb_xcc_id(); \
    xb_.st = (volatile LAS unsigned*)(lds + LDS_BYTES - 12); xcd_barrier(xb_); } while (0)
  grid.sync();
  unsigned char* ws = p.ws;
  phase_init(p);
  phase_convert(p, 0, lds);
  GRID_SYNC();
  for (int layer = 0; layer < 2; layer++) {
    if (layer == 1) {
      phase_convert(p, 1, lds);
#pragma unroll 1
      for (int bb = 0; bb < 2; bb++)
        phase_norm(p, bb, p.in[2] + 1024, (bf16_t*)(ws + OFF_HN) + (size_t)bb * LT * 1024);
      GRID_SYNC();
    }
    for (int b = 0; b < 2; b++) {
      bf16_t* HNb = (bf16_t*)(ws + OFF_HN) + (size_t)b * LT * 1024;
      phase_projA(p, layer, b, lds);
      GRID_SYNC();
      phase_U(p, lds);
      GRID_SYNC();
      phase_scan(p);
      GRID_SYNC();
      phase_O(p, layer, layer * 2 + b, lds);
      GRID_SYNC();
      phase_G(p, b, lds);
      GRID_SYNC();
      phase_Y(p, lds);
      GRID_SYNC();
      phase_resid(p, b, (const bf16_t*)(ws + OFF_Y), 1024, (const bf16_t*)(ws + OFF_WO), lds);
      GRID_SYNC();
      phase_norm(p, b, p.in[9] + layer * 1024, HNb);
      GRID_SYNC();
      phase_F1(p, b, lds);
      GRID_SYNC();
      phase_conv(p, layer);
      GRID_SYNC();
      phase_resid(p, b, (const bf16_t*)(ws + OFF_GF), DFF, (const bf16_t*)(ws + OFF_WFO), lds);
      GRID_SYNC();
    }
  }
  phase_final(p);
}

extern "C" void kernel_launch(void* const* d_in, const int* in_sizes, int n_in, void* d_out, int out_size,
                              void* d_ws, size_t ws_size, hipStream_t stream) {
  static int grid_blocks = 0;
  if (grid_blocks == 0) {
    if (n_in != 15 || ws_size < OFF_END) {
      fprintf(stderr, "kernel_launch: need 15 inputs and %zu bytes of workspace, got %d and %zu\n", (size_t)OFF_END, n_in, ws_size);
      grid_blocks = -1; return;
    }
    int dev = 0, cus = 0, per_cu = 0;
    hipGetDevice(&dev);
    hipDeviceGetAttribute(&cus, hipDeviceAttributeMultiprocessorCount, dev);
    if (hipFuncSetAttribute((const void*)fwd_megakernel, hipFuncAttributeMaxDynamicSharedMemorySize, LDS_BYTES) != hipSuccess) {
      fprintf(stderr, "kernel_launch: hipFuncSetAttribute failed\n"); grid_blocks = -1; return;
    }
    hipOccupancyMaxActiveBlocksPerMultiprocessor(&per_cu, (const void*)fwd_megakernel, NTHR, LDS_BYTES);
    if (per_cu < 1) per_cu = 1;
    if (per_cu > 1) per_cu = 1;
    grid_blocks = cus * per_cu;
  }
  if (grid_blocks < 0) return;
  hipMemsetAsync((char*)d_ws + OFF_CTR, 0, 256 + XBAR_BYTES, stream);
  Params p{};
  for (int i = 0; i < 15; i++) p.in[i] = (const float*)d_in[i];
  p.out = (float*)d_out;
  p.ws = (unsigned char*)d_ws;
  void* args[] = {&p};
  hipError_t e = hipLaunchCooperativeKernel((const void*)fwd_megakernel, dim3(grid_blocks), dim3(NTHR), args, LDS_BYTES, stream);
  if (e != hipSuccess) fprintf(stderr, "cooperative launch failed: %s (grid %d)\n", hipGetErrorString(e), grid_blocks);
}
```

```cpp
#include <hip/hip_runtime.h>
#include <hip/hip_cooperative_groups.h>
#include <cstdio>
#include <cstdint>
namespace cg = cooperative_groups;

typedef unsigned short bf16_t;
typedef __attribute__((ext_vector_type(8))) short bf16x8;
typedef __attribute__((ext_vector_type(4))) short bf16x4;
typedef __attribute__((ext_vector_type(4))) float f32x4;
typedef __attribute__((ext_vector_type(4))) unsigned u32x4;

#define DEV __device__ __forceinline__
#define MFMA(a, b, c) __builtin_amdgcn_mfma_f32_16x16x32_bf16(a, b, c, 0, 0, 0)

constexpr int LT = 8320;
constexpr int NCH = 65;
constexpr int NTHR = 512;
constexpr int LDS_BYTES = 144 * 1024;
constexpr int INW = 13312;
constexpr int DFF = 2816;

constexpr size_t SZ_ACT = (size_t)LT * 1024 * 2;
constexpr size_t OFF_WIN = 0;
constexpr size_t OFF_WB = OFF_WIN + (size_t)INW * 1024 * 2;
constexpr size_t OFF_WO = OFF_WB + (size_t)3 * 1024 * 1024 * 2;
constexpr size_t OFF_WFI = OFF_WO + (size_t)1024 * 1024 * 2;
constexpr size_t OFF_WFO = OFF_WFI + (size_t)5632 * 1024 * 2;
constexpr size_t OFF_H = OFF_WFO + (size_t)1024 * 2816 * 2;
constexpr size_t OFF_HN = OFF_H + (size_t)2 * 128 * 1024 * 4;
constexpr size_t OFF_R128 = OFF_HN + 2 * SZ_ACT;
constexpr size_t OFF_R64 = OFF_R128 + (size_t)LT * 64 * 8;
constexpr size_t OFF_CTR = OFF_R64 + (size_t)LT * 32 * 8;
constexpr size_t OFF_XBAR = OFF_CTR + 256;
constexpr size_t XBAR_BYTES = 3456 * 4;
constexpr size_t OFF_ARENA = OFF_XBAR + XBAR_BYTES;
constexpr size_t OFF_RQ = OFF_ARENA;
constexpr size_t OFF_RK = OFF_RQ + SZ_ACT / 2;
constexpr size_t OFF_RKT = OFF_RK + SZ_ACT / 2;
constexpr size_t OFF_RVT = OFF_RKT + SZ_ACT / 2;
constexpr size_t OFF_HQ = OFF_RVT + SZ_ACT;
constexpr size_t OFF_HK = OFF_HQ + SZ_ACT;
constexpr size_t OFF_HCB = OFF_HK + SZ_ACT;
constexpr size_t OFF_HKET = OFF_HCB + 2 * SZ_ACT;
constexpr size_t OFF_HVT = OFF_HKET + SZ_ACT;
constexpr size_t OFF_DQ = OFF_HVT + SZ_ACT;
constexpr size_t OFF_DK = OFF_DQ + SZ_ACT;
constexpr size_t OFF_DVT = OFF_DK + SZ_ACT;
constexpr size_t OFF_ORET = OFF_DVT + SZ_ACT;
constexpr size_t OFF_OHG = OFF_ORET + SZ_ACT;
constexpr size_t OFF_STR = OFF_OHG + SZ_ACT;
constexpr size_t OFF_STH = OFF_STR + SZ_ACT;
constexpr size_t OFF_HDEC = OFF_STH + SZ_ACT;
constexpr size_t OFF_END = OFF_HDEC + (size_t)65 * 1024 * 4;
constexpr size_t OFF_G = OFF_RQ;
constexpr size_t OFF_Y = OFF_HK;
constexpr size_t OFF_ODA = OFF_HKET;
constexpr size_t OFF_U = OFF_ARENA;
constexpr size_t OFF_GF = OFF_U + (size_t)LT * 5632 * 2;

struct Params {
  const float* in[15];
  float* out;
  unsigned char* ws;
};

DEV int get_tid() { int t = threadIdx.x; asm volatile("" : "+v"(t)); return t; }
DEV int get_bid() { int b = blockIdx.x; asm volatile("" : "+s"(b)); return b; }
DEV float shfl_xor_l(float v, int m, int lane) { return __int_as_float(__builtin_amdgcn_ds_bpermute((lane ^ m) << 2, __float_as_int(v))); }
DEV float shfl_l(float v, int srclane) { return __int_as_float(__builtin_amdgcn_ds_bpermute(srclane << 2, __float_as_int(v))); }
DEV float* hrow(const Params& p, int b, int t) {
  return (t < 128) ? (float*)(p.ws + OFF_H) + (size_t)(b * 128 + t) * 1024 : p.out + ((size_t)b * 8192 + (t - 128)) * 1024;
}
typedef __bf16 hwbf16x2 __attribute__((ext_vector_type(2)));
typedef float hwf32x2 __attribute__((ext_vector_type(2)));
DEV unsigned pack2(float a, float b) {
  hwf32x2 f = {a, b};
  hwbf16x2 h = __builtin_convertvector(f, hwbf16x2);
  return __builtin_bit_cast(unsigned, h);
}
DEV bf16_t f2bf(float f) { return (bf16_t)(pack2(f, f) & 0xffffu); }
DEV float bf2f(bf16_t h) { return __uint_as_float(((unsigned)h) << 16); }
DEV uint2 pack4(f32x4 v) { uint2 r; r.x = pack2(v[0], v[1]); r.y = pack2(v[2], v[3]); return r; }
DEV float silu_f(float x) { return x / (1.f + __expf(-x)); }
DEV float sigmoid_f(float x) { return 1.f / (1.f + __expf(-x)); }
DEV float ex2(float x) { return __builtin_amdgcn_exp2f(x); }
DEV bf16x8 ldfrag(const bf16_t* base, int stride, int row, int k) {
  return *(const bf16x8*)(base + row * stride + k);
}

template <int BN, bool TRANS>
DEV void gemm_compute(f32x4 (&acc)[2][BN / 32], const bf16_t* as, const bf16_t* bs, int sw0, int sw1) {
  constexpr int NJ = BN / 32, LS = 64;
#pragma unroll
  for (int ks = 0; ks < 2; ks++) {
    const int sw = ks == 0 ? sw0 : sw1;
    bf16x8 a0 = *(const bf16x8*)(as + sw);
    bf16x8 a1 = *(const bf16x8*)(as + 16 * LS + sw);
#pragma unroll
    for (int j = 0; j < NJ; j++) {
      bf16x8 bb = *(const bf16x8*)(bs + j * 16 * LS + sw);
      if (TRANS) {
        acc[0][j] = MFMA(a0, bb, acc[0][j]);
        acc[1][j] = MFMA(a1, bb, acc[1][j]);
      } else {
        acc[0][j] = MFMA(bb, a0, acc[0][j]);
        acc[1][j] = MFMA(bb, a1, acc[1][j]);
      }
    }
  }
}

template <int BN, bool TRANS>
DEV void gemm_acc(f32x4 (&acc)[2][BN / 32], const bf16_t* __restrict__ A, int lda,
                  const bf16_t* __restrict__ Bt, int ldb, int K, bf16_t* lds) {
  constexpr int LS = 64, A_SZ = 128 * LS, B_SZ = BN * LS, NB = BN / 64;
  const int tid = get_tid(), lane = tid & 63, wave = tid >> 6, wm = wave >> 1, wn = wave & 1;
  const int lr = lane & 15, lg = lane >> 4;
  bf16_t* As = lds;
  bf16_t* Bs = lds + 2 * A_SZ;
  const int crow = tid >> 3, ckc = (tid & 7) * 8;
  const int cks = ((tid & 7) ^ ((crow >> 1) & 7)) * 8;
  const int sw0 = (lg ^ ((lr >> 1) & 7)) * 8, sw1 = sw0 ^ 32;
  const bf16_t* ga = A + (size_t)crow * lda + ckc;
  const bf16_t* gb = Bt + (size_t)crow * ldb + ckc;
  u32x4 ra0, ra1, rb0, rb1, rb2, rb3;
#define GLOAD(k0)                                                        \
  ra0 = *(const u32x4*)(ga + (k0));                                      \
  ra1 = *(const u32x4*)(ga + (size_t)64 * lda + (k0));                   \
  rb0 = *(const u32x4*)(gb + (k0));                                      \
  rb1 = *(const u32x4*)(gb + (size_t)64 * ldb + (k0));                   \
  if (NB == 4) {                                                         \
    rb2 = *(const u32x4*)(gb + (size_t)128 * ldb + (k0));                \
    rb3 = *(const u32x4*)(gb + (size_t)192 * ldb + (k0));                \
  }
#define LSTORE(buf)                                                      \
  *(u32x4*)(As + (buf) * A_SZ + crow * LS + cks) = ra0;                  \
  *(u32x4*)(As + (buf) * A_SZ + (crow + 64) * LS + cks) = ra1;           \
  *(u32x4*)(Bs + (buf) * B_SZ + crow * LS + cks) = rb0;                  \
  *(u32x4*)(Bs + (buf) * B_SZ + (crow + 64) * LS + cks) = rb1;           \
  if (NB == 4) {                                                         \
    *(u32x4*)(Bs + (buf) * B_SZ + (crow + 128) * LS + cks) = rb2;        \
    *(u32x4*)(Bs + (buf) * B_SZ + (crow + 192) * LS + cks) = rb3;        \
  }
  const int nk = K / 64;
  const int aoff = (wm * 32 + lr) * LS;
  const int boff = (wn * (BN / 2) + lr) * LS;
  GLOAD(0)
  __syncthreads();
  LSTORE(0)
  GLOAD(64)
  __syncthreads();
  for (int kt = 0; kt < nk; kt++) {
    const int cur = kt & 1;
    LSTORE(cur ^ 1)
    {
      const int kn = (kt + 2 < nk) ? kt + 2 : nk - 1;
      GLOAD(kn * 64)
    }
    __builtin_amdgcn_sched_barrier(0);
    gemm_compute<BN, TRANS>(acc, As + cur * A_SZ + aoff, Bs + cur * B_SZ + boff, sw0, sw1);
    __syncthreads();
  }
#undef GLOAD
#undef LSTORE
}

template <int BN, bool TRANS>
DEV void gemm256_compute(f32x4 (&acc)[4][BN / 32], const bf16_t* as, const bf16_t* bs, int sw0, int sw1) {
  constexpr int LS = 64, NJ = BN / 32;
#pragma unroll
  for (int ks = 0; ks < 2; ks++) {
    const int sw = ks == 0 ? sw0 : sw1;
    bf16x8 a[4];
#pragma unroll
    for (int i = 0; i < 4; i++) a[i] = *(const bf16x8*)(as + i * 16 * LS + sw);
#pragma unroll
    for (int j = 0; j < NJ; j++) {
      bf16x8 bb = *(const bf16x8*)(bs + j * 16 * LS + sw);
#pragma unroll
      for (int i = 0; i < 4; i++) acc[i][j] = TRANS ? MFMA(a[i], bb, acc[i][j]) : MFMA(bb, a[i], acc[i][j]);
    }
  }
}

template <int BN, bool TRANS = false>
DEV void gemm256_acc(f32x4 (&acc)[4][BN / 32], const bf16_t* __restrict__ A, int lda, int m_valid,
                     const bf16_t* __restrict__ Bt, int ldb, int K, bf16_t* lds) {
  constexpr int LS = 64, A_SZ = 256 * LS, B_SZ = BN * LS, NB = BN / 64;
  const int tid = get_tid(), lane = tid & 63, wave = tid >> 6, wm = wave >> 1, wn = wave & 1;
  const int lr = lane & 15, lg = lane >> 4;
  bf16_t* As = lds;
  bf16_t* Bs = lds + 2 * A_SZ;
  const int crow = tid >> 3, ckc = (tid & 7) * 8;
  const int cks = ((tid & 7) ^ ((crow >> 1) & 7)) * 8;
  const int sw0 = (lg ^ ((lr >> 1) & 7)) * 8, sw1 = sw0 ^ 32;
  const bf16_t* ga0 = A + (size_t)min(crow, m_valid - 1) * lda + ckc;
  const bf16_t* ga1 = A + (size_t)min(crow + 64, m_valid - 1) * lda + ckc;
  const bf16_t* ga2 = A + (size_t)min(crow + 128, m_valid - 1) * lda + ckc;
  const bf16_t* ga3 = A + (size_t)min(crow + 192, m_valid - 1) * lda + ckc;
  const bf16_t* gb = Bt + (size_t)crow * ldb + ckc;
  u32x4 ra0, ra1, ra2, ra3, rb0, rb1, rb2, rb3;
#define GLOAD(k0)                                                        \
  ra0 = *(const u32x4*)(ga0 + (k0));                                     \
  ra1 = *(const u32x4*)(ga1 + (k0));                                     \
  ra2 = *(const u32x4*)(ga2 + (k0));                                     \
  ra3 = *(const u32x4*)(ga3 + (k0));                                     \
  rb0 = *(const u32x4*)(gb + (k0));                                      \
  rb1 = *(const u32x4*)(gb + (size_t)64 * ldb + (k0));                   \
  if (NB == 4) {                                                         \
    rb2 = *(const u32x4*)(gb + (size_t)128 * ldb + (k0));                \
    rb3 = *(const u32x4*)(gb + (size_t)192 * ldb + (k0));                \
  }
#define LSTORE(buf)                                                      \
  *(u32x4*)(As + (buf) * A_SZ + crow * LS + cks) = ra0;                  \
  *(u32x4*)(As + (buf) * A_SZ + (crow + 64) * LS + cks) = ra1;           \
  *(u32x4*)(As + (buf) * A_SZ + (crow + 128) * LS + cks) = ra2;          \
  *(u32x4*)(As + (buf) * A_SZ + (crow + 192) * LS + cks) = ra3;          \
  *(u32x4*)(Bs + (buf) * B_SZ + crow * LS + cks) = rb0;                  \
  *(u32x4*)(Bs + (buf) * B_SZ + (crow + 64) * LS + cks) = rb1;           \
  if (NB == 4) {                                                         \
    *(u32x4*)(Bs + (buf) * B_SZ + (crow + 128) * LS + cks) = rb2;        \
    *(u32x4*)(Bs + (buf) * B_SZ + (crow + 192) * LS + cks) = rb3;        \
  }
  const int nk = K / 64;
  const int aoff = (wm * 64 + lr) * LS;
  const int boff = (wn * (BN / 2) + lr) * LS;
  GLOAD(0)
  __syncthreads();
  LSTORE(0)
  GLOAD(64)
  __syncthreads();
  for (int kt = 0; kt < nk; kt++) {
    const int cur = kt & 1;
    LSTORE(cur ^ 1)
    {
      const int kn = (kt + 2 < nk) ? kt + 2 : nk - 1;
      GLOAD(kn * 64)
    }
    __builtin_amdgcn_sched_barrier(0);
    gemm256_compute<BN, TRANS>(acc, As + cur * A_SZ + aoff, Bs + cur * B_SZ + boff, sw0, sw1);
    __syncthreads();
  }
#undef GLOAD
#undef LSTORE
}

DEV void tconv_tiles4(const float* __restrict__ src, int K, int N, bf16_t* __restrict__ dst, int idx0, int ntn, float* tile) {
  const int tid = get_tid();
  const int r = tid >> 4, c4 = (tid & 15) * 4;
  float4 v[4][2];
#pragma unroll
  for (int u = 0; u < 4; u++) {
    const int idx = idx0 + u, tk = idx / ntn, tn = idx - tk * ntn;
#pragma unroll
    for (int i = 0; i < 2; i++) v[u][i] = *(const float4*)(src + (size_t)(tk * 64 + r + i * 32) * N + tn * 64 + c4);
  }
  __syncthreads();
#pragma unroll
  for (int u = 0; u < 4; u++)
#pragma unroll
    for (int i = 0; i < 2; i++) {
      float* t = tile + u * (64 * 65) + (r + i * 32) * 65 + c4;
      t[0] = v[u][i].x; t[1] = v[u][i].y; t[2] = v[u][i].z; t[3] = v[u][i].w;
    }
  __syncthreads();
  const int n = tid >> 3, k8 = (tid & 7) * 8;
#pragma unroll
  for (int u = 0; u < 4; u++) {
    const int idx = idx0 + u, tk = idx / ntn, tn = idx - tk * ntn;
    const float* t = tile + u * (64 * 65);
    u32x4 o;
    o[0] = pack2(t[(k8 + 0) * 65 + n], t[(k8 + 1) * 65 + n]);
    o[1] = pack2(t[(k8 + 2) * 65 + n], t[(k8 + 3) * 65 + n]);
    o[2] = pack2(t[(k8 + 4) * 65 + n], t[(k8 + 5) * 65 + n]);
    o[3] = pack2(t[(k8 + 6) * 65 + n], t[(k8 + 7) * 65 + n]);
    *(u32x4*)(dst + (size_t)(tn * 64 + n) * K + tk * 64 + k8) = o;
  }
}

DEV void phase_convert(const Params& p, int layer, unsigned char* lds) {
  unsigned char* ws = p.ws;
  float* tile = (float*)lds;
  for (int g = get_bid(); g < 1616; g += gridDim.x) {
    const float* src; bf16_t* dst; int K, N, gi;
    if (g < 832) { gi = g; src = p.in[3] + (size_t)layer * 1024 * INW; K = 1024; N = INW; dst = (bf16_t*)(ws + OFF_WIN); }
    else if (g < 832 + 192) { gi = g - 832; const int br = gi >> 6; gi &= 63; src = p.in[4] + ((size_t)layer * 3 + br) * 1024 * 1024; K = 1024; N = 1024; dst = (bf16_t*)(ws + OFF_WB) + (size_t)br * 1024 * 1024; }
    else if (g < 1088) { gi = g - 1024; src = p.in[5] + (size_t)layer * 1024 * 1024; K = 1024; N = 1024; dst = (bf16_t*)(ws + OFF_WO); }
    else if (g < 1440) { gi = g - 1088; src = p.in[10] + (size_t)layer * 1024 * 5632; K = 1024; N = 5632; dst = (bf16_t*)(ws + OFF_WFI); }
    else { gi = g - 1440; src = p.in[13] + (size_t)layer * 2816 * 1024; K = 2816; N = 1024; dst = (bf16_t*)(ws + OFF_WFO); }
    tconv_tiles4(src, K, N, dst, gi * 4, N / 64, (float*)tile);
  }
}

DEV void phase_init(const Params& p) {
  unsigned char* ws = p.ws;
  const int gt = get_bid() * NTHR + get_tid(), gs = gridDim.x * NTHR;
  {
    const int lane = get_tid() & 63, wave = get_tid() >> 6;
    const float* g = p.in[2];
    for (int row = get_bid() * 8 + wave; row < 2 * LT; row += gridDim.x * 8) {
      const int b = row / LT, t = row - b * LT;
      float4 v[4]; float ss = 0.f;
#pragma unroll
      for (int k = 0; k < 4; k++) {
        const int c4 = k * 256 + lane * 4;
        if (t < 112) v[k] = make_float4(0.f, 0.f, 0.f, 0.f);
        else if (t < 128) v[k] = *(const float4*)(p.in[1] + (size_t)(t - 112) * 1024 + c4);
        else v[k] = *(const float4*)(p.in[0] + ((size_t)b * 8192 + (t - 128)) * 1024 + c4);
        *(float4*)(hrow(p, b, t) + c4) = v[k];
        ss += v[k].x * v[k].x + v[k].y * v[k].y + v[k].z * v[k].z + v[k].w * v[k].w;
      }
#pragma unroll
      for (int o = 1; o < 64; o <<= 1) ss += shfl_xor_l(ss, o, lane);
      const float rs = rsqrtf(ss * (1.f / 1024.f) + 1e-6f);
      bf16_t* dst = (bf16_t*)(ws + OFF_HN) + (size_t)b * LT * 1024 + (size_t)t * 1024;
#pragma unroll
      for (int k = 0; k < 4; k++) {
        float4 gg = *(const float4*)(g + k * 256 + lane * 4);
        uint2 o; o.x = pack2(v[k].x * rs * gg.x, v[k].y * rs * gg.y); o.y = pack2(v[k].z * rs * gg.z, v[k].w * rs * gg.w);
        *(uint2*)(dst + k * 256 + lane * 4) = o;
      }
    }
  }
  float2* R128 = (float2*)(ws + OFF_R128);
  float2* R64 = (float2*)(ws + OFF_R64);
  for (int idx = gt; idx < LT * 96; idx += gs) {
    const int t = idx / 96, f = idx - t * 96;
    float inv;
    if (f < 64) inv = powf(10000.f, -(float)(2 * f) / 128.f);
    else inv = powf(10000.f, -(float)(2 * (f - 64)) / 64.f);
    const float ang = (float)(t - 112) * inv;
    const double ad = (double)ang;
    const double n = rint(ad * 0.15915494309189535);
    const float rr = (float)(ad - n * 6.283185307179586);
    float2 cs; cs.x = __cosf(rr); cs.y = __sinf(rr);
    if (f < 64) R128[(size_t)t * 64 + f] = cs; else R64[(size_t)t * 32 + (f - 64)] = cs;
  }
}

DEV void phase_norm(const Params& p, int b, const float* __restrict__ g, bf16_t* __restrict__ dst) {
  const int lane = get_tid() & 63, wave = get_tid() >> 6;
  for (int row = get_bid() * 8 + wave; row < LT; row += gridDim.x * 8) {
    const float* src = hrow(p, b, row);
    float4 v[4]; float ss = 0.f;
#pragma unroll
    for (int k = 0; k < 4; k++) { v[k] = *(const float4*)(src + k * 256 + lane * 4); ss += v[k].x * v[k].x + v[k].y * v[k].y + v[k].z * v[k].z + v[k].w * v[k].w; }
#pragma unroll
    for (int o = 1; o < 64; o <<= 1) ss += shfl_xor_l(ss, o, lane);
    const float rs = rsqrtf(ss * (1.f / 1024.f) + 1e-6f);
#pragma unroll
    for (int k = 0; k < 4; k++) {
      float4 gg = *(const float4*)(g + k * 256 + lane * 4);
      uint2 o; o.x = pack2(v[k].x * rs * gg.x, v[k].y * rs * gg.y); o.y = pack2(v[k].z * rs * gg.z, v[k].w * rs * gg.w);
      *(uint2*)(dst + (size_t)row * 1024 + k * 256 + lane * 4) = o;
    }
  }
}

DEV void phase_final(const Params& p) {
  const float* g = p.in[14];
  const int lane = get_tid() & 63, wave = get_tid() >> 6;
  for (int row = get_bid() * 8 + wave; row < 2 * 8192; row += gridDim.x * 8) {
    const float* src = p.out + (size_t)row * 1024;
    float4 v[4]; float ss = 0.f;
#pragma unroll
    for (int k = 0; k < 4; k++) { v[k] = *(const float4*)(src + k * 256 + lane * 4); ss += v[k].x * v[k].x + v[k].y * v[k].y + v[k].z * v[k].z + v[k].w * v[k].w; }
#pragma unroll
    for (int o = 1; o < 64; o <<= 1) ss += shfl_xor_l(ss, o, lane);
    const float rs = rsqrtf(ss * (1.f / 1024.f) + 1e-6f);
#pragma unroll
    for (int k = 0; k < 4; k++) {
      float4 gg = *(const float4*)(g + k * 256 + lane * 4);
      float4 o = make_float4(v[k].x * rs * gg.x, v[k].y * rs * gg.y, v[k].z * rs * gg.z, v[k].w * rs * gg.w);
      *(float4*)(p.out + (size_t)row * 1024 + k * 256 + lane * 4) = o;
    }
  }
}

DEV void tile_map(int it, int MT, int NG, int& mt, int& nt) {
  const int ng = it / (MT * NG), rem = it - ng * (MT * NG);
  mt = rem / NG; nt = ng * NG + (rem - mt * NG);
}
DEV int vblock() { const int b = get_bid(), G = (int)gridDim.x; return ((G & 7) == 0) ? (b & 7) * (G >> 3) + (b >> 3) : b; }

template <int NI>
DEV void projA_epiN(const Params& p, f32x4 (&acc)[NI][8], int seg, int cw, int trow0, int lr, int lg) {
  unsigned char* ws = p.ws;
  const float2* R128 = (const float2*)(ws + OFF_R128);
  const float2* R64 = (const float2*)(ws + OFF_R64);
  bf16_t* dstb; int ld;
  if (seg == 0) { dstb = (bf16_t*)(ws + OFF_RQ); ld = 512; }
  else if (seg == 3) { dstb = (bf16_t*)(ws + OFF_HQ); ld = 1024; }
  else if (seg == 6) { dstb = (bf16_t*)(ws + OFF_DQ); ld = 1024; }
  else { dstb = (bf16_t*)(ws + OFF_DK); ld = 1024; }
#pragma unroll
  for (int i = 0; i < NI; i++) {
    const int t = trow0 + i * 16 + lr;
    if (seg == 0) {
      const float2* tab = R128 + (size_t)t * 64;
#pragma unroll
      for (int j = 0; j < 4; j++)
#pragma unroll
        for (int r = 0; r < 4; r++) {
          float2 cs = tab[j * 16 + lg * 4 + r];
          float x1 = acc[i][j][r], x2 = acc[i][j + 4][r];
          acc[i][j][r] = x1 * cs.x - x2 * cs.y;
          acc[i][j + 4][r] = x2 * cs.x + x1 * cs.y;
        }
    } else if (seg == 6 || seg == 7) {
      const float2* tab = R64 + (size_t)t * 32;
      const float sc = (seg == 6) ? (0.125f * 1.4426950408889634f) : 1.f;
#pragma unroll
      for (int jq = 0; jq < 4; jq++) {
        const int j = (jq & 1) + (jq >> 1) * 4;
#pragma unroll
        for (int r = 0; r < 4; r++) {
          float2 cs = tab[(jq & 1) * 16 + lg * 4 + r];
          float x1 = acc[i][j][r], x2 = acc[i][j + 2][r];
          acc[i][j][r] = (x1 * cs.x - x2 * cs.y) * sc;
          acc[i][j + 2][r] = (x2 * cs.x + x1 * cs.y) * sc;
        }
      }
    }
    bf16_t* dst = dstb + (size_t)t * ld + cw;
#pragma unroll
    for (int j = 0; j < 8; j++) *(uint2*)(dst + j * 16 + lg * 4) = pack4(acc[i][j]);
    __builtin_amdgcn_sched_barrier(0);
  }
}

template <int NI>
DEV void projA_epiT(const Params& p, int layer, f32x4 (&acc)[NI][8], int seg, int cw, int trow0, int wn,
                    int mloc0, int lr, int lg, int tid, unsigned char* ldsraw) {
  unsigned char* ws = p.ws;
  const float2* R128 = (const float2*)(ws + OFF_R128);
  if (seg == 1) {
    bf16_t* RK = (bf16_t*)(ws + OFF_RK);
    bf16_t* RKT = (bf16_t*)(ws + OFF_RKT);
    const int h = cw >> 7;
    const float l2g = log2f(1.f - ex2(-5.f - (float)h));
#pragma unroll
    for (int i = 0; i < NI; i++) {
      const int tb = trow0 + i * 16 + lg * 4;
#pragma unroll
      for (int j = 0; j < 4; j++)
#pragma unroll
        for (int r = 0; r < 4; r++) {
          const int t = tb + r;
          float2 cs = R128[(size_t)t * 64 + j * 16 + lr];
          const float sc = (t >= 112) ? 0.08838834764831845f : 0.f;
          float x1 = acc[i][j][r], x2 = acc[i][j + 4][r];
          acc[i][j][r] = (x1 * cs.x - x2 * cs.y) * sc;
          acc[i][j + 4][r] = (x2 * cs.x + x1 * cs.y) * sc;
        }
#pragma unroll
      for (int j = 0; j < 8; j++) {
        const int col = cw + j * 16 + lr;
        f32x4 kd;
#pragma unroll
        for (int r = 0; r < 4; r++) {
          const int t = tb + r;
          RK[(size_t)t * 512 + col] = f2bf(acc[i][j][r]);
          kd[r] = acc[i][j][r] * ex2(l2g * (float)(127 - (t & 127)));
        }
        *(uint2*)(RKT + (size_t)col * LT + tb) = pack4(kd);
      }
      __builtin_amdgcn_sched_barrier(0);
    }
  } else if (seg == 2 || seg == 5 || seg == 8) {
    bf16_t* dT = (bf16_t*)(ws + (seg == 2 ? OFF_RVT : (seg == 5 ? OFF_HVT : OFF_DVT)));
#pragma unroll
    for (int i = 0; i < NI; i++) {
      const int tb = trow0 + i * 16 + lg * 4;
#pragma unroll
      for (int j = 0; j < 8; j++) {
        const int col = cw + j * 16 + lr;
        f32x4 v = acc[i][j];
        if (seg == 5) {
#pragma unroll
          for (int r = 0; r < 4; r++) if (tb + r < 112) v[r] = 0.f;
        }
        *(uint2*)(dT + (size_t)col * LT + tb) = pack4(v);
      }
      __builtin_amdgcn_sched_barrier(0);
    }
  } else if constexpr (NI == 2) {
    float* Lf = (float*)ldsraw;
    float* HCB = (float*)(ws + OFF_HCB);
    bf16_t* HK = (bf16_t*)(ws + OFF_HK);
    bf16_t* HKET = (bf16_t*)(ws + OFF_HKET);
    float* HDEC = (float*)(ws + OFF_HDEC);
    const float* lbp = p.in[6];
#pragma unroll
    for (int j = 0; j < 8; j++) {
      const int col = cw + j * 16 + lr;
      float lb = 0.f;
      if (layer == 1) lb = 1.f / (1.f + __expf(lbp[col] - lbp[1024 + col]));
#pragma unroll
      for (int i = 0; i < 2; i++)
#pragma unroll
        for (int r = 0; r < 4; r++) {
          const int m = mloc0 + i * 16 + lg * 4 + r;
          const float z = acc[i][j][r];
          const float kk = (1.f - lb) / (1.f + __expf(z));
          const float lf = fmaxf(log1pf(-kk), -69.0776f);
          acc[i][j][r] = kk;
          Lf[m * 260 + wn * 128 + j * 16 + lr] = lf;
        }
    }
    __syncthreads();
    {
      const int colL = tid & 255, half = tid >> 8;
      float run = 0.f;
      for (int rr = 0; rr < 64; rr++) {
        float* q = &Lf[(half * 64 + rr) * 260 + colL];
        run += *q; *q = run;
      }
    }
    __syncthreads();
#pragma unroll
    for (int j = 0; j < 8; j++) {
      const int colL = wn * 128 + j * 16 + lr;
      const int col = cw + j * 16 + lr;
      const float ft = Lf[63 * 260 + colL];
      const float cend = Lf[127 * 260 + colL] + ft;
#pragma unroll
      for (int i = 0; i < 2; i++) {
        const int mb = mloc0 + i * 16 + lg * 4;
        const int tb = trow0 + i * 16 + lg * 4;
        f32x4 ke;
#pragma unroll
        for (int r = 0; r < 4; r++) {
          const int m = mb + r;
          const int t = tb + r;
          const float cb = Lf[m * 260 + colL] + (m >= 64 ? ft : 0.f);
          HCB[(size_t)t * 1024 + col] = cb;
          HK[(size_t)t * 1024 + col] = f2bf(acc[i][j][r]);
          ke[r] = acc[i][j][r] * __expf(cend - cb);
          if (m == 127) HDEC[(t >> 7) * 1024 + col] = __expf(cend);
        }
        *(uint2*)(HKET + (size_t)col * LT + tb) = pack4(ke);
      }
    }
    __syncthreads();
  }
}

DEV void projA_seg(int nt, int& n0, int& seg, int& segstart) {
  if (nt < 8) { n0 = nt * 256; seg = nt < 2 ? 0 : (nt < 4 ? 1 : 2); segstart = seg == 0 ? 0 : (seg == 1 ? 512 : 1024); }
  else if (nt < 20) { n0 = 3072 + (nt - 8) * 256; seg = 3 + (nt - 8) / 4; segstart = 3072 + (seg - 3) * 1024; }
  else { n0 = 7168 + (nt - 20) * 256; seg = 6 + (nt - 20) / 4; segstart = 7168 + (seg - 6) * 1024; }
}

DEV void phase_projA(const Params& p, int layer, int b, unsigned char* ldsraw) {
  unsigned char* ws = p.ws;
  bf16_t* lds = (bf16_t*)ldsraw;
  const bf16_t* HN = (const bf16_t*)(ws + OFF_HN) + (size_t)b * LT * 1024;
  const bf16_t* WIN = (const bf16_t*)(ws + OFF_WIN);
  const int G = (int)gridDim.x, vb = vblock();
  for (int item = vb; item < 32 * 28; item += G) {
    int ntb, mt; tile_map(item, 32, 4, mt, ntb);
    const int nt = ntb < 12 ? ntb : ntb + 4;
    int n0, seg, segstart; projA_seg(nt, n0, seg, segstart);
    const int row0 = 128 + mt * 256;
    const bf16_t* A = HN + (size_t)row0 * 1024;
    const bf16_t* Bt = WIN + (size_t)n0 * 1024;
    f32x4 acc[4][8];
#pragma unroll
    for (int i = 0; i < 4; i++)
#pragma unroll
      for (int j = 0; j < 8; j++) acc[i][j] = (f32x4){0.f, 0.f, 0.f, 0.f};
    if (seg == 0 || seg == 3 || seg == 6 || seg == 7) {
      gemm256_acc<256, false>(acc, A, 1024, 256, Bt, 1024, 1024, lds);
      const int tid = get_tid(), lane = tid & 63, wave = tid >> 6, wm = wave >> 1, wn = wave & 1; const int lr = lane & 15, lg = lane >> 4;
      projA_epiN<4>(p, acc, seg, (n0 - segstart) + wn * 128, row0 + wm * 64, lr, lg);
    } else {
      gemm256_acc<256, true>(acc, A, 1024, 256, Bt, 1024, 1024, lds);
      const int tid = get_tid(), lane = tid & 63, wave = tid >> 6, wm = wave >> 1, wn = wave & 1; const int lr = lane & 15, lg = lane >> 4;
      projA_epiT<4>(p, layer, acc, seg, (n0 - segstart) + wn * 128, row0 + wm * 64, wn, (wm & 1) * 64, lr, lg, tid, ldsraw);
    }
  }
  for (int s = (vb + G / 2) % G; s < 288; s += G) {
    int nt, mt;
    if (s < 28) { mt = 0; nt = s < 12 ? s : s + 4; }
    else { const int q = s - 28; mt = q >> 2; nt = 12 + (q & 3); }
    int n0, seg, segstart; projA_seg(nt, n0, seg, segstart);
    const bf16_t* A = HN + (size_t)mt * 128 * 1024;
    const bf16_t* Bt = WIN + (size_t)n0 * 1024;
    f32x4 acc[2][8];
#pragma unroll
    for (int i = 0; i < 2; i++)
#pragma unroll
      for (int j = 0; j < 8; j++) acc[i][j] = (f32x4){0.f, 0.f, 0.f, 0.f};
    if (seg == 0 || seg == 3 || seg == 6 || seg == 7) {
      gemm_acc<256, false>(acc, A, 1024, Bt, 1024, 1024, lds);
      const int tid = get_tid(), lane = tid & 63, wave = tid >> 6, wm = wave >> 1, wn = wave & 1; const int lr = lane & 15, lg = lane >> 4;
      projA_epiN<2>(p, acc, seg, (n0 - segstart) + wn * 128, mt * 128 + wm * 32, lr, lg);
    } else {
      gemm_acc<256, true>(acc, A, 1024, Bt, 1024, 1024, lds);
      const int tid = get_tid(), lane = tid & 63, wave = tid >> 6, wm = wave >> 1, wn = wave & 1; const int lr = lane & 15, lg = lane >> 4;
      projA_epiT<2>(p, layer, acc, seg, (n0 - segstart) + wn * 128, mt * 128 + wm * 32, wn, wm * 32, lr, lg, tid, ldsraw);
    }
  }
}

DEV void phase_U(const Params& p, unsigned char* ldsraw) {
  unsigned char* ws = p.ws;
  bf16_t* lds = (bf16_t*)ldsraw;
  for (int item = get_bid(); item < 1040; item += gridDim.x) {
    const bf16_t *A, *Bt; bf16_t* dst;
    if (item < 520) {
      const int h = item & 3, rest = item >> 2, mh = rest & 1, c = rest >> 1;
      A = (const bf16_t*)(ws + OFF_RVT) + (size_t)(h * 256 + mh * 128) * LT + c * 128;
      Bt = (const bf16_t*)(ws + OFF_RKT) + (size_t)(h * 128) * LT + c * 128;
      dst = (bf16_t*)(ws + OFF_STR) + ((size_t)(h * 65 + c) * 256 + mh * 128) * 128;
    } else {
      const int it = item - 520, h = it & 7, c = it >> 3;
      A = (const bf16_t*)(ws + OFF_HVT) + (size_t)(h * 128) * LT + c * 128;
      Bt = (const bf16_t*)(ws + OFF_HKET) + (size_t)(h * 128) * LT + c * 128;
      dst = (bf16_t*)(ws + OFF_STH) + ((size_t)(h * 65 + c) * 128) * 128;
    }
    f32x4 acc[2][4];
#pragma unroll
    for (int i = 0; i < 2; i++)
#pragma unroll
      for (int j = 0; j < 4; j++) acc[i][j] = (f32x4){0.f, 0.f, 0.f, 0.f};
    gemm_acc<128, false>(acc, A, LT, Bt, LT, 128, lds);
      const int tid = get_tid(), lane = tid & 63, wave = tid >> 6, wm = wave >> 1, wn = wave & 1; const int lr = lane & 15, lg = lane >> 4; (void)tid; (void)lane; (void)wm; (void)wn; (void)lr; (void)lg;
#pragma unroll
    for (int i = 0; i < 2; i++)
#pragma unroll
      for (int j = 0; j < 4; j++)
        *(uint2*)(dst + (size_t)(wm * 32 + i * 16 + lr) * 128 + wn * 64 + j * 16 + lg * 4) = pack4(acc[i][j]);
  }
}

DEV void phase_scan(const Params& p) {
  unsigned char* ws = p.ws;
  const float* HDEC = (const float*)(ws + OFF_HDEC);
  for (int task = get_bid() * NTHR + get_tid(); task < 65536; task += gridDim.x * NTHR) {
    bf16_t* base; size_t stride; int h, d4; bool hg;
    float dec0 = 0.f;
    if (task < 32768) {
      const int v = task; d4 = (v & 31) * 4; const int e = (v >> 5) & 255; h = v >> 13; hg = false;
      base = (bf16_t*)(ws + OFF_STR) + ((size_t)(h * 65) * 256 + e) * 128 + d4; stride = 256 * 128;
      dec0 = ex2(128.f * log2f(1.f - ex2(-5.f - (float)h)));
    } else {
      const int v = task - 32768; d4 = (v & 31) * 4; const int e = (v >> 5) & 127; h = v >> 12; hg = true;
      base = (bf16_t*)(ws + OFF_STH) + ((size_t)(h * 65) * 128 + e) * 128 + d4; stride = 128 * 128;
    }
    float c0 = 0.f, c1 = 0.f, c2 = 0.f, c3 = 0.f;
    for (int cg0 = 0; cg0 < 65; cg0 += 13) {
      uint2 u[13]; float4 dc[13];
#pragma unroll
      for (int k = 0; k < 13; k++) {
        u[k] = *(const uint2*)(base + (size_t)(cg0 + k) * stride);
        if (hg) dc[k] = *(const float4*)(HDEC + (size_t)(cg0 + k) * 1024 + h * 128 + d4);
        else dc[k] = make_float4(dec0, dec0, dec0, dec0);
      }
#pragma unroll
      for (int k = 0; k < 13; k++) {
        uint2 o; o.x = pack2(c0, c1); o.y = pack2(c2, c3);
        *(uint2*)(base + (size_t)(cg0 + k) * stride) = o;
        c0 = dc[k].x * c0 + bf2f((bf16_t)(u[k].x & 0xffff));
        c1 = dc[k].y * c1 + bf2f((bf16_t)(u[k].x >> 16));
        c2 = dc[k].z * c2 + bf2f((bf16_t)(u[k].y & 0xffff));
        c3 = dc[k].w * c3 + bf2f((bf16_t)(u[k].y >> 16));
      }
    }
  }
}

DEV void attn_item(const Params& p, int layer, int h, int qb, float lam, bf16_t* lds) {
  unsigned char* ws = p.ws;
  const bf16_t* DQ = (const bf16_t*)(ws + OFF_DQ);
  bf16_t* ODA = (bf16_t*)(ws + OFF_ODA);
  const bf16_t* DK = (const bf16_t*)(ws + OFF_DK);
  const bf16_t* DVT = (const bf16_t*)(ws + OFF_DVT);
  constexpr int PS = 136, XS = 132;
  constexpr int TS = 128 * PS;
  bf16_t* KV = lds;
  float* X = (float*)lds;
  const int tid = get_tid(), lane = tid & 63, wave = tid >> 6;
  const int lr = lane & 15, lg = lane >> 4;
  const int grp = wave >> 2, wq = wave & 3;
  const int t0 = qb * 128;
  const int lrow = tid >> 4, lc8 = (tid & 15) * 8;
  const bf16_t* gq = DQ + (size_t)(t0 + wq * 32 + lr) * 1024 + h * 128 + grp * 64 + lg * 8;
  const bf16x8 a00 = *(const bf16x8*)(gq);
  const bf16x8 a01 = *(const bf16x8*)(gq + 32);
  const bf16x8 a10 = *(const bf16x8*)(gq + (size_t)16 * 1024);
  const bf16x8 a11 = *(const bf16x8*)(gq + (size_t)16 * 1024 + 32);
  f32x4 o[2][8];
#pragma unroll
  for (int i = 0; i < 2; i++)
#pragma unroll
    for (int j = 0; j < 8; j++) o[i][j] = (f32x4){0.f, 0.f, 0.f, 0.f};
  float mrun0 = -1e30f, mrun1 = -1e30f, lrun0 = 0.f, lrun1 = 0.f;
  u32x4 rk0, rk1, rk2, rk3, rv0, rv1, rv2, rv3;
  const unsigned ko = (unsigned)(lrow * 1024 + h * 128 + lc8);
  const unsigned vo = (unsigned)((h * 128 + lrow) * LT + lc8);
#define ALOAD(kbn)                                                              \
  rk0 = *(const u32x4*)(DK + (ko + (unsigned)(kbn) * 131072u));                 \
  rk1 = *(const u32x4*)(DK + (ko + (unsigned)(kbn) * 131072u + 32768u));        \
  rk2 = *(const u32x4*)(DK + (ko + (unsigned)(kbn) * 131072u + 65536u));        \
  rk3 = *(const u32x4*)(DK + (ko + (unsigned)(kbn) * 131072u + 98304u));        \
  rv0 = *(const u32x4*)(DVT + (vo + (unsigned)(kbn) * 128u));                   \
  rv1 = *(const u32x4*)(DVT + (vo + (unsigned)(kbn) * 128u + 32u * LT));        \
  rv2 = *(const u32x4*)(DVT + (vo + (unsigned)(kbn) * 128u + 64u * LT));        \
  rv3 = *(const u32x4*)(DVT + (vo + (unsigned)(kbn) * 128u + 96u * LT));
#define ASTORE(sp)                                                              \
  *(u32x4*)((sp)) = rk0;                                                        \
  *(u32x4*)((sp) + 32 * PS) = rk1;                                              \
  *(u32x4*)((sp) + 64 * PS) = rk2;                                              \
  *(u32x4*)((sp) + 96 * PS) = rk3;                                              \
  *(u32x4*)((sp) + 2 * TS) = rv0;                                               \
  *(u32x4*)((sp) + 2 * TS + 32 * PS) = rv1;                                     \
  *(u32x4*)((sp) + 2 * TS + 64 * PS) = rv2;                                     \
  *(u32x4*)((sp) + 2 * TS + 96 * PS) = rv3;
  ALOAD(0)
  const int qrow0 = t0 + wq * 32 + lr;
  __syncthreads();
  ASTORE(KV + lrow * PS + lc8)
  {
    const int kb1 = qb > 0 ? 1 : 0;
    ALOAD(kb1)
  }
  __syncthreads();
  for (int kb = 0; kb <= qb; kb++) {
    const int cur = kb & 1;
    const bf16_t* kp = KV + cur * TS + lr * PS + grp * 64 + lg * 8;
    const bf16_t* vq = KV + 2 * TS + cur * TS + lr * PS + lg * 4;
    {
      bf16_t* sp = KV + (cur ^ 1) * TS + lrow * PS + lc8;
      ASTORE(sp)
    }
    __builtin_amdgcn_sched_barrier(0);
    f32x4 s[2][8];
    {
#pragma unroll
      for (int j = 0; j < 8; j++) {
        const bf16x8 kf0 = *(const bf16x8*)(kp + j * 16 * PS);
        const bf16x8 kf1 = *(const bf16x8*)(kp + j * 16 * PS + 32);
        s[0][j] = MFMA(kf0, a00, ((f32x4){0.f, 0.f, 0.f, 0.f}));
        s[1][j] = MFMA(kf0, a10, ((f32x4){0.f, 0.f, 0.f, 0.f}));
        s[0][j] = MFMA(kf1, a01, s[0][j]);
        s[1][j] = MFMA(kf1, a11, s[1][j]);
      }
    }
    __builtin_amdgcn_sched_barrier(0);
    {
      const int kbn = (kb + 2 <= qb) ? kb + 2 : qb;
      ALOAD(kbn)
    }
    __builtin_amdgcn_sched_barrier(0);
    if (kb == qb || kb == 0) {
#pragma unroll
      for (int i = 0; i < 2; i++)
#pragma unroll
        for (int j = 0; j < 8; j++)
#pragma unroll
          for (int r = 0; r < 4; r++) {
            const int key = kb * 128 + j * 16 + lg * 4 + r;
            if (key > qrow0 + 16 * i || key < 112) s[i][j][r] = -1e30f;
          }
    }
    float al[2];
#pragma unroll
    for (int i = 0; i < 2; i++) {
      float mx = -1e30f;
#pragma unroll
      for (int j = 0; j < 8; j++)
#pragma unroll
        for (int r = 0; r < 4; r++) mx = fmaxf(mx, s[i][j][r]);
      mx = fmaxf(mx, shfl_xor_l(mx, 16, lane));
      mx = fmaxf(mx, shfl_xor_l(mx, 32, lane));
      const float mold = i == 0 ? mrun0 : mrun1;
      const float mnew = (mx > mold + 8.f) ? mx : mold;
      al[i] = ex2(mold - mnew);
      float ps = 0.f;
#pragma unroll
      for (int j = 0; j < 8; j++)
#pragma unroll
        for (int r = 0; r < 4; r++) { const float pv = ex2(s[i][j][r] - mnew); s[i][j][r] = pv; ps += pv; }
      if (i == 0) { mrun0 = mnew; lrun0 = lrun0 * al[0] + ps; } else { mrun1 = mnew; lrun1 = lrun1 * al[1] + ps; }
    }
    if (__builtin_amdgcn_ballot_w64(al[0] != 1.f || al[1] != 1.f) != 0ull) {
#pragma unroll
      for (int i = 0; i < 2; i++) {
        float ao[4];
#pragma unroll
        for (int r = 0; r < 4; r++) ao[r] = shfl_l(al[i], lg * 4 + r);
#pragma unroll
        for (int je = 0; je < 8; je++)
#pragma unroll
          for (int r = 0; r < 4; r++) o[i][je][r] *= ao[r];
      }
    }
#pragma unroll
    for (int ks = 0; ks < 4; ks++) {
      union { u32x4 u; bf16x8 v; } pf0, pf1;
      pf0.u[0] = pack2(s[0][2 * ks][0], s[0][2 * ks][1]);
      pf0.u[1] = pack2(s[0][2 * ks][2], s[0][2 * ks][3]);
      pf0.u[2] = pack2(s[0][2 * ks + 1][0], s[0][2 * ks + 1][1]);
      pf0.u[3] = pack2(s[0][2 * ks + 1][2], s[0][2 * ks + 1][3]);
      pf1.u[0] = pack2(s[1][2 * ks][0], s[1][2 * ks][1]);
      pf1.u[1] = pack2(s[1][2 * ks][2], s[1][2 * ks][3]);
      pf1.u[2] = pack2(s[1][2 * ks + 1][0], s[1][2 * ks + 1][1]);
      pf1.u[3] = pack2(s[1][2 * ks + 1][2], s[1][2 * ks + 1][3]);
#pragma unroll
      for (int je = 0; je < 8; je++) {
        const bf16_t* vp = vq + je * 16 * PS + ks * 32;
        union { uint2 u[2]; bf16x8 v; } vf;
        vf.u[0] = *(const uint2*)vp;
        vf.u[1] = *(const uint2*)(vp + 16);
        o[0][je] = MFMA(pf0.v, vf.v, o[0][je]);
        o[1][je] = MFMA(pf1.v, vf.v, o[1][je]);
      }
    }
    __builtin_amdgcn_sched_barrier(0);
    __syncthreads();
  }
#undef ASTORE
#undef ALOAD
#pragma unroll
  for (int i = 0; i < 2; i++) {
    float l = i == 0 ? lrun0 : lrun1;
    l += shfl_xor_l(l, 16, lane);
    l += shfl_xor_l(l, 32, lane);
    const float inv = l > 0.f ? 1.f / l : 0.f;
#pragma unroll
    for (int r = 0; r < 4; r++) {
      const float ir = shfl_l(inv, lg * 4 + r);
#pragma unroll
      for (int je = 0; je < 8; je++) o[i][je][r] *= ir;
    }
  }
  __syncthreads();
  if (grp == 1) {
#pragma unroll
    for (int i = 0; i < 2; i++)
#pragma unroll
      for (int je = 0; je < 8; je++)
#pragma unroll
        for (int r = 0; r < 4; r++) X[(wq * 32 + i * 16 + lg * 4 + r) * XS + je * 16 + lr] = o[i][je][r];
  }
  __syncthreads();
  if (grp == 0) {
    int ly = layer; asm volatile("" : "+s"(ly));
    const float li = (ly == 0) ? 0.2f : 0.35550906759f;
    const float* sg = p.in[8] + ly * 128;
#pragma unroll
    for (int i = 0; i < 2; i++) {
      float ss[4] = {0.f, 0.f, 0.f, 0.f};
#pragma unroll
      for (int je = 0; je < 8; je++)
#pragma unroll
        for (int r = 0; r < 4; r++) {
          const float v = o[i][je][r] - lam * X[(wq * 32 + i * 16 + lg * 4 + r) * XS + je * 16 + lr];
          o[i][je][r] = v; ss[r] += v * v;
        }
#pragma unroll
      for (int r = 0; r < 4; r++) {
        float s2 = ss[r];
        s2 += shfl_xor_l(s2, 1, lane); s2 += shfl_xor_l(s2, 2, lane); s2 += shfl_xor_l(s2, 4, lane); s2 += shfl_xor_l(s2, 8, lane);
        ss[r] = rsqrtf(s2 * (1.f / 128.f) + 1e-6f) * (1.f - li);
      }
#pragma unroll
      for (int je = 0; je < 8; je++) {
        const float g = sg[je * 16 + lr];
#pragma unroll
        for (int r = 0; r < 4; r++)
          ODA[(size_t)(t0 + wq * 32 + i * 16 + lg * 4 + r) * 1024 + h * 128 + je * 16 + lr] = f2bf(o[i][je][r] * ss[r] * g);
      }
    }
  }
}

DEV void ret_item(const Params& p, int h, int c, bf16_t* lds) {
  unsigned char* ws = p.ws;
  const bf16_t* RQ = (const bf16_t*)(ws + OFF_RQ);
  const bf16_t* RK = (const bf16_t*)(ws + OFF_RK);
  const bf16_t* RVT = (const bf16_t*)(ws + OFF_RVT);
  const bf16_t* STR = (const bf16_t*)(ws + OFF_STR);
  bf16_t* ORET = (bf16_t*)(ws + OFF_ORET);
  constexpr int PS = 136;
  bf16_t* Qs = lds;
  bf16_t* Ks = lds + 128 * PS;
  bf16_t* Big = lds + 2 * 128 * PS;
  float* RED = (float*)(lds + 2 * 128 * PS + 256 * PS);
  const int tid = get_tid(), lane = tid & 63, wave = tid >> 6, wm = wave >> 1, wn = wave & 1;
  const int lr = lane & 15, lg = lane >> 4;
  const int t0 = c * 128;
  const int lrow = tid >> 4, lc8 = (tid & 15) * 8;
  const float l2g = log2f(1.f - ex2(-5.f - (float)h));
#pragma unroll
  for (int i = 0; i < 4; i++) {
    const int row = lrow + i * 32;
    *(uint4*)(Qs + row * PS + lc8) = *(const uint4*)(RQ + (size_t)(t0 + row) * 512 + h * 128 + lc8);
    *(uint4*)(Ks + row * PS + lc8) = *(const uint4*)(RK + (size_t)(t0 + row) * 512 + h * 128 + lc8);
  }
#pragma unroll
  for (int i = 0; i < 8; i++) {
    const int row = lrow + i * 32;
    *(uint4*)(Big + row * PS + lc8) = *(const uint4*)(STR + ((size_t)(h * 65 + c) * 256 + row) * 128 + lc8);
  }
  __syncthreads();
  f32x4 s[2][4];
  f32x4 o[2][8];
#pragma unroll
  for (int i = 0; i < 2; i++) {
#pragma unroll
    for (int j = 0; j < 4; j++) s[i][j] = (f32x4){0.f, 0.f, 0.f, 0.f};
#pragma unroll
    for (int j = 0; j < 8; j++) o[i][j] = (f32x4){0.f, 0.f, 0.f, 0.f};
  }
#pragma unroll
  for (int ks = 0; ks < 4; ks++) {
    bf16x8 a0 = ldfrag(Qs, PS, wm * 32 + lr, ks * 32 + lg * 8);
    bf16x8 a1 = ldfrag(Qs, PS, wm * 32 + 16 + lr, ks * 32 + lg * 8);
#pragma unroll
    for (int j = 0; j < 4; j++) {
      bf16x8 bb = ldfrag(Ks, PS, wn * 64 + j * 16 + lr, ks * 32 + lg * 8);
      s[0][j] = MFMA(bb, a0, s[0][j]);
      s[1][j] = MFMA(bb, a1, s[1][j]);
    }
#pragma unroll
    for (int j = 0; j < 8; j++) {
      bf16x8 bb = ldfrag(Big, PS, wn * 128 + j * 16 + lr, ks * 32 + lg * 8);
      o[0][j] = MFMA(bb, a0, o[0][j]);
      o[1][j] = MFMA(bb, a1, o[1][j]);
    }
    __builtin_amdgcn_sched_barrier(0);
  }
#pragma unroll
  for (int i = 0; i < 2; i++) {
    const int q = wm * 32 + i * 16 + lr;
    const float qd = ex2(l2g * (float)(q + 1));
#pragma unroll
    for (int j = 0; j < 8; j++)
#pragma unroll
      for (int r = 0; r < 4; r++) o[i][j][r] *= qd;
  }
  __syncthreads();
#pragma unroll
  for (int i = 0; i < 2; i++) {
    const int q = wm * 32 + i * 16 + lr;
#pragma unroll
    for (int j = 0; j < 4; j++) {
      f32x4 v;
#pragma unroll
      for (int r = 0; r < 4; r++) {
        const int key = wn * 64 + j * 16 + lg * 4 + r;
        v[r] = (key <= q) ? s[i][j][r] * ex2(l2g * (float)(q - key)) : 0.f;
      }
      *(uint2*)(Ks + q * PS + wn * 64 + j * 16 + lg * 4) = pack4(v);
    }
  }
#pragma unroll
  for (int i = 0; i < 8; i++) {
    const int row = lrow + i * 32;
    *(uint4*)(Big + row * PS + lc8) = *(const uint4*)(RVT + (size_t)(h * 256 + row) * LT + t0 + lc8);
  }
  __syncthreads();
#pragma unroll
  for (int ks = 0; ks < 4; ks++) {
    bf16x8 a0 = ldfrag(Ks, PS, wm * 32 + lr, ks * 32 + lg * 8);
    bf16x8 a1 = ldfrag(Ks, PS, wm * 32 + 16 + lr, ks * 32 + lg * 8);
#pragma unroll
    for (int j = 0; j < 8; j++) {
      bf16x8 bb = ldfrag(Big, PS, wn * 128 + j * 16 + lr, ks * 32 + lg * 8);
      o[0][j] = MFMA(bb, a0, o[0][j]);
      o[1][j] = MFMA(bb, a1, o[1][j]);
    }
    __builtin_amdgcn_sched_barrier(0);
  }
#pragma unroll
  for (int i = 0; i < 2; i++) {
    float ss = 0.f;
#pragma unroll
    for (int j = 0; j < 8; j++)
#pragma unroll
      for (int r = 0; r < 4; r++) ss += o[i][j][r] * o[i][j][r];
    ss += shfl_xor_l(ss, 16, lane);
    ss += shfl_xor_l(ss, 32, lane);
    if (lg == 0) RED[(wm * 32 + i * 16 + lr) * 2 + wn] = ss;
  }
  __syncthreads();
#pragma unroll
  for (int i = 0; i < 2; i++) {
    const int q = wm * 32 + i * 16 + lr;
    const float rs = rsqrtf((RED[q * 2] + RED[q * 2 + 1]) * (1.f / 256.f) + 1e-6f);
#pragma unroll
    for (int j = 0; j < 8; j++) {
      f32x4 v = o[i][j];
#pragma unroll
      for (int r = 0; r < 4; r++) v[r] *= rs;
      *(uint2*)(ORET + (size_t)(t0 + q) * 1024 + h * 256 + wn * 128 + j * 16 + lg * 4) = pack4(v);
    }
  }
}

DEV u32x4 scale8(u32x4 raw, f32x4 ea, f32x4 eb) {
  u32x4 o;
  o[0] = pack2(bf2f((bf16_t)(raw[0] & 0xffff)) * __expf(ea[0]), bf2f((bf16_t)(raw[0] >> 16)) * __expf(ea[1]));
  o[1] = pack2(bf2f((bf16_t)(raw[1] & 0xffff)) * __expf(ea[2]), bf2f((bf16_t)(raw[1] >> 16)) * __expf(ea[3]));
  o[2] = pack2(bf2f((bf16_t)(raw[2] & 0xffff)) * __expf(eb[0]), bf2f((bf16_t)(raw[2] >> 16)) * __expf(eb[1]));
  o[3] = pack2(bf2f((bf16_t)(raw[3] & 0xffff)) * __expf(eb[2]), bf2f((bf16_t)(raw[3] >> 16)) * __expf(eb[3]));
  return o;
}
DEV f32x4 min80(f32x4 v) { return (f32x4){fminf(v[0], 80.f), fminf(v[1], 80.f), fminf(v[2], 80.f), fminf(v[3], 80.f)}; }

DEV void hg_item(const Params& p, int h, int c, bf16_t* lds) {
  unsigned char* ws = p.ws;
  const bf16_t* HQ = (const bf16_t*)(ws + OFF_HQ);
  const bf16_t* HK = (const bf16_t*)(ws + OFF_HK);
  const float* HCB = (const float*)(ws + OFF_HCB);
  const bf16_t* HVT = (const bf16_t*)(ws + OFF_HVT);
  const bf16_t* STH = (const bf16_t*)(ws + OFF_STH);
  bf16_t* OHG = (bf16_t*)(ws + OFF_OHG);
  constexpr int PS = 136;
  bf16_t* Qp = lds;
  bf16_t* Kp = lds + 128 * PS;
  bf16_t* As = lds + 2 * 128 * PS;
  float* RED = (float*)(lds + 2 * 128 * PS + 256 * PS);
  const int tid = get_tid(), lane = tid & 63, wave = tid >> 6, wm = wave >> 1, wn = wave & 1;
  const int lr = lane & 15, lg = lane >> 4;
  const int t0 = c * 128, colb = h * 128;
  const int lrow = tid >> 4, lc8 = (tid & 15) * 8;
  u32x4 qv[4], kv[4], vv[4], sv[4];
  f32x4 ca[4], cb2[4], ra[3], rb[3];
#pragma unroll
  for (int i = 0; i < 4; i++) {
    const int row = lrow + i * 32;
    const size_t g = (size_t)(t0 + row) * 1024 + colb + lc8;
    qv[i] = *(const u32x4*)(HQ + g);
    kv[i] = *(const u32x4*)(HK + g);
    ca[i] = *(const f32x4*)(HCB + g);
    cb2[i] = *(const f32x4*)(HCB + g + 4);
    vv[i] = *(const u32x4*)(HVT + (size_t)(colb + row) * LT + t0 + lc8);
    sv[i] = *(const u32x4*)(STH + ((size_t)(h * 65 + c) * 128 + row) * 128 + lc8);
  }
#pragma unroll
  for (int I = 1; I < 4; I++) {
    const size_t gr = (size_t)(t0 + 32 * I - 1) * 1024 + colb + lc8;
    ra[I - 1] = *(const f32x4*)(HCB + gr);
    rb[I - 1] = *(const f32x4*)(HCB + gr + 4);
  }
  const f32x4 z4 = (f32x4){0.f, 0.f, 0.f, 0.f};
#pragma unroll
  for (int i = 0; i < 4; i++) {
    const f32x4 fa = i == 0 ? z4 : ra[i == 0 ? 0 : i - 1], fb = i == 0 ? z4 : rb[i == 0 ? 0 : i - 1];
    *(u32x4*)(Qp + (lrow + i * 32) * PS + lc8) = scale8(qv[i], ca[i] - fa, cb2[i] - fb);
  }
#pragma unroll
  for (int I = 0; I < 4; I++) {
    const int nrows = 32 * (I + 1);
    const f32x4 fa = I == 0 ? z4 : ra[I == 0 ? 0 : I - 1], fb = I == 0 ? z4 : rb[I == 0 ? 0 : I - 1];
#pragma unroll
    for (int i = 0; i < 4; i++) {
      if (i <= I) *(u32x4*)(Kp + (lrow + i * 32) * PS + lc8) = scale8(kv[i], min80(fa - ca[i]), min80(fb - cb2[i]));
    }
    __syncthreads();
    if (wave * 16 < nrows) {
      f32x4 a2[2];
      a2[0] = (f32x4){0.f, 0.f, 0.f, 0.f}; a2[1] = a2[0];
#pragma unroll
      for (int ks = 0; ks < 4; ks++) {
        bf16x8 bb = ldfrag(Kp, PS, wave * 16 + lr, ks * 32 + lg * 8);
        bf16x8 a0 = ldfrag(Qp, PS, 32 * I + lr, ks * 32 + lg * 8);
        bf16x8 a1 = ldfrag(Qp, PS, 32 * I + 16 + lr, ks * 32 + lg * 8);
        a2[0] = MFMA(bb, a0, a2[0]);
        a2[1] = MFMA(bb, a1, a2[1]);
      }
#pragma unroll
      for (int i = 0; i < 2; i++) {
        const int q = 32 * I + i * 16 + lr;
        f32x4 v;
#pragma unroll
        for (int r = 0; r < 4; r++) { const int key = wave * 16 + lg * 4 + r; v[r] = (key <= q) ? a2[i][r] : 0.f; }
        *(uint2*)(As + q * PS + wave * 16 + lg * 4) = pack4(v);
      }
    } else {
#pragma unroll
      for (int i = 0; i < 2; i++) {
        const int q = 32 * I + i * 16 + lr;
        *(uint2*)(As + q * PS + wave * 16 + lg * 4) = make_uint2(0u, 0u);
      }
    }
    __syncthreads();
  }
#pragma unroll
  for (int i = 0; i < 4; i++) *(u32x4*)(Kp + (lrow + i * 32) * PS + lc8) = vv[i];
  __syncthreads();
  f32x4 o[2][4];
#pragma unroll
  for (int i = 0; i < 2; i++)
#pragma unroll
    for (int j = 0; j < 4; j++) o[i][j] = (f32x4){0.f, 0.f, 0.f, 0.f};
#pragma unroll
  for (int ks = 0; ks < 4; ks++) {
    bf16x8 a0 = ldfrag(As, PS, wm * 32 + lr, ks * 32 + lg * 8);
    bf16x8 a1 = ldfrag(As, PS, wm * 32 + 16 + lr, ks * 32 + lg * 8);
#pragma unroll
    for (int j = 0; j < 4; j++) {
      bf16x8 bb = ldfrag(Kp, PS, wn * 64 + j * 16 + lr, ks * 32 + lg * 8);
      o[0][j] = MFMA(bb, a0, o[0][j]);
      o[1][j] = MFMA(bb, a1, o[1][j]);
    }
  }
  __syncthreads();
#pragma unroll
  for (int i = 0; i < 4; i++) {
    *(u32x4*)(Qp + (lrow + i * 32) * PS + lc8) = scale8(qv[i], ca[i], cb2[i]);
    *(u32x4*)(Kp + (lrow + i * 32) * PS + lc8) = sv[i];
  }
  __syncthreads();
#pragma unroll
  for (int ks = 0; ks < 4; ks++) {
    bf16x8 a0 = ldfrag(Qp, PS, wm * 32 + lr, ks * 32 + lg * 8);
    bf16x8 a1 = ldfrag(Qp, PS, wm * 32 + 16 + lr, ks * 32 + lg * 8);
#pragma unroll
    for (int j = 0; j < 4; j++) {
      bf16x8 bb = ldfrag(Kp, PS, wn * 64 + j * 16 + lr, ks * 32 + lg * 8);
      o[0][j] = MFMA(bb, a0, o[0][j]);
      o[1][j] = MFMA(bb, a1, o[1][j]);
    }
  }
#pragma unroll
  for (int i = 0; i < 2; i++) {
    float ss = 0.f;
#pragma unroll
    for (int j = 0; j < 4; j++)
#pragma unroll
      for (int r = 0; r < 4; r++) ss += o[i][j][r] * o[i][j][r];
    ss += shfl_xor_l(ss, 16, lane);
    ss += shfl_xor_l(ss, 32, lane);
    if (lg == 0) RED[(wm * 32 + i * 16 + lr) * 2 + wn] = ss;
  }
  __syncthreads();
#pragma unroll
  for (int i = 0; i < 2; i++) {
    const int q = wm * 32 + i * 16 + lr;
    const float rs = rsqrtf((RED[q * 2] + RED[q * 2 + 1]) * (1.f / 128.f) + 1e-6f);
#pragma unroll
    for (int j = 0; j < 4; j++) {
      f32x4 v = o[i][j];
#pragma unroll
      for (int r = 0; r < 4; r++) v[r] *= rs;
      *(uint2*)(OHG + (size_t)(t0 + q) * 1024 + colb + wn * 64 + j * 16 + lg * 4) = pack4(v);
    }
  }
}

DEV void phase_O(const Params& p, int layer, int qidx, unsigned char* ldsraw) {
  bf16_t* lds = (bf16_t*)ldsraw;
  int* ctr = (int*)(p.ws + OFF_CTR) + qidx;
  int* sitem = (int*)(ldsraw + LDS_BYTES - 16);
  const float* lp = p.in[7] + layer * 256;
  float d0 = 0.f, d1 = 0.f;
  for (int i = 0; i < 64; i++) { d0 += lp[i] * lp[64 + i]; d1 += lp[128 + i] * lp[192 + i]; }
  int ly = layer; asm volatile("" : "+s"(ly));
  const float li = (ly == 0) ? 0.2f : 0.35550906759f;
  const float lam = __uint_as_float(__builtin_amdgcn_readfirstlane(__float_as_uint(__expf(d0) - __expf(d1) + li)));
  const int tid0 = get_tid();
  for (;;) {
    __syncthreads();
    if (tid0 == 0) *sitem = atomicAdd(ctr, 1);
    __syncthreads();
    const int item = __builtin_amdgcn_readfirstlane(*sitem);
    if (item >= 1300) break;
    if (item < 520) attn_item(p, layer, item & 7, 64 - (item >> 3), lam, lds);
    else if (item < 780) ret_item(p, (item - 520) & 3, (item - 520) >> 2, lds);
    else hg_item(p, (item - 780) & 7, (item - 780) >> 3, lds);
  }
}

DEV void phase_G(const Params& p, int b, unsigned char* ldsraw) {
  unsigned char* ws = p.ws;
  bf16_t* lds = (bf16_t*)ldsraw;
  const bf16_t* HN = (const bf16_t*)(ws + OFF_HN) + (size_t)b * LT * 1024;
  const bf16_t* WIN = (const bf16_t*)(ws + OFF_WIN);
  for (int item = vblock(); item < 33 * 20; item += gridDim.x) {
    int nt, mt; tile_map(item, 33, 4, mt, nt);
    int n0, cb; bf16_t* dst; int ld; bool gate;
    if (nt < 4) { n0 = 2048 + nt * 256; cb = nt * 256; dst = (bf16_t*)(ws + OFF_ORET); ld = 1024; gate = true; }
    else if (nt < 8) { n0 = 6144 + (nt - 4) * 256; cb = (nt - 4) * 256; dst = (bf16_t*)(ws + OFF_OHG); ld = 1024; gate = true; }
    else { n0 = 10240 + (nt - 8) * 256; cb = (nt - 8) * 256; dst = (bf16_t*)(ws + OFF_G); ld = 3072; gate = false; }
    f32x4 acc[4][8];
#pragma unroll
    for (int i = 0; i < 4; i++)
#pragma unroll
      for (int j = 0; j < 8; j++) acc[i][j] = (f32x4){0.f, 0.f, 0.f, 0.f};
    gemm256_acc<256>(acc, HN + (size_t)mt * 256 * 1024, 1024, LT - mt * 256, WIN + (size_t)n0 * 1024, 1024, 1024, lds);
    const int tid = get_tid(), lane = tid & 63, wave = tid >> 6, wm = wave >> 1, wn = wave & 1; const int lr = lane & 15, lg = lane >> 4;
#pragma unroll
    for (int i = 0; i < 4; i++) {
      const int t = mt * 256 + wm * 64 + i * 16 + lr;
      if (t < LT) {
#pragma unroll
        for (int j = 0; j < 8; j++) {
          bf16_t* d = dst + (size_t)t * ld + cb + wn * 128 + j * 16 + lg * 4;
          f32x4 v;
          if (gate) {
            uint2 ov = *(const uint2*)d;
            v[0] = bf2f((bf16_t)(ov.x & 0xffff)) * silu_f(acc[i][j][0]);
            v[1] = bf2f((bf16_t)(ov.x >> 16)) * silu_f(acc[i][j][1]);
            v[2] = bf2f((bf16_t)(ov.y & 0xffff)) * silu_f(acc[i][j][2]);
            v[3] = bf2f((bf16_t)(ov.y >> 16)) * silu_f(acc[i][j][3]);
          } else {
#pragma unroll
            for (int r = 0; r < 4; r++) v[r] = sigmoid_f(acc[i][j][r]);
          }
          *(uint2*)d = pack4(v);
        }
      }
    }
  }
}

DEV f32x4 mini_gemm16(const bf16_t* __restrict__ A16, int lda, const bf16_t* __restrict__ Bt16, int ldb, int k0, int klen, int lane) {
  const int lr = lane & 15, lg = lane >> 4;
  const bf16_t* pa = A16 + (size_t)lr * lda + k0 + lg * 8;
  const bf16_t* pb = Bt16 + (size_t)lr * ldb + k0 + lg * 8;
  f32x4 acc = (f32x4){0.f, 0.f, 0.f, 0.f};
#pragma unroll 4
  for (int k = 0; k < klen; k += 32) {
    bf16x8 a = *(const bf16x8*)(pa + k);
    bf16x8 b = *(const bf16x8*)(pb + k);
    acc = MFMA(b, a, acc);
  }
  return acc;
}

DEV void phase_Y(const Params& p, unsigned char* ldsraw) {
  unsigned char* ws = p.ws;
  bf16_t* lds = (bf16_t*)ldsraw;
  const bf16_t* WB = (const bf16_t*)(ws + OFF_WB);
  const bf16_t* G = (const bf16_t*)(ws + OFF_G);
  bf16_t* Y = (bf16_t*)(ws + OFF_Y);
  for (int item = vblock(); item < 32 * 8 + 64; item += gridDim.x) {
    if (item >= 256) {
      const int lane = get_tid() & 63, wave = get_tid() >> 6, lr = lane & 15, lg = lane >> 4;
      const int n0 = (item - 256) * 16;
      f32x4* red = (f32x4*)ldsraw;
      __syncthreads();
#pragma unroll 1
      for (int br = 0; br < 3; br++) {
        const bf16_t* Ab = (const bf16_t*)(ws + (br == 0 ? OFF_ORET : (br == 1 ? OFF_OHG : OFF_ODA))) + (size_t)112 * 1024;
        red[(br * 8 + wave) * 64 + lane] = mini_gemm16(Ab, 1024, WB + ((size_t)br * 1024 + n0) * 1024, 1024, wave * 128, 128, lane);
      }
      __syncthreads();
      if (wave == 0) {
        f32x4 y = (f32x4){0.f, 0.f, 0.f, 0.f};
#pragma unroll
        for (int br = 0; br < 3; br++) {
          f32x4 a = red[(br * 8) * 64 + lane];
#pragma unroll
          for (int w = 1; w < 8; w++) a += red[(br * 8 + w) * 64 + lane];
          uint2 gv = *(const uint2*)(G + (size_t)(112 + lr) * 3072 + br * 1024 + n0 + lg * 4);
          y[0] += bf2f((bf16_t)(gv.x & 0xffff)) * a[0];
          y[1] += bf2f((bf16_t)(gv.x >> 16)) * a[1];
          y[2] += bf2f((bf16_t)(gv.y & 0xffff)) * a[2];
          y[3] += bf2f((bf16_t)(gv.y >> 16)) * a[3];
        }
        *(uint2*)(Y + (size_t)(112 + lr) * 1024 + n0 + lg * 4) = pack4(y);
      }
      continue;
    }
    int nt, mt; tile_map(item, 32, 4, mt, nt);
    const int row0 = 128 + mt * 256;
    f32x4 y[4][4];
#pragma unroll
    for (int i = 0; i < 4; i++)
#pragma unroll
      for (int j = 0; j < 4; j++) y[i][j] = (f32x4){0.f, 0.f, 0.f, 0.f};
#pragma unroll 1
    for (int br = 0; br < 3; br++) {
      const bf16_t* Ab = (const bf16_t*)(ws + (br == 0 ? OFF_ORET : (br == 1 ? OFF_OHG : OFF_ODA))) + (size_t)row0 * 1024;
      f32x4 acc[4][4];
#pragma unroll
      for (int i = 0; i < 4; i++)
#pragma unroll
        for (int j = 0; j < 4; j++) acc[i][j] = (f32x4){0.f, 0.f, 0.f, 0.f};
      gemm256_acc<128>(acc, Ab, 1024, 256, WB + ((size_t)br * 1024 + nt * 128) * 1024, 1024, 1024, lds);
      const int tid = get_tid(), lane = tid & 63, wave = tid >> 6, wm = wave >> 1, wn = wave & 1; const int lr = lane & 15, lg = lane >> 4;
#pragma unroll
      for (int i = 0; i < 4; i++) {
        const int t = row0 + wm * 64 + i * 16 + lr;
#pragma unroll
        for (int j = 0; j < 4; j++) {
          uint2 gv = *(const uint2*)(G + (size_t)t * 3072 + br * 1024 + nt * 128 + wn * 64 + j * 16 + lg * 4);
          y[i][j][0] += bf2f((bf16_t)(gv.x & 0xffff)) * acc[i][j][0];
          y[i][j][1] += bf2f((bf16_t)(gv.x >> 16)) * acc[i][j][1];
          y[i][j][2] += bf2f((bf16_t)(gv.y & 0xffff)) * acc[i][j][2];
          y[i][j][3] += bf2f((bf16_t)(gv.y >> 16)) * acc[i][j][3];
        }
      }
    }
    const int tid = get_tid(), lane = tid & 63, wave = tid >> 6, wm = wave >> 1, wn = wave & 1; const int lr = lane & 15, lg = lane >> 4;
#pragma unroll
    for (int i = 0; i < 4; i++) {
      const int t = row0 + wm * 64 + i * 16 + lr;
#pragma unroll
      for (int j = 0; j < 4; j++)
        *(uint2*)(Y + (size_t)t * 1024 + nt * 128 + wn * 64 + j * 16 + lg * 4) = pack4(y[i][j]);
    }
  }
}

DEV void phase_resid(const Params& p, int b, const bf16_t* A, int K, const bf16_t* Wt, unsigned char* ldsraw) {
  bf16_t* lds = (bf16_t*)ldsraw;
  for (int item = vblock(); item < 32 * 8 + 64; item += gridDim.x) {
    if (item >= 256) {
      const int lane = get_tid() & 63, wave = get_tid() >> 6, lr = lane & 15, lg = lane >> 4;
      const int n0 = (item - 256) * 16;
      f32x4* red = (f32x4*)ldsraw;
      const int ks = K >> 3;
      __syncthreads();
      red[wave * 64 + lane] = mini_gemm16(A + (size_t)112 * K, K, Wt + (size_t)n0 * K, K, wave * ks, ks, lane);
      __syncthreads();
      if (wave == 0) {
        f32x4 a = red[lane];
#pragma unroll
        for (int w = 1; w < 8; w++) a += red[w * 64 + lane];
        float4* d = (float4*)(hrow(p, b, 112 + lr) + n0 + lg * 4);
        float4 v = *d;
        v.x += a[0]; v.y += a[1]; v.z += a[2]; v.w += a[3];
        *d = v;
      }
      continue;
    }
    int nt, mt; tile_map(item, 32, 4, mt, nt);
    const int row0 = 128 + mt * 256;
    f32x4 acc[4][4];
#pragma unroll
    for (int i = 0; i < 4; i++)
#pragma unroll
      for (int j = 0; j < 4; j++) acc[i][j] = (f32x4){0.f, 0.f, 0.f, 0.f};
    gemm256_acc<128>(acc, A + (size_t)row0 * K, K, 256, Wt + (size_t)nt * 128 * K, K, K, lds);
    const int tid = get_tid(), lane = tid & 63, wave = tid >> 6, wm = wave >> 1, wn = wave & 1; const int lr = lane & 15, lg = lane >> 4;
#pragma unroll
    for (int i = 0; i < 4; i++) {
      const int t = row0 + wm * 64 + i * 16 + lr;
#pragma unroll
      for (int j = 0; j < 4; j++) {
        float4* d = (float4*)(hrow(p, b, t) + nt * 128 + wn * 64 + j * 16 + lg * 4);
        float4 v = *d;
        v.x += acc[i][j][0]; v.y += acc[i][j][1]; v.z += acc[i][j][2]; v.w += acc[i][j][3];
        *d = v;
      }
    }
  }
}

DEV void phase_F1(const Params& p, int b, unsigned char* ldsraw) {
  unsigned char* ws = p.ws;
  bf16_t* lds = (bf16_t*)ldsraw;
  const bf16_t* HN = (const bf16_t*)(ws + OFF_HN) + (size_t)b * LT * 1024;
  const bf16_t* WFI = (const bf16_t*)(ws + OFF_WFI);
  bf16_t* U = (bf16_t*)(ws + OFF_U);
  for (int item = vblock(); item < 33 * 22; item += gridDim.x) {
    int nt, mt; tile_map(item, 33, 2, mt, nt);
    f32x4 acc[4][8];
#pragma unroll
    for (int i = 0; i < 4; i++)
#pragma unroll
      for (int j = 0; j < 8; j++) acc[i][j] = (f32x4){0.f, 0.f, 0.f, 0.f};
    gemm256_acc<256>(acc, HN + (size_t)mt * 256 * 1024, 1024, LT - mt * 256, WFI + (size_t)nt * 256 * 1024, 1024, 1024, lds);
    const int tid = get_tid(), lane = tid & 63, wave = tid >> 6, wm = wave >> 1, wn = wave & 1; const int lr = lane & 15, lg = lane >> 4;
#pragma unroll
    for (int i = 0; i < 4; i++) {
      const int t = mt * 256 + wm * 64 + i * 16 + lr;
      if (t < LT) {
        const float vm = (t >= 112) ? 1.f : 0.f;
#pragma unroll
        for (int j = 0; j < 8; j++) {
          f32x4 v = acc[i][j];
#pragma unroll
          for (int r = 0; r < 4; r++) v[r] *= vm;
          *(uint2*)(U + (size_t)t * 5632 + nt * 256 + wn * 128 + j * 16 + lg * 4) = pack4(v);
        }
      }
    }
  }
}

DEV void unpack8(const u32x4 v, float (&f)[8]) {
#pragma unroll
  for (int k = 0; k < 4; k++) { f[2 * k] = bf2f((bf16_t)(v[k] & 0xffff)); f[2 * k + 1] = bf2f((bf16_t)(v[k] >> 16)); }
}
DEV void phase_conv(const Params& p, int layer) {
  unsigned char* ws = p.ws;
  const bf16_t* U = (const bf16_t*)(ws + OFF_U);
  bf16_t* GF = (bf16_t*)(ws + OFF_GF);
  const float* cw = p.in[11] + (size_t)layer * 3 * 5632;
  const float* cbias = p.in[12] + (size_t)layer * 5632;
  for (int idx = get_bid() * NTHR + get_tid(); idx < (LT / 8) * 352; idx += gridDim.x * NTHR) {
    const int tb = idx / 352, c8 = (idx - tb * 352) * 8;
    const int t0 = tb * 8;
    float wg[3][8], wv[3][8], bg[8], bv[8];
#pragma unroll
    for (int k = 0; k < 8; k++) {
      bg[k] = cbias[c8 + k]; bv[k] = cbias[2816 + c8 + k];
#pragma unroll
      for (int j = 0; j < 3; j++) { wg[j][k] = cw[j * 5632 + c8 + k]; wv[j][k] = cw[j * 5632 + 2816 + c8 + k]; }
    }
    float g0[8], g1[8], v0[8], v1[8];
    if (t0 >= 2) {
      unpack8(*(const u32x4*)(U + (size_t)(t0 - 2) * 5632 + c8), g0);
      unpack8(*(const u32x4*)(U + (size_t)(t0 - 2) * 5632 + 2816 + c8), v0);
      unpack8(*(const u32x4*)(U + (size_t)(t0 - 1) * 5632 + c8), g1);
      unpack8(*(const u32x4*)(U + (size_t)(t0 - 1) * 5632 + 2816 + c8), v1);
    } else {
#pragma unroll
      for (int k = 0; k < 8; k++) { g0[k] = 0.f; g1[k] = 0.f; v0[k] = 0.f; v1[k] = 0.f; }
    }
#pragma unroll
    for (int tt = 0; tt < 8; tt++) {
      float g2[8], v2[8];
      unpack8(*(const u32x4*)(U + (size_t)(t0 + tt) * 5632 + c8), g2);
      unpack8(*(const u32x4*)(U + (size_t)(t0 + tt) * 5632 + 2816 + c8), v2);
      float og[8];
#pragma unroll
      for (int k = 0; k < 8; k++) {
        const float gg = bg[k] + wg[0][k] * g0[k] + wg[1][k] * g1[k] + wg[2][k] * g2[k];
        const float vv = bv[k] + wv[0][k] * v0[k] + wv[1][k] * v1[k] + wv[2][k] * v2[k];
        og[k] = silu_f(gg) * vv;
        g0[k] = g1[k]; g1[k] = g2[k]; v0[k] = v1[k]; v1[k] = v2[k];
      }
      u32x4 o;
      o[0] = pack2(og[0], og[1]); o[1] = pack2(og[2], og[3]); o[2] = pack2(og[4], og[5]); o[3] = pack2(og[6], og[7]);
      *(u32x4*)(GF + (size_t)(t0 + tt) * 2816 + c8) = o;
    }
  }
}

#define XB_TMO      128
#define XB_XCNT(j)  (256  + 64 * (j))
#define XB_XSUB(j)  (1280 + 64 * (j))
#define XB_XGEN(j)  (2304 + 64 * (j))
#define XB_TOP      3328
#define XB_TOPGEN   3392
#define XB_SPIN_CAP (1u << 18)
#define LAS __attribute__((address_space(3)))
DEV unsigned xb_ld(unsigned* p) { return __hip_atomic_load(p, __ATOMIC_RELAXED, __HIP_MEMORY_SCOPE_AGENT); }
DEV unsigned xb_add(unsigned* p, unsigned v) { return __hip_atomic_fetch_add(p, v, __ATOMIC_RELAXED, __HIP_MEMORY_SCOPE_AGENT); }
DEV unsigned xb_xcc_id() { return (unsigned)__builtin_amdgcn_s_getreg((3 << 11) | 20) & 0xFu; }
#define XB_SPIN(cond, bar) do { unsigned _sp = 0; while (cond) { __builtin_amdgcn_s_sleep(1); \
    if ((++_sp & 255u) == 0u) { if (xb_ld(&(bar)[XB_TMO])) break; if (_sp > XB_SPIN_CAP) { atomicAdd(&(bar)[XB_TMO], 1u); break; } } } } while (0)
struct XcdBarrier { unsigned* bar; unsigned x; volatile LAS unsigned* st; };
DEV XcdBarrier xcd_barrier_post(unsigned* bar, volatile LAS unsigned* st) {
  XcdBarrier b; b.bar = bar; b.x = xb_xcc_id(); b.st = st;
  if (threadIdx.x == 0) (void)xb_add(&bar[XB_XCNT(b.x)], 1u);
  return b;
}
DEV void xcd_barrier_complete(unsigned* bar, unsigned x, unsigned& nloc, unsigned& nx) {
  const unsigned G = gridDim.x;
  unsigned sum, cnt, mine, sp = 0u;
  for (;;) {
    sum = 0u; cnt = 0u; mine = 0u;
#pragma unroll
    for (unsigned j = 0; j < 16; ++j) { const unsigned c = xb_ld(&bar[XB_XCNT(j)]); sum += c; cnt += (c > 0u) ? 1u : 0u; mine = (j == x) ? c : mine; }
    if (sum == G) break;
    __builtin_amdgcn_s_sleep(1);
    if ((++sp & 255u) == 0u) { if (xb_ld(&bar[XB_TMO])) break; if (sp > XB_SPIN_CAP) { atomicAdd(&bar[XB_TMO], 1u); break; } }
  }
  nloc = mine > 0u ? mine : 1u; nx = cnt > 0u ? cnt : 1u;
}
DEV void xcd_barrier(const XcdBarrier& b) {
  asm volatile("s_waitcnt vmcnt(0)" ::: "memory");
  __syncthreads();
  if (threadIdx.x == 0) {
    unsigned* bar = b.bar;
    __builtin_amdgcn_s_waitcnt(0);
    unsigned nloc = b.st[0], nx = b.st[1];
    if (nloc == 0u) { xcd_barrier_complete(bar, b.x, nloc, nx); b.st[0] = nloc; b.st[1] = nx; }
    const unsigned old = xb_add(&bar[XB_XSUB(b.x)], 1u);
    const unsigned gen = old / nloc;
    if (old + 1u == (gen + 1u) * nloc) {
      __builtin_amdgcn_fence(__ATOMIC_RELEASE, "agent");
      asm volatile("s_waitcnt vmcnt(0)" ::: "memory");
      const unsigned og = xb_add(&bar[XB_TOP], 1u);
      const unsigned tg = og / nx;
      if (og + 1u == (tg + 1u) * nx) xb_add(&bar[XB_TOPGEN], 1u);
      else XB_SPIN(xb_ld(&bar[XB_TOPGEN]) == tg, bar);
      __builtin_amdgcn_fence(__ATOMIC_ACQUIRE, "agent");
      xb_add(&bar[XB_XGEN(b.x)], 1u);
      asm volatile("s_waitcnt vmcnt(0)" ::: "memory");
    } else {
      XB_SPIN(xb_ld(&bar[XB_XGEN(b.x)]) == gen, bar);
      __builtin_amdgcn_fence(__ATOMIC_ACQUIRE, "agent");
      asm volatile("s_waitcnt vmcnt(0)" ::: "memory");
    }
  }
  __syncthreads();
}

__global__ void __launch_bounds__(NTHR) fwd_megakernel(Params p) {
  extern __shared__ __attribute__((aligned(16))) unsigned char lds[];
  cg::grid_group grid = cg::this_grid();
  volatile LAS unsigned* xst = (volatile LAS unsigned*)(lds + LDS_BYTES - 12);
  if (threadIdx.x == 0) { xst[0] = 0u; xst[1] = 0u; }
  __syncthreads();
  (void)xcd_barrier_post((unsigned*)(p.ws + OFF_XBAR), xst);
#define GRID_SYNC() do { XcdBarrier xb_; xb_.bar = (unsigned*)(p.ws + OFF_XBAR); xb_.x = xb_xcc_id(); \
    xb_.st = (volatile LAS unsigned*)(lds + LDS_BYTES - 12); xcd_barrier(xb_); } while (0)
  grid.sync();
  unsigned char* ws = p.ws;
  phase_init(p);
  phase_convert(p, 0, lds);
  GRID_SYNC();
  for (int layer = 0; layer < 2; layer++) {
    if (layer == 1) {
      phase_convert(p, 1, lds);
#pragma unroll 1
      for (int bb = 0; bb < 2; bb++)
        phase_norm(p, bb, p.in[2] + 1024, (bf16_t*)(ws + OFF_HN) + (size_t)bb * LT * 1024);
      GRID_SYNC();
    }
    for (int b = 0; b < 2; b++) {
      bf16_t* HNb = (bf16_t*)(ws + OFF_HN) + (size_t)b * LT * 1024;
      phase_projA(p, layer, b, lds);
      GRID_SYNC();
      phase_U(p, lds);
      GRID_SYNC();
      phase_scan(p);
      GRID_SYNC();
      phase_O(p, layer, layer * 2 + b, lds);
      GRID_SYNC();
      phase_G(p, b, lds);
      GRID_SYNC();
      phase_Y(p, lds);
      GRID_SYNC();
      phase_resid(p, b, (const bf16_t*)(ws + OFF_Y), 1024, (const bf16_t*)(ws + OFF_WO), lds);
      GRID_SYNC();
      phase_norm(p, b, p.in[9] + layer * 1024, HNb);
      GRID_SYNC();
      phase_F1(p, b, lds);
      GRID_SYNC();
      phase_conv(p, layer);
      GRID_SYNC();
      phase_resid(p, b, (const bf16_t*)(ws + OFF_GF), DFF, (const bf16_t*)(ws + OFF_WFO), lds);
      GRID_SYNC();
    }
  }
  phase_final(p);
}

extern "C" void kernel_launch(void* const* d_in, const int* in_sizes, int n_in, void* d_out, int out_size,
                              void* d_ws, size_t ws_size, hipStream_t stream) {
  static int grid_blocks = 0;
  if (grid_blocks == 0) {
    if (n_in != 15 || ws_size < OFF_END) {
      fprintf(stderr, "kernel_launch: need 15 inputs and %zu bytes of workspace, got %d and %zu\n", (size_t)OFF_END, n_in, ws_size);
      grid_blocks = -1; return;
    }
    int dev = 0, cus = 0, per_cu = 0;
    hipGetDevice(&dev);
    hipDeviceGetAttribute(&cus, hipDeviceAttributeMultiprocessorCount, dev);
    if (hipFuncSetAttribute((const void*)fwd_megakernel, hipFuncAttributeMaxDynamicSharedMemorySize, LDS_BYTES) != hipSuccess) {
      fprintf(stderr, "kernel_launch: hipFuncSetAttribute failed\n"); grid_blocks = -1; return;
    }
    hipOccupancyMaxActiveBlocksPerMultiprocessor(&per_cu, (const void*)fwd_megakernel, NTHR, LDS_BYTES);
    if (per_cu < 1) per_cu = 1;
    if (per_cu > 1) per_cu = 1;
    grid_blocks = cus * per_cu;
  }
  if (grid_blocks < 0) return;
  hipMemsetAsync((char*)d_ws + OFF_CTR, 0, 256 + XBAR_BYTES, stream);
  Params p{};
  for (int i = 0; i < 15; i++) p.in[i] = (const float*)d_in[i];
  p.out = (float*)d_out;
  p.ws = (unsigned char*)d_ws;
  void* args[] = {&p};
  hipError_t e = hipLaunchCooperativeKernel((const void*)fwd_megakernel, dim3(grid_blocks), dim3(NTHR), args, LDS_BYTES, stream);
  if (e != hipSuccess) fprintf(stderr, "cooperative launch failed: %s (grid %d)\n", hipGetErrorString(e), grid_blocks);
}
```

```cpp
#include <hip/hip_runtime.h>
#include <hip/hip_cooperative_groups.h>
#include <cstdio>
#include <cstdint>
namespace cg = cooperative_groups;

typedef unsigned short bf16_t;
typedef __attribute__((ext_vector_type(8))) short bf16x8;
typedef __attribute__((ext_vector_type(4))) short bf16x4;
typedef __attribute__((ext_vector_type(4))) float f32x4;
typedef __attribute__((ext_vector_type(4))) unsigned u32x4;

#define DEV __device__ __forceinline__
#define MFMA(a, b, c) __builtin_amdgcn_mfma_f32_16x16x32_bf16(a, b, c, 0, 0, 0)

constexpr int LT = 8320;
constexpr int NCH = 65;
constexpr int NTHR = 512;
constexpr int LDS_BYTES = 144 * 1024;
constexpr int INW = 13312;
constexpr int DFF = 2816;

constexpr size_t SZ_ACT = (size_t)LT * 1024 * 2;
constexpr size_t OFF_WIN = 0;
constexpr size_t OFF_WB = OFF_WIN + (size_t)INW * 1024 * 2;
constexpr size_t OFF_WO = OFF_WB + (size_t)3 * 1024 * 1024 * 2;
constexpr size_t OFF_WFI = OFF_WO + (size_t)1024 * 1024 * 2;
constexpr size_t OFF_WFO = OFF_WFI + (size_t)5632 * 1024 * 2;
constexpr size_t OFF_H = OFF_WFO + (size_t)1024 * 2816 * 2;
constexpr size_t OFF_HN = OFF_H + (size_t)2 * 128 * 1024 * 4;
constexpr size_t OFF_R128 = OFF_HN + 2 * SZ_ACT;
constexpr size_t OFF_R64 = OFF_R128 + (size_t)LT * 64 * 8;
constexpr size_t OFF_CTR = OFF_R64 + (size_t)LT * 32 * 8;
constexpr size_t OFF_XBAR = OFF_CTR + 256;
constexpr size_t XBAR_BYTES = 3456 * 4;
constexpr size_t OFF_ARENA = OFF_XBAR + XBAR_BYTES;
constexpr size_t OFF_RQ = OFF_ARENA;
constexpr size_t OFF_RK = OFF_RQ + SZ_ACT / 2;
constexpr size_t OFF_RKT = OFF_RK + SZ_ACT / 2;
constexpr size_t OFF_RVT = OFF_RKT + SZ_ACT / 2;
constexpr size_t OFF_HQ = OFF_RVT + SZ_ACT;
constexpr size_t OFF_HK = OFF_HQ + SZ_ACT;
constexpr size_t OFF_HCB = OFF_HK + SZ_ACT;
constexpr size_t OFF_HKET = OFF_HCB + 2 * SZ_ACT;
constexpr size_t OFF_HVT = OFF_HKET + SZ_ACT;
constexpr size_t OFF_DQ = OFF_HVT + SZ_ACT;
constexpr size_t OFF_DK = OFF_DQ + SZ_ACT;
constexpr size_t OFF_DVT = OFF_DK + SZ_ACT;
constexpr size_t OFF_ORET = OFF_DVT + SZ_ACT;
constexpr size_t OFF_OHG = OFF_ORET + SZ_ACT;
constexpr size_t OFF_STR = OFF_OHG + SZ_ACT;
constexpr size_t OFF_STH = OFF_STR + SZ_ACT;
constexpr size_t OFF_HDEC = OFF_STH + SZ_ACT;
constexpr size_t OFF_END = OFF_HDEC + (size_t)65 * 1024 * 4;
constexpr size_t OFF_G = OFF_RQ;
constexpr size_t OFF_Y = OFF_HK;
constexpr size_t OFF_ODA = OFF_HKET;
constexpr size_t OFF_U = OFF_ARENA;
constexpr size_t OFF_GF = OFF_U + (size_t)LT * 5632 * 2;

struct Params {
  const float* in[15];
  float* out;
  unsigned char* ws;
};

DEV int get_tid() { int t = threadIdx.x; asm volatile("" : "+v"(t)); return t; }
DEV int get_bid() { int b = blockIdx.x; asm volatile("" : "+s"(b)); return b; }
DEV float shfl_xor_l(float v, int m, int lane) { return __int_as_float(__builtin_amdgcn_ds_bpermute((lane ^ m) << 2, __float_as_int(v))); }
DEV float shfl_l(float v, int srclane) { return __int_as_float(__builtin_amdgcn_ds_bpermute(srclane << 2, __float_as_int(v))); }
DEV float* hrow(const Params& p, int b, int t) {
  return (t < 128) ? (float*)(p.ws + OFF_H) + (size_t)(b * 128 + t) * 1024 : p.out + ((size_t)b * 8192 + (t - 128)) * 1024;
}
typedef __bf16 hwbf16x2 __attribute__((ext_vector_type(2)));
typedef float hwf32x2 __attribute__((ext_vector_type(2)));
DEV unsigned pack2(float a, float b) {
  hwf32x2 f = {a, b};
  hwbf16x2 h = __builtin_convertvector(f, hwbf16x2);
  return __builtin_bit_cast(unsigned, h);
}
DEV bf16_t f2bf(float f) { return (bf16_t)(pack2(f, f) & 0xffffu); }
DEV float bf2f(bf16_t h) { return __uint_as_float(((unsigned)h) << 16); }
DEV uint2 pack4(f32x4 v) { uint2 r; r.x = pack2(v[0], v[1]); r.y = pack2(v[2], v[3]); return r; }
DEV float silu_f(float x) { return x / (1.f + __expf(-x)); }
DEV float sigmoid_f(float x) { return 1.f / (1.f + __expf(-x)); }
DEV float ex2(float x) { return __builtin_amdgcn_exp2f(x); }
DEV bf16x8 ldfrag(const bf16_t* base, int stride, int row, int k) {
  return *(const bf16x8*)(base + row * stride + k);
}

template <int BN, bool TRANS>
DEV void gemm_compute(f32x4 (&acc)[2][BN / 32], const bf16_t* as, const bf16_t* bs, int sw0, int sw1) {
  constexpr int NJ = BN / 32, LS = 64;
#pragma unroll
  for (int ks = 0; ks < 2; ks++) {
    const int sw = ks == 0 ? sw0 : sw1;
    bf16x8 a0 = *(const bf16x8*)(as + sw);
    bf16x8 a1 = *(const bf16x8*)(as + 16 * LS + sw);
#pragma unroll
    for (int j = 0; j < NJ; j++) {
      bf16x8 bb = *(const bf16x8*)(bs + j * 16 * LS + sw);
      if (TRANS) {
        acc[0][j] = MFMA(a0, bb, acc[0][j]);
        acc[1][j] = MFMA(a1, bb, acc[1][j]);
      } else {
        acc[0][j] = MFMA(bb, a0, acc[0][j]);
        acc[1][j] = MFMA(bb, a1, acc[1][j]);
      }
    }
  }
}

template <int BN, bool TRANS>
DEV void gemm_acc(f32x4 (&acc)[2][BN / 32], const bf16_t* __restrict__ A, int lda,
                  const bf16_t* __restrict__ Bt, int ldb, int K, bf16_t* lds) {
  constexpr int LS = 64, A_SZ = 128 * LS, B_SZ = BN * LS, NB = BN / 64;
  const int tid = get_tid(), lane = tid & 63, wave = tid >> 6, wm = wave >> 1, wn = wave & 1;
  const int lr = lane & 15, lg = lane >> 4;
  bf16_t* As = lds;
  bf16_t* Bs = lds + 2 * A_SZ;
  const int crow = tid >> 3, ckc = (tid & 7) * 8;
  const int cks = ((tid & 7) ^ ((crow >> 1) & 7)) * 8;
  const int sw0 = (lg ^ ((lr >> 1) & 7)) * 8, sw1 = sw0 ^ 32;
  const bf16_t* ga = A + (size_t)crow * lda + ckc;
  const bf16_t* gb = Bt + (size_t)crow * ldb + ckc;
  u32x4 ra0, ra1, rb0, rb1, rb2, rb3;
#define GLOAD(k0)                                                        \
  ra0 = *(const u32x4*)(ga + (k0));                                      \
  ra1 = *(const u32x4*)(ga + (size_t)64 * lda + (k0));                   \
  rb0 = *(const u32x4*)(gb + (k0));                                      \
  rb1 = *(const u32x4*)(gb + (size_t)64 * ldb + (k0));                   \
  if (NB == 4) {                                                         \
    rb2 = *(const u32x4*)(gb + (size_t)128 * ldb + (k0));                \
    rb3 = *(const u32x4*)(gb + (size_t)192 * ldb + (k0));                \
  }
#define LSTORE(buf)                                                      \
  *(u32x4*)(As + (buf) * A_SZ + crow * LS + cks) = ra0;                  \
  *(u32x4*)(As + (buf) * A_SZ + (crow + 64) * LS + cks) = ra1;           \
  *(u32x4*)(Bs + (buf) * B_SZ + crow * LS + cks) = rb0;                  \
  *(u32x4*)(Bs + (buf) * B_SZ + (crow + 64) * LS + cks) = rb1;           \
  if (NB == 4) {                                                         \
    *(u32x4*)(Bs + (buf) * B_SZ + (crow + 128) * LS + cks) = rb2;        \
    *(u32x4*)(Bs + (buf) * B_SZ + (crow + 192) * LS + cks) = rb3;        \
  }
  const int nk = K / 64;
  const int aoff = (wm * 32 + lr) * LS;
  const int boff = (wn * (BN / 2) + lr) * LS;
  GLOAD(0)
  __syncthreads();
  LSTORE(0)
  GLOAD(64)
  __syncthreads();
  for (int kt = 0; kt < nk; kt++) {
    const int cur = kt & 1;
    LSTORE(cur ^ 1)
    {
      const int kn = (kt + 2 < nk) ? kt + 2 : nk - 1;
      GLOAD(kn * 64)
    }
    __builtin_amdgcn_sched_barrier(0);
    gemm_compute<BN, TRANS>(acc, As + cur * A_SZ + aoff, Bs + cur * B_SZ + boff, sw0, sw1);
    __syncthreads();
  }
#undef GLOAD
#undef LSTORE
}

template <int BN, bool TRANS>
DEV void gemm256_compute(f32x4 (&acc)[4][BN / 32], const bf16_t* as, const bf16_t* bs, int sw0, int sw1) {
  constexpr int LS = 64, NJ = BN / 32;
#pragma unroll
  for (int ks = 0; ks < 2; ks++) {
    const int sw = ks == 0 ? sw0 : sw1;
    bf16x8 a[4];
#pragma unroll
    for (int i = 0; i < 4; i++) a[i] = *(const bf16x8*)(as + i * 16 * LS + sw);
#pragma unroll
    for (int j = 0; j < NJ; j++) {
      bf16x8 bb = *(const bf16x8*)(bs + j * 16 * LS + sw);
#pragma unroll
      for (int i = 0; i < 4; i++) acc[i][j] = TRANS ? MFMA(a[i], bb, acc[i][j]) : MFMA(bb, a[i], acc[i][j]);
    }
  }
}

template <int BN, bool TRANS = false>
DEV void gemm256_acc(f32x4 (&acc)[4][BN / 32], const bf16_t* __restrict__ A, int lda, int m_valid,
                     const bf16_t* __restrict__ Bt, int ldb, int K, bf16_t* lds) {
  constexpr int LS = 64, A_SZ = 256 * LS, B_SZ = BN * LS, NB = BN / 64;
  const int tid = get_tid(), lane = tid & 63, wave = tid >> 6, wm = wave >> 1, wn = wave & 1;
  const int lr = lane & 15, lg = lane >> 4;
  bf16_t* As = lds;
  bf16_t* Bs = lds + 2 * A_SZ;
  const int crow = tid >> 3, ckc = (tid & 7) * 8;
  const int cks = ((tid & 7) ^ ((crow >> 1) & 7)) * 8;
  const int sw0 = (lg ^ ((lr >> 1) & 7)) * 8, sw1 = sw0 ^ 32;
  const bf16_t* ga0 = A + (size_t)min(crow, m_valid - 1) * lda + ckc;
  const bf16_t* ga1 = A + (size_t)min(crow + 64, m_valid - 1) * lda + ckc;
  const bf16_t* ga2 = A + (size_t)min(crow + 128, m_valid - 1) * lda + ckc;
  const bf16_t* ga3 = A + (size_t)min(crow + 192, m_valid - 1) * lda + ckc;
  const bf16_t* gb = Bt + (size_t)crow * ldb + ckc;
  u32x4 ra0, ra1, ra2, ra3, rb0, rb1, rb2, rb3;
#define GLOAD(k0)                                                        \
  ra0 = *(const u32x4*)(ga0 + (k0));                                     \
  ra1 = *(const u32x4*)(ga1 + (k0));                                     \
  ra2 = *(const u32x4*)(ga2 + (k0));                                     \
  ra3 = *(const u32x4*)(ga3 + (k0));                                     \
  rb0 = *(const u32x4*)(gb + (k0));                                      \
  rb1 = *(const u32x4*)(gb + (size_t)64 * ldb + (k0));                   \
  if (NB == 4) {                                                         \
    rb2 = *(const u32x4*)(gb + (size_t)128 * ldb + (k0));                \
    rb3 = *(const u32x4*)(gb + (size_t)192 * ldb + (k0));                \
  }
#define LSTORE(buf)                                                      \
  *(u32x4*)(As + (buf) * A_SZ + crow * LS + cks) = ra0;                  \
  *(u32x4*)(As + (buf) * A_SZ + (crow + 64) * LS + cks) = ra1;           \
  *(u32x4*)(As + (buf) * A_SZ + (crow + 128) * LS + cks) = ra2;          \
  *(u32x4*)(As + (buf) * A_SZ + (crow + 192) * LS + cks) = ra3;          \
  *(u32x4*)(Bs + (buf) * B_SZ + crow * LS + cks) = rb0;                  \
  *(u32x4*)(Bs + (buf) * B_SZ + (crow + 64) * LS + cks) = rb1;           \
  if (NB == 4) {                                                         \
    *(u32x4*)(Bs + (buf) * B_SZ + (crow + 128) * LS + cks) = rb2;        \
    *(u32x4*)(Bs + (buf) * B_SZ + (crow + 192) * LS + cks) = rb3;        \
  }
  const int nk = K / 64;
  const int aoff = (wm * 64 + lr) * LS;
  const int boff = (wn * (BN / 2) + lr) * LS;
  GLOAD(0)
  __syncthreads();
  LSTORE(0)
  GLOAD(64)
  __syncthreads();
  for (int kt = 0; kt < nk; kt++) {
    const int cur = kt & 1;
    LSTORE(cur ^ 1)
    {
      const int kn = (kt + 2 < nk) ? kt + 2 : nk - 1;
      GLOAD(kn * 64)
    }
    __builtin_amdgcn_sched_barrier(0);
    gemm256_compute<BN, TRANS>(acc, As + cur * A_SZ + aoff, Bs + cur * B_SZ + boff, sw0, sw1);
    __syncthreads();
  }
#undef GLOAD
#undef LSTORE
}

DEV void tconv_tiles4(const float* __restrict__ src, int K, int N, bf16_t* __restrict__ dst, int idx0, int ntn, float* tile) {
  const int tid = get_tid();
  const int r = tid >> 4, c4 = (tid & 15) * 4;
  float4 v[4][2];
#pragma unroll
  for (int u = 0; u < 4; u++) {
    const int idx = idx0 + u, tk = idx / ntn, tn = idx - tk * ntn;
#pragma unroll
    for (int i = 0; i < 2; i++) v[u][i] = *(const float4*)(src + (size_t)(tk * 64 + r + i * 32) * N + tn * 64 + c4);
  }
  __syncthreads();
#pragma unroll
  for (int u = 0; u < 4; u++)
#pragma unroll
    for (int i = 0; i < 2; i++) {
      float* t = tile + u * (64 * 65) + (r + i * 32) * 65 + c4;
      t[0] = v[u][i].x; t[1] = v[u][i].y; t[2] = v[u][i].z; t[3] = v[u][i].w;
    }
  __syncthreads();
  const int n = tid >> 3, k8 = (tid & 7) * 8;
#pragma unroll
  for (int u = 0; u < 4; u++) {
    const int idx = idx0 + u, tk = idx / ntn, tn = idx - tk * ntn;
    const float* t = tile + u * (64 * 65);
    u32x4 o;
    o[0] = pack2(t[(k8 + 0) * 65 + n], t[(k8 + 1) * 65 + n]);
    o[1] = pack2(t[(k8 + 2) * 65 + n], t[(k8 + 3) * 65 + n]);
    o[2] = pack2(t[(k8 + 4) * 65 + n], t[(k8 + 5) * 65 + n]);
    o[3] = pack2(t[(k8 + 6) * 65 + n], t[(k8 + 7) * 65 + n]);
    *(u32x4*)(dst + (size_t)(tn * 64 + n) * K + tk * 64 + k8) = o;
  }
}

DEV void phase_convert(const Params& p, int layer, unsigned char* lds) {
  unsigned char* ws = p.ws;
  float* tile = (float*)lds;
  for (int g = get_bid(); g < 1616; g += gridDim.x) {
    const float* src; bf16_t* dst; int K, N, gi;
    if (g < 832) { gi = g; src = p.in[3] + (size_t)layer * 1024 * INW; K = 1024; N = INW; dst = (bf16_t*)(ws + OFF_WIN); }
    else if (g < 832 + 192) { gi = g - 832; const int br = gi >> 6; gi &= 63; src = p.in[4] + ((size_t)layer * 3 + br) * 1024 * 1024; K = 1024; N = 1024; dst = (bf16_t*)(ws + OFF_WB) + (size_t)br * 1024 * 1024; }
    else if (g < 1088) { gi = g - 1024; src = p.in[5] + (size_t)layer * 1024 * 1024; K = 1024; N = 1024; dst = (bf16_t*)(ws + OFF_WO); }
    else if (g < 1440) { gi = g - 1088; src = p.in[10] + (size_t)layer * 1024 * 5632; K = 1024; N = 5632; dst = (bf16_t*)(ws + OFF_WFI); }
    else { gi = g - 1440; src = p.in[13] + (size_t)layer * 2816 * 1024; K = 2816; N = 1024; dst = (bf16_t*)(ws + OFF_WFO); }
    tconv_tiles4(src, K, N, dst, gi * 4, N / 64, (float*)tile);
  }
}

DEV void phase_init(const Params& p) {
  unsigned char* ws = p.ws;
  const int gt = get_bid() * NTHR + get_tid(), gs = gridDim.x * NTHR;
  {
    const int lane = get_tid() & 63, wave = get_tid() >> 6;
    const float* g = p.in[2];
    for (int row = get_bid() * 8 + wave; row < 2 * LT; row += gridDim.x * 8) {
      const int b = row / LT, t = row - b * LT;
      float4 v[4]; float ss = 0.f;
#pragma unroll
      for (int k = 0; k < 4; k++) {
        const int c4 = k * 256 + lane * 4;
        if (t < 112) v[k] = make_float4(0.f, 0.f, 0.f, 0.f);
        else if (t < 128) v[k] = *(const float4*)(p.in[1] + (size_t)(t - 112) * 1024 + c4);
        else v[k] = *(const float4*)(p.in[0] + ((size_t)b * 8192 + (t - 128)) * 1024 + c4);
        *(float4*)(hrow(p, b, t) + c4) = v[k];
        ss += v[k].x * v[k].x + v[k].y * v[k].y + v[k].z * v[k].z + v[k].w * v[k].w;
      }
#pragma unroll
      for (int o = 1; o < 64; o <<= 1) ss += shfl_xor_l(ss, o, lane);
      const float rs = rsqrtf(ss * (1.f / 1024.f) + 1e-6f);
      bf16_t* dst = (bf16_t*)(ws + OFF_HN) + (size_t)b * LT * 1024 + (size_t)t * 1024;
#pragma unroll
      for (int k = 0; k < 4; k++) {
        float4 gg = *(const float4*)(g + k * 256 + lane * 4);
        uint2 o; o.x = pack2(v[k].x * rs * gg.x, v[k].y * rs * gg.y); o.y = pack2(v[k].z * rs * gg.z, v[k].w * rs * gg.w);
        *(uint2*)(dst + k * 256 + lane * 4) = o;
      }
    }
  }
  float2* R128 = (float2*)(ws + OFF_R128);
  float2* R64 = (float2*)(ws + OFF_R64);
  for (int idx = gt; idx < LT * 96; idx += gs) {
    const int t = idx / 96, f = idx - t * 96;
    float inv;
    if (f < 64) inv = powf(10000.f, -(float)(2 * f) / 128.f);
    else inv = powf(10000.f, -(float)(2 * (f - 64)) / 64.f);
    const float ang = (float)(t - 112) * inv;
    const double ad = (double)ang;
    const double n = rint(ad * 0.15915494309189535);
    const float rr = (float)(ad - n * 6.283185307179586);
    float2 cs; cs.x = __cosf(rr); cs.y = __sinf(rr);
    if (f < 64) R128[(size_t)t * 64 + f] = cs; else R64[(size_t)t * 32 + (f - 64)] = cs;
  }
}

DEV void phase_norm(const Params& p, int b, const float* __restrict__ g, bf16_t* __restrict__ dst) {
  const int lane = get_tid() & 63, wave = get_tid() >> 6;
  for (int row = get_bid() * 8 + wave; row < LT; row += gridDim.x * 8) {
    const float* src = hrow(p, b, row);
    float4 v[4]; float ss = 0.f;
#pragma unroll
    for (int k = 0; k < 4; k++) { v[k] = *(const float4*)(src + k * 256 + lane * 4); ss += v[k].x * v[k].x + v[k].y * v[k].y + v[k].z * v[k].z + v[k].w * v[k].w; }
#pragma unroll
    for (int o = 1; o < 64; o <<= 1) ss += shfl_xor_l(ss, o, lane);
    const float rs = rsqrtf(ss * (1.f / 1024.f) + 1e-6f);
#pragma unroll
    for (int k = 0; k < 4; k++) {
      float4 gg = *(const float4*)(g + k * 256 + lane * 4);
      uint2 o; o.x = pack2(v[k].x * rs * gg.x, v[k].y * rs * gg.y); o.y = pack2(v[k].z * rs * gg.z, v[k].w * rs * gg.w);
      *(uint2*)(dst + (size_t)row * 1024 + k * 256 + lane * 4) = o;
    }
  }
}

DEV void phase_final(const Params& p) {
  const float* g = p.in[14];
  const int lane = get_tid() & 63, wave = get_tid() >> 6;
  for (int row = get_bid() * 8 + wave; row < 2 * 8192; row += gridDim.x * 8) {
    const float* src = p.out + (size_t)row * 1024;
    float4 v[4]; float ss = 0.f;
#pragma unroll
    for (int k = 0; k < 4; k++) { v[k] = *(const float4*)(src + k * 256 + lane * 4); ss += v[k].x * v[k].x + v[k].y * v[k].y + v[k].z * v[k].z + v[k].w * v[k].w; }
#pragma unroll
    for (int o = 1; o < 64; o <<= 1) ss += shfl_xor_l(ss, o, lane);
    const float rs = rsqrtf(ss * (1.f / 1024.f) + 1e-6f);
#pragma unroll
    for (int k = 0; k < 4; k++) {
      float4 gg = *(const float4*)(g + k * 256 + lane * 4);
      float4 o = make_float4(v[k].x * rs * gg.x, v[k].y * rs * gg.y, v[k].z * rs * gg.z, v[k].w * rs * gg.w);
      *(float4*)(p.out + (size_t)row * 1024 + k * 256 + lane * 4) = o;
    }
  }
}

DEV void tile_map(int it, int MT, int NG, int& mt, int& nt) {
  const int ng = it / (MT * NG), rem = it - ng * (MT * NG);
  mt = rem / NG; nt = ng * NG + (rem - mt * NG);
}
DEV int vblock() { const int b = get_bid(), G = (int)gridDim.x; return ((G & 7) == 0) ? (b & 7) * (G >> 3) + (b >> 3) : b; }

template <int NI>
DEV void projA_epiN(const Params& p, f32x4 (&acc)[NI][8], int seg, int cw, int trow0, int lr, int lg) {
  unsigned char* ws = p.ws;
  const float2* R128 = (const float2*)(ws + OFF_R128);
  const float2* R64 = (const float2*)(ws + OFF_R64);
  bf16_t* dstb; int ld;
  if (seg == 0) { dstb = (bf16_t*)(ws + OFF_RQ); ld = 512; }
  else if (seg == 3) { dstb = (bf16_t*)(ws + OFF_HQ); ld = 1024; }
  else if (seg == 6) { dstb = (bf16_t*)(ws + OFF_DQ); ld = 1024; }
  else { dstb = (bf16_t*)(ws + OFF_DK); ld = 1024; }
#pragma unroll
  for (int i = 0; i < NI; i++) {
    const int t = trow0 + i * 16 + lr;
    if (seg == 0) {
      const float2* tab = R128 + (size_t)t * 64;
#pragma unroll
      for (int j = 0; j < 4; j++)
#pragma unroll
        for (int r = 0; r < 4; r++) {
          float2 cs = tab[j * 16 + lg * 4 + r];
          float x1 = acc[i][j][r], x2 = acc[i][j + 4][r];
          acc[i][j][r] = x1 * cs.x - x2 * cs.y;
          acc[i][j + 4][r] = x2 * cs.x + x1 * cs.y;
        }
    } else if (seg == 6 || seg == 7) {
      const float2* tab = R64 + (size_t)t * 32;
      const float sc = (seg == 6) ? (0.125f * 1.4426950408889634f) : 1.f;
#pragma unroll
      for (int jq = 0; jq < 4; jq++) {
        const int j = (jq & 1) + (jq >> 1) * 4;
#pragma unroll
        for (int r = 0; r < 4; r++) {
          float2 cs = tab[(jq & 1) * 16 + lg * 4 + r];
          float x1 = acc[i][j][r], x2 = acc[i][j + 2][r];
          acc[i][j][r] = (x1 * cs.x - x2 * cs.y) * sc;
          acc[i][j + 2][r] = (x2 * cs.x + x1 * cs.y) * sc;
        }
      }
    }
    bf16_t* dst = dstb + (size_t)t * ld + cw;
#pragma unroll
    for (int j = 0; j < 8; j++) *(uint2*)(dst + j * 16 + lg * 4) = pack4(acc[i][j]);
    __builtin_amdgcn_sched_barrier(0);
  }
}

template <int NI>
DEV void projA_epiT(const Params& p, int layer, f32x4 (&acc)[NI][8], int seg, int cw, int trow0, int wn,
                    int mloc0, int lr, int lg, int tid, unsigned char* ldsraw) {
  unsigned char* ws = p.ws;
  const float2* R128 = (const float2*)(ws + OFF_R128);
  if (seg == 1) {
    bf16_t* RK = (bf16_t*)(ws + OFF_RK);
    bf16_t* RKT = (bf16_t*)(ws + OFF_RKT);
    const int h = cw >> 7;
    const float l2g = log2f(1.f - ex2(-5.f - (float)h));
#pragma unroll
    for (int i = 0; i < NI; i++) {
      const int tb = trow0 + i * 16 + lg * 4;
#pragma unroll
      for (int j = 0; j < 4; j++)
#pragma unroll
        for (int r = 0; r < 4; r++) {
          const int t = tb + r;
          float2 cs = R128[(size_t)t * 64 + j * 16 + lr];
          const float sc = (t >= 112) ? 0.08838834764831845f : 0.f;
          float x1 = acc[i][j][r], x2 = acc[i][j + 4][r];
          acc[i][j][r] = (x1 * cs.x - x2 * cs.y) * sc;
          acc[i][j + 4][r] = (x2 * cs.x + x1 * cs.y) * sc;
        }
#pragma unroll
      for (int j = 0; j < 8; j++) {
        const int col = cw + j * 16 + lr;
        f32x4 kd;
#pragma unroll
        for (int r = 0; r < 4; r++) {
          const int t = tb + r;
          RK[(size_t)t * 512 + col] = f2bf(acc[i][j][r]);
          kd[r] = acc[i][j][r] * ex2(l2g * (float)(127 - (t & 127)));
        }
        *(uint2*)(RKT + (size_t)col * LT + tb) = pack4(kd);
      }
      __builtin_amdgcn_sched_barrier(0);
    }
  } else if (seg == 2 || seg == 5 || seg == 8) {
    bf16_t* dT = (bf16_t*)(ws + (seg == 2 ? OFF_RVT : (seg == 5 ? OFF_HVT : OFF_DVT)));
#pragma unroll
    for (int i = 0; i < NI; i++) {
      const int tb = trow0 + i * 16 + lg * 4;
#pragma unroll
      for (int j = 0; j < 8; j++) {
        const int col = cw + j * 16 + lr;
        f32x4 v = acc[i][j];
        if (seg == 5) {
#pragma unroll
          for (int r = 0; r < 4; r++) if (tb + r < 112) v[r] = 0.f;
        }
        *(uint2*)(dT + (size_t)col * LT + tb) = pack4(v);
      }
      __builtin_amdgcn_sched_barrier(0);
    }
  } else if constexpr (NI == 2) {
    float* Lf = (float*)ldsraw;
    float* HCB = (float*)(ws + OFF_HCB);
    bf16_t* HK = (bf16_t*)(ws + OFF_HK);
    bf16_t* HKET = (bf16_t*)(ws + OFF_HKET);
    float* HDEC = (float*)(ws + OFF_HDEC);
    const float* lbp = p.in[6];
#pragma unroll
    for (int j = 0; j < 8; j++) {
      const int col = cw + j * 16 + lr;
      float lb = 0.f;
      if (layer == 1) lb = 1.f / (1.f + __expf(lbp[col] - lbp[1024 + col]));
#pragma unroll
      for (int i = 0; i < 2; i++)
#pragma unroll
        for (int r = 0; r < 4; r++) {
          const int m = mloc0 + i * 16 + lg * 4 + r;
          const float z = acc[i][j][r];
          const float kk = (1.f - lb) / (1.f + __expf(z));
          const float lf = fmaxf(log1pf(-kk), -69.0776f);
          acc[i][j][r] = kk;
          Lf[m * 260 + wn * 128 + j * 16 + lr] = lf;
        }
    }
    __syncthreads();
    {
      const int colL = tid & 255, half = tid >> 8;
      float run = 0.f;
      for (int rr = 0; rr < 64; rr++) {
        float* q = &Lf[(half * 64 + rr) * 260 + colL];
        run += *q; *q = run;
      }
    }
    __syncthreads();
#pragma unroll
    for (int j = 0; j < 8; j++) {
      const int colL = wn * 128 + j * 16 + lr;
      const int col = cw + j * 16 + lr;
      const float ft = Lf[63 * 260 + colL];
      const float cend = Lf[127 * 260 + colL] + ft;
#pragma unroll
      for (int i = 0; i < 2; i++) {
        const int mb = mloc0 + i * 16 + lg * 4;
        const int tb = trow0 + i * 16 + lg * 4;
        f32x4 ke;
#pragma unroll
        for (int r = 0; r < 4; r++) {
          const int m = mb + r;
          const int t = tb + r;
          const float cb = Lf[m * 260 + colL] + (m >= 64 ? ft : 0.f);
          HCB[(size_t)t * 1024 + col] = cb;
          HK[(size_t)t * 1024 + col] = f2bf(acc[i][j][r]);
          ke[r] = acc[i][j][r] * __expf(cend - cb);
          if (m == 127) HDEC[(t >> 7) * 1024 + col] = __expf(cend);
        }
        *(uint2*)(HKET + (size_t)col * LT + tb) = pack4(ke);
      }
    }
    __syncthreads();
  }
}

DEV void projA_seg(int nt, int& n0, int& seg, int& segstart) {
  if (nt < 8) { n0 = nt * 256; seg = nt < 2 ? 0 : (nt < 4 ? 1 : 2); segstart = seg == 0 ? 0 : (seg == 1 ? 512 : 1024); }
  else if (nt < 20) { n0 = 3072 + (nt - 8) * 256; seg = 3 + (nt - 8) / 4; segstart = 3072 + (seg - 3) * 1024; }
  else { n0 = 7168 + (nt - 20) * 256; seg = 6 + (nt - 20) / 4; segstart = 7168 + (seg - 6) * 1024; }
}

DEV void phase_projA(const Params& p, int layer, int b, unsigned char* ldsraw) {
  unsigned char* ws = p.ws;
  bf16_t* lds = (bf16_t*)ldsraw;
  const bf16_t* HN = (const bf16_t*)(ws + OFF_HN) + (size_t)b * LT * 1024;
  const bf16_t* WIN = (const bf16_t*)(ws + OFF_WIN);
  const int G = (int)gridDim.x, vb = vblock();
  for (int item = vb; item < 32 * 28; item += G) {
    int ntb, mt; tile_map(item, 32, 4, mt, ntb);
    const int nt = ntb < 12 ? ntb : ntb + 4;
    int n0, seg, segstart; projA_seg(nt, n0, seg, segstart);
    const int row0 = 128 + mt * 256;
    const bf16_t* A = HN + (size_t)row0 * 1024;
    const bf16_t* Bt = WIN + (size_t)n0 * 1024;
    f32x4 acc[4][8];
#pragma unroll
    for (int i = 0; i < 4; i++)
#pragma unroll
      for (int j = 0; j < 8; j++) acc[i][j] = (f32x4){0.f, 0.f, 0.f, 0.f};
    if (seg == 0 || seg == 3 || seg == 6 || seg == 7) {
      gemm256_acc<256, false>(acc, A, 1024, 256, Bt, 1024, 1024, lds);
      const int tid = get_tid(), lane = tid & 63, wave = tid >> 6, wm = wave >> 1, wn = wave & 1; const int lr = lane & 15, lg = lane >> 4;
      projA_epiN<4>(p, acc, seg, (n0 - segstart) + wn * 128, row0 + wm * 64, lr, lg);
    } else {
      gemm256_acc<256, true>(acc, A, 1024, 256, Bt, 1024, 1024, lds);
      const int tid = get_tid(), lane = tid & 63, wave = tid >> 6, wm = wave >> 1, wn = wave & 1; const int lr = lane & 15, lg = lane >> 4;
      projA_epiT<4>(p, layer, acc, seg, (n0 - segstart) + wn * 128, row0 + wm * 64, wn, (wm & 1) * 64, lr, lg, tid, ldsraw);
    }
  }
  for (int s = (vb + G / 2) % G; s < 288; s += G) {
    int nt, mt;
    if (s < 28) { mt = 0; nt = s < 12 ? s : s + 4; }
    else { const int q = s - 28; mt = q >> 2; nt = 12 + (q & 3); }
    int n0, seg, segstart; projA_seg(nt, n0, seg, segstart);
    const bf16_t* A = HN + (size_t)mt * 128 * 1024;
    const bf16_t* Bt = WIN + (size_t)n0 * 1024;
    f32x4 acc[2][8];
#pragma unroll
    for (int i = 0; i < 2; i++)
#pragma unroll
      for (int j = 0; j < 8; j++) acc[i][j] = (f32x4){0.f, 0.f, 0.f, 0.f};
    if (seg == 0 || seg == 3 || seg == 6 || seg == 7) {
      gemm_acc<256, false>(acc, A, 1024, Bt, 1024, 1024, lds);
      const int tid = get_tid(), lane = tid & 63, wave = tid >> 6, wm = wave >> 1, wn = wave & 1; const int lr = lane & 15, lg = lane >> 4;
      projA_epiN<2>(p, acc, seg, (n0 - segstart) + wn * 128, mt * 128 + wm * 32, lr, lg);
    } else {
      gemm_acc<256, true>(acc, A, 1024, Bt, 1024, 1024, lds);
      const int tid = get_tid(), lane = tid & 63, wave = tid >> 6, wm = wave >> 1, wn = wave & 1; const int lr = lane & 15, lg = lane >> 4;
      projA_epiT<2>(p, layer, acc, seg, (n0 - segstart) + wn * 128, mt * 128 + wm * 32, wn, wm * 32, lr, lg, tid, ldsraw);
    }
  }
}

DEV void gemm_k128(f32x4 (&acc)[2][4], const bf16_t* __restrict__ A, int lda, const bf16_t* __restrict__ Bt, int ldb, bf16_t* lds) {
  constexpr int LS = 64, T_SZ = 128 * LS;
  const int tid = get_tid(), lane = tid & 63, wave = tid >> 6, wm = wave >> 1, wn = wave & 1;
  const int lr = lane & 15, lg = lane >> 4;
  bf16_t* As = lds;
  bf16_t* Bs = lds + 2 * T_SZ;
  const int crow = tid >> 3, ckc = (tid & 7) * 8;
  const int cks = ((tid & 7) ^ ((crow >> 1) & 7)) * 8;
  const int sw0 = (lg ^ ((lr >> 1) & 7)) * 8, sw1 = sw0 ^ 32;
  const bf16_t* ga = A + (size_t)crow * lda + ckc;
  const bf16_t* gb = Bt + (size_t)crow * ldb + ckc;
  const u32x4 a00 = *(const u32x4*)(ga), a01 = *(const u32x4*)(ga + (size_t)64 * lda);
  const u32x4 b00 = *(const u32x4*)(gb), b01 = *(const u32x4*)(gb + (size_t)64 * ldb);
  const u32x4 a10 = *(const u32x4*)(ga + 64), a11 = *(const u32x4*)(ga + (size_t)64 * lda + 64);
  const u32x4 b10 = *(const u32x4*)(gb + 64), b11 = *(const u32x4*)(gb + (size_t)64 * ldb + 64);
  __syncthreads();
  *(u32x4*)(As + crow * LS + cks) = a00;
  *(u32x4*)(As + (crow + 64) * LS + cks) = a01;
  *(u32x4*)(Bs + crow * LS + cks) = b00;
  *(u32x4*)(Bs + (crow + 64) * LS + cks) = b01;
  *(u32x4*)(As + T_SZ + crow * LS + cks) = a10;
  *(u32x4*)(As + T_SZ + (crow + 64) * LS + cks) = a11;
  *(u32x4*)(Bs + T_SZ + crow * LS + cks) = b10;
  *(u32x4*)(Bs + T_SZ + (crow + 64) * LS + cks) = b11;
  __syncthreads();
  const int aoff = (wm * 32 + lr) * LS, boff = (wn * 64 + lr) * LS;
  gemm_compute<128, false>(acc, As + aoff, Bs + boff, sw0, sw1);
  gemm_compute<128, false>(acc, As + T_SZ + aoff, Bs + T_SZ + boff, sw0, sw1);
  __syncthreads();
}

DEV void phase_U(const Params& p, unsigned char* ldsraw) {
  unsigned char* ws = p.ws;
  bf16_t* lds = (bf16_t*)ldsraw;
  for (int item = get_bid(); item < 1040; item += gridDim.x) {
    const bf16_t *A, *Bt; bf16_t* dst;
    if (item < 520) {
      const int h = item & 3, rest = item >> 2, mh = rest & 1, c = rest >> 1;
      A = (const bf16_t*)(ws + OFF_RVT) + (size_t)(h * 256 + mh * 128) * LT + c * 128;
      Bt = (const bf16_t*)(ws + OFF_RKT) + (size_t)(h * 128) * LT + c * 128;
      dst = (bf16_t*)(ws + OFF_STR) + ((size_t)(h * 65 + c) * 256 + mh * 128) * 128;
    } else {
      const int it = item - 520, h = it & 7, c = it >> 3;
      A = (const bf16_t*)(ws + OFF_HVT) + (size_t)(h * 128) * LT + c * 128;
      Bt = (const bf16_t*)(ws + OFF_HKET) + (size_t)(h * 128) * LT + c * 128;
      dst = (bf16_t*)(ws + OFF_STH) + ((size_t)(h * 65 + c) * 128) * 128;
    }
    f32x4 acc[2][4];
#pragma unroll
    for (int i = 0; i < 2; i++)
#pragma unroll
      for (int j = 0; j < 4; j++) acc[i][j] = (f32x4){0.f, 0.f, 0.f, 0.f};
    gemm_k128(acc, A, LT, Bt, LT, lds);
      const int tid = get_tid(), lane = tid & 63, wave = tid >> 6, wm = wave >> 1, wn = wave & 1; const int lr = lane & 15, lg = lane >> 4; (void)tid; (void)lane; (void)wm; (void)wn; (void)lr; (void)lg;
#pragma unroll
    for (int i = 0; i < 2; i++)
#pragma unroll
      for (int j = 0; j < 4; j++)
        *(uint2*)(dst + (size_t)(wm * 32 + i * 16 + lr) * 128 + wn * 64 + j * 16 + lg * 4) = pack4(acc[i][j]);
  }
}

DEV void phase_scan(const Params& p) {
  unsigned char* ws = p.ws;
  const float* HDEC = (const float*)(ws + OFF_HDEC);
  for (int task = get_bid() * NTHR + get_tid(); task < 65536; task += gridDim.x * NTHR) {
    bf16_t* base; size_t stride; int h, d4; bool hg;
    float dec0 = 0.f;
    if (task < 32768) {
      const int v = task; d4 = (v & 31) * 4; const int e = (v >> 5) & 255; h = v >> 13; hg = false;
      base = (bf16_t*)(ws + OFF_STR) + ((size_t)(h * 65) * 256 + e) * 128 + d4; stride = 256 * 128;
      dec0 = ex2(128.f * log2f(1.f - ex2(-5.f - (float)h)));
    } else {
      const int v = task - 32768; d4 = (v & 31) * 4; const int e = (v >> 5) & 127; h = v >> 12; hg = true;
      base = (bf16_t*)(ws + OFF_STH) + ((size_t)(h * 65) * 128 + e) * 128 + d4; stride = 128 * 128;
    }
    float c0 = 0.f, c1 = 0.f, c2 = 0.f, c3 = 0.f;
    for (int cg0 = 0; cg0 < 65; cg0 += 13) {
      uint2 u[13]; float4 dc[13];
#pragma unroll
      for (int k = 0; k < 13; k++) {
        u[k] = *(const uint2*)(base + (size_t)(cg0 + k) * stride);
        if (hg) dc[k] = *(const float4*)(HDEC + (size_t)(cg0 + k) * 1024 + h * 128 + d4);
        else dc[k] = make_float4(dec0, dec0, dec0, dec0);
      }
#pragma unroll
      for (int k = 0; k < 13; k++) {
        uint2 o; o.x = pack2(c0, c1); o.y = pack2(c2, c3);
        *(uint2*)(base + (size_t)(cg0 + k) * stride) = o;
        c0 = dc[k].x * c0 + bf2f((bf16_t)(u[k].x & 0xffff));
        c1 = dc[k].y * c1 + bf2f((bf16_t)(u[k].x >> 16));
        c2 = dc[k].z * c2 + bf2f((bf16_t)(u[k].y & 0xffff));
        c3 = dc[k].w * c3 + bf2f((bf16_t)(u[k].y >> 16));
      }
    }
  }
}

DEV void attn_item(const Params& p, int layer, int h, int qb, float lam, bf16_t* lds) {
  unsigned char* ws = p.ws;
  const bf16_t* DQ = (const bf16_t*)(ws + OFF_DQ);
  bf16_t* ODA = (bf16_t*)(ws + OFF_ODA);
  const bf16_t* DK = (const bf16_t*)(ws + OFF_DK);
  const bf16_t* DVT = (const bf16_t*)(ws + OFF_DVT);
  constexpr int PS = 136, XS = 132;
  constexpr int TS = 128 * PS;
  bf16_t* KV = lds;
  float* X = (float*)lds;
  const int tid = get_tid(), lane = tid & 63, wave = tid >> 6;
  const int lr = lane & 15, lg = lane >> 4;
  const int grp = wave >> 2, wq = wave & 3;
  const int t0 = qb * 128;
  const int lrow = tid >> 4, lc8 = (tid & 15) * 8;
  const bf16_t* gq = DQ + (size_t)(t0 + wq * 32 + lr) * 1024 + h * 128 + grp * 64 + lg * 8;
  const bf16x8 a00 = *(const bf16x8*)(gq);
  const bf16x8 a01 = *(const bf16x8*)(gq + 32);
  const bf16x8 a10 = *(const bf16x8*)(gq + (size_t)16 * 1024);
  const bf16x8 a11 = *(const bf16x8*)(gq + (size_t)16 * 1024 + 32);
  f32x4 o[2][8];
#pragma unroll
  for (int i = 0; i < 2; i++)
#pragma unroll
    for (int j = 0; j < 8; j++) o[i][j] = (f32x4){0.f, 0.f, 0.f, 0.f};
  float mrun0 = -1e30f, mrun1 = -1e30f, lrun0 = 0.f, lrun1 = 0.f;
  u32x4 rk0, rk1, rk2, rk3, rv0, rv1, rv2, rv3;
  const unsigned ko = (unsigned)(lrow * 1024 + h * 128 + lc8);
  const unsigned vo = (unsigned)((h * 128 + lrow) * LT + lc8);
#define ALOAD(kbn)                                                              \
  rk0 = *(const u32x4*)(DK + (ko + (unsigned)(kbn) * 131072u));                 \
  rk1 = *(const u32x4*)(DK + (ko + (unsigned)(kbn) * 131072u + 32768u));        \
  rk2 = *(const u32x4*)(DK + (ko + (unsigned)(kbn) * 131072u + 65536u));        \
  rk3 = *(const u32x4*)(DK + (ko + (unsigned)(kbn) * 131072u + 98304u));        \
  rv0 = *(const u32x4*)(DVT + (vo + (unsigned)(kbn) * 128u));                   \
  rv1 = *(const u32x4*)(DVT + (vo + (unsigned)(kbn) * 128u + 32u * LT));        \
  rv2 = *(const u32x4*)(DVT + (vo + (unsigned)(kbn) * 128u + 64u * LT));        \
  rv3 = *(const u32x4*)(DVT + (vo + (unsigned)(kbn) * 128u + 96u * LT));
#define ASTORE(sp)                                                              \
  *(u32x4*)((sp)) = rk0;                                                        \
  *(u32x4*)((sp) + 32 * PS) = rk1;                                              \
  *(u32x4*)((sp) + 64 * PS) = rk2;                                              \
  *(u32x4*)((sp) + 96 * PS) = rk3;                                              \
  *(u32x4*)((sp) + 2 * TS) = rv0;                                               \
  *(u32x4*)((sp) + 2 * TS + 32 * PS) = rv1;                                     \
  *(u32x4*)((sp) + 2 * TS + 64 * PS) = rv2;                                     \
  *(u32x4*)((sp) + 2 * TS + 96 * PS) = rv3;
  ALOAD(0)
  const int qrow0 = t0 + wq * 32 + lr;
  __syncthreads();
  ASTORE(KV + lrow * PS + lc8)
  {
    const int kb1 = qb > 0 ? 1 : 0;
    ALOAD(kb1)
  }
  __syncthreads();
  for (int kb = 0; kb <= qb; kb++) {
    const int cur = kb & 1;
    const bf16_t* kp = KV + cur * TS + lr * PS + grp * 64 + lg * 8;
    const bf16_t* vq = KV + 2 * TS + cur * TS + lr * PS + lg * 4;
    {
      bf16_t* sp = KV + (cur ^ 1) * TS + lrow * PS + lc8;
      ASTORE(sp)
    }
    __builtin_amdgcn_sched_barrier(0);
    f32x4 s[2][8];
    {
#pragma unroll
      for (int j = 0; j < 8; j++) {
        const bf16x8 kf0 = *(const bf16x8*)(kp + j * 16 * PS);
        const bf16x8 kf1 = *(const bf16x8*)(kp + j * 16 * PS + 32);
        s[0][j] = MFMA(kf0, a00, ((f32x4){0.f, 0.f, 0.f, 0.f}));
        s[1][j] = MFMA(kf0, a10, ((f32x4){0.f, 0.f, 0.f, 0.f}));
        s[0][j] = MFMA(kf1, a01, s[0][j]);
        s[1][j] = MFMA(kf1, a11, s[1][j]);
      }
    }
    __builtin_amdgcn_sched_barrier(0);
    {
      const int kbn = (kb + 2 <= qb) ? kb + 2 : qb;
      ALOAD(kbn)
    }
    __builtin_amdgcn_sched_barrier(0);
    if (kb == qb || kb == 0) {
#pragma unroll
      for (int i = 0; i < 2; i++)
#pragma unroll
        for (int j = 0; j < 8; j++)
#pragma unroll
          for (int r = 0; r < 4; r++) {
            const int key = kb * 128 + j * 16 + lg * 4 + r;
            if (key > qrow0 + 16 * i || key < 112) s[i][j][r] = -1e30f;
          }
    }
    float al[2];
#pragma unroll
    for (int i = 0; i < 2; i++) {
      float mx = -1e30f;
#pragma unroll
      for (int j = 0; j < 8; j++)
#pragma unroll
        for (int r = 0; r < 4; r++) mx = fmaxf(mx, s[i][j][r]);
      mx = fmaxf(mx, shfl_xor_l(mx, 16, lane));
      mx = fmaxf(mx, shfl_xor_l(mx, 32, lane));
      const float mold = i == 0 ? mrun0 : mrun1;
      const float mnew = (mx > mold + 8.f) ? mx : mold;
      al[i] = ex2(mold - mnew);
      float ps = 0.f;
#pragma unroll
      for (int j = 0; j < 8; j++)
#pragma unroll
        for (int r = 0; r < 4; r++) { const float pv = ex2(s[i][j][r] - mnew); s[i][j][r] = pv; ps += pv; }
      if (i == 0) { mrun0 = mnew; lrun0 = lrun0 * al[0] + ps; } else { mrun1 = mnew; lrun1 = lrun1 * al[1] + ps; }
    }
    if (__builtin_amdgcn_ballot_w64(al[0] != 1.f || al[1] != 1.f) != 0ull) {
#pragma unroll
      for (int i = 0; i < 2; i++) {
        float ao[4];
#pragma unroll
        for (int r = 0; r < 4; r++) ao[r] = shfl_l(al[i], lg * 4 + r);
#pragma unroll
        for (int je = 0; je < 8; je++)
#pragma unroll
          for (int r = 0; r < 4; r++) o[i][je][r] *= ao[r];
      }
    }
#pragma unroll
    for (int ks = 0; ks < 4; ks++) {
      union { u32x4 u; bf16x8 v; } pf0, pf1;
      pf0.u[0] = pack2(s[0][2 * ks][0], s[0][2 * ks][1]);
      pf0.u[1] = pack2(s[0][2 * ks][2], s[0][2 * ks][3]);
      pf0.u[2] = pack2(s[0][2 * ks + 1][0], s[0][2 * ks + 1][1]);
      pf0.u[3] = pack2(s[0][2 * ks + 1][2], s[0][2 * ks + 1][3]);
      pf1.u[0] = pack2(s[1][2 * ks][0], s[1][2 * ks][1]);
      pf1.u[1] = pack2(s[1][2 * ks][2], s[1][2 * ks][3]);
      pf1.u[2] = pack2(s[1][2 * ks + 1][0], s[1][2 * ks + 1][1]);
      pf1.u[3] = pack2(s[1][2 * ks + 1][2], s[1][2 * ks + 1][3]);
#pragma unroll
      for (int je = 0; je < 8; je++) {
        const bf16_t* vp = vq + je * 16 * PS + ks * 32;
        union { uint2 u[2]; bf16x8 v; } vf;
        vf.u[0] = *(const uint2*)vp;
        vf.u[1] = *(const uint2*)(vp + 16);
        o[0][je] = MFMA(pf0.v, vf.v, o[0][je]);
        o[1][je] = MFMA(pf1.v, vf.v, o[1][je]);
      }
    }
    __builtin_amdgcn_sched_barrier(0);
    __syncthreads();
  }
#undef ASTORE
#undef ALOAD
#pragma unroll
  for (int i = 0; i < 2; i++) {
    float l = i == 0 ? lrun0 : lrun1;
    l += shfl_xor_l(l, 16, lane);
    l += shfl_xor_l(l, 32, lane);
    const float inv = l > 0.f ? 1.f / l : 0.f;
#pragma unroll
    for (int r = 0; r < 4; r++) {
      const float ir = shfl_l(inv, lg * 4 + r);
#pragma unroll
      for (int je = 0; je < 8; je++) o[i][je][r] *= ir;
    }
  }
  __syncthreads();
  if (grp == 1) {
#pragma unroll
    for (int i = 0; i < 2; i++)
#pragma unroll
      for (int je = 0; je < 8; je++)
#pragma unroll
        for (int r = 0; r < 4; r++) X[(wq * 32 + i * 16 + lg * 4 + r) * XS + je * 16 + lr] = o[i][je][r];
  }
  __syncthreads();
  if (grp == 0) {
    int ly = layer; asm volatile("" : "+s"(ly));
    const float li = (ly == 0) ? 0.2f : 0.35550906759f;
    const float* sg = p.in[8] + ly * 128;
#pragma unroll
    for (int i = 0; i < 2; i++) {
      float ss[4] = {0.f, 0.f, 0.f, 0.f};
#pragma unroll
      for (int je = 0; je < 8; je++)
#pragma unroll
        for (int r = 0; r < 4; r++) {
          const float v = o[i][je][r] - lam * X[(wq * 32 + i * 16 + lg * 4 + r) * XS + je * 16 + lr];
          o[i][je][r] = v; ss[r] += v * v;
        }
#pragma unroll
      for (int r = 0; r < 4; r++) {
        float s2 = ss[r];
        s2 += shfl_xor_l(s2, 1, lane); s2 += shfl_xor_l(s2, 2, lane); s2 += shfl_xor_l(s2, 4, lane); s2 += shfl_xor_l(s2, 8, lane);
        ss[r] = rsqrtf(s2 * (1.f / 128.f) + 1e-6f) * (1.f - li);
      }
#pragma unroll
      for (int je = 0; je < 8; je++) {
        const float g = sg[je * 16 + lr];
#pragma unroll
        for (int r = 0; r < 4; r++)
          ODA[(size_t)(t0 + wq * 32 + i * 16 + lg * 4 + r) * 1024 + h * 128 + je * 16 + lr] = f2bf(o[i][je][r] * ss[r] * g);
      }
    }
  }
}

DEV void ret_item(const Params& p, int h, int c, bf16_t* lds) {
  unsigned char* ws = p.ws;
  const bf16_t* RQ = (const bf16_t*)(ws + OFF_RQ);
  const bf16_t* RK = (const bf16_t*)(ws + OFF_RK);
  const bf16_t* RVT = (const bf16_t*)(ws + OFF_RVT);
  const bf16_t* STR = (const bf16_t*)(ws + OFF_STR);
  bf16_t* ORET = (bf16_t*)(ws + OFF_ORET);
  constexpr int PS = 136;
  bf16_t* Qs = lds;
  bf16_t* Ks = lds + 128 * PS;
  bf16_t* Big = lds + 2 * 128 * PS;
  float* RED = (float*)(lds + 2 * 128 * PS + 256 * PS);
  const int tid = get_tid(), lane = tid & 63, wave = tid >> 6, wm = wave >> 1, wn = wave & 1;
  const int lr = lane & 15, lg = lane >> 4;
  const int t0 = c * 128;
  const int lrow = tid >> 4, lc8 = (tid & 15) * 8;
  const float l2g = log2f(1.f - ex2(-5.f - (float)h));
#pragma unroll
  for (int i = 0; i < 4; i++) {
    const int row = lrow + i * 32;
    *(uint4*)(Qs + row * PS + lc8) = *(const uint4*)(RQ + (size_t)(t0 + row) * 512 + h * 128 + lc8);
    *(uint4*)(Ks + row * PS + lc8) = *(const uint4*)(RK + (size_t)(t0 + row) * 512 + h * 128 + lc8);
  }
#pragma unroll
  for (int i = 0; i < 8; i++) {
    const int row = lrow + i * 32;
    *(uint4*)(Big + row * PS + lc8) = *(const uint4*)(STR + ((size_t)(h * 65 + c) * 256 + row) * 128 + lc8);
  }
  u32x4 vpre[8];
#pragma unroll
  for (int i = 0; i < 8; i++) vpre[i] = *(const u32x4*)(RVT + (size_t)(h * 256 + lrow + i * 32) * LT + t0 + lc8);
  __syncthreads();
  f32x4 s[2][4];
  f32x4 o[2][8];
#pragma unroll
  for (int i = 0; i < 2; i++) {
#pragma unroll
    for (int j = 0; j < 4; j++) s[i][j] = (f32x4){0.f, 0.f, 0.f, 0.f};
#pragma unroll
    for (int j = 0; j < 8; j++) o[i][j] = (f32x4){0.f, 0.f, 0.f, 0.f};
  }
#pragma unroll
  for (int ks = 0; ks < 4; ks++) {
    bf16x8 a0 = ldfrag(Qs, PS, wm * 32 + lr, ks * 32 + lg * 8);
    bf16x8 a1 = ldfrag(Qs, PS, wm * 32 + 16 + lr, ks * 32 + lg * 8);
#pragma unroll
    for (int j = 0; j < 4; j++) {
      bf16x8 bb = ldfrag(Ks, PS, wn * 64 + j * 16 + lr, ks * 32 + lg * 8);
      s[0][j] = MFMA(bb, a0, s[0][j]);
      s[1][j] = MFMA(bb, a1, s[1][j]);
    }
#pragma unroll
    for (int j = 0; j < 8; j++) {
      bf16x8 bb = ldfrag(Big, PS, wn * 128 + j * 16 + lr, ks * 32 + lg * 8);
      o[0][j] = MFMA(bb, a0, o[0][j]);
      o[1][j] = MFMA(bb, a1, o[1][j]);
    }
    __builtin_amdgcn_sched_barrier(0);
  }
#pragma unroll
  for (int i = 0; i < 2; i++) {
    const int q = wm * 32 + i * 16 + lr;
    const float qd = ex2(l2g * (float)(q + 1));
#pragma unroll
    for (int j = 0; j < 8; j++)
#pragma unroll
      for (int r = 0; r < 4; r++) o[i][j][r] *= qd;
  }
  __syncthreads();
#pragma unroll
  for (int i = 0; i < 2; i++) {
    const int q = wm * 32 + i * 16 + lr;
#pragma unroll
    for (int j = 0; j < 4; j++) {
      f32x4 v;
#pragma unroll
      for (int r = 0; r < 4; r++) {
        const int key = wn * 64 + j * 16 + lg * 4 + r;
        v[r] = (key <= q) ? s[i][j][r] * ex2(l2g * (float)(q - key)) : 0.f;
      }
      *(uint2*)(Ks + q * PS + wn * 64 + j * 16 + lg * 4) = pack4(v);
    }
  }
#pragma unroll
  for (int i = 0; i < 8; i++) *(u32x4*)(Big + (lrow + i * 32) * PS + lc8) = vpre[i];
  __syncthreads();
#pragma unroll
  for (int ks = 0; ks < 4; ks++) {
    bf16x8 a0 = ldfrag(Ks, PS, wm * 32 + lr, ks * 32 + lg * 8);
    bf16x8 a1 = ldfrag(Ks, PS, wm * 32 + 16 + lr, ks * 32 + lg * 8);
#pragma unroll
    for (int j = 0; j < 8; j++) {
      bf16x8 bb = ldfrag(Big, PS, wn * 128 + j * 16 + lr, ks * 32 + lg * 8);
      o[0][j] = MFMA(bb, a0, o[0][j]);
      o[1][j] = MFMA(bb, a1, o[1][j]);
    }
    __builtin_amdgcn_sched_barrier(0);
  }
#pragma unroll
  for (int i = 0; i < 2; i++) {
    float ss = 0.f;
#pragma unroll
    for (int j = 0; j < 8; j++)
#pragma unroll
      for (int r = 0; r < 4; r++) ss += o[i][j][r] * o[i][j][r];
    ss += shfl_xor_l(ss, 16, lane);
    ss += shfl_xor_l(ss, 32, lane);
    if (lg == 0) RED[(wm * 32 + i * 16 + lr) * 2 + wn] = ss;
  }
  __syncthreads();
#pragma unroll
  for (int i = 0; i < 2; i++) {
    const int q = wm * 32 + i * 16 + lr;
    const float rs = rsqrtf((RED[q * 2] + RED[q * 2 + 1]) * (1.f / 256.f) + 1e-6f);
#pragma unroll
    for (int j = 0; j < 8; j++) {
      f32x4 v = o[i][j];
#pragma unroll
      for (int r = 0; r < 4; r++) v[r] *= rs;
      *(uint2*)(ORET + (size_t)(t0 + q) * 1024 + h * 256 + wn * 128 + j * 16 + lg * 4) = pack4(v);
    }
  }
}

DEV u32x4 scale8(u32x4 raw, f32x4 ea, f32x4 eb) {
  u32x4 o;
  o[0] = pack2(bf2f((bf16_t)(raw[0] & 0xffff)) * __expf(ea[0]), bf2f((bf16_t)(raw[0] >> 16)) * __expf(ea[1]));
  o[1] = pack2(bf2f((bf16_t)(raw[1] & 0xffff)) * __expf(ea[2]), bf2f((bf16_t)(raw[1] >> 16)) * __expf(ea[3]));
  o[2] = pack2(bf2f((bf16_t)(raw[2] & 0xffff)) * __expf(eb[0]), bf2f((bf16_t)(raw[2] >> 16)) * __expf(eb[1]));
  o[3] = pack2(bf2f((bf16_t)(raw[3] & 0xffff)) * __expf(eb[2]), bf2f((bf16_t)(raw[3] >> 16)) * __expf(eb[3]));
  return o;
}
DEV f32x4 min80(f32x4 v) { return (f32x4){fminf(v[0], 80.f), fminf(v[1], 80.f), fminf(v[2], 80.f), fminf(v[3], 80.f)}; }

DEV void hg_item(const Params& p, int h, int c, bf16_t* lds) {
  unsigned char* ws = p.ws;
  const bf16_t* HQ = (const bf16_t*)(ws + OFF_HQ);
  const bf16_t* HK = (const bf16_t*)(ws + OFF_HK);
  const float* HCB = (const float*)(ws + OFF_HCB);
  const bf16_t* HVT = (const bf16_t*)(ws + OFF_HVT);
  const bf16_t* STH = (const bf16_t*)(ws + OFF_STH);
  bf16_t* OHG = (bf16_t*)(ws + OFF_OHG);
  constexpr int PS = 136;
  bf16_t* Qp = lds;
  bf16_t* Kp = lds + 128 * PS;
  bf16_t* As = lds + 2 * 128 * PS;
  float* RED = (float*)(lds + 2 * 128 * PS + 256 * PS);
  const int tid = get_tid(), lane = tid & 63, wave = tid >> 6, wm = wave >> 1, wn = wave & 1;
  const int lr = lane & 15, lg = lane >> 4;
  const int t0 = c * 128, colb = h * 128;
  const int lrow = tid >> 4, lc8 = (tid & 15) * 8;
  u32x4 qv[4], kv[4], vv[4], sv[4];
  f32x4 ca[4], cb2[4], ra[3], rb[3];
#pragma unroll
  for (int i = 0; i < 4; i++) {
    const int row = lrow + i * 32;
    const size_t g = (size_t)(t0 + row) * 1024 + colb + lc8;
    qv[i] = *(const u32x4*)(HQ + g);
    kv[i] = *(const u32x4*)(HK + g);
    ca[i] = *(const f32x4*)(HCB + g);
    cb2[i] = *(const f32x4*)(HCB + g + 4);
    vv[i] = *(const u32x4*)(HVT + (size_t)(colb + row) * LT + t0 + lc8);
    sv[i] = *(const u32x4*)(STH + ((size_t)(h * 65 + c) * 128 + row) * 128 + lc8);
  }
#pragma unroll
  for (int I = 1; I < 4; I++) {
    const size_t gr = (size_t)(t0 + 32 * I - 1) * 1024 + colb + lc8;
    ra[I - 1] = *(const f32x4*)(HCB + gr);
    rb[I - 1] = *(const f32x4*)(HCB + gr + 4);
  }
  const f32x4 z4 = (f32x4){0.f, 0.f, 0.f, 0.f};
#pragma unroll
  for (int i = 0; i < 4; i++) {
    const f32x4 fa = i == 0 ? z4 : ra[i == 0 ? 0 : i - 1], fb = i == 0 ? z4 : rb[i == 0 ? 0 : i - 1];
    *(u32x4*)(Qp + (lrow + i * 32) * PS + lc8) = scale8(qv[i], ca[i] - fa, cb2[i] - fb);
  }
#pragma unroll
  for (int I = 0; I < 4; I++) {
    const int nrows = 32 * (I + 1);
    const f32x4 fa = I == 0 ? z4 : ra[I == 0 ? 0 : I - 1], fb = I == 0 ? z4 : rb[I == 0 ? 0 : I - 1];
#pragma unroll
    for (int i = 0; i < 4; i++) {
      if (i <= I) *(u32x4*)(Kp + (lrow + i * 32) * PS + lc8) = scale8(kv[i], min80(fa - ca[i]), min80(fb - cb2[i]));
    }
    __syncthreads();
    if (wave * 16 < nrows) {
      f32x4 a2[2];
      a2[0] = (f32x4){0.f, 0.f, 0.f, 0.f}; a2[1] = a2[0];
#pragma unroll
      for (int ks = 0; ks < 4; ks++) {
        bf16x8 bb = ldfrag(Kp, PS, wave * 16 + lr, ks * 32 + lg * 8);
        bf16x8 a0 = ldfrag(Qp, PS, 32 * I + lr, ks * 32 + lg * 8);
        bf16x8 a1 = ldfrag(Qp, PS, 32 * I + 16 + lr, ks * 32 + lg * 8);
        a2[0] = MFMA(bb, a0, a2[0]);
        a2[1] = MFMA(bb, a1, a2[1]);
      }
#pragma unroll
      for (int i = 0; i < 2; i++) {
        const int q = 32 * I + i * 16 + lr;
        f32x4 v;
#pragma unroll
        for (int r = 0; r < 4; r++) { const int key = wave * 16 + lg * 4 + r; v[r] = (key <= q) ? a2[i][r] : 0.f; }
        *(uint2*)(As + q * PS + wave * 16 + lg * 4) = pack4(v);
      }
    } else {
#pragma unroll
      for (int i = 0; i < 2; i++) {
        const int q = 32 * I + i * 16 + lr;
        *(uint2*)(As + q * PS + wave * 16 + lg * 4) = make_uint2(0u, 0u);
      }
    }
    __syncthreads();
  }
#pragma unroll
  for (int i = 0; i < 4; i++) *(u32x4*)(Kp + (lrow + i * 32) * PS + lc8) = vv[i];
  __syncthreads();
  f32x4 o[2][4];
#pragma unroll
  for (int i = 0; i < 2; i++)
#pragma unroll
    for (int j = 0; j < 4; j++) o[i][j] = (f32x4){0.f, 0.f, 0.f, 0.f};
#pragma unroll
  for (int ks = 0; ks < 4; ks++) {
    bf16x8 a0 = ldfrag(As, PS, wm * 32 + lr, ks * 32 + lg * 8);
    bf16x8 a1 = ldfrag(As, PS, wm * 32 + 16 + lr, ks * 32 + lg * 8);
#pragma unroll
    for (int j = 0; j < 4; j++) {
      bf16x8 bb = ldfrag(Kp, PS, wn * 64 + j * 16 + lr, ks * 32 + lg * 8);
      o[0][j] = MFMA(bb, a0, o[0][j]);
      o[1][j] = MFMA(bb, a1, o[1][j]);
    }
  }
  __syncthreads();
#pragma unroll
  for (int i = 0; i < 4; i++) {
    *(u32x4*)(Qp + (lrow + i * 32) * PS + lc8) = scale8(qv[i], ca[i], cb2[i]);
    *(u32x4*)(Kp + (lrow + i * 32) * PS + lc8) = sv[i];
  }
  __syncthreads();
#pragma unroll
  for (int ks = 0; ks < 4; ks++) {
    bf16x8 a0 = ldfrag(Qp, PS, wm * 32 + lr, ks * 32 + lg * 8);
    bf16x8 a1 = ldfrag(Qp, PS, wm * 32 + 16 + lr, ks * 32 + lg * 8);
#pragma unroll
    for (int j = 0; j < 4; j++) {
      bf16x8 bb = ldfrag(Kp, PS, wn * 64 + j * 16 + lr, ks * 32 + lg * 8);
      o[0][j] = MFMA(bb, a0, o[0][j]);
      o[1][j] = MFMA(bb, a1, o[1][j]);
    }
  }
#pragma unroll
  for (int i = 0; i < 2; i++) {
    float ss = 0.f;
#pragma unroll
    for (int j = 0; j < 4; j++)
#pragma unroll
      for (int r = 0; r < 4; r++) ss += o[i][j][r] * o[i][j][r];
    ss += shfl_xor_l(ss, 16, lane);
    ss += shfl_xor_l(ss, 32, lane);
    if (lg == 0) RED[(wm * 32 + i * 16 + lr) * 2 + wn] = ss;
  }
  __syncthreads();
#pragma unroll
  for (int i = 0; i < 2; i++) {
    const int q = wm * 32 + i * 16 + lr;
    const float rs = rsqrtf((RED[q * 2] + RED[q * 2 + 1]) * (1.f / 128.f) + 1e-6f);
#pragma unroll
    for (int j = 0; j < 4; j++) {
      f32x4 v = o[i][j];
#pragma unroll
      for (int r = 0; r < 4; r++) v[r] *= rs;
      *(uint2*)(OHG + (size_t)(t0 + q) * 1024 + colb + wn * 64 + j * 16 + lg * 4) = pack4(v);
    }
  }
}

DEV void phase_O(const Params& p, int layer, int qidx, unsigned char* ldsraw) {
  bf16_t* lds = (bf16_t*)ldsraw;
  int* ctr = (int*)(p.ws + OFF_CTR) + qidx;
  int* sitem = (int*)(ldsraw + LDS_BYTES - 16);
  const float* lp = p.in[7] + layer * 256;
  float d0 = 0.f, d1 = 0.f;
  for (int i = 0; i < 64; i++) { d0 += lp[i] * lp[64 + i]; d1 += lp[128 + i] * lp[192 + i]; }
  int ly = layer; asm volatile("" : "+s"(ly));
  const float li = (ly == 0) ? 0.2f : 0.35550906759f;
  const float lam = __uint_as_float(__builtin_amdgcn_readfirstlane(__float_as_uint(__expf(d0) - __expf(d1) + li)));
  const int tid0 = get_tid();
  for (;;) {
    __syncthreads();
    if (tid0 == 0) *sitem = atomicAdd(ctr, 1);
    __syncthreads();
    const int item = __builtin_amdgcn_readfirstlane(*sitem);
    if (item >= 1300) break;
    if (item < 520) attn_item(p, layer, item & 7, 64 - (item >> 3), lam, lds);
    else if (item < 780) ret_item(p, (item - 520) & 3, (item - 520) >> 2, lds);
    else hg_item(p, (item - 780) & 7, (item - 780) >> 3, lds);
  }
}

DEV void phase_G(const Params& p, int b, unsigned char* ldsraw) {
  unsigned char* ws = p.ws;
  bf16_t* lds = (bf16_t*)ldsraw;
  const bf16_t* HN = (const bf16_t*)(ws + OFF_HN) + (size_t)b * LT * 1024;
  const bf16_t* WIN = (const bf16_t*)(ws + OFF_WIN);
  for (int item = vblock(); item < 33 * 20; item += gridDim.x) {
    int nt, mt; tile_map(item, 33, 4, mt, nt);
    int n0, cb; bf16_t* dst; int ld; bool gate;
    if (nt < 4) { n0 = 2048 + nt * 256; cb = nt * 256; dst = (bf16_t*)(ws + OFF_ORET); ld = 1024; gate = true; }
    else if (nt < 8) { n0 = 6144 + (nt - 4) * 256; cb = (nt - 4) * 256; dst = (bf16_t*)(ws + OFF_OHG); ld = 1024; gate = true; }
    else { n0 = 10240 + (nt - 8) * 256; cb = (nt - 8) * 256; dst = (bf16_t*)(ws + OFF_G); ld = 3072; gate = false; }
    f32x4 acc[4][8];
#pragma unroll
    for (int i = 0; i < 4; i++)
#pragma unroll
      for (int j = 0; j < 8; j++) acc[i][j] = (f32x4){0.f, 0.f, 0.f, 0.f};
    gemm256_acc<256>(acc, HN + (size_t)mt * 256 * 1024, 1024, LT - mt * 256, WIN + (size_t)n0 * 1024, 1024, 1024, lds);
    const int tid = get_tid(), lane = tid & 63, wave = tid >> 6, wm = wave >> 1, wn = wave & 1; const int lr = lane & 15, lg = lane >> 4;
#pragma unroll
    for (int i = 0; i < 4; i++) {
      const int t = mt * 256 + wm * 64 + i * 16 + lr;
      if (t < LT) {
#pragma unroll
        for (int j = 0; j < 8; j++) {
          bf16_t* d = dst + (size_t)t * ld + cb + wn * 128 + j * 16 + lg * 4;
          f32x4 v;
          if (gate) {
            uint2 ov = *(const uint2*)d;
            v[0] = bf2f((bf16_t)(ov.x & 0xffff)) * silu_f(acc[i][j][0]);
            v[1] = bf2f((bf16_t)(ov.x >> 16)) * silu_f(acc[i][j][1]);
            v[2] = bf2f((bf16_t)(ov.y & 0xffff)) * silu_f(acc[i][j][2]);
            v[3] = bf2f((bf16_t)(ov.y >> 16)) * silu_f(acc[i][j][3]);
          } else {
#pragma unroll
            for (int r = 0; r < 4; r++) v[r] = sigmoid_f(acc[i][j][r]);
          }
          *(uint2*)d = pack4(v);
        }
      }
    }
  }
}

DEV f32x4 mini_gemm16(const bf16_t* __restrict__ A16, int lda, const bf16_t* __restrict__ Bt16, int ldb, int k0, int klen, int lane) {
  const int lr = lane & 15, lg = lane >> 4;
  const bf16_t* pa = A16 + (size_t)lr * lda + k0 + lg * 8;
  const bf16_t* pb = Bt16 + (size_t)lr * ldb + k0 + lg * 8;
  f32x4 acc = (f32x4){0.f, 0.f, 0.f, 0.f};
#pragma unroll 4
  for (int k = 0; k < klen; k += 32) {
    bf16x8 a = *(const bf16x8*)(pa + k);
    bf16x8 b = *(const bf16x8*)(pb + k);
    acc = MFMA(b, a, acc);
  }
  return acc;
}

DEV void phase_Y(const Params& p, unsigned char* ldsraw) {
  unsigned char* ws = p.ws;
  bf16_t* lds = (bf16_t*)ldsraw;
  const bf16_t* WB = (const bf16_t*)(ws + OFF_WB);
  const bf16_t* G = (const bf16_t*)(ws + OFF_G);
  bf16_t* Y = (bf16_t*)(ws + OFF_Y);
  for (int item = vblock(); item < 32 * 8 + 64; item += gridDim.x) {
    if (item >= 256) {
      const int lane = get_tid() & 63, wave = get_tid() >> 6, lr = lane & 15, lg = lane >> 4;
      const int n0 = (item - 256) * 16;
      f32x4* red = (f32x4*)ldsraw;
      __syncthreads();
#pragma unroll 1
      for (int br = 0; br < 3; br++) {
        const bf16_t* Ab = (const bf16_t*)(ws + (br == 0 ? OFF_ORET : (br == 1 ? OFF_OHG : OFF_ODA))) + (size_t)112 * 1024;
        red[(br * 8 + wave) * 64 + lane] = mini_gemm16(Ab, 1024, WB + ((size_t)br * 1024 + n0) * 1024, 1024, wave * 128, 128, lane);
      }
      __syncthreads();
      if (wave == 0) {
        f32x4 y = (f32x4){0.f, 0.f, 0.f, 0.f};
#pragma unroll
        for (int br = 0; br < 3; br++) {
          f32x4 a = red[(br * 8) * 64 + lane];
#pragma unroll
          for (int w = 1; w < 8; w++) a += red[(br * 8 + w) * 64 + lane];
          uint2 gv = *(const uint2*)(G + (size_t)(112 + lr) * 3072 + br * 1024 + n0 + lg * 4);
          y[0] += bf2f((bf16_t)(gv.x & 0xffff)) * a[0];
          y[1] += bf2f((bf16_t)(gv.x >> 16)) * a[1];
          y[2] += bf2f((bf16_t)(gv.y & 0xffff)) * a[2];
          y[3] += bf2f((bf16_t)(gv.y >> 16)) * a[3];
        }
        *(uint2*)(Y + (size_t)(112 + lr) * 1024 + n0 + lg * 4) = pack4(y);
      }
      continue;
    }
    int nt, mt; tile_map(item, 32, 4, mt, nt);
    const int row0 = 128 + mt * 256;
    f32x4 y[4][4];
#pragma unroll
    for (int i = 0; i < 4; i++)
#pragma unroll
      for (int j = 0; j < 4; j++) y[i][j] = (f32x4){0.f, 0.f, 0.f, 0.f};
#pragma unroll 1
    for (int br = 0; br < 3; br++) {
      const bf16_t* Ab = (const bf16_t*)(ws + (br == 0 ? OFF_ORET : (br == 1 ? OFF_OHG : OFF_ODA))) + (size_t)row0 * 1024;
      f32x4 acc[4][4];
#pragma unroll
      for (int i = 0; i < 4; i++)
#pragma unroll
        for (int j = 0; j < 4; j++) acc[i][j] = (f32x4){0.f, 0.f, 0.f, 0.f};
      gemm256_acc<128>(acc, Ab, 1024, 256, WB + ((size_t)br * 1024 + nt * 128) * 1024, 1024, 1024, lds);
      const int tid = get_tid(), lane = tid & 63, wave = tid >> 6, wm = wave >> 1, wn = wave & 1; const int lr = lane & 15, lg = lane >> 4;
#pragma unroll
      for (int i = 0; i < 4; i++) {
        const int t = row0 + wm * 64 + i * 16 + lr;
#pragma unroll
        for (int j = 0; j < 4; j++) {
          uint2 gv = *(const uint2*)(G + (size_t)t * 3072 + br * 1024 + nt * 128 + wn * 64 + j * 16 + lg * 4);
          y[i][j][0] += bf2f((bf16_t)(gv.x & 0xffff)) * acc[i][j][0];
          y[i][j][1] += bf2f((bf16_t)(gv.x >> 16)) * acc[i][j][1];
          y[i][j][2] += bf2f((bf16_t)(gv.y & 0xffff)) * acc[i][j][2];
          y[i][j][3] += bf2f((bf16_t)(gv.y >> 16)) * acc[i][j][3];
        }
      }
    }
    const int tid = get_tid(), lane = tid & 63, wave = tid >> 6, wm = wave >> 1, wn = wave & 1; const int lr = lane & 15, lg = lane >> 4;
#pragma unroll
    for (int i = 0; i < 4; i++) {
      const int t = row0 + wm * 64 + i * 16 + lr;
#pragma unroll
      for (int j = 0; j < 4; j++)
        *(uint2*)(Y + (size_t)t * 1024 + nt * 128 + wn * 64 + j * 16 + lg * 4) = pack4(y[i][j]);
    }
  }
}

DEV void phase_resid(const Params& p, int b, const bf16_t* A, int K, const bf16_t* Wt, unsigned char* ldsraw) {
  bf16_t* lds = (bf16_t*)ldsraw;
  for (int item = vblock(); item < 32 * 8 + 64; item += gridDim.x) {
    if (item >= 256) {
      const int lane = get_tid() & 63, wave = get_tid() >> 6, lr = lane & 15, lg = lane >> 4;
      const int n0 = (item - 256) * 16;
      f32x4* red = (f32x4*)ldsraw;
      const int ks = K >> 3;
      __syncthreads();
      red[wave * 64 + lane] = mini_gemm16(A + (size_t)112 * K, K, Wt + (size_t)n0 * K, K, wave * ks, ks, lane);
      __syncthreads();
      if (wave == 0) {
        f32x4 a = red[lane];
#pragma unroll
        for (int w = 1; w < 8; w++) a += red[w * 64 + lane];
        float4* d = (float4*)(hrow(p, b, 112 + lr) + n0 + lg * 4);
        float4 v = *d;
        v.x += a[0]; v.y += a[1]; v.z += a[2]; v.w += a[3];
        *d = v;
      }
      continue;
    }
    int nt, mt; tile_map(item, 32, 4, mt, nt);
    const int row0 = 128 + mt * 256;
    f32x4 acc[4][4];
#pragma unroll
    for (int i = 0; i < 4; i++)
#pragma unroll
      for (int j = 0; j < 4; j++) acc[i][j] = (f32x4){0.f, 0.f, 0.f, 0.f};
    gemm256_acc<128>(acc, A + (size_t)row0 * K, K, 256, Wt + (size_t)nt * 128 * K, K, K, lds);
    const int tid = get_tid(), lane = tid & 63, wave = tid >> 6, wm = wave >> 1, wn = wave & 1; const int lr = lane & 15, lg = lane >> 4;
#pragma unroll
    for (int i = 0; i < 4; i++) {
      const int t = row0 + wm * 64 + i * 16 + lr;
#pragma unroll
      for (int j = 0; j < 4; j++) {
        float4* d = (float4*)(hrow(p, b, t) + nt * 128 + wn * 64 + j * 16 + lg * 4);
        float4 v = *d;
        v.x += acc[i][j][0]; v.y += acc[i][j][1]; v.z += acc[i][j][2]; v.w += acc[i][j][3];
        *d = v;
      }
    }
  }
}

DEV void phase_F1(const Params& p, int b, unsigned char* ldsraw) {
  unsigned char* ws = p.ws;
  bf16_t* lds = (bf16_t*)ldsraw;
  const bf16_t* HN = (const bf16_t*)(ws + OFF_HN) + (size_t)b * LT * 1024;
  const bf16_t* WFI = (const bf16_t*)(ws + OFF_WFI);
  bf16_t* U = (bf16_t*)(ws + OFF_U);
  for (int item = vblock(); item < 33 * 22; item += gridDim.x) {
    int nt, mt; tile_map(item, 33, 2, mt, nt);
    f32x4 acc[4][8];
#pragma unroll
    for (int i = 0; i < 4; i++)
#pragma unroll
      for (int j = 0; j < 8; j++) acc[i][j] = (f32x4){0.f, 0.f, 0.f, 0.f};
    gemm256_acc<256>(acc, HN + (size_t)mt * 256 * 1024, 1024, LT - mt * 256, WFI + (size_t)nt * 256 * 1024, 1024, 1024, lds);
    const int tid = get_tid(), lane = tid & 63, wave = tid >> 6, wm = wave >> 1, wn = wave & 1; const int lr = lane & 15, lg = lane >> 4;
#pragma unroll
    for (int i = 0; i < 4; i++) {
      const int t = mt * 256 + wm * 64 + i * 16 + lr;
      if (t < LT) {
        const float vm = (t >= 112) ? 1.f : 0.f;
#pragma unroll
        for (int j = 0; j < 8; j++) {
          f32x4 v = acc[i][j];
#pragma unroll
          for (int r = 0; r < 4; r++) v[r] *= vm;
          *(uint2*)(U + (size_t)t * 5632 + nt * 256 + wn * 128 + j * 16 + lg * 4) = pack4(v);
        }
      }
    }
  }
}

DEV void unpack8(const u32x4 v, float (&f)[8]) {
#pragma unroll
  for (int k = 0; k < 4; k++) { f[2 * k] = bf2f((bf16_t)(v[k] & 0xffff)); f[2 * k + 1] = bf2f((bf16_t)(v[k] >> 16)); }
}
DEV void phase_conv(const Params& p, int layer) {
  unsigned char* ws = p.ws;
  const bf16_t* U = (const bf16_t*)(ws + OFF_U);
  bf16_t* GF = (bf16_t*)(ws + OFF_GF);
  const float* cw = p.in[11] + (size_t)layer * 3 * 5632;
  const float* cbias = p.in[12] + (size_t)layer * 5632;
  for (int idx = get_bid() * NTHR + get_tid(); idx < (LT / 8) * 352; idx += gridDim.x * NTHR) {
    const int tb = idx / 352, c8 = (idx - tb * 352) * 8;
    const int t0 = tb * 8;
    float wg[3][8], wv[3][8], bg[8], bv[8];
#pragma unroll
    for (int k = 0; k < 8; k++) {
      bg[k] = cbias[c8 + k]; bv[k] = cbias[2816 + c8 + k];
#pragma unroll
      for (int j = 0; j < 3; j++) { wg[j][k] = cw[j * 5632 + c8 + k]; wv[j][k] = cw[j * 5632 + 2816 + c8 + k]; }
    }
    float g0[8], g1[8], v0[8], v1[8];
    if (t0 >= 2) {
      unpack8(*(const u32x4*)(U + (size_t)(t0 - 2) * 5632 + c8), g0);
      unpack8(*(const u32x4*)(U + (size_t)(t0 - 2) * 5632 + 2816 + c8), v0);
      unpack8(*(const u32x4*)(U + (size_t)(t0 - 1) * 5632 + c8), g1);
      unpack8(*(const u32x4*)(U + (size_t)(t0 - 1) * 5632 + 2816 + c8), v1);
    } else {
#pragma unroll
      for (int k = 0; k < 8; k++) { g0[k] = 0.f; g1[k] = 0.f; v0[k] = 0.f; v1[k] = 0.f; }
    }
#pragma unroll
    for (int tt = 0; tt < 8; tt++) {
      float g2[8], v2[8];
      unpack8(*(const u32x4*)(U + (size_t)(t0 + tt) * 5632 + c8), g2);
      unpack8(*(const u32x4*)(U + (size_t)(t0 + tt) * 5632 + 2816 + c8), v2);
      float og[8];
#pragma unroll
      for (int k = 0; k < 8; k++) {
        const float gg = bg[k] + wg[0][k] * g0[k] + wg[1][k] * g1[k] + wg[2][k] * g2[k];
        const float vv = bv[k] + wv[0][k] * v0[k] + wv[1][k] * v1[k] + wv[2][k] * v2[k];
        og[k] = silu_f(gg) * vv;
        g0[k] = g1[k]; g1[k] = g2[k]; v0[k] = v1[k]; v1[k] = v2[k];
      }
      u32x4 o;
      o[0] = pack2(og[0], og[1]); o[1] = pack2(og[2], og[3]); o[2] = pack2(og[4], og[5]); o[3] = pack2(og[6], og[7]);
      *(u32x4*)(GF + (size_t)(t0 + tt) * 2816 + c8) = o;
    }
  }
}

#define XB_TMO      128
#define XB_XCNT(j)  (256  + 64 * (j))
#define XB_XSUB(j)  (1280 + 64 * (j))
#define XB_XGEN(j)  (2304 + 64 * (j))
#define XB_TOP      3328
#define XB_TOPGEN   3392
#define XB_SPIN_CAP (1u << 18)
#define LAS __attribute__((address_space(3)))
DEV unsigned xb_ld(unsigned* p) { return __hip_atomic_load(p, __ATOMIC_RELAXED, __HIP_MEMORY_SCOPE_AGENT); }
DEV unsigned xb_add(unsigned* p, unsigned v) { return __hip_atomic_fetch_add(p, v, __ATOMIC_RELAXED, __HIP_MEMORY_SCOPE_AGENT); }
DEV unsigned xb_xcc_id() { return (unsigned)__builtin_amdgcn_s_getreg((3 << 11) | 20) & 0xFu; }
#define XB_SPIN(cond, bar) do { unsigned _sp = 0; while (cond) { __builtin_amdgcn_s_sleep(1); \
    if ((++_sp & 255u) == 0u) { if (xb_ld(&(bar)[XB_TMO])) break; if (_sp > XB_SPIN_CAP) { atomicAdd(&(bar)[XB_TMO], 1u); break; } } } } while (0)
struct XcdBarrier { unsigned* bar; unsigned x; volatile LAS unsigned* st; };
DEV XcdBarrier xcd_barrier_post(unsigned* bar, volatile LAS unsigned* st) {
  XcdBarrier b; b.bar = bar; b.x = xb_xcc_id(); b.st = st;
  if (threadIdx.x == 0) (void)xb_add(&bar[XB_XCNT(b.x)], 1u);
  return b;
}
DEV void xcd_barrier_complete(unsigned* bar, unsigned x, unsigned& nloc, unsigned& nx) {
  const unsigned G = gridDim.x;
  unsigned sum, cnt, mine, sp = 0u;
  for (;;) {
    sum = 0u; cnt = 0u; mine = 0u;
#pragma unroll
    for (unsigned j = 0; j < 16; ++j) { const unsigned c = xb_ld(&bar[XB_XCNT(j)]); sum += c; cnt += (c > 0u) ? 1u : 0u; mine = (j == x) ? c : mine; }
    if (sum == G) break;
    __builtin_amdgcn_s_sleep(1);
    if ((++sp & 255u) == 0u) { if (xb_ld(&bar[XB_TMO])) break; if (sp > XB_SPIN_CAP) { atomicAdd(&bar[XB_TMO], 1u); break; } }
  }
  nloc = mine > 0u ? mine : 1u; nx = cnt > 0u ? cnt : 1u;
}
DEV void xcd_barrier(const XcdBarrier& b) {
  asm volatile("s_waitcnt vmcnt(0)" ::: "memory");
  __syncthreads();
  if (threadIdx.x == 0) {
    unsigned* bar = b.bar;
    __builtin_amdgcn_s_waitcnt(0);
    unsigned nloc = b.st[0], nx = b.st[1];
    if (nloc == 0u) { xcd_barrier_complete(bar, b.x, nloc, nx); b.st[0] = nloc; b.st[1] = nx; }
    const unsigned old = xb_add(&bar[XB_XSUB(b.x)], 1u);
    const unsigned gen = old / nloc;
    if (old + 1u == (gen + 1u) * nloc) {
      __builtin_amdgcn_fence(__ATOMIC_RELEASE, "agent");
      asm volatile("s_waitcnt vmcnt(0)" ::: "memory");
      const unsigned og = xb_add(&bar[XB_TOP], 1u);
      const unsigned tg = og / nx;
      if (og + 1u == (tg + 1u) * nx) xb_add(&bar[XB_TOPGEN], 1u);
      else XB_SPIN(xb_ld(&bar[XB_TOPGEN]) == tg, bar);
      __builtin_amdgcn_fence(__ATOMIC_ACQUIRE, "agent");
      xb_add(&bar[XB_XGEN(b.x)], 1u);
      asm volatile("s_waitcnt vmcnt(0)" ::: "memory");
    } else {
      XB_SPIN(xb_ld(&bar[XB_XGEN(b.x)]) == gen, bar);
      __builtin_amdgcn_fence(__ATOMIC_ACQUIRE, "agent");
      asm volatile("s_waitcnt vmcnt(0)" ::: "memory");
    }
  }
  __syncthreads();
}

__global__ void __launch_bounds__(NTHR) fwd_megakernel(Params p) {
  extern __shared__ __attribute__((aligned(16))) unsigned char lds[];
  cg::grid_group grid = cg::this_grid();
  volatile LAS unsigned* xst = (volatile LAS unsigned*)(lds + LDS_BYTES - 12);
  if (threadIdx.x == 0) { xst[0] = 0u; xst[1] = 0u; }
  __syncthreads();
  (void)xcd_barrier_post((unsigned*)(p.ws + OFF_XBAR), xst);
#define GRID_SYNC() do { XcdBarrier xb_; xb_.bar = (unsigned*)(p.ws + OFF_XBAR); xb_.x = xb_xcc_id(); \
    xb_.st = (volatile LAS unsigned*)(lds + LDS_BYTES - 12); xcd_barrier(xb_); } while (0)
  grid.sync();
  unsigned char* ws = p.ws;
  phase_init(p);
  phase_convert(p, 0, lds);
  GRID_SYNC();
  for (int layer = 0; layer < 2; layer++) {
    if (layer == 1) {
      phase_convert(p, 1, lds);
#pragma unroll 1
      for (int bb = 0; bb < 2; bb++)
        phase_norm(p, bb, p.in[2] + 1024, (bf16_t*)(ws + OFF_HN) + (size_t)bb * LT * 1024);
      GRID_SYNC();
    }
    for (int b = 0; b < 2; b++) {
      bf16_t* HNb = (bf16_t*)(ws + OFF_HN) + (size_t)b * LT * 1024;
      phase_projA(p, layer, b, lds);
      GRID_SYNC();
      phase_U(p, lds);
      GRID_SYNC();
      phase_scan(p);
      GRID_SYNC();
      phase_O(p, layer, layer * 2 + b, lds);
      GRID_SYNC();
      phase_G(p, b, lds);
      GRID_SYNC();
      phase_Y(p, lds);
      GRID_SYNC();
      phase_resid(p, b, (const bf16_t*)(ws + OFF_Y), 1024, (const bf16_t*)(ws + OFF_WO), lds);
      GRID_SYNC();
      phase_norm(p, b, p.in[9] + layer * 1024, HNb);
      GRID_SYNC();
      phase_F1(p, b, lds);
      GRID_SYNC();
      phase_conv(p, layer);
      GRID_SYNC();
      phase_resid(p, b, (const bf16_t*)(ws + OFF_GF), DFF, (const bf16_t*)(ws + OFF_WFO), lds);
      GRID_SYNC();
    }
  }
  phase_final(p);
}

extern "C" void kernel_launch(void* const* d_in, const int* in_sizes, int n_in, void* d_out, int out_size,
                              void* d_ws, size_t ws_size, hipStream_t stream) {
  static int grid_blocks = 0;
  if (grid_blocks == 0) {
    if (n_in != 15 || ws_size < OFF_END) {
      fprintf(stderr, "kernel_launch: need 15 inputs and %zu bytes of workspace, got %d and %zu\n", (size_t)OFF_END, n_in, ws_size);
      grid_blocks = -1; return;
    }
    int dev = 0, cus = 0, per_cu = 0;
    hipGetDevice(&dev);
    hipDeviceGetAttribute(&cus, hipDeviceAttributeMultiprocessorCount, dev);
    if (hipFuncSetAttribute((const void*)fwd_megakernel, hipFuncAttributeMaxDynamicSharedMemorySize, LDS_BYTES) != hipSuccess) {
      fprintf(stderr, "kernel_launch: hipFuncSetAttribute failed\n"); grid_blocks = -1; return;
    }
    hipOccupancyMaxActiveBlocksPerMultiprocessor(&per_cu, (const void*)fwd_megakernel, NTHR, LDS_BYTES);
    if (per_cu < 1) per_cu = 1;
    if (per_cu > 1) per_cu = 1;
    grid_blocks = cus * per_cu;
  }
  if (grid_blocks < 0) return;
  hipMemsetAsync((char*)d_ws + OFF_CTR, 0, 256 + XBAR_BYTES, stream);
  Params p{};
  for (int i = 0; i < 15; i++) p.in[i] = (const float*)d_in[i];
  p.out = (float*)d_out;
  p.ws = (unsigned char*)d_ws;
  void* args[] = {&p};
  hipError_t e = hipLaunchCooperativeKernel((const void*)fwd_megakernel, dim3(grid_blocks), dim3(NTHR), args, LDS_BYTES, stream);
  if (e != hipSuccess) fprintf(stderr, "cooperative launch failed: %s (grid %d)\n", hipGetErrorString(e), grid_blocks);
}
```

```cpp
#include <hip/hip_runtime.h>
#include <hip/hip_cooperative_groups.h>
#include <cstdio>
#include <cstdint>
namespace cg = cooperative_groups;

typedef unsigned short bf16_t;
typedef __attribute__((ext_vector_type(8))) short bf16x8;
typedef __attribute__((ext_vector_type(4))) short bf16x4;
typedef __attribute__((ext_vector_type(4))) float f32x4;
typedef __attribute__((ext_vector_type(4))) unsigned u32x4;

#define DEV __device__ __forceinline__
#define MFMA(a, b, c) __builtin_amdgcn_mfma_f32_16x16x32_bf16(a, b, c, 0, 0, 0)

constexpr int LT = 8320;
constexpr int NCH = 65;
constexpr int NTHR = 512;
constexpr int LDS_BYTES = 144 * 1024;
constexpr int INW = 13312;
constexpr int DFF = 2816;

constexpr size_t SZ_ACT = (size_t)LT * 1024 * 2;
constexpr size_t OFF_WIN = 0;
constexpr size_t OFF_WB = OFF_WIN + (size_t)INW * 1024 * 2;
constexpr size_t OFF_WO = OFF_WB + (size_t)3 * 1024 * 1024 * 2;
constexpr size_t OFF_WFI = OFF_WO + (size_t)1024 * 1024 * 2;
constexpr size_t OFF_WFO = OFF_WFI + (size_t)5632 * 1024 * 2;
constexpr size_t OFF_H = OFF_WFO + (size_t)1024 * 2816 * 2;
constexpr size_t OFF_HN = OFF_H + (size_t)2 * 128 * 1024 * 4;
constexpr size_t OFF_R128 = OFF_HN + 2 * SZ_ACT;
constexpr size_t OFF_R64 = OFF_R128 + (size_t)LT * 64 * 8;
constexpr size_t OFF_CTR = OFF_R64 + (size_t)LT * 32 * 8;
constexpr size_t OFF_XBAR = OFF_CTR + 256;
constexpr size_t XBAR_BYTES = 3456 * 4;
constexpr size_t OFF_ARENA = OFF_XBAR + XBAR_BYTES;
constexpr size_t OFF_RQ = OFF_ARENA;
constexpr size_t OFF_RK = OFF_RQ + SZ_ACT / 2;
constexpr size_t OFF_RKT = OFF_RK + SZ_ACT / 2;
constexpr size_t OFF_RVT = OFF_RKT + SZ_ACT / 2;
constexpr size_t OFF_HQ = OFF_RVT + SZ_ACT;
constexpr size_t OFF_HK = OFF_HQ + SZ_ACT;
constexpr size_t OFF_HCB = OFF_HK + SZ_ACT;
constexpr size_t OFF_HKET = OFF_HCB + 2 * SZ_ACT;
constexpr size_t OFF_HVT = OFF_HKET + SZ_ACT;
constexpr size_t OFF_DQ = OFF_HVT + SZ_ACT;
constexpr size_t OFF_DK = OFF_DQ + SZ_ACT;
constexpr size_t OFF_DVT = OFF_DK + SZ_ACT;
constexpr size_t OFF_ORET = OFF_DVT + SZ_ACT;
constexpr size_t OFF_OHG = OFF_ORET + SZ_ACT;
constexpr size_t OFF_STR = OFF_OHG + SZ_ACT;
constexpr size_t OFF_STH = OFF_STR + SZ_ACT;
constexpr size_t OFF_HDEC = OFF_STH + SZ_ACT;
constexpr size_t OFF_END = OFF_HDEC + (size_t)65 * 1024 * 4;
constexpr size_t OFF_G = OFF_RQ;
constexpr size_t OFF_Y = OFF_HK;
constexpr size_t OFF_ODA = OFF_HKET;
constexpr size_t OFF_U = OFF_ARENA;
constexpr size_t OFF_GF = OFF_U + (size_t)LT * 5632 * 2;

struct Params {
  const float* in[15];
  float* out;
  unsigned char* ws;
};

DEV int get_tid() { int t = threadIdx.x; asm volatile("" : "+v"(t)); return t; }
DEV int get_bid() { int b = blockIdx.x; asm volatile("" : "+s"(b)); return b; }
DEV float shfl_xor_l(float v, int m, int lane) { return __int_as_float(__builtin_amdgcn_ds_bpermute((lane ^ m) << 2, __float_as_int(v))); }
DEV float shfl_l(float v, int srclane) { return __int_as_float(__builtin_amdgcn_ds_bpermute(srclane << 2, __float_as_int(v))); }
DEV float* hrow(const Params& p, int b, int t) {
  return (t < 128) ? (float*)(p.ws + OFF_H) + (size_t)(b * 128 + t) * 1024 : p.out + ((size_t)b * 8192 + (t - 128)) * 1024;
}
typedef __bf16 hwbf16x2 __attribute__((ext_vector_type(2)));
typedef float hwf32x2 __attribute__((ext_vector_type(2)));
DEV unsigned pack2(float a, float b) {
  hwf32x2 f = {a, b};
  hwbf16x2 h = __builtin_convertvector(f, hwbf16x2);
  return __builtin_bit_cast(unsigned, h);
}
DEV bf16_t f2bf(float f) { return (bf16_t)(pack2(f, f) & 0xffffu); }
DEV float bf2f(bf16_t h) { return __uint_as_float(((unsigned)h) << 16); }
DEV uint2 pack4(f32x4 v) { uint2 r; r.x = pack2(v[0], v[1]); r.y = pack2(v[2], v[3]); return r; }
DEV float silu_f(float x) { return x / (1.f + __expf(-x)); }
DEV float sigmoid_f(float x) { return 1.f / (1.f + __expf(-x)); }
DEV float ex2(float x) { return __builtin_amdgcn_exp2f(x); }
DEV bf16x8 ldfrag(const bf16_t* base, int stride, int row, int k) {
  return *(const bf16x8*)(base + row * stride + k);
}

template <int BN, bool TRANS>
DEV void gemm_compute(f32x4 (&acc)[2][BN / 32], const bf16_t* as, const bf16_t* bs, int sw0, int sw1) {
  constexpr int NJ = BN / 32, LS = 64;
#pragma unroll
  for (int ks = 0; ks < 2; ks++) {
    const int sw = ks == 0 ? sw0 : sw1;
    bf16x8 a0 = *(const bf16x8*)(as + sw);
    bf16x8 a1 = *(const bf16x8*)(as + 16 * LS + sw);
#pragma unroll
    for (int j = 0; j < NJ; j++) {
      bf16x8 bb = *(const bf16x8*)(bs + j * 16 * LS + sw);
      if (TRANS) {
        acc[0][j] = MFMA(a0, bb, acc[0][j]);
        acc[1][j] = MFMA(a1, bb, acc[1][j]);
      } else {
        acc[0][j] = MFMA(bb, a0, acc[0][j]);
        acc[1][j] = MFMA(bb, a1, acc[1][j]);
      }
    }
  }
}

template <int BN, bool TRANS>
DEV void gemm_acc(f32x4 (&acc)[2][BN / 32], const bf16_t* __restrict__ A, int lda,
                  const bf16_t* __restrict__ Bt, int ldb, int K, bf16_t* lds) {
  constexpr int LS = 64, A_SZ = 128 * LS, B_SZ = BN * LS, NB = BN / 64;
  const int tid = get_tid(), lane = tid & 63, wave = tid >> 6, wm = wave >> 1, wn = wave & 1;
  const int lr = lane & 15, lg = lane >> 4;
  bf16_t* As = lds;
  bf16_t* Bs = lds + 2 * A_SZ;
  const int crow = tid >> 3, ckc = (tid & 7) * 8;
  const int cks = ((tid & 7) ^ ((crow >> 1) & 7)) * 8;
  const int sw0 = (lg ^ ((lr >> 1) & 7)) * 8, sw1 = sw0 ^ 32;
  const bf16_t* ga = A + (size_t)crow * lda + ckc;
  const bf16_t* gb = Bt + (size_t)crow * ldb + ckc;
  u32x4 ra0, ra1, rb0, rb1, rb2, rb3;
#define GLOAD(k0)                                                        \
  ra0 = *(const u32x4*)(ga + (k0));                                      \
  ra1 = *(const u32x4*)(ga + (size_t)64 * lda + (k0));                   \
  rb0 = *(const u32x4*)(gb + (k0));                                      \
  rb1 = *(const u32x4*)(gb + (size_t)64 * ldb + (k0));                   \
  if (NB == 4) {                                                         \
    rb2 = *(const u32x4*)(gb + (size_t)128 * ldb + (k0));                \
    rb3 = *(const u32x4*)(gb + (size_t)192 * ldb + (k0));                \
  }
#define LSTORE(buf)                                                      \
  *(u32x4*)(As + (buf) * A_SZ + crow * LS + cks) = ra0;                  \
  *(u32x4*)(As + (buf) * A_SZ + (crow + 64) * LS + cks) = ra1;           \
  *(u32x4*)(Bs + (buf) * B_SZ + crow * LS + cks) = rb0;                  \
  *(u32x4*)(Bs + (buf) * B_SZ + (crow + 64) * LS + cks) = rb1;           \
  if (NB == 4) {                                                         \
    *(u32x4*)(Bs + (buf) * B_SZ + (crow + 128) * LS + cks) = rb2;        \
    *(u32x4*)(Bs + (buf) * B_SZ + (crow + 192) * LS + cks) = rb3;        \
  }
  const int nk = K / 64;
  const int aoff = (wm * 32 + lr) * LS;
  const int boff = (wn * (BN / 2) + lr) * LS;
  GLOAD(0)
  __syncthreads();
  LSTORE(0)
  GLOAD(64)
  __syncthreads();
  for (int kt = 0; kt < nk; kt++) {
    const int cur = kt & 1;
    LSTORE(cur ^ 1)
    {
      const int kn = (kt + 2 < nk) ? kt + 2 : nk - 1;
      GLOAD(kn * 64)
    }
    __builtin_amdgcn_sched_barrier(0);
    gemm_compute<BN, TRANS>(acc, As + cur * A_SZ + aoff, Bs + cur * B_SZ + boff, sw0, sw1);
    __syncthreads();
  }
#undef GLOAD
#undef LSTORE
}

template <int BN, bool TRANS>
DEV void gemm256_kstep(f32x4 (&acc)[4][BN / 32], const bf16_t* as, const bf16_t* bs, int sw) {
  constexpr int LS = 64, NJ = BN / 32;
  bf16x8 a[4];
#pragma unroll
  for (int i = 0; i < 4; i++) a[i] = *(const bf16x8*)(as + i * 16 * LS + sw);
#pragma unroll
  for (int j = 0; j < NJ; j++) {
    bf16x8 bb = *(const bf16x8*)(bs + j * 16 * LS + sw);
#pragma unroll
    for (int i = 0; i < 4; i++) acc[i][j] = TRANS ? MFMA(a[i], bb, acc[i][j]) : MFMA(bb, a[i], acc[i][j]);
  }
}

template <int BN, bool TRANS>
DEV void gemm256_compute(f32x4 (&acc)[4][BN / 32], const bf16_t* as, const bf16_t* bs, int sw0, int sw1) {
  constexpr int LS = 64, NJ = BN / 32;
#pragma unroll
  for (int ks = 0; ks < 2; ks++) {
    const int sw = ks == 0 ? sw0 : sw1;
    bf16x8 a[4];
#pragma unroll
    for (int i = 0; i < 4; i++) a[i] = *(const bf16x8*)(as + i * 16 * LS + sw);
#pragma unroll
    for (int j = 0; j < NJ; j++) {
      bf16x8 bb = *(const bf16x8*)(bs + j * 16 * LS + sw);
#pragma unroll
      for (int i = 0; i < 4; i++) acc[i][j] = TRANS ? MFMA(a[i], bb, acc[i][j]) : MFMA(bb, a[i], acc[i][j]);
    }
  }
}

template <int BN, bool TRANS = false>
DEV void gemm256_acc(f32x4 (&acc)[4][BN / 32], const bf16_t* __restrict__ A, int lda, int m_valid,
                     const bf16_t* __restrict__ Bt, int ldb, int K, bf16_t* lds) {
  constexpr int LS = 64, A_SZ = 256 * LS, B_SZ = BN * LS, NB = BN / 64;
  const int tid = get_tid(), lane = tid & 63, wave = tid >> 6, wm = wave >> 1, wn = wave & 1;
  const int lr = lane & 15, lg = lane >> 4;
  bf16_t* As = lds;
  bf16_t* Bs = lds + 2 * A_SZ;
  const int crow = tid >> 3, ckc = (tid & 7) * 8;
  const int cks = ((tid & 7) ^ ((crow >> 1) & 7)) * 8;
  const int sw0 = (lg ^ ((lr >> 1) & 7)) * 8, sw1 = sw0 ^ 32;
  const bf16_t* ga0 = A + (size_t)min(crow, m_valid - 1) * lda + ckc;
  const bf16_t* ga1 = A + (size_t)min(crow + 64, m_valid - 1) * lda + ckc;
  const bf16_t* ga2 = A + (size_t)min(crow + 128, m_valid - 1) * lda + ckc;
  const bf16_t* ga3 = A + (size_t)min(crow + 192, m_valid - 1) * lda + ckc;
  const bf16_t* gb = Bt + (size_t)crow * ldb + ckc;
  u32x4 ra0, ra1, ra2, ra3, rb0, rb1, rb2, rb3;
#define GLOAD(k0)                                                        \
  ra0 = *(const u32x4*)(ga0 + (k0));                                     \
  ra1 = *(const u32x4*)(ga1 + (k0));                                     \
  ra2 = *(const u32x4*)(ga2 + (k0));                                     \
  ra3 = *(const u32x4*)(ga3 + (k0));                                     \
  rb0 = *(const u32x4*)(gb + (k0));                                      \
  rb1 = *(const u32x4*)(gb + (size_t)64 * ldb + (k0));                   \
  if (NB == 4) {                                                         \
    rb2 = *(const u32x4*)(gb + (size_t)128 * ldb + (k0));                \
    rb3 = *(const u32x4*)(gb + (size_t)192 * ldb + (k0));                \
  }
#define LSTORE(buf)                                                      \
  *(u32x4*)(As + (buf) * A_SZ + crow * LS + cks) = ra0;                  \
  *(u32x4*)(As + (buf) * A_SZ + (crow + 64) * LS + cks) = ra1;           \
  *(u32x4*)(As + (buf) * A_SZ + (crow + 128) * LS + cks) = ra2;          \
  *(u32x4*)(As + (buf) * A_SZ + (crow + 192) * LS + cks) = ra3;          \
  *(u32x4*)(Bs + (buf) * B_SZ + crow * LS + cks) = rb0;                  \
  *(u32x4*)(Bs + (buf) * B_SZ + (crow + 64) * LS + cks) = rb1;           \
  if (NB == 4) {                                                         \
    *(u32x4*)(Bs + (buf) * B_SZ + (crow + 128) * LS + cks) = rb2;        \
    *(u32x4*)(Bs + (buf) * B_SZ + (crow + 192) * LS + cks) = rb3;        \
  }
  const int nk = K / 64;
  const int aoff = (wm * 64 + lr) * LS;
  const int boff = (wn * (BN / 2) + lr) * LS;
  GLOAD(0)
  __syncthreads();
  LSTORE(0)
  GLOAD(64)
  __syncthreads();
  for (int kt = 0; kt < nk; kt++) {
    const int cur = kt & 1, nx = cur ^ 1;
    const int kn = ((kt + 2 < nk) ? kt + 2 : nk - 1) * 64;
    *(u32x4*)(As + nx * A_SZ + crow * LS + cks) = ra0;
    *(u32x4*)(As + nx * A_SZ + (crow + 64) * LS + cks) = ra1;
    *(u32x4*)(As + nx * A_SZ + (crow + 128) * LS + cks) = ra2;
    *(u32x4*)(As + nx * A_SZ + (crow + 192) * LS + cks) = ra3;
    ra0 = *(const u32x4*)(ga0 + kn);
    ra1 = *(const u32x4*)(ga1 + kn);
    ra2 = *(const u32x4*)(ga2 + kn);
    ra3 = *(const u32x4*)(ga3 + kn);
    __builtin_amdgcn_sched_barrier(0);
    gemm256_kstep<BN, TRANS>(acc, As + cur * A_SZ + aoff, Bs + cur * B_SZ + boff, sw0);
    __builtin_amdgcn_sched_barrier(0);
    *(u32x4*)(Bs + nx * B_SZ + crow * LS + cks) = rb0;
    *(u32x4*)(Bs + nx * B_SZ + (crow + 64) * LS + cks) = rb1;
    rb0 = *(const u32x4*)(gb + kn);
    rb1 = *(const u32x4*)(gb + (size_t)64 * ldb + kn);
    if (NB == 4) {
      *(u32x4*)(Bs + nx * B_SZ + (crow + 128) * LS + cks) = rb2;
      *(u32x4*)(Bs + nx * B_SZ + (crow + 192) * LS + cks) = rb3;
      rb2 = *(const u32x4*)(gb + (size_t)128 * ldb + kn);
      rb3 = *(const u32x4*)(gb + (size_t)192 * ldb + kn);
    }
    __builtin_amdgcn_sched_barrier(0);
    gemm256_kstep<BN, TRANS>(acc, As + cur * A_SZ + aoff, Bs + cur * B_SZ + boff, sw1);
    __syncthreads();
  }
#undef GLOAD
#undef LSTORE
}

DEV void tconv_tiles4(const float* __restrict__ src, int K, int N, bf16_t* __restrict__ dst, int idx0, int ntn, float* tile) {
  const int tid = get_tid();
  const int r = tid >> 4, c4 = (tid & 15) * 4;
  float4 v[4][2];
#pragma unroll
  for (int u = 0; u < 4; u++) {
    const int idx = idx0 + u, tk = idx / ntn, tn = idx - tk * ntn;
#pragma unroll
    for (int i = 0; i < 2; i++) v[u][i] = *(const float4*)(src + (size_t)(tk * 64 + r + i * 32) * N + tn * 64 + c4);
  }
  __syncthreads();
#pragma unroll
  for (int u = 0; u < 4; u++)
#pragma unroll
    for (int i = 0; i < 2; i++) {
      float* t = tile + u * (64 * 65) + (r + i * 32) * 65 + c4;
      t[0] = v[u][i].x; t[1] = v[u][i].y; t[2] = v[u][i].z; t[3] = v[u][i].w;
    }
  __syncthreads();
  const int n = tid >> 3, k8 = (tid & 7) * 8;
#pragma unroll
  for (int u = 0; u < 4; u++) {
    const int idx = idx0 + u, tk = idx / ntn, tn = idx - tk * ntn;
    const float* t = tile + u * (64 * 65);
    u32x4 o;
    o[0] = pack2(t[(k8 + 0) * 65 + n], t[(k8 + 1) * 65 + n]);
    o[1] = pack2(t[(k8 + 2) * 65 + n], t[(k8 + 3) * 65 + n]);
    o[2] = pack2(t[(k8 + 4) * 65 + n], t[(k8 + 5) * 65 + n]);
    o[3] = pack2(t[(k8 + 6) * 65 + n], t[(k8 + 7) * 65 + n]);
    *(u32x4*)(dst + (size_t)(tn * 64 + n) * K + tk * 64 + k8) = o;
  }
}

DEV void phase_convert(const Params& p, int layer, unsigned char* lds) {
  unsigned char* ws = p.ws;
  float* tile = (float*)lds;
  for (int g = get_bid(); g < 1616; g += gridDim.x) {
    const float* src; bf16_t* dst; int K, N, gi;
    if (g < 832) { gi = g; src = p.in[3] + (size_t)layer * 1024 * INW; K = 1024; N = INW; dst = (bf16_t*)(ws + OFF_WIN); }
    else if (g < 832 + 192) { gi = g - 832; const int br = gi >> 6; gi &= 63; src = p.in[4] + ((size_t)layer * 3 + br) * 1024 * 1024; K = 1024; N = 1024; dst = (bf16_t*)(ws + OFF_WB) + (size_t)br * 1024 * 1024; }
    else if (g < 1088) { gi = g - 1024; src = p.in[5] + (size_t)layer * 1024 * 1024; K = 1024; N = 1024; dst = (bf16_t*)(ws + OFF_WO); }
    else if (g < 1440) { gi = g - 1088; src = p.in[10] + (size_t)layer * 1024 * 5632; K = 1024; N = 5632; dst = (bf16_t*)(ws + OFF_WFI); }
    else { gi = g - 1440; src = p.in[13] + (size_t)layer * 2816 * 1024; K = 2816; N = 1024; dst = (bf16_t*)(ws + OFF_WFO); }
    tconv_tiles4(src, K, N, dst, gi * 4, N / 64, (float*)tile);
  }
}

DEV void phase_init(const Params& p) {
  unsigned char* ws = p.ws;
  const int gt = get_bid() * NTHR + get_tid(), gs = gridDim.x * NTHR;
  {
    const int lane = get_tid() & 63, wave = get_tid() >> 6;
    const float* g = p.in[2];
    for (int row = get_bid() * 8 + wave; row < 2 * LT; row += gridDim.x * 8) {
      const int b = row / LT, t = row - b * LT;
      float4 v[4]; float ss = 0.f;
#pragma unroll
      for (int k = 0; k < 4; k++) {
        const int c4 = k * 256 + lane * 4;
        if (t < 112) v[k] = make_float4(0.f, 0.f, 0.f, 0.f);
        else if (t < 128) v[k] = *(const float4*)(p.in[1] + (size_t)(t - 112) * 1024 + c4);
        else v[k] = *(const float4*)(p.in[0] + ((size_t)b * 8192 + (t - 128)) * 1024 + c4);
        *(float4*)(hrow(p, b, t) + c4) = v[k];
        ss += v[k].x * v[k].x + v[k].y * v[k].y + v[k].z * v[k].z + v[k].w * v[k].w;
      }
#pragma unroll
      for (int o = 1; o < 64; o <<= 1) ss += shfl_xor_l(ss, o, lane);
      const float rs = rsqrtf(ss * (1.f / 1024.f) + 1e-6f);
      bf16_t* dst = (bf16_t*)(ws + OFF_HN) + (size_t)b * LT * 1024 + (size_t)t * 1024;
#pragma unroll
      for (int k = 0; k < 4; k++) {
        float4 gg = *(const float4*)(g + k * 256 + lane * 4);
        uint2 o; o.x = pack2(v[k].x * rs * gg.x, v[k].y * rs * gg.y); o.y = pack2(v[k].z * rs * gg.z, v[k].w * rs * gg.w);
        *(uint2*)(dst + k * 256 + lane * 4) = o;
      }
    }
  }
  float2* R128 = (float2*)(ws + OFF_R128);
  float2* R64 = (float2*)(ws + OFF_R64);
  for (int idx = gt; idx < LT * 96; idx += gs) {
    const int t = idx / 96, f = idx - t * 96;
    float inv;
    if (f < 64) inv = powf(10000.f, -(float)(2 * f) / 128.f);
    else inv = powf(10000.f, -(float)(2 * (f - 64)) / 64.f);
    const float ang = (float)(t - 112) * inv;
    const double ad = (double)ang;
    const double n = rint(ad * 0.15915494309189535);
    const float rr = (float)(ad - n * 6.283185307179586);
    float2 cs; cs.x = __cosf(rr); cs.y = __sinf(rr);
    if (f < 64) R128[(size_t)t * 64 + f] = cs; else R64[(size_t)t * 32 + (f - 64)] = cs;
  }
}

DEV void phase_norm(const Params& p, int b, const float* __restrict__ g, bf16_t* __restrict__ dst) {
  const int lane = get_tid() & 63, wave = get_tid() >> 6;
  for (int row = get_bid() * 8 + wave; row < LT; row += gridDim.x * 8) {
    const float* src = hrow(p, b, row);
    float4 v[4]; float ss = 0.f;
#pragma unroll
    for (int k = 0; k < 4; k++) { v[k] = *(const float4*)(src + k * 256 + lane * 4); ss += v[k].x * v[k].x + v[k].y * v[k].y + v[k].z * v[k].z + v[k].w * v[k].w; }
#pragma unroll
    for (int o = 1; o < 64; o <<= 1) ss += shfl_xor_l(ss, o, lane);
    const float rs = rsqrtf(ss * (1.f / 1024.f) + 1e-6f);
#pragma unroll
    for (int k = 0; k < 4; k++) {
      float4 gg = *(const float4*)(g + k * 256 + lane * 4);
      uint2 o; o.x = pack2(v[k].x * rs * gg.x, v[k].y * rs * gg.y); o.y = pack2(v[k].z * rs * gg.z, v[k].w * rs * gg.w);
      *(uint2*)(dst + (size_t)row * 1024 + k * 256 + lane * 4) = o;
    }
  }
}

DEV void phase_final(const Params& p) {
  const float* g = p.in[14];
  const int lane = get_tid() & 63, wave = get_tid() >> 6;
  for (int row = get_bid() * 8 + wave; row < 2 * 8192; row += gridDim.x * 8) {
    const float* src = p.out + (size_t)row * 1024;
    float4 v[4]; float ss = 0.f;
#pragma unroll
    for (int k = 0; k < 4; k++) { v[k] = *(const float4*)(src + k * 256 + lane * 4); ss += v[k].x * v[k].x + v[k].y * v[k].y + v[k].z * v[k].z + v[k].w * v[k].w; }
#pragma unroll
    for (int o = 1; o < 64; o <<= 1) ss += shfl_xor_l(ss, o, lane);
    const float rs = rsqrtf(ss * (1.f / 1024.f) + 1e-6f);
#pragma unroll
    for (int k = 0; k < 4; k++) {
      float4 gg = *(const float4*)(g + k * 256 + lane * 4);
      float4 o = make_float4(v[k].x * rs * gg.x, v[k].y * rs * gg.y, v[k].z * rs * gg.z, v[k].w * rs * gg.w);
      *(float4*)(p.out + (size_t)row * 1024 + k * 256 + lane * 4) = o;
    }
  }
}

DEV void tile_map(int it, int MT, int NG, int& mt, int& nt) {
  const int ng = it / (MT * NG), rem = it - ng * (MT * NG);
  mt = rem / NG; nt = ng * NG + (rem - mt * NG);
}
DEV int vblock() { const int b = get_bid(), G = (int)gridDim.x; return ((G & 7) == 0) ? (b & 7) * (G >> 3) + (b >> 3) : b; }

template <int NI>
DEV void projA_epiN(const Params& p, f32x4 (&acc)[NI][8], int seg, int cw, int trow0, int lr, int lg) {
  unsigned char* ws = p.ws;
  const float2* R128 = (const float2*)(ws + OFF_R128);
  const float2* R64 = (const float2*)(ws + OFF_R64);
  bf16_t* dstb; int ld;
  if (seg == 0) { dstb = (bf16_t*)(ws + OFF_RQ); ld = 512; }
  else if (seg == 3) { dstb = (bf16_t*)(ws + OFF_HQ); ld = 1024; }
  else if (seg == 6) { dstb = (bf16_t*)(ws + OFF_DQ); ld = 1024; }
  else { dstb = (bf16_t*)(ws + OFF_DK); ld = 1024; }
#pragma unroll
  for (int i = 0; i < NI; i++) {
    const int t = trow0 + i * 16 + lr;
    if (seg == 0) {
      const float2* tab = R128 + (size_t)t * 64;
#pragma unroll
      for (int j = 0; j < 4; j++)
#pragma unroll
        for (int r = 0; r < 4; r++) {
          float2 cs = tab[j * 16 + lg * 4 + r];
          float x1 = acc[i][j][r], x2 = acc[i][j + 4][r];
          acc[i][j][r] = x1 * cs.x - x2 * cs.y;
          acc[i][j + 4][r] = x2 * cs.x + x1 * cs.y;
        }
    } else if (seg == 6 || seg == 7) {
      const float2* tab = R64 + (size_t)t * 32;
      const float sc = (seg == 6) ? (0.125f * 1.4426950408889634f) : 1.f;
#pragma unroll
      for (int jq = 0; jq < 4; jq++) {
        const int j = (jq & 1) + (jq >> 1) * 4;
#pragma unroll
        for (int r = 0; r < 4; r++) {
          float2 cs = tab[(jq & 1) * 16 + lg * 4 + r];
          float x1 = acc[i][j][r], x2 = acc[i][j + 2][r];
          acc[i][j][r] = (x1 * cs.x - x2 * cs.y) * sc;
          acc[i][j + 2][r] = (x2 * cs.x + x1 * cs.y) * sc;
        }
      }
    }
    bf16_t* dst = dstb + (size_t)t * ld + cw;
#pragma unroll
    for (int j = 0; j < 8; j++) *(uint2*)(dst + j * 16 + lg * 4) = pack4(acc[i][j]);
    __builtin_amdgcn_sched_barrier(0);
  }
}

template <int NI>
DEV void projA_epiT(const Params& p, int layer, f32x4 (&acc)[NI][8], int seg, int cw, int trow0, int wn,
                    int mloc0, int lr, int lg, int tid, unsigned char* ldsraw) {
  unsigned char* ws = p.ws;
  const float2* R128 = (const float2*)(ws + OFF_R128);
  if (seg == 1) {
    bf16_t* RK = (bf16_t*)(ws + OFF_RK);
    bf16_t* RKT = (bf16_t*)(ws + OFF_RKT);
    const int h = cw >> 7;
    const float l2g = log2f(1.f - ex2(-5.f - (float)h));
#pragma unroll
    for (int i = 0; i < NI; i++) {
      const int tb = trow0 + i * 16 + lg * 4;
#pragma unroll
      for (int j = 0; j < 4; j++)
#pragma unroll
        for (int r = 0; r < 4; r++) {
          const int t = tb + r;
          float2 cs = R128[(size_t)t * 64 + j * 16 + lr];
          const float sc = (t >= 112) ? 0.08838834764831845f : 0.f;
          float x1 = acc[i][j][r], x2 = acc[i][j + 4][r];
          acc[i][j][r] = (x1 * cs.x - x2 * cs.y) * sc;
          acc[i][j + 4][r] = (x2 * cs.x + x1 * cs.y) * sc;
        }
#pragma unroll
      for (int j = 0; j < 8; j++) {
        const int col = cw + j * 16 + lr;
        f32x4 kd;
#pragma unroll
        for (int r = 0; r < 4; r++) {
          const int t = tb + r;
          RK[(size_t)t * 512 + col] = f2bf(acc[i][j][r]);
          kd[r] = acc[i][j][r] * ex2(l2g * (float)(127 - (t & 127)));
        }
        *(uint2*)(RKT + (size_t)col * LT + tb) = pack4(kd);
      }
      __builtin_amdgcn_sched_barrier(0);
    }
  } else if (seg == 2 || seg == 5 || seg == 8) {
    bf16_t* dT = (bf16_t*)(ws + (seg == 2 ? OFF_RVT : (seg == 5 ? OFF_HVT : OFF_DVT)));
#pragma unroll
    for (int i = 0; i < NI; i++) {
      const int tb = trow0 + i * 16 + lg * 4;
#pragma unroll
      for (int j = 0; j < 8; j++) {
        const int col = cw + j * 16 + lr;
        f32x4 v = acc[i][j];
        if (seg == 5) {
#pragma unroll
          for (int r = 0; r < 4; r++) if (tb + r < 112) v[r] = 0.f;
        }
        *(uint2*)(dT + (size_t)col * LT + tb) = pack4(v);
      }
      __builtin_amdgcn_sched_barrier(0);
    }
  } else if constexpr (NI == 2) {
    float* Lf = (float*)ldsraw;
    float* HCB = (float*)(ws + OFF_HCB);
    bf16_t* HK = (bf16_t*)(ws + OFF_HK);
    bf16_t* HKET = (bf16_t*)(ws + OFF_HKET);
    float* HDEC = (float*)(ws + OFF_HDEC);
    const float* lbp = p.in[6];
#pragma unroll
    for (int j = 0; j < 8; j++) {
      const int col = cw + j * 16 + lr;
      float lb = 0.f;
      if (layer == 1) lb = 1.f / (1.f + __expf(lbp[col] - lbp[1024 + col]));
#pragma unroll
      for (int i = 0; i < 2; i++)
#pragma unroll
        for (int r = 0; r < 4; r++) {
          const int m = mloc0 + i * 16 + lg * 4 + r;
          const float z = acc[i][j][r];
          const float kk = (1.f - lb) / (1.f + __expf(z));
          const float lf = fmaxf(log1pf(-kk), -69.0776f);
          acc[i][j][r] = kk;
          Lf[m * 260 + wn * 128 + j * 16 + lr] = lf;
        }
    }
    __syncthreads();
    {
      const int colL = tid & 255, half = tid >> 8;
      float run = 0.f;
      for (int rr = 0; rr < 64; rr++) {
        float* q = &Lf[(half * 64 + rr) * 260 + colL];
        run += *q; *q = run;
      }
    }
    __syncthreads();
#pragma unroll
    for (int j = 0; j < 8; j++) {
      const int colL = wn * 128 + j * 16 + lr;
      const int col = cw + j * 16 + lr;
      const float ft = Lf[63 * 260 + colL];
      const float cend = Lf[127 * 260 + colL] + ft;
#pragma unroll
      for (int i = 0; i < 2; i++) {
        const int mb = mloc0 + i * 16 + lg * 4;
        const int tb = trow0 + i * 16 + lg * 4;
        f32x4 ke;
#pragma unroll
        for (int r = 0; r < 4; r++) {
          const int m = mb + r;
          const int t = tb + r;
          const float cb = Lf[m * 260 + colL] + (m >= 64 ? ft : 0.f);
          HCB[(size_t)t * 1024 + col] = cb;
          HK[(size_t)t * 1024 + col] = f2bf(acc[i][j][r]);
          ke[r] = acc[i][j][r] * __expf(cend - cb);
          if (m == 127) HDEC[(t >> 7) * 1024 + col] = __expf(cend);
        }
        *(uint2*)(HKET + (size_t)col * LT + tb) = pack4(ke);
      }
    }
    __syncthreads();
  }
}

DEV void projA_seg(int nt, int& n0, int& seg, int& segstart) {
  if (nt < 8) { n0 = nt * 256; seg = nt < 2 ? 0 : (nt < 4 ? 1 : 2); segstart = seg == 0 ? 0 : (seg == 1 ? 512 : 1024); }
  else if (nt < 20) { n0 = 3072 + (nt - 8) * 256; seg = 3 + (nt - 8) / 4; segstart = 3072 + (seg - 3) * 1024; }
  else { n0 = 7168 + (nt - 20) * 256; seg = 6 + (nt - 20) / 4; segstart = 7168 + (seg - 6) * 1024; }
}

DEV void phase_projA(const Params& p, int layer, int b, unsigned char* ldsraw) {
  unsigned char* ws = p.ws;
  bf16_t* lds = (bf16_t*)ldsraw;
  const bf16_t* HN = (const bf16_t*)(ws + OFF_HN) + (size_t)b * LT * 1024;
  const bf16_t* WIN = (const bf16_t*)(ws + OFF_WIN);
  const int G = (int)gridDim.x, vb = vblock();
  for (int item = vb; item < 32 * 28; item += G) {
    int ntb, mt; tile_map(item, 32, 4, mt, ntb);
    const int nt = ntb < 12 ? ntb : ntb + 4;
    int n0, seg, segstart; projA_seg(nt, n0, seg, segstart);
    const int row0 = 128 + mt * 256;
    const bf16_t* A = HN + (size_t)row0 * 1024;
    const bf16_t* Bt = WIN + (size_t)n0 * 1024;
    f32x4 acc[4][8];
#pragma unroll
    for (int i = 0; i < 4; i++)
#pragma unroll
      for (int j = 0; j < 8; j++) acc[i][j] = (f32x4){0.f, 0.f, 0.f, 0.f};
    if (seg == 0 || seg == 3 || seg == 6 || seg == 7) {
      gemm256_acc<256, false>(acc, A, 1024, 256, Bt, 1024, 1024, lds);
      const int tid = get_tid(), lane = tid & 63, wave = tid >> 6, wm = wave >> 1, wn = wave & 1; const int lr = lane & 15, lg = lane >> 4;
      projA_epiN<4>(p, acc, seg, (n0 - segstart) + wn * 128, row0 + wm * 64, lr, lg);
    } else {
      gemm256_acc<256, true>(acc, A, 1024, 256, Bt, 1024, 1024, lds);
      const int tid = get_tid(), lane = tid & 63, wave = tid >> 6, wm = wave >> 1, wn = wave & 1; const int lr = lane & 15, lg = lane >> 4;
      projA_epiT<4>(p, layer, acc, seg, (n0 - segstart) + wn * 128, row0 + wm * 64, wn, (wm & 1) * 64, lr, lg, tid, ldsraw);
    }
  }
  for (int s = (vb + G / 2) % G; s < 288; s += G) {
    int nt, mt;
    if (s < 28) { mt = 0; nt = s < 12 ? s : s + 4; }
    else { const int q = s - 28; mt = q >> 2; nt = 12 + (q & 3); }
    int n0, seg, segstart; projA_seg(nt, n0, seg, segstart);
    const bf16_t* A = HN + (size_t)mt * 128 * 1024;
    const bf16_t* Bt = WIN + (size_t)n0 * 1024;
    f32x4 acc[2][8];
#pragma unroll
    for (int i = 0; i < 2; i++)
#pragma unroll
      for (int j = 0; j < 8; j++) acc[i][j] = (f32x4){0.f, 0.f, 0.f, 0.f};
    if (seg == 0 || seg == 3 || seg == 6 || seg == 7) {
      gemm_acc<256, false>(acc, A, 1024, Bt, 1024, 1024, lds);
      const int tid = get_tid(), lane = tid & 63, wave = tid >> 6, wm = wave >> 1, wn = wave & 1; const int lr = lane & 15, lg = lane >> 4;
      projA_epiN<2>(p, acc, seg, (n0 - segstart) + wn * 128, mt * 128 + wm * 32, lr, lg);
    } else {
      gemm_acc<256, true>(acc, A, 1024, Bt, 1024, 1024, lds);
      const int tid = get_tid(), lane = tid & 63, wave = tid >> 6, wm = wave >> 1, wn = wave & 1; const int lr = lane & 15, lg = lane >> 4;
      projA_epiT<2>(p, layer, acc, seg, (n0 - segstart) + wn * 128, mt * 128 + wm * 32, wn, wm * 32, lr, lg, tid, ldsraw);
    }
  }
}

DEV void gemm_k128(f32x4 (&acc)[2][4], const bf16_t* __restrict__ A, int lda, const bf16_t* __restrict__ Bt, int ldb, bf16_t* lds) {
  constexpr int LS = 64, T_SZ = 128 * LS;
  const int tid = get_tid(), lane = tid & 63, wave = tid >> 6, wm = wave >> 1, wn = wave & 1;
  const int lr = lane & 15, lg = lane >> 4;
  bf16_t* As = lds;
  bf16_t* Bs = lds + 2 * T_SZ;
  const int crow = tid >> 3, ckc = (tid & 7) * 8;
  const int cks = ((tid & 7) ^ ((crow >> 1) & 7)) * 8;
  const int sw0 = (lg ^ ((lr >> 1) & 7)) * 8, sw1 = sw0 ^ 32;
  const bf16_t* ga = A + (size_t)crow * lda + ckc;
  const bf16_t* gb = Bt + (size_t)crow * ldb + ckc;
  const u32x4 a00 = *(const u32x4*)(ga), a01 = *(const u32x4*)(ga + (size_t)64 * lda);
  const u32x4 b00 = *(const u32x4*)(gb), b01 = *(const u32x4*)(gb + (size_t)64 * ldb);
  const u32x4 a10 = *(const u32x4*)(ga + 64), a11 = *(const u32x4*)(ga + (size_t)64 * lda + 64);
  const u32x4 b10 = *(const u32x4*)(gb + 64), b11 = *(const u32x4*)(gb + (size_t)64 * ldb + 64);
  __syncthreads();
  *(u32x4*)(As + crow * LS + cks) = a00;
  *(u32x4*)(As + (crow + 64) * LS + cks) = a01;
  *(u32x4*)(Bs + crow * LS + cks) = b00;
  *(u32x4*)(Bs + (crow + 64) * LS + cks) = b01;
  *(u32x4*)(As + T_SZ + crow * LS + cks) = a10;
  *(u32x4*)(As + T_SZ + (crow + 64) * LS + cks) = a11;
  *(u32x4*)(Bs + T_SZ + crow * LS + cks) = b10;
  *(u32x4*)(Bs + T_SZ + (crow + 64) * LS + cks) = b11;
  __syncthreads();
  const int aoff = (wm * 32 + lr) * LS, boff = (wn * 64 + lr) * LS;
  gemm_compute<128, false>(acc, As + aoff, Bs + boff, sw0, sw1);
  gemm_compute<128, false>(acc, As + T_SZ + aoff, Bs + T_SZ + boff, sw0, sw1);
  __syncthreads();
}

DEV void phase_U(const Params& p, unsigned char* ldsraw) {
  unsigned char* ws = p.ws;
  bf16_t* lds = (bf16_t*)ldsraw;
  for (int item = get_bid(); item < 1040; item += gridDim.x) {
    const bf16_t *A, *Bt; bf16_t* dst;
    if (item < 520) {
      const int h = item & 3, rest = item >> 2, mh = rest & 1, c = rest >> 1;
      A = (const bf16_t*)(ws + OFF_RVT) + (size_t)(h * 256 + mh * 128) * LT + c * 128;
      Bt = (const bf16_t*)(ws + OFF_RKT) + (size_t)(h * 128) * LT + c * 128;
      dst = (bf16_t*)(ws + OFF_STR) + ((size_t)(h * 65 + c) * 256 + mh * 128) * 128;
    } else {
      const int it = item - 520, h = it & 7, c = it >> 3;
      A = (const bf16_t*)(ws + OFF_HVT) + (size_t)(h * 128) * LT + c * 128;
      Bt = (const bf16_t*)(ws + OFF_HKET) + (size_t)(h * 128) * LT + c * 128;
      dst = (bf16_t*)(ws + OFF_STH) + ((size_t)(h * 65 + c) * 128) * 128;
    }
    f32x4 acc[2][4];
#pragma unroll
    for (int i = 0; i < 2; i++)
#pragma unroll
      for (int j = 0; j < 4; j++) acc[i][j] = (f32x4){0.f, 0.f, 0.f, 0.f};
    gemm_k128(acc, A, LT, Bt, LT, lds);
      const int tid = get_tid(), lane = tid & 63, wave = tid >> 6, wm = wave >> 1, wn = wave & 1; const int lr = lane & 15, lg = lane >> 4; (void)tid; (void)lane; (void)wm; (void)wn; (void)lr; (void)lg;
#pragma unroll
    for (int i = 0; i < 2; i++)
#pragma unroll
      for (int j = 0; j < 4; j++)
        *(uint2*)(dst + (size_t)(wm * 32 + i * 16 + lr) * 128 + wn * 64 + j * 16 + lg * 4) = pack4(acc[i][j]);
  }
}

DEV void phase_scan(const Params& p) {
  unsigned char* ws = p.ws;
  const float* HDEC = (const float*)(ws + OFF_HDEC);
  for (int task = get_bid() * NTHR + get_tid(); task < 65536; task += gridDim.x * NTHR) {
    bf16_t* base; size_t stride; int h, d4; bool hg;
    float dec0 = 0.f;
    if (task < 32768) {
      const int v = task; d4 = (v & 31) * 4; const int e = (v >> 5) & 255; h = v >> 13; hg = false;
      base = (bf16_t*)(ws + OFF_STR) + ((size_t)(h * 65) * 256 + e) * 128 + d4; stride = 256 * 128;
      dec0 = ex2(128.f * log2f(1.f - ex2(-5.f - (float)h)));
    } else {
      const int v = task - 32768; d4 = (v & 31) * 4; const int e = (v >> 5) & 127; h = v >> 12; hg = true;
      base = (bf16_t*)(ws + OFF_STH) + ((size_t)(h * 65) * 128 + e) * 128 + d4; stride = 128 * 128;
    }
    float c0 = 0.f, c1 = 0.f, c2 = 0.f, c3 = 0.f;
    for (int cg0 = 0; cg0 < 65; cg0 += 13) {
      uint2 u[13]; float4 dc[13];
#pragma unroll
      for (int k = 0; k < 13; k++) {
        u[k] = *(const uint2*)(base + (size_t)(cg0 + k) * stride);
        if (hg) dc[k] = *(const float4*)(HDEC + (size_t)(cg0 + k) * 1024 + h * 128 + d4);
        else dc[k] = make_float4(dec0, dec0, dec0, dec0);
      }
#pragma unroll
      for (int k = 0; k < 13; k++) {
        uint2 o; o.x = pack2(c0, c1); o.y = pack2(c2, c3);
        *(uint2*)(base + (size_t)(cg0 + k) * stride) = o;
        c0 = dc[k].x * c0 + bf2f((bf16_t)(u[k].x & 0xffff));
        c1 = dc[k].y * c1 + bf2f((bf16_t)(u[k].x >> 16));
        c2 = dc[k].z * c2 + bf2f((bf16_t)(u[k].y & 0xffff));
        c3 = dc[k].w * c3 + bf2f((bf16_t)(u[k].y >> 16));
      }
    }
  }
}

DEV void attn_item(const Params& p, int layer, int h, int qb, float lam, bf16_t* lds) {
  unsigned char* ws = p.ws;
  const bf16_t* DQ = (const bf16_t*)(ws + OFF_DQ);
  bf16_t* ODA = (bf16_t*)(ws + OFF_ODA);
  const bf16_t* DK = (const bf16_t*)(ws + OFF_DK);
  const bf16_t* DVT = (const bf16_t*)(ws + OFF_DVT);
  constexpr int PS = 136, XS = 132;
  constexpr int TS = 128 * PS;
  bf16_t* KV = lds;
  float* X = (float*)lds;
  const int tid = get_tid(), lane = tid & 63, wave = tid >> 6;
  const int lr = lane & 15, lg = lane >> 4;
  const int grp = wave >> 2, wq = wave & 3;
  const int t0 = qb * 128;
  const int lrow = tid >> 4, lc8 = (tid & 15) * 8;
  const bf16_t* gq = DQ + (size_t)(t0 + wq * 32 + lr) * 1024 + h * 128 + grp * 64 + lg * 8;
  const bf16x8 a00 = *(const bf16x8*)(gq);
  const bf16x8 a01 = *(const bf16x8*)(gq + 32);
  const bf16x8 a10 = *(const bf16x8*)(gq + (size_t)16 * 1024);
  const bf16x8 a11 = *(const bf16x8*)(gq + (size_t)16 * 1024 + 32);
  f32x4 o[2][8];
#pragma unroll
  for (int i = 0; i < 2; i++)
#pragma unroll
    for (int j = 0; j < 8; j++) o[i][j] = (f32x4){0.f, 0.f, 0.f, 0.f};
  float mrun0 = -1e30f, mrun1 = -1e30f, lrun0 = 0.f, lrun1 = 0.f;
  u32x4 rk0, rk1, rk2, rk3, rv0, rv1, rv2, rv3;
  const unsigned ko = (unsigned)(lrow * 1024 + h * 128 + lc8);
  const unsigned vo = (unsigned)((h * 128 + lrow) * LT + lc8);
#define ALOAD(kbn)                                                              \
  rk0 = *(const u32x4*)(DK + (ko + (unsigned)(kbn) * 131072u));                 \
  rk1 = *(const u32x4*)(DK + (ko + (unsigned)(kbn) * 131072u + 32768u));        \
  rk2 = *(const u32x4*)(DK + (ko + (unsigned)(kbn) * 131072u + 65536u));        \
  rk3 = *(const u32x4*)(DK + (ko + (unsigned)(kbn) * 131072u + 98304u));        \
  rv0 = *(const u32x4*)(DVT + (vo + (unsigned)(kbn) * 128u));                   \
  rv1 = *(const u32x4*)(DVT + (vo + (unsigned)(kbn) * 128u + 32u * LT));        \
  rv2 = *(const u32x4*)(DVT + (vo + (unsigned)(kbn) * 128u + 64u * LT));        \
  rv3 = *(const u32x4*)(DVT + (vo + (unsigned)(kbn) * 128u + 96u * LT));
#define ASTORE(sp)                                                              \
  *(u32x4*)((sp)) = rk0;                                                        \
  *(u32x4*)((sp) + 32 * PS) = rk1;                                              \
  *(u32x4*)((sp) + 64 * PS) = rk2;                                              \
  *(u32x4*)((sp) + 96 * PS) = rk3;                                              \
  *(u32x4*)((sp) + 2 * TS) = rv0;                                               \
  *(u32x4*)((sp) + 2 * TS + 32 * PS) = rv1;                                     \
  *(u32x4*)((sp) + 2 * TS + 64 * PS) = rv2;                                     \
  *(u32x4*)((sp) + 2 * TS + 96 * PS) = rv3;
  ALOAD(0)
  const int qrow0 = t0 + wq * 32 + lr;
  __syncthreads();
  ASTORE(KV + lrow * PS + lc8)
  {
    const int kb1 = qb > 0 ? 1 : 0;
    ALOAD(kb1)
  }
  __syncthreads();
  for (int kb = 0; kb <= qb; kb++) {
    const int cur = kb & 1;
    const bf16_t* kp = KV + cur * TS + lr * PS + grp * 64 + lg * 8;
    const bf16_t* vq = KV + 2 * TS + cur * TS + lr * PS + lg * 4;
    {
      bf16_t* sp = KV + (cur ^ 1) * TS + lrow * PS + lc8;
      ASTORE(sp)
    }
    __builtin_amdgcn_sched_barrier(0);
    f32x4 s[2][8];
    {
#pragma unroll
      for (int j = 0; j < 8; j++) {
        const bf16x8 kf0 = *(const bf16x8*)(kp + j * 16 * PS);
        const bf16x8 kf1 = *(const bf16x8*)(kp + j * 16 * PS + 32);
        s[0][j] = MFMA(kf0, a00, ((f32x4){0.f, 0.f, 0.f, 0.f}));
        s[1][j] = MFMA(kf0, a10, ((f32x4){0.f, 0.f, 0.f, 0.f}));
        s[0][j] = MFMA(kf1, a01, s[0][j]);
        s[1][j] = MFMA(kf1, a11, s[1][j]);
      }
    }
    __builtin_amdgcn_sched_barrier(0);
    {
      const int kbn = (kb + 2 <= qb) ? kb + 2 : qb;
      ALOAD(kbn)
    }
    __builtin_amdgcn_sched_barrier(0);
    if (kb == qb || kb == 0) {
#pragma unroll
      for (int i = 0; i < 2; i++)
#pragma unroll
        for (int j = 0; j < 8; j++)
#pragma unroll
          for (int r = 0; r < 4; r++) {
            const int key = kb * 128 + j * 16 + lg * 4 + r;
            if (key > qrow0 + 16 * i || key < 112) s[i][j][r] = -1e30f;
          }
    }
    float al[2];
#pragma unroll
    for (int i = 0; i < 2; i++) {
      float mx = -1e30f;
#pragma unroll
      for (int j = 0; j < 8; j++)
#pragma unroll
        for (int r = 0; r < 4; r++) mx = fmaxf(mx, s[i][j][r]);
      mx = fmaxf(mx, shfl_xor_l(mx, 16, lane));
      mx = fmaxf(mx, shfl_xor_l(mx, 32, lane));
      const float mold = i == 0 ? mrun0 : mrun1;
      const float mnew = (mx > mold + 8.f) ? mx : mold;
      al[i] = ex2(mold - mnew);
      float ps = 0.f;
#pragma unroll
      for (int j = 0; j < 8; j++)
#pragma unroll
        for (int r = 0; r < 4; r++) { const float pv = ex2(s[i][j][r] - mnew); s[i][j][r] = pv; ps += pv; }
      if (i == 0) { mrun0 = mnew; lrun0 = lrun0 * al[0] + ps; } else { mrun1 = mnew; lrun1 = lrun1 * al[1] + ps; }
    }
    if (__builtin_amdgcn_ballot_w64(al[0] != 1.f || al[1] != 1.f) != 0ull) {
#pragma unroll
      for (int i = 0; i < 2; i++) {
        float ao[4];
#pragma unroll
        for (int r = 0; r < 4; r++) ao[r] = shfl_l(al[i], lg * 4 + r);
#pragma unroll
        for (int je = 0; je < 8; je++)
#pragma unroll
          for (int r = 0; r < 4; r++) o[i][je][r] *= ao[r];
      }
    }
#pragma unroll
    for (int ks = 0; ks < 4; ks++) {
      union { u32x4 u; bf16x8 v; } pf0, pf1;
      pf0.u[0] = pack2(s[0][2 * ks][0], s[0][2 * ks][1]);
      pf0.u[1] = pack2(s[0][2 * ks][2], s[0][2 * ks][3]);
      pf0.u[2] = pack2(s[0][2 * ks + 1][0], s[0][2 * ks + 1][1]);
      pf0.u[3] = pack2(s[0][2 * ks + 1][2], s[0][2 * ks + 1][3]);
      pf1.u[0] = pack2(s[1][2 * ks][0], s[1][2 * ks][1]);
      pf1.u[1] = pack2(s[1][2 * ks][2], s[1][2 * ks][3]);
      pf1.u[2] = pack2(s[1][2 * ks + 1][0], s[1][2 * ks + 1][1]);
      pf1.u[3] = pack2(s[1][2 * ks + 1][2], s[1][2 * ks + 1][3]);
#pragma unroll
      for (int je = 0; je < 8; je++) {
        const bf16_t* vp = vq + je * 16 * PS + ks * 32;
        union { uint2 u[2]; bf16x8 v; } vf;
        vf.u[0] = *(const uint2*)vp;
        vf.u[1] = *(const uint2*)(vp + 16);
        o[0][je] = MFMA(pf0.v, vf.v, o[0][je]);
        o[1][je] = MFMA(pf1.v, vf.v, o[1][je]);
      }
    }
    __builtin_amdgcn_sched_barrier(0);
    __syncthreads();
  }
#undef ASTORE
#undef ALOAD
#pragma unroll
  for (int i = 0; i < 2; i++) {
    float l = i == 0 ? lrun0 : lrun1;
    l += shfl_xor_l(l, 16, lane);
    l += shfl_xor_l(l, 32, lane);
    const float inv = l > 0.f ? 1.f / l : 0.f;
#pragma unroll
    for (int r = 0; r < 4; r++) {
      const float ir = shfl_l(inv, lg * 4 + r);
#pragma unroll
      for (int je = 0; je < 8; je++) o[i][je][r] *= ir;
    }
  }
  __syncthreads();
  if (grp == 1) {
#pragma unroll
    for (int i = 0; i < 2; i++)
#pragma unroll
      for (int je = 0; je < 8; je++)
#pragma unroll
        for (int r = 0; r < 4; r++) X[(wq * 32 + i * 16 + lg * 4 + r) * XS + je * 16 + lr] = o[i][je][r];
  }
  __syncthreads();
  if (grp == 0) {
    int ly = layer; asm volatile("" : "+s"(ly));
    const float li = (ly == 0) ? 0.2f : 0.35550906759f;
    const float* sg = p.in[8] + ly * 128;
#pragma unroll
    for (int i = 0; i < 2; i++) {
      float ss[4] = {0.f, 0.f, 0.f, 0.f};
#pragma unroll
      for (int je = 0; je < 8; je++)
#pragma unroll
        for (int r = 0; r < 4; r++) {
          const float v = o[i][je][r] - lam * X[(wq * 32 + i * 16 + lg * 4 + r) * XS + je * 16 + lr];
          o[i][je][r] = v; ss[r] += v * v;
        }
#pragma unroll
      for (int r = 0; r < 4; r++) {
        float s2 = ss[r];
        s2 += shfl_xor_l(s2, 1, lane); s2 += shfl_xor_l(s2, 2, lane); s2 += shfl_xor_l(s2, 4, lane); s2 += shfl_xor_l(s2, 8, lane);
        ss[r] = rsqrtf(s2 * (1.f / 128.f) + 1e-6f) * (1.f - li);
      }
#pragma unroll
      for (int je = 0; je < 8; je++) {
        const float g = sg[je * 16 + lr];
#pragma unroll
        for (int r = 0; r < 4; r++)
          ODA[(size_t)(t0 + wq * 32 + i * 16 + lg * 4 + r) * 1024 + h * 128 + je * 16 + lr] = f2bf(o[i][je][r] * ss[r] * g);
      }
    }
  }
}

DEV void ret_item(const Params& p, int h, int c, bf16_t* lds) {
  unsigned char* ws = p.ws;
  const bf16_t* RQ = (const bf16_t*)(ws + OFF_RQ);
  const bf16_t* RK = (const bf16_t*)(ws + OFF_RK);
  const bf16_t* RVT = (const bf16_t*)(ws + OFF_RVT);
  const bf16_t* STR = (const bf16_t*)(ws + OFF_STR);
  bf16_t* ORET = (bf16_t*)(ws + OFF_ORET);
  constexpr int PS = 136;
  bf16_t* Qs = lds;
  bf16_t* Ks = lds + 128 * PS;
  bf16_t* Big = lds + 2 * 128 * PS;
  float* RED = (float*)(lds + 2 * 128 * PS + 256 * PS);
  const int tid = get_tid(), lane = tid & 63, wave = tid >> 6, wm = wave >> 1, wn = wave & 1;
  const int lr = lane & 15, lg = lane >> 4;
  const int t0 = c * 128;
  const int lrow = tid >> 4, lc8 = (tid & 15) * 8;
  const float l2g = log2f(1.f - ex2(-5.f - (float)h));
#pragma unroll
  for (int i = 0; i < 4; i++) {
    const int row = lrow + i * 32;
    *(uint4*)(Qs + row * PS + lc8) = *(const uint4*)(RQ + (size_t)(t0 + row) * 512 + h * 128 + lc8);
    *(uint4*)(Ks + row * PS + lc8) = *(const uint4*)(RK + (size_t)(t0 + row) * 512 + h * 128 + lc8);
  }
#pragma unroll
  for (int i = 0; i < 8; i++) {
    const int row = lrow + i * 32;
    *(uint4*)(Big + row * PS + lc8) = *(const uint4*)(STR + ((size_t)(h * 65 + c) * 256 + row) * 128 + lc8);
  }
  u32x4 vpre[8];
#pragma unroll
  for (int i = 0; i < 8; i++) vpre[i] = *(const u32x4*)(RVT + (size_t)(h * 256 + lrow + i * 32) * LT + t0 + lc8);
  __syncthreads();
  f32x4 s[2][4];
  f32x4 o[2][8];
#pragma unroll
  for (int i = 0; i < 2; i++) {
#pragma unroll
    for (int j = 0; j < 4; j++) s[i][j] = (f32x4){0.f, 0.f, 0.f, 0.f};
#pragma unroll
    for (int j = 0; j < 8; j++) o[i][j] = (f32x4){0.f, 0.f, 0.f, 0.f};
  }
#pragma unroll
  for (int ks = 0; ks < 4; ks++) {
    bf16x8 a0 = ldfrag(Qs, PS, wm * 32 + lr, ks * 32 + lg * 8);
    bf16x8 a1 = ldfrag(Qs, PS, wm * 32 + 16 + lr, ks * 32 + lg * 8);
#pragma unroll
    for (int j = 0; j < 4; j++) {
      bf16x8 bb = ldfrag(Ks, PS, wn * 64 + j * 16 + lr, ks * 32 + lg * 8);
      s[0][j] = MFMA(bb, a0, s[0][j]);
      s[1][j] = MFMA(bb, a1, s[1][j]);
    }
#pragma unroll
    for (int j = 0; j < 8; j++) {
      bf16x8 bb = ldfrag(Big, PS, wn * 128 + j * 16 + lr, ks * 32 + lg * 8);
      o[0][j] = MFMA(bb, a0, o[0][j]);
      o[1][j] = MFMA(bb, a1, o[1][j]);
    }
    __builtin_amdgcn_sched_barrier(0);
  }
#pragma unroll
  for (int i = 0; i < 2; i++) {
    const int q = wm * 32 + i * 16 + lr;
    const float qd = ex2(l2g * (float)(q + 1));
#pragma unroll
    for (int j = 0; j < 8; j++)
#pragma unroll
      for (int r = 0; r < 4; r++) o[i][j][r] *= qd;
  }
  __syncthreads();
#pragma unroll
  for (int i = 0; i < 2; i++) {
    const int q = wm * 32 + i * 16 + lr;
#pragma unroll
    for (int j = 0; j < 4; j++) {
      f32x4 v;
#pragma unroll
      for (int r = 0; r < 4; r++) {
        const int key = wn * 64 + j * 16 + lg * 4 + r;
        v[r] = (key <= q) ? s[i][j][r] * ex2(l2g * (float)(q - key)) : 0.f;
      }
      *(uint2*)(Ks + q * PS + wn * 64 + j * 16 + lg * 4) = pack4(v);
    }
  }
#pragma unroll
  for (int i = 0; i < 8; i++) *(u32x4*)(Big + (lrow + i * 32) * PS + lc8) = vpre[i];
  __syncthreads();
#pragma unroll
  for (int ks = 0; ks < 4; ks++) {
    bf16x8 a0 = ldfrag(Ks, PS, wm * 32 + lr, ks * 32 + lg * 8);
    bf16x8 a1 = ldfrag(Ks, PS, wm * 32 + 16 + lr, ks * 32 + lg * 8);
#pragma unroll
    for (int j = 0; j < 8; j++) {
      bf16x8 bb = ldfrag(Big, PS, wn * 128 + j * 16 + lr, ks * 32 + lg * 8);
      o[0][j] = MFMA(bb, a0, o[0][j]);
      o[1][j] = MFMA(bb, a1, o[1][j]);
    }
    __builtin_amdgcn_sched_barrier(0);
  }
#pragma unroll
  for (int i = 0; i < 2; i++) {
    float ss = 0.f;
#pragma unroll
    for (int j = 0; j < 8; j++)
#pragma unroll
      for (int r = 0; r < 4; r++) ss += o[i][j][r] * o[i][j][r];
    ss += shfl_xor_l(ss, 16, lane);
    ss += shfl_xor_l(ss, 32, lane);
    if (lg == 0) RED[(wm * 32 + i * 16 + lr) * 2 + wn] = ss;
  }
  __syncthreads();
#pragma unroll
  for (int i = 0; i < 2; i++) {
    const int q = wm * 32 + i * 16 + lr;
    const float rs = rsqrtf((RED[q * 2] + RED[q * 2 + 1]) * (1.f / 256.f) + 1e-6f);
#pragma unroll
    for (int j = 0; j < 8; j++) {
      f32x4 v = o[i][j];
#pragma unroll
      for (int r = 0; r < 4; r++) v[r] *= rs;
      *(uint2*)(ORET + (size_t)(t0 + q) * 1024 + h * 256 + wn * 128 + j * 16 + lg * 4) = pack4(v);
    }
  }
}

DEV u32x4 scale8(u32x4 raw, f32x4 ea, f32x4 eb) {
  u32x4 o;
  o[0] = pack2(bf2f((bf16_t)(raw[0] & 0xffff)) * __expf(ea[0]), bf2f((bf16_t)(raw[0] >> 16)) * __expf(ea[1]));
  o[1] = pack2(bf2f((bf16_t)(raw[1] & 0xffff)) * __expf(ea[2]), bf2f((bf16_t)(raw[1] >> 16)) * __expf(ea[3]));
  o[2] = pack2(bf2f((bf16_t)(raw[2] & 0xffff)) * __expf(eb[0]), bf2f((bf16_t)(raw[2] >> 16)) * __expf(eb[1]));
  o[3] = pack2(bf2f((bf16_t)(raw[3] & 0xffff)) * __expf(eb[2]), bf2f((bf16_t)(raw[3] >> 16)) * __expf(eb[3]));
  return o;
}
DEV f32x4 min80(f32x4 v) { return (f32x4){fminf(v[0], 80.f), fminf(v[1], 80.f), fminf(v[2], 80.f), fminf(v[3], 80.f)}; }

DEV void hg_item(const Params& p, int h, int c, bf16_t* lds) {
  unsigned char* ws = p.ws;
  const bf16_t* HQ = (const bf16_t*)(ws + OFF_HQ);
  const bf16_t* HK = (const bf16_t*)(ws + OFF_HK);
  const float* HCB = (const float*)(ws + OFF_HCB);
  const bf16_t* HVT = (const bf16_t*)(ws + OFF_HVT);
  const bf16_t* STH = (const bf16_t*)(ws + OFF_STH);
  bf16_t* OHG = (bf16_t*)(ws + OFF_OHG);
  constexpr int PS = 136;
  bf16_t* Qp = lds;
  bf16_t* Kp = lds + 128 * PS;
  bf16_t* As = lds + 2 * 128 * PS;
  float* RED = (float*)(lds + 2 * 128 * PS + 256 * PS);
  const int tid = get_tid(), lane = tid & 63, wave = tid >> 6, wm = wave >> 1, wn = wave & 1;
  const int lr = lane & 15, lg = lane >> 4;
  const int t0 = c * 128, colb = h * 128;
  const int lrow = tid >> 4, lc8 = (tid & 15) * 8;
  u32x4 qv[4], kv[4], vv[4], sv[4];
  f32x4 ca[4], cb2[4], ra[3], rb[3];
#pragma unroll
  for (int i = 0; i < 4; i++) {
    const int row = lrow + i * 32;
    const size_t g = (size_t)(t0 + row) * 1024 + colb + lc8;
    qv[i] = *(const u32x4*)(HQ + g);
    kv[i] = *(const u32x4*)(HK + g);
    ca[i] = *(const f32x4*)(HCB + g);
    cb2[i] = *(const f32x4*)(HCB + g + 4);
    vv[i] = *(const u32x4*)(HVT + (size_t)(colb + row) * LT + t0 + lc8);
    sv[i] = *(const u32x4*)(STH + ((size_t)(h * 65 + c) * 128 + row) * 128 + lc8);
  }
#pragma unroll
  for (int I = 1; I < 4; I++) {
    const size_t gr = (size_t)(t0 + 32 * I - 1) * 1024 + colb + lc8;
    ra[I - 1] = *(const f32x4*)(HCB + gr);
    rb[I - 1] = *(const f32x4*)(HCB + gr + 4);
  }
  const f32x4 z4 = (f32x4){0.f, 0.f, 0.f, 0.f};
#pragma unroll
  for (int i = 0; i < 4; i++) {
    const f32x4 fa = i == 0 ? z4 : ra[i == 0 ? 0 : i - 1], fb = i == 0 ? z4 : rb[i == 0 ? 0 : i - 1];
    *(u32x4*)(Qp + (lrow + i * 32) * PS + lc8) = scale8(qv[i], ca[i] - fa, cb2[i] - fb);
  }
#pragma unroll
  for (int I = 0; I < 4; I++) {
    const int nrows = 32 * (I + 1);
    const f32x4 fa = I == 0 ? z4 : ra[I == 0 ? 0 : I - 1], fb = I == 0 ? z4 : rb[I == 0 ? 0 : I - 1];
#pragma unroll
    for (int i = 0; i < 4; i++) {
      if (i <= I) *(u32x4*)(Kp + (lrow + i * 32) * PS + lc8) = scale8(kv[i], min80(fa - ca[i]), min80(fb - cb2[i]));
    }
    __syncthreads();
    if (wave * 16 < nrows) {
      f32x4 a2[2];
      a2[0] = (f32x4){0.f, 0.f, 0.f, 0.f}; a2[1] = a2[0];
#pragma unroll
      for (int ks = 0; ks < 4; ks++) {
        bf16x8 bb = ldfrag(Kp, PS, wave * 16 + lr, ks * 32 + lg * 8);
        bf16x8 a0 = ldfrag(Qp, PS, 32 * I + lr, ks * 32 + lg * 8);
        bf16x8 a1 = ldfrag(Qp, PS, 32 * I + 16 + lr, ks * 32 + lg * 8);
        a2[0] = MFMA(bb, a0, a2[0]);
        a2[1] = MFMA(bb, a1, a2[1]);
      }
#pragma unroll
      for (int i = 0; i < 2; i++) {
        const int q = 32 * I + i * 16 + lr;
        f32x4 v;
#pragma unroll
        for (int r = 0; r < 4; r++) { const int key = wave * 16 + lg * 4 + r; v[r] = (key <= q) ? a2[i][r] : 0.f; }
        *(uint2*)(As + q * PS + wave * 16 + lg * 4) = pack4(v);
      }
    } else {
#pragma unroll
      for (int i = 0; i < 2; i++) {
        const int q = 32 * I + i * 16 + lr;
        *(uint2*)(As + q * PS + wave * 16 + lg * 4) = make_uint2(0u, 0u);
      }
    }
    __syncthreads();
  }
#pragma unroll
  for (int i = 0; i < 4; i++) *(u32x4*)(Kp + (lrow + i * 32) * PS + lc8) = vv[i];
  __syncthreads();
  f32x4 o[2][4];
#pragma unroll
  for (int i = 0; i < 2; i++)
#pragma unroll
    for (int j = 0; j < 4; j++) o[i][j] = (f32x4){0.f, 0.f, 0.f, 0.f};
#pragma unroll
  for (int ks = 0; ks < 4; ks++) {
    bf16x8 a0 = ldfrag(As, PS, wm * 32 + lr, ks * 32 + lg * 8);
    bf16x8 a1 = ldfrag(As, PS, wm * 32 + 16 + lr, ks * 32 + lg * 8);
#pragma unroll
    for (int j = 0; j < 4; j++) {
      bf16x8 bb = ldfrag(Kp, PS, wn * 64 + j * 16 + lr, ks * 32 + lg * 8);
      o[0][j] = MFMA(bb, a0, o[0][j]);
      o[1][j] = MFMA(bb, a1, o[1][j]);
    }
  }
  __syncthreads();
#pragma unroll
  for (int i = 0; i < 4; i++) {
    *(u32x4*)(Qp + (lrow + i * 32) * PS + lc8) = scale8(qv[i], ca[i], cb2[i]);
    *(u32x4*)(Kp + (lrow + i * 32) * PS + lc8) = sv[i];
  }
  __syncthreads();
#pragma unroll
  for (int ks = 0; ks < 4; ks++) {
    bf16x8 a0 = ldfrag(Qp, PS, wm * 32 + lr, ks * 32 + lg * 8);
    bf16x8 a1 = ldfrag(Qp, PS, wm * 32 + 16 + lr, ks * 32 + lg * 8);
#pragma unroll
    for (int j = 0; j < 4; j++) {
      bf16x8 bb = ldfrag(Kp, PS, wn * 64 + j * 16 + lr, ks * 32 + lg * 8);
      o[0][j] = MFMA(bb, a0, o[0][j]);
      o[1][j] = MFMA(bb, a1, o[1][j]);
    }
  }
#pragma unroll
  for (int i = 0; i < 2; i++) {
    float ss = 0.f;
#pragma unroll
    for (int j = 0; j < 4; j++)
#pragma unroll
      for (int r = 0; r < 4; r++) ss += o[i][j][r] * o[i][j][r];
    ss += shfl_xor_l(ss, 16, lane);
    ss += shfl_xor_l(ss, 32, lane);
    if (lg == 0) RED[(wm * 32 + i * 16 + lr) * 2 + wn] = ss;
  }
  __syncthreads();
#pragma unroll
  for (int i = 0; i < 2; i++) {
    const int q = wm * 32 + i * 16 + lr;
    const float rs = rsqrtf((RED[q * 2] + RED[q * 2 + 1]) * (1.f / 128.f) + 1e-6f);
#pragma unroll
    for (int j = 0; j < 4; j++) {
      f32x4 v = o[i][j];
#pragma unroll
      for (int r = 0; r < 4; r++) v[r] *= rs;
      *(uint2*)(OHG + (size_t)(t0 + q) * 1024 + colb + wn * 64 + j * 16 + lg * 4) = pack4(v);
    }
  }
}

DEV void phase_O(const Params& p, int layer, int qidx, unsigned char* ldsraw) {
  bf16_t* lds = (bf16_t*)ldsraw;
  int* ctr = (int*)(p.ws + OFF_CTR) + qidx;
  int* sitem = (int*)(ldsraw + LDS_BYTES - 16);
  const float* lp = p.in[7] + layer * 256;
  float d0 = 0.f, d1 = 0.f;
  for (int i = 0; i < 64; i++) { d0 += lp[i] * lp[64 + i]; d1 += lp[128 + i] * lp[192 + i]; }
  int ly = layer; asm volatile("" : "+s"(ly));
  const float li = (ly == 0) ? 0.2f : 0.35550906759f;
  const float lam = __uint_as_float(__builtin_amdgcn_readfirstlane(__float_as_uint(__expf(d0) - __expf(d1) + li)));
  const int tid0 = get_tid();
  for (;;) {
    __syncthreads();
    if (tid0 == 0) *sitem = atomicAdd(ctr, 1);
    __syncthreads();
    const int item = __builtin_amdgcn_readfirstlane(*sitem);
    if (item >= 1300) break;
    if (item < 520) attn_item(p, layer, item & 7, 64 - (item >> 3), lam, lds);
    else if (item < 780) ret_item(p, (item - 520) & 3, (item - 520) >> 2, lds);
    else hg_item(p, (item - 780) & 7, (item - 780) >> 3, lds);
  }
}

DEV void phase_G(const Params& p, int b, unsigned char* ldsraw) {
  unsigned char* ws = p.ws;
  bf16_t* lds = (bf16_t*)ldsraw;
  const bf16_t* HN = (const bf16_t*)(ws + OFF_HN) + (size_t)b * LT * 1024;
  const bf16_t* WIN = (const bf16_t*)(ws + OFF_WIN);
  for (int item = vblock(); item < 33 * 20; item += gridDim.x) {
    int nt, mt; tile_map(item, 33, 4, mt, nt);
    int n0, cb; bf16_t* dst; int ld; bool gate;
    if (nt < 4) { n0 = 2048 + nt * 256; cb = nt * 256; dst = (bf16_t*)(ws + OFF_ORET); ld = 1024; gate = true; }
    else if (nt < 8) { n0 = 6144 + (nt - 4) * 256; cb = (nt - 4) * 256; dst = (bf16_t*)(ws + OFF_OHG); ld = 1024; gate = true; }
    else { n0 = 10240 + (nt - 8) * 256; cb = (nt - 8) * 256; dst = (bf16_t*)(ws + OFF_G); ld = 3072; gate = false; }
    f32x4 acc[4][8];
#pragma unroll
    for (int i = 0; i < 4; i++)
#pragma unroll
      for (int j = 0; j < 8; j++) acc[i][j] = (f32x4){0.f, 0.f, 0.f, 0.f};
    gemm256_acc<256>(acc, HN + (size_t)mt * 256 * 1024, 1024, LT - mt * 256, WIN + (size_t)n0 * 1024, 1024, 1024, lds);
    const int tid = get_tid(), lane = tid & 63, wave = tid >> 6, wm = wave >> 1, wn = wave & 1; const int lr = lane & 15, lg = lane >> 4;
#pragma unroll
    for (int i = 0; i < 4; i++) {
      const int t = mt * 256 + wm * 64 + i * 16 + lr;
      if (t < LT) {
#pragma unroll
        for (int j = 0; j < 8; j++) {
          bf16_t* d = dst + (size_t)t * ld + cb + wn * 128 + j * 16 + lg * 4;
          f32x4 v;
          if (gate) {
            uint2 ov = *(const uint2*)d;
            v[0] = bf2f((bf16_t)(ov.x & 0xffff)) * silu_f(acc[i][j][0]);
            v[1] = bf2f((bf16_t)(ov.x >> 16)) * silu_f(acc[i][j][1]);
            v[2] = bf2f((bf16_t)(ov.y & 0xffff)) * silu_f(acc[i][j][2]);
            v[3] = bf2f((bf16_t)(ov.y >> 16)) * silu_f(acc[i][j][3]);
          } else {
#pragma unroll
            for (int r = 0; r < 4; r++) v[r] = sigmoid_f(acc[i][j][r]);
          }
          *(uint2*)d = pack4(v);
        }
      }
    }
  }
}

DEV f32x4 mini_gemm16(const bf16_t* __restrict__ A16, int lda, const bf16_t* __restrict__ Bt16, int ldb, int k0, int klen, int lane) {
  const int lr = lane & 15, lg = lane >> 4;
  const bf16_t* pa = A16 + (size_t)lr * lda + k0 + lg * 8;
  const bf16_t* pb = Bt16 + (size_t)lr * ldb + k0 + lg * 8;
  f32x4 acc = (f32x4){0.f, 0.f, 0.f, 0.f};
#pragma unroll 4
  for (int k = 0; k < klen; k += 32) {
    bf16x8 a = *(const bf16x8*)(pa + k);
    bf16x8 b = *(const bf16x8*)(pb + k);
    acc = MFMA(b, a, acc);
  }
  return acc;
}

DEV void phase_Y(const Params& p, unsigned char* ldsraw) {
  unsigned char* ws = p.ws;
  bf16_t* lds = (bf16_t*)ldsraw;
  const bf16_t* WB = (const bf16_t*)(ws + OFF_WB);
  const bf16_t* G = (const bf16_t*)(ws + OFF_G);
  bf16_t* Y = (bf16_t*)(ws + OFF_Y);
  for (int item = vblock(); item < 32 * 8 + 64; item += gridDim.x) {
    if (item >= 256) {
      const int lane = get_tid() & 63, wave = get_tid() >> 6, lr = lane & 15, lg = lane >> 4;
      const int n0 = (item - 256) * 16;
      f32x4* red = (f32x4*)ldsraw;
      __syncthreads();
#pragma unroll 1
      for (int br = 0; br < 3; br++) {
        const bf16_t* Ab = (const bf16_t*)(ws + (br == 0 ? OFF_ORET : (br == 1 ? OFF_OHG : OFF_ODA))) + (size_t)112 * 1024;
        red[(br * 8 + wave) * 64 + lane] = mini_gemm16(Ab, 1024, WB + ((size_t)br * 1024 + n0) * 1024, 1024, wave * 128, 128, lane);
      }
      __syncthreads();
      if (wave == 0) {
        f32x4 y = (f32x4){0.f, 0.f, 0.f, 0.f};
#pragma unroll
        for (int br = 0; br < 3; br++) {
          f32x4 a = red[(br * 8) * 64 + lane];
#pragma unroll
          for (int w = 1; w < 8; w++) a += red[(br * 8 + w) * 64 + lane];
          uint2 gv = *(const uint2*)(G + (size_t)(112 + lr) * 3072 + br * 1024 + n0 + lg * 4);
          y[0] += bf2f((bf16_t)(gv.x & 0xffff)) * a[0];
          y[1] += bf2f((bf16_t)(gv.x >> 16)) * a[1];
          y[2] += bf2f((bf16_t)(gv.y & 0xffff)) * a[2];
          y[3] += bf2f((bf16_t)(gv.y >> 16)) * a[3];
        }
        *(uint2*)(Y + (size_t)(112 + lr) * 1024 + n0 + lg * 4) = pack4(y);
      }
      continue;
    }
    int nt, mt; tile_map(item, 32, 4, mt, nt);
    const int row0 = 128 + mt * 256;
    f32x4 y[4][4];
#pragma unroll
    for (int i = 0; i < 4; i++)
#pragma unroll
      for (int j = 0; j < 4; j++) y[i][j] = (f32x4){0.f, 0.f, 0.f, 0.f};
#pragma unroll 1
    for (int br = 0; br < 3; br++) {
      const bf16_t* Ab = (const bf16_t*)(ws + (br == 0 ? OFF_ORET : (br == 1 ? OFF_OHG : OFF_ODA))) + (size_t)row0 * 1024;
      f32x4 acc[4][4];
#pragma unroll
      for (int i = 0; i < 4; i++)
#pragma unroll
        for (int j = 0; j < 4; j++) acc[i][j] = (f32x4){0.f, 0.f, 0.f, 0.f};
      gemm256_acc<128>(acc, Ab, 1024, 256, WB + ((size_t)br * 1024 + nt * 128) * 1024, 1024, 1024, lds);
      const int tid = get_tid(), lane = tid & 63, wave = tid >> 6, wm = wave >> 1, wn = wave & 1; const int lr = lane & 15, lg = lane >> 4;
#pragma unroll
      for (int i = 0; i < 4; i++) {
        const int t = row0 + wm * 64 + i * 16 + lr;
#pragma unroll
        for (int j = 0; j < 4; j++) {
          uint2 gv = *(const uint2*)(G + (size_t)t * 3072 + br * 1024 + nt * 128 + wn * 64 + j * 16 + lg * 4);
          y[i][j][0] += bf2f((bf16_t)(gv.x & 0xffff)) * acc[i][j][0];
          y[i][j][1] += bf2f((bf16_t)(gv.x >> 16)) * acc[i][j][1];
          y[i][j][2] += bf2f((bf16_t)(gv.y & 0xffff)) * acc[i][j][2];
          y[i][j][3] += bf2f((bf16_t)(gv.y >> 16)) * acc[i][j][3];
        }
      }
    }
    const int tid = get_tid(), lane = tid & 63, wave = tid >> 6, wm = wave >> 1, wn = wave & 1; const int lr = lane & 15, lg = lane >> 4;
#pragma unroll
    for (int i = 0; i < 4; i++) {
      const int t = row0 + wm * 64 + i * 16 + lr;
#pragma unroll
      for (int j = 0; j < 4; j++)
        *(uint2*)(Y + (size_t)t * 1024 + nt * 128 + wn * 64 + j * 16 + lg * 4) = pack4(y[i][j]);
    }
  }
}

DEV void phase_resid(const Params& p, int b, const bf16_t* A, int K, const bf16_t* Wt, unsigned char* ldsraw) {
  bf16_t* lds = (bf16_t*)ldsraw;
  for (int item = vblock(); item < 32 * 8 + 64; item += gridDim.x) {
    if (item >= 256) {
      const int lane = get_tid() & 63, wave = get_tid() >> 6, lr = lane & 15, lg = lane >> 4;
      const int n0 = (item - 256) * 16;
      f32x4* red = (f32x4*)ldsraw;
      const int ks = K >> 3;
      __syncthreads();
      red[wave * 64 + lane] = mini_gemm16(A + (size_t)112 * K, K, Wt + (size_t)n0 * K, K, wave * ks, ks, lane);
      __syncthreads();
      if (wave == 0) {
        f32x4 a = red[lane];
#pragma unroll
        for (int w = 1; w < 8; w++) a += red[w * 64 + lane];
        float4* d = (float4*)(hrow(p, b, 112 + lr) + n0 + lg * 4);
        float4 v = *d;
        v.x += a[0]; v.y += a[1]; v.z += a[2]; v.w += a[3];
        *d = v;
      }
      continue;
    }
    int nt, mt; tile_map(item, 32, 4, mt, nt);
    const int row0 = 128 + mt * 256;
    f32x4 acc[4][4];
#pragma unroll
    for (int i = 0; i < 4; i++)
#pragma unroll
      for (int j = 0; j < 4; j++) acc[i][j] = (f32x4){0.f, 0.f, 0.f, 0.f};
    gemm256_acc<128>(acc, A + (size_t)row0 * K, K, 256, Wt + (size_t)nt * 128 * K, K, K, lds);
    const int tid = get_tid(), lane = tid & 63, wave = tid >> 6, wm = wave >> 1, wn = wave & 1; const int lr = lane & 15, lg = lane >> 4;
#pragma unroll
    for (int i = 0; i < 4; i++) {
      const int t = row0 + wm * 64 + i * 16 + lr;
#pragma unroll
      for (int j = 0; j < 4; j++) {
        float4* d = (float4*)(hrow(p, b, t) + nt * 128 + wn * 64 + j * 16 + lg * 4);
        float4 v = *d;
        v.x += acc[i][j][0]; v.y += acc[i][j][1]; v.z += acc[i][j][2]; v.w += acc[i][j][3];
        *d = v;
      }
    }
  }
}

DEV void phase_F1(const Params& p, int b, unsigned char* ldsraw) {
  unsigned char* ws = p.ws;
  bf16_t* lds = (bf16_t*)ldsraw;
  const bf16_t* HN = (const bf16_t*)(ws + OFF_HN) + (size_t)b * LT * 1024;
  const bf16_t* WFI = (const bf16_t*)(ws + OFF_WFI);
  bf16_t* U = (bf16_t*)(ws + OFF_U);
  for (int item = vblock(); item < 33 * 22; item += gridDim.x) {
    int nt, mt; tile_map(item, 33, 2, mt, nt);
    f32x4 acc[4][8];
#pragma unroll
    for (int i = 0; i < 4; i++)
#pragma unroll
      for (int j = 0; j < 8; j++) acc[i][j] = (f32x4){0.f, 0.f, 0.f, 0.f};
    gemm256_acc<256>(acc, HN + (size_t)mt * 256 * 1024, 1024, LT - mt * 256, WFI + (size_t)nt * 256 * 1024, 1024, 1024, lds);
    const int tid = get_tid(), lane = tid & 63, wave = tid >> 6, wm = wave >> 1, wn = wave & 1; const int lr = lane & 15, lg = lane >> 4;
#pragma unroll
    for (int i = 0; i < 4; i++) {
      const int t = mt * 256 + wm * 64 + i * 16 + lr;
      if (t < LT) {
        const float vm = (t >= 112) ? 1.f : 0.f;
#pragma unroll
        for (int j = 0; j < 8; j++) {
          f32x4 v = acc[i][j];
#pragma unroll
          for (int r = 0; r < 4; r++) v[r] *= vm;
          *(uint2*)(U + (size_t)t * 5632 + nt * 256 + wn * 128 + j * 16 + lg * 4) = pack4(v);
        }
      }
    }
  }
}

DEV void unpack8(const u32x4 v, float (&f)[8]) {
#pragma unroll
  for (int k = 0; k < 4; k++) { f[2 * k] = bf2f((bf16_t)(v[k] & 0xffff)); f[2 * k + 1] = bf2f((bf16_t)(v[k] >> 16)); }
}
DEV void phase_conv(const Params& p, int layer) {
  unsigned char* ws = p.ws;
  const bf16_t* U = (const bf16_t*)(ws + OFF_U);
  bf16_t* GF = (bf16_t*)(ws + OFF_GF);
  const float* cw = p.in[11] + (size_t)layer * 3 * 5632;
  const float* cbias = p.in[12] + (size_t)layer * 5632;
  for (int idx = get_bid() * NTHR + get_tid(); idx < (LT / 8) * 352; idx += gridDim.x * NTHR) {
    const int tb = idx / 352, c8 = (idx - tb * 352) * 8;
    const int t0 = tb * 8;
    float wg[3][8], wv[3][8], bg[8], bv[8];
#pragma unroll
    for (int k = 0; k < 8; k++) {
      bg[k] = cbias[c8 + k]; bv[k] = cbias[2816 + c8 + k];
#pragma unroll
      for (int j = 0; j < 3; j++) { wg[j][k] = cw[j * 5632 + c8 + k]; wv[j][k] = cw[j * 5632 + 2816 + c8 + k]; }
    }
    float g0[8], g1[8], v0[8], v1[8];
    if (t0 >= 2) {
      unpack8(*(const u32x4*)(U + (size_t)(t0 - 2) * 5632 + c8), g0);
      unpack8(*(const u32x4*)(U + (size_t)(t0 - 2) * 5632 + 2816 + c8), v0);
      unpack8(*(const u32x4*)(U + (size_t)(t0 - 1) * 5632 + c8), g1);
      unpack8(*(const u32x4*)(U + (size_t)(t0 - 1) * 5632 + 2816 + c8), v1);
    } else {
#pragma unroll
      for (int k = 0; k < 8; k++) { g0[k] = 0.f; g1[k] = 0.f; v0[k] = 0.f; v1[k] = 0.f; }
    }
#pragma unroll
    for (int tt = 0; tt < 8; tt++) {
      float g2[8], v2[8];
      unpack8(*(const u32x4*)(U + (size_t)(t0 + tt) * 5632 + c8), g2);
      unpack8(*(const u32x4*)(U + (size_t)(t0 + tt) * 5632 + 2816 + c8), v2);
      float og[8];
#pragma unroll
      for (int k = 0; k < 8; k++) {
        const float gg = bg[k] + wg[0][k] * g0[k] + wg[1][k] * g1[k] + wg[2][k] * g2[k];
        const float vv = bv[k] + wv[0][k] * v0[k] + wv[1][k] * v1[k] + wv[2][k] * v2[k];
        og[k] = silu_f(gg) * vv;
        g0[k] = g1[k]; g1[k] = g2[k]; v0[k] = v1[k]; v1[k] = v2[k];
      }
      u32x4 o;
      o[0] = pack2(og[0], og[1]); o[1] = pack2(og[2], og[3]); o[2] = pack2(og[4], og[5]); o[3] = pack2(og[6], og[7]);
      *(u32x4*)(GF + (size_t)(t0 + tt) * 2816 + c8) = o;
    }
  }
}

#define XB_TMO      128
#define XB_XCNT(j)  (256  + 64 * (j))
#define XB_XSUB(j)  (1280 + 64 * (j))
#define XB_XGEN(j)  (2304 + 64 * (j))
#define XB_TOP      3328
#define XB_TOPGEN   3392
#define XB_SPIN_CAP (1u << 18)
#define LAS __attribute__((address_space(3)))
DEV unsigned xb_ld(unsigned* p) { return __hip_atomic_load(p, __ATOMIC_RELAXED, __HIP_MEMORY_SCOPE_AGENT); }
DEV unsigned xb_add(unsigned* p, unsigned v) { return __hip_atomic_fetch_add(p, v, __ATOMIC_RELAXED, __HIP_MEMORY_SCOPE_AGENT); }
DEV unsigned xb_xcc_id() { return (unsigned)__builtin_amdgcn_s_getreg((3 << 11) | 20) & 0xFu; }
#define XB_SPIN(cond, bar) do { unsigned _sp = 0; while (cond) { __builtin_amdgcn_s_sleep(1); \
    if ((++_sp & 255u) == 0u) { if (xb_ld(&(bar)[XB_TMO])) break; if (_sp > XB_SPIN_CAP) { atomicAdd(&(bar)[XB_TMO], 1u); break; } } } } while (0)
struct XcdBarrier { unsigned* bar; unsigned x; volatile LAS unsigned* st; };
DEV XcdBarrier xcd_barrier_post(unsigned* bar, volatile LAS unsigned* st) {
  XcdBarrier b; b.bar = bar; b.x = xb_xcc_id(); b.st = st;
  if (threadIdx.x == 0) (void)xb_add(&bar[XB_XCNT(b.x)], 1u);
  return b;
}
DEV void xcd_barrier_complete(unsigned* bar, unsigned x, unsigned& nloc, unsigned& nx) {
  const unsigned G = gridDim.x;
  unsigned sum, cnt, mine, sp = 0u;
  for (;;) {
    sum = 0u; cnt = 0u; mine = 0u;
#pragma unroll
    for (unsigned j = 0; j < 16; ++j) { const unsigned c = xb_ld(&bar[XB_XCNT(j)]); sum += c; cnt += (c > 0u) ? 1u : 0u; mine = (j == x) ? c : mine; }
    if (sum == G) break;
    __builtin_amdgcn_s_sleep(1);
    if ((++sp & 255u) == 0u) { if (xb_ld(&bar[XB_TMO])) break; if (sp > XB_SPIN_CAP) { atomicAdd(&bar[XB_TMO], 1u); break; } }
  }
  nloc = mine > 0u ? mine : 1u; nx = cnt > 0u ? cnt : 1u;
}
DEV void xcd_barrier(const XcdBarrier& b) {
  asm volatile("s_waitcnt vmcnt(0)" ::: "memory");
  __syncthreads();
  if (threadIdx.x == 0) {
    unsigned* bar = b.bar;
    __builtin_amdgcn_s_waitcnt(0);
    unsigned nloc = b.st[0], nx = b.st[1];
    if (nloc == 0u) { xcd_barrier_complete(bar, b.x, nloc, nx); b.st[0] = nloc; b.st[1] = nx; }
    const unsigned old = xb_add(&bar[XB_XSUB(b.x)], 1u);
    const unsigned gen = old / nloc;
    if (old + 1u == (gen + 1u) * nloc) {
      __builtin_amdgcn_fence(__ATOMIC_RELEASE, "agent");
      asm volatile("s_waitcnt vmcnt(0)" ::: "memory");
      const unsigned og = xb_add(&bar[XB_TOP], 1u);
      const unsigned tg = og / nx;
      if (og + 1u == (tg + 1u) * nx) xb_add(&bar[XB_TOPGEN], 1u);
      else XB_SPIN(xb_ld(&bar[XB_TOPGEN]) == tg, bar);
      __builtin_amdgcn_fence(__ATOMIC_ACQUIRE, "agent");
      xb_add(&bar[XB_XGEN(b.x)], 1u);
      asm volatile("s_waitcnt vmcnt(0)" ::: "memory");
    } else {
      XB_SPIN(xb_ld(&bar[XB_XGEN(b.x)]) == gen, bar);
      __builtin_amdgcn_fence(__ATOMIC_ACQUIRE, "agent");
      asm volatile("s_waitcnt vmcnt(0)" ::: "memory");
    }
  }
  __syncthreads();
}

__global__ void __launch_bounds__(NTHR) fwd_megakernel(Params p) {
  extern __shared__ __attribute__((aligned(16))) unsigned char lds[];
  cg::grid_group grid = cg::this_grid();
  volatile LAS unsigned* xst = (volatile LAS unsigned*)(lds + LDS_BYTES - 12);
  if (threadIdx.x == 0) { xst[0] = 0u; xst[1] = 0u; }
  __syncthreads();
  (void)xcd_barrier_post((unsigned*)(p.ws + OFF_XBAR), xst);
#define GRID_SYNC() do { XcdBarrier xb_; xb_.bar = (unsigned*)(p.ws + OFF_XBAR); xb_.x = xb_xcc_id(); \
    xb_.st = (volatile LAS unsigned*)(lds + LDS_BYTES - 12); xcd_barrier(xb_); } while (0)
  grid.sync();
  unsigned char* ws = p.ws;
  phase_init(p);
  phase_convert(p, 0, lds);
  GRID_SYNC();
  for (int layer = 0; layer < 2; layer++) {
    if (layer == 1) {
      phase_convert(p, 1, lds);
#pragma unroll 1
      for (int bb = 0; bb < 2; bb++)
        phase_norm(p, bb, p.in[2] + 1024, (bf16_t*)(ws + OFF_HN) + (size_t)bb * LT * 1024);
      GRID_SYNC();
    }
    for (int b = 0; b < 2; b++) {
      bf16_t* HNb = (bf16_t*)(ws + OFF_HN) + (size_t)b * LT * 1024;
      phase_projA(p, layer, b, lds);
      GRID_SYNC();
      phase_U(p, lds);
      GRID_SYNC();
      phase_scan(p);
      GRID_SYNC();
      phase_O(p, layer, layer * 2 + b, lds);
      GRID_SYNC();
      phase_G(p, b, lds);
      GRID_SYNC();
      phase_Y(p, lds);
      GRID_SYNC();
      phase_resid(p, b, (const bf16_t*)(ws + OFF_Y), 1024, (const bf16_t*)(ws + OFF_WO), lds);
      GRID_SYNC();
      phase_norm(p, b, p.in[9] + layer * 1024, HNb);
      GRID_SYNC();
      phase_F1(p, b, lds);
      GRID_SYNC();
      phase_conv(p, layer);
      GRID_SYNC();
      phase_resid(p, b, (const bf16_t*)(ws + OFF_GF), DFF, (const bf16_t*)(ws + OFF_WFO), lds);
      GRID_SYNC();
    }
  }
  phase_final(p);
}

extern "C" void kernel_launch(void* const* d_in, const int* in_sizes, int n_in, void* d_out, int out_size,
                              void* d_ws, size_t ws_size, hipStream_t stream) {
  static int grid_blocks = 0;
  if (grid_blocks == 0) {
    if (n_in != 15 || ws_size < OFF_END) {
      fprintf(stderr, "kernel_launch: need 15 inputs and %zu bytes of workspace, got %d and %zu\n", (size_t)OFF_END, n_in, ws_size);
      grid_blocks = -1; return;
    }
    int dev = 0, cus = 0, per_cu = 0;
    hipGetDevice(&dev);
    hipDeviceGetAttribute(&cus, hipDeviceAttributeMultiprocessorCount, dev);
    if (hipFuncSetAttribute((const void*)fwd_megakernel, hipFuncAttributeMaxDynamicSharedMemorySize, LDS_BYTES) != hipSuccess) {
      fprintf(stderr, "kernel_launch: hipFuncSetAttribute failed\n"); grid_blocks = -1; return;
    }
    hipOccupancyMaxActiveBlocksPerMultiprocessor(&per_cu, (const void*)fwd_megakernel, NTHR, LDS_BYTES);
    if (per_cu < 1) per_cu = 1;
    if (per_cu > 1) per_cu = 1;
    grid_blocks = cus * per_cu;
  }
  if (grid_blocks < 0) return;
  hipMemsetAsync((char*)d_ws + OFF_CTR, 0, 256 + XBAR_BYTES, stream);
  Params p{};
  for (int i = 0; i < 15; i++) p.in[i] = (const float*)d_in[i];
  p.out = (float*)d_out;
  p.ws = (unsigned char*)d_ws;
  void* args[] = {&p};
  hipError_t e = hipLaunchCooperativeKernel((const void*)fwd_megakernel, dim3(grid_blocks), dim3(NTHR), args, LDS_BYTES, stream);
  if (e != hipSuccess) fprintf(stderr, "cooperative launch failed: %s (grid %d)\n", hipGetErrorString(e), grid_blocks);
}
```
